# Optimizing an MI355X kernel written in HIP

```python
import math
import jax, jax.numpy as jnp
from jax import lax
import numpy as np

D_MODEL = 1024
BATCH = 32
SEQ = 2048
DEPTH = 1

D_MIX = D_MODEL
D_SSM = D_MIX // 2
SSM_GROUP = 16
N_SSM_GROUPS = D_SSM // SSM_GROUP
SSM_STATE = 64
N_DIR = 2
DT_MIN = 1e-3
DT_MAX = 1e-1
N_HEADS = 8
QK_NOPE_DIM = 64
QK_ROPE_DIM = 32
V_HEAD_DIM = 64
D_ATTN = N_HEADS * V_HEAD_DIM
Q_LORA_RANK = 256
KV_LORA_RANK = 128
ROPE_THETA = 10000.0
Q_BLOCK = 128
D_IN = D_SSM + Q_LORA_RANK + KV_LORA_RANK + QK_ROPE_DIM
N_EXPERTS = 64
TOP_K = 6
N_EXPERT_GROUPS = 8
TOPK_GROUPS = 4
D_EXPERT = 256
N_SHARED = 1
ROUTED_SCALE = 2.5
EXPERT_BLOCK = 128
DEEPNORM_ALPHA = (2 * DEPTH) ** 0.25
DEEPNORM_BETA = (8 * DEPTH) ** -0.25
LN_EPS = 1e-5
RMS_EPS = 1e-6

kernel_name = "hybrid_s5_mla_moe_deepnorm_encoder"


def _layer_norm(x, g, b):
    xf = x.astype(jnp.float32)
    mu = jnp.mean(xf, axis=-1, keepdims=True)
    xc = xf - mu
    var = jnp.mean(xc * xc, axis=-1, keepdims=True)
    return xc * lax.rsqrt(var + LN_EPS) * g.astype(jnp.float32) + b.astype(jnp.float32)


def _rms_norm(x, g):
    xf = x.astype(jnp.float32)
    y = xf * lax.rsqrt(jnp.mean(xf * xf, axis=-1, keepdims=True) + RMS_EPS) * g.astype(jnp.float32)
    return y.astype(x.dtype)


def _rope(t, cos, sin):
    half = t.shape[-1] // 2
    t1, t2 = t[..., :half], t[..., half:]
    cos = cos.astype(t.dtype)
    sin = sin.astype(t.dtype)
    return jnp.concatenate([t1 * cos - t2 * sin, t1 * sin + t2 * cos], axis=-1)


def _ssm_combine(ei, ej):
    ai_r, ai_i, bi_r, bi_i = ei
    aj_r, aj_i, bj_r, bj_i = ej
    a_r = aj_r * ai_r - aj_i * ai_i
    a_i = aj_r * ai_i + aj_i * ai_r
    b_r = aj_r * bi_r - aj_i * bi_i + bj_r
    b_i = aj_r * bi_i + aj_i * bi_r + bj_i
    return a_r, a_i, b_r, b_i


def _s5_bidirectional(u, lam_re, lam_im, log_dt, b_re, b_im, c_re, c_im, d_skip):
    bsz, seq, _ = u.shape
    uf = u.astype(jnp.float32)
    ul = uf.reshape(bsz, seq, N_SSM_GROUPS, SSM_GROUP).transpose(1, 0, 2, 3)
    y = jnp.zeros_like(ul)
    for d in range(N_DIR):
        lr = jnp.minimum(lam_re[d].astype(jnp.float32), -1e-4)
        li = lam_im[d].astype(jnp.float32)
        dt = jnp.exp(log_dt[d].astype(jnp.float32))[:, None]
        mag = jnp.exp(lr * dt)
        ar = mag * jnp.cos(li * dt)
        ai = mag * jnp.sin(li * dt)
        den = lr * lr + li * li
        kr = ((ar - 1.0) * lr + ai * li) / den
        ki = (ai * lr - (ar - 1.0) * li) / den
        br = b_re[d].astype(jnp.float32)
        bi = b_im[d].astype(jnp.float32)
        bbr = kr[..., None] * br - ki[..., None] * bi
        bbi = kr[..., None] * bi + ki[..., None] * br
        bu_r = jnp.einsum('lbgp,gnp->lbgn', ul, bbr)
        bu_i = jnp.einsum('lbgp,gnp->lbgn', ul, bbi)
        a_r = jnp.broadcast_to(ar[None, None], (seq, 1) + ar.shape)
        a_i = jnp.broadcast_to(ai[None, None], (seq, 1) + ai.shape)
        _, _, h_r, h_i = lax.associative_scan(
            _ssm_combine, (a_r, a_i, bu_r, bu_i), reverse=(d == 1), axis=0)
        y = y + jnp.einsum('lbgn,gpn->lbgp', h_r, c_re[d].astype(jnp.float32)) \
              - jnp.einsum('lbgn,gpn->lbgp', h_i, c_im[d].astype(jnp.float32))
    y = y.transpose(1, 0, 2, 3).reshape(bsz, seq, D_SSM) + uf * d_skip.astype(jnp.float32)
    return y.astype(u.dtype)


def _mla(c_q, ckv_rope, q_norm_g, w_uq, kv_norm_g, w_ukv, cos, sin):
    bsz, seq, _ = c_q.shape
    q = (_rms_norm(c_q, q_norm_g) @ w_uq).reshape(bsz, seq, N_HEADS, QK_NOPE_DIM + QK_ROPE_DIM)
    q_nope = q[..., :QK_NOPE_DIM]
    q_rope = _rope(q[..., QK_NOPE_DIM:], cos[None, :, None, :], sin[None, :, None, :])
    ckv = _rms_norm(ckv_rope[..., :KV_LORA_RANK], kv_norm_g)
    k_rope = _rope(ckv_rope[..., KV_LORA_RANK:], cos[None], sin[None])
    kv = (ckv @ w_ukv).reshape(bsz, seq, N_HEADS, QK_NOPE_DIM + V_HEAD_DIM)
    k_nope = kv[..., :QK_NOPE_DIM]
    v = kv[..., QK_NOPE_DIM:]
    scale = (QK_NOPE_DIM + QK_ROPE_DIM) ** -0.5
    n_blk = seq // Q_BLOCK
    qn_blocks = q_nope.reshape(bsz, n_blk, Q_BLOCK, N_HEADS, QK_NOPE_DIM).transpose(1, 0, 2, 3, 4)
    qr_blocks = q_rope.reshape(bsz, n_blk, Q_BLOCK, N_HEADS, QK_ROPE_DIM).transpose(1, 0, 2, 3, 4)

    def attend(blk):
        qn, qr = blk
        s = (jnp.einsum('bqhd,bkhd->bhqk', qn, k_nope)
             + jnp.einsum('bqhr,bkr->bhqk', qr, k_rope)).astype(jnp.float32) * scale
        p = jax.nn.softmax(s, axis=-1).astype(v.dtype)
        return jnp.einsum('bhqk,bkhd->bqhd', p, v)

    o = lax.map(attend, (qn_blocks, qr_blocks))
    return o.transpose(1, 0, 2, 3, 4).reshape(bsz, seq, D_ATTN)


def _moe(x, w_router, router_bias, we_gate, we_up, we_down, ws_gate, ws_up, ws_down):
    bsz, seq, dm = x.shape
    xt = x.reshape(-1, dm)
    n_tok = xt.shape[0]
    scores = jax.nn.sigmoid((xt @ w_router).astype(jnp.float32))
    choice = scores + router_bias.astype(jnp.float32)
    grp = choice.reshape(n_tok, N_EXPERT_GROUPS, N_EXPERTS // N_EXPERT_GROUPS)
    grp_score = lax.top_k(grp, 2)[0].sum(-1)
    top_grp = lax.top_k(grp_score, TOPK_GROUPS)[1]
    grp_mask = jax.nn.one_hot(top_grp, N_EXPERT_GROUPS, dtype=jnp.float32).sum(1) > 0
    exp_mask = jnp.repeat(grp_mask, N_EXPERTS // N_EXPERT_GROUPS, axis=1)
    _, top_idx = lax.top_k(jnp.where(exp_mask, choice, -jnp.inf), TOP_K)
    top_w = jnp.take_along_axis(scores, top_idx, axis=1)
    top_w = top_w / (top_w.sum(-1, keepdims=True) + 1e-20) * ROUTED_SCALE

    n_assign = n_tok * TOP_K
    n_blocks = -(-n_assign // EXPERT_BLOCK) + N_EXPERTS
    n_rows = n_blocks * EXPERT_BLOCK
    flat_e = top_idx.reshape(-1).astype(jnp.int32)
    flat_tok = jnp.arange(n_assign, dtype=jnp.int32) // TOP_K
    flat_w = top_w.reshape(-1)
    order = jnp.argsort(flat_e)
    sorted_e = flat_e[order]
    counts = jnp.bincount(flat_e, length=N_EXPERTS).astype(jnp.int32)
    starts = jnp.cumsum(counts) - counts
    padded = (counts + EXPERT_BLOCK - 1) // EXPERT_BLOCK * EXPERT_BLOCK
    pends = jnp.cumsum(padded)
    pstarts = pends - padded
    dest = pstarts[sorted_e] + jnp.arange(n_assign, dtype=jnp.int32) - starts[sorted_e]
    row_tok = jnp.full((n_rows,), n_tok, jnp.int32).at[dest].set(flat_tok[order])
    row_w = jnp.zeros((n_rows,), jnp.float32).at[dest].set(flat_w[order])
    block_start = jnp.arange(n_blocks, dtype=jnp.int32) * EXPERT_BLOCK
    block_e = jnp.minimum(jnp.searchsorted(pends, block_start, side='right'), N_EXPERTS - 1)
    x_pad = jnp.concatenate([xt, jnp.zeros((1, dm), xt.dtype)], axis=0)

    def run_block(args):
        tok, wrow, e = args
        xb = x_pad[tok]
        hb = jax.nn.silu(xb @ we_gate[e]) * (xb @ we_up[e])
        return (hb @ we_down[e]).astype(jnp.float32) * wrow[:, None]

    y_rows = lax.map(run_block, (row_tok.reshape(n_blocks, EXPERT_BLOCK),
                                 row_w.reshape(n_blocks, EXPERT_BLOCK), block_e))
    routed = jnp.zeros((n_tok + 1, dm), jnp.float32).at[row_tok].add(
        y_rows.reshape(n_rows, dm))[:n_tok]
    shared = (jax.nn.silu(xt @ ws_gate) * (xt @ ws_up)) @ ws_down
    return (routed.astype(x.dtype) + shared).reshape(bsz, seq, dm)


def _layer(x, cos, sin, w_in, lam_re, lam_im, log_dt, b_re, b_im, c_re, c_im, d_skip,
           w_glu, b_glu, q_norm_g, w_uq, kv_norm_g, w_ukv, w_o, ln1_g, ln1_b,
           w_router, router_bias, we_gate, we_up, we_down, ws_gate, ws_up, ws_down,
           ln2_g, ln2_b):
    proj = x @ w_in
    u = proj[..., :D_SSM]
    c_q = proj[..., D_SSM:D_SSM + Q_LORA_RANK]
    ckv_rope = proj[..., D_SSM + Q_LORA_RANK:]
    s = jax.nn.gelu(_s5_bidirectional(u, lam_re, lam_im, log_dt, b_re, b_im, c_re, c_im, d_skip))
    s = s * jax.nn.sigmoid(s @ w_glu + b_glu)
    a = _mla(c_q, ckv_rope, q_norm_g, w_uq, kv_norm_g, w_ukv, cos, sin)
    mix = jnp.concatenate([s, a], axis=-1) @ w_o
    x1 = _layer_norm(DEEPNORM_ALPHA * x + mix, ln1_g, ln1_b).astype(x.dtype)
    f = _moe(x1, w_router, router_bias, we_gate, we_up, we_down, ws_gate, ws_up, ws_down)
    return _layer_norm(DEEPNORM_ALPHA * x1 + f, ln2_g, ln2_b).astype(x.dtype)


def setup_inputs(seed: int = 0) -> dict:
    key = jax.random.key(seed)
    ks = jax.random.split(key, 32)
    f32 = jnp.float32
    nrm = lambda k, shape, s: jax.random.normal(k, shape, f32) * s
    L = DEPTH
    G, N, P = N_SSM_GROUPS, SSM_STATE, SSM_GROUP
    d_sh = D_EXPERT * N_SHARED
    return {
        "x": jax.random.normal(ks[0], (BATCH, SEQ, D_MODEL), f32),
        "w_in": nrm(ks[1], (L, D_MODEL, D_IN), D_MODEL ** -0.5),
        "lam_re": -0.5 + nrm(ks[2], (L, N_DIR, G, N), 0.01),
        "lam_im": math.pi * jnp.arange(N, dtype=f32) + nrm(ks[3], (L, N_DIR, G, N), 0.01),
        "log_dt": jax.random.uniform(ks[4], (L, N_DIR, G), f32, math.log(DT_MIN), math.log(DT_MAX)),
        "b_re": nrm(ks[5], (L, N_DIR, G, N, P), (2 * P) ** -0.5),
        "b_im": nrm(ks[6], (L, N_DIR, G, N, P), (2 * P) ** -0.5),
        "c_re": nrm(ks[7], (L, N_DIR, G, P, N), N ** -0.5),
        "c_im": nrm(ks[8], (L, N_DIR, G, P, N), N ** -0.5),
        "d_skip": nrm(ks[9], (L, D_SSM), 1.0),
        "w_glu": nrm(ks[10], (L, D_SSM, D_SSM), D_SSM ** -0.5),
        "b_glu": nrm(ks[11], (L, D_SSM), 0.01),
        "q_norm_g": 1.0 + nrm(ks[12], (L, Q_LORA_RANK), 0.01),
        "w_uq": nrm(ks[13], (L, Q_LORA_RANK, N_HEADS * (QK_NOPE_DIM + QK_ROPE_DIM)), Q_LORA_RANK ** -0.5),
        "kv_norm_g": 1.0 + nrm(ks[14], (L, KV_LORA_RANK), 0.01),
        "w_ukv": nrm(ks[15], (L, KV_LORA_RANK, N_HEADS * (QK_NOPE_DIM + V_HEAD_DIM)), KV_LORA_RANK ** -0.5),
        "w_o": nrm(ks[16], (L, D_MIX, D_MODEL), D_MIX ** -0.5 * DEEPNORM_BETA),
        "ln1_g": 1.0 + nrm(ks[17], (L, D_MODEL), 0.01),
        "ln1_b": nrm(ks[18], (L, D_MODEL), 0.01),
        "w_router": nrm(ks[19], (L, D_MODEL, N_EXPERTS), D_MODEL ** -0.5),
        "router_bias": nrm(ks[20], (L, N_EXPERTS), 0.01),
        "we_gate": nrm(ks[21], (L, N_EXPERTS, D_MODEL, D_EXPERT), D_MODEL ** -0.5),
        "we_up": nrm(ks[22], (L, N_EXPERTS, D_MODEL, D_EXPERT), D_MODEL ** -0.5),
        "we_down": nrm(ks[23], (L, N_EXPERTS, D_EXPERT, D_MODEL), D_EXPERT ** -0.5 * DEEPNORM_BETA),
        "ws_gate": nrm(ks[24], (L, D_MODEL, d_sh), D_MODEL ** -0.5),
        "ws_up": nrm(ks[25], (L, D_MODEL, d_sh), D_MODEL ** -0.5),
        "ws_down": nrm(ks[26], (L, d_sh, D_MODEL), d_sh ** -0.5 * DEEPNORM_BETA),
        "ln2_g": 1.0 + nrm(ks[27], (L, D_MODEL), 0.01),
        "ln2_b": nrm(ks[28], (L, D_MODEL), 0.01),
    }


def reference(x, w_in, lam_re, lam_im, log_dt, b_re, b_im, c_re, c_im, d_skip, w_glu, b_glu,
              q_norm_g, w_uq, kv_norm_g, w_ukv, w_o, ln1_g, ln1_b, w_router, router_bias,
              we_gate, we_up, we_down, ws_gate, ws_up, ws_down, ln2_g, ln2_b):
    seq = x.shape[1]
    pos = jnp.arange(seq, dtype=jnp.float32)
    inv_freq = ROPE_THETA ** (-jnp.arange(0, QK_ROPE_DIM, 2, dtype=jnp.float32) / QK_ROPE_DIM)
    ang = pos[:, None] * inv_freq[None, :]
    cos, sin = jnp.cos(ang), jnp.sin(ang)
    h = x
    for i in range(DEPTH):
        h = _layer(h, cos, sin, w_in[i], lam_re[i], lam_im[i], log_dt[i], b_re[i], b_im[i],
                   c_re[i], c_im[i], d_skip[i], w_glu[i], b_glu[i], q_norm_g[i], w_uq[i],
                   kv_norm_g[i], w_ukv[i], w_o[i], ln1_g[i], ln1_b[i], w_router[i],
                   router_bias[i], we_gate[i], we_up[i], we_down[i], ws_gate[i], ws_up[i],
                   ws_down[i], ln2_g[i], ln2_b[i])
    return h
```

```cpp
#define MK_MODE 2
#define MK_DEBUG 0
#include <hip/hip_runtime.h>
#include <cstdio>
#include <cstdint>
#include <cmath>
#ifndef MK_MODE
#define MK_MODE 1
#endif
#ifndef MK_DBG_NPH
#define MK_DBG_NPH 99
#endif
#ifndef MK_DBG_K0
#define MK_DBG_K0 0
#endif
#ifndef MK_DBG_NK
#define MK_DBG_NK 10
#endif
#ifndef MK_DEBUG
#define MK_DEBUG 0
#endif
namespace gold {
constexpr int D_MODEL = 1024, SEQ = 2048, D_SSM = 512, D_IN = 928, NH = 8, QLR = 256, KVLR = 128, ROPE = 32;
constexpr int NEXP = 64, TOPK = 6, DEXP = 256;
constexpr float ALPHA = 1.189207115002721f, LN_EPS = 1e-5f, RMS_EPS = 1e-6f, ATT_SCALE = 0.10206207261596577f;

__global__ void __launch_bounds__(256) sgemm(const float* __restrict__ A, int lda, const float* __restrict__ B, int ldb, float* __restrict__ C, int ldc, int M, int N, int K) {
    __shared__ float As[16][65];
    __shared__ float Bs[16][65];
    const int tid = threadIdx.x, tx = tid & 15, ty = tid >> 4;
    const int m0 = blockIdx.y * 64, n0 = blockIdx.x * 64;
    float acc[4][4];
#pragma unroll
    for (int i = 0; i < 4; ++i)
#pragma unroll
        for (int j = 0; j < 4; ++j) acc[i][j] = 0.f;
    for (int k0 = 0; k0 < K; k0 += 16) {
#pragma unroll
        for (int i = 0; i < 4; ++i) { const int idx = tid + 256 * i, r = idx >> 4, c = idx & 15; As[c][r] = A[(size_t)(m0 + r) * lda + k0 + c]; }
#pragma unroll
        for (int i = 0; i < 4; ++i) { const int idx = tid + 256 * i, r = idx >> 6, c = idx & 63; Bs[r][c] = (n0 + c < N) ? B[(size_t)(k0 + r) * ldb + n0 + c] : 0.f; }
        __syncthreads();
#pragma unroll
        for (int k = 0; k < 16; ++k) {
            float a[4], b[4];
#pragma unroll
            for (int i = 0; i < 4; ++i) a[i] = As[k][ty + 16 * i];
#pragma unroll
            for (int j = 0; j < 4; ++j) b[j] = Bs[k][tx + 16 * j];
#pragma unroll
            for (int i = 0; i < 4; ++i)
#pragma unroll
                for (int j = 0; j < 4; ++j) acc[i][j] = fmaf(a[i], b[j], acc[i][j]);
        }
        __syncthreads();
    }
#pragma unroll
    for (int i = 0; i < 4; ++i)
#pragma unroll
        for (int j = 0; j < 4; ++j) { const int c = n0 + tx + 16 * j; if (c < N) C[(size_t)(m0 + ty + 16 * i) * ldc + c] = acc[i][j]; }
}

__device__ __forceinline__ float gelu_tanh(float x) {
    const float z = 0.7978845608028654f * (x + 0.044715f * x * x * x);
    const float e = __expf(2.f * z);
    const float th = 1.f - 2.f / (1.f + e);
    return 0.5f * x * (1.f + th);
}
__device__ __forceinline__ float sigmoidf_(float x) { return 1.f / (1.f + __expf(-x)); }

struct SsmPar { float ar, ai, kr, ki; };
__device__ __forceinline__ SsmPar ssm_par(const float* lam_re, const float* lam_im, const float* log_dt, int d, int g, int n) {
    const float lr = fminf(lam_re[(d * 32 + g) * 64 + n], -1e-4f), li = lam_im[(d * 32 + g) * 64 + n];
    const float dt = expf(log_dt[d * 32 + g]);
    const float x = lr * dt, th = li * dt;
    const float em1 = expm1f(x), cs = cosf(th), sn = sinf(th), sh = sinf(0.5f * th);
    const float mag = em1 + 1.f;
    SsmPar p; p.ar = mag * cs; p.ai = mag * sn;
    const float arm1 = em1 * cs - 2.f * sh * sh;
    const float den = lr * lr + li * li;
    p.kr = (arm1 * lr + p.ai * li) / den; p.ki = (p.ai * lr - arm1 * li) / den;
    return p;
}

__global__ void __launch_bounds__(64) ssm_naive(const float* __restrict__ proj, int ldp, const float* __restrict__ lam_re, const float* __restrict__ lam_im, const float* __restrict__ log_dt,
                                                const float* __restrict__ b_re, const float* __restrict__ b_im, const float* __restrict__ c_re, const float* __restrict__ c_im,
                                                const float* __restrict__ d_skip, float* __restrict__ spre) {
    const int g = blockIdx.x, b = blockIdx.y, n = threadIdx.x;
    for (int d = 0; d < 2; ++d) {
        const SsmPar P = ssm_par(lam_re, lam_im, log_dt, d, g, n);
        float Br[16], Bi[16], Cr[16], Ci[16];
#pragma unroll
        for (int q = 0; q < 16; ++q) { const float br = b_re[((d * 32 + g) * 64 + n) * 16 + q], bi = b_im[((d * 32 + g) * 64 + n) * 16 + q];
            Br[q] = P.kr * br - P.ki * bi; Bi[q] = P.kr * bi + P.ki * br;
            Cr[q] = c_re[((d * 32 + g) * 16 + q) * 64 + n]; Ci[q] = c_im[((d * 32 + g) * 16 + q) * 64 + n]; }
        float hr = 0.f, hi = 0.f;
        for (int step = 0; step < SEQ; ++step) {
            const int t = d ? (SEQ - 1 - step) : step;
            const float* up = proj + (size_t)(b * SEQ + t) * ldp + g * 16;
            float u[16];
#pragma unroll
            for (int q = 0; q < 16; ++q) u[q] = up[q];
            float bur = 0.f, bui = 0.f;
#pragma unroll
            for (int q = 0; q < 16; ++q) { bur = fmaf(Br[q], u[q], bur); bui = fmaf(Bi[q], u[q], bui); }
            const float nr = P.ar * hr - P.ai * hi + bur, ni = P.ar * hi + P.ai * hr + bui;
            hr = nr; hi = ni;
            float y[16];
#pragma unroll
            for (int p = 0; p < 16; ++p) y[p] = Cr[p] * hr - Ci[p] * hi;
#pragma unroll
            for (int o = 1; o < 64; o <<= 1)
#pragma unroll
                for (int p = 0; p < 16; ++p) y[p] += __shfl_xor(y[p], o);
            if (n < 16) {
                float v = 0.f;
#pragma unroll
                for (int p = 0; p < 16; ++p) if (p == n) v = y[p];
                float* o = spre + (size_t)(b * SEQ + t) * 512 + g * 16 + n;
                if (d == 0) *o = v;
                else { float uu = 0.f;
#pragma unroll
                    for (int p = 0; p < 16; ++p) if (p == n) uu = u[p];
                    *o = gelu_tanh(*o + v + uu * d_skip[g * 16 + n]); }
            }
        }
    }
}
__global__ void glu_ew(const float* __restrict__ spre, const float* __restrict__ gl, const float* __restrict__ bglu, float* __restrict__ mix, int ntok) {
    const size_t i = (size_t)blockIdx.x * 256 + threadIdx.x; if (i >= (size_t)ntok * 512) return;
    const int c = (int)(i & 511); const size_t r = i >> 9;
    mix[r * 1024 + c] = spre[i] * sigmoidf_(gl[i] + bglu[c]);
}
__global__ void rmsnorm_rows(const float* __restrict__ in, int ld, int off, int n, const float* __restrict__ g, float* __restrict__ out, int ntok) {
    const int r = blockIdx.x * 256 + threadIdx.x; if (r >= ntok) return;
    const float* p = in + (size_t)r * ld + off; float s = 0.f;
    for (int j = 0; j < n; ++j) s = fmaf(p[j], p[j], s);
    const float rs = rsqrtf(s / n + RMS_EPS);
    for (int j = 0; j < n; ++j) out[(size_t)r * n + j] = p[j] * rs * g[j];
}
__device__ __forceinline__ void rope_cs(int pos, int i, float& c, float& s) {
    const float inv = expf(-9.210340371976184f * (float)i * (1.f / 16.f));
    const float a = (float)pos * inv; c = cosf(a); s = sinf(a);
}
__global__ void rope_ew(float* __restrict__ q, const float* __restrict__ proj, int ldp, float* __restrict__ krope, int ntok) {
    const int idx = blockIdx.x * 256 + threadIdx.x; if (idx >= ntok * 9 * 16) return;
    const int i = idx & 15, hh = (idx >> 4) % 9, r = idx / 144, pos = r % SEQ;
    float c, s; rope_cs(pos, i, c, s);
    if (hh < 8) { float* p = q + (size_t)r * 768 + hh * 96 + 64; const float t1 = p[i], t2 = p[i + 16]; p[i] = t1 * c - t2 * s; p[i + 16] = t1 * s + t2 * c; }
    else { const float* p = proj + (size_t)r * ldp + 896; const float t1 = p[i], t2 = p[i + 16]; krope[(size_t)r * 32 + i] = t1 * c - t2 * s; krope[(size_t)r * 32 + i + 16] = t1 * s + t2 * c; }
}
__global__ void __launch_bounds__(64) attn_naive(const float* __restrict__ q, const float* __restrict__ kv, const float* __restrict__ krope, float* __restrict__ mix) {
    const int qi = blockIdx.x * 64 + threadIdx.x, h = blockIdx.y, b = blockIdx.z;
    const size_t r = (size_t)b * SEQ + qi;
    float qv[96], o[64];
#pragma unroll
    for (int d = 0; d < 96; ++d) qv[d] = q[r * 768 + h * 96 + d] * ATT_SCALE;
#pragma unroll
    for (int d = 0; d < 64; ++d) o[d] = 0.f;
    float m = -1e30f, l = 0.f;
    for (int s = 0; s < SEQ; ++s) {
        const size_t kr = (size_t)b * SEQ + s;
        const float4* kn = (const float4*)(kv + kr * 1024 + h * 128);
        const float4* kp = (const float4*)(krope + kr * 32);
        float sc = 0.f;
#pragma unroll
        for (int d = 0; d < 16; ++d) { const float4 k4 = kn[d]; sc = fmaf(qv[4 * d], k4.x, sc); sc = fmaf(qv[4 * d + 1], k4.y, sc); sc = fmaf(qv[4 * d + 2], k4.z, sc); sc = fmaf(qv[4 * d + 3], k4.w, sc); }
#pragma unroll
        for (int d = 0; d < 8; ++d) { const float4 k4 = kp[d]; sc = fmaf(qv[64 + 4 * d], k4.x, sc); sc = fmaf(qv[64 + 4 * d + 1], k4.y, sc); sc = fmaf(qv[64 + 4 * d + 2], k4.z, sc); sc = fmaf(qv[64 + 4 * d + 3], k4.w, sc); }
        const float mn = fmaxf(m, sc), al = __expf(m - mn), p = __expf(sc - mn);
        l = l * al + p; m = mn;
        const float4* vp = (const float4*)(kv + kr * 1024 + h * 128 + 64);
#pragma unroll
        for (int d = 0; d < 16; ++d) { const float4 v4 = vp[d]; o[4 * d] = fmaf(o[4 * d], al, p * v4.x); o[4 * d + 1] = fmaf(o[4 * d + 1], al, p * v4.y); o[4 * d + 2] = fmaf(o[4 * d + 2], al, p * v4.z); o[4 * d + 3] = fmaf(o[4 * d + 3], al, p * v4.w); }
    }
    const float il = 1.f / l;
#pragma unroll
    for (int d = 0; d < 64; ++d) mix[r * 1024 + 512 + h * 64 + d] = o[d] * il;
}
__device__ __forceinline__ float wsum(float v) {
#pragma unroll
    for (int o = 1; o < 64; o <<= 1) v += __shfl_xor(v, o);
    return v;
}
__global__ void __launch_bounds__(256) ln1_rows(const float* __restrict__ x, const float* __restrict__ mixo, const float* __restrict__ g, const float* __restrict__ bb, float* __restrict__ x1, int ntok) {
    const int r = blockIdx.x * 4 + (threadIdx.x >> 6), lane = threadIdx.x & 63; if (r >= ntok) return;
    float v[16]; float s = 0.f;
#pragma unroll
    for (int j = 0; j < 16; ++j) { const int c = lane + 64 * j; v[j] = ALPHA * x[(size_t)r * 1024 + c] + mixo[(size_t)r * 1024 + c]; s += v[j]; }
    const float mean = wsum(s) * (1.f / 1024.f); float q = 0.f;
#pragma unroll
    for (int j = 0; j < 16; ++j) { v[j] -= mean; q = fmaf(v[j], v[j], q); }
    const float rstd = rsqrtf(wsum(q) * (1.f / 1024.f) + LN_EPS);
#pragma unroll
    for (int j = 0; j < 16; ++j) { const int c = lane + 64 * j; x1[(size_t)r * 1024 + c] = v[j] * rstd * g[c] + bb[c]; }
}
}

__device__ __forceinline__ void route_token(const float (&lg)[64], const float* __restrict__ rbias, int (&idx)[6], float (&w)[6]) {
    float sc[64], ch[64];
#pragma unroll
    for (int j = 0; j < 64; ++j) { sc[j] = 1.f / (1.f + __expf(-lg[j])); ch[j] = sc[j] + rbias[j]; }
    float gs[8];
#pragma unroll
    for (int g = 0; g < 8; ++g) { float m1 = -INFINITY, m2 = -INFINITY;
#pragma unroll
        for (int j = 0; j < 8; ++j) { const float v = ch[g * 8 + j]; if (v > m1) { m2 = m1; m1 = v; } else if (v > m2) m2 = v; }
        gs[g] = m1 + m2; }
    bool sel[8];
#pragma unroll
    for (int g = 0; g < 8; ++g) { int rank = 0;
#pragma unroll
        for (int o = 0; o < 8; ++o) { if (o != g && (gs[o] > gs[g] || (gs[o] == gs[g] && o < g))) ++rank; }
        sel[g] = rank < 4; }
#pragma unroll
    for (int j = 0; j < 64; ++j) if (!sel[j >> 3]) ch[j] = -INFINITY;
    float wsum_ = 0.f;
#pragma unroll
    for (int k = 0; k < 6; ++k) { float best = -INFINITY; int bi = 0;
#pragma unroll
        for (int j = 0; j < 64; ++j) if (ch[j] > best) { best = ch[j]; bi = j; }
        float sv = 0.f;
#pragma unroll
        for (int j = 0; j < 64; ++j) if (j == bi) { sv = sc[j]; ch[j] = -INFINITY; }
        idx[k] = bi; w[k] = sv; wsum_ += sv; }
    const float inv = 2.5f / (wsum_ + 1e-20f);
#pragma unroll
    for (int k = 0; k < 6; ++k) w[k] *= inv;
}

namespace gold {
__global__ void __launch_bounds__(64) route_rows(const float* __restrict__ logits, const float* __restrict__ rbias, int* __restrict__ topi, float* __restrict__ topw, int ntok) {
    const int r = blockIdx.x * 64 + threadIdx.x; if (r >= ntok) return;
    float lg[64];
#pragma unroll
    for (int j = 0; j < 16; ++j) { const float4 v = ((const float4*)(logits + (size_t)r * 64))[j]; lg[4 * j] = v.x; lg[4 * j + 1] = v.y; lg[4 * j + 2] = v.z; lg[4 * j + 3] = v.w; }
    int idx[6]; float w[6]; route_token(lg, rbias, idx, w);
#pragma unroll
    for (int k = 0; k < 6; ++k) { topi[(size_t)r * 6 + k] = idx[k]; topw[(size_t)r * 6 + k] = w[k]; }
}
__global__ void __launch_bounds__(256) moe_naive(const float* x1, const int* __restrict__ topi, const float* __restrict__ topw,
                                                  const float* __restrict__ weg, const float* __restrict__ weu, const float* __restrict__ wed,
                                                  const float* __restrict__ wsg, const float* __restrict__ wsu, const float* __restrict__ wsd,
                                                  const float* __restrict__ g2, const float* __restrict__ b2, float* out) {
    __shared__ float xs[1024]; __shared__ float hs[256]; __shared__ float red[8];
    const int r = blockIdx.x, tid = threadIdx.x;
#pragma unroll
    for (int j = 0; j < 4; ++j) xs[tid + 256 * j] = x1[(size_t)r * 1024 + tid + 256 * j];
    __syncthreads();
    float acc[4] = {0.f, 0.f, 0.f, 0.f};
    for (int ei = 0; ei < 7; ++ei) {
        const int e = ei < 6 ? topi[(size_t)r * 6 + ei] : 0; const float w = ei < 6 ? topw[(size_t)r * 6 + ei] : 1.f;
        const float* Wg = ei < 6 ? weg + (size_t)e * 1024 * 256 : wsg; const float* Wu = ei < 6 ? weu + (size_t)e * 1024 * 256 : wsu; const float* Wd = ei < 6 ? wed + (size_t)e * 256 * 1024 : wsd;
        float gg = 0.f, uu = 0.f;
        for (int k = 0; k < 1024; ++k) { const float xv = xs[k]; gg = fmaf(xv, Wg[(size_t)k * 256 + tid], gg); uu = fmaf(xv, Wu[(size_t)k * 256 + tid], uu); }
        hs[tid] = gg / (1.f + __expf(-gg)) * uu;
        __syncthreads();
        float y[4] = {0.f, 0.f, 0.f, 0.f};
        for (int i = 0; i < 256; ++i) { const float hv = hs[i];
#pragma unroll
            for (int j = 0; j < 4; ++j) y[j] = fmaf(hv, Wd[(size_t)i * 1024 + tid + 256 * j], y[j]); }
#pragma unroll
        for (int j = 0; j < 4; ++j) acc[j] = fmaf(w, y[j], acc[j]);
        __syncthreads();
    }
    float v[4]; float s = 0.f;
#pragma unroll
    for (int j = 0; j < 4; ++j) { v[j] = ALPHA * xs[tid + 256 * j] + acc[j]; s += v[j]; }
    s = wsum(s); if ((tid & 63) == 0) red[tid >> 6] = s; __syncthreads();
    const float mean = (red[0] + red[1] + red[2] + red[3]) * (1.f / 1024.f); float q = 0.f;
#pragma unroll
    for (int j = 0; j < 4; ++j) { v[j] -= mean; q = fmaf(v[j], v[j], q); }
    q = wsum(q); if ((tid & 63) == 0) red[4 + (tid >> 6)] = q; __syncthreads();
    const float rstd = rsqrtf((red[4] + red[5] + red[6] + red[7]) * (1.f / 1024.f) + LN_EPS);
#pragma unroll
    for (int j = 0; j < 4; ++j) { const int c = tid + 256 * j; out[(size_t)r * 1024 + c] = v[j] * rstd * g2[c] + b2[c]; }
}

struct In {
    const float *x, *w_in, *lam_re, *lam_im, *log_dt, *b_re, *b_im, *c_re, *c_im, *d_skip, *w_glu, *b_glu, *q_norm_g, *w_uq, *kv_norm_g, *w_ukv, *w_o, *ln1_g, *ln1_b,
                *w_router, *router_bias, *we_gate, *we_up, *we_down, *ws_gate, *ws_up, *ws_down, *ln2_g, *ln2_b;
};
constexpr size_t GOLD_FLOATS_PER_TOK = 6400;
struct Bufs { float *proj, *spre, *gl, *mix, *cqn, *ckvn, *q, *kv, *krope, *mixo, *logits; int* topi; float* topw; };
static Bufs run(const In& I, int tok0, int ntok, float* scratch, float* x1out, float* out, hipStream_t st) {
    Bufs B;
    B.proj = scratch; B.spre = B.proj + (size_t)ntok * 928; B.gl = B.spre + (size_t)ntok * 512; B.mix = B.gl + (size_t)ntok * 512;
    B.cqn = B.mix + (size_t)ntok * 1024; B.ckvn = B.cqn + (size_t)ntok * 256; B.q = B.ckvn + (size_t)ntok * 128; B.kv = B.q + (size_t)ntok * 768;
    B.krope = B.kv + (size_t)ntok * 1024; B.mixo = B.krope + (size_t)ntok * 32; B.logits = B.mixo + (size_t)ntok * 1024;
    B.topi = (int*)(B.logits + (size_t)ntok * 64); B.topw = (float*)(B.topi + (size_t)ntok * 6);
    float *proj = B.proj, *spre = B.spre, *gl = B.gl, *mix = B.mix, *cqn = B.cqn, *ckvn = B.ckvn, *q = B.q, *kv = B.kv, *krope = B.krope, *mixo = B.mixo, *logits = B.logits; int* topi = B.topi; float* topw = B.topw;
    const float* x = I.x + (size_t)tok0 * 1024; const int nb = ntok / SEQ;
    hipLaunchKernelGGL(sgemm, dim3((928 + 63) / 64, ntok / 64), dim3(256), 0, st, x, 1024, I.w_in, 928, proj, 928, ntok, 928, 1024);
    hipLaunchKernelGGL(ssm_naive, dim3(32, nb), dim3(64), 0, st, proj, 928, I.lam_re, I.lam_im, I.log_dt, I.b_re, I.b_im, I.c_re, I.c_im, I.d_skip, spre);
    hipLaunchKernelGGL(sgemm, dim3(8, ntok / 64), dim3(256), 0, st, spre, 512, I.w_glu, 512, gl, 512, ntok, 512, 512);
    hipLaunchKernelGGL(glu_ew, dim3((unsigned)(((size_t)ntok * 512 + 255) / 256)), dim3(256), 0, st, spre, gl, I.b_glu, mix, ntok);
    hipLaunchKernelGGL(rmsnorm_rows, dim3((ntok + 255) / 256), dim3(256), 0, st, proj, 928, 512, 256, I.q_norm_g, cqn, ntok);
    hipLaunchKernelGGL(rmsnorm_rows, dim3((ntok + 255) / 256), dim3(256), 0, st, proj, 928, 768, 128, I.kv_norm_g, ckvn, ntok);
    hipLaunchKernelGGL(sgemm, dim3(12, ntok / 64), dim3(256), 0, st, cqn, 256, I.w_uq, 768, q, 768, ntok, 768, 256);
    hipLaunchKernelGGL(sgemm, dim3(16, ntok / 64), dim3(256), 0, st, ckvn, 128, I.w_ukv, 1024, kv, 1024, ntok, 1024, 128);
    hipLaunchKernelGGL(rope_ew, dim3((ntok * 144 + 255) / 256), dim3(256), 0, st, q, proj, 928, krope, ntok);
    hipLaunchKernelGGL(attn_naive, dim3(SEQ / 64, 8, nb), dim3(64), 0, st, q, kv, krope, mix);
    hipLaunchKernelGGL(sgemm, dim3(16, ntok / 64), dim3(256), 0, st, mix, 1024, I.w_o, 1024, mixo, 1024, ntok, 1024, 1024);
    hipLaunchKernelGGL(ln1_rows, dim3(ntok / 4), dim3(256), 0, st, x, mixo, I.ln1_g, I.ln1_b, x1out, ntok);
    hipLaunchKernelGGL(sgemm, dim3(1, ntok / 64), dim3(256), 0, st, x1out, 1024, I.w_router, 64, logits, 64, ntok, 64, 1024);
    hipLaunchKernelGGL(route_rows, dim3(ntok / 64), dim3(64), 0, st, logits, I.router_bias, topi, topw, ntok);
    hipLaunchKernelGGL(moe_naive, dim3(ntok), dim3(256), 0, st, x1out, topi, topw, I.we_gate, I.we_up, I.we_down, I.ws_gate, I.ws_up, I.ws_down, I.ln2_g, I.ln2_b, out);
    return B;
}
}
#define GAS __attribute__((address_space(1)))
#define LAS __attribute__((address_space(3)))
typedef unsigned short bf16_t;
typedef short bf16x8 __attribute__((ext_vector_type(8)));
typedef short s16x4 __attribute__((ext_vector_type(4)));
typedef float f32x4 __attribute__((ext_vector_type(4)));
typedef float f32x2 __attribute__((ext_vector_type(2)));
typedef float f32x16 __attribute__((ext_vector_type(16)));
typedef unsigned u32x4 __attribute__((ext_vector_type(4)));
typedef unsigned u32x2 __attribute__((ext_vector_type(2)));

namespace fx {
constexpr int T = 65536, SEQ = 2048, DM = 1024, NB = 32;
constexpr int CHK = 32;
constexpr int NCHK = SEQ / CHK;
constexpr int UHR = NB * NCHK;
constexpr int UHK = CHK * 16 + 256;
constexpr int NCH = 4;
constexpr int CAPC = T / NCH;
constexpr int NVE = NCH * 65;
constexpr float ALPHA = 1.189207115002721f, LN_EPS = 1e-5f, RMS_EPS = 1e-6f;
constexpr float QSCALE = 0.10206207261596577f * 1.4426950408889634f;

constexpr size_t MiB = 1u << 20;
constexpr size_t WS_CTL = 0, CTL_BYTES = 1 * MiB;
constexpr size_t WS_ROPE = 1 * MiB;
constexpr size_t WS_KT = 2 * MiB;
constexpr size_t WS_WIN = 4 * MiB, WS_WGLU = 6 * MiB, WS_WUQ = 6 * MiB + 512 * 1024, WS_WUKV = 7 * MiB, WS_WR = 7 * MiB + 512 * 1024, WS_WO = 8 * MiB;
constexpr size_t WS_WST = 10 * MiB, WS_MO = 18 * MiB, WS_WGU = 42 * MiB, WS_WD = 107 * MiB;
constexpr size_t WS_SSQQ = 140 * MiB, WS_SSQKV = 141 * MiB, WS_TSLOT = 142 * MiB, WS_TOPW = 144 * MiB, WS_ROWTOK = 146 * MiB, WS_LOGIT = 162 * MiB;
constexpr size_t WS_XB = 178 * MiB, WS_UH = 306 * MiB, WS_CQ = 402 * MiB, WS_CKVR = 434 * MiB, WS_S = 466 * MiB, WS_Q = 530 * MiB, WS_KV = 626 * MiB, WS_SPRE = 754 * MiB, WS_MIX = 818 * MiB;
constexpr size_t WS_X1B = 178 * MiB, WS_H = 306 * MiB, WS_Y = 562 * MiB;
constexpr size_t WS_GOLD = 946 * MiB, WS_END = 1024 * MiB;
constexpr int CW_TMO = 0, CW_CODE = 1, CW_BAR = 4096, CW_CNT = 16384  , CW_DBG = 65536  ;

constexpr int RING_BYTES = 131072, TAB_OFF = RING_BYTES, TAB_BYTES = 12288, MISC_OFF = TAB_OFF + TAB_BYTES, LDS_BYTES = 147456;

__device__ __forceinline__ unsigned cvt_pk_bf16(float lo, float hi) { unsigned r; asm volatile("v_cvt_pk_bf16_f32 %0, %1, %2" : "=v"(r) : "v"(lo), "v"(hi)); return r; }
__device__ __forceinline__ float bf_lo(unsigned w) { return __uint_as_float(w << 16); }
__device__ __forceinline__ float bf_hi(unsigned w) { return __uint_as_float(w & 0xffff0000u); }
__device__ __forceinline__ u32x4 pack8(const f32x4 a, const f32x4 b) { u32x4 w; w.x = cvt_pk_bf16(a[0], a[1]); w.y = cvt_pk_bf16(a[2], a[3]); w.z = cvt_pk_bf16(b[0], b[1]); w.w = cvt_pk_bf16(b[2], b[3]); return w; }
__device__ __forceinline__ void unpack8(const u32x4 w, f32x4& a, f32x4& b) { a = (f32x4){bf_lo(w.x), bf_hi(w.x), bf_lo(w.y), bf_hi(w.y)}; b = (f32x4){bf_lo(w.z), bf_hi(w.z), bf_lo(w.w), bf_hi(w.w)}; }
__device__ __forceinline__ float fast_sigmoid(float x) { return __builtin_amdgcn_rcpf(1.f + __builtin_amdgcn_exp2f(-1.4426950408889634f * x)); }
__device__ __forceinline__ float gelu_tanh_f(float x) {
    const float z2 = 1.5957691216057308f * (x + 0.044715f * x * x * x);
    return x * fast_sigmoid(z2);
}
__device__ __forceinline__ float wave_sum(float v) {
#pragma unroll
    for (int o = 1; o < 64; o <<= 1) v += __shfl_xor(v, o);
    return v;
}

#define XB_TMO      128
#define XB_XCNT(j)  (256  + 64 * (j))
#define XB_XSUB(j)  (1280 + 64 * (j))
#define XB_XGEN(j)  (2304 + 64 * (j))
#define XB_TOP      3328
#define XB_TOPGEN   3392
#define XCD_BAR_WORDS 3456
#define XB_SPIN_CAP (1u << 18)
__device__ __forceinline__ unsigned xb_ld(unsigned* p)              { return __hip_atomic_load(p, __ATOMIC_RELAXED, __HIP_MEMORY_SCOPE_AGENT); }
__device__ __forceinline__ unsigned xb_add(unsigned* p, unsigned v) { return __hip_atomic_fetch_add(p, v, __ATOMIC_RELAXED, __HIP_MEMORY_SCOPE_AGENT); }
__device__ __forceinline__ unsigned xb_xcc_id() { return (unsigned)__builtin_amdgcn_s_getreg((3 << 11) | 20) & 0xFu; }
#define XB_SPIN(cond, bar) do { unsigned _sp = 0; while (cond) { __builtin_amdgcn_s_sleep(1); \
    if ((++_sp & 255u) == 0u) { if (xb_ld(&(bar)[XB_TMO])) break; if (_sp > XB_SPIN_CAP) { atomicAdd(&(bar)[XB_TMO], 1u); break; } } } } while (0)
struct XcdBarrier { unsigned* bar; unsigned x; volatile LAS unsigned* st; };
__device__ __forceinline__ XcdBarrier xcd_barrier_post(unsigned* bar, volatile LAS unsigned* st) {
    XcdBarrier b; b.bar = bar; b.x = xb_xcc_id(); b.st = st;
    if (threadIdx.x == 0) (void)xb_add(&bar[XB_XCNT(b.x)], 1u);
    return b;
}
__device__ __forceinline__ void xcd_barrier_complete(unsigned* bar, unsigned x, unsigned& nloc, unsigned& nx) {
    const unsigned G = gridDim.x * gridDim.y * gridDim.z;
    unsigned sum, cnt, mine, sp = 0u;
    for (;;) {
        sum = 0u; cnt = 0u; mine = 0u;
#pragma unroll
        for (unsigned j = 0; j < 16; ++j) { const unsigned c = xb_ld(&bar[XB_XCNT(j)]); sum += c; cnt += (c > 0u) ? 1u : 0u; mine = (j == x) ? c : mine; }
        if (sum == G) break;
        __builtin_amdgcn_s_sleep(1);
        if ((++sp & 255u) == 0u) { if (xb_ld(&bar[XB_TMO])) break; if (sp > XB_SPIN_CAP) { atomicAdd(&bar[XB_TMO], 1u); break; } }
    }
    nloc = mine > 0u ? mine : 1u; nx = cnt > 0u ? cnt : 1u;
}
__device__ __forceinline__ void xcd_barrier(const XcdBarrier& b) {
    asm volatile("s_waitcnt vmcnt(0)" ::: "memory");
    __syncthreads();
    if (threadIdx.x == 0) {
        unsigned* bar = b.bar;
        __builtin_amdgcn_s_waitcnt(0);
        unsigned nloc = b.st[0], nx = b.st[1];
        if (nloc == 0u) { xcd_barrier_complete(bar, b.x, nloc, nx); b.st[0] = nloc; b.st[1] = nx; }
        const unsigned old = xb_add(&bar[XB_XSUB(b.x)], 1u);
        const unsigned gen = old / nloc;
        if (old + 1u == (gen + 1u) * nloc) {
            __builtin_amdgcn_fence(__ATOMIC_RELEASE, "agent");
            asm volatile("s_waitcnt vmcnt(0)" ::: "memory");
            const unsigned og = xb_add(&bar[XB_TOP], 1u);
            const unsigned tg = og / nx;
            if (og + 1u == (tg + 1u) * nx) xb_add(&bar[XB_TOPGEN], 1u);
            else XB_SPIN(xb_ld(&bar[XB_TOPGEN]) == tg, bar);
            __builtin_amdgcn_fence(__ATOMIC_ACQUIRE, "agent");
            xb_add(&bar[XB_XGEN(b.x)], 1u);
            asm volatile("s_waitcnt vmcnt(0)" ::: "memory");
        } else {
            XB_SPIN(xb_ld(&bar[XB_XGEN(b.x)]) == gen, bar);
            __builtin_amdgcn_fence(__ATOMIC_ACQUIRE, "agent");
            asm volatile("s_waitcnt vmcnt(0)" ::: "memory");
        }
    }
    __syncthreads();
}

constexpr int BM = 256, BK = 64, HALF = 128, HTB = HALF * BK * 2, STAGE_BYTES = 8 * HTB;
__host__ __device__ __forceinline__ int lds_byte(int r, int c) { const int st = (r >> 4) * 2 + (c >> 5), rr = r & 15, cc = c & 31, ob = rr * 64 + cc * 2; return st * 1024 + (ob ^ (((ob >> 9) & 1) << 5)); }
__host__ __device__ __forceinline__ void stage_rc(int b, int& R, int& C) { const int st = b / 1024, sb = b % 1024, swz = sb ^ (((sb >> 9) & 1) << 5); R = (st >> 1) * 16 + swz / 64; C = (st & 1) * 32 + (swz % 64) / 2; }
__host__ __device__ __forceinline__ int perm32(int rho) { const int n = rho >> 4, i = rho & 15; return 8 * (i >> 2) + 4 * n + (i & 3); }

struct Unit { const char* A; const char* B; int i0, i1, i2, i3; };
__device__ __forceinline__ int xcd_remap(int L, int nwg) { const int q = nwg / 8, r = nwg % 8, xcd = L % 8, off = L / 8; return (xcd < r ? xcd * (q + 1) : r * (q + 1) + (xcd - r) * q) + off; }

template <class Epi, class Sched, bool ALIGN_EPI, bool GATHER>
__device__ __forceinline__ void gemm_phase(LAS unsigned char* lds, const int lda, const int ldb, const int K, const Sched& S, const Epi& E) {
    const int tid = threadIdx.x, wid = __builtin_amdgcn_readfirstlane(tid >> 6), lane = tid & 63, wr = wid >> 2, wc = wid & 3, fr = lane & 15, fq = lane >> 4;
    const int nt = K / BK;
    unsigned voffA[2], voffB[2]; int RA[2], CA[2];
#pragma unroll
    for (int i = 0; i < 2; ++i) { int R, C; stage_rc(tid * 16 + i * 8192, R, C); const int Rb = Epi::PERM ? ((R & ~31) + perm32(R & 31)) : R;
        RA[i] = R; CA[i] = C; voffA[i] = (unsigned)(R * lda + C) * 2u; voffB[i] = (unsigned)(Rb * ldb + C) * 2u; }
    const size_t kstep = (size_t)(BK * 2);
    const size_t hstepA = (size_t)HALF * lda * 2, hstepB = (size_t)HALF * ldb * 2;
    const unsigned ldsw = (unsigned)wid * 1024u;
    const int aoff = lds_byte(wr * 64 + fr, fq * 8), boff = lds_byte(wc * 32 + fr, fq * 8);
#define PG8_SA(b, h) (((b) * 2 + (h)) * HTB)
#define PG8_SB(b, h) ((4 + (b) * 2 + (h)) * HTB)
#define PG8_STAGE(bufoff, gbase, voff) do { _Pragma("unroll") for (int _i = 0; _i < 2; ++_i) \
        __builtin_amdgcn_global_load_lds((const unsigned*)((const char*)(gbase) + (voff)[_i]), (LAS unsigned*)(lds + (bufoff) + ldsw + _i * 8192), 16, 0, 0); } while (0)
#define PG8_STAGE_A(bufoff, base, g0, g1, h, kb) do { if constexpr (GATHER) { \
        __builtin_amdgcn_global_load_lds((const unsigned*)((base) + (kb) + (g0)), (LAS unsigned*)(lds + (bufoff) + ldsw), 16, 0, 0); \
        __builtin_amdgcn_global_load_lds((const unsigned*)((base) + (kb) + (g1)), (LAS unsigned*)(lds + (bufoff) + ldsw + 8192), 16, 0, 0); } \
      else { PG8_STAGE(bufoff, (base) + (h) * hstepA + (kb), voffA); } } while (0)
#define PG8_LDA(dst, b, h) do { _Pragma("unroll") for (int m = 0; m < 4; ++m) _Pragma("unroll") for (int k = 0; k < 2; ++k) dst[m][k] = *(const LAS bf16x8*)(lds + PG8_SA(b, h) + aoff + m * 2048 + k * 1024); } while (0)
#define PG8_LDB(dst, b, h) do { _Pragma("unroll") for (int n = 0; n < 2; ++n) _Pragma("unroll") for (int k = 0; k < 2; ++k) dst[n][k] = *(const LAS bf16x8*)(lds + PG8_SB(b, h) + boff + n * 2048 + k * 1024); } while (0)
#define PG8_MMA(ai, bj, At, Bt) do { __builtin_amdgcn_s_setprio(1); _Pragma("unroll") for (int m = 0; m < 4; ++m) _Pragma("unroll") for (int n = 0; n < 2; ++n) _Pragma("unroll") for (int k = 0; k < 2; ++k) \
        acc[ai][bj][m][n] = __builtin_amdgcn_mfma_f32_16x16x32_bf16(Bt[n][k], At[m][k], acc[ai][bj][m][n], 0, 0, 0); __builtin_amdgcn_s_setprio(0); } while (0)
#define PG8_WAIT_V(n) asm volatile("s_waitcnt vmcnt(" #n ")" ::: "memory")
#define PG8_WAIT_L(n) asm volatile("s_waitcnt lgkmcnt(" #n ")" ::: "memory")
#define PG8_BAR __builtin_amdgcn_s_barrier()
#define PG8_SCHED __builtin_amdgcn_sched_barrier(0)
    Unit cur, nxt; int ui = 0;
    if (!S.next(0, cur)) return;
    unsigned gc00 = 0, gc01 = 0, gc10 = 0, gc11 = 0, gn00 = 0, gn01 = 0, gn10 = 0, gn11 = 0;
    if constexpr (GATHER) { S.gather(cur, RA[0], CA[0], RA[1], CA[1], gc00, gc01, gc10, gc11); gn00 = gc00; gn01 = gc01; gn10 = gc10; gn11 = gc11; }
    f32x4 acc[2][2][4][2];
#pragma unroll
    for (int a = 0; a < 2; ++a)
#pragma unroll
        for (int b = 0; b < 2; ++b)
#pragma unroll
            for (int m = 0; m < 4; ++m)
#pragma unroll
                for (int n = 0; n < 2; ++n) acc[a][b][m][n] = (f32x4){0.f, 0.f, 0.f, 0.f};
    bf16x8 At[4][2], B0[2][2], B1[2][2];
    const char* cA = cur.A; const char* cB = cur.B;
    PG8_STAGE(PG8_SB(0, 0), cB, voffB); PG8_STAGE(PG8_SB(0, 1), cB + hstepB, voffB); PG8_STAGE_A(PG8_SA(0, 0), cA, gc00, gc01, 0, 0); PG8_STAGE_A(PG8_SA(0, 1), cA, gc10, gc11, 1, 0);
    if (wr == 1) PG8_BAR;
    PG8_WAIT_V(2); PG8_BAR;
    PG8_STAGE(PG8_SB(1, 0), cB + kstep, voffB); PG8_STAGE_A(PG8_SA(1, 0), cA, gc00, gc01, 0, kstep); PG8_STAGE(PG8_SB(1, 1), cB + hstepB + kstep, voffB);
    PG8_WAIT_V(6); PG8_BAR;
    for (;;) {
        const bool has_next = S.next(ui + 1, nxt);
        if constexpr (GATHER) { if (has_next) S.gather(nxt, RA[0], CA[0], RA[1], CA[1], gn00, gn01, gn10, gn11); }
        const char* nA = has_next ? nxt.A : cA; const char* nB = has_next ? nxt.B : cB;
#pragma unroll 1
        for (int t = 0; t < nt; t += 2) {
            const bool last = (t == nt - 2);
            const size_t k1 = (size_t)(t + 1) * kstep;
            const char* a2 = last ? nA : cA; const char* b2 = last ? nB : cB + (size_t)(t + 2) * kstep;
            const size_t k2 = last ? 0 : (size_t)(t + 2) * kstep, k3 = k2 + kstep;
            const char* b3 = b2 + kstep;
            unsigned g200 = gc00, g201 = gc01, g210 = gc10, g211 = gc11;
            if constexpr (GATHER) { if (last) { g200 = gn00; g201 = gn01; g210 = gn10; g211 = gn11; } }
            PG8_LDB(B0, 0, 0); PG8_LDB(B1, 0, 1); PG8_SCHED; PG8_LDA(At, 0, 0); PG8_STAGE_A(PG8_SA(1, 1), cA, gc10, gc11, 1, k1);
            PG8_WAIT_V(8); PG8_WAIT_L(0); PG8_BAR; PG8_MMA(0, 0, At, B0); PG8_MMA(0, 1, At, B1); PG8_BAR; PG8_SCHED;
            PG8_LDA(At, 0, 1); PG8_STAGE(PG8_SB(0, 0), b2, voffB); PG8_STAGE(PG8_SB(0, 1), b2 + hstepB, voffB); PG8_STAGE_A(PG8_SA(0, 0), a2, g200, g201, 0, k2);
            PG8_WAIT_V(8); PG8_WAIT_L(0); PG8_BAR; PG8_MMA(1, 0, At, B0); PG8_MMA(1, 1, At, B1); PG8_BAR; PG8_SCHED;
            PG8_LDB(B0, 1, 0); PG8_LDB(B1, 1, 1); PG8_SCHED; PG8_LDA(At, 1, 0); PG8_STAGE_A(PG8_SA(0, 1), a2, g210, g211, 1, k2);
            PG8_WAIT_V(8); PG8_WAIT_L(0); PG8_BAR; PG8_MMA(0, 0, At, B0); PG8_MMA(0, 1, At, B1); PG8_BAR; PG8_SCHED;
            PG8_LDA(At, 1, 1); PG8_STAGE(PG8_SB(1, 0), b3, voffB); PG8_STAGE(PG8_SB(1, 1), b3 + hstepB, voffB); PG8_STAGE_A(PG8_SA(1, 0), a2, g200, g201, 0, k3);
            PG8_WAIT_V(8); PG8_WAIT_L(0); PG8_BAR; PG8_MMA(1, 0, At, B0); PG8_MMA(1, 1, At, B1); PG8_BAR; PG8_SCHED;
        }
        if constexpr (ALIGN_EPI) { if (wr == 0) PG8_BAR; }
        E(acc, cur, wr, wc, fr, fq);
        if (!has_next) break;
#pragma unroll
        for (int a = 0; a < 2; ++a)
#pragma unroll
            for (int b = 0; b < 2; ++b)
#pragma unroll
                for (int m = 0; m < 4; ++m)
#pragma unroll
                    for (int n = 0; n < 2; ++n) acc[a][b][m][n] = (f32x4){0.f, 0.f, 0.f, 0.f};
        cur = nxt; cA = nA; cB = nB; ++ui;
        if constexpr (GATHER) { gc00 = gn00; gc01 = gn01; gc10 = gn10; gc11 = gn11; }
        if constexpr (ALIGN_EPI) { if (wr == 1) PG8_BAR; }
    }
    PG8_WAIT_V(0);
    if constexpr (!ALIGN_EPI) { if (wr == 0) PG8_BAR; }
    PG8_BAR;
#undef PG8_SA
#undef PG8_SB
#undef PG8_STAGE
#undef PG8_STAGE_A
#undef PG8_LDA
#undef PG8_LDB
#undef PG8_MMA
#undef PG8_WAIT_V
#undef PG8_WAIT_L
#undef PG8_BAR
#undef PG8_SCHED
}
}
namespace fx {
#define FX_ROWLOOP _Pragma("unroll") for (int ai = 0; ai < 2; ++ai) _Pragma("unroll") for (int m = 0; m < 4; ++m)

struct PlainOrder {
    const char* A; const char* B; int lda, ldb, nM, nN, nwg, G, c;
    __device__ void init(const void* A_, int lda_, const void* B_, int ldb_, int M, int N, int G_, int c_) { A = (const char*)A_; B = (const char*)B_; lda = lda_; ldb = ldb_; nM = M / 256; nN = N / 256; nwg = nM * nN; G = G_; c = c_; }
    __device__ __forceinline__ bool next(int i, Unit& u) const {
        const long L = (long)i * G + c; if (L >= nwg) return false;
        const int wgid = xcd_remap((int)L, nwg);
        const int nig = 8 * nN, gid = wgid / nig, fm = gid * 8, gsz = (nM - fm) < 8 ? (nM - fm) : 8;
        const int pm = fm + ((wgid % nig) % gsz), pn = (wgid % nig) / gsz;
        u.A = A + (size_t)pm * 256 * lda * 2; u.B = B + (size_t)pn * 256 * ldb * 2; u.i0 = pm; u.i1 = pn; u.i2 = 0; u.i3 = 0; return true;
    }
};
struct GroupOrder {
    const char* A; const char* B; int ldb, nN, nwg, G, c;
    __device__ void init(const void* A_, const void* B_, int ldb_, int nN_, int G_, int c_) { A = (const char*)A_; B = (const char*)B_; ldb = ldb_; nN = nN_; nwg = 32 * 8 * nN_; G = G_; c = c_; }
    __device__ __forceinline__ bool next(int i, Unit& u) const {
        const long L = (long)i * G + c; if (L >= nwg) return false;
        const int wgid = xcd_remap((int)L, nwg);
        const int per = 8 * nN, g = wgid / per, rem = wgid % per, pm = rem % 8, pn = rem / 8;
        u.A = A + ((size_t)g * UHR + (size_t)pm * 256) * UHK * 2; u.B = B + ((size_t)g * nN * 256 + (size_t)pn * 256) * ldb * 2; u.i0 = g; u.i1 = pm; u.i2 = pn; u.i3 = 0; return true;
    }
};

__device__ __forceinline__ void rope8(f32x4& v0, f32x4& v1, const float* __restrict__ ropec, const float* __restrict__ ropes, int pos, int fq) {
    const f32x4 c = *(const f32x4*)(ropec + pos * 16 + 4 * fq), s = *(const f32x4*)(ropes + pos * 16 + 4 * fq);
    const f32x4 a = v0, b = v1;
    v0 = (f32x4){a[0] * c[0] - a[1] * s[0], a[0] * s[0] + a[1] * c[0], a[2] * c[1] - a[3] * s[1], a[2] * s[1] + a[3] * c[1]};
    v1 = (f32x4){b[0] * c[2] - b[1] * s[2], b[0] * s[2] + b[1] * c[2], b[2] * c[3] - b[3] * s[3], b[2] * s[3] + b[3] * c[3]};
}
__device__ __forceinline__ float sumsq8(const f32x4 a, const f32x4 b) { return (a[0] * a[0] + a[1] * a[1]) + (a[2] * a[2] + a[3] * a[3]) + (b[0] * b[0] + b[1] * b[1]) + (b[2] * b[2] + b[3] * b[3]); }

struct EpiWin {
    static constexpr bool PERM = true;
    bf16_t* UH; bf16_t* CQ; bf16_t* CKVR; float* ssqq; float* ssqkv; const float* ropec; const float* ropes;
    __device__ __forceinline__ void operator()(const f32x4 (&acc)[2][2][4][2], const Unit& u, int wr, int wc, int fr, int fq) const {
        const int pm = u.i0, pn = u.i1, row0 = pm * 256 + wr * 64 + fr;
        if (pn < 2) {
            FX_ROWLOOP { const int row = row0 + ai * 128 + m * 16, r32 = row >> 5, tq = row & 31;
#pragma unroll
                for (int bj = 0; bj < 2; ++bj) { const int c = pn * 256 + bj * 128 + wc * 32 + 8 * fq, g = c >> 4, p0 = c & 15;
                    *(u32x4*)(UH + ((size_t)(g * UHR + r32) * UHK + tq * 16 + p0)) = pack8(acc[ai][bj][m][0], acc[ai][bj][m][1]); } }
        } else if (pn == 2) {
            FX_ROWLOOP { const int row = row0 + ai * 128 + m * 16; float ss = 0.f;
#pragma unroll
                for (int bj = 0; bj < 2; ++bj) { const int c = bj * 128 + wc * 32 + 8 * fq;
                    *(u32x4*)(CQ + (size_t)row * 256 + c) = pack8(acc[ai][bj][m][0], acc[ai][bj][m][1]); ss += sumsq8(acc[ai][bj][m][0], acc[ai][bj][m][1]); }
                ss += __shfl_xor(ss, 16); ss += __shfl_xor(ss, 32);
                if (fq == 0) ssqq[(size_t)row * 4 + wc] = ss; }
        } else {
            FX_ROWLOOP { const int row = row0 + ai * 128 + m * 16;
                { const int c = wc * 32 + 8 * fq;
                  *(u32x4*)(CKVR + (size_t)row * 256 + c) = pack8(acc[ai][0][m][0], acc[ai][0][m][1]);
                  float ss = sumsq8(acc[ai][0][m][0], acc[ai][0][m][1]); ss += __shfl_xor(ss, 16); ss += __shfl_xor(ss, 32);
                  if (fq == 0) ssqkv[(size_t)row * 4 + wc] = ss; }
                { const int c = 128 + wc * 32 + 8 * fq; f32x4 v0 = acc[ai][1][m][0], v1 = acc[ai][1][m][1];
                  if (wc == 0) rope8(v0, v1, ropec, ropes, row & (SEQ - 1), fq);
                  *(u32x4*)(CKVR + (size_t)row * 256 + c) = pack8(v0, v1); } __builtin_amdgcn_sched_barrier(0); }
        }
    }
};
struct EpiQ {
    static constexpr bool PERM = true;
    bf16_t* Q; const float* ssqq; const float* ropec; const float* ropes;
    __device__ __forceinline__ void operator()(const f32x4 (&acc)[2][2][4][2], const Unit& u, int wr, int wc, int fr, int fq) const {
        const int pm = u.i0, pn = u.i1, row0 = pm * 256 + wr * 64 + fr;
        FX_ROWLOOP { const int row = row0 + ai * 128 + m * 16; const f32x4 s4 = *(const f32x4*)(ssqq + (size_t)row * 4);
            const float rs = __builtin_amdgcn_rsqf(((s4[0] + s4[1]) + (s4[2] + s4[3])) * (1.f / 256.f) + RMS_EPS) * QSCALE;
#pragma unroll
            for (int bj = 0; bj < 2; ++bj) { const int G = 8 * pn + 4 * bj + wc, c = 256 * pn + 128 * bj + 32 * wc + 8 * fq;
                f32x4 v0 = acc[ai][bj][m][0] * rs, v1 = acc[ai][bj][m][1] * rs;
                if (G % 3 == 2) rope8(v0, v1, ropec, ropes, row & (SEQ - 1), fq);
                *(u32x4*)(Q + (size_t)row * 768 + c) = pack8(v0, v1); } __builtin_amdgcn_sched_barrier(0); }
    }
};
struct EpiKV {
    static constexpr bool PERM = true;
    bf16_t* KV; const float* ssqkv;
    __device__ __forceinline__ void operator()(const f32x4 (&acc)[2][2][4][2], const Unit& u, int wr, int wc, int fr, int fq) const {
        const int pm = u.i0, pn = u.i1, row0 = pm * 256 + wr * 64 + fr;
        FX_ROWLOOP { const int row = row0 + ai * 128 + m * 16; const f32x4 s4 = *(const f32x4*)(ssqkv + (size_t)row * 4);
            const float rs = __builtin_amdgcn_rsqf(((s4[0] + s4[1]) + (s4[2] + s4[3])) * (1.f / 128.f) + RMS_EPS);
#pragma unroll
            for (int bj = 0; bj < 2; ++bj) { const int c = 256 * pn + 128 * bj + 32 * wc + 8 * fq;
                *(u32x4*)(KV + (size_t)row * 1024 + c) = pack8(acc[ai][bj][m][0] * rs, acc[ai][bj][m][1] * rs); } }
    }
};
struct EpiSt {
    static constexpr bool PERM = false;
    float* S;
    __device__ __forceinline__ void operator()(const f32x4 (&acc)[2][2][4][2], const Unit& u, int wr, int wc, int fr, int fq) const {
        const int g = u.i0, pm = u.i1, row0 = pm * 256 + wr * 64 + fr;
        FX_ROWLOOP { const int R = row0 + ai * 128 + m * 16; float* rp = S + ((size_t)g * UHR + R) * 256 + wc * 32 + 4 * fq;
#pragma unroll
            for (int bj = 0; bj < 2; ++bj)
#pragma unroll
                for (int n = 0; n < 2; ++n) *(f32x4*)(rp + bj * 128 + n * 16) = acc[ai][bj][m][n]; }
    }
};
struct EpiSsmOut {
    static constexpr bool PERM = true;
    const bf16_t* UH; bf16_t* SPRE; const float* dskip;
    __device__ __forceinline__ void operator()(const f32x4 (&acc)[2][2][4][2], const Unit& u, int wr, int wc, int fr, int fq) const {
        const int g = u.i0, pm = u.i1, pn = u.i2, row0 = pm * 256 + wr * 64 + fr;
        const int p0 = 8 * (fq & 1);
        const f32x4 d0 = *(const f32x4*)(dskip + g * 16 + p0), d1 = *(const f32x4*)(dskip + g * 16 + p0 + 4);
        FX_ROWLOOP { const int R = row0 + ai * 128 + m * 16;
#pragma unroll
            for (int bj = 0; bj < 2; ++bj) { const int c = 256 * pn + 128 * bj + 32 * wc + 8 * fq, tq = c >> 4;
                const u32x4 uw = *(const u32x4*)(UH + ((size_t)g * UHR + R) * UHK + c); f32x4 u0, u1; unpack8(uw, u0, u1);
                f32x4 y0 = acc[ai][bj][m][0] + u0 * d0, y1 = acc[ai][bj][m][1] + u1 * d1;
#pragma unroll
                for (int j = 0; j < 4; ++j) { y0[j] = gelu_tanh_f(y0[j]); y1[j] = gelu_tanh_f(y1[j]); }
                *(u32x4*)(SPRE + ((size_t)R * 32 + tq) * 512 + g * 16 + p0) = pack8(y0, y1); } __builtin_amdgcn_sched_barrier(0); }
    }
};
struct EpiGlu {
    static constexpr bool PERM = true;
    const bf16_t* SPRE; bf16_t* MIX; const float* bglu;
    __device__ __forceinline__ void operator()(const f32x4 (&acc)[2][2][4][2], const Unit& u, int wr, int wc, int fr, int fq) const {
        const int pm = u.i0, pn = u.i1, row0 = pm * 256 + wr * 64 + fr;
#pragma unroll
        for (int bj = 0; bj < 2; ++bj) { const int c = 256 * pn + 128 * bj + 32 * wc + 8 * fq;
            const f32x4 b0 = *(const f32x4*)(bglu + c), b1 = *(const f32x4*)(bglu + c + 4);
            FX_ROWLOOP { const int row = row0 + ai * 128 + m * 16;
                const u32x4 sw = *(const u32x4*)(SPRE + (size_t)row * 512 + c); f32x4 s0, s1; unpack8(sw, s0, s1);
                f32x4 z0 = acc[ai][bj][m][0] + b0, z1 = acc[ai][bj][m][1] + b1;
#pragma unroll
                for (int j = 0; j < 4; ++j) { z0[j] = s0[j] * fast_sigmoid(z0[j]); z1[j] = s1[j] * fast_sigmoid(z1[j]); }
                *(u32x4*)(MIX + (size_t)row * 1024 + c) = pack8(z0, z1); __builtin_amdgcn_sched_barrier(0); } }
    }
};
struct EpiWo {
    static constexpr bool PERM = false;
    const float* X; float* Y;
    __device__ __forceinline__ void operator()(const f32x4 (&acc)[2][2][4][2], const Unit& u, int wr, int wc, int fr, int fq) const {
        const int pm = u.i0, pn = u.i1, row0 = pm * 256 + wr * 64 + fr;
        FX_ROWLOOP { const size_t off = (size_t)(row0 + ai * 128 + m * 16) * 1024 + 256 * pn + wc * 32 + 4 * fq;
#pragma unroll
            for (int bj = 0; bj < 2; ++bj)
#pragma unroll
                for (int n = 0; n < 2; ++n) { const f32x4 xv = *(const f32x4*)(X + off + bj * 128 + n * 16); *(f32x4*)(Y + off + bj * 128 + n * 16) = xv * ALPHA + acc[ai][bj][m][n]; } }
    }
};
struct EpiRouter {
    static constexpr bool PERM = false;
    float* LG;
    __device__ __forceinline__ void operator()(const f32x4 (&acc)[2][2][4][2], const Unit& u, int wr, int wc, int fr, int fq) const {
        if (wc >= 2) return;
        const int pm = u.i0, row0 = pm * 256 + wr * 64 + fr;
        FX_ROWLOOP { float* rp = LG + (size_t)(row0 + ai * 128 + m * 16) * 64 + wc * 32 + 4 * fq;
#pragma unroll
            for (int n = 0; n < 2; ++n) *(f32x4*)(rp + n * 16) = acc[ai][0][m][n]; }
    }
};

struct MoeTab { LAS int* tbase; LAS unsigned* tab; };
__device__ __forceinline__ MoeTab moe_tab(LAS unsigned char* lds) { MoeTab t; t.tbase = (LAS int*)(lds + TAB_OFF); t.tab = (LAS unsigned*)(lds + TAB_OFF + 2304); return t; }
__device__ __forceinline__ int ve_count(const unsigned* ctl, int ve) { return (ve % 65 == 64) ? CAPC : (int)__hip_atomic_load(ctl + CW_CNT + 64 * ve, __ATOMIC_RELAXED, __HIP_MEMORY_SCOPE_AGENT); }
__device__ __forceinline__ void moe_build_tab(LAS unsigned char* lds, const unsigned* ctl) {
    const MoeTab t = moe_tab(lds); LAS int* nt = (LAS int*)(lds + TAB_OFF + 1024 + 64);
    const int tid = threadIdx.x;
    if (tid < NVE) nt[tid] = (ve_count(ctl, tid) + 255) >> 8;
    __syncthreads();
    if (tid == 0) { int s = 0; for (int v = 0; v < NVE; ++v) { t.tbase[v] = s; s += nt[v]; } t.tbase[NVE] = s; }
    __syncthreads();
    for (int v = tid; v < NVE; v += 512) { const int b = t.tbase[v], n = t.tbase[v + 1] - b; for (int j = 0; j < n; ++j) t.tab[b + j] = (unsigned)v | ((unsigned)j << 16); }
    __syncthreads();
}
struct GateUpOrder {
    const char* X1B; const char* WGU; const int* rowtok; const unsigned* ctl; MoeTab tb; int nunits, G, c;
    __device__ void init(const void* x1b, const void* wgu, const int* rt, const unsigned* ctl_, MoeTab tb_, int G_, int c_) { X1B = (const char*)x1b; WGU = (const char*)wgu; rowtok = rt; ctl = ctl_; tb = tb_; nunits = 2 * tb_.tbase[NVE]; G = G_; c = c_; }
    __device__ __forceinline__ bool next(int i, Unit& u) const {
        const long L = (long)i * G + c; if (L >= nunits) return false;
        const int wgid = xcd_remap((int)L, nunits), tile = wgid >> 1, pn = wgid & 1;
        const unsigned e = tb.tab[tile]; const int ve = (int)(e & 0xffffu), tix = (int)(e >> 16), ex = ve % 65;
        u.A = X1B; u.B = WGU + ((size_t)ex * 512 + (size_t)pn * 256) * 1024 * 2; u.i0 = tile * 256; u.i1 = pn; u.i2 = ve; u.i3 = tix; return true;
    }
    __device__ __forceinline__ unsigned tok_of(int ve, int cnt, int slot) const {
        const int ch = ve / 65, ex = ve % 65;
        if (ex == 64) return (unsigned)(ch * CAPC + slot);
        return slot < cnt ? (unsigned)rowtok[(size_t)(ch * 64 + ex) * CAPC + slot] : (unsigned)(ch * CAPC);
    }
    __device__ __forceinline__ void gather(const Unit& u, int R0, int C0, int R1, int C1, unsigned& g00, unsigned& g01, unsigned& g10, unsigned& g11) const {
        const int ve = u.i2, cnt = ve_count(ctl, ve), s0 = u.i3 * 256;
        g00 = tok_of(ve, cnt, s0 + R0) * 2048u + (unsigned)C0 * 2u; g01 = tok_of(ve, cnt, s0 + R1) * 2048u + (unsigned)C1 * 2u;
        g10 = tok_of(ve, cnt, s0 + 128 + R0) * 2048u + (unsigned)C0 * 2u; g11 = tok_of(ve, cnt, s0 + 128 + R1) * 2048u + (unsigned)C1 * 2u;
    }
};
struct EpiGateUp {
    static constexpr bool PERM = true;
    bf16_t* H;
    __device__ __forceinline__ void operator()(const f32x4 (&acc)[2][2][4][2], const Unit& u, int wr, int wc, int fr, int fq) const {
        const int hrow0 = u.i0 + wr * 64 + fr, c = 128 * u.i1 + 32 * wc + 8 * fq;
        FX_ROWLOOP { f32x4 h0, h1;
#pragma unroll
            for (int j = 0; j < 4; ++j) { const float g0 = acc[ai][0][m][0][j], g1 = acc[ai][0][m][1][j];
                h0[j] = g0 * fast_sigmoid(g0) * acc[ai][1][m][0][j]; h1[j] = g1 * fast_sigmoid(g1) * acc[ai][1][m][1][j]; }
            *(u32x4*)(H + (size_t)(hrow0 + ai * 128 + m * 16) * 256 + c) = pack8(h0, h1); }
    }
};
struct DownOrder {
    const char* Hh; const char* WD; MoeTab tb; int t0, nunits, G, c;
    __device__ void init(const void* h, const void* wd, MoeTab tb_, int ch, int G_, int c_) { Hh = (const char*)h; WD = (const char*)wd; tb = tb_; t0 = tb_.tbase[ch * 65]; nunits = 4 * (tb_.tbase[(ch + 1) * 65] - t0); G = G_; c = c_; }
    __device__ __forceinline__ bool next(int i, Unit& u) const {
        const long L = (long)i * G + c; if (L >= nunits) return false;
        const int wgid = xcd_remap((int)L, nunits), tile = t0 + (wgid >> 2), pn = wgid & 3;
        const int ex = (int)(tb.tab[tile] & 0xffffu) % 65;
        u.A = Hh + (size_t)tile * 256 * 256 * 2; u.B = WD + ((size_t)ex * 1024 + (size_t)pn * 256) * 256 * 2; u.i0 = (tile - t0) * 256; u.i1 = pn; u.i2 = 0; u.i3 = 0; return true;
    }
};
struct EpiDown {
    static constexpr bool PERM = true;
    bf16_t* Y;
    __device__ __forceinline__ void operator()(const f32x4 (&acc)[2][2][4][2], const Unit& u, int wr, int wc, int fr, int fq) const {
        const int yrow0 = u.i0 + wr * 64 + fr;
        FX_ROWLOOP { bf16_t* rp = Y + (size_t)(yrow0 + ai * 128 + m * 16) * 1024 + 256 * u.i1 + 32 * wc + 8 * fq;
#pragma unroll
            for (int bj = 0; bj < 2; ++bj) *(u32x4*)(rp + bj * 128) = pack8(acc[ai][bj][m][0], acc[ai][bj][m][1]); }
    }
};
}
namespace fx {
namespace att {
constexpr int NW = 8, QBLK = 32, KVBLK = 64;
constexpr int SHM_V = 16384, SHM_K = 16384, SHM_ATTN = 2 * SHM_V + 2 * SHM_K + NW * 64 * 4;
constexpr float THRL = 8.f;
#define KSWZ(row, colB) ((row) * 256 + ((colB) ^ (((row) & 7) << 4)))
#define SBAR() __builtin_amdgcn_sched_barrier(0)
__device__ __forceinline__ int crow(int r, int hi) { return (r & 3) + 8 * (r >> 2) + 4 * hi; }
__device__ __forceinline__ void partialSM(f32x16& p0, f32x16& p1, float& m_reg, float& mn, float& alpha) {
  float pmax = p0[0];
#pragma unroll
  for (int r = 1; r < 16; ++r) pmax = fmaxf(pmax, p0[r]);
#pragma unroll
  for (int r = 0; r < 16; ++r) pmax = fmaxf(pmax, p1[r]);
  { auto rr = __builtin_amdgcn_permlane32_swap(__float_as_uint(pmax), __float_as_uint(pmax), false, false);
    pmax = fmaxf(__uint_as_float(rr[0]), __uint_as_float(rr[1])); }
  if (__builtin_expect(__all(pmax - m_reg <= THRL), 1)) { mn = m_reg; alpha = 1.f; }
  else { mn = fmaxf(m_reg, pmax); alpha = __builtin_amdgcn_exp2f(m_reg - mn); m_reg = mn; }
#pragma unroll
  for (int r = 0; r < 16; ++r) p0[r] = p0[r] - mn;
#pragma unroll
  for (int r = 0; r < 16; ++r) p1[r] = p1[r] - mn;
#pragma unroll
  for (int r = 0; r < 16; ++r) p0[r] = __builtin_amdgcn_exp2f(p0[r]);
}
__device__ __forceinline__ void finishSM(f32x16& p0, f32x16& p1, float alpha, float& l_reg, bf16x8& pa0, bf16x8& pa1, bf16x8& pa2, bf16x8& pa3) {
#pragma unroll
  for (int r = 0; r < 16; ++r) p1[r] = __builtin_amdgcn_exp2f(p1[r]);
  float ps = 0;
#pragma unroll
  for (int r = 0; r < 16; ++r) ps += p0[r];
#pragma unroll
  for (int r = 0; r < 16; ++r) ps += p1[r];
  { auto rr = __builtin_amdgcn_permlane32_swap(__float_as_uint(ps), __float_as_uint(ps), false, false);
    ps = __uint_as_float(rr[0]) + __uint_as_float(rr[1]); }
  l_reg = l_reg * alpha + ps;
#define PK4(P, BASE, OUT) do { unsigned a0 = cvt_pk_bf16(P[BASE + 0], P[BASE + 1]), a1 = cvt_pk_bf16(P[BASE + 2], P[BASE + 3]);   \
    unsigned b0 = cvt_pk_bf16(P[BASE + 4], P[BASE + 5]), b1 = cvt_pk_bf16(P[BASE + 6], P[BASE + 7]);                              \
    auto r0 = __builtin_amdgcn_permlane32_swap(a0, b0, false, false); auto r1 = __builtin_amdgcn_permlane32_swap(a1, b1, false, false); \
    u32x4 w = {r0[0], r1[0], r0[1], r1[1]}; OUT = *reinterpret_cast<bf16x8*>(&w); } while (0)
  PK4(p0, 0, pa0); PK4(p0, 8, pa1); PK4(p1, 0, pa2); PK4(p1, 8, pa3);
#undef PK4
}
__device__ __forceinline__ void qkt(f32x16& p0, f32x16& p1, const char* Ks, const bf16x8 (&qr)[6], int r32, int hi) {
  p0 = f32x16{}; p1 = f32x16{};
#pragma unroll
  for (int d0 = 0; d0 < 6; ++d0) { const int cb = (d0 * 16 + hi * 8) * 2;
    const bf16x8 b0 = *reinterpret_cast<const bf16x8*>(Ks + KSWZ(r32, cb));
    const bf16x8 b1 = *reinterpret_cast<const bf16x8*>(Ks + KSWZ(32 + r32, cb));
    p0 = __builtin_amdgcn_mfma_f32_32x32x16_bf16(b0, qr[d0], p0, 0, 0, 0);
    p1 = __builtin_amdgcn_mfma_f32_32x32x16_bf16(b1, qr[d0], p1, 0, 0, 0); }
}
__device__ __forceinline__ int v_st(int k, int c) { const int kk = (k & ~0xC) | ((k & 4) << 1) | ((k & 8) >> 1); return ((kk >> 3) * 4 + (c >> 5)) * 512 + ((kk & 7) * 32 + (c & 31)) * 2; }
__device__ __forceinline__ int v_rd_base(int lane) { return ((lane & 3) << 3) | (((lane >> 2) & 3) << 6) | (((lane >> 4) & 1) << 5) | (((lane >> 5) & 1) << 8); }
constexpr int v_rd_off(int d0, int ks, int half) { return d0 * 512 + ks * 4096 + half * 2048; }
template <int OFF> __device__ __forceinline__ s16x4 tr_read(int vb) {
  s16x4 r; asm volatile("ds_read_b64_tr_b16 %0, %1 offset:%2" : "=&v"(r) : "v"(vb), "i"(OFF) : "memory"); return r;
}
template <int D0> __device__ __forceinline__ void pv_one(f32x16& od, int vb, bf16x8 pa0, bf16x8 pa1, bf16x8 pa2, bf16x8 pa3) {
  const s16x4 l0 = tr_read<v_rd_off(D0, 0, 0)>(vb), h0 = tr_read<v_rd_off(D0, 0, 1)>(vb), l1 = tr_read<v_rd_off(D0, 1, 0)>(vb), h1 = tr_read<v_rd_off(D0, 1, 1)>(vb);
  const s16x4 l2 = tr_read<v_rd_off(D0, 2, 0)>(vb), h2 = tr_read<v_rd_off(D0, 2, 1)>(vb), l3 = tr_read<v_rd_off(D0, 3, 0)>(vb), h3 = tr_read<v_rd_off(D0, 3, 1)>(vb);
  asm volatile("s_waitcnt lgkmcnt(0)" ::: "memory"); SBAR();
#define PK(L, H) (bf16x8){L[0], L[1], L[2], L[3], H[0], H[1], H[2], H[3]}
  od = __builtin_amdgcn_mfma_f32_32x32x16_bf16(pa0, PK(l0, h0), od, 0, 0, 0);
  od = __builtin_amdgcn_mfma_f32_32x32x16_bf16(pa1, PK(l1, h1), od, 0, 0, 0);
  od = __builtin_amdgcn_mfma_f32_32x32x16_bf16(pa2, PK(l2, h2), od, 0, 0, 0);
  od = __builtin_amdgcn_mfma_f32_32x32x16_bf16(pa3, PK(l3, h3), od, 0, 0, 0);
#undef PK
}
__device__ __forceinline__ void pv_d0(f32x16 (&o)[2], int vb, bf16x8 pa0, bf16x8 pa1, bf16x8 pa2, bf16x8 pa3) {
  pv_one<0>(o[0], vb, pa0, pa1, pa2, pa3); pv_one<1>(o[1], vb, pa0, pa1, pa2, pa3);
}
__device__ __forceinline__ void attn_unit(const unsigned char* __restrict__ wsb, const bf16_t* __restrict__ Q, bf16_t* __restrict__ MIX, int tok0, int qrow0, int h, char* lds) {
  const int tid = threadIdx.x, wid = tid >> 6, lane = tid & 63, r32 = lane & 31, hi = lane >> 5;
  char* V_lds = lds; char* K_lds = lds + 2 * SHM_V;
  float* ws = (float*)(lds + 2 * SHM_V + 2 * SHM_K) + wid * 64; float* li_l = ws; float* al_l = ws + 32;
  float m_reg = -1e30f, l_reg = 0; f32x16 o[2] = {}; bf16x8 qr[6];
  const bf16_t* Qw = Q + (size_t)(tok0 + qrow0 + wid * QBLK + r32) * 768 + h * 96 + hi * 8;
#pragma unroll
  for (int d0 = 0; d0 < 6; ++d0) qr[d0] = *reinterpret_cast<const bf16x8*>(Qw + d0 * 16);
  const int sr = tid >> 4, c16 = tid & 15, sc = c16 * 8, vst0 = v_st(sr, sc), vst1 = v_st(32 + sr, sc);
  const int vb0 = (int)(uintptr_t)V_lds + v_rd_base(lane);
  const unsigned vofs = (unsigned)WS_KV + (unsigned)(((tok0 + sr) * 1024 + h * 128 + 64 + (c16 & 7) * 8) * 2);
  const unsigned kinc = c16 < 8 ? 64u * 2048u : 64u * 512u;
  const unsigned kofs = (c16 < 8 ? (unsigned)WS_KV + (unsigned)((tok0 * 1024 + h * 128 + c16 * 8) * 2) : (unsigned)WS_CKVR + (unsigned)((tok0 * 256 + 128 + (c16 - 8) * 8) * 2)) + (unsigned)sr * (kinc >> 6);
  struct { bf16x8 vs0, vs1, ks0, ks1; } sr_[2];
#define SLOAD(i, k0) do { const unsigned vo_ = vofs + (unsigned)(k0) * 2048u, ko_ = kofs + (unsigned)((k0) >> 6) * kinc; \
    sr_[i].vs0 = *reinterpret_cast<const bf16x8*>(wsb + vo_); sr_[i].vs1 = *reinterpret_cast<const bf16x8*>(wsb + vo_ + 32u * 2048u); \
    sr_[i].ks0 = *reinterpret_cast<const bf16x8*>(wsb + ko_); sr_[i].ks1 = *reinterpret_cast<const bf16x8*>(wsb + ko_ + (kinc >> 1)); } while (0)
#define SWRITE(b, i) do { *(bf16x8*)(V_lds + (b) * SHM_V + vst0) = sr_[i].vs0;          \
    *(bf16x8*)(V_lds + (b) * SHM_V + vst1) = sr_[i].vs1; const int kc = sc * 2;               \
    *(bf16x8*)(K_lds + (b) * SHM_K + KSWZ(sr, kc)) = sr_[i].ks0;                       \
    *(bf16x8*)(K_lds + (b) * SHM_K + KSWZ(32 + sr, kc)) = sr_[i].ks1; } while (0)
#define SWAIT() asm volatile("s_waitcnt vmcnt(4)" ::: "memory")
#define RESC(a) do { if (__any((a) < 1.f)) { if (hi == 0) al_l[r32] = (a); asm volatile("s_waitcnt lgkmcnt(0)" ::: "memory"); \
    _Pragma("unroll") for (int d = 0; d < 2; ++d) _Pragma("unroll") for (int r = 0; r < 16; ++r) o[d][r] *= al_l[crow(r, hi)]; } } while (0)
  f32x16 pA0, pA1, pB0, pB1; float mnA, mnB, alA, alB; bf16x8 pa0, pa1, pa2, pa3; constexpr int NT = SEQ / KVBLK;
  constexpr int SE = 0, SO = 1;
  SLOAD(SE, 0); asm volatile("s_waitcnt vmcnt(0)" ::: "memory"); SWRITE(0, SE); __syncthreads();
  qkt(pA0, pA1, K_lds, qr, r32, hi); partialSM(pA0, pA1, m_reg, mnA, alA);
  SLOAD(SO, KVBLK); SLOAD(SE, 2 * KVBLK);
  SWAIT(); SWRITE(1, SO); __syncthreads();
  for (int j = 1; j + 1 < NT; j += 2) {
    SBAR(); qkt(pB0, pB1, K_lds + SHM_K, qr, r32, hi);
    finishSM(pA0, pA1, alA, l_reg, pa0, pa1, pa2, pa3); SBAR();
    SLOAD(SO, (j + 2) * KVBLK); SBAR();
    pv_d0(o, vb0, pa0, pa1, pa2, pa3); partialSM(pB0, pB1, m_reg, mnB, alB);
    __syncthreads(); SWAIT(); SWRITE(0, SE);
    RESC(alB); __syncthreads();
    SBAR(); qkt(pA0, pA1, K_lds, qr, r32, hi);
    finishSM(pB0, pB1, alB, l_reg, pa0, pa1, pa2, pa3); SBAR();
    if (j + 3 < NT) SLOAD(SE, (j + 3) * KVBLK); SBAR();
    pv_d0(o, vb0 + SHM_V, pa0, pa1, pa2, pa3); partialSM(pA0, pA1, m_reg, mnA, alA);
    __syncthreads(); SWAIT(); SWRITE(1, SO);
    RESC(alA); __syncthreads();
  }
  SBAR(); qkt(pB0, pB1, K_lds + SHM_K, qr, r32, hi);
  finishSM(pA0, pA1, alA, l_reg, pa0, pa1, pa2, pa3); SBAR();
  pv_d0(o, vb0, pa0, pa1, pa2, pa3); partialSM(pB0, pB1, m_reg, mnB, alB);
  __syncthreads(); RESC(alB);
  finishSM(pB0, pB1, alB, l_reg, pa0, pa1, pa2, pa3); SBAR();
  pv_d0(o, vb0 + SHM_V, pa0, pa1, pa2, pa3);
  if (hi == 0) li_l[r32] = l_reg; asm volatile("s_waitcnt lgkmcnt(0)" ::: "memory");
  bf16_t* Ow = MIX + (size_t)(tok0 + qrow0 + wid * QBLK) * 1024 + 512 + h * 64 + r32;
#pragma unroll
  for (int r = 0; r < 16; ++r) { const int orow = crow(r, hi); const float rl = __builtin_amdgcn_rcpf(li_l[orow]);
#pragma unroll
    for (int d0 = 0; d0 < 2; ++d0) Ow[(size_t)orow * 1024 + d0 * 32] = (bf16_t)(cvt_pk_bf16(o[d0][r] * rl, 0.f) & 0xffffu); }
  __syncthreads();
#undef SLOAD
#undef SWRITE
#undef SWAIT
#undef RESC
}
#undef KSWZ
#undef SBAR
}

struct Frame {
    LAS unsigned char* lds; unsigned* ctl; unsigned char* ws; float* out; const float* in[29];
    int tid, lane, wave, G, bid;
};
enum { I_X = 0, I_WIN, I_LRE, I_LIM, I_LDT, I_BRE, I_BIM, I_CRE, I_CIM, I_DSK, I_WGLU, I_BGLU, I_QG, I_WUQ, I_KVG, I_WUKV, I_WO, I_LN1G, I_LN1B, I_WR, I_RB, I_WEG, I_WEU, I_WED, I_WSG, I_WSU, I_WSD, I_LN2G, I_LN2B };

template <class F> __device__ __forceinline__ void transpose_item(const F& f, bf16_t* Bt, int ldk, int k0, int n0, LAS float* scr, int lane) {
#pragma unroll 8
    for (int i = 0; i < 32; ++i) { const int kk = 2 * i + (lane >> 5); scr[kk * 33 + (lane & 31)] = f(k0 + kk, n0 + (lane & 31)); }
    asm volatile("s_waitcnt lgkmcnt(0)" ::: "memory");
    const int c = lane & 7;
#pragma unroll
    for (int j = 0; j < 4; ++j) { const int n = (lane >> 3) + 8 * j; const LAS float* s = scr + (8 * c) * 33 + n;
        u32x4 o; o.x = cvt_pk_bf16(s[0 * 33], s[1 * 33]); o.y = cvt_pk_bf16(s[2 * 33], s[3 * 33]); o.z = cvt_pk_bf16(s[4 * 33], s[5 * 33]); o.w = cvt_pk_bf16(s[6 * 33], s[7 * 33]);
        *(u32x4*)(Bt + (size_t)(n0 + n) * ldk + k0 + 8 * c) = o; }
    asm volatile("s_waitcnt lgkmcnt(0)" ::: "memory");
}
__device__ __forceinline__ int rope_perm_src(int p) { return (p & 1) ? 16 + (p >> 1) : (p >> 1); }
struct SsmPar { float lr, li, dt, kr, ki; };
__device__ __forceinline__ SsmPar ssm_par(const float* lam_re, const float* lam_im, const float* log_dt, int d, int g, int n) {
    SsmPar p; p.lr = fminf(lam_re[(d * 32 + g) * 64 + n], -1e-4f); p.li = lam_im[(d * 32 + g) * 64 + n]; p.dt = expf(log_dt[d * 32 + g]);
    const float x = p.lr * p.dt, th = p.li * p.dt;
    const float em1 = expm1f(x), cs = cosf(th), sn = sinf(th), sh = sinf(0.5f * th);
    const float ai = (em1 + 1.f) * sn, arm1 = em1 * cs - 2.f * sh * sh, den = p.lr * p.lr + p.li * p.li;
    p.kr = (arm1 * p.lr + ai * p.li) / den; p.ki = (ai * p.lr - arm1 * p.li) / den; return p;
}
__device__ __forceinline__ void ssm_pow(const SsmPar& p, float e, float& pr, float& pi) { const float mag = expf(p.lr * p.dt * e), th = p.li * p.dt * e; pr = mag * cosf(th); pi = mag * sinf(th); }

__device__ __forceinline__ void p0_ssm_item(Frame& F, int g, int j) {
    LAS float* Pr = (LAS float*)F.lds;
    LAS float* Pi = Pr + 2 * 64 * 33;
    LAS float* Br = Pi + 2 * 64 * 33;
    LAS float* Bi = Br + 2 * 64 * 16;
    LAS float* Cr = Bi + 2 * 64 * 16;
    LAS float* Ci = Cr + 2 * 16 * 64;
    const float* lam_re = F.in[I_LRE]; const float* lam_im = F.in[I_LIM]; const float* log_dt = F.in[I_LDT];
    __syncthreads();
    for (int idx = F.tid; idx < 2 * 64 * 33; idx += 512) { const int tau = idx % 33, n = (idx / 33) & 63, d = idx / (33 * 64);
        const SsmPar p = ssm_par(lam_re, lam_im, log_dt, d, g, n); float pr, pi; ssm_pow(p, (float)tau, pr, pi); Pr[idx] = pr; Pi[idx] = pi; }
    for (int idx = F.tid; idx < 2 * 64 * 16; idx += 512) { const int q = idx & 15, n = (idx >> 4) & 63, d = idx >> 10;
        const SsmPar p = ssm_par(lam_re, lam_im, log_dt, d, g, n);
        const float br = F.in[I_BRE][((d * 32 + g) * 64 + n) * 16 + q], bi = F.in[I_BIM][((d * 32 + g) * 64 + n) * 16 + q];
        Br[idx] = p.kr * br - p.ki * bi; Bi[idx] = p.kr * bi + p.ki * br; }
    for (int idx = F.tid; idx < 2 * 16 * 64; idx += 512) { const int n = idx & 63, pp = (idx >> 6) & 15, d = idx >> 10;
        Cr[idx] = F.in[I_CRE][((d * 32 + g) * 16 + pp) * 64 + n]; Ci[idx] = F.in[I_CIM][((d * 32 + g) * 16 + pp) * 64 + n]; }
    __syncthreads();
    float* Kt = (float*)(F.ws + WS_KT) + (size_t)g * 16384;
    for (int e = 2048 * j + F.tid; e < 2048 * j + 2048; e += 512) { const int q = e & 15, pp = (e >> 4) & 15, tau = (e >> 8) & 31, d = e >> 13; float s = 0.f;
        for (int n = 0; n < 64; ++n) { const float pr = Pr[(d * 64 + n) * 33 + tau], pi = Pi[(d * 64 + n) * 33 + tau], br = Br[(d * 64 + n) * 16 + q], bi = Bi[(d * 64 + n) * 16 + q];
            const float dr = pr * br - pi * bi, di = pr * bi + pi * br; s += Cr[(d * 16 + pp) * 64 + n] * dr - Ci[(d * 16 + pp) * 64 + n] * di; }
        Kt[e] = s; }
    bf16_t* Wst = (bf16_t*)(F.ws + WS_WST) + (size_t)g * 256 * 512;
    for (int pc = F.tid; pc < 32 * 64; pc += 512) { const int row = 32 * j + (pc >> 6), k0 = (pc & 63) * 8, s = k0 >> 4, q0 = k0 & 15;
        const int d = row >> 7, ri = (row >> 6) & 1, n = row & 63, e = d ? s : (CHK - 1 - s);
        const float pr = Pr[(d * 64 + n) * 33 + e], pi = Pi[(d * 64 + n) * 33 + e]; float v[8];
#pragma unroll
        for (int t = 0; t < 8; ++t) { const float br = Br[(d * 64 + n) * 16 + q0 + t], bi = Bi[(d * 64 + n) * 16 + q0 + t]; v[t] = ri ? (pr * bi + pi * br) : (pr * br - pi * bi); }
        u32x4 o; o.x = cvt_pk_bf16(v[0], v[1]); o.y = cvt_pk_bf16(v[2], v[3]); o.z = cvt_pk_bf16(v[4], v[5]); o.w = cvt_pk_bf16(v[6], v[7]);
        *(u32x4*)(Wst + (size_t)row * 512 + k0) = o; }
    bf16_t* Mo = (bf16_t*)(F.ws + WS_MO) + (size_t)g * 512 * UHK;
    for (int pc = F.tid; pc < 64 * 32; pc += 512) { const int row = 64 * j + (pc >> 5), kk = (pc & 31) * 8, d = kk >> 7, ri = (kk >> 6) & 1, n0 = kk & 63, tq = row >> 4, pp = row & 15;
        const int e = d ? (CHK - tq) : (tq + 1); float v[8];
#pragma unroll
        for (int t = 0; t < 8; ++t) { const int n = n0 + t; const float pr = Pr[(d * 64 + n) * 33 + e], pi = Pi[(d * 64 + n) * 33 + e], cr = Cr[(d * 16 + pp) * 64 + n], ci = Ci[(d * 16 + pp) * 64 + n];
            v[t] = ri ? -(cr * pi + ci * pr) : (cr * pr - ci * pi); }
        u32x4 o; o.x = cvt_pk_bf16(v[0], v[1]); o.y = cvt_pk_bf16(v[2], v[3]); o.z = cvt_pk_bf16(v[4], v[5]); o.w = cvt_pk_bf16(v[6], v[7]);
        *(u32x4*)(Mo + (size_t)row * UHK + 512 + kk) = o; }
}

__device__ __forceinline__ void p0_prologue(Frame& F) {
    for (int it = F.bid; it < 256; it += F.G) p0_ssm_item(F, it >> 3, it & 7);
    __syncthreads();
    { float* rc = (float*)(F.ws + WS_ROPE); float* rs = rc + 2048 * 16;
      for (int idx = F.bid * 512 + F.tid; idx < 2048 * 16; idx += F.G * 512) { const int i = idx & 15, pos = idx >> 4;
          const float inv = expf(-9.210340371976184f * (float)i * (1.f / 16.f)); const float a = (float)pos * inv; rc[idx] = cosf(a); rs[idx] = sinf(a); } }
    LAS float* scr = (LAS float*)(F.lds + F.wave * 16384);
    const int gw = F.bid * 8 + F.wave, NGW = F.G * 8;
    constexpr int I_A = 512, I_B = 128, I_C = 96, I_D = 128, I_E = 128, I_F = 512, I_G = 65 * 256, I_H = 65 * 128;
    constexpr int NITEMS = I_A + I_B + I_C + I_D + I_E + I_F + I_G + I_H;
    for (int it = gw; it < NITEMS; it += NGW) {
        int r = it;
        if (r < I_A) { const float* W = F.in[I_WIN]; const int kb = r / 32, nb = r % 32;
            transpose_item([&](int k, int n) -> float { if (n >= 928) return 0.f; const int src = n < 896 ? n : 896 + rope_perm_src(n - 896); return W[(size_t)k * 928 + src]; }, (bf16_t*)(F.ws + WS_WIN), 1024, kb * 64, nb * 32, scr, F.lane); continue; } r -= I_A;
        if (r < I_B) { const float* W = F.in[I_WGLU]; const int kb = r / 16, nb = r % 16;
            transpose_item([&](int k, int n) -> float { return W[(size_t)k * 512 + n]; }, (bf16_t*)(F.ws + WS_WGLU), 512, kb * 64, nb * 32, scr, F.lane); continue; } r -= I_B;
        if (r < I_C) { const float* W = F.in[I_WUQ]; const float* gq = F.in[I_QG]; const int kb = r / 24, nb = r % 24;
            transpose_item([&](int k, int n) -> float { const int hh = n / 96, jj = n % 96; const int src = jj < 64 ? n : hh * 96 + 64 + rope_perm_src(jj - 64); return W[(size_t)k * 768 + src] * gq[k]; }, (bf16_t*)(F.ws + WS_WUQ), 256, kb * 64, nb * 32, scr, F.lane); continue; } r -= I_C;
        if (r < I_D) { const float* W = F.in[I_WUKV]; const float* gk = F.in[I_KVG]; const int kb = r / 32, nb = r % 32;
            transpose_item([&](int k, int n) -> float { return k < 128 ? W[(size_t)k * 1024 + n] * gk[k] : 0.f; }, (bf16_t*)(F.ws + WS_WUKV), 256, kb * 64, nb * 32, scr, F.lane); continue; } r -= I_D;
        if (r < I_E) { const float* W = F.in[I_WR]; const int kb = r / 8, nb = r % 8;
            transpose_item([&](int k, int n) -> float { return n < 64 ? W[(size_t)k * 64 + n] : 0.f; }, (bf16_t*)(F.ws + WS_WR), 1024, kb * 64, nb * 32, scr, F.lane); continue; } r -= I_E;
        if (r < I_F) { const float* W = F.in[I_WO]; const int kb = r / 32, nb = r % 32;
            transpose_item([&](int k, int n) -> float { return W[(size_t)k * 1024 + n]; }, (bf16_t*)(F.ws + WS_WO), 1024, kb * 64, nb * 32, scr, F.lane); continue; } r -= I_F;
        if (r < I_G) { const int e = r / 256, rr = r % 256, kb = rr / 16, nb = rr % 16;
            const float* Wg = e < 64 ? F.in[I_WEG] + (size_t)e * 1024 * 256 : F.in[I_WSG]; const float* Wu = e < 64 ? F.in[I_WEU] + (size_t)e * 1024 * 256 : F.in[I_WSU];
            transpose_item([&](int k, int n) -> float { const int col = 128 * (n >> 8) + (n & 127); return ((n >> 7) & 1) ? Wu[(size_t)k * 256 + col] : Wg[(size_t)k * 256 + col]; }, (bf16_t*)(F.ws + WS_WGU) + (size_t)e * 512 * 1024, 1024, kb * 64, nb * 32, scr, F.lane); continue; } r -= I_G;
        { const int e = r / 128, rr = r % 128, kb = rr / 32, nb = rr % 32;
            const float* Wd = e < 64 ? F.in[I_WED] + (size_t)e * 256 * 1024 : F.in[I_WSD];
            transpose_item([&](int k, int n) -> float { return Wd[(size_t)k * 1024 + n]; }, (bf16_t*)(F.ws + WS_WD) + (size_t)e * 1024 * 256, 256, kb * 64, nb * 32, scr, F.lane); }
    }
    { const float* x = F.in[I_X]; bf16_t* xb = (bf16_t*)(F.ws + WS_XB);
      for (size_t i = (size_t)F.bid * 512 + F.tid; i < (size_t)T * DM / 8; i += (size_t)F.G * 512) {
          const f32x4 a = *(const f32x4*)(x + i * 8), b = *(const f32x4*)(x + i * 8 + 4); *(u32x4*)(xb + i * 8) = pack8(a, b); } }
}

__device__ __forceinline__ void p3_scan_fill(Frame& F) {
    const float* S = (const float*)(F.ws + WS_S); bf16_t* UH = (bf16_t*)(F.ws + WS_UH);
    for (int gid = F.bid * 512 + F.tid; gid < 32 * 32 * 2 * 64; gid += F.G * 512) {
        const int n = gid & 63, d = (gid >> 6) & 1, b = (gid >> 7) & 31, g = gid >> 12;
        const SsmPar p = ssm_par(F.in[I_LRE], F.in[I_LIM], F.in[I_LDT], d, g, n); float acr, aci; ssm_pow(p, (float)CHK, acr, aci);
        float hr = 0.f, hi = 0.f;
        const size_t rbase = (size_t)g * UHR + (size_t)b * NCHK;
#pragma unroll 8
        for (int st = 0; st < NCHK; ++st) { const int ci = d ? (NCHK - 1 - st) : st;
            const float sr = S[(rbase + ci) * 256 + d * 128 + n], si = S[(rbase + ci) * 256 + d * 128 + 64 + n];
            bf16_t* hp = UH + (rbase + ci) * UHK + 512 + d * 128 + n;
            hp[0] = (bf16_t)(cvt_pk_bf16(hr, 0.f) & 0xffffu); hp[64] = (bf16_t)(cvt_pk_bf16(hi, 0.f) & 0xffffu);
            const float nr = acr * hr - aci * hi + sr, ni = acr * hi + aci * hr + si; hr = nr; hi = ni; }
    }
    const float* Kt = (const float*)(F.ws + WS_KT); bf16_t* Mo = (bf16_t*)(F.ws + WS_MO);
    for (int pc = F.bid * 512 + F.tid; pc < 32 * 512 * 64; pc += F.G * 512) {
        const int k0 = (pc & 63) * 8, row = (pc >> 6) & 511, g = pc >> 15, s = k0 >> 4, q0 = k0 & 15, tq = row >> 4, pp = row & 15;
        f32x4 v0 = {0.f, 0.f, 0.f, 0.f}, v1 = {0.f, 0.f, 0.f, 0.f};
        if (tq >= s) { const float* kp = Kt + ((size_t)(g * 2 + 0) * 32 + (tq - s)) * 256 + pp * 16 + q0; v0 += *(const f32x4*)kp; v1 += *(const f32x4*)(kp + 4); }
        if (s >= tq) { const float* kp = Kt + ((size_t)(g * 2 + 1) * 32 + (s - tq)) * 256 + pp * 16 + q0; v0 += *(const f32x4*)kp; v1 += *(const f32x4*)(kp + 4); }
        *(u32x4*)(Mo + ((size_t)g * 512 + row) * UHK + k0) = pack8(v0, v1);
    }
}

__device__ __forceinline__ void p7_ln1(Frame& F) {
    const float* g1 = F.in[I_LN1G]; const float* b1 = F.in[I_LN1B]; bf16_t* x1b = (bf16_t*)(F.ws + WS_X1B);
    for (int row = F.bid * 8 + F.wave; row < T; row += F.G * 8) {
        f32x4* xr = (f32x4*)(F.out + (size_t)row * 1024) + F.lane; f32x4 v[4]; float s = 0.f;
#pragma unroll
        for (int j = 0; j < 4; ++j) { v[j] = xr[64 * j]; s += (v[j][0] + v[j][1]) + (v[j][2] + v[j][3]); }
        const float mean = wave_sum(s) * (1.f / 1024.f); float q = 0.f;
#pragma unroll
        for (int j = 0; j < 4; ++j) { v[j] = v[j] - mean; q += (v[j][0] * v[j][0] + v[j][1] * v[j][1]) + (v[j][2] * v[j][2] + v[j][3] * v[j][3]); }
        const float rstd = __builtin_amdgcn_rsqf(wave_sum(q) * (1.f / 1024.f) + LN_EPS);
#pragma unroll
        for (int j = 0; j < 4; ++j) { const int c = 4 * F.lane + 256 * j; const f32x4 gg = *(const f32x4*)(g1 + c), bb = *(const f32x4*)(b1 + c);
            const f32x4 o = v[j] * rstd * gg + bb; xr[64 * j] = o;
            u32x2 w; w.x = cvt_pk_bf16(o[0], o[1]); w.y = cvt_pk_bf16(o[2], o[3]); *(u32x2*)(x1b + (size_t)row * 1024 + c) = w; }
    }
}

__device__ __forceinline__ void p9_route(Frame& F) {
    LAS int* hist = (LAS int*)(F.lds); LAS int* base = hist + 64;
    const float* LG = (const float*)(F.ws + WS_LOGIT); int* rowtok = (int*)(F.ws + WS_ROWTOK); int* tslot = (int*)(F.ws + WS_TSLOT); float* topw = (float*)(F.ws + WS_TOPW);
    for (int bt = F.bid; bt < T / 256; bt += F.G) {
        __syncthreads();
        if (F.tid < 64) hist[F.tid] = 0;
        __syncthreads();
        const int tok = bt * 256 + F.tid, ch = (bt * 256) / CAPC;
        int idx[6], lr[6]; float w[6];
        if (F.tid < 256) {
            float lg[64];
#pragma unroll
            for (int j = 0; j < 16; ++j) { const f32x4 v = *(const f32x4*)(LG + (size_t)tok * 64 + 4 * j); lg[4 * j] = v[0]; lg[4 * j + 1] = v[1]; lg[4 * j + 2] = v[2]; lg[4 * j + 3] = v[3]; }
            route_token(lg, F.in[I_RB], idx, w);
#pragma unroll
            for (int k = 0; k < 6; ++k) lr[k] = atomicAdd((int*)&hist[idx[k]], 1);
        }
        __syncthreads();
        if (F.tid < 64) base[F.tid] = (int)__hip_atomic_fetch_add(F.ctl + CW_CNT + 64 * (ch * 65 + F.tid), (unsigned)hist[F.tid], __ATOMIC_RELAXED, __HIP_MEMORY_SCOPE_AGENT);
        __syncthreads();
        if (F.tid < 256) {
#pragma unroll
            for (int k = 0; k < 6; ++k) { const int slot = base[idx[k]] + lr[k];
                rowtok[(size_t)(ch * 64 + idx[k]) * CAPC + slot] = tok; tslot[(size_t)tok * 8 + k] = (idx[k] << 16) | slot; topw[(size_t)tok * 8 + k] = w[k]; }
        }
    }
}

__device__ __forceinline__ void p12_combine(Frame& F, int ch) {
    const MoeTab tb = moe_tab(F.lds); const int t0 = tb.tbase[ch * 65];
    const bf16_t* Y = (const bf16_t*)(F.ws + WS_Y); const int* tslot = (const int*)(F.ws + WS_TSLOT); const float* topw = (const float*)(F.ws + WS_TOPW);
    const float* g2 = F.in[I_LN2G]; const float* b2 = F.in[I_LN2B];
    for (int tk = F.bid * 8 + F.wave; tk < CAPC; tk += F.G * 8) {
        const int tok = ch * CAPC + tk;
        f32x4 a[4];
        { const float* xr = F.out + (size_t)tok * 1024 + 8 * F.lane; a[0] = *(const f32x4*)xr * ALPHA; a[1] = *(const f32x4*)(xr + 4) * ALPHA; a[2] = *(const f32x4*)(xr + 512) * ALPHA; a[3] = *(const f32x4*)(xr + 516) * ALPHA; }
#pragma unroll
        for (int k = 0; k < 7; ++k) {
            int yrow; float w;
            if (k < 6) { const int ts = tslot[(size_t)tok * 8 + k]; yrow = (tb.tbase[ch * 65 + (ts >> 16)] - t0) * 256 + (ts & 0xffff); w = topw[(size_t)tok * 8 + k]; }
            else { yrow = (tb.tbase[ch * 65 + 64] - t0) * 256 + tk; w = 1.f; }
            const bf16_t* yr = Y + (size_t)yrow * 1024 + 8 * F.lane;
            const u32x4 w0 = *(const u32x4*)yr, w1 = *(const u32x4*)(yr + 512); f32x4 y0, y1, y2, y3; unpack8(w0, y0, y1); unpack8(w1, y2, y3);
            a[0] += y0 * w; a[1] += y1 * w; a[2] += y2 * w; a[3] += y3 * w;
        }
        float s = 0.f;
#pragma unroll
        for (int j = 0; j < 4; ++j) s += (a[j][0] + a[j][1]) + (a[j][2] + a[j][3]);
        const float mean = wave_sum(s) * (1.f / 1024.f); float q = 0.f;
#pragma unroll
        for (int j = 0; j < 4; ++j) { a[j] = a[j] - mean; q += (a[j][0] * a[j][0] + a[j][1] * a[j][1]) + (a[j][2] * a[j][2] + a[j][3] * a[j][3]); }
        const float rstd = __builtin_amdgcn_rsqf(wave_sum(q) * (1.f / 1024.f) + LN_EPS);
        float* orow = F.out + (size_t)tok * 1024 + 8 * F.lane;
#pragma unroll
        for (int j = 0; j < 4; ++j) { const int c = 8 * F.lane + (j >> 1) * 512 + (j & 1) * 4; const f32x4 gg = *(const f32x4*)(g2 + c), bb = *(const f32x4*)(b2 + c);
            *(f32x4*)(orow + (j >> 1) * 512 + (j & 1) * 4) = a[j] * rstd * gg + bb; }
    }
}
}

namespace fx {
constexpr int NPHASE = 11 + 2 * NCH;
struct Args { const float* in[29]; float* out; unsigned char* ws; int ph_lo, ph_hi; };

__global__ void __launch_bounds__(512, 2) fwd(Args args) {
    extern __shared__ __attribute__((aligned(16))) unsigned char lds_raw[];
    Frame F;
    F.lds = (LAS unsigned char*)lds_raw; F.ws = args.ws; F.ctl = (unsigned*)(args.ws + WS_CTL); F.out = args.out;
#pragma unroll
    for (int i = 0; i < 29; ++i) F.in[i] = args.in[i];
    F.tid = threadIdx.x; F.lane = F.tid & 63; F.wave = __builtin_amdgcn_readfirstlane(F.tid >> 6); F.G = gridDim.x; F.bid = blockIdx.x;
    volatile LAS unsigned* MISC = (volatile LAS unsigned*)(F.lds + MISC_OFF);
    if (F.tid < 32) MISC[F.tid] = 0u;
    __syncthreads();
    const int lo = args.ph_lo, hi = args.ph_hi;
    XcdBarrier bar; bar.bar = F.ctl + CW_BAR; bar.x = 0; bar.st = MISC + 8;
    if (hi - lo > 1) bar = xcd_barrier_post(F.ctl + CW_BAR, MISC + 8);
#ifndef PH_MASK
#define PH_MASK 0xFFFFFFFFu
#endif
#define IN(k) (((PH_MASK >> ((k) > 11 ? 11 + (((k) - 11) & 1) : (k))) & 1u) && lo <= (k) && (k) < hi)
#define SEAM(k) do { if (IN(k) && IN((k) + 1)) xcd_barrier(bar); } while (0)
    unsigned char* ws = args.ws;
    bf16_t* UH = (bf16_t*)(ws + WS_UH); bf16_t* CQ = (bf16_t*)(ws + WS_CQ); bf16_t* CKVR = (bf16_t*)(ws + WS_CKVR); bf16_t* Qb = (bf16_t*)(ws + WS_Q); bf16_t* KVb = (bf16_t*)(ws + WS_KV);
    bf16_t* SPRE = (bf16_t*)(ws + WS_SPRE); bf16_t* MIX = (bf16_t*)(ws + WS_MIX);
    float* ssqq = (float*)(ws + WS_SSQQ); float* ssqkv = (float*)(ws + WS_SSQKV); const float* ropec = (const float*)(ws + WS_ROPE); const float* ropes = ropec + 2048 * 16;

    if (IN(0)) { p0_prologue(F); } SEAM(0);
    if (IN(1)) {
        PlainOrder S; S.init(ws + WS_XB, 1024, ws + WS_WIN, 1024, T, 1024, F.G, F.bid);
        EpiWin E{UH, CQ, CKVR, ssqq, ssqkv, ropec, ropes};
        gemm_phase<EpiWin, PlainOrder, true, false>(F.lds, 1024, 1024, 1024, S, E);
    } SEAM(1);
    if (IN(2)) {
#ifndef SUB2
#define SUB2 7
#endif
        if (SUB2 & 1) { PlainOrder S; S.init(CQ, 256, ws + WS_WUQ, 256, T, 768, F.G, F.bid); EpiQ E{Qb, ssqq, ropec, ropes};
          gemm_phase<EpiQ, PlainOrder, true, false>(F.lds, 256, 256, 256, S, E); }
        if (SUB2 & 2) { PlainOrder S; S.init(CKVR, 256, ws + WS_WUKV, 256, T, 1024, F.G, F.bid); EpiKV E{KVb, ssqkv};
          gemm_phase<EpiKV, PlainOrder, true, false>(F.lds, 256, 256, 256, S, E); }
        if (SUB2 & 4) { GroupOrder S; S.init(UH, ws + WS_WST, 512, 1, F.G, F.bid); EpiSt E{(float*)(ws + WS_S)};
          gemm_phase<EpiSt, GroupOrder, true, false>(F.lds, UHK, 512, 512, S, E); }
    } SEAM(2);
    if (IN(3)) { p3_scan_fill(F); } SEAM(3);
    if (IN(4)) {
#ifndef SUB4
#define SUB4 3
#endif
        if (SUB4 & 1) { GroupOrder S; S.init(UH, ws + WS_MO, UHK, 2, F.G, F.bid); EpiSsmOut E{UH, SPRE, F.in[I_DSK]};
          gemm_phase<EpiSsmOut, GroupOrder, true, false>(F.lds, UHK, UHK, UHK, S, E); }
        if (SUB4 & 2) for (int i = 0;; ++i) { const long L = (long)i * F.G + F.bid; if (L >= 2048) break;
            const int un = xcd_remap((int)L, 2048), pair = un >> 3, qb = un & 7, b = pair >> 3, h = pair & 7;
            att::attn_unit(ws, Qb, MIX, b * SEQ, qb * 256, h, (char*)lds_raw); }
    } SEAM(4);
    if (IN(5)) {
        PlainOrder S; S.init(SPRE, 512, ws + WS_WGLU, 512, T, 512, F.G, F.bid); EpiGlu E{SPRE, MIX, F.in[I_BGLU]};
        gemm_phase<EpiGlu, PlainOrder, true, false>(F.lds, 512, 512, 512, S, E);
    } SEAM(5);
    if (IN(6)) {
        PlainOrder S; S.init(MIX, 1024, ws + WS_WO, 1024, T, 1024, F.G, F.bid); EpiWo E{F.in[I_X], F.out};
        gemm_phase<EpiWo, PlainOrder, true, false>(F.lds, 1024, 1024, 1024, S, E);
    } SEAM(6);
    if (IN(7)) { p7_ln1(F); } SEAM(7);
    if (IN(8)) {
        PlainOrder S; S.init(ws + WS_X1B, 1024, ws + WS_WR, 1024, T, 256, F.G, F.bid); EpiRouter E{(float*)(ws + WS_LOGIT)};
        gemm_phase<EpiRouter, PlainOrder, true, false>(F.lds, 1024, 1024, 1024, S, E);
    } SEAM(8);
    if (IN(9)) { p9_route(F); } SEAM(9);
    if (IN(10)) {
        moe_build_tab(F.lds, F.ctl);
        GateUpOrder S; S.init(ws + WS_X1B, ws + WS_WGU, (const int*)(ws + WS_ROWTOK), F.ctl, moe_tab(F.lds), F.G, F.bid); EpiGateUp E{(bf16_t*)(ws + WS_H)};
        gemm_phase<EpiGateUp, GateUpOrder, true, true>(F.lds, 1024, 1024, 1024, S, E);
    } SEAM(10);
#pragma unroll
    for (int ch = 0; ch < NCH; ++ch) {
        if (IN(11 + 2 * ch)) {
            moe_build_tab(F.lds, F.ctl);
            DownOrder S; S.init(ws + WS_H, ws + WS_WD, moe_tab(F.lds), ch, F.G, F.bid); EpiDown E{(bf16_t*)(ws + WS_Y)};
            gemm_phase<EpiDown, DownOrder, true, false>(F.lds, 256, 256, 256, S, E);
        } SEAM(11 + 2 * ch);
        if (IN(12 + 2 * ch)) { moe_build_tab(F.lds, F.ctl); p12_combine(F, ch); } SEAM(12 + 2 * ch);
    }
#undef IN
#undef SEAM
}

#if MK_DEBUG
__global__ void dbg_cmp(int k, const unsigned char* ws, const float* out_fast, gold::Bufs B, const float* gx1, const float* gout, float* acc) {
    const int t = blockIdx.x;
    float num = 0.f, den = 0.f;
    auto bf = [](const bf16_t* p, size_t i) -> float { return __uint_as_float(((unsigned)p[i]) << 16); };
    int ncol = 0;
    switch (k) { case 0: ncol = 512; break; case 1: ncol = 256; break; case 2: ncol = 160; break; case 3: ncol = 768; break; case 4: ncol = 1024; break; case 5: ncol = 512; break; case 6: ncol = 512; break; case 7: ncol = 512; break; case 8: ncol = 1024; break; default: ncol = 1024; }
    for (int c = threadIdx.x; c < ncol; c += blockDim.x) {
        float f = 0.f, g = 0.f;
        if (k == 0) { const int gg = c >> 4, p = c & 15; f = bf((const bf16_t*)(ws + WS_UH), ((size_t)gg * UHR + (t >> 5)) * UHK + (t & 31) * 16 + p); g = B.proj[(size_t)t * 928 + c]; }
        else if (k == 1) { f = bf((const bf16_t*)(ws + WS_CQ), (size_t)t * 256 + c); g = B.proj[(size_t)t * 928 + 512 + c]; }
        else if (k == 2) { f = bf((const bf16_t*)(ws + WS_CKVR), (size_t)t * 256 + c); g = c < 128 ? B.proj[(size_t)t * 928 + 768 + c] : B.krope[(size_t)t * 32 + rope_perm_src(c - 128)]; }
        else if (k == 3) { const int hh = c / 96, jj = c % 96, src = jj < 64 ? c : hh * 96 + 64 + rope_perm_src(jj - 64); f = bf((const bf16_t*)(ws + WS_Q), (size_t)t * 768 + c); g = B.q[(size_t)t * 768 + src] * QSCALE; }
        else if (k == 4) { f = bf((const bf16_t*)(ws + WS_KV), (size_t)t * 1024 + c); g = B.kv[(size_t)t * 1024 + c]; }
        else if (k == 5) { f = bf((const bf16_t*)(ws + WS_SPRE), (size_t)t * 512 + c); g = B.spre[(size_t)t * 512 + c]; }
        else if (k == 6) { f = bf((const bf16_t*)(ws + WS_MIX), (size_t)t * 1024 + c); g = B.mix[(size_t)t * 1024 + c]; }
        else if (k == 7) { f = bf((const bf16_t*)(ws + WS_MIX), (size_t)t * 1024 + 512 + c); g = B.mix[(size_t)t * 1024 + 512 + c]; }
        else if (k == 8) { f = bf((const bf16_t*)(ws + WS_X1B), (size_t)t * 1024 + c); g = gx1[(size_t)t * 1024 + c]; }
        else { f = out_fast[(size_t)t * 1024 + c]; g = gout[(size_t)t * 1024 + c]; }
        const float d = f - g; num += d * d; den += g * g;
        if (!(fabsf(f) < 1e30f)) num += 1e30f;
    }
    num = wave_sum(num); den = wave_sum(den);
    if ((threadIdx.x & 63) == 0) { atomicAdd(acc + 2 * k, num); atomicAdd(acc + 2 * k + 1, den); }
}
__global__ void dbg_encode(const float* acc, float* out, int k0, int nk) {
    float c2 = 0.f;
    for (int k = k0; k < k0 + nk; ++k) { const float e = sqrtf(acc[2 * k] / fmaxf(acc[2 * k + 1], 1e-30f)); const float tol = (k == 9) ? 0.08f : 0.04f;
        if (!(e <= tol)) { const int bucket = !(e <= 0.5f) ? 0 : (e > 0.1f ? 1 : 2); c2 = (float)(k - k0 + 1) + 20.f * bucket; break; } }
    if (c2 == 0.f) { if (MK_DBG_NPH >= NPHASE) return; c2 = 90.f; }
    const float c = sqrtf(c2);
    for (size_t i = (size_t)blockIdx.x * blockDim.x + threadIdx.x; i < (size_t)T * 1024; i += (size_t)gridDim.x * blockDim.x) out[i] = c;
}
#endif
}

extern "C" void kernel_launch(void* const* d_in, const int* in_sizes, int n_in, void* d_out, int out_size, void* d_ws, size_t ws_size, hipStream_t stream) {
#if MK_MODE == 0
    gold::In I; const float** p = (const float**)&I;
    for (int i = 0; i < 29; ++i) p[i] = (const float*)d_in[i];
    for (int t0 = 0; t0 < 65536; t0 += 16384) gold::run(I, t0, 16384, (float*)d_ws, (float*)d_out + (size_t)t0 * 1024, (float*)d_out + (size_t)t0 * 1024, stream);
#else
    using namespace fx;
    static int grid = 0;
    if (grid == 0) {
        if (n_in != 29 || ws_size < WS_END) { fprintf(stderr, "kernel_launch: need 29 inputs and >= %zu bytes of workspace (got %d, %zu)\n", (size_t)WS_END, n_in, ws_size); grid = -1; return; }
        int dev = 0, cus = 0, per_cu = 0;
        hipGetDevice(&dev); hipDeviceGetAttribute(&cus, hipDeviceAttributeMultiprocessorCount, dev);
        if (hipFuncSetAttribute((const void*)fwd, hipFuncAttributeMaxDynamicSharedMemorySize, LDS_BYTES) != hipSuccess) { fprintf(stderr, "kernel_launch: hipFuncSetAttribute failed\n"); grid = -1; return; }
        if (hipOccupancyMaxActiveBlocksPerMultiprocessor(&per_cu, (const void*)fwd, 512, LDS_BYTES) != hipSuccess || per_cu < 1) { fprintf(stderr, "kernel_launch: occupancy query says %d\n", per_cu); }
        (void)hipGetLastError();
        grid = cus > 0 ? cus : 256;
    }
    if (grid < 0) return;
    hipMemsetAsync((char*)d_ws + WS_CTL, 0, CTL_BYTES, stream);
    Args a{};
    for (int i = 0; i < 29; ++i) a.in[i] = (const float*)d_in[i];
    a.out = (float*)d_out; a.ws = (unsigned char*)d_ws;
#if MK_MODE == 1
    for (int ph = 0; ph < NPHASE && ph < MK_DBG_NPH; ++ph) { a.ph_lo = ph; a.ph_hi = ph + 1; hipLaunchKernelGGL(fwd, dim3(grid), dim3(512), LDS_BYTES, stream, a); }
#else
    a.ph_lo = 0; a.ph_hi = NPHASE; hipLaunchKernelGGL(fwd, dim3(grid), dim3(512), LDS_BYTES, stream, a);
#endif
#if MK_DEBUG
    {
        gold::In I; const float** p = (const float**)&I;
        for (int i = 0; i < 29; ++i) p[i] = (const float*)d_in[i];
        float* gs = (float*)((char*)d_ws + WS_GOLD); float* gx1 = gs + (size_t)2048 * gold::GOLD_FLOATS_PER_TOK; float* gout = gx1 + (size_t)2048 * 1024;
        gold::Bufs B = gold::run(I, 0, 2048, gs, gx1, gout, stream);
        float* acc = (float*)((char*)d_ws + WS_CTL) + CW_DBG;
        for (int k = 0; k < 10; ++k) hipLaunchKernelGGL(dbg_cmp, dim3(2048), dim3(256), 0, stream, k, (const unsigned char*)d_ws, (const float*)d_out, B, (const float*)gx1, (const float*)gout, acc);
        hipLaunchKernelGGL(dbg_encode, dim3(1024), dim3(256), 0, stream, (const float*)acc, (float*)d_out, MK_DBG_K0, MK_DBG_NK);
    }
#endif
    const hipError_t le = hipPeekAtLastError();
    if (le != hipSuccess) fprintf(stderr, "kernel_launch: launch failed: %s\n", hipGetErrorName(le));
#endif
}
```

```cpp
#define MK_MODE 2
#include <hip/hip_runtime.h>
#include <cstdio>
#include <cstdint>
#include <cmath>
#ifndef MK_MODE
#define MK_MODE 1
#endif
#ifndef MK_DBG_NPH
#define MK_DBG_NPH 99
#endif
#ifndef MK_DBG_K0
#define MK_DBG_K0 0
#endif
#ifndef MK_DBG_NK
#define MK_DBG_NK 10
#endif
#ifndef MK_DUP
#define MK_DUP -1
#endif
#define REP(k) for (int rep_ = 0; rep_ < ((MK_DUP == (k)) ? 2 : 1); ++rep_)
#define DUP2(k, ...) do { __VA_ARGS__ if constexpr (MK_DUP == (k)) { __VA_ARGS__ } } while (0)
#ifndef MK_DEBUG
#define MK_DEBUG 0
#endif
namespace gold {
constexpr int D_MODEL = 1024, SEQ = 2048, D_SSM = 512, D_IN = 928, NH = 8, QLR = 256, KVLR = 128, ROPE = 32;
constexpr int NEXP = 64, TOPK = 6, DEXP = 256;
constexpr float ALPHA = 1.189207115002721f, LN_EPS = 1e-5f, RMS_EPS = 1e-6f, ATT_SCALE = 0.10206207261596577f;

__global__ void __launch_bounds__(256) sgemm(const float* __restrict__ A, int lda, const float* __restrict__ B, int ldb, float* __restrict__ C, int ldc, int M, int N, int K) {
    __shared__ float As[16][65];
    __shared__ float Bs[16][65];
    const int tid = threadIdx.x, tx = tid & 15, ty = tid >> 4;
    const int m0 = blockIdx.y * 64, n0 = blockIdx.x * 64;
    float acc[4][4];
#pragma unroll
    for (int i = 0; i < 4; ++i)
#pragma unroll
        for (int j = 0; j < 4; ++j) acc[i][j] = 0.f;
    for (int k0 = 0; k0 < K; k0 += 16) {
#pragma unroll
        for (int i = 0; i < 4; ++i) { const int idx = tid + 256 * i, r = idx >> 4, c = idx & 15; As[c][r] = A[(size_t)(m0 + r) * lda + k0 + c]; }
#pragma unroll
        for (int i = 0; i < 4; ++i) { const int idx = tid + 256 * i, r = idx >> 6, c = idx & 63; Bs[r][c] = (n0 + c < N) ? B[(size_t)(k0 + r) * ldb + n0 + c] : 0.f; }
        __syncthreads();
#pragma unroll
        for (int k = 0; k < 16; ++k) {
            float a[4], b[4];
#pragma unroll
            for (int i = 0; i < 4; ++i) a[i] = As[k][ty + 16 * i];
#pragma unroll
            for (int j = 0; j < 4; ++j) b[j] = Bs[k][tx + 16 * j];
#pragma unroll
            for (int i = 0; i < 4; ++i)
#pragma unroll
                for (int j = 0; j < 4; ++j) acc[i][j] = fmaf(a[i], b[j], acc[i][j]);
        }
        __syncthreads();
    }
#pragma unroll
    for (int i = 0; i < 4; ++i)
#pragma unroll
        for (int j = 0; j < 4; ++j) { const int c = n0 + tx + 16 * j; if (c < N) C[(size_t)(m0 + ty + 16 * i) * ldc + c] = acc[i][j]; }
}

__device__ __forceinline__ float gelu_tanh(float x) {
    const float z = 0.7978845608028654f * (x + 0.044715f * x * x * x);
    const float e = __expf(2.f * z);
    const float th = 1.f - 2.f / (1.f + e);
    return 0.5f * x * (1.f + th);
}
__device__ __forceinline__ float sigmoidf_(float x) { return 1.f / (1.f + __expf(-x)); }

struct SsmPar { float ar, ai, kr, ki; };
__device__ __forceinline__ SsmPar ssm_par(const float* lam_re, const float* lam_im, const float* log_dt, int d, int g, int n) {
    const float lr = fminf(lam_re[(d * 32 + g) * 64 + n], -1e-4f), li = lam_im[(d * 32 + g) * 64 + n];
    const float dt = expf(log_dt[d * 32 + g]);
    const float x = lr * dt, th = li * dt;
    const float em1 = expm1f(x), cs = cosf(th), sn = sinf(th), sh = sinf(0.5f * th);
    const float mag = em1 + 1.f;
    SsmPar p; p.ar = mag * cs; p.ai = mag * sn;
    const float arm1 = em1 * cs - 2.f * sh * sh;
    const float den = lr * lr + li * li;
    p.kr = (arm1 * lr + p.ai * li) / den; p.ki = (p.ai * lr - arm1 * li) / den;
    return p;
}

__global__ void __launch_bounds__(64) ssm_naive(const float* __restrict__ proj, int ldp, const float* __restrict__ lam_re, const float* __restrict__ lam_im, const float* __restrict__ log_dt,
                                                const float* __restrict__ b_re, const float* __restrict__ b_im, const float* __restrict__ c_re, const float* __restrict__ c_im,
                                                const float* __restrict__ d_skip, float* __restrict__ spre) {
    const int g = blockIdx.x, b = blockIdx.y, n = threadIdx.x;
    for (int d = 0; d < 2; ++d) {
        const SsmPar P = ssm_par(lam_re, lam_im, log_dt, d, g, n);
        float Br[16], Bi[16], Cr[16], Ci[16];
#pragma unroll
        for (int q = 0; q < 16; ++q) { const float br = b_re[((d * 32 + g) * 64 + n) * 16 + q], bi = b_im[((d * 32 + g) * 64 + n) * 16 + q];
            Br[q] = P.kr * br - P.ki * bi; Bi[q] = P.kr * bi + P.ki * br;
            Cr[q] = c_re[((d * 32 + g) * 16 + q) * 64 + n]; Ci[q] = c_im[((d * 32 + g) * 16 + q) * 64 + n]; }
        float hr = 0.f, hi = 0.f;
        for (int step = 0; step < SEQ; ++step) {
            const int t = d ? (SEQ - 1 - step) : step;
            const float* up = proj + (size_t)(b * SEQ + t) * ldp + g * 16;
            float u[16];
#pragma unroll
            for (int q = 0; q < 16; ++q) u[q] = up[q];
            float bur = 0.f, bui = 0.f;
#pragma unroll
            for (int q = 0; q < 16; ++q) { bur = fmaf(Br[q], u[q], bur); bui = fmaf(Bi[q], u[q], bui); }
            const float nr = P.ar * hr - P.ai * hi + bur, ni = P.ar * hi + P.ai * hr + bui;
            hr = nr; hi = ni;
            float y[16];
#pragma unroll
            for (int p = 0; p < 16; ++p) y[p] = Cr[p] * hr - Ci[p] * hi;
#pragma unroll
            for (int o = 1; o < 64; o <<= 1)
#pragma unroll
                for (int p = 0; p < 16; ++p) y[p] += __shfl_xor(y[p], o);
            if (n < 16) {
                float v = 0.f;
#pragma unroll
                for (int p = 0; p < 16; ++p) if (p == n) v = y[p];
                float* o = spre + (size_t)(b * SEQ + t) * 512 + g * 16 + n;
                if (d == 0) *o = v;
                else { float uu = 0.f;
#pragma unroll
                    for (int p = 0; p < 16; ++p) if (p == n) uu = u[p];
                    *o = gelu_tanh(*o + v + uu * d_skip[g * 16 + n]); }
            }
        }
    }
}
__global__ void glu_ew(const float* __restrict__ spre, const float* __restrict__ gl, const float* __restrict__ bglu, float* __restrict__ mix, int ntok) {
    const size_t i = (size_t)blockIdx.x * 256 + threadIdx.x; if (i >= (size_t)ntok * 512) return;
    const int c = (int)(i & 511); const size_t r = i >> 9;
    mix[r * 1024 + c] = spre[i] * sigmoidf_(gl[i] + bglu[c]);
}
__global__ void rmsnorm_rows(const float* __restrict__ in, int ld, int off, int n, const float* __restrict__ g, float* __restrict__ out, int ntok) {
    const int r = blockIdx.x * 256 + threadIdx.x; if (r >= ntok) return;
    const float* p = in + (size_t)r * ld + off; float s = 0.f;
    for (int j = 0; j < n; ++j) s = fmaf(p[j], p[j], s);
    const float rs = rsqrtf(s / n + RMS_EPS);
    for (int j = 0; j < n; ++j) out[(size_t)r * n + j] = p[j] * rs * g[j];
}
__device__ __forceinline__ void rope_cs(int pos, int i, float& c, float& s) {
    const float inv = expf(-9.210340371976184f * (float)i * (1.f / 16.f));
    const float a = (float)pos * inv; c = cosf(a); s = sinf(a);
}
__global__ void rope_ew(float* __restrict__ q, const float* __restrict__ proj, int ldp, float* __restrict__ krope, int ntok) {
    const int idx = blockIdx.x * 256 + threadIdx.x; if (idx >= ntok * 9 * 16) return;
    const int i = idx & 15, hh = (idx >> 4) % 9, r = idx / 144, pos = r % SEQ;
    float c, s; rope_cs(pos, i, c, s);
    if (hh < 8) { float* p = q + (size_t)r * 768 + hh * 96 + 64; const float t1 = p[i], t2 = p[i + 16]; p[i] = t1 * c - t2 * s; p[i + 16] = t1 * s + t2 * c; }
    else { const float* p = proj + (size_t)r * ldp + 896; const float t1 = p[i], t2 = p[i + 16]; krope[(size_t)r * 32 + i] = t1 * c - t2 * s; krope[(size_t)r * 32 + i + 16] = t1 * s + t2 * c; }
}
__global__ void __launch_bounds__(64) attn_naive(const float* __restrict__ q, const float* __restrict__ kv, const float* __restrict__ krope, float* __restrict__ mix) {
    const int qi = blockIdx.x * 64 + threadIdx.x, h = blockIdx.y, b = blockIdx.z;
    const size_t r = (size_t)b * SEQ + qi;
    float qv[96], o[64];
#pragma unroll
    for (int d = 0; d < 96; ++d) qv[d] = q[r * 768 + h * 96 + d] * ATT_SCALE;
#pragma unroll
    for (int d = 0; d < 64; ++d) o[d] = 0.f;
    float m = -1e30f, l = 0.f;
    for (int s = 0; s < SEQ; ++s) {
        const size_t kr = (size_t)b * SEQ + s;
        const float4* kn = (const float4*)(kv + kr * 1024 + h * 128);
        const float4* kp = (const float4*)(krope + kr * 32);
        float sc = 0.f;
#pragma unroll
        for (int d = 0; d < 16; ++d) { const float4 k4 = kn[d]; sc = fmaf(qv[4 * d], k4.x, sc); sc = fmaf(qv[4 * d + 1], k4.y, sc); sc = fmaf(qv[4 * d + 2], k4.z, sc); sc = fmaf(qv[4 * d + 3], k4.w, sc); }
#pragma unroll
        for (int d = 0; d < 8; ++d) { const float4 k4 = kp[d]; sc = fmaf(qv[64 + 4 * d], k4.x, sc); sc = fmaf(qv[64 + 4 * d + 1], k4.y, sc); sc = fmaf(qv[64 + 4 * d + 2], k4.z, sc); sc = fmaf(qv[64 + 4 * d + 3], k4.w, sc); }
        const float mn = fmaxf(m, sc), al = __expf(m - mn), p = __expf(sc - mn);
        l = l * al + p; m = mn;
        const float4* vp = (const float4*)(kv + kr * 1024 + h * 128 + 64);
#pragma unroll
        for (int d = 0; d < 16; ++d) { const float4 v4 = vp[d]; o[4 * d] = fmaf(o[4 * d], al, p * v4.x); o[4 * d + 1] = fmaf(o[4 * d + 1], al, p * v4.y); o[4 * d + 2] = fmaf(o[4 * d + 2], al, p * v4.z); o[4 * d + 3] = fmaf(o[4 * d + 3], al, p * v4.w); }
    }
    const float il = 1.f / l;
#pragma unroll
    for (int d = 0; d < 64; ++d) mix[r * 1024 + 512 + h * 64 + d] = o[d] * il;
}
__device__ __forceinline__ float wsum(float v) {
#pragma unroll
    for (int o = 1; o < 64; o <<= 1) v += __shfl_xor(v, o);
    return v;
}
__global__ void __launch_bounds__(256) ln1_rows(const float* __restrict__ x, const float* __restrict__ mixo, const float* __restrict__ g, const float* __restrict__ bb, float* __restrict__ x1, int ntok) {
    const int r = blockIdx.x * 4 + (threadIdx.x >> 6), lane = threadIdx.x & 63; if (r >= ntok) return;
    float v[16]; float s = 0.f;
#pragma unroll
    for (int j = 0; j < 16; ++j) { const int c = lane + 64 * j; v[j] = ALPHA * x[(size_t)r * 1024 + c] + mixo[(size_t)r * 1024 + c]; s += v[j]; }
    const float mean = wsum(s) * (1.f / 1024.f); float q = 0.f;
#pragma unroll
    for (int j = 0; j < 16; ++j) { v[j] -= mean; q = fmaf(v[j], v[j], q); }
    const float rstd = rsqrtf(wsum(q) * (1.f / 1024.f) + LN_EPS);
#pragma unroll
    for (int j = 0; j < 16; ++j) { const int c = lane + 64 * j; x1[(size_t)r * 1024 + c] = v[j] * rstd * g[c] + bb[c]; }
}
}

__device__ __forceinline__ void route_token(const float (&lg)[64], const float* __restrict__ rbias, int (&idx)[6], float (&w)[6]) {
    float sc[64], ch[64];
#pragma unroll
    for (int j = 0; j < 64; ++j) { sc[j] = 1.f / (1.f + __expf(-lg[j])); ch[j] = sc[j] + rbias[j]; }
    float gs[8];
#pragma unroll
    for (int g = 0; g < 8; ++g) { float m1 = -INFINITY, m2 = -INFINITY;
#pragma unroll
        for (int j = 0; j < 8; ++j) { const float v = ch[g * 8 + j]; if (v > m1) { m2 = m1; m1 = v; } else if (v > m2) m2 = v; }
        gs[g] = m1 + m2; }
    bool sel[8];
#pragma unroll
    for (int g = 0; g < 8; ++g) { int rank = 0;
#pragma unroll
        for (int o = 0; o < 8; ++o) { if (o != g && (gs[o] > gs[g] || (gs[o] == gs[g] && o < g))) ++rank; }
        sel[g] = rank < 4; }
#pragma unroll
    for (int j = 0; j < 64; ++j) if (!sel[j >> 3]) ch[j] = -INFINITY;
    float wsum_ = 0.f;
#pragma unroll
    for (int k = 0; k < 6; ++k) { float best = -INFINITY; int bi = 0;
#pragma unroll
        for (int j = 0; j < 64; ++j) if (ch[j] > best) { best = ch[j]; bi = j; }
        float sv = 0.f;
#pragma unroll
        for (int j = 0; j < 64; ++j) if (j == bi) { sv = sc[j]; ch[j] = -INFINITY; }
        idx[k] = bi; w[k] = sv; wsum_ += sv; }
    const float inv = 2.5f / (wsum_ + 1e-20f);
#pragma unroll
    for (int k = 0; k < 6; ++k) w[k] *= inv;
}

namespace gold {
__global__ void __launch_bounds__(64) route_rows(const float* __restrict__ logits, const float* __restrict__ rbias, int* __restrict__ topi, float* __restrict__ topw, int ntok) {
    const int r = blockIdx.x * 64 + threadIdx.x; if (r >= ntok) return;
    float lg[64];
#pragma unroll
    for (int j = 0; j < 16; ++j) { const float4 v = ((const float4*)(logits + (size_t)r * 64))[j]; lg[4 * j] = v.x; lg[4 * j + 1] = v.y; lg[4 * j + 2] = v.z; lg[4 * j + 3] = v.w; }
    int idx[6]; float w[6]; route_token(lg, rbias, idx, w);
#pragma unroll
    for (int k = 0; k < 6; ++k) { topi[(size_t)r * 6 + k] = idx[k]; topw[(size_t)r * 6 + k] = w[k]; }
}
__global__ void __launch_bounds__(256) moe_naive(const float* x1, const int* __restrict__ topi, const float* __restrict__ topw,
                                                  const float* __restrict__ weg, const float* __restrict__ weu, const float* __restrict__ wed,
                                                  const float* __restrict__ wsg, const float* __restrict__ wsu, const float* __restrict__ wsd,
                                                  const float* __restrict__ g2, const float* __restrict__ b2, float* out) {
    __shared__ float xs[1024]; __shared__ float hs[256]; __shared__ float red[8];
    const int r = blockIdx.x, tid = threadIdx.x;
#pragma unroll
    for (int j = 0; j < 4; ++j) xs[tid + 256 * j] = x1[(size_t)r * 1024 + tid + 256 * j];
    __syncthreads();
    float acc[4] = {0.f, 0.f, 0.f, 0.f};
    for (int ei = 0; ei < 7; ++ei) {
        const int e = ei < 6 ? topi[(size_t)r * 6 + ei] : 0; const float w = ei < 6 ? topw[(size_t)r * 6 + ei] : 1.f;
        const float* Wg = ei < 6 ? weg + (size_t)e * 1024 * 256 : wsg; const float* Wu = ei < 6 ? weu + (size_t)e * 1024 * 256 : wsu; const float* Wd = ei < 6 ? wed + (size_t)e * 256 * 1024 : wsd;
        float gg = 0.f, uu = 0.f;
        for (int k = 0; k < 1024; ++k) { const float xv = xs[k]; gg = fmaf(xv, Wg[(size_t)k * 256 + tid], gg); uu = fmaf(xv, Wu[(size_t)k * 256 + tid], uu); }
        hs[tid] = gg / (1.f + __expf(-gg)) * uu;
        __syncthreads();
        float y[4] = {0.f, 0.f, 0.f, 0.f};
        for (int i = 0; i < 256; ++i) { const float hv = hs[i];
#pragma unroll
            for (int j = 0; j < 4; ++j) y[j] = fmaf(hv, Wd[(size_t)i * 1024 + tid + 256 * j], y[j]); }
#pragma unroll
        for (int j = 0; j < 4; ++j) acc[j] = fmaf(w, y[j], acc[j]);
        __syncthreads();
    }
    float v[4]; float s = 0.f;
#pragma unroll
    for (int j = 0; j < 4; ++j) { v[j] = ALPHA * xs[tid + 256 * j] + acc[j]; s += v[j]; }
    s = wsum(s); if ((tid & 63) == 0) red[tid >> 6] = s; __syncthreads();
    const float mean = (red[0] + red[1] + red[2] + red[3]) * (1.f / 1024.f); float q = 0.f;
#pragma unroll
    for (int j = 0; j < 4; ++j) { v[j] -= mean; q = fmaf(v[j], v[j], q); }
    q = wsum(q); if ((tid & 63) == 0) red[4 + (tid >> 6)] = q; __syncthreads();
    const float rstd = rsqrtf((red[4] + red[5] + red[6] + red[7]) * (1.f / 1024.f) + LN_EPS);
#pragma unroll
    for (int j = 0; j < 4; ++j) { const int c = tid + 256 * j; out[(size_t)r * 1024 + c] = v[j] * rstd * g2[c] + b2[c]; }
}

struct In {
    const float *x, *w_in, *lam_re, *lam_im, *log_dt, *b_re, *b_im, *c_re, *c_im, *d_skip, *w_glu, *b_glu, *q_norm_g, *w_uq, *kv_norm_g, *w_ukv, *w_o, *ln1_g, *ln1_b,
                *w_router, *router_bias, *we_gate, *we_up, *we_down, *ws_gate, *ws_up, *ws_down, *ln2_g, *ln2_b;
};
constexpr size_t GOLD_FLOATS_PER_TOK = 6400;
struct Bufs { float *proj, *spre, *gl, *mix, *cqn, *ckvn, *q, *kv, *krope, *mixo, *logits; int* topi; float* topw; };
static Bufs run(const In& I, int tok0, int ntok, float* scratch, float* x1out, float* out, hipStream_t st) {
    Bufs B;
    B.proj = scratch; B.spre = B.proj + (size_t)ntok * 928; B.gl = B.spre + (size_t)ntok * 512; B.mix = B.gl + (size_t)ntok * 512;
    B.cqn = B.mix + (size_t)ntok * 1024; B.ckvn = B.cqn + (size_t)ntok * 256; B.q = B.ckvn + (size_t)ntok * 128; B.kv = B.q + (size_t)ntok * 768;
    B.krope = B.kv + (size_t)ntok * 1024; B.mixo = B.krope + (size_t)ntok * 32; B.logits = B.mixo + (size_t)ntok * 1024;
    B.topi = (int*)(B.logits + (size_t)ntok * 64); B.topw = (float*)(B.topi + (size_t)ntok * 6);
    float *proj = B.proj, *spre = B.spre, *gl = B.gl, *mix = B.mix, *cqn = B.cqn, *ckvn = B.ckvn, *q = B.q, *kv = B.kv, *krope = B.krope, *mixo = B.mixo, *logits = B.logits; int* topi = B.topi; float* topw = B.topw;
    const float* x = I.x + (size_t)tok0 * 1024; const int nb = ntok / SEQ;
    hipLaunchKernelGGL(sgemm, dim3((928 + 63) / 64, ntok / 64), dim3(256), 0, st, x, 1024, I.w_in, 928, proj, 928, ntok, 928, 1024);
    hipLaunchKernelGGL(ssm_naive, dim3(32, nb), dim3(64), 0, st, proj, 928, I.lam_re, I.lam_im, I.log_dt, I.b_re, I.b_im, I.c_re, I.c_im, I.d_skip, spre);
    hipLaunchKernelGGL(sgemm, dim3(8, ntok / 64), dim3(256), 0, st, spre, 512, I.w_glu, 512, gl, 512, ntok, 512, 512);
    hipLaunchKernelGGL(glu_ew, dim3((unsigned)(((size_t)ntok * 512 + 255) / 256)), dim3(256), 0, st, spre, gl, I.b_glu, mix, ntok);
    hipLaunchKernelGGL(rmsnorm_rows, dim3((ntok + 255) / 256), dim3(256), 0, st, proj, 928, 512, 256, I.q_norm_g, cqn, ntok);
    hipLaunchKernelGGL(rmsnorm_rows, dim3((ntok + 255) / 256), dim3(256), 0, st, proj, 928, 768, 128, I.kv_norm_g, ckvn, ntok);
    hipLaunchKernelGGL(sgemm, dim3(12, ntok / 64), dim3(256), 0, st, cqn, 256, I.w_uq, 768, q, 768, ntok, 768, 256);
    hipLaunchKernelGGL(sgemm, dim3(16, ntok / 64), dim3(256), 0, st, ckvn, 128, I.w_ukv, 1024, kv, 1024, ntok, 1024, 128);
    hipLaunchKernelGGL(rope_ew, dim3((ntok * 144 + 255) / 256), dim3(256), 0, st, q, proj, 928, krope, ntok);
    hipLaunchKernelGGL(attn_naive, dim3(SEQ / 64, 8, nb), dim3(64), 0, st, q, kv, krope, mix);
    hipLaunchKernelGGL(sgemm, dim3(16, ntok / 64), dim3(256), 0, st, mix, 1024, I.w_o, 1024, mixo, 1024, ntok, 1024, 1024);
    hipLaunchKernelGGL(ln1_rows, dim3(ntok / 4), dim3(256), 0, st, x, mixo, I.ln1_g, I.ln1_b, x1out, ntok);
    hipLaunchKernelGGL(sgemm, dim3(1, ntok / 64), dim3(256), 0, st, x1out, 1024, I.w_router, 64, logits, 64, ntok, 64, 1024);
    hipLaunchKernelGGL(route_rows, dim3(ntok / 64), dim3(64), 0, st, logits, I.router_bias, topi, topw, ntok);
    hipLaunchKernelGGL(moe_naive, dim3(ntok), dim3(256), 0, st, x1out, topi, topw, I.we_gate, I.we_up, I.we_down, I.ws_gate, I.ws_up, I.ws_down, I.ln2_g, I.ln2_b, out);
    return B;
}
}
#define GAS __attribute__((address_space(1)))
#define LAS __attribute__((address_space(3)))
typedef unsigned short bf16_t;
typedef short bf16x8 __attribute__((ext_vector_type(8)));
typedef short s16x4 __attribute__((ext_vector_type(4)));
typedef float f32x4 __attribute__((ext_vector_type(4)));
typedef float f32x2 __attribute__((ext_vector_type(2)));
typedef float f32x16 __attribute__((ext_vector_type(16)));
typedef unsigned u32x4 __attribute__((ext_vector_type(4)));
typedef unsigned u32x2 __attribute__((ext_vector_type(2)));

namespace fx {
constexpr int T = 65536, SEQ = 2048, DM = 1024, NB = 32;
constexpr int CHK = 32;
constexpr int NCHK = SEQ / CHK;
constexpr int UHR = NB * NCHK;
constexpr int UHK = CHK * 16 + 256;
constexpr int NCH = 4;
constexpr int CAPC = T / NCH;
constexpr int NVE = NCH * 65;
constexpr float ALPHA = 1.189207115002721f, LN_EPS = 1e-5f, RMS_EPS = 1e-6f;
constexpr float QSCALE = 0.10206207261596577f * 1.4426950408889634f;

constexpr size_t MiB = 1u << 20;
constexpr size_t WS_CTL = 0, CTL_BYTES = 1 * MiB;
constexpr size_t WS_ROPE = 1 * MiB;
constexpr size_t WS_KT = 2 * MiB;
constexpr size_t WS_WIN = 4 * MiB, WS_WGLU = 6 * MiB, WS_WUQ = 6 * MiB + 512 * 1024, WS_WUKV = 7 * MiB, WS_WR = 7 * MiB + 512 * 1024, WS_WO = 8 * MiB;
constexpr size_t WS_WST = 10 * MiB, WS_MO = 18 * MiB, WS_WGU = 42 * MiB, WS_WD = 107 * MiB;
constexpr size_t WS_SSQQ = 140 * MiB, WS_SSQKV = 141 * MiB, WS_TSLOT = 142 * MiB, WS_TOPW = 144 * MiB, WS_ROWTOK = 146 * MiB, WS_LOGIT = 162 * MiB;
constexpr size_t WS_XB = 178 * MiB, WS_UH = 306 * MiB, WS_CQ = 402 * MiB, WS_CKVR = 434 * MiB, WS_S = 466 * MiB, WS_Q = 530 * MiB, WS_KV = 626 * MiB, WS_SPRE = 754 * MiB, WS_MIX = 818 * MiB;
constexpr size_t WS_X1B = 178 * MiB, WS_H = 306 * MiB, WS_Y = 562 * MiB  , WS_YS = 690 * MiB  ;
constexpr size_t WS_GOLD = 946 * MiB, WS_END = 1024 * MiB;
constexpr int CW_TMO = 0, CW_CODE = 1, CW_BAR = 4096, CW_CNT = 16384  , CW_DBG = 65536  ;

constexpr int RING_BYTES = 131072, TAB_OFF = RING_BYTES, TAB_BYTES = 12288, MISC_OFF = TAB_OFF + TAB_BYTES, LDS_BYTES = 147456;

__device__ __forceinline__ unsigned cvt_pk_bf16(float lo, float hi) { unsigned r; asm volatile("v_cvt_pk_bf16_f32 %0, %1, %2" : "=v"(r) : "v"(lo), "v"(hi)); return r; }
__device__ __forceinline__ float bf_lo(unsigned w) { return __uint_as_float(w << 16); }
__device__ __forceinline__ float bf_hi(unsigned w) { return __uint_as_float(w & 0xffff0000u); }
__device__ __forceinline__ u32x4 pack8(const f32x4 a, const f32x4 b) { u32x4 w; w.x = cvt_pk_bf16(a[0], a[1]); w.y = cvt_pk_bf16(a[2], a[3]); w.z = cvt_pk_bf16(b[0], b[1]); w.w = cvt_pk_bf16(b[2], b[3]); return w; }
__device__ __forceinline__ void unpack8(const u32x4 w, f32x4& a, f32x4& b) { a = (f32x4){bf_lo(w.x), bf_hi(w.x), bf_lo(w.y), bf_hi(w.y)}; b = (f32x4){bf_lo(w.z), bf_hi(w.z), bf_lo(w.w), bf_hi(w.w)}; }
__device__ __forceinline__ float fast_sigmoid(float x) { return __builtin_amdgcn_rcpf(1.f + __builtin_amdgcn_exp2f(-1.4426950408889634f * x)); }
__device__ __forceinline__ float gelu_tanh_f(float x) {
    const float z2 = 1.5957691216057308f * (x + 0.044715f * x * x * x);
    return x * fast_sigmoid(z2);
}
__device__ __forceinline__ float wave_sum(float v) {
#pragma unroll
    for (int o = 1; o < 64; o <<= 1) v += __shfl_xor(v, o);
    return v;
}

#define XB_TMO      128
#define XB_XCNT(j)  (256  + 64 * (j))
#define XB_XSUB(j)  (1280 + 64 * (j))
#define XB_XGEN(j)  (2304 + 64 * (j))
#define XB_TOP      3328
#define XB_TOPGEN   3392
#define XCD_BAR_WORDS 3456
#define XB_SPIN_CAP (1u << 18)
__device__ __forceinline__ unsigned xb_ld(unsigned* p)              { return __hip_atomic_load(p, __ATOMIC_RELAXED, __HIP_MEMORY_SCOPE_AGENT); }
__device__ __forceinline__ unsigned xb_add(unsigned* p, unsigned v) { return __hip_atomic_fetch_add(p, v, __ATOMIC_RELAXED, __HIP_MEMORY_SCOPE_AGENT); }
__device__ __forceinline__ unsigned xb_xcc_id() { return (unsigned)__builtin_amdgcn_s_getreg((3 << 11) | 20) & 0xFu; }
#define XB_SPIN(cond, bar) do { unsigned _sp = 0; while (cond) { __builtin_amdgcn_s_sleep(1); \
    if ((++_sp & 255u) == 0u) { if (xb_ld(&(bar)[XB_TMO])) break; if (_sp > XB_SPIN_CAP) { atomicAdd(&(bar)[XB_TMO], 1u); break; } } } } while (0)
struct XcdBarrier { unsigned* bar; unsigned x; volatile LAS unsigned* st; };
__device__ __forceinline__ XcdBarrier xcd_barrier_post(unsigned* bar, volatile LAS unsigned* st) {
    XcdBarrier b; b.bar = bar; b.x = xb_xcc_id(); b.st = st;
    if (threadIdx.x == 0) (void)xb_add(&bar[XB_XCNT(b.x)], 1u);
    return b;
}
__device__ __forceinline__ void xcd_barrier_complete(unsigned* bar, unsigned x, unsigned& nloc, unsigned& nx) {
    const unsigned G = gridDim.x * gridDim.y * gridDim.z;
    unsigned sum, cnt, mine, sp = 0u;
    for (;;) {
        sum = 0u; cnt = 0u; mine = 0u;
#pragma unroll
        for (unsigned j = 0; j < 16; ++j) { const unsigned c = xb_ld(&bar[XB_XCNT(j)]); sum += c; cnt += (c > 0u) ? 1u : 0u; mine = (j == x) ? c : mine; }
        if (sum == G) break;
        __builtin_amdgcn_s_sleep(1);
        if ((++sp & 255u) == 0u) { if (xb_ld(&bar[XB_TMO])) break; if (sp > XB_SPIN_CAP) { atomicAdd(&bar[XB_TMO], 1u); break; } }
    }
    nloc = mine > 0u ? mine : 1u; nx = cnt > 0u ? cnt : 1u;
}
__device__ __forceinline__ void xcd_barrier(const XcdBarrier& b) {
    asm volatile("s_waitcnt vmcnt(0)" ::: "memory");
    __syncthreads();
    if (threadIdx.x == 0) {
        unsigned* bar = b.bar;
        __builtin_amdgcn_s_waitcnt(0);
        unsigned nloc = b.st[0], nx = b.st[1];
        if (nloc == 0u) { xcd_barrier_complete(bar, b.x, nloc, nx); b.st[0] = nloc; b.st[1] = nx; }
        const unsigned old = xb_add(&bar[XB_XSUB(b.x)], 1u);
        const unsigned gen = old / nloc;
        if (old + 1u == (gen + 1u) * nloc) {
            __builtin_amdgcn_fence(__ATOMIC_RELEASE, "agent");
            asm volatile("s_waitcnt vmcnt(0)" ::: "memory");
            const unsigned og = xb_add(&bar[XB_TOP], 1u);
            const unsigned tg = og / nx;
            if (og + 1u == (tg + 1u) * nx) xb_add(&bar[XB_TOPGEN], 1u);
            else XB_SPIN(xb_ld(&bar[XB_TOPGEN]) == tg, bar);
            __builtin_amdgcn_fence(__ATOMIC_ACQUIRE, "agent");
            xb_add(&bar[XB_XGEN(b.x)], 1u);
            asm volatile("s_waitcnt vmcnt(0)" ::: "memory");
        } else {
            XB_SPIN(xb_ld(&bar[XB_XGEN(b.x)]) == gen, bar);
            __builtin_amdgcn_fence(__ATOMIC_ACQUIRE, "agent");
            asm volatile("s_waitcnt vmcnt(0)" ::: "memory");
        }
    }
    __syncthreads();
}

constexpr int BM = 256, BK = 64, HALF = 128, HTB = HALF * BK * 2, STAGE_BYTES = 8 * HTB;
__host__ __device__ __forceinline__ int lds_byte(int r, int c) { const int st = (r >> 4) * 2 + (c >> 5), rr = r & 15, cc = c & 31, ob = rr * 64 + cc * 2; return st * 1024 + (ob ^ (((ob >> 9) & 1) << 5)); }
__host__ __device__ __forceinline__ void stage_rc(int b, int& R, int& C) { const int st = b / 1024, sb = b % 1024, swz = sb ^ (((sb >> 9) & 1) << 5); R = (st >> 1) * 16 + swz / 64; C = (st & 1) * 32 + (swz % 64) / 2; }
__host__ __device__ __forceinline__ int perm32(int rho) { const int n = rho >> 4, i = rho & 15; return 8 * (i >> 2) + 4 * n + (i & 3); }

struct Unit { const char* A; const char* B; int i0, i1, i2, i3; };
__device__ __forceinline__ int xcd_remap(int L, int nwg) { const int q = nwg / 8, r = nwg % 8, xcd = L % 8, off = L / 8; return (xcd < r ? xcd * (q + 1) : r * (q + 1) + (xcd - r) * q) + off; }

template <class Epi, class Sched, bool ALIGN_EPI, bool GATHER>
__device__ __forceinline__ void gemm_phase(LAS unsigned char* lds, const int lda, const int ldb, const int K, const Sched& S, const Epi& E) {
    const int tid = threadIdx.x, wid = __builtin_amdgcn_readfirstlane(tid >> 6), lane = tid & 63, wr = wid >> 2, wc = wid & 3, fr = lane & 15, fq = lane >> 4;
    const int nt = K / BK;
    unsigned voffA[2], voffB[2]; int RA[2], CA[2];
#pragma unroll
    for (int i = 0; i < 2; ++i) { int R, C; stage_rc(tid * 16 + i * 8192, R, C); const int Rb = 64 * (R >> 5) + (Epi::PERM ? perm32(R & 31) : (R & 31));
        RA[i] = R; CA[i] = C; voffA[i] = (unsigned)(R * lda + C) * 2u; voffB[i] = (unsigned)(Rb * ldb + C) * 2u; }
    const size_t kstep = (size_t)(BK * 2);
    const size_t hstepA = (size_t)HALF * lda * 2, hstepB = (size_t)32 * ldb * 2;
    const unsigned ldsw = (unsigned)wid * 1024u;
    const int aoff = lds_byte(wr * 64 + fr, fq * 8), boff = lds_byte(wc * 32 + fr, fq * 8);
#define PG8_SA(b, h) (((b) * 2 + (h)) * HTB)
#define PG8_SB(b, h) ((4 + (b) * 2 + (h)) * HTB)
#define PG8_STAGE(bufoff, gbase, voff) do { _Pragma("unroll") for (int _i = 0; _i < 2; ++_i) \
        __builtin_amdgcn_global_load_lds((const unsigned*)((const char*)(gbase) + (voff)[_i]), (LAS unsigned*)(lds + (bufoff) + ldsw + _i * 8192), 16, 0, 0); } while (0)
#define PG8_STAGE_A(bufoff, base, g0, g1, h, kb) do { if constexpr (GATHER) { \
        __builtin_amdgcn_global_load_lds((const unsigned*)((base) + (kb) + (g0)), (LAS unsigned*)(lds + (bufoff) + ldsw), 16, 0, 0); \
        __builtin_amdgcn_global_load_lds((const unsigned*)((base) + (kb) + (g1)), (LAS unsigned*)(lds + (bufoff) + ldsw + 8192), 16, 0, 0); } \
      else { PG8_STAGE(bufoff, (base) + (h) * hstepA + (kb), voffA); } } while (0)
#define PG8_LDA(dst, b, h) do { _Pragma("unroll") for (int m = 0; m < 4; ++m) _Pragma("unroll") for (int k = 0; k < 2; ++k) dst[m][k] = *(const LAS bf16x8*)(lds + PG8_SA(b, h) + aoff + m * 2048 + k * 1024); } while (0)
#define PG8_LDB(dst, b, h) do { _Pragma("unroll") for (int n = 0; n < 2; ++n) _Pragma("unroll") for (int k = 0; k < 2; ++k) dst[n][k] = *(const LAS bf16x8*)(lds + PG8_SB(b, h) + boff + n * 2048 + k * 1024); } while (0)
#define PG8_MMA(ai, bj, At, Bt) do { __builtin_amdgcn_s_setprio(1); _Pragma("unroll") for (int m = 0; m < 4; ++m) _Pragma("unroll") for (int n = 0; n < 2; ++n) _Pragma("unroll") for (int k = 0; k < 2; ++k) \
        acc[ai][bj][m][n] = __builtin_amdgcn_mfma_f32_16x16x32_bf16(Bt[n][k], At[m][k], acc[ai][bj][m][n], 0, 0, 0); __builtin_amdgcn_s_setprio(0); } while (0)
#define PG8_WAIT_V(n) asm volatile("s_waitcnt vmcnt(" #n ")" ::: "memory")
#define PG8_WAIT_L(n) asm volatile("s_waitcnt lgkmcnt(" #n ")" ::: "memory")
#define PG8_BAR __builtin_amdgcn_s_barrier()
#define PG8_SCHED __builtin_amdgcn_sched_barrier(0)
    Unit cur, nxt; int ui = 0;
    if (!S.next(0, cur)) return;
    unsigned gc00 = 0, gc01 = 0, gc10 = 0, gc11 = 0, gn00 = 0, gn01 = 0, gn10 = 0, gn11 = 0;
    if constexpr (GATHER) { S.gather(cur, RA[0], CA[0], RA[1], CA[1], gc00, gc01, gc10, gc11); gn00 = gc00; gn01 = gc01; gn10 = gc10; gn11 = gc11; }
    f32x4 acc[2][2][4][2];
#pragma unroll
    for (int a = 0; a < 2; ++a)
#pragma unroll
        for (int b = 0; b < 2; ++b)
#pragma unroll
            for (int m = 0; m < 4; ++m)
#pragma unroll
                for (int n = 0; n < 2; ++n) acc[a][b][m][n] = (f32x4){0.f, 0.f, 0.f, 0.f};
    bf16x8 At[4][2], B0[2][2], B1[2][2];
    const char* cA = cur.A; const char* cB = cur.B;
    PG8_STAGE(PG8_SB(0, 0), cB, voffB); PG8_STAGE(PG8_SB(0, 1), cB + hstepB, voffB); PG8_STAGE_A(PG8_SA(0, 0), cA, gc00, gc01, 0, 0); PG8_STAGE_A(PG8_SA(0, 1), cA, gc10, gc11, 1, 0);
    if (wr == 1) PG8_BAR;
    PG8_WAIT_V(2); PG8_BAR;
    PG8_STAGE(PG8_SB(1, 0), cB + kstep, voffB); PG8_STAGE_A(PG8_SA(1, 0), cA, gc00, gc01, 0, kstep); PG8_STAGE(PG8_SB(1, 1), cB + hstepB + kstep, voffB);
    PG8_WAIT_V(6); PG8_BAR;
    for (;;) {
        const bool has_next = S.next(ui + 1, nxt);
        if constexpr (GATHER) { if (has_next) S.gather(nxt, RA[0], CA[0], RA[1], CA[1], gn00, gn01, gn10, gn11); }
        const char* nA = has_next ? nxt.A : cA; const char* nB = has_next ? nxt.B : cB;
#pragma unroll 1
        for (int t = 0; t < nt; t += 2) {
            const bool last = (t == nt - 2);
            const size_t k1 = (size_t)(t + 1) * kstep;
            const char* a2 = last ? nA : cA; const char* b2 = last ? nB : cB + (size_t)(t + 2) * kstep;
            const size_t k2 = last ? 0 : (size_t)(t + 2) * kstep, k3 = k2 + kstep;
            const char* b3 = b2 + kstep;
            unsigned g200 = gc00, g201 = gc01, g210 = gc10, g211 = gc11;
            if constexpr (GATHER) { if (last) { g200 = gn00; g201 = gn01; g210 = gn10; g211 = gn11; } }
            PG8_LDB(B0, 0, 0); PG8_LDB(B1, 0, 1); PG8_SCHED; PG8_LDA(At, 0, 0); PG8_STAGE_A(PG8_SA(1, 1), cA, gc10, gc11, 1, k1);
            PG8_WAIT_V(8); PG8_WAIT_L(0); PG8_BAR; PG8_MMA(0, 0, At, B0); PG8_MMA(0, 1, At, B1); PG8_BAR; PG8_SCHED;
            PG8_LDA(At, 0, 1); PG8_STAGE(PG8_SB(0, 0), b2, voffB); PG8_STAGE(PG8_SB(0, 1), b2 + hstepB, voffB); PG8_STAGE_A(PG8_SA(0, 0), a2, g200, g201, 0, k2);
            PG8_WAIT_V(8); PG8_WAIT_L(0); PG8_BAR; PG8_MMA(1, 0, At, B0); PG8_MMA(1, 1, At, B1); PG8_BAR; PG8_SCHED;
            PG8_LDB(B0, 1, 0); PG8_LDB(B1, 1, 1); PG8_SCHED; PG8_LDA(At, 1, 0); PG8_STAGE_A(PG8_SA(0, 1), a2, g210, g211, 1, k2);
            PG8_WAIT_V(8); PG8_WAIT_L(0); PG8_BAR; PG8_MMA(0, 0, At, B0); PG8_MMA(0, 1, At, B1); PG8_BAR; PG8_SCHED;
            PG8_LDA(At, 1, 1); PG8_STAGE(PG8_SB(1, 0), b3, voffB); PG8_STAGE(PG8_SB(1, 1), b3 + hstepB, voffB); PG8_STAGE_A(PG8_SA(1, 0), a2, g200, g201, 0, k3);
            PG8_WAIT_V(8); PG8_WAIT_L(0); PG8_BAR; PG8_MMA(1, 0, At, B0); PG8_MMA(1, 1, At, B1); PG8_BAR; PG8_SCHED;
        }
        if constexpr (ALIGN_EPI) { if (wr == 0) PG8_BAR; }
        E(acc, cur, wr, wc, fr, fq);
        if (!has_next) break;
#pragma unroll
        for (int a = 0; a < 2; ++a)
#pragma unroll
            for (int b = 0; b < 2; ++b)
#pragma unroll
                for (int m = 0; m < 4; ++m)
#pragma unroll
                    for (int n = 0; n < 2; ++n) acc[a][b][m][n] = (f32x4){0.f, 0.f, 0.f, 0.f};
        cur = nxt; cA = nA; cB = nB; ++ui;
        if constexpr (GATHER) { gc00 = gn00; gc01 = gn01; gc10 = gn10; gc11 = gn11; }
        if constexpr (ALIGN_EPI) { if (wr == 1) PG8_BAR; }
    }
    PG8_WAIT_V(0);
    if constexpr (!ALIGN_EPI) { if (wr == 0) PG8_BAR; }
    PG8_BAR;
#undef PG8_SA
#undef PG8_SB
#undef PG8_STAGE
#undef PG8_STAGE_A
#undef PG8_LDA
#undef PG8_LDB
#undef PG8_MMA
#undef PG8_WAIT_V
#undef PG8_WAIT_L
#undef PG8_BAR
#undef PG8_SCHED
}
}
namespace fx {
#define FX_ROWLOOP _Pragma("unroll") for (int ai = 0; ai < 2; ++ai) _Pragma("unroll") for (int m = 0; m < 4; ++m)

struct PlainOrder {
    const char* A; const char* B; int lda, ldb, nM, nN, nwg, G, c;
    __device__ void init(const void* A_, int lda_, const void* B_, int ldb_, int M, int N, int G_, int c_) { A = (const char*)A_; B = (const char*)B_; lda = lda_; ldb = ldb_; nM = M / 256; nN = N / 256; nwg = nM * nN; G = G_; c = c_; }
    __device__ __forceinline__ bool next(int i, Unit& u) const {
        const long L = (long)i * G + c; if (L >= nwg) return false;
        const int wgid = xcd_remap((int)L, nwg);
        const int nig = 8 * nN, gid = wgid / nig, fm = gid * 8, gsz = (nM - fm) < 8 ? (nM - fm) : 8;
        const int pm = fm + ((wgid % nig) % gsz), pn = (wgid % nig) / gsz;
        u.A = A + (size_t)pm * 256 * lda * 2; u.B = B + (size_t)pn * 256 * ldb * 2; u.i0 = pm; u.i1 = pn; u.i2 = 0; u.i3 = 0; return true;
    }
};
struct GroupOrder {
    const char* A; const char* B; int ldb, nN, nwg, G, c;
    __device__ void init(const void* A_, const void* B_, int ldb_, int nN_, int G_, int c_) { A = (const char*)A_; B = (const char*)B_; ldb = ldb_; nN = nN_; nwg = 32 * 8 * nN_; G = G_; c = c_; }
    __device__ __forceinline__ bool next(int i, Unit& u) const {
        const long L = (long)i * G + c; if (L >= nwg) return false;
        const int wgid = xcd_remap((int)L, nwg);
        const int per = 8 * nN, g = wgid / per, rem = wgid % per, pm = rem % 8, pn = rem / 8;
        u.A = A + ((size_t)g * UHR + (size_t)pm * 256) * UHK * 2; u.B = B + ((size_t)g * nN * 256 + (size_t)pn * 256) * ldb * 2; u.i0 = g; u.i1 = pm; u.i2 = pn; u.i3 = 0; return true;
    }
};

__device__ __forceinline__ void rope8(f32x4& v0, f32x4& v1, const float* __restrict__ ropec, const float* __restrict__ ropes, int pos, int fq) {
    const f32x4 c = *(const f32x4*)(ropec + pos * 16 + 4 * fq), s = *(const f32x4*)(ropes + pos * 16 + 4 * fq);
    const f32x4 a = v0, b = v1;
    v0 = (f32x4){a[0] * c[0] - a[1] * s[0], a[0] * s[0] + a[1] * c[0], a[2] * c[1] - a[3] * s[1], a[2] * s[1] + a[3] * c[1]};
    v1 = (f32x4){b[0] * c[2] - b[1] * s[2], b[0] * s[2] + b[1] * c[2], b[2] * c[3] - b[3] * s[3], b[2] * s[3] + b[3] * c[3]};
}
__device__ __forceinline__ float sumsq8(const f32x4 a, const f32x4 b) { return (a[0] * a[0] + a[1] * a[1]) + (a[2] * a[2] + a[3] * a[3]) + (b[0] * b[0] + b[1] * b[1]) + (b[2] * b[2] + b[3] * b[3]); }

struct EpiWin {
    static constexpr bool PERM = true;
    bf16_t* UH; bf16_t* CQ; bf16_t* CKVR; float* ssqq; float* ssqkv; const float* ropec; const float* ropes;
    __device__ __forceinline__ void operator()(const f32x4 (&acc)[2][2][4][2], const Unit& u, int wr, int wc, int fr, int fq) const {
        const int pm = u.i0, pn = u.i1, row0 = pm * 256 + wr * 64 + fr;
        if (pn < 2) {
            FX_ROWLOOP { const int row = row0 + ai * 128 + m * 16, r32 = row >> 5, tq = row & 31;
#pragma unroll
                for (int bj = 0; bj < 2; ++bj) { const int c = pn * 256 + wc * 64 + bj * 32 + 8 * fq, g = c >> 4, p0 = c & 15;
                    *(u32x4*)(UH + ((size_t)(g * UHR + r32) * UHK + tq * 16 + p0)) = pack8(acc[ai][bj][m][0], acc[ai][bj][m][1]); } }
        } else if (pn == 2) {
            FX_ROWLOOP { const int row = row0 + ai * 128 + m * 16; float ss = 0.f;
#pragma unroll
                for (int bj = 0; bj < 2; ++bj) { const int c = wc * 64 + bj * 32 + 8 * fq;
                    *(u32x4*)(CQ + (size_t)row * 256 + c) = pack8(acc[ai][bj][m][0], acc[ai][bj][m][1]); ss += sumsq8(acc[ai][bj][m][0], acc[ai][bj][m][1]); }
                ss += __shfl_xor(ss, 16); ss += __shfl_xor(ss, 32);
                if (fq == 0) ssqq[(size_t)row * 4 + wc] = ss; }
        } else {
            FX_ROWLOOP { const int row = row0 + ai * 128 + m * 16; float ss = 0.f;
#pragma unroll
                for (int bj = 0; bj < 2; ++bj) { const int c = wc * 64 + bj * 32 + 8 * fq; f32x4 v0 = acc[ai][bj][m][0], v1 = acc[ai][bj][m][1];
                    if (wc < 2) ss += sumsq8(v0, v1);
                    if (wc == 2 && bj == 0) rope8(v0, v1, ropec, ropes, row & (SEQ - 1), fq);
                    *(u32x4*)(CKVR + (size_t)row * 256 + c) = pack8(v0, v1); }
                ss += __shfl_xor(ss, 16); ss += __shfl_xor(ss, 32);
                if (fq == 0) ssqkv[(size_t)row * 4 + wc] = ss; }
        }
    }
};
struct EpiQ {
    static constexpr bool PERM = true;
    bf16_t* Q; const float* ssqq; const float* ropec; const float* ropes;
    __device__ __forceinline__ void operator()(const f32x4 (&acc)[2][2][4][2], const Unit& u, int wr, int wc, int fr, int fq) const {
        const int pm = u.i0, pn = u.i1, row0 = pm * 256 + wr * 64 + fr;
        FX_ROWLOOP { const int row = row0 + ai * 128 + m * 16; const f32x4 s4 = *(const f32x4*)(ssqq + (size_t)row * 4);
            const float rs = __builtin_amdgcn_rsqf(((s4[0] + s4[1]) + (s4[2] + s4[3])) * (1.f / 256.f) + RMS_EPS) * QSCALE;
#pragma unroll
            for (int bj = 0; bj < 2; ++bj) { const int G = 8 * pn + 2 * wc + bj, c = 256 * pn + 64 * wc + 32 * bj + 8 * fq;
                f32x4 v0 = acc[ai][bj][m][0] * rs, v1 = acc[ai][bj][m][1] * rs;
                if (G % 3 == 2) rope8(v0, v1, ropec, ropes, row & (SEQ - 1), fq);
                *(u32x4*)(Q + (size_t)row * 768 + c) = pack8(v0, v1); } }
    }
};
struct EpiKV {
    static constexpr bool PERM = true;
    bf16_t* KV; const float* ssqkv;
    __device__ __forceinline__ void operator()(const f32x4 (&acc)[2][2][4][2], const Unit& u, int wr, int wc, int fr, int fq) const {
        const int pm = u.i0, pn = u.i1, row0 = pm * 256 + wr * 64 + fr;
        FX_ROWLOOP { const int row = row0 + ai * 128 + m * 16; const f32x4 s4 = *(const f32x4*)(ssqkv + (size_t)row * 4);
            const float rs = __builtin_amdgcn_rsqf(((s4[0] + s4[1]) + (s4[2] + s4[3])) * (1.f / 128.f) + RMS_EPS);
#pragma unroll
            for (int bj = 0; bj < 2; ++bj) { const int c = 256 * pn + 64 * wc + 32 * bj + 8 * fq;
                *(u32x4*)(KV + (size_t)row * 1024 + c) = pack8(acc[ai][bj][m][0] * rs, acc[ai][bj][m][1] * rs); } }
    }
};
struct EpiSt {
    static constexpr bool PERM = false;
    float* S;
    __device__ __forceinline__ void operator()(const f32x4 (&acc)[2][2][4][2], const Unit& u, int wr, int wc, int fr, int fq) const {
        const int g = u.i0, pm = u.i1, row0 = pm * 256 + wr * 64 + fr;
        FX_ROWLOOP { const int R = row0 + ai * 128 + m * 16; float* rp = S + ((size_t)g * UHR + R) * 256 + wc * 64 + 4 * fq;
#pragma unroll
            for (int bj = 0; bj < 2; ++bj)
#pragma unroll
                for (int n = 0; n < 2; ++n) *(f32x4*)(rp + bj * 32 + n * 16) = acc[ai][bj][m][n]; }
    }
};
struct EpiSsmOut {
    static constexpr bool PERM = true;
    const bf16_t* UH; bf16_t* SPRE; const float* dskip;
    __device__ __forceinline__ void operator()(const f32x4 (&acc)[2][2][4][2], const Unit& u, int wr, int wc, int fr, int fq) const {
        const int g = u.i0, pm = u.i1, pn = u.i2, row0 = pm * 256 + wr * 64 + fr;
        const int p0 = 8 * (fq & 1);
        const f32x4 d0 = *(const f32x4*)(dskip + g * 16 + p0), d1 = *(const f32x4*)(dskip + g * 16 + p0 + 4);
        FX_ROWLOOP { const int R = row0 + ai * 128 + m * 16;
#pragma unroll
            for (int bj = 0; bj < 2; ++bj) { const int c = 256 * pn + 64 * wc + 32 * bj + 8 * fq, tq = c >> 4;
                const u32x4 uw = *(const u32x4*)(UH + ((size_t)g * UHR + R) * UHK + c); f32x4 u0, u1; unpack8(uw, u0, u1);
                f32x4 y0 = acc[ai][bj][m][0] + u0 * d0, y1 = acc[ai][bj][m][1] + u1 * d1;
#pragma unroll
                for (int j = 0; j < 4; ++j) { y0[j] = gelu_tanh_f(y0[j]); y1[j] = gelu_tanh_f(y1[j]); }
                *(u32x4*)(SPRE + ((size_t)R * 32 + tq) * 512 + g * 16 + p0) = pack8(y0, y1); } }
    }
};
struct EpiGlu {
    static constexpr bool PERM = true;
    const bf16_t* SPRE; bf16_t* MIX; const float* bglu;
    __device__ __forceinline__ void operator()(const f32x4 (&acc)[2][2][4][2], const Unit& u, int wr, int wc, int fr, int fq) const {
        const int pm = u.i0, pn = u.i1, row0 = pm * 256 + wr * 64 + fr;
#pragma unroll
        for (int bj = 0; bj < 2; ++bj) { const int c = 256 * pn + 64 * wc + 32 * bj + 8 * fq;
            const f32x4 b0 = *(const f32x4*)(bglu + c), b1 = *(const f32x4*)(bglu + c + 4);
            FX_ROWLOOP { const int row = row0 + ai * 128 + m * 16;
                const u32x4 sw = *(const u32x4*)(SPRE + (size_t)row * 512 + c); f32x4 s0, s1; unpack8(sw, s0, s1);
                f32x4 z0 = acc[ai][bj][m][0] + b0, z1 = acc[ai][bj][m][1] + b1;
#pragma unroll
                for (int j = 0; j < 4; ++j) { z0[j] = s0[j] * fast_sigmoid(z0[j]); z1[j] = s1[j] * fast_sigmoid(z1[j]); }
                *(u32x4*)(MIX + (size_t)row * 1024 + c) = pack8(z0, z1); } }
    }
};
struct EpiWo {
    static constexpr bool PERM = true;
    const float* X; bf16_t* Y;
    __device__ __forceinline__ void operator()(const f32x4 (&acc)[2][2][4][2], const Unit& u, int wr, int wc, int fr, int fq) const {
        const int pm = u.i0, pn = u.i1, row0 = pm * 256 + wr * 64 + fr;
        FX_ROWLOOP { const size_t off = (size_t)(row0 + ai * 128 + m * 16) * 1024 + 256 * pn + wc * 64 + 8 * fq;
#pragma unroll
            for (int bj = 0; bj < 2; ++bj) { const f32x4 x0 = *(const f32x4*)(X + off + bj * 32), x1 = *(const f32x4*)(X + off + bj * 32 + 4);
                *(u32x4*)(Y + off + bj * 32) = pack8(x0 * ALPHA + acc[ai][bj][m][0], x1 * ALPHA + acc[ai][bj][m][1]); } }
    }
};
struct EpiRouter {
    static constexpr bool PERM = false;
    float* LG;
    __device__ __forceinline__ void operator()(const f32x4 (&acc)[2][2][4][2], const Unit& u, int wr, int wc, int fr, int fq) const {
        if (wc != 0) return;
        const int pm = u.i0, row0 = pm * 256 + wr * 64 + fr;
        FX_ROWLOOP { float* rp = LG + (size_t)(row0 + ai * 128 + m * 16) * 64 + 4 * fq;
#pragma unroll
            for (int bj = 0; bj < 2; ++bj)
#pragma unroll
            for (int n = 0; n < 2; ++n) *(f32x4*)(rp + bj * 32 + n * 16) = acc[ai][bj][m][n]; }
    }
};

struct MoeTab { LAS int* tbase; LAS unsigned* tab; };
__device__ __forceinline__ MoeTab moe_tab(LAS unsigned char* lds) { MoeTab t; t.tbase = (LAS int*)(lds + TAB_OFF); t.tab = (LAS unsigned*)(lds + TAB_OFF + 2304); return t; }
__device__ __forceinline__ int ve_count(const unsigned* ctl, int ve) { return (ve % 65 == 64) ? CAPC : (int)__hip_atomic_load(ctl + CW_CNT + 64 * ve, __ATOMIC_RELAXED, __HIP_MEMORY_SCOPE_AGENT); }
__device__ __forceinline__ void moe_build_tab(LAS unsigned char* lds, const unsigned* ctl) {
    const MoeTab t = moe_tab(lds); LAS int* nt = (LAS int*)(lds + TAB_OFF + 1024 + 64);
    const int tid = threadIdx.x;
    if (tid < NVE) nt[tid] = (ve_count(ctl, tid) + 255) >> 8;
    __syncthreads();
    if (tid == 0) { int s = 0; for (int v = 0; v < NVE; ++v) { t.tbase[v] = s; s += nt[v]; } t.tbase[NVE] = s; }
    __syncthreads();
    for (int v = tid; v < NVE; v += 512) { const int b = t.tbase[v], n = t.tbase[v + 1] - b; for (int j = 0; j < n; ++j) t.tab[b + j] = (unsigned)v | ((unsigned)j << 16); }
    __syncthreads();
}
struct GateUpOrder {
    const char* X1B; const char* WGU; const int* rowtok; const unsigned* ctl; MoeTab tb; int nunits, G, c;
    __device__ void init(const void* x1b, const void* wgu, const int* rt, const unsigned* ctl_, MoeTab tb_, int G_, int c_) { X1B = (const char*)x1b; WGU = (const char*)wgu; rowtok = rt; ctl = ctl_; tb = tb_; nunits = 2 * tb_.tbase[NVE]; G = G_; c = c_; }
    __device__ __forceinline__ bool next(int i, Unit& u) const {
        const long L = (long)i * G + c; if (L >= nunits) return false;
        const int wgid = xcd_remap((int)L, nunits), tile = wgid >> 1, pn = wgid & 1;
        const unsigned e = tb.tab[tile]; const int ve = (int)(e & 0xffffu), tix = (int)(e >> 16), ex = ve % 65;
        u.A = X1B; u.B = WGU + ((size_t)ex * 512 + (size_t)pn * 256) * 1024 * 2; u.i0 = tile * 256; u.i1 = pn; u.i2 = ve; u.i3 = tix; return true;
    }
    __device__ __forceinline__ unsigned tok_of(int ve, int cnt, int slot) const {
        const int ch = ve / 65, ex = ve % 65;
        if (ex == 64) return (unsigned)(ch * CAPC + slot);
        return slot < cnt ? (unsigned)rowtok[(size_t)(ch * 64 + ex) * CAPC + slot] : (unsigned)(ch * CAPC);
    }
    __device__ __forceinline__ void gather(const Unit& u, int R0, int C0, int R1, int C1, unsigned& g00, unsigned& g01, unsigned& g10, unsigned& g11) const {
        const int ve = u.i2, cnt = ve_count(ctl, ve), s0 = u.i3 * 256;
        g00 = tok_of(ve, cnt, s0 + R0) * 2048u + (unsigned)C0 * 2u; g01 = tok_of(ve, cnt, s0 + R1) * 2048u + (unsigned)C1 * 2u;
        g10 = tok_of(ve, cnt, s0 + 128 + R0) * 2048u + (unsigned)C0 * 2u; g11 = tok_of(ve, cnt, s0 + 128 + R1) * 2048u + (unsigned)C1 * 2u;
    }
};
struct EpiGateUp {
    static constexpr bool PERM = true;
    bf16_t* H;
    __device__ __forceinline__ void operator()(const f32x4 (&acc)[2][2][4][2], const Unit& u, int wr, int wc, int fr, int fq) const {
        const int hrow0 = u.i0 + wr * 64 + fr, c = 128 * u.i1 + 32 * wc + 8 * fq;
        FX_ROWLOOP { f32x4 h0, h1;
#pragma unroll
            for (int j = 0; j < 4; ++j) { const float g0 = acc[ai][0][m][0][j], g1 = acc[ai][0][m][1][j];
                h0[j] = g0 * fast_sigmoid(g0) * acc[ai][1][m][0][j]; h1[j] = g1 * fast_sigmoid(g1) * acc[ai][1][m][1][j]; }
            *(u32x4*)(H + (size_t)(hrow0 + ai * 128 + m * 16) * 256 + c) = pack8(h0, h1); }
    }
};
struct DownOrder {
    const char* Hh; const char* WD; MoeTab tb; int t0, nunits, G, c;
    __device__ void init(const void* h, const void* wd, MoeTab tb_, int ch, int G_, int c_) { Hh = (const char*)h; WD = (const char*)wd; tb = tb_; t0 = tb_.tbase[ch * 65]; nunits = 4 * (tb_.tbase[(ch + 1) * 65] - t0); G = G_; c = c_; }
    __device__ __forceinline__ bool next(int i, Unit& u) const {
        const long L = (long)i * G + c; if (L >= nunits) return false;
        const int wgid = xcd_remap((int)L, nunits), tile = t0 + (wgid >> 2), pn = wgid & 3;
        const int ex = (int)(tb.tab[tile] & 0xffffu) % 65;
        u.A = Hh + (size_t)tile * 256 * 256 * 2; u.B = WD + ((size_t)ex * 1024 + (size_t)pn * 256) * 256 * 2; u.i0 = ex == 64 ? (int)(tb.tab[tile] >> 16) * 256 : (tile - t0) * 256; u.i1 = pn; u.i2 = ex == 64; u.i3 = 0; return true;
    }
};
constexpr float Y8_SCALE = 32.f, Y8_INV = 1.f / 32.f;
__device__ __forceinline__ u32x2 pack8_fp8(const f32x4 a, const f32x4 b) {
    int w0 = 0, w1 = 0;
    w0 = __builtin_amdgcn_cvt_pk_fp8_f32(a[0] * Y8_SCALE, a[1] * Y8_SCALE, w0, false); w0 = __builtin_amdgcn_cvt_pk_fp8_f32(a[2] * Y8_SCALE, a[3] * Y8_SCALE, w0, true);
    w1 = __builtin_amdgcn_cvt_pk_fp8_f32(b[0] * Y8_SCALE, b[1] * Y8_SCALE, w1, false); w1 = __builtin_amdgcn_cvt_pk_fp8_f32(b[2] * Y8_SCALE, b[3] * Y8_SCALE, w1, true);
    u32x2 r; r.x = (unsigned)w0; r.y = (unsigned)w1; return r;
}
__device__ __forceinline__ void unpack8_fp8(const u32x2 w, f32x4& a, f32x4& b) {
    const f32x2 p0 = __builtin_amdgcn_cvt_pk_f32_fp8((int)w.x, false), p1 = __builtin_amdgcn_cvt_pk_f32_fp8((int)w.x, true);
    const f32x2 p2 = __builtin_amdgcn_cvt_pk_f32_fp8((int)w.y, false), p3 = __builtin_amdgcn_cvt_pk_f32_fp8((int)w.y, true);
    a = (f32x4){p0.x, p0.y, p1.x, p1.y}; b = (f32x4){p2.x, p2.y, p3.x, p3.y};
}
struct EpiDown {
    static constexpr bool PERM = true;
    unsigned char* Y8; bf16_t* YS;
    __device__ __forceinline__ void operator()(const f32x4 (&acc)[2][2][4][2], const Unit& u, int wr, int wc, int fr, int fq) const {
        const int yrow0 = u.i0 + wr * 64 + fr, c0 = 256 * u.i1 + 64 * wc + 8 * fq;
        if (u.i2) {
            FX_ROWLOOP { bf16_t* rp = YS + (size_t)(yrow0 + ai * 128 + m * 16) * 1024 + c0;
#pragma unroll
                for (int bj = 0; bj < 2; ++bj) *(u32x4*)(rp + bj * 32) = pack8(acc[ai][bj][m][0], acc[ai][bj][m][1]); }
        } else {
            FX_ROWLOOP { unsigned char* rp = Y8 + (size_t)(yrow0 + ai * 128 + m * 16) * 1024 + c0;
#pragma unroll
                for (int bj = 0; bj < 2; ++bj) *(u32x2*)(rp + bj * 32) = pack8_fp8(acc[ai][bj][m][0], acc[ai][bj][m][1]); }
        }
    }
};
}
namespace fx {
namespace att {
constexpr int NW = 8, QBLK = 32, KVBLK = 64;
constexpr int SHM_V = 16384, SHM_K = 16384, SHM_ATTN = 2 * SHM_V + 2 * SHM_K + NW * 64 * 4;
constexpr float THRL = 8.f;
#define KSWZ(row, colB) ((row) * 256 + ((colB) ^ (((row) & 7) << 4)))
#define SBAR() __builtin_amdgcn_sched_barrier(0)
__device__ __forceinline__ int crow(int r, int hi) { return (r & 3) + 8 * (r >> 2) + 4 * hi; }
__device__ __forceinline__ void partialSM(f32x16& p0, f32x16& p1, float& m_reg, float& mn, float& alpha) {
  float pmax = p0[0];
#pragma unroll
  for (int r = 1; r < 16; ++r) pmax = fmaxf(pmax, p0[r]);
#pragma unroll
  for (int r = 0; r < 16; ++r) pmax = fmaxf(pmax, p1[r]);
  { auto rr = __builtin_amdgcn_permlane32_swap(__float_as_uint(pmax), __float_as_uint(pmax), false, false);
    pmax = fmaxf(__uint_as_float(rr[0]), __uint_as_float(rr[1])); }
  if (__builtin_expect(__all(pmax - m_reg <= THRL), 1)) { mn = m_reg; alpha = 1.f; }
  else { mn = fmaxf(m_reg, pmax); alpha = __builtin_amdgcn_exp2f(m_reg - mn); m_reg = mn; }
#pragma unroll
  for (int r = 0; r < 16; ++r) p0[r] = p0[r] - mn;
#pragma unroll
  for (int r = 0; r < 16; ++r) p1[r] = p1[r] - mn;
#pragma unroll
  for (int r = 0; r < 16; ++r) p0[r] = __builtin_amdgcn_exp2f(p0[r]);
}
__device__ __forceinline__ void finishSM(f32x16& p0, f32x16& p1, float alpha, float& l_reg, bf16x8& pa0, bf16x8& pa1, bf16x8& pa2, bf16x8& pa3) {
#pragma unroll
  for (int r = 0; r < 16; ++r) p1[r] = __builtin_amdgcn_exp2f(p1[r]);
  float ps = 0;
#pragma unroll
  for (int r = 0; r < 16; ++r) ps += p0[r];
#pragma unroll
  for (int r = 0; r < 16; ++r) ps += p1[r];
  { auto rr = __builtin_amdgcn_permlane32_swap(__float_as_uint(ps), __float_as_uint(ps), false, false);
    ps = __uint_as_float(rr[0]) + __uint_as_float(rr[1]); }
  l_reg = l_reg * alpha + ps;
#define PK4(P, BASE, OUT) do { unsigned a0 = cvt_pk_bf16(P[BASE + 0], P[BASE + 1]), a1 = cvt_pk_bf16(P[BASE + 2], P[BASE + 3]);   \
    unsigned b0 = cvt_pk_bf16(P[BASE + 4], P[BASE + 5]), b1 = cvt_pk_bf16(P[BASE + 6], P[BASE + 7]);                              \
    auto r0 = __builtin_amdgcn_permlane32_swap(a0, b0, false, false); auto r1 = __builtin_amdgcn_permlane32_swap(a1, b1, false, false); \
    u32x4 w = {r0[0], r1[0], r0[1], r1[1]}; OUT = *reinterpret_cast<bf16x8*>(&w); } while (0)
  PK4(p0, 0, pa0); PK4(p0, 8, pa1); PK4(p1, 0, pa2); PK4(p1, 8, pa3);
#undef PK4
}
__device__ __forceinline__ void qkt(f32x16& p0, f32x16& p1, const char* Ks, const bf16x8 (&qr)[6], int r32, int hi) {
  p0 = f32x16{}; p1 = f32x16{};
#pragma unroll
  for (int d0 = 0; d0 < 6; ++d0) { const int cb = (d0 * 16 + hi * 8) * 2;
    const bf16x8 b0 = *reinterpret_cast<const bf16x8*>(Ks + KSWZ(r32, cb));
    const bf16x8 b1 = *reinterpret_cast<const bf16x8*>(Ks + KSWZ(32 + r32, cb));
    p0 = __builtin_amdgcn_mfma_f32_32x32x16_bf16(b0, qr[d0], p0, 0, 0, 0);
    p1 = __builtin_amdgcn_mfma_f32_32x32x16_bf16(b1, qr[d0], p1, 0, 0, 0); }
}
__device__ __forceinline__ int v_st(int k, int c) { const int kk = (k & ~0xC) | ((k & 4) << 1) | ((k & 8) >> 1); return ((kk >> 3) * 4 + (c >> 5)) * 512 + ((kk & 7) * 32 + (c & 31)) * 2; }
__device__ __forceinline__ int v_rd_base(int lane) { return ((lane & 3) << 3) | (((lane >> 2) & 3) << 6) | (((lane >> 4) & 1) << 5) | (((lane >> 5) & 1) << 8); }
constexpr int v_rd_off(int d0, int ks, int half) { return d0 * 512 + ks * 4096 + half * 2048; }
template <int OFF> __device__ __forceinline__ s16x4 tr_read(int vb) {
  s16x4 r; asm volatile("ds_read_b64_tr_b16 %0, %1 offset:%2" : "=&v"(r) : "v"(vb), "i"(OFF) : "memory"); return r;
}
template <int D0> __device__ __forceinline__ void pv_one(f32x16& od, int vb, bf16x8 pa0, bf16x8 pa1, bf16x8 pa2, bf16x8 pa3) {
  const s16x4 l0 = tr_read<v_rd_off(D0, 0, 0)>(vb), h0 = tr_read<v_rd_off(D0, 0, 1)>(vb), l1 = tr_read<v_rd_off(D0, 1, 0)>(vb), h1 = tr_read<v_rd_off(D0, 1, 1)>(vb);
  const s16x4 l2 = tr_read<v_rd_off(D0, 2, 0)>(vb), h2 = tr_read<v_rd_off(D0, 2, 1)>(vb), l3 = tr_read<v_rd_off(D0, 3, 0)>(vb), h3 = tr_read<v_rd_off(D0, 3, 1)>(vb);
  asm volatile("s_waitcnt lgkmcnt(0)" ::: "memory"); SBAR();
#define PK(L, H) (bf16x8){L[0], L[1], L[2], L[3], H[0], H[1], H[2], H[3]}
  od = __builtin_amdgcn_mfma_f32_32x32x16_bf16(pa0, PK(l0, h0), od, 0, 0, 0);
  od = __builtin_amdgcn_mfma_f32_32x32x16_bf16(pa1, PK(l1, h1), od, 0, 0, 0);
  od = __builtin_amdgcn_mfma_f32_32x32x16_bf16(pa2, PK(l2, h2), od, 0, 0, 0);
  od = __builtin_amdgcn_mfma_f32_32x32x16_bf16(pa3, PK(l3, h3), od, 0, 0, 0);
#undef PK
}
__device__ __forceinline__ void pv_d0(f32x16 (&o)[2], int vb, bf16x8 pa0, bf16x8 pa1, bf16x8 pa2, bf16x8 pa3) {
  pv_one<0>(o[0], vb, pa0, pa1, pa2, pa3); pv_one<1>(o[1], vb, pa0, pa1, pa2, pa3);
}
__device__ __forceinline__ void attn_unit(const unsigned char* __restrict__ wsb, const bf16_t* __restrict__ Q, bf16_t* __restrict__ MIX, int tok0, int qrow0, int h, char* lds) {
  const int tid = threadIdx.x, wid = tid >> 6, lane = tid & 63, r32 = lane & 31, hi = lane >> 5;
  char* V_lds = lds; char* K_lds = lds + 2 * SHM_V;
  float* ws = (float*)(lds + 2 * SHM_V + 2 * SHM_K) + wid * 64; float* li_l = ws; float* al_l = ws + 32;
  float m_reg = -1e30f, l_reg = 0; f32x16 o[2] = {}; bf16x8 qr[6];
  const bf16_t* Qw = Q + (size_t)(tok0 + qrow0 + wid * QBLK + r32) * 768 + h * 96 + hi * 8;
#pragma unroll
  for (int d0 = 0; d0 < 6; ++d0) qr[d0] = *reinterpret_cast<const bf16x8*>(Qw + d0 * 16);
  const int sr = tid >> 4, c16 = tid & 15, sc = c16 * 8, vst0 = v_st(sr, sc), vst1 = v_st(32 + sr, sc);
  const int vb0 = (int)(uintptr_t)V_lds + v_rd_base(lane);
  const unsigned vofs = (unsigned)WS_KV + (unsigned)(((tok0 + sr) * 1024 + h * 128 + 64 + (c16 & 7) * 8) * 2);
  const unsigned kinc = c16 < 8 ? 64u * 2048u : 64u * 512u;
  const unsigned kofs = (c16 < 8 ? (unsigned)WS_KV + (unsigned)((tok0 * 1024 + h * 128 + c16 * 8) * 2) : (unsigned)WS_CKVR + (unsigned)((tok0 * 256 + 128 + (c16 - 8) * 8) * 2)) + (unsigned)sr * (kinc >> 6);
  struct { bf16x8 vs0, vs1, ks0, ks1; } sr_[2];
#define SLOAD(i, k0) do { const unsigned vo_ = vofs + (unsigned)(k0) * 2048u, ko_ = kofs + (unsigned)((k0) >> 6) * kinc; \
    sr_[i].vs0 = *reinterpret_cast<const bf16x8*>(wsb + vo_); sr_[i].vs1 = *reinterpret_cast<const bf16x8*>(wsb + vo_ + 32u * 2048u); \
    sr_[i].ks0 = *reinterpret_cast<const bf16x8*>(wsb + ko_); sr_[i].ks1 = *reinterpret_cast<const bf16x8*>(wsb + ko_ + (kinc >> 1)); } while (0)
#define SWRITE(b, i) do { *(bf16x8*)(V_lds + (b) * SHM_V + vst0) = sr_[i].vs0;          \
    *(bf16x8*)(V_lds + (b) * SHM_V + vst1) = sr_[i].vs1; const int kc = sc * 2;               \
    *(bf16x8*)(K_lds + (b) * SHM_K + KSWZ(sr, kc)) = sr_[i].ks0;                       \
    *(bf16x8*)(K_lds + (b) * SHM_K + KSWZ(32 + sr, kc)) = sr_[i].ks1; } while (0)
#define SWAIT() asm volatile("s_waitcnt vmcnt(4)" ::: "memory")
#define RESC(a) do { if (__any((a) < 1.f)) { if (hi == 0) al_l[r32] = (a); asm volatile("s_waitcnt lgkmcnt(0)" ::: "memory"); \
    _Pragma("unroll") for (int d = 0; d < 2; ++d) _Pragma("unroll") for (int r = 0; r < 16; ++r) o[d][r] *= al_l[crow(r, hi)]; } } while (0)
  f32x16 pA0, pA1, pB0, pB1; float mnA, mnB, alA, alB; bf16x8 pa0, pa1, pa2, pa3; constexpr int NT = SEQ / KVBLK;
  constexpr int SE = 0, SO = 1;
  SLOAD(SE, 0); asm volatile("s_waitcnt vmcnt(0)" ::: "memory"); SWRITE(0, SE); __syncthreads();
  qkt(pA0, pA1, K_lds, qr, r32, hi); partialSM(pA0, pA1, m_reg, mnA, alA);
  SLOAD(SO, KVBLK); SLOAD(SE, 2 * KVBLK);
  SWAIT(); SWRITE(1, SO); __syncthreads();
  for (int j = 1; j + 1 < NT; j += 2) {
    SBAR(); qkt(pB0, pB1, K_lds + SHM_K, qr, r32, hi);
    finishSM(pA0, pA1, alA, l_reg, pa0, pa1, pa2, pa3); SBAR();
    SLOAD(SO, (j + 2) * KVBLK); SBAR();
    pv_d0(o, vb0, pa0, pa1, pa2, pa3); partialSM(pB0, pB1, m_reg, mnB, alB);
    __syncthreads(); SWAIT(); SWRITE(0, SE);
    RESC(alB); __syncthreads();
    SBAR(); qkt(pA0, pA1, K_lds, qr, r32, hi);
    finishSM(pB0, pB1, alB, l_reg, pa0, pa1, pa2, pa3); SBAR();
    if (j + 3 < NT) SLOAD(SE, (j + 3) * KVBLK); SBAR();
    pv_d0(o, vb0 + SHM_V, pa0, pa1, pa2, pa3); partialSM(pA0, pA1, m_reg, mnA, alA);
    __syncthreads(); SWAIT(); SWRITE(1, SO);
    RESC(alA); __syncthreads();
  }
  SBAR(); qkt(pB0, pB1, K_lds + SHM_K, qr, r32, hi);
  finishSM(pA0, pA1, alA, l_reg, pa0, pa1, pa2, pa3); SBAR();
  pv_d0(o, vb0, pa0, pa1, pa2, pa3); partialSM(pB0, pB1, m_reg, mnB, alB);
  __syncthreads(); RESC(alB);
  finishSM(pB0, pB1, alB, l_reg, pa0, pa1, pa2, pa3); SBAR();
  pv_d0(o, vb0 + SHM_V, pa0, pa1, pa2, pa3);
  if (hi == 0) li_l[r32] = l_reg; asm volatile("s_waitcnt lgkmcnt(0)" ::: "memory");
  bf16_t* Ow = MIX + (size_t)(tok0 + qrow0 + wid * QBLK) * 1024 + 512 + h * 64 + r32;
#pragma unroll
  for (int r = 0; r < 16; ++r) { const int orow = crow(r, hi); const float rl = __builtin_amdgcn_rcpf(li_l[orow]);
#pragma unroll
    for (int d0 = 0; d0 < 2; ++d0) Ow[(size_t)orow * 1024 + d0 * 32] = (bf16_t)(cvt_pk_bf16(o[d0][r] * rl, 0.f) & 0xffffu); }
  __syncthreads();
#undef SLOAD
#undef SWRITE
#undef SWAIT
#undef RESC
}
#undef KSWZ
#undef SBAR
}

struct Frame {
    LAS unsigned char* lds; unsigned* ctl; unsigned char* ws; float* out; const float* in[29];
    int tid, lane, wave, G, bid;
};
enum { I_X = 0, I_WIN, I_LRE, I_LIM, I_LDT, I_BRE, I_BIM, I_CRE, I_CIM, I_DSK, I_WGLU, I_BGLU, I_QG, I_WUQ, I_KVG, I_WUKV, I_WO, I_LN1G, I_LN1B, I_WR, I_RB, I_WEG, I_WEU, I_WED, I_WSG, I_WSU, I_WSD, I_LN2G, I_LN2B };

template <class F> __device__ __forceinline__ void transpose_item(const F& f, bf16_t* Bt, int ldk, int k0, int n0, LAS float* scr, int lane) {
#pragma unroll 8
    for (int i = 0; i < 32; ++i) { const int kk = 2 * i + (lane >> 5); scr[kk * 33 + (lane & 31)] = f(k0 + kk, n0 + (lane & 31)); }
    asm volatile("s_waitcnt lgkmcnt(0)" ::: "memory");
    const int c = lane & 7;
#pragma unroll
    for (int j = 0; j < 4; ++j) { const int n = (lane >> 3) + 8 * j; const LAS float* s = scr + (8 * c) * 33 + n;
        u32x4 o; o.x = cvt_pk_bf16(s[0 * 33], s[1 * 33]); o.y = cvt_pk_bf16(s[2 * 33], s[3 * 33]); o.z = cvt_pk_bf16(s[4 * 33], s[5 * 33]); o.w = cvt_pk_bf16(s[6 * 33], s[7 * 33]);
        *(u32x4*)(Bt + (size_t)(n0 + n) * ldk + k0 + 8 * c) = o; }
    asm volatile("s_waitcnt lgkmcnt(0)" ::: "memory");
}
__device__ __forceinline__ int rope_perm_src(int p) { return (p & 1) ? 16 + (p >> 1) : (p >> 1); }
struct SsmPar { float lr, li, dt, kr, ki; };
__device__ __forceinline__ SsmPar ssm_par(const float* lam_re, const float* lam_im, const float* log_dt, int d, int g, int n) {
    SsmPar p; p.lr = fminf(lam_re[(d * 32 + g) * 64 + n], -1e-4f); p.li = lam_im[(d * 32 + g) * 64 + n]; p.dt = expf(log_dt[d * 32 + g]);
    const float x = p.lr * p.dt, th = p.li * p.dt;
    const float em1 = expm1f(x), cs = cosf(th), sn = sinf(th), sh = sinf(0.5f * th);
    const float ai = (em1 + 1.f) * sn, arm1 = em1 * cs - 2.f * sh * sh, den = p.lr * p.lr + p.li * p.li;
    p.kr = (arm1 * p.lr + ai * p.li) / den; p.ki = (ai * p.lr - arm1 * p.li) / den; return p;
}
__device__ __forceinline__ void ssm_pow_xt(float x, float th, float e, float& pr, float& pi) {
    const float mag = __builtin_amdgcn_exp2f(x * e * 1.4426950408889634f); double trd = (double)th * (double)e * 0.15915494309189535; trd -= rint(trd); const float tr = (float)trd;
    pr = mag * __builtin_amdgcn_cosf(tr); pi = mag * __builtin_amdgcn_sinf(tr);
}
__device__ __forceinline__ void ssm_pow(const SsmPar& p, float e, float& pr, float& pi) { ssm_pow_xt(p.lr * p.dt, p.li * p.dt, e, pr, pi); }

__device__ __forceinline__ void p0_ssm_item(Frame& F, int g, int j) {
    LAS float* Pr = (LAS float*)F.lds;
    LAS float* Pi = Pr + 2 * 64 * 33;
    LAS float* Br = Pi + 2 * 64 * 33;
    LAS float* Bi = Br + 2 * 64 * 16;
    LAS float* Cr = Bi + 2 * 64 * 16;
    LAS float* Ci = Cr + 2 * 16 * 64;
    LAS float* Par = Ci + 2 * 16 * 64;
    const float* lam_re = F.in[I_LRE]; const float* lam_im = F.in[I_LIM]; const float* log_dt = F.in[I_LDT];
    __syncthreads();
    if (F.tid < 128) { const SsmPar p = ssm_par(lam_re, lam_im, log_dt, F.tid >> 6, g, F.tid & 63); Par[F.tid * 4] = p.lr * p.dt; Par[F.tid * 4 + 1] = p.li * p.dt; Par[F.tid * 4 + 2] = p.kr; Par[F.tid * 4 + 3] = p.ki; }
    for (int idx = F.tid; idx < 2 * 16 * 64; idx += 512) { const int n = idx & 63, pp = (idx >> 6) & 15, d = idx >> 10;
        Cr[idx] = F.in[I_CRE][((d * 32 + g) * 16 + pp) * 64 + n]; Ci[idx] = F.in[I_CIM][((d * 32 + g) * 16 + pp) * 64 + n]; }
    __syncthreads();
    for (int idx = F.tid; idx < 2 * 64 * 33; idx += 512) { const int tau = idx % 33, dn = idx / 33; float pr, pi; ssm_pow_xt(Par[dn * 4], Par[dn * 4 + 1], (float)tau, pr, pi); Pr[idx] = pr; Pi[idx] = pi; }
    for (int idx = F.tid; idx < 2 * 64 * 16; idx += 512) { const int q = idx & 15, dn = idx >> 4, n = dn & 63, d = dn >> 6; const float kr = Par[dn * 4 + 2], ki = Par[dn * 4 + 3];
        const float br = F.in[I_BRE][((d * 32 + g) * 64 + n) * 16 + q], bi = F.in[I_BIM][((d * 32 + g) * 64 + n) * 16 + q];
        Br[idx] = kr * br - ki * bi; Bi[idx] = kr * bi + ki * br; }
    __syncthreads();
    float* Kt = (float*)(F.ws + WS_KT) + (size_t)g * 16384;
    { const int blk = 512 * j + F.tid;
      const int q2 = blk & 7, p2 = (blk >> 3) & 7, tau = (blk >> 6) & 31, d = blk >> 11; float s00 = 0.f, s01 = 0.f, s10 = 0.f, s11 = 0.f;
      for (int n = 0; n < 64; ++n) { const float pr = Pr[(d * 64 + n) * 33 + tau], pi = Pi[(d * 64 + n) * 33 + tau];
          const float b0r = Br[(d * 64 + n) * 16 + 2 * q2], b0i = Bi[(d * 64 + n) * 16 + 2 * q2], b1r = Br[(d * 64 + n) * 16 + 2 * q2 + 1], b1i = Bi[(d * 64 + n) * 16 + 2 * q2 + 1];
          const float d0r = pr * b0r - pi * b0i, d0i = pr * b0i + pi * b0r, d1r = pr * b1r - pi * b1i, d1i = pr * b1i + pi * b1r;
          const float c0r = Cr[(d * 16 + 2 * p2) * 64 + n], c0i = Ci[(d * 16 + 2 * p2) * 64 + n], c1r = Cr[(d * 16 + 2 * p2 + 1) * 64 + n], c1i = Ci[(d * 16 + 2 * p2 + 1) * 64 + n];
          s00 += c0r * d0r - c0i * d0i; s01 += c0r * d1r - c0i * d1i; s10 += c1r * d0r - c1i * d0i; s11 += c1r * d1r - c1i * d1i; }
      float* kp = Kt + ((size_t)(d * 32 + tau) * 16 + 2 * p2) * 16 + 2 * q2; kp[0] = s00; kp[1] = s01; kp[16] = s10; kp[17] = s11; }
    bf16_t* Wst = (bf16_t*)(F.ws + WS_WST) + (size_t)g * 256 * 512;
    for (int pc = F.tid; pc < 32 * 64; pc += 512) { const int row = 32 * j + (pc >> 6), k0 = (pc & 63) * 8, s = k0 >> 4, q0 = k0 & 15;
        const int d = row >> 7, ri = (row >> 6) & 1, n = row & 63, e = d ? s : (CHK - 1 - s);
        const float pr = Pr[(d * 64 + n) * 33 + e], pi = Pi[(d * 64 + n) * 33 + e]; float v[8];
#pragma unroll
        for (int t = 0; t < 8; ++t) { const float br = Br[(d * 64 + n) * 16 + q0 + t], bi = Bi[(d * 64 + n) * 16 + q0 + t]; v[t] = ri ? (pr * bi + pi * br) : (pr * br - pi * bi); }
        u32x4 o; o.x = cvt_pk_bf16(v[0], v[1]); o.y = cvt_pk_bf16(v[2], v[3]); o.z = cvt_pk_bf16(v[4], v[5]); o.w = cvt_pk_bf16(v[6], v[7]);
        *(u32x4*)(Wst + (size_t)row * 512 + k0) = o; }
    bf16_t* Mo = (bf16_t*)(F.ws + WS_MO) + (size_t)g * 512 * UHK;
    for (int pc = F.tid; pc < 64 * 32; pc += 512) { const int row = 64 * j + (pc >> 5), kk = (pc & 31) * 8, d = kk >> 7, ri = (kk >> 6) & 1, n0 = kk & 63, tq = row >> 4, pp = row & 15;
        const int e = d ? (CHK - tq) : (tq + 1); float v[8];
#pragma unroll
        for (int t = 0; t < 8; ++t) { const int n = n0 + t; const float pr = Pr[(d * 64 + n) * 33 + e], pi = Pi[(d * 64 + n) * 33 + e], cr = Cr[(d * 16 + pp) * 64 + n], ci = Ci[(d * 16 + pp) * 64 + n];
            v[t] = ri ? -(cr * pi + ci * pr) : (cr * pr - ci * pi); }
        u32x4 o; o.x = cvt_pk_bf16(v[0], v[1]); o.y = cvt_pk_bf16(v[2], v[3]); o.z = cvt_pk_bf16(v[4], v[5]); o.w = cvt_pk_bf16(v[6], v[7]);
        *(u32x4*)(Mo + (size_t)row * UHK + 512 + kk) = o; }
}

__device__ __forceinline__ void p0_prologue(Frame& F) {
    for (int it = F.bid; it < 256; it += F.G) p0_ssm_item(F, it >> 3, it & 7);
    __syncthreads();
    { float* rc = (float*)(F.ws + WS_ROPE); float* rs = rc + 2048 * 16;
      for (int idx = F.bid * 512 + F.tid; idx < 2048 * 16; idx += F.G * 512) { const int i = idx & 15, pos = idx >> 4;
          const float inv = expf(-9.210340371976184f * (float)i * (1.f / 16.f)); const float a = (float)pos * inv; rc[idx] = cosf(a); rs[idx] = sinf(a); } }
    LAS float* scr = (LAS float*)(F.lds + F.wave * 16384);
    const int gw = F.bid * 8 + F.wave, NGW = F.G * 8;
    constexpr int I_A = 512, I_B = 128, I_C = 96, I_D = 128, I_E = 128, I_F = 512, I_G = 65 * 256, I_H = 65 * 128;
    constexpr int NITEMS = I_A + I_B + I_C + I_D + I_E + I_F + I_G + I_H;
    for (int it = gw; it < NITEMS; it += NGW) {
        int r = it;
        if (r < I_A) { const float* W = F.in[I_WIN]; const int kb = r / 32, nb = r % 32;
            transpose_item([&](int k, int n) -> float { if (n >= 928) return 0.f; const int src = n < 896 ? n : 896 + rope_perm_src(n - 896); return W[(size_t)k * 928 + src]; }, (bf16_t*)(F.ws + WS_WIN), 1024, kb * 64, nb * 32, scr, F.lane); continue; } r -= I_A;
        if (r < I_B) { const float* W = F.in[I_WGLU]; const int kb = r / 16, nb = r % 16;
            transpose_item([&](int k, int n) -> float { return W[(size_t)k * 512 + n]; }, (bf16_t*)(F.ws + WS_WGLU), 512, kb * 64, nb * 32, scr, F.lane); continue; } r -= I_B;
        if (r < I_C) { const float* W = F.in[I_WUQ]; const float* gq = F.in[I_QG]; const int kb = r / 24, nb = r % 24;
            transpose_item([&](int k, int n) -> float { const int hh = n / 96, jj = n % 96; const int src = jj < 64 ? n : hh * 96 + 64 + rope_perm_src(jj - 64); return W[(size_t)k * 768 + src] * gq[k]; }, (bf16_t*)(F.ws + WS_WUQ), 256, kb * 64, nb * 32, scr, F.lane); continue; } r -= I_C;
        if (r < I_D) { const float* W = F.in[I_WUKV]; const float* gk = F.in[I_KVG]; const int kb = r / 32, nb = r % 32;
            transpose_item([&](int k, int n) -> float { return k < 128 ? W[(size_t)k * 1024 + n] * gk[k] : 0.f; }, (bf16_t*)(F.ws + WS_WUKV), 256, kb * 64, nb * 32, scr, F.lane); continue; } r -= I_D;
        if (r < I_E) { const float* W = F.in[I_WR]; const int kb = r / 8, nb = r % 8;
            transpose_item([&](int k, int n) -> float { return n < 64 ? W[(size_t)k * 64 + n] : 0.f; }, (bf16_t*)(F.ws + WS_WR), 1024, kb * 64, nb * 32, scr, F.lane); continue; } r -= I_E;
        if (r < I_F) { const float* W = F.in[I_WO]; const int kb = r / 32, nb = r % 32;
            transpose_item([&](int k, int n) -> float { return W[(size_t)k * 1024 + n]; }, (bf16_t*)(F.ws + WS_WO), 1024, kb * 64, nb * 32, scr, F.lane); continue; } r -= I_F;
        if (r < I_G) { const int e = r / 256, rr = r % 256, kb = rr / 16, nb = rr % 16;
            const float* Wg = e < 64 ? F.in[I_WEG] + (size_t)e * 1024 * 256 : F.in[I_WSG]; const float* Wu = e < 64 ? F.in[I_WEU] + (size_t)e * 1024 * 256 : F.in[I_WSU];
            transpose_item([&](int k, int n) -> float { const int r = n & 255, col = 128 * (n >> 8) + 32 * (r >> 6) + (r & 31); return ((r >> 5) & 1) ? Wu[(size_t)k * 256 + col] : Wg[(size_t)k * 256 + col]; }, (bf16_t*)(F.ws + WS_WGU) + (size_t)e * 512 * 1024, 1024, kb * 64, nb * 32, scr, F.lane); continue; } r -= I_G;
        { const int e = r / 128, rr = r % 128, kb = rr / 32, nb = rr % 32;
            const float* Wd = e < 64 ? F.in[I_WED] + (size_t)e * 256 * 1024 : F.in[I_WSD];
            transpose_item([&](int k, int n) -> float { return Wd[(size_t)k * 1024 + n]; }, (bf16_t*)(F.ws + WS_WD) + (size_t)e * 1024 * 256, 256, kb * 64, nb * 32, scr, F.lane); }
    }
    { const float* x = F.in[I_X]; bf16_t* xb = (bf16_t*)(F.ws + WS_XB);
      for (size_t i = (size_t)F.bid * 512 + F.tid; i < (size_t)T * DM / 8; i += (size_t)F.G * 512) {
          const f32x4 a = *(const f32x4*)(x + i * 8), b = *(const f32x4*)(x + i * 8 + 4); *(u32x4*)(xb + i * 8) = pack8(a, b); } }
}

__device__ __forceinline__ void p3_scan_fill(Frame& F) {
    const float* S = (const float*)(F.ws + WS_S); bf16_t* UH = (bf16_t*)(F.ws + WS_UH);
    for (int gid = F.bid * 512 + F.tid; gid < 32 * 32 * 2 * 64; gid += F.G * 512) {
        const int n = gid & 63, d = (gid >> 6) & 1, b = (gid >> 7) & 31, g = gid >> 12;
        const SsmPar p = ssm_par(F.in[I_LRE], F.in[I_LIM], F.in[I_LDT], d, g, n); float acr, aci; ssm_pow(p, (float)CHK, acr, aci);
        float hr = 0.f, hi = 0.f;
        const size_t rbase = (size_t)g * UHR + (size_t)b * NCHK;
#pragma unroll
        for (int hb = 0; hb < 2; ++hb) {
            float sr[32], si[32];
#pragma unroll
            for (int st = 0; st < 32; ++st) { const int ci = d ? (NCHK - 1 - (hb * 32 + st)) : (hb * 32 + st);
                sr[st] = S[(rbase + ci) * 256 + d * 128 + n]; si[st] = S[(rbase + ci) * 256 + d * 128 + 64 + n]; }
#pragma unroll
            for (int st = 0; st < 32; ++st) { const int ci = d ? (NCHK - 1 - (hb * 32 + st)) : (hb * 32 + st);
                bf16_t* hp = UH + (rbase + ci) * UHK + 512 + d * 128 + n;
                hp[0] = (bf16_t)(cvt_pk_bf16(hr, 0.f) & 0xffffu); hp[64] = (bf16_t)(cvt_pk_bf16(hi, 0.f) & 0xffffu);
                const float nr = acr * hr - aci * hi + sr[st], ni = acr * hi + aci * hr + si[st]; hr = nr; hi = ni; }
        }
    }
    const float* Kt = (const float*)(F.ws + WS_KT); bf16_t* Mo = (bf16_t*)(F.ws + WS_MO);
    for (int pc = F.bid * 512 + F.tid; pc < 32 * 512 * 64; pc += F.G * 512) {
        const int k0 = (pc & 63) * 8, row = (pc >> 6) & 511, g = pc >> 15, s = k0 >> 4, q0 = k0 & 15, tq = row >> 4, pp = row & 15;
        f32x4 v0 = {0.f, 0.f, 0.f, 0.f}, v1 = {0.f, 0.f, 0.f, 0.f};
        if (tq >= s) { const float* kp = Kt + ((size_t)(g * 2 + 0) * 32 + (tq - s)) * 256 + pp * 16 + q0; v0 += *(const f32x4*)kp; v1 += *(const f32x4*)(kp + 4); }
        if (s >= tq) { const float* kp = Kt + ((size_t)(g * 2 + 1) * 32 + (s - tq)) * 256 + pp * 16 + q0; v0 += *(const f32x4*)kp; v1 += *(const f32x4*)(kp + 4); }
        *(u32x4*)(Mo + ((size_t)g * 512 + row) * UHK + k0) = pack8(v0, v1);
    }
}

__device__ __forceinline__ void p7_ln1(Frame& F) {
    const float* g1 = F.in[I_LN1G]; const float* b1 = F.in[I_LN1B]; bf16_t* x1b = (bf16_t*)(F.ws + WS_X1B);
    f32x4 gg[4], bb[4];
#pragma unroll
    for (int j = 0; j < 4; ++j) { const int c = 8 * F.lane + (j >> 1) * 512 + (j & 1) * 4; gg[j] = *(const f32x4*)(g1 + c); bb[j] = *(const f32x4*)(b1 + c); }
    for (int row = F.bid * 8 + F.wave; row < T; row += F.G * 8) {
        bf16_t* rp = x1b + (size_t)row * 1024 + 8 * F.lane; f32x4 v[4];
        { const u32x4 w0 = *(const u32x4*)rp, w1 = *(const u32x4*)(rp + 512); unpack8(w0, v[0], v[1]); unpack8(w1, v[2], v[3]); }
        float s = 0.f;
#pragma unroll
        for (int j = 0; j < 4; ++j) s += (v[j][0] + v[j][1]) + (v[j][2] + v[j][3]);
        const float mean = wave_sum(s) * (1.f / 1024.f); float q = 0.f;
#pragma unroll
        for (int j = 0; j < 4; ++j) { v[j] = v[j] - mean; q += (v[j][0] * v[j][0] + v[j][1] * v[j][1]) + (v[j][2] * v[j][2] + v[j][3] * v[j][3]); }
        const float rstd = __builtin_amdgcn_rsqf(wave_sum(q) * (1.f / 1024.f) + LN_EPS);
#pragma unroll
        for (int j = 0; j < 4; ++j) v[j] = v[j] * rstd * gg[j] + bb[j];
        *(u32x4*)rp = pack8(v[0], v[1]); *(u32x4*)(rp + 512) = pack8(v[2], v[3]);
    }
}

__device__ __forceinline__ void p9_route(Frame& F) {
    LAS int* hist = (LAS int*)(F.lds); LAS int* base = hist + 64;
    const float* LG = (const float*)(F.ws + WS_LOGIT); int* rowtok = (int*)(F.ws + WS_ROWTOK); int* tslot = (int*)(F.ws + WS_TSLOT); float* topw = (float*)(F.ws + WS_TOPW);
    for (int bt = F.bid; bt < T / 256; bt += F.G) {
        __syncthreads();
        if (F.tid < 64) hist[F.tid] = 0;
        __syncthreads();
        const int tok = bt * 256 + F.tid, ch = (bt * 256) / CAPC;
        int idx[6], lr[6]; float w[6];
        if (F.tid < 256) {
            float lg[64];
#pragma unroll
            for (int j = 0; j < 16; ++j) { const f32x4 v = *(const f32x4*)(LG + (size_t)tok * 64 + 4 * j); lg[4 * j] = v[0]; lg[4 * j + 1] = v[1]; lg[4 * j + 2] = v[2]; lg[4 * j + 3] = v[3]; }
            route_token(lg, F.in[I_RB], idx, w);
#pragma unroll
            for (int k = 0; k < 6; ++k) lr[k] = atomicAdd((int*)&hist[idx[k]], 1);
        }
        __syncthreads();
        if (F.tid < 64) base[F.tid] = (int)__hip_atomic_fetch_add(F.ctl + CW_CNT + 64 * (ch * 65 + F.tid), (unsigned)hist[F.tid], __ATOMIC_RELAXED, __HIP_MEMORY_SCOPE_AGENT);
        __syncthreads();
        if (F.tid < 256) {
#pragma unroll
            for (int k = 0; k < 6; ++k) { const int slot = base[idx[k]] + lr[k];
                rowtok[(size_t)(ch * 64 + idx[k]) * CAPC + slot] = tok; tslot[(size_t)tok * 8 + k] = (idx[k] << 16) | slot; topw[(size_t)tok * 8 + k] = w[k]; }
        }
    }
}

__device__ __forceinline__ void p12_combine(Frame& F, int ch) {
    const MoeTab tb = moe_tab(F.lds); const int t0 = tb.tbase[ch * 65];
    const unsigned char* Y8 = F.ws + WS_Y; const bf16_t* YS = (const bf16_t*)(F.ws + WS_YS); const bf16_t* x1b = (const bf16_t*)(F.ws + WS_X1B);
    const int* tslot = (const int*)(F.ws + WS_TSLOT); const float* topw = (const float*)(F.ws + WS_TOPW);
    const float* g2 = F.in[I_LN2G]; const float* b2 = F.in[I_LN2B];
    f32x4 gg[4], bb[4];
#pragma unroll
    for (int j = 0; j < 4; ++j) { const int c = 8 * F.lane + (j >> 1) * 512 + (j & 1) * 4; gg[j] = *(const f32x4*)(g2 + c); bb[j] = *(const f32x4*)(b2 + c); }
    for (int tk = F.bid * 8 + F.wave; tk < CAPC; tk += F.G * 8) {
        const int tok = ch * CAPC + tk;
        f32x4 a[4];
        { const bf16_t* xr = x1b + (size_t)tok * 1024 + 8 * F.lane; const u32x4 w0 = *(const u32x4*)xr, w1 = *(const u32x4*)(xr + 512);
          unpack8(w0, a[0], a[1]); unpack8(w1, a[2], a[3]); a[0] *= ALPHA; a[1] *= ALPHA; a[2] *= ALPHA; a[3] *= ALPHA; }
        { const bf16_t* yr = YS + (size_t)tk * 1024 + 8 * F.lane; const u32x4 w0 = *(const u32x4*)yr, w1 = *(const u32x4*)(yr + 512);
          f32x4 y0, y1, y2, y3; unpack8(w0, y0, y1); unpack8(w1, y2, y3); a[0] += y0; a[1] += y1; a[2] += y2; a[3] += y3; }
#pragma unroll
        for (int k = 0; k < 6; ++k) {
            const int ts = tslot[(size_t)tok * 8 + k]; const int yrow = (tb.tbase[ch * 65 + (ts >> 16)] - t0) * 256 + (ts & 0xffff); const float w = topw[(size_t)tok * 8 + k] * Y8_INV;
            const unsigned char* yr = Y8 + (size_t)yrow * 1024 + 8 * F.lane;
            const u32x2 w0 = *(const u32x2*)yr, w1 = *(const u32x2*)(yr + 512); f32x4 y0, y1, y2, y3; unpack8_fp8(w0, y0, y1); unpack8_fp8(w1, y2, y3);
            a[0] += y0 * w; a[1] += y1 * w; a[2] += y2 * w; a[3] += y3 * w;
        }
        float s = 0.f;
#pragma unroll
        for (int j = 0; j < 4; ++j) s += (a[j][0] + a[j][1]) + (a[j][2] + a[j][3]);
        const float mean = wave_sum(s) * (1.f / 1024.f); float q = 0.f;
#pragma unroll
        for (int j = 0; j < 4; ++j) { a[j] = a[j] - mean; q += (a[j][0] * a[j][0] + a[j][1] * a[j][1]) + (a[j][2] * a[j][2] + a[j][3] * a[j][3]); }
        const float rstd = __builtin_amdgcn_rsqf(wave_sum(q) * (1.f / 1024.f) + LN_EPS);
        float* orow = F.out + (size_t)tok * 1024 + 8 * F.lane;
#pragma unroll
        for (int j = 0; j < 4; ++j) *(f32x4*)(orow + (j >> 1) * 512 + (j & 1) * 4) = a[j] * rstd * gg[j] + bb[j];
    }
}
}

namespace fx {
constexpr int NPHASE = 11 + 2 * NCH;
struct Args { const float* in[29]; float* out; unsigned char* ws; int ph_lo, ph_hi; };

__global__ void __launch_bounds__(512, 2) fwd(Args args) {
    extern __shared__ __attribute__((aligned(16))) unsigned char lds_raw[];
    Frame F;
    F.lds = (LAS unsigned char*)lds_raw; F.ws = args.ws; F.ctl = (unsigned*)(args.ws + WS_CTL); F.out = args.out;
#pragma unroll
    for (int i = 0; i < 29; ++i) F.in[i] = args.in[i];
    F.tid = threadIdx.x; F.lane = F.tid & 63; F.wave = __builtin_amdgcn_readfirstlane(F.tid >> 6); F.G = gridDim.x; F.bid = blockIdx.x;
    volatile LAS unsigned* MISC = (volatile LAS unsigned*)(F.lds + MISC_OFF);
    if (F.tid < 32) MISC[F.tid] = 0u;
    __syncthreads();
    const int lo = args.ph_lo, hi = args.ph_hi;
    XcdBarrier bar; bar.bar = F.ctl + CW_BAR; bar.x = 0; bar.st = MISC + 8;
    if (hi - lo > 1) bar = xcd_barrier_post(F.ctl + CW_BAR, MISC + 8);
#ifndef PH_MASK
#define PH_MASK 0xFFFFFFFFu
#endif
#define IN(k) (((PH_MASK >> ((k) > 11 ? 11 + (((k) - 11) & 1) : (k))) & 1u) && lo <= (k) && (k) < hi)
#define SEAM(k) do { if (IN(k) && IN((k) + 1)) xcd_barrier(bar); } while (0)
    unsigned char* ws = args.ws;
    bf16_t* UH = (bf16_t*)(ws + WS_UH); bf16_t* CQ = (bf16_t*)(ws + WS_CQ); bf16_t* CKVR = (bf16_t*)(ws + WS_CKVR); bf16_t* Qb = (bf16_t*)(ws + WS_Q); bf16_t* KVb = (bf16_t*)(ws + WS_KV);
    bf16_t* SPRE = (bf16_t*)(ws + WS_SPRE); bf16_t* MIX = (bf16_t*)(ws + WS_MIX);
    float* ssqq = (float*)(ws + WS_SSQQ); float* ssqkv = (float*)(ws + WS_SSQKV); const float* ropec = (const float*)(ws + WS_ROPE); const float* ropes = ropec + 2048 * 16;

    if (IN(0)) { REP(0) p0_prologue(F); } SEAM(0);
    if (IN(1)) DUP2(1, {
        PlainOrder S; S.init(ws + WS_XB, 1024, ws + WS_WIN, 1024, T, 1024, F.G, F.bid);
        EpiWin E{UH, CQ, CKVR, ssqq, ssqkv, ropec, ropes};
        gemm_phase<EpiWin, PlainOrder, true, false>(F.lds, 1024, 1024, 1024, S, E);
    }); SEAM(1);
    if (IN(2)) {
#ifndef SUB2
#define SUB2 7
#endif
        if (SUB2 & 1) DUP2(20, { PlainOrder S; S.init(CQ, 256, ws + WS_WUQ, 256, T, 768, F.G, F.bid); EpiQ E{Qb, ssqq, ropec, ropes};
          gemm_phase<EpiQ, PlainOrder, true, false>(F.lds, 256, 256, 256, S, E); });
        if (SUB2 & 2) DUP2(21, { PlainOrder S; S.init(CKVR, 256, ws + WS_WUKV, 256, T, 1024, F.G, F.bid); EpiKV E{KVb, ssqkv};
          gemm_phase<EpiKV, PlainOrder, true, false>(F.lds, 256, 256, 256, S, E); });
        if (SUB2 & 4) DUP2(22, { GroupOrder S; S.init(UH, ws + WS_WST, 512, 1, F.G, F.bid); EpiSt E{(float*)(ws + WS_S)};
          gemm_phase<EpiSt, GroupOrder, true, false>(F.lds, UHK, 512, 512, S, E); });
    } SEAM(2);
    if (IN(3)) { REP(3) p3_scan_fill(F); } SEAM(3);
    if (IN(4)) {
#ifndef SUB4
#define SUB4 3
#endif
        if (SUB4 & 1) DUP2(4, { GroupOrder S; S.init(UH, ws + WS_MO, UHK, 2, F.G, F.bid); EpiSsmOut E{UH, SPRE, F.in[I_DSK]};
          gemm_phase<EpiSsmOut, GroupOrder, true, false>(F.lds, UHK, UHK, UHK, S, E); });
        if (SUB4 & 2) REP(40) for (int i = 0;; ++i) { const long L = (long)i * F.G + F.bid; if (L >= 2048) break;
            const int un = xcd_remap((int)L, 2048), pair = un >> 3, qb = un & 7, b = pair >> 3, h = pair & 7;
            att::attn_unit(ws, Qb, MIX, b * SEQ, qb * 256, h, (char*)lds_raw); }
    } SEAM(4);
    if (IN(5)) DUP2(5, {
        PlainOrder S; S.init(SPRE, 512, ws + WS_WGLU, 512, T, 512, F.G, F.bid); EpiGlu E{SPRE, MIX, F.in[I_BGLU]};
        gemm_phase<EpiGlu, PlainOrder, true, false>(F.lds, 512, 512, 512, S, E);
    }); SEAM(5);
    if (IN(6)) DUP2(6, {
        PlainOrder S; S.init(MIX, 1024, ws + WS_WO, 1024, T, 1024, F.G, F.bid); EpiWo E{F.in[I_X], (bf16_t*)(ws + WS_X1B)};
        gemm_phase<EpiWo, PlainOrder, true, false>(F.lds, 1024, 1024, 1024, S, E);
    }); SEAM(6);
    if (IN(7)) { p7_ln1(F); } SEAM(7);
    if (IN(8)) DUP2(8, {
        PlainOrder S; S.init(ws + WS_X1B, 1024, ws + WS_WR, 1024, T, 256, F.G, F.bid); EpiRouter E{(float*)(ws + WS_LOGIT)};
        gemm_phase<EpiRouter, PlainOrder, true, false>(F.lds, 1024, 1024, 1024, S, E);
    }); SEAM(8);
    if (IN(9)) { p9_route(F); } SEAM(9);
    if (IN(10)) DUP2(10, {
        moe_build_tab(F.lds, F.ctl);
        GateUpOrder S; S.init(ws + WS_X1B, ws + WS_WGU, (const int*)(ws + WS_ROWTOK), F.ctl, moe_tab(F.lds), F.G, F.bid); EpiGateUp E{(bf16_t*)(ws + WS_H)};
        gemm_phase<EpiGateUp, GateUpOrder, true, true>(F.lds, 1024, 1024, 1024, S, E);
    }); SEAM(10);
#pragma unroll
    for (int ch = 0; ch < NCH; ++ch) {
        if (IN(11 + 2 * ch)) DUP2(11, {
            moe_build_tab(F.lds, F.ctl);
            DownOrder S; S.init(ws + WS_H, ws + WS_WD, moe_tab(F.lds), ch, F.G, F.bid); EpiDown E{ws + WS_Y, (bf16_t*)(ws + WS_YS)};
            gemm_phase<EpiDown, DownOrder, true, false>(F.lds, 256, 256, 256, S, E);
        }); SEAM(11 + 2 * ch);
        if (IN(12 + 2 * ch)) { moe_build_tab(F.lds, F.ctl); p12_combine(F, ch); } SEAM(12 + 2 * ch);
    }
#undef IN
#undef SEAM
}

#if MK_DEBUG
__global__ void dbg_cmp(int k, const unsigned char* ws, const float* out_fast, gold::Bufs B, const float* gx1, const float* gout, float* acc) {
    const int t = blockIdx.x;
    float num = 0.f, den = 0.f;
    auto bf = [](const bf16_t* p, size_t i) -> float { return __uint_as_float(((unsigned)p[i]) << 16); };
    int ncol = 0;
    switch (k) { case 0: ncol = 512; break; case 1: ncol = 256; break; case 2: ncol = 160; break; case 3: ncol = 768; break; case 4: ncol = 1024; break; case 5: ncol = 512; break; case 6: ncol = 512; break; case 7: ncol = 512; break; case 8: ncol = 1024; break; default: ncol = 1024; }
    for (int c = threadIdx.x; c < ncol; c += blockDim.x) {
        float f = 0.f, g = 0.f;
        if (k == 0) { const int gg = c >> 4, p = c & 15; f = bf((const bf16_t*)(ws + WS_UH), ((size_t)gg * UHR + (t >> 5)) * UHK + (t & 31) * 16 + p); g = B.proj[(size_t)t * 928 + c]; }
        else if (k == 1) { f = bf((const bf16_t*)(ws + WS_CQ), (size_t)t * 256 + c); g = B.proj[(size_t)t * 928 + 512 + c]; }
        else if (k == 2) { f = bf((const bf16_t*)(ws + WS_CKVR), (size_t)t * 256 + c); g = c < 128 ? B.proj[(size_t)t * 928 + 768 + c] : B.krope[(size_t)t * 32 + rope_perm_src(c - 128)]; }
        else if (k == 3) { const int hh = c / 96, jj = c % 96, src = jj < 64 ? c : hh * 96 + 64 + rope_perm_src(jj - 64); f = bf((const bf16_t*)(ws + WS_Q), (size_t)t * 768 + c); g = B.q[(size_t)t * 768 + src] * QSCALE; }
        else if (k == 4) { f = bf((const bf16_t*)(ws + WS_KV), (size_t)t * 1024 + c); g = B.kv[(size_t)t * 1024 + c]; }
        else if (k == 5) { f = bf((const bf16_t*)(ws + WS_SPRE), (size_t)t * 512 + c); g = B.spre[(size_t)t * 512 + c]; }
        else if (k == 6) { f = bf((const bf16_t*)(ws + WS_MIX), (size_t)t * 1024 + c); g = B.mix[(size_t)t * 1024 + c]; }
        else if (k == 7) { f = bf((const bf16_t*)(ws + WS_MIX), (size_t)t * 1024 + 512 + c); g = B.mix[(size_t)t * 1024 + 512 + c]; }
        else if (k == 8) { f = bf((const bf16_t*)(ws + WS_X1B), (size_t)t * 1024 + c); g = gx1[(size_t)t * 1024 + c]; }
        else { f = out_fast[(size_t)t * 1024 + c]; g = gout[(size_t)t * 1024 + c]; }
        const float d = f - g; num += d * d; den += g * g;
        if (!(fabsf(f) < 1e30f)) num += 1e30f;
    }
    num = wave_sum(num); den = wave_sum(den);
    if ((threadIdx.x & 63) == 0) { atomicAdd(acc + 2 * k, num); atomicAdd(acc + 2 * k + 1, den); }
}
__global__ void dbg_encode(const float* acc, float* out, int k0, int nk) {
    float c2 = 0.f;
    for (int k = k0; k < k0 + nk; ++k) { const float e = sqrtf(acc[2 * k] / fmaxf(acc[2 * k + 1], 1e-30f)); const float tol = (k == 9) ? 0.08f : 0.04f;
        if (!(e <= tol)) { const int bucket = !(e <= 0.5f) ? 0 : (e > 0.1f ? 1 : 2); c2 = (float)(k - k0 + 1) + 20.f * bucket; break; } }
    if (c2 == 0.f) { if (MK_DBG_NPH >= NPHASE) return; c2 = 90.f; }
    const float c = sqrtf(c2);
    for (size_t i = (size_t)blockIdx.x * blockDim.x + threadIdx.x; i < (size_t)T * 1024; i += (size_t)gridDim.x * blockDim.x) out[i] = c;
}
#endif
}

extern "C" void kernel_launch(void* const* d_in, const int* in_sizes, int n_in, void* d_out, int out_size, void* d_ws, size_t ws_size, hipStream_t stream) {
#if MK_MODE == 0
    gold::In I; const float** p = (const float**)&I;
    for (int i = 0; i < 29; ++i) p[i] = (const float*)d_in[i];
    for (int t0 = 0; t0 < 65536; t0 += 16384) gold::run(I, t0, 16384, (float*)d_ws, (float*)d_out + (size_t)t0 * 1024, (float*)d_out + (size_t)t0 * 1024, stream);
#else
    using namespace fx;
    static int grid = 0;
    if (grid == 0) {
        if (n_in != 29 || ws_size < WS_END) { fprintf(stderr, "kernel_launch: need 29 inputs and >= %zu bytes of workspace (got %d, %zu)\n", (size_t)WS_END, n_in, ws_size); grid = -1; return; }
        int dev = 0, cus = 0, per_cu = 0;
        hipGetDevice(&dev); hipDeviceGetAttribute(&cus, hipDeviceAttributeMultiprocessorCount, dev);
        if (hipFuncSetAttribute((const void*)fwd, hipFuncAttributeMaxDynamicSharedMemorySize, LDS_BYTES) != hipSuccess) { fprintf(stderr, "kernel_launch: hipFuncSetAttribute failed\n"); grid = -1; return; }
        if (hipOccupancyMaxActiveBlocksPerMultiprocessor(&per_cu, (const void*)fwd, 512, LDS_BYTES) != hipSuccess || per_cu < 1) { fprintf(stderr, "kernel_launch: occupancy query says %d\n", per_cu); }
        (void)hipGetLastError();
        grid = cus > 0 ? cus : 256;
    }
    if (grid < 0) return;
    hipMemsetAsync((char*)d_ws + WS_CTL, 0, CTL_BYTES, stream);
    Args a{};
    for (int i = 0; i < 29; ++i) a.in[i] = (const float*)d_in[i];
    a.out = (float*)d_out; a.ws = (unsigned char*)d_ws;
#if MK_MODE == 1
    for (int ph = 0; ph < NPHASE && ph < MK_DBG_NPH; ++ph) { a.ph_lo = ph; a.ph_hi = ph + 1; hipLaunchKernelGGL(fwd, dim3(grid), dim3(512), LDS_BYTES, stream, a); }
#else
    a.ph_lo = 0; a.ph_hi = NPHASE; hipLaunchKernelGGL(fwd, dim3(grid), dim3(512), LDS_BYTES, stream, a);
#endif
#if MK_DEBUG
    {
        gold::In I; const float** p = (const float**)&I;
        for (int i = 0; i < 29; ++i) p[i] = (const float*)d_in[i];
        float* gs = (float*)((char*)d_ws + WS_GOLD); float* gx1 = gs + (size_t)2048 * gold::GOLD_FLOATS_PER_TOK; float* gout = gx1 + (size_t)2048 * 1024;
        gold::Bufs B = gold::run(I, 0, 2048, gs, gx1, gout, stream);
        float* acc = (float*)((char*)d_ws + WS_CTL) + CW_DBG;
        for (int k = 0; k < 10; ++k) hipLaunchKernelGGL(dbg_cmp, dim3(2048), dim3(256), 0, stream, k, (const unsigned char*)d_ws, (const float*)d_out, B, (const float*)gx1, (const float*)gout, acc);
        hipLaunchKernelGGL(dbg_encode, dim3(1024), dim3(256), 0, stream, (const float*)acc, (float*)d_out, MK_DBG_K0, MK_DBG_NK);
    }
#endif
    const hipError_t le = hipPeekAtLastError();
    if (le != hipSuccess) fprintf(stderr, "kernel_launch: launch failed: %s\n", hipGetErrorName(le));
#endif
}
```

```cpp
#define MK_MODE 2
#include <hip/hip_runtime.h>
#include <cstdio>
#include <cstdint>
#include <cmath>
#ifndef MK_MODE
#define MK_MODE 1
#endif
#ifndef MK_DBG_NPH
#define MK_DBG_NPH 99
#endif
#ifndef MK_DBG_K0
#define MK_DBG_K0 0
#endif
#ifndef MK_DBG_NK
#define MK_DBG_NK 10
#endif
#ifndef MK_DUP
#define MK_DUP -1
#endif
#define REP(k) for (int rep_ = 0; rep_ < ((MK_DUP == (k)) ? 2 : 1); ++rep_)
#define DUP2(k, ...) do { __VA_ARGS__ if constexpr (MK_DUP == (k)) { __VA_ARGS__ } } while (0)
#ifndef MK_TPROBE
#define MK_TPROBE -1
#endif
#ifndef MK_DEBUG
#define MK_DEBUG 0
#endif
namespace gold {
constexpr int D_MODEL = 1024, SEQ = 2048, D_SSM = 512, D_IN = 928, NH = 8, QLR = 256, KVLR = 128, ROPE = 32;
constexpr int NEXP = 64, TOPK = 6, DEXP = 256;
constexpr float ALPHA = 1.189207115002721f, LN_EPS = 1e-5f, RMS_EPS = 1e-6f, ATT_SCALE = 0.10206207261596577f;

__global__ void __launch_bounds__(256) sgemm(const float* __restrict__ A, int lda, const float* __restrict__ B, int ldb, float* __restrict__ C, int ldc, int M, int N, int K) {
    __shared__ float As[16][65];
    __shared__ float Bs[16][65];
    const int tid = threadIdx.x, tx = tid & 15, ty = tid >> 4;
    const int m0 = blockIdx.y * 64, n0 = blockIdx.x * 64;
    float acc[4][4];
#pragma unroll
    for (int i = 0; i < 4; ++i)
#pragma unroll
        for (int j = 0; j < 4; ++j) acc[i][j] = 0.f;
    for (int k0 = 0; k0 < K; k0 += 16) {
#pragma unroll
        for (int i = 0; i < 4; ++i) { const int idx = tid + 256 * i, r = idx >> 4, c = idx & 15; As[c][r] = A[(size_t)(m0 + r) * lda + k0 + c]; }
#pragma unroll
        for (int i = 0; i < 4; ++i) { const int idx = tid + 256 * i, r = idx >> 6, c = idx & 63; Bs[r][c] = (n0 + c < N) ? B[(size_t)(k0 + r) * ldb + n0 + c] : 0.f; }
        __syncthreads();
#pragma unroll
        for (int k = 0; k < 16; ++k) {
            float a[4], b[4];
#pragma unroll
            for (int i = 0; i < 4; ++i) a[i] = As[k][ty + 16 * i];
#pragma unroll
            for (int j = 0; j < 4; ++j) b[j] = Bs[k][tx + 16 * j];
#pragma unroll
            for (int i = 0; i < 4; ++i)
#pragma unroll
                for (int j = 0; j < 4; ++j) acc[i][j] = fmaf(a[i], b[j], acc[i][j]);
        }
        __syncthreads();
    }
#pragma unroll
    for (int i = 0; i < 4; ++i)
#pragma unroll
        for (int j = 0; j < 4; ++j) { const int c = n0 + tx + 16 * j; if (c < N) C[(size_t)(m0 + ty + 16 * i) * ldc + c] = acc[i][j]; }
}

__device__ __forceinline__ float gelu_tanh(float x) {
    const float z = 0.7978845608028654f * (x + 0.044715f * x * x * x);
    const float e = __expf(2.f * z);
    const float th = 1.f - 2.f / (1.f + e);
    return 0.5f * x * (1.f + th);
}
__device__ __forceinline__ float sigmoidf_(float x) { return 1.f / (1.f + __expf(-x)); }

struct SsmPar { float ar, ai, kr, ki; };
__device__ __forceinline__ SsmPar ssm_par(const float* lam_re, const float* lam_im, const float* log_dt, int d, int g, int n) {
    const float lr = fminf(lam_re[(d * 32 + g) * 64 + n], -1e-4f), li = lam_im[(d * 32 + g) * 64 + n];
    const float dt = expf(log_dt[d * 32 + g]);
    const float x = lr * dt, th = li * dt;
    const float em1 = expm1f(x), cs = cosf(th), sn = sinf(th), sh = sinf(0.5f * th);
    const float mag = em1 + 1.f;
    SsmPar p; p.ar = mag * cs; p.ai = mag * sn;
    const float arm1 = em1 * cs - 2.f * sh * sh;
    const float den = lr * lr + li * li;
    p.kr = (arm1 * lr + p.ai * li) / den; p.ki = (p.ai * lr - arm1 * li) / den;
    return p;
}

__global__ void __launch_bounds__(64) ssm_naive(const float* __restrict__ proj, int ldp, const float* __restrict__ lam_re, const float* __restrict__ lam_im, const float* __restrict__ log_dt,
                                                const float* __restrict__ b_re, const float* __restrict__ b_im, const float* __restrict__ c_re, const float* __restrict__ c_im,
                                                const float* __restrict__ d_skip, float* __restrict__ spre) {
    const int g = blockIdx.x, b = blockIdx.y, n = threadIdx.x;
    for (int d = 0; d < 2; ++d) {
        const SsmPar P = ssm_par(lam_re, lam_im, log_dt, d, g, n);
        float Br[16], Bi[16], Cr[16], Ci[16];
#pragma unroll
        for (int q = 0; q < 16; ++q) { const float br = b_re[((d * 32 + g) * 64 + n) * 16 + q], bi = b_im[((d * 32 + g) * 64 + n) * 16 + q];
            Br[q] = P.kr * br - P.ki * bi; Bi[q] = P.kr * bi + P.ki * br;
            Cr[q] = c_re[((d * 32 + g) * 16 + q) * 64 + n]; Ci[q] = c_im[((d * 32 + g) * 16 + q) * 64 + n]; }
        float hr = 0.f, hi = 0.f;
        for (int step = 0; step < SEQ; ++step) {
            const int t = d ? (SEQ - 1 - step) : step;
            const float* up = proj + (size_t)(b * SEQ + t) * ldp + g * 16;
            float u[16];
#pragma unroll
            for (int q = 0; q < 16; ++q) u[q] = up[q];
            float bur = 0.f, bui = 0.f;
#pragma unroll
            for (int q = 0; q < 16; ++q) { bur = fmaf(Br[q], u[q], bur); bui = fmaf(Bi[q], u[q], bui); }
            const float nr = P.ar * hr - P.ai * hi + bur, ni = P.ar * hi + P.ai * hr + bui;
            hr = nr; hi = ni;
            float y[16];
#pragma unroll
            for (int p = 0; p < 16; ++p) y[p] = Cr[p] * hr - Ci[p] * hi;
#pragma unroll
            for (int o = 1; o < 64; o <<= 1)
#pragma unroll
                for (int p = 0; p < 16; ++p) y[p] += __shfl_xor(y[p], o);
            if (n < 16) {
                float v = 0.f;
#pragma unroll
                for (int p = 0; p < 16; ++p) if (p == n) v = y[p];
                float* o = spre + (size_t)(b * SEQ + t) * 512 + g * 16 + n;
                if (d == 0) *o = v;
                else { float uu = 0.f;
#pragma unroll
                    for (int p = 0; p < 16; ++p) if (p == n) uu = u[p];
                    *o = gelu_tanh(*o + v + uu * d_skip[g * 16 + n]); }
            }
        }
    }
}
__global__ void glu_ew(const float* __restrict__ spre, const float* __restrict__ gl, const float* __restrict__ bglu, float* __restrict__ mix, int ntok) {
    const size_t i = (size_t)blockIdx.x * 256 + threadIdx.x; if (i >= (size_t)ntok * 512) return;
    const int c = (int)(i & 511); const size_t r = i >> 9;
    mix[r * 1024 + c] = spre[i] * sigmoidf_(gl[i] + bglu[c]);
}
__global__ void rmsnorm_rows(const float* __restrict__ in, int ld, int off, int n, const float* __restrict__ g, float* __restrict__ out, int ntok) {
    const int r = blockIdx.x * 256 + threadIdx.x; if (r >= ntok) return;
    const float* p = in + (size_t)r * ld + off; float s = 0.f;
    for (int j = 0; j < n; ++j) s = fmaf(p[j], p[j], s);
    const float rs = rsqrtf(s / n + RMS_EPS);
    for (int j = 0; j < n; ++j) out[(size_t)r * n + j] = p[j] * rs * g[j];
}
__device__ __forceinline__ void rope_cs(int pos, int i, float& c, float& s) {
    const float inv = expf(-9.210340371976184f * (float)i * (1.f / 16.f));
    const float a = (float)pos * inv; c = cosf(a); s = sinf(a);
}
__global__ void rope_ew(float* __restrict__ q, const float* __restrict__ proj, int ldp, float* __restrict__ krope, int ntok) {
    const int idx = blockIdx.x * 256 + threadIdx.x; if (idx >= ntok * 9 * 16) return;
    const int i = idx & 15, hh = (idx >> 4) % 9, r = idx / 144, pos = r % SEQ;
    float c, s; rope_cs(pos, i, c, s);
    if (hh < 8) { float* p = q + (size_t)r * 768 + hh * 96 + 64; const float t1 = p[i], t2 = p[i + 16]; p[i] = t1 * c - t2 * s; p[i + 16] = t1 * s + t2 * c; }
    else { const float* p = proj + (size_t)r * ldp + 896; const float t1 = p[i], t2 = p[i + 16]; krope[(size_t)r * 32 + i] = t1 * c - t2 * s; krope[(size_t)r * 32 + i + 16] = t1 * s + t2 * c; }
}
__global__ void __launch_bounds__(64) attn_naive(const float* __restrict__ q, const float* __restrict__ kv, const float* __restrict__ krope, float* __restrict__ mix) {
    const int qi = blockIdx.x * 64 + threadIdx.x, h = blockIdx.y, b = blockIdx.z;
    const size_t r = (size_t)b * SEQ + qi;
    float qv[96], o[64];
#pragma unroll
    for (int d = 0; d < 96; ++d) qv[d] = q[r * 768 + h * 96 + d] * ATT_SCALE;
#pragma unroll
    for (int d = 0; d < 64; ++d) o[d] = 0.f;
    float m = -1e30f, l = 0.f;
    for (int s = 0; s < SEQ; ++s) {
        const size_t kr = (size_t)b * SEQ + s;
        const float4* kn = (const float4*)(kv + kr * 1024 + h * 128);
        const float4* kp = (const float4*)(krope + kr * 32);
        float sc = 0.f;
#pragma unroll
        for (int d = 0; d < 16; ++d) { const float4 k4 = kn[d]; sc = fmaf(qv[4 * d], k4.x, sc); sc = fmaf(qv[4 * d + 1], k4.y, sc); sc = fmaf(qv[4 * d + 2], k4.z, sc); sc = fmaf(qv[4 * d + 3], k4.w, sc); }
#pragma unroll
        for (int d = 0; d < 8; ++d) { const float4 k4 = kp[d]; sc = fmaf(qv[64 + 4 * d], k4.x, sc); sc = fmaf(qv[64 + 4 * d + 1], k4.y, sc); sc = fmaf(qv[64 + 4 * d + 2], k4.z, sc); sc = fmaf(qv[64 + 4 * d + 3], k4.w, sc); }
        const float mn = fmaxf(m, sc), al = __expf(m - mn), p = __expf(sc - mn);
        l = l * al + p; m = mn;
        const float4* vp = (const float4*)(kv + kr * 1024 + h * 128 + 64);
#pragma unroll
        for (int d = 0; d < 16; ++d) { const float4 v4 = vp[d]; o[4 * d] = fmaf(o[4 * d], al, p * v4.x); o[4 * d + 1] = fmaf(o[4 * d + 1], al, p * v4.y); o[4 * d + 2] = fmaf(o[4 * d + 2], al, p * v4.z); o[4 * d + 3] = fmaf(o[4 * d + 3], al, p * v4.w); }
    }
    const float il = 1.f / l;
#pragma unroll
    for (int d = 0; d < 64; ++d) mix[r * 1024 + 512 + h * 64 + d] = o[d] * il;
}
__device__ __forceinline__ float wsum(float v) {
#pragma unroll
    for (int o = 1; o < 64; o <<= 1) v += __shfl_xor(v, o);
    return v;
}
__global__ void __launch_bounds__(256) ln1_rows(const float* __restrict__ x, const float* __restrict__ mixo, const float* __restrict__ g, const float* __restrict__ bb, float* __restrict__ x1, int ntok) {
    const int r = blockIdx.x * 4 + (threadIdx.x >> 6), lane = threadIdx.x & 63; if (r >= ntok) return;
    float v[16]; float s = 0.f;
#pragma unroll
    for (int j = 0; j < 16; ++j) { const int c = lane + 64 * j; v[j] = ALPHA * x[(size_t)r * 1024 + c] + mixo[(size_t)r * 1024 + c]; s += v[j]; }
    const float mean = wsum(s) * (1.f / 1024.f); float q = 0.f;
#pragma unroll
    for (int j = 0; j < 16; ++j) { v[j] -= mean; q = fmaf(v[j], v[j], q); }
    const float rstd = rsqrtf(wsum(q) * (1.f / 1024.f) + LN_EPS);
#pragma unroll
    for (int j = 0; j < 16; ++j) { const int c = lane + 64 * j; x1[(size_t)r * 1024 + c] = v[j] * rstd * g[c] + bb[c]; }
}
}

__device__ __forceinline__ void route_token(const float (&lg)[64], const float* __restrict__ rbias, int (&idx)[6], float (&w)[6]) {
    float sc[64], ch[64];
#pragma unroll
    for (int j = 0; j < 64; ++j) { sc[j] = 1.f / (1.f + __expf(-lg[j])); ch[j] = sc[j] + rbias[j]; }
    float gs[8];
#pragma unroll
    for (int g = 0; g < 8; ++g) { float m1 = -INFINITY, m2 = -INFINITY;
#pragma unroll
        for (int j = 0; j < 8; ++j) { const float v = ch[g * 8 + j]; if (v > m1) { m2 = m1; m1 = v; } else if (v > m2) m2 = v; }
        gs[g] = m1 + m2; }
    bool sel[8];
#pragma unroll
    for (int g = 0; g < 8; ++g) { int rank = 0;
#pragma unroll
        for (int o = 0; o < 8; ++o) { if (o != g && (gs[o] > gs[g] || (gs[o] == gs[g] && o < g))) ++rank; }
        sel[g] = rank < 4; }
#pragma unroll
    for (int j = 0; j < 64; ++j) if (!sel[j >> 3]) ch[j] = -INFINITY;
    float wsum_ = 0.f;
#pragma unroll
    for (int k = 0; k < 6; ++k) { float best = -INFINITY; int bi = 0;
#pragma unroll
        for (int j = 0; j < 64; ++j) if (ch[j] > best) { best = ch[j]; bi = j; }
        float sv = 0.f;
#pragma unroll
        for (int j = 0; j < 64; ++j) if (j == bi) { sv = sc[j]; ch[j] = -INFINITY; }
        idx[k] = bi; w[k] = sv; wsum_ += sv; }
    const float inv = 2.5f / (wsum_ + 1e-20f);
#pragma unroll
    for (int k = 0; k < 6; ++k) w[k] *= inv;
}

namespace gold {
__global__ void __launch_bounds__(64) route_rows(const float* __restrict__ logits, const float* __restrict__ rbias, int* __restrict__ topi, float* __restrict__ topw, int ntok) {
    const int r = blockIdx.x * 64 + threadIdx.x; if (r >= ntok) return;
    float lg[64];
#pragma unroll
    for (int j = 0; j < 16; ++j) { const float4 v = ((const float4*)(logits + (size_t)r * 64))[j]; lg[4 * j] = v.x; lg[4 * j + 1] = v.y; lg[4 * j + 2] = v.z; lg[4 * j + 3] = v.w; }
    int idx[6]; float w[6]; route_token(lg, rbias, idx, w);
#pragma unroll
    for (int k = 0; k < 6; ++k) { topi[(size_t)r * 6 + k] = idx[k]; topw[(size_t)r * 6 + k] = w[k]; }
}
__global__ void __launch_bounds__(256) moe_naive(const float* x1, const int* __restrict__ topi, const float* __restrict__ topw,
                                                  const float* __restrict__ weg, const float* __restrict__ weu, const float* __restrict__ wed,
                                                  const float* __restrict__ wsg, const float* __restrict__ wsu, const float* __restrict__ wsd,
                                                  const float* __restrict__ g2, const float* __restrict__ b2, float* out) {
    __shared__ float xs[1024]; __shared__ float hs[256]; __shared__ float red[8];
    const int r = blockIdx.x, tid = threadIdx.x;
#pragma unroll
    for (int j = 0; j < 4; ++j) xs[tid + 256 * j] = x1[(size_t)r * 1024 + tid + 256 * j];
    __syncthreads();
    float acc[4] = {0.f, 0.f, 0.f, 0.f};
    for (int ei = 0; ei < 7; ++ei) {
        const int e = ei < 6 ? topi[(size_t)r * 6 + ei] : 0; const float w = ei < 6 ? topw[(size_t)r * 6 + ei] : 1.f;
        const float* Wg = ei < 6 ? weg + (size_t)e * 1024 * 256 : wsg; const float* Wu = ei < 6 ? weu + (size_t)e * 1024 * 256 : wsu; const float* Wd = ei < 6 ? wed + (size_t)e * 256 * 1024 : wsd;
        float gg = 0.f, uu = 0.f;
        for (int k = 0; k < 1024; ++k) { const float xv = xs[k]; gg = fmaf(xv, Wg[(size_t)k * 256 + tid], gg); uu = fmaf(xv, Wu[(size_t)k * 256 + tid], uu); }
        hs[tid] = gg / (1.f + __expf(-gg)) * uu;
        __syncthreads();
        float y[4] = {0.f, 0.f, 0.f, 0.f};
        for (int i = 0; i < 256; ++i) { const float hv = hs[i];
#pragma unroll
            for (int j = 0; j < 4; ++j) y[j] = fmaf(hv, Wd[(size_t)i * 1024 + tid + 256 * j], y[j]); }
#pragma unroll
        for (int j = 0; j < 4; ++j) acc[j] = fmaf(w, y[j], acc[j]);
        __syncthreads();
    }
    float v[4]; float s = 0.f;
#pragma unroll
    for (int j = 0; j < 4; ++j) { v[j] = ALPHA * xs[tid + 256 * j] + acc[j]; s += v[j]; }
    s = wsum(s); if ((tid & 63) == 0) red[tid >> 6] = s; __syncthreads();
    const float mean = (red[0] + red[1] + red[2] + red[3]) * (1.f / 1024.f); float q = 0.f;
#pragma unroll
    for (int j = 0; j < 4; ++j) { v[j] -= mean; q = fmaf(v[j], v[j], q); }
    q = wsum(q); if ((tid & 63) == 0) red[4 + (tid >> 6)] = q; __syncthreads();
    const float rstd = rsqrtf((red[4] + red[5] + red[6] + red[7]) * (1.f / 1024.f) + LN_EPS);
#pragma unroll
    for (int j = 0; j < 4; ++j) { const int c = tid + 256 * j; out[(size_t)r * 1024 + c] = v[j] * rstd * g2[c] + b2[c]; }
}

struct In {
    const float *x, *w_in, *lam_re, *lam_im, *log_dt, *b_re, *b_im, *c_re, *c_im, *d_skip, *w_glu, *b_glu, *q_norm_g, *w_uq, *kv_norm_g, *w_ukv, *w_o, *ln1_g, *ln1_b,
                *w_router, *router_bias, *we_gate, *we_up, *we_down, *ws_gate, *ws_up, *ws_down, *ln2_g, *ln2_b;
};
constexpr size_t GOLD_FLOATS_PER_TOK = 6400;
struct Bufs { float *proj, *spre, *gl, *mix, *cqn, *ckvn, *q, *kv, *krope, *mixo, *logits; int* topi; float* topw; };
static Bufs run(const In& I, int tok0, int ntok, float* scratch, float* x1out, float* out, hipStream_t st) {
    Bufs B;
    B.proj = scratch; B.spre = B.proj + (size_t)ntok * 928; B.gl = B.spre + (size_t)ntok * 512; B.mix = B.gl + (size_t)ntok * 512;
    B.cqn = B.mix + (size_t)ntok * 1024; B.ckvn = B.cqn + (size_t)ntok * 256; B.q = B.ckvn + (size_t)ntok * 128; B.kv = B.q + (size_t)ntok * 768;
    B.krope = B.kv + (size_t)ntok * 1024; B.mixo = B.krope + (size_t)ntok * 32; B.logits = B.mixo + (size_t)ntok * 1024;
    B.topi = (int*)(B.logits + (size_t)ntok * 64); B.topw = (float*)(B.topi + (size_t)ntok * 6);
    float *proj = B.proj, *spre = B.spre, *gl = B.gl, *mix = B.mix, *cqn = B.cqn, *ckvn = B.ckvn, *q = B.q, *kv = B.kv, *krope = B.krope, *mixo = B.mixo, *logits = B.logits; int* topi = B.topi; float* topw = B.topw;
    const float* x = I.x + (size_t)tok0 * 1024; const int nb = ntok / SEQ;
    hipLaunchKernelGGL(sgemm, dim3((928 + 63) / 64, ntok / 64), dim3(256), 0, st, x, 1024, I.w_in, 928, proj, 928, ntok, 928, 1024);
    hipLaunchKernelGGL(ssm_naive, dim3(32, nb), dim3(64), 0, st, proj, 928, I.lam_re, I.lam_im, I.log_dt, I.b_re, I.b_im, I.c_re, I.c_im, I.d_skip, spre);
    hipLaunchKernelGGL(sgemm, dim3(8, ntok / 64), dim3(256), 0, st, spre, 512, I.w_glu, 512, gl, 512, ntok, 512, 512);
    hipLaunchKernelGGL(glu_ew, dim3((unsigned)(((size_t)ntok * 512 + 255) / 256)), dim3(256), 0, st, spre, gl, I.b_glu, mix, ntok);
    hipLaunchKernelGGL(rmsnorm_rows, dim3((ntok + 255) / 256), dim3(256), 0, st, proj, 928, 512, 256, I.q_norm_g, cqn, ntok);
    hipLaunchKernelGGL(rmsnorm_rows, dim3((ntok + 255) / 256), dim3(256), 0, st, proj, 928, 768, 128, I.kv_norm_g, ckvn, ntok);
    hipLaunchKernelGGL(sgemm, dim3(12, ntok / 64), dim3(256), 0, st, cqn, 256, I.w_uq, 768, q, 768, ntok, 768, 256);
    hipLaunchKernelGGL(sgemm, dim3(16, ntok / 64), dim3(256), 0, st, ckvn, 128, I.w_ukv, 1024, kv, 1024, ntok, 1024, 128);
    hipLaunchKernelGGL(rope_ew, dim3((ntok * 144 + 255) / 256), dim3(256), 0, st, q, proj, 928, krope, ntok);
    hipLaunchKernelGGL(attn_naive, dim3(SEQ / 64, 8, nb), dim3(64), 0, st, q, kv, krope, mix);
    hipLaunchKernelGGL(sgemm, dim3(16, ntok / 64), dim3(256), 0, st, mix, 1024, I.w_o, 1024, mixo, 1024, ntok, 1024, 1024);
    hipLaunchKernelGGL(ln1_rows, dim3(ntok / 4), dim3(256), 0, st, x, mixo, I.ln1_g, I.ln1_b, x1out, ntok);
    hipLaunchKernelGGL(sgemm, dim3(1, ntok / 64), dim3(256), 0, st, x1out, 1024, I.w_router, 64, logits, 64, ntok, 64, 1024);
    hipLaunchKernelGGL(route_rows, dim3(ntok / 64), dim3(64), 0, st, logits, I.router_bias, topi, topw, ntok);
    hipLaunchKernelGGL(moe_naive, dim3(ntok), dim3(256), 0, st, x1out, topi, topw, I.we_gate, I.we_up, I.we_down, I.ws_gate, I.ws_up, I.ws_down, I.ln2_g, I.ln2_b, out);
    return B;
}
}
#define GAS __attribute__((address_space(1)))
#define LAS __attribute__((address_space(3)))
typedef unsigned short bf16_t;
typedef short bf16x8 __attribute__((ext_vector_type(8)));
typedef short s16x4 __attribute__((ext_vector_type(4)));
typedef float f32x4 __attribute__((ext_vector_type(4)));
typedef float f32x2 __attribute__((ext_vector_type(2)));
typedef float f32x16 __attribute__((ext_vector_type(16)));
typedef unsigned u32x4 __attribute__((ext_vector_type(4)));
typedef unsigned u32x2 __attribute__((ext_vector_type(2)));

namespace fx {
constexpr int T = 65536, SEQ = 2048, DM = 1024, NB = 32;
constexpr int CHK = 32;
constexpr int NCHK = SEQ / CHK;
constexpr int UHR = NB * NCHK;
constexpr int UHK = CHK * 16 + 256;
constexpr int SPRE_LD = 512;
constexpr int NCH = 2;
constexpr int CAPC = T / NCH;
constexpr int NVE = NCH * 65;
constexpr float ALPHA = 1.189207115002721f, LN_EPS = 1e-5f, RMS_EPS = 1e-6f;
constexpr float QSCALE = 0.10206207261596577f * 1.4426950408889634f;

constexpr size_t MiB = 1u << 20;
constexpr size_t WS_CTL = 0, CTL_BYTES = 1 * MiB;
constexpr size_t WS_ROPE = 1 * MiB;
constexpr size_t WS_KT = 2 * MiB;
constexpr size_t WS_WIN = 4 * MiB, WS_WGLU = 6 * MiB, WS_WUQ = 6 * MiB + 512 * 1024, WS_WUKV = 7 * MiB, WS_WO = 8 * MiB;
constexpr size_t WS_WST = 10 * MiB, WS_MO = 18 * MiB, WS_WGU = 42 * MiB  , WS_WR = 107 * MiB  , WS_WD = 107 * MiB + 512 * 1024;
constexpr size_t WS_SSQQ = 140 * MiB, WS_SSQKV = 141 * MiB, WS_TSLOT = 142 * MiB, WS_TOPW = 144 * MiB, WS_ROWTOK = 146 * MiB, WS_LOGIT = 162 * MiB;
constexpr size_t WS_XB = 178 * MiB, WS_UH = 306 * MiB, WS_CQ = 402 * MiB, WS_CKVR = 434 * MiB, WS_S = 466 * MiB, WS_Q = 530 * MiB, WS_KV = 626 * MiB, WS_SPRE = 754 * MiB, WS_MIX = 818 * MiB;
constexpr size_t WS_X1B = 178 * MiB, WS_H = 306 * MiB, WS_Y = 562 * MiB  , WS_YS = 800 * MiB  , WS_HS = 864 * MiB  ;
constexpr size_t WS_GOLD = 946 * MiB, WS_END = 1024 * MiB;
constexpr int CW_TMO = 0, CW_CODE = 1, CW_BAR = 4096, CW_CNT = 16384  , CW_DBG = 65536  ;

constexpr int RING_BYTES = 131072, TAB_OFF = RING_BYTES, IDX_OFF = TAB_OFF + 10752  , IDX_UNITS = 16, MISC_OFF = IDX_OFF + IDX_UNITS * 1024, LDS_BYTES = MISC_OFF + 256;

__device__ __forceinline__ unsigned cvt_pk_bf16(float lo, float hi) { unsigned r; asm volatile("v_cvt_pk_bf16_f32 %0, %1, %2" : "=v"(r) : "v"(lo), "v"(hi)); return r; }
__device__ __forceinline__ float bf_lo(unsigned w) { return __uint_as_float(w << 16); }
__device__ __forceinline__ float bf_hi(unsigned w) { return __uint_as_float(w & 0xffff0000u); }
__device__ __forceinline__ u32x4 pack8(const f32x4 a, const f32x4 b) { u32x4 w; w.x = cvt_pk_bf16(a[0], a[1]); w.y = cvt_pk_bf16(a[2], a[3]); w.z = cvt_pk_bf16(b[0], b[1]); w.w = cvt_pk_bf16(b[2], b[3]); return w; }
__device__ __forceinline__ void unpack8(const u32x4 w, f32x4& a, f32x4& b) { a = (f32x4){bf_lo(w.x), bf_hi(w.x), bf_lo(w.y), bf_hi(w.y)}; b = (f32x4){bf_lo(w.z), bf_hi(w.z), bf_lo(w.w), bf_hi(w.w)}; }
__device__ __forceinline__ float fast_sigmoid(float x) { return __builtin_amdgcn_rcpf(1.f + __builtin_amdgcn_exp2f(-1.4426950408889634f * x)); }
__device__ __forceinline__ float gelu_tanh_f(float x) {
    const float z2 = 1.5957691216057308f * (x + 0.044715f * x * x * x);
    return x * fast_sigmoid(z2);
}
__device__ __forceinline__ float wave_sum(float v) {
#pragma unroll
    for (int o = 1; o < 64; o <<= 1) v += __shfl_xor(v, o);
    return v;
}

#define XB_TMO      128
#define XB_XCNT(j)  (256  + 64 * (j))
#define XB_XSUB(j)  (1280 + 64 * (j))
#define XB_XGEN(j)  (2304 + 64 * (j))
#define XB_TOP      3328
#define XB_TOPGEN   3392
#define XCD_BAR_WORDS 3456
#define XB_SPIN_CAP (1u << 18)
__device__ __forceinline__ unsigned xb_ld(unsigned* p)              { return __hip_atomic_load(p, __ATOMIC_RELAXED, __HIP_MEMORY_SCOPE_AGENT); }
__device__ __forceinline__ unsigned xb_add(unsigned* p, unsigned v) { return __hip_atomic_fetch_add(p, v, __ATOMIC_RELAXED, __HIP_MEMORY_SCOPE_AGENT); }
__device__ __forceinline__ unsigned xb_xcc_id() { return (unsigned)__builtin_amdgcn_s_getreg((3 << 11) | 20) & 0xFu; }
#define XB_SPIN(cond, bar) do { unsigned _sp = 0; while (cond) { __builtin_amdgcn_s_sleep(1); \
    if ((++_sp & 255u) == 0u) { if (xb_ld(&(bar)[XB_TMO])) break; if (_sp > XB_SPIN_CAP) { atomicAdd(&(bar)[XB_TMO], 1u); break; } } } } while (0)
struct XcdBarrier { unsigned* bar; unsigned x; volatile LAS unsigned* st; };
__device__ __forceinline__ XcdBarrier xcd_barrier_post(unsigned* bar, volatile LAS unsigned* st) {
    XcdBarrier b; b.bar = bar; b.x = xb_xcc_id(); b.st = st;
    if (threadIdx.x == 0) (void)xb_add(&bar[XB_XCNT(b.x)], 1u);
    return b;
}
__device__ __forceinline__ void xcd_barrier_complete(unsigned* bar, unsigned x, unsigned& nloc, unsigned& nx) {
    const unsigned G = gridDim.x * gridDim.y * gridDim.z;
    unsigned sum, cnt, mine, sp = 0u;
    for (;;) {
        sum = 0u; cnt = 0u; mine = 0u;
#pragma unroll
        for (unsigned j = 0; j < 16; ++j) { const unsigned c = xb_ld(&bar[XB_XCNT(j)]); sum += c; cnt += (c > 0u) ? 1u : 0u; mine = (j == x) ? c : mine; }
        if (sum == G) break;
        __builtin_amdgcn_s_sleep(1);
        if ((++sp & 255u) == 0u) { if (xb_ld(&bar[XB_TMO])) break; if (sp > XB_SPIN_CAP) { atomicAdd(&bar[XB_TMO], 1u); break; } }
    }
    nloc = mine > 0u ? mine : 1u; nx = cnt > 0u ? cnt : 1u;
}
__device__ __forceinline__ void xcd_barrier(const XcdBarrier& b) {
    asm volatile("s_waitcnt vmcnt(0)" ::: "memory");
    __syncthreads();
    if (threadIdx.x == 0) {
        unsigned* bar = b.bar;
        __builtin_amdgcn_s_waitcnt(0);
        unsigned nloc = b.st[0], nx = b.st[1];
        if (nloc == 0u) { xcd_barrier_complete(bar, b.x, nloc, nx); b.st[0] = nloc; b.st[1] = nx; }
        const unsigned old = xb_add(&bar[XB_XSUB(b.x)], 1u);
        const unsigned gen = old / nloc;
        if (old + 1u == (gen + 1u) * nloc) {
            __builtin_amdgcn_fence(__ATOMIC_RELEASE, "agent");
            asm volatile("s_waitcnt vmcnt(0)" ::: "memory");
            const unsigned og = xb_add(&bar[XB_TOP], 1u);
            const unsigned tg = og / nx;
            if (og + 1u == (tg + 1u) * nx) xb_add(&bar[XB_TOPGEN], 1u);
            else XB_SPIN(xb_ld(&bar[XB_TOPGEN]) == tg, bar);
            __builtin_amdgcn_fence(__ATOMIC_ACQUIRE, "agent");
            xb_add(&bar[XB_XGEN(b.x)], 1u);
            asm volatile("s_waitcnt vmcnt(0)" ::: "memory");
        } else {
            XB_SPIN(xb_ld(&bar[XB_XGEN(b.x)]) == gen, bar);
            __builtin_amdgcn_fence(__ATOMIC_ACQUIRE, "agent");
            asm volatile("s_waitcnt vmcnt(0)" ::: "memory");
        }
    }
    __syncthreads();
}

constexpr int BM = 256, BK = 64, HALF = 128, HTB = HALF * BK * 2, STAGE_BYTES = 8 * HTB;
__host__ __device__ __forceinline__ int lds_byte(int r, int c) { const int st = (r >> 4) * 2 + (c >> 5), rr = r & 15, cc = c & 31, ob = rr * 64 + cc * 2; return st * 1024 + (ob ^ (((ob >> 9) & 1) << 5)); }
__host__ __device__ __forceinline__ void stage_rc(int b, int& R, int& C) { const int st = b / 1024, sb = b % 1024, swz = sb ^ (((sb >> 9) & 1) << 5); R = (st >> 1) * 16 + swz / 64; C = (st & 1) * 32 + (swz % 64) / 2; }
__host__ __device__ __forceinline__ int perm32(int rho) { const int n = rho >> 4, i = rho & 15; return 8 * (i >> 2) + 4 * n + (i & 3); }

struct Unit { const char* A; const char* B; int i0, i1, i2, i3; };
__device__ __forceinline__ int xcd_remap(int L, int nwg) { const int q = nwg / 8, r = nwg % 8, xcd = L % 8, off = L / 8; return (xcd < r ? xcd * (q + 1) : r * (q + 1) + (xcd - r) * q) + off; }

template <class Epi, class Sched, bool ALIGN_EPI, bool GATHER>
__device__ __forceinline__ void gemm_phase(LAS unsigned char* lds, const int lda, const int ldb, const int K, const Sched& S, const Epi& E) {
    const int tid = threadIdx.x, wid = __builtin_amdgcn_readfirstlane(tid >> 6), lane = tid & 63, wr = wid >> 2, wc = wid & 3, fr = lane & 15, fq = lane >> 4;
    const int nt = K / BK;
    unsigned voffA[2], voffB[2]; int RA[2], CA[2];
#pragma unroll
    for (int i = 0; i < 2; ++i) { int R, C; stage_rc(tid * 16 + i * 8192, R, C); const int Rb = 64 * (R >> 5) + (Epi::PERM ? perm32(R & 31) : (R & 31));
        RA[i] = R; CA[i] = C; voffA[i] = (unsigned)(R * lda + C) * 2u; voffB[i] = (unsigned)(Rb * ldb + C) * 2u; }
    const size_t kstep = (size_t)(BK * 2);
    const size_t hstepA = (size_t)HALF * lda * 2, hstepB = (size_t)32 * ldb * 2;
    const unsigned ldsw = (unsigned)wid * 1024u;
    const int aoff = lds_byte(wr * 64 + fr, fq * 8), boff = lds_byte(wc * 32 + fr, fq * 8);
#define PG8_SA(b, h) (((b) * 2 + (h)) * HTB)
#define PG8_SB(b, h) ((4 + (b) * 2 + (h)) * HTB)
#define PG8_STAGE(bufoff, gbase, voff) do { _Pragma("unroll") for (int _i = 0; _i < 2; ++_i) \
        __builtin_amdgcn_global_load_lds((const unsigned*)((const char*)(gbase) + (voff)[_i]), (LAS unsigned*)(lds + (bufoff) + ldsw + _i * 8192), 16, 0, 0); } while (0)
#define PG8_STAGE_A(bufoff, base, g0, g1, h, kb) do { if constexpr (GATHER) { \
        __builtin_amdgcn_global_load_lds((const unsigned*)((base) + (kb) + (g0)), (LAS unsigned*)(lds + (bufoff) + ldsw), 16, 0, 0); \
        __builtin_amdgcn_global_load_lds((const unsigned*)((base) + (kb) + (g1)), (LAS unsigned*)(lds + (bufoff) + ldsw + 8192), 16, 0, 0); } \
      else { PG8_STAGE(bufoff, (base) + (h) * hstepA + (kb), voffA); } } while (0)
#define PG8_LDA(dst, b, h) do { _Pragma("unroll") for (int m = 0; m < 4; ++m) _Pragma("unroll") for (int k = 0; k < 2; ++k) dst[m][k] = *(const LAS bf16x8*)(lds + PG8_SA(b, h) + aoff + m * 2048 + k * 1024); } while (0)
#define PG8_LDB(dst, b, h) do { _Pragma("unroll") for (int n = 0; n < 2; ++n) _Pragma("unroll") for (int k = 0; k < 2; ++k) dst[n][k] = *(const LAS bf16x8*)(lds + PG8_SB(b, h) + boff + n * 2048 + k * 1024); } while (0)
#define PG8_MMA(ai, bj, At, Bt) do { __builtin_amdgcn_s_setprio(1); _Pragma("unroll") for (int m = 0; m < 4; ++m) _Pragma("unroll") for (int n = 0; n < 2; ++n) _Pragma("unroll") for (int k = 0; k < 2; ++k) \
        acc[ai][bj][m][n] = __builtin_amdgcn_mfma_f32_16x16x32_bf16(Bt[n][k], At[m][k], acc[ai][bj][m][n], 0, 0, 0); __builtin_amdgcn_s_setprio(0); } while (0)
#define PG8_WAIT_V(n) asm volatile("s_waitcnt vmcnt(" #n ")" ::: "memory")
#define PG8_WAIT_L(n) asm volatile("s_waitcnt lgkmcnt(" #n ")" ::: "memory")
#define PG8_BAR __builtin_amdgcn_s_barrier()
#define PG8_SCHED __builtin_amdgcn_sched_barrier(0)
    Unit cur, nxt; int ui = 0;
    if (!S.next(0, cur)) return;
    unsigned gc00 = 0, gc01 = 0, gc10 = 0, gc11 = 0, gn00 = 0, gn01 = 0, gn10 = 0, gn11 = 0;
    if constexpr (GATHER) { S.gather(cur, RA[0], CA[0], RA[1], CA[1], gc00, gc01, gc10, gc11); gn00 = gc00; gn01 = gc01; gn10 = gc10; gn11 = gc11; }
    f32x4 acc[2][2][4][2];
#pragma unroll
    for (int a = 0; a < 2; ++a)
#pragma unroll
        for (int b = 0; b < 2; ++b)
#pragma unroll
            for (int m = 0; m < 4; ++m)
#pragma unroll
                for (int n = 0; n < 2; ++n) acc[a][b][m][n] = (f32x4){0.f, 0.f, 0.f, 0.f};
    bf16x8 At[4][2], B0[2][2], B1[2][2];
    const char* cA = cur.A; const char* cB = cur.B;
    PG8_STAGE(PG8_SB(0, 0), cB, voffB); PG8_STAGE(PG8_SB(0, 1), cB + hstepB, voffB); PG8_STAGE_A(PG8_SA(0, 0), cA, gc00, gc01, 0, 0); PG8_STAGE_A(PG8_SA(0, 1), cA, gc10, gc11, 1, 0);
    if (wr == 1) PG8_BAR;
    PG8_WAIT_V(2); PG8_BAR;
    PG8_STAGE(PG8_SB(1, 0), cB + kstep, voffB); PG8_STAGE_A(PG8_SA(1, 0), cA, gc00, gc01, 0, kstep); PG8_STAGE(PG8_SB(1, 1), cB + hstepB + kstep, voffB);
    PG8_WAIT_V(6); PG8_BAR;
    for (;;) {
        const bool has_next = S.next(ui + 1, nxt);
        if constexpr (GATHER) { if (has_next) S.gather(nxt, RA[0], CA[0], RA[1], CA[1], gn00, gn01, gn10, gn11); }
        const char* nA = has_next ? nxt.A : cA; const char* nB = has_next ? nxt.B : cB;
#pragma unroll 1
        for (int t = 0; t < nt; t += 2) {
            const bool last = (t == nt - 2);
            const size_t k1 = (size_t)(t + 1) * kstep;
            const char* a2 = last ? nA : cA; const char* b2 = last ? nB : cB + (size_t)(t + 2) * kstep;
            const size_t k2 = last ? 0 : (size_t)(t + 2) * kstep, k3 = k2 + kstep;
            const char* b3 = b2 + kstep;
            unsigned g200 = gc00, g201 = gc01, g210 = gc10, g211 = gc11;
            if constexpr (GATHER) { if (last) { g200 = gn00; g201 = gn01; g210 = gn10; g211 = gn11; } }
            PG8_LDB(B0, 0, 0); PG8_LDB(B1, 0, 1); PG8_SCHED; PG8_LDA(At, 0, 0); PG8_STAGE_A(PG8_SA(1, 1), cA, gc10, gc11, 1, k1);
            PG8_WAIT_V(8); PG8_WAIT_L(0); PG8_BAR; PG8_MMA(0, 0, At, B0); PG8_MMA(0, 1, At, B1); PG8_BAR; PG8_SCHED;
            PG8_LDA(At, 0, 1); PG8_STAGE(PG8_SB(0, 0), b2, voffB); PG8_STAGE(PG8_SB(0, 1), b2 + hstepB, voffB); PG8_STAGE_A(PG8_SA(0, 0), a2, g200, g201, 0, k2);
            PG8_WAIT_V(8); PG8_WAIT_L(0); PG8_BAR; PG8_MMA(1, 0, At, B0); PG8_MMA(1, 1, At, B1); PG8_BAR; PG8_SCHED;
            PG8_LDB(B0, 1, 0); PG8_LDB(B1, 1, 1); PG8_SCHED; PG8_LDA(At, 1, 0); PG8_STAGE_A(PG8_SA(0, 1), a2, g210, g211, 1, k2);
            PG8_WAIT_V(8); PG8_WAIT_L(0); PG8_BAR; PG8_MMA(0, 0, At, B0); PG8_MMA(0, 1, At, B1); PG8_BAR; PG8_SCHED;
            PG8_LDA(At, 1, 1); PG8_STAGE(PG8_SB(1, 0), b3, voffB); PG8_STAGE(PG8_SB(1, 1), b3 + hstepB, voffB); PG8_STAGE_A(PG8_SA(1, 0), a2, g200, g201, 0, k3);
            PG8_WAIT_V(8); PG8_WAIT_L(0); PG8_BAR; PG8_MMA(1, 0, At, B0); PG8_MMA(1, 1, At, B1); PG8_BAR; PG8_SCHED;
        }
#if defined(MK_TPROBE) && MK_TPROBE >= 200
        unsigned long long tp0_ = 0; if (blockIdx.x == 0 && wid == 0) tp0_ = __builtin_amdgcn_s_memrealtime();
#endif
        if constexpr (ALIGN_EPI) { if (wr == 0) PG8_BAR; }
        E(acc, cur, wr, wc, fr, fq);
#if defined(MK_TPROBE) && MK_TPROBE >= 200
        if (blockIdx.x == 0 && wid == 0) { asm volatile("s_waitcnt vmcnt(0)" ::: "memory"); const unsigned long long d_ = __builtin_amdgcn_s_memrealtime() - tp0_; if (lane == 0) { volatile LAS unsigned* M_ = (volatile LAS unsigned*)(lds + MISC_OFF); const unsigned long long a_ = (((unsigned long long)M_[23] << 32) | M_[22]) + d_; M_[22] = (unsigned)a_; M_[23] = (unsigned)(a_ >> 32); } }
#endif
        if (!has_next) break;
#pragma unroll
        for (int a = 0; a < 2; ++a)
#pragma unroll
            for (int b = 0; b < 2; ++b)
#pragma unroll
                for (int m = 0; m < 4; ++m)
#pragma unroll
                    for (int n = 0; n < 2; ++n) acc[a][b][m][n] = (f32x4){0.f, 0.f, 0.f, 0.f};
        cur = nxt; cA = nA; cB = nB; ++ui;
        if constexpr (GATHER) { gc00 = gn00; gc01 = gn01; gc10 = gn10; gc11 = gn11; }
        if constexpr (ALIGN_EPI) { if (wr == 1) PG8_BAR; }
    }
    PG8_WAIT_V(0);
    if constexpr (!ALIGN_EPI) { if (wr == 0) PG8_BAR; }
    PG8_BAR;
#undef PG8_SA
#undef PG8_SB
#undef PG8_STAGE
#undef PG8_STAGE_A
#undef PG8_LDA
#undef PG8_LDB
#undef PG8_MMA
#undef PG8_WAIT_V
#undef PG8_WAIT_L
#undef PG8_BAR
#undef PG8_SCHED
}
}
namespace fx {
#define FX_ROWLOOP _Pragma("unroll") for (int ai = 0; ai < 2; ++ai) _Pragma("unroll") for (int m = 0; m < 4; ++m)

struct PlainOrder {
    const char* A; const char* B; int lda, ldb, nM, nN, nwg, G, c;
    __device__ __forceinline__ void init(const void* A_, int lda_, const void* B_, int ldb_, int M, int N, int G_, int c_) { A = (const char*)A_; B = (const char*)B_; lda = lda_; ldb = ldb_; nM = M / 256; nN = N / 256; nwg = nM * nN; G = G_; c = c_; }
    __device__ __forceinline__ bool next(int i, Unit& u) const {
        const long L = (long)i * G + c; if (L >= nwg) return false;
        const int wgid = xcd_remap((int)L, nwg);
        const int nig = 8 * nN, gid = wgid / nig, fm = gid * 8, gsz = (nM - fm) < 8 ? (nM - fm) : 8;
        const int pm = fm + ((wgid % nig) % gsz), pn = (wgid % nig) / gsz;
        u.A = A + (size_t)pm * 256 * lda * 2; u.B = B + (size_t)pn * 256 * ldb * 2; u.i0 = pm; u.i1 = pn; u.i2 = 0; u.i3 = 0; return true;
    }
};
struct GroupOrder {
    const char* A; const char* B; int ldb, nN, nwg, G, c;
    __device__ __forceinline__ void init(const void* A_, const void* B_, int ldb_, int nN_, int G_, int c_) { A = (const char*)A_; B = (const char*)B_; ldb = ldb_; nN = nN_; nwg = 32 * 8 * nN_; G = G_; c = c_; }
    __device__ __forceinline__ bool next(int i, Unit& u) const {
        const long L = (long)i * G + c; if (L >= nwg) return false;
        const int wgid = xcd_remap((int)L, nwg);
        const int per = 8 * nN, g = wgid / per, rem = wgid % per, pm = rem % 8, pn = rem / 8;
        u.A = A + ((size_t)g * UHR + (size_t)pm * 256) * UHK * 2; u.B = B + ((size_t)g * nN * 256 + (size_t)pn * 256) * ldb * 2; u.i0 = g; u.i1 = pm; u.i2 = pn; u.i3 = 0; return true;
    }
};

__device__ __forceinline__ void rope8(f32x4& v0, f32x4& v1, const float* __restrict__ ropec, const float* __restrict__ ropes, int pos, int fq) {
    const f32x4 c = *(const f32x4*)(ropec + pos * 16 + 4 * fq), s = *(const f32x4*)(ropes + pos * 16 + 4 * fq);
    const f32x4 a = v0, b = v1;
    v0 = (f32x4){a[0] * c[0] - a[1] * s[0], a[0] * s[0] + a[1] * c[0], a[2] * c[1] - a[3] * s[1], a[2] * s[1] + a[3] * c[1]};
    v1 = (f32x4){b[0] * c[2] - b[1] * s[2], b[0] * s[2] + b[1] * c[2], b[2] * c[3] - b[3] * s[3], b[2] * s[3] + b[3] * c[3]};
}
__device__ __forceinline__ float sumsq8(const f32x4 a, const f32x4 b) { return (a[0] * a[0] + a[1] * a[1]) + (a[2] * a[2] + a[3] * a[3]) + (b[0] * b[0] + b[1] * b[1]) + (b[2] * b[2] + b[3] * b[3]); }

struct EpiWin {
    static constexpr bool PERM = true;
    bf16_t* UH; bf16_t* CQ; bf16_t* CKVR; float* ssqq; float* ssqkv; const float* ropec; const float* ropes;
    __device__ __forceinline__ void operator()(const f32x4 (&acc)[2][2][4][2], const Unit& u, int wr, int wc, int fr, int fq) const {
        const int pm = u.i0, pn = u.i1, row0 = pm * 256 + wr * 64 + fr;
        if (pn < 2) {
            FX_ROWLOOP { const int row = row0 + ai * 128 + m * 16, r32 = row >> 5, tq = row & 31;
#pragma unroll
                for (int bj = 0; bj < 2; ++bj) { const int c = pn * 256 + wc * 64 + bj * 32 + 8 * fq, g = c >> 4, p0 = c & 15;
                    *(u32x4*)(UH + ((size_t)(g * UHR + r32) * UHK + tq * 16 + p0)) = pack8(acc[ai][bj][m][0], acc[ai][bj][m][1]); } }
        } else if (pn == 2) {
            FX_ROWLOOP { const int row = row0 + ai * 128 + m * 16; float ss = 0.f;
#pragma unroll
                for (int bj = 0; bj < 2; ++bj) { const int c = wc * 64 + bj * 32 + 8 * fq;
                    *(u32x4*)(CQ + (size_t)row * 256 + c) = pack8(acc[ai][bj][m][0], acc[ai][bj][m][1]); ss += sumsq8(acc[ai][bj][m][0], acc[ai][bj][m][1]); }
                ss += __shfl_xor(ss, 16); ss += __shfl_xor(ss, 32);
                if (fq == 0) ssqq[(size_t)row * 4 + wc] = ss; }
        } else {
            FX_ROWLOOP { const int row = row0 + ai * 128 + m * 16; float ss = 0.f;
#pragma unroll
                for (int bj = 0; bj < 2; ++bj) { const int c = wc * 64 + bj * 32 + 8 * fq; f32x4 v0 = acc[ai][bj][m][0], v1 = acc[ai][bj][m][1];
                    if (wc < 2) ss += sumsq8(v0, v1);
                    if (wc == 2 && bj == 0) rope8(v0, v1, ropec, ropes, row & (SEQ - 1), fq);
                    *(u32x4*)(CKVR + (size_t)row * 256 + c) = pack8(v0, v1); }
                ss += __shfl_xor(ss, 16); ss += __shfl_xor(ss, 32);
                if (fq == 0) ssqkv[(size_t)row * 4 + wc] = ss; }
        }
    }
};
struct EpiQ {
    static constexpr bool PERM = true;
    bf16_t* Q; const float* ssqq; const float* ropec; const float* ropes;
    __device__ __forceinline__ void operator()(const f32x4 (&acc)[2][2][4][2], const Unit& u, int wr, int wc, int fr, int fq) const {
        const int pm = u.i0, pn = u.i1, row0 = pm * 256 + wr * 64 + fr;
        FX_ROWLOOP { const int row = row0 + ai * 128 + m * 16; const f32x4 s4 = *(const f32x4*)(ssqq + (size_t)row * 4);
            const float rs = __builtin_amdgcn_rsqf(((s4[0] + s4[1]) + (s4[2] + s4[3])) * (1.f / 256.f) + RMS_EPS) * QSCALE;
#pragma unroll
            for (int bj = 0; bj < 2; ++bj) { const int G = 8 * pn + 2 * wc + bj, c = 256 * pn + 64 * wc + 32 * bj + 8 * fq;
                f32x4 v0 = acc[ai][bj][m][0] * rs, v1 = acc[ai][bj][m][1] * rs;
                if (G % 3 == 2) rope8(v0, v1, ropec, ropes, row & (SEQ - 1), fq);
                *(u32x4*)(Q + (size_t)row * 768 + c) = pack8(v0, v1); } }
    }
};
struct EpiKV {
    static constexpr bool PERM = true;
    bf16_t* KV; const float* ssqkv;
    __device__ __forceinline__ void operator()(const f32x4 (&acc)[2][2][4][2], const Unit& u, int wr, int wc, int fr, int fq) const {
        const int pm = u.i0, pn = u.i1, row0 = pm * 256 + wr * 64 + fr;
        FX_ROWLOOP { const int row = row0 + ai * 128 + m * 16; const f32x4 s4 = *(const f32x4*)(ssqkv + (size_t)row * 4);
            const float rs = __builtin_amdgcn_rsqf(((s4[0] + s4[1]) + (s4[2] + s4[3])) * (1.f / 128.f) + RMS_EPS);
#pragma unroll
            for (int bj = 0; bj < 2; ++bj) { const int c = 256 * pn + 64 * wc + 32 * bj + 8 * fq;
                *(u32x4*)(KV + (size_t)row * 1024 + c) = pack8(acc[ai][bj][m][0] * rs, acc[ai][bj][m][1] * rs); } }
    }
};
struct EpiSt {
    static constexpr bool PERM = false;
    float* S;
    __device__ __forceinline__ void operator()(const f32x4 (&acc)[2][2][4][2], const Unit& u, int wr, int wc, int fr, int fq) const {
        const int g = u.i0, pm = u.i1, row0 = pm * 256 + wr * 64 + fr;
        FX_ROWLOOP { const int R = row0 + ai * 128 + m * 16; float* rp = S + ((size_t)g * UHR + R) * 256 + wc * 64 + 4 * fq;
#pragma unroll
            for (int bj = 0; bj < 2; ++bj)
#pragma unroll
                for (int n = 0; n < 2; ++n) *(f32x4*)(rp + bj * 32 + n * 16) = acc[ai][bj][m][n]; }
    }
};
struct EpiSsmOut {
    static constexpr bool PERM = true;
    const bf16_t* UH; bf16_t* SPRE; const float* dskip;
    __device__ __forceinline__ void operator()(const f32x4 (&acc)[2][2][4][2], const Unit& u, int wr, int wc, int fr, int fq) const {
        const int g = u.i0, pm = u.i1, pn = u.i2, row0 = pm * 256 + wr * 64 + fr;
        const int p0 = 8 * (fq & 1);
        const f32x4 d0 = *(const f32x4*)(dskip + g * 16 + p0), d1 = *(const f32x4*)(dskip + g * 16 + p0 + 4);
        FX_ROWLOOP { const int R = row0 + ai * 128 + m * 16;
#pragma unroll
            for (int bj = 0; bj < 2; ++bj) { const int c = 256 * pn + 64 * wc + 32 * bj + 8 * fq, tq = c >> 4;
                const u32x4 uw = *(const u32x4*)(UH + ((size_t)g * UHR + R) * UHK + c); f32x4 u0, u1; unpack8(uw, u0, u1);
                f32x4 y0 = acc[ai][bj][m][0] + u0 * d0, y1 = acc[ai][bj][m][1] + u1 * d1;
#pragma unroll
                for (int j = 0; j < 4; ++j) { y0[j] = gelu_tanh_f(y0[j]); y1[j] = gelu_tanh_f(y1[j]); }
                *(u32x4*)(SPRE + ((size_t)R * 32 + tq) * SPRE_LD + g * 16 + p0) = pack8(y0, y1); } }
    }
};
struct EpiGlu {
    static constexpr bool PERM = true;
    const bf16_t* SPRE; bf16_t* MIX; const float* bglu;
    __device__ __forceinline__ void operator()(const f32x4 (&acc)[2][2][4][2], const Unit& u, int wr, int wc, int fr, int fq) const {
        const int pm = u.i0, pn = u.i1, row0 = pm * 256 + wr * 64 + fr;
#pragma unroll
        for (int bj = 0; bj < 2; ++bj) { const int c = 256 * pn + 64 * wc + 32 * bj + 8 * fq;
            const f32x4 b0 = *(const f32x4*)(bglu + c), b1 = *(const f32x4*)(bglu + c + 4);
            FX_ROWLOOP { const int row = row0 + ai * 128 + m * 16;
                const u32x4 sw = *(const u32x4*)(SPRE + (size_t)row * SPRE_LD + c); f32x4 s0, s1; unpack8(sw, s0, s1);
                f32x4 z0 = acc[ai][bj][m][0] + b0, z1 = acc[ai][bj][m][1] + b1;
#pragma unroll
                for (int j = 0; j < 4; ++j) { z0[j] = s0[j] * fast_sigmoid(z0[j]); z1[j] = s1[j] * fast_sigmoid(z1[j]); }
                *(u32x4*)(MIX + (size_t)row * 1024 + c) = pack8(z0, z1); } }
    }
};
struct EpiWo {
    static constexpr bool PERM = true;
    const float* X; bf16_t* Y;
    __device__ __forceinline__ void operator()(const f32x4 (&acc)[2][2][4][2], const Unit& u, int wr, int wc, int fr, int fq) const {
        const int pm = u.i0, pn = u.i1, row0 = pm * 256 + wr * 64 + fr;
        FX_ROWLOOP { const size_t off = (size_t)(row0 + ai * 128 + m * 16) * 1024 + 256 * pn + wc * 64 + 8 * fq;
#pragma unroll
            for (int bj = 0; bj < 2; ++bj) { const f32x4 x0 = *(const f32x4*)(X + off + bj * 32), x1 = *(const f32x4*)(X + off + bj * 32 + 4);
                *(u32x4*)(Y + off + bj * 32) = pack8(x0 * ALPHA + acc[ai][bj][m][0], x1 * ALPHA + acc[ai][bj][m][1]); } }
    }
};
struct EpiSharedRouter {
    static constexpr bool PERM = true;
    bf16_t* HS; float* LG;
    __device__ __forceinline__ void operator()(const f32x4 (&acc)[2][2][4][2], const Unit& u, int wr, int wc, int fr, int fq) const {
        const int pm = u.i0, pn = u.i1, row0 = pm * 256 + wr * 64 + fr;
        if (pn < 2) {
            const int c = 128 * pn + 32 * wc + 8 * fq;
            FX_ROWLOOP { f32x4 h0, h1;
#pragma unroll
                for (int j = 0; j < 4; ++j) { const float g0 = acc[ai][0][m][0][j], g1 = acc[ai][0][m][1][j];
                    h0[j] = g0 * fast_sigmoid(g0) * acc[ai][1][m][0][j]; h1[j] = g1 * fast_sigmoid(g1) * acc[ai][1][m][1][j]; }
                *(u32x4*)(HS + (size_t)(row0 + ai * 128 + m * 16) * 256 + c) = pack8(h0, h1); }
        } else if (wc == 0) {
            FX_ROWLOOP { float* rp = LG + (size_t)(row0 + ai * 128 + m * 16) * 64 + 8 * fq;
#pragma unroll
                for (int bj = 0; bj < 2; ++bj) { *(f32x4*)(rp + bj * 32) = acc[ai][bj][m][0]; *(f32x4*)(rp + bj * 32 + 4) = acc[ai][bj][m][1]; } }
        }
    }
};

struct MoeTab { LAS int* tbase; LAS unsigned* tab; };
__device__ __forceinline__ MoeTab moe_tab(LAS unsigned char* lds) { MoeTab t; t.tbase = (LAS int*)(lds + TAB_OFF); t.tab = (LAS unsigned*)(lds + TAB_OFF + 2304); return t; }
__device__ __forceinline__ int ve_count(const unsigned* ctl, int ve) { return (ve % 65 == 64) ? CAPC : (int)__hip_atomic_load(ctl + CW_CNT + 64 * ve, __ATOMIC_RELAXED, __HIP_MEMORY_SCOPE_AGENT); }
__device__ __forceinline__ void moe_build_tab(LAS unsigned char* lds, const unsigned* ctl) {
    const MoeTab t = moe_tab(lds); LAS int* nt = (LAS int*)(lds + TAB_OFF + 1024 + 64);
    const int tid = threadIdx.x;
    if (tid < NVE) nt[tid] = (ve_count(ctl, tid) + 255) >> 8;
    __syncthreads();
    if (tid == 0) { int s = 0; for (int v = 0; v < NVE; ++v) { t.tbase[v] = s; s += nt[v]; } t.tbase[NVE] = s; }
    __syncthreads();
    for (int v = tid; v < NVE; v += 512) { const int b = t.tbase[v], n = t.tbase[v + 1] - b; for (int j = 0; j < n; ++j) t.tab[b + j] = (unsigned)v | ((unsigned)j << 16); }
    __syncthreads();
}
struct GateUpOrder {
    const char* X1B; const char* WGU; MoeTab tb; LAS int* idx; int nunits, G, c;
    int tb0;
    __device__ __forceinline__ int tile_of(int tr) const { return tb0 + tr; }
    __device__ __forceinline__ void init(LAS unsigned char* lds, const void* x1b, const void* wgu, const int* rowtok, const unsigned* ctl, int chn, int G_, int c_) {
        X1B = (const char*)x1b; WGU = (const char*)wgu; tb = moe_tab(lds); idx = (LAS int*)(lds + IDX_OFF); G = G_; c = c_;
        tb0 = tb.tbase[chn * 65]; nunits = 2 * (tb.tbase[chn * 65 + 64] - tb0);
        __syncthreads();
        for (int i = 0; i < IDX_UNITS; ++i) { const long L = (long)i * G + c; if (L >= nunits) break;
            const int tile = tile_of(xcd_remap((int)L, nunits) >> 1); const unsigned e = tb.tab[tile]; const int ve = (int)(e & 0xffffu), tix = (int)(e >> 16), ch = ve / 65, ex = ve % 65;
            const int cnt = ve_count(ctl, ve);
            if (threadIdx.x < 256) { const int slot = tix * 256 + (int)threadIdx.x; idx[i * 256 + threadIdx.x] = slot < cnt ? rowtok[(size_t)(ch * 64 + ex) * CAPC + slot] : ch * CAPC; } }
        __syncthreads();
    }
    __device__ __forceinline__ bool next(int i, Unit& u) const {
        const long L = (long)i * G + c; if (L >= nunits) return false;
        const int wgid = xcd_remap((int)L, nunits), tile = tile_of(wgid >> 1), pn = wgid & 1;
        const int ex = (int)(tb.tab[tile] & 0xffffu) % 65;
        u.A = X1B; u.B = WGU + ((size_t)ex * 512 + (size_t)pn * 256) * 1024 * 2; u.i0 = tile * 256; u.i1 = pn; u.i2 = 0; u.i3 = i < IDX_UNITS ? i : IDX_UNITS - 1; return true;
    }
    __device__ __forceinline__ void gather(const Unit& u, int R0, int C0, int R1, int C1, unsigned& g00, unsigned& g01, unsigned& g10, unsigned& g11) const {
        const LAS int* ip = idx + u.i3 * 256;
        g00 = (unsigned)ip[R0] * 2048u + (unsigned)C0 * 2u; g01 = (unsigned)ip[R1] * 2048u + (unsigned)C1 * 2u;
        g10 = (unsigned)ip[128 + R0] * 2048u + (unsigned)C0 * 2u; g11 = (unsigned)ip[128 + R1] * 2048u + (unsigned)C1 * 2u;
    }
};
struct EpiGateUp {
    static constexpr bool PERM = true;
    bf16_t* H;
    __device__ __forceinline__ void operator()(const f32x4 (&acc)[2][2][4][2], const Unit& u, int wr, int wc, int fr, int fq) const {
        const int hrow0 = u.i0 + wr * 64 + fr, c = 128 * u.i1 + 32 * wc + 8 * fq;
        FX_ROWLOOP { f32x4 h0, h1;
#pragma unroll
            for (int j = 0; j < 4; ++j) { const float g0 = acc[ai][0][m][0][j], g1 = acc[ai][0][m][1][j];
                h0[j] = g0 * fast_sigmoid(g0) * acc[ai][1][m][0][j]; h1[j] = g1 * fast_sigmoid(g1) * acc[ai][1][m][1][j]; }
            *(u32x4*)(H + (size_t)(hrow0 + ai * 128 + m * 16) * 256 + c) = pack8(h0, h1); }
    }
};
struct DownOrder {
    const char* Hh; const char* HS; const char* WD; MoeTab tb; int t0, nunits, G, c, chn;
    __device__ __forceinline__ void init(const void* h, const void* hs, const void* wd, MoeTab tb_, int ch, int G_, int c_) { Hh = (const char*)h; HS = (const char*)hs; WD = (const char*)wd; tb = tb_; chn = ch; t0 = tb_.tbase[ch * 65]; nunits = 4 * (tb_.tbase[(ch + 1) * 65] - t0); G = G_; c = c_; }
    __device__ __forceinline__ bool next(int i, Unit& u) const {
        const long L = (long)i * G + c; if (L >= nunits) return false;
        const int wgid = xcd_remap((int)L, nunits), tile = t0 + (wgid >> 2), pn = wgid & 3;
        const int ex = (int)(tb.tab[tile] & 0xffffu) % 65;
        u.A = ex == 64 ? HS + ((size_t)chn * CAPC + (size_t)(tb.tab[tile] >> 16) * 256) * 256 * 2 : Hh + (size_t)tile * 256 * 256 * 2; u.B = WD + ((size_t)ex * 1024 + (size_t)pn * 256) * 256 * 2; u.i0 = ex == 64 ? (int)(tb.tab[tile] >> 16) * 256 : (tile - t0) * 256; u.i1 = pn; u.i2 = ex == 64; u.i3 = 0; return true;
    }
};
constexpr float Y8_SCALE = 32.f, Y8_INV = 1.f / 32.f;
__device__ __forceinline__ u32x2 pack8_fp8(const f32x4 a, const f32x4 b) {
    int w0 = 0, w1 = 0;
    w0 = __builtin_amdgcn_cvt_pk_fp8_f32(a[0] * Y8_SCALE, a[1] * Y8_SCALE, w0, false); w0 = __builtin_amdgcn_cvt_pk_fp8_f32(a[2] * Y8_SCALE, a[3] * Y8_SCALE, w0, true);
    w1 = __builtin_amdgcn_cvt_pk_fp8_f32(b[0] * Y8_SCALE, b[1] * Y8_SCALE, w1, false); w1 = __builtin_amdgcn_cvt_pk_fp8_f32(b[2] * Y8_SCALE, b[3] * Y8_SCALE, w1, true);
    u32x2 r; r.x = (unsigned)w0; r.y = (unsigned)w1; return r;
}
__device__ __forceinline__ void unpack8_fp8(const u32x2 w, f32x4& a, f32x4& b) {
    const f32x2 p0 = __builtin_amdgcn_cvt_pk_f32_fp8((int)w.x, false), p1 = __builtin_amdgcn_cvt_pk_f32_fp8((int)w.x, true);
    const f32x2 p2 = __builtin_amdgcn_cvt_pk_f32_fp8((int)w.y, false), p3 = __builtin_amdgcn_cvt_pk_f32_fp8((int)w.y, true);
    a = (f32x4){p0.x, p0.y, p1.x, p1.y}; b = (f32x4){p2.x, p2.y, p3.x, p3.y};
}
struct EpiDown {
    static constexpr bool PERM = true;
    unsigned char* Y8; bf16_t* YS;
    __device__ __forceinline__ void operator()(const f32x4 (&acc)[2][2][4][2], const Unit& u, int wr, int wc, int fr, int fq) const {
        const int yrow0 = u.i0 + wr * 64 + fr, c0 = 256 * u.i1 + 64 * wc + 8 * fq;
        if (u.i2) {
            FX_ROWLOOP { bf16_t* rp = YS + (size_t)(yrow0 + ai * 128 + m * 16) * 1024 + c0;
#pragma unroll
                for (int bj = 0; bj < 2; ++bj) *(u32x4*)(rp + bj * 32) = pack8(acc[ai][bj][m][0], acc[ai][bj][m][1]); }
        } else {
            FX_ROWLOOP { unsigned char* rp = Y8 + (size_t)(yrow0 + ai * 128 + m * 16) * 1024 + c0;
#pragma unroll
                for (int bj = 0; bj < 2; ++bj) *(u32x2*)(rp + bj * 32) = pack8_fp8(acc[ai][bj][m][0], acc[ai][bj][m][1]); }
        }
    }
};
}
namespace fx {
namespace att {
constexpr int NW = 8, QBLK = 32, KVBLK = 64;
constexpr int SHM_V = 16384, SHM_K = 16384, SHM_ATTN = 2 * SHM_V + 2 * SHM_K + NW * 64 * 4;
constexpr float THRL = 8.f;
#define KSWZ(row, colB) ((row) * 256 + ((colB) ^ (((row) & 7) << 4)))
#define SBAR() __builtin_amdgcn_sched_barrier(0)
__device__ __forceinline__ int crow(int r, int hi) { return (r & 3) + 8 * (r >> 2) + 4 * hi; }
__device__ __forceinline__ void partialSM(f32x16& p0, f32x16& p1, float& m_reg, float& mn, float& alpha) {
  float pmax = p0[0];
#pragma unroll
  for (int r = 1; r < 16; ++r) pmax = fmaxf(pmax, p0[r]);
#pragma unroll
  for (int r = 0; r < 16; ++r) pmax = fmaxf(pmax, p1[r]);
  { auto rr = __builtin_amdgcn_permlane32_swap(__float_as_uint(pmax), __float_as_uint(pmax), false, false);
    pmax = fmaxf(__uint_as_float(rr[0]), __uint_as_float(rr[1])); }
  if (__builtin_expect(__all(pmax - m_reg <= THRL), 1)) { mn = m_reg; alpha = 1.f; }
  else { mn = fmaxf(m_reg, pmax); alpha = __builtin_amdgcn_exp2f(m_reg - mn); m_reg = mn; }
#pragma unroll
  for (int r = 0; r < 16; ++r) p0[r] = p0[r] - mn;
#pragma unroll
  for (int r = 0; r < 16; ++r) p1[r] = p1[r] - mn;
#pragma unroll
  for (int r = 0; r < 16; ++r) p0[r] = __builtin_amdgcn_exp2f(p0[r]);
}
__device__ __forceinline__ void finishSM(f32x16& p0, f32x16& p1, float alpha, float& l_reg, bf16x8& pa0, bf16x8& pa1, bf16x8& pa2, bf16x8& pa3) {
#pragma unroll
  for (int r = 0; r < 16; ++r) p1[r] = __builtin_amdgcn_exp2f(p1[r]);
  float ps = 0;
#pragma unroll
  for (int r = 0; r < 16; ++r) ps += p0[r];
#pragma unroll
  for (int r = 0; r < 16; ++r) ps += p1[r];
  { auto rr = __builtin_amdgcn_permlane32_swap(__float_as_uint(ps), __float_as_uint(ps), false, false);
    ps = __uint_as_float(rr[0]) + __uint_as_float(rr[1]); }
  l_reg = l_reg * alpha + ps;
#define PK4(P, BASE, OUT) do { unsigned a0 = cvt_pk_bf16(P[BASE + 0], P[BASE + 1]), a1 = cvt_pk_bf16(P[BASE + 2], P[BASE + 3]);   \
    unsigned b0 = cvt_pk_bf16(P[BASE + 4], P[BASE + 5]), b1 = cvt_pk_bf16(P[BASE + 6], P[BASE + 7]);                              \
    auto r0 = __builtin_amdgcn_permlane32_swap(a0, b0, false, false); auto r1 = __builtin_amdgcn_permlane32_swap(a1, b1, false, false); \
    u32x4 w = {r0[0], r1[0], r0[1], r1[1]}; OUT = *reinterpret_cast<bf16x8*>(&w); } while (0)
  PK4(p0, 0, pa0); PK4(p0, 8, pa1); PK4(p1, 0, pa2); PK4(p1, 8, pa3);
#undef PK4
}
__device__ __forceinline__ void qkt(f32x16& p0, f32x16& p1, const char* Ks, const bf16x8 (&qr)[6], int r32, int hi) {
  p0 = f32x16{}; p1 = f32x16{};
#pragma unroll
  for (int d0 = 0; d0 < 6; ++d0) { const int cb = (d0 * 16 + hi * 8) * 2;
    const bf16x8 b0 = *reinterpret_cast<const bf16x8*>(Ks + KSWZ(r32, cb));
    const bf16x8 b1 = *reinterpret_cast<const bf16x8*>(Ks + KSWZ(32 + r32, cb));
    p0 = __builtin_amdgcn_mfma_f32_32x32x16_bf16(b0, qr[d0], p0, 0, 0, 0);
    p1 = __builtin_amdgcn_mfma_f32_32x32x16_bf16(b1, qr[d0], p1, 0, 0, 0); }
}
__device__ __forceinline__ int v_st(int k, int c) { const int kk = (k & ~0xC) | ((k & 4) << 1) | ((k & 8) >> 1); return ((kk >> 3) * 4 + (c >> 5)) * 512 + ((kk & 7) * 32 + (c & 31)) * 2; }
__device__ __forceinline__ int v_rd_base(int lane) { return ((lane & 3) << 3) | (((lane >> 2) & 3) << 6) | (((lane >> 4) & 1) << 5) | (((lane >> 5) & 1) << 8); }
constexpr int v_rd_off(int d0, int ks, int half) { return d0 * 512 + ks * 4096 + half * 2048; }
template <int OFF> __device__ __forceinline__ s16x4 tr_read(int vb) {
  s16x4 r; asm volatile("ds_read_b64_tr_b16 %0, %1 offset:%2" : "=&v"(r) : "v"(vb), "i"(OFF) : "memory"); return r;
}
template <int D0> __device__ __forceinline__ void pv_one(f32x16& od, int vb, bf16x8 pa0, bf16x8 pa1, bf16x8 pa2, bf16x8 pa3) {
  const s16x4 l0 = tr_read<v_rd_off(D0, 0, 0)>(vb), h0 = tr_read<v_rd_off(D0, 0, 1)>(vb), l1 = tr_read<v_rd_off(D0, 1, 0)>(vb), h1 = tr_read<v_rd_off(D0, 1, 1)>(vb);
  const s16x4 l2 = tr_read<v_rd_off(D0, 2, 0)>(vb), h2 = tr_read<v_rd_off(D0, 2, 1)>(vb), l3 = tr_read<v_rd_off(D0, 3, 0)>(vb), h3 = tr_read<v_rd_off(D0, 3, 1)>(vb);
  asm volatile("s_waitcnt lgkmcnt(0)" ::: "memory"); SBAR();
#define PK(L, H) (bf16x8){L[0], L[1], L[2], L[3], H[0], H[1], H[2], H[3]}
  od = __builtin_amdgcn_mfma_f32_32x32x16_bf16(pa0, PK(l0, h0), od, 0, 0, 0);
  od = __builtin_amdgcn_mfma_f32_32x32x16_bf16(pa1, PK(l1, h1), od, 0, 0, 0);
  od = __builtin_amdgcn_mfma_f32_32x32x16_bf16(pa2, PK(l2, h2), od, 0, 0, 0);
  od = __builtin_amdgcn_mfma_f32_32x32x16_bf16(pa3, PK(l3, h3), od, 0, 0, 0);
#undef PK
}
__device__ __forceinline__ void pv_d0(f32x16 (&o)[2], int vb, bf16x8 pa0, bf16x8 pa1, bf16x8 pa2, bf16x8 pa3) {
  pv_one<0>(o[0], vb, pa0, pa1, pa2, pa3); pv_one<1>(o[1], vb, pa0, pa1, pa2, pa3);
}
__device__ __forceinline__ void attn_unit(const unsigned char* __restrict__ wsb, const bf16_t* __restrict__ Q, bf16_t* __restrict__ MIX, int tok0, int qrow0, int h, char* lds) {
  const int tid = threadIdx.x, wid = tid >> 6, lane = tid & 63, r32 = lane & 31, hi = lane >> 5;
  char* V_lds = lds; char* K_lds = lds + 2 * SHM_V;
  float* ws = (float*)(lds + 2 * SHM_V + 2 * SHM_K) + wid * 64; float* li_l = ws; float* al_l = ws + 32;
  float m_reg = -1e30f, l_reg = 0; f32x16 o[2] = {}; bf16x8 qr[6];
  const bf16_t* Qw = Q + (size_t)(tok0 + qrow0 + wid * QBLK + r32) * 768 + h * 96 + hi * 8;
#pragma unroll
  for (int d0 = 0; d0 < 6; ++d0) qr[d0] = *reinterpret_cast<const bf16x8*>(Qw + d0 * 16);
  const int sr = tid >> 4, c16 = tid & 15, sc = c16 * 8, vst0 = v_st(sr, sc), vst1 = v_st(32 + sr, sc);
  const int vb0 = (int)(uintptr_t)V_lds + v_rd_base(lane);
  const unsigned vofs = (unsigned)WS_KV + (unsigned)(((tok0 + sr) * 1024 + h * 128 + 64 + (c16 & 7) * 8) * 2);
  const unsigned kinc = c16 < 8 ? 64u * 2048u : 64u * 512u;
  const unsigned kofs = (c16 < 8 ? (unsigned)WS_KV + (unsigned)((tok0 * 1024 + h * 128 + c16 * 8) * 2) : (unsigned)WS_CKVR + (unsigned)((tok0 * 256 + 128 + (c16 - 8) * 8) * 2)) + (unsigned)sr * (kinc >> 6);
  struct { bf16x8 vs0, vs1, ks0, ks1; } sr_[2];
#define SLOAD(i, k0) do { const unsigned vo_ = vofs + (unsigned)(k0) * 2048u, ko_ = kofs + (unsigned)((k0) >> 6) * kinc; \
    sr_[i].vs0 = *reinterpret_cast<const bf16x8*>(wsb + vo_); sr_[i].vs1 = *reinterpret_cast<const bf16x8*>(wsb + vo_ + 32u * 2048u); \
    sr_[i].ks0 = *reinterpret_cast<const bf16x8*>(wsb + ko_); sr_[i].ks1 = *reinterpret_cast<const bf16x8*>(wsb + ko_ + (kinc >> 1)); } while (0)
#define SWRITE(b, i) do { *(bf16x8*)(V_lds + (b) * SHM_V + vst0) = sr_[i].vs0;          \
    *(bf16x8*)(V_lds + (b) * SHM_V + vst1) = sr_[i].vs1; const int kc = sc * 2;               \
    *(bf16x8*)(K_lds + (b) * SHM_K + KSWZ(sr, kc)) = sr_[i].ks0;                       \
    *(bf16x8*)(K_lds + (b) * SHM_K + KSWZ(32 + sr, kc)) = sr_[i].ks1; } while (0)
#define SWAIT() asm volatile("s_waitcnt vmcnt(4)" ::: "memory")
#define RESC(a) do { if (__any((a) < 1.f)) { if (hi == 0) al_l[r32] = (a); asm volatile("s_waitcnt lgkmcnt(0)" ::: "memory"); \
    _Pragma("unroll") for (int d = 0; d < 2; ++d) _Pragma("unroll") for (int r = 0; r < 16; ++r) o[d][r] *= al_l[crow(r, hi)]; } } while (0)
  f32x16 pA0, pA1, pB0, pB1; float mnA, mnB, alA, alB; bf16x8 pa0, pa1, pa2, pa3; constexpr int NT = SEQ / KVBLK;
  constexpr int SE = 0, SO = 1;
  SLOAD(SE, 0); asm volatile("s_waitcnt vmcnt(0)" ::: "memory"); SWRITE(0, SE); __syncthreads();
  qkt(pA0, pA1, K_lds, qr, r32, hi); partialSM(pA0, pA1, m_reg, mnA, alA);
  SLOAD(SO, KVBLK); SLOAD(SE, 2 * KVBLK);
  SWAIT(); SWRITE(1, SO); __syncthreads();
  for (int j = 1; j + 1 < NT; j += 2) {
    SBAR(); qkt(pB0, pB1, K_lds + SHM_K, qr, r32, hi);
    finishSM(pA0, pA1, alA, l_reg, pa0, pa1, pa2, pa3); SBAR();
    SLOAD(SO, (j + 2) * KVBLK); SBAR();
    pv_d0(o, vb0, pa0, pa1, pa2, pa3); partialSM(pB0, pB1, m_reg, mnB, alB);
    __syncthreads(); SWAIT(); SWRITE(0, SE);
    RESC(alB); __syncthreads();
    SBAR(); qkt(pA0, pA1, K_lds, qr, r32, hi);
    finishSM(pB0, pB1, alB, l_reg, pa0, pa1, pa2, pa3); SBAR();
    if (j + 3 < NT) SLOAD(SE, (j + 3) * KVBLK); SBAR();
    pv_d0(o, vb0 + SHM_V, pa0, pa1, pa2, pa3); partialSM(pA0, pA1, m_reg, mnA, alA);
    __syncthreads(); SWAIT(); SWRITE(1, SO);
    RESC(alA); __syncthreads();
  }
  SBAR(); qkt(pB0, pB1, K_lds + SHM_K, qr, r32, hi);
  finishSM(pA0, pA1, alA, l_reg, pa0, pa1, pa2, pa3); SBAR();
  pv_d0(o, vb0, pa0, pa1, pa2, pa3); partialSM(pB0, pB1, m_reg, mnB, alB);
  __syncthreads(); RESC(alB);
  finishSM(pB0, pB1, alB, l_reg, pa0, pa1, pa2, pa3); SBAR();
  pv_d0(o, vb0 + SHM_V, pa0, pa1, pa2, pa3);
  if (hi == 0) li_l[r32] = l_reg; asm volatile("s_waitcnt lgkmcnt(0)" ::: "memory");
  bf16_t* Ow = MIX + (size_t)(tok0 + qrow0 + wid * QBLK) * 1024 + 512 + h * 64 + r32;
#pragma unroll
  for (int r = 0; r < 16; ++r) { const int orow = crow(r, hi); const float rl = __builtin_amdgcn_rcpf(li_l[orow]);
#pragma unroll
    for (int d0 = 0; d0 < 2; ++d0) Ow[(size_t)orow * 1024 + d0 * 32] = (bf16_t)(cvt_pk_bf16(o[d0][r] * rl, 0.f) & 0xffffu); }
  __syncthreads();
#undef SLOAD
#undef SWRITE
#undef SWAIT
#undef RESC
}
#undef KSWZ
#undef SBAR
}

struct Frame {
    LAS unsigned char* lds; unsigned* ctl; unsigned char* ws; float* out; const float* in[29];
    int tid, lane, wave, G, bid;
};
enum { I_X = 0, I_WIN, I_LRE, I_LIM, I_LDT, I_BRE, I_BIM, I_CRE, I_CIM, I_DSK, I_WGLU, I_BGLU, I_QG, I_WUQ, I_KVG, I_WUKV, I_WO, I_LN1G, I_LN1B, I_WR, I_RB, I_WEG, I_WEU, I_WED, I_WSG, I_WSU, I_WSD, I_LN2G, I_LN2B };

#ifndef MK_TPROBE
#define MK_TPROBE -1
#endif
#define TSUB(F, id) do { if (MK_TPROBE >= 100) { __syncthreads(); if (blockIdx.x == 0 && threadIdx.x == 0) { volatile LAS unsigned* M_ = (volatile LAS unsigned*)((F).lds + MISC_OFF); const unsigned long long tn_ = __builtin_amdgcn_s_memrealtime(); \
    const unsigned long long tl_ = ((unsigned long long)M_[17] << 32) | M_[16]; if ((id) == MK_TPROBE) { const unsigned long long d_ = tn_ - tl_; M_[18] = (unsigned)d_; M_[19] = (unsigned)(d_ >> 32); } M_[16] = (unsigned)tn_; M_[17] = (unsigned)(tn_ >> 32); } } } while (0)
template <class F> __device__ __forceinline__ void transpose_item(const F& f, bf16_t* Bt, int ldk, int k0, int n0, LAS float* scr, int lane) {
    float tv[32];
#pragma unroll
    for (int i = 0; i < 32; ++i) tv[i] = f(k0 + 2 * i + (lane >> 5), n0 + (lane & 31));
#pragma unroll
    for (int i = 0; i < 32; ++i) scr[(2 * i + (lane >> 5)) * 33 + (lane & 31)] = tv[i];
    asm volatile("s_waitcnt lgkmcnt(0)" ::: "memory");
    const int c = lane & 7;
#pragma unroll
    for (int j = 0; j < 4; ++j) { const int n = (lane >> 3) + 8 * j; const LAS float* s = scr + (8 * c) * 33 + n;
        u32x4 o; o.x = cvt_pk_bf16(s[0 * 33], s[1 * 33]); o.y = cvt_pk_bf16(s[2 * 33], s[3 * 33]); o.z = cvt_pk_bf16(s[4 * 33], s[5 * 33]); o.w = cvt_pk_bf16(s[6 * 33], s[7 * 33]);
        *(u32x4*)(Bt + (size_t)(n0 + n) * ldk + k0 + 8 * c) = o; }
    asm volatile("s_waitcnt lgkmcnt(0)" ::: "memory");
}
__device__ __forceinline__ int rope_perm_src(int p) { return (p & 1) ? 16 + (p >> 1) : (p >> 1); }
struct SsmPar { float lr, li, dt, kr, ki; };
__device__ __forceinline__ SsmPar ssm_par(const float* lam_re, const float* lam_im, const float* log_dt, int d, int g, int n) {
    SsmPar p; p.lr = fminf(lam_re[(d * 32 + g) * 64 + n], -1e-4f); p.li = lam_im[(d * 32 + g) * 64 + n]; p.dt = expf(log_dt[d * 32 + g]);
    const float x = p.lr * p.dt, th = p.li * p.dt;
    const float em1 = expm1f(x), cs = cosf(th), sn = sinf(th), sh = sinf(0.5f * th);
    const float ai = (em1 + 1.f) * sn, arm1 = em1 * cs - 2.f * sh * sh, den = p.lr * p.lr + p.li * p.li;
    p.kr = (arm1 * p.lr + ai * p.li) / den; p.ki = (ai * p.lr - arm1 * p.li) / den; return p;
}
__device__ __forceinline__ void ssm_pow_xt(float x, float th, float e, float& pr, float& pi) {
    const float mag = __builtin_amdgcn_exp2f(x * e * 1.4426950408889634f); double trd = (double)th * (double)e * 0.15915494309189535; trd -= rint(trd); const float tr = (float)trd;
    pr = mag * __builtin_amdgcn_cosf(tr); pi = mag * __builtin_amdgcn_sinf(tr);
}
__device__ __forceinline__ void ssm_pow(const SsmPar& p, float e, float& pr, float& pi) { ssm_pow_xt(p.lr * p.dt, p.li * p.dt, e, pr, pi); }

__device__ __forceinline__ void p0_ssm_item(Frame& F, int g, int j) {
    LAS float* Pr = (LAS float*)F.lds;
    LAS float* Pi = Pr + 2 * 64 * 33;
    LAS float* Br = Pi + 2 * 64 * 33;
    LAS float* Bi = Br + 2 * 64 * 16;
    LAS float* Cr = Bi + 2 * 64 * 16;
    LAS float* Ci = Cr + 2 * 16 * 64;
    LAS float* Par = Ci + 2 * 16 * 64;
    const float* lam_re = F.in[I_LRE]; const float* lam_im = F.in[I_LIM]; const float* log_dt = F.in[I_LDT];
    __syncthreads();
    if (F.tid < 128) { const SsmPar p = ssm_par(lam_re, lam_im, log_dt, F.tid >> 6, g, F.tid & 63); Par[F.tid * 4] = p.lr * p.dt; Par[F.tid * 4 + 1] = p.li * p.dt; Par[F.tid * 4 + 2] = p.kr; Par[F.tid * 4 + 3] = p.ki; }
    for (int idx = F.tid; idx < 2 * 16 * 64; idx += 512) { const int n = idx & 63, pp = (idx >> 6) & 15, d = idx >> 10;
        Cr[idx] = F.in[I_CRE][((d * 32 + g) * 16 + pp) * 64 + n]; Ci[idx] = F.in[I_CIM][((d * 32 + g) * 16 + pp) * 64 + n]; }
    __syncthreads();
    for (int idx = F.tid; idx < 2 * 64 * 33; idx += 512) { const int tau = idx % 33, dn = idx / 33; float pr, pi; ssm_pow_xt(Par[dn * 4], Par[dn * 4 + 1], (float)tau, pr, pi); Pr[idx] = pr; Pi[idx] = pi; }
    for (int idx = F.tid; idx < 2 * 64 * 16; idx += 512) { const int q = idx & 15, dn = idx >> 4, n = dn & 63, d = dn >> 6; const float kr = Par[dn * 4 + 2], ki = Par[dn * 4 + 3];
        const float br = F.in[I_BRE][((d * 32 + g) * 64 + n) * 16 + q], bi = F.in[I_BIM][((d * 32 + g) * 64 + n) * 16 + q];
        Br[idx] = kr * br - ki * bi; Bi[idx] = kr * bi + ki * br; }
    __syncthreads();
    float* Kt = (float*)(F.ws + WS_KT) + (size_t)g * 16384;
    { const int blk = 512 * j + F.tid;
      const int q2 = blk & 7, p2 = (blk >> 3) & 7, tau = (blk >> 6) & 31, d = blk >> 11; float s00 = 0.f, s01 = 0.f, s10 = 0.f, s11 = 0.f;
      for (int n = 0; n < 64; ++n) { const float pr = Pr[(d * 64 + n) * 33 + tau], pi = Pi[(d * 64 + n) * 33 + tau];
          const float b0r = Br[(d * 64 + n) * 16 + 2 * q2], b0i = Bi[(d * 64 + n) * 16 + 2 * q2], b1r = Br[(d * 64 + n) * 16 + 2 * q2 + 1], b1i = Bi[(d * 64 + n) * 16 + 2 * q2 + 1];
          const float d0r = pr * b0r - pi * b0i, d0i = pr * b0i + pi * b0r, d1r = pr * b1r - pi * b1i, d1i = pr * b1i + pi * b1r;
          const float c0r = Cr[(d * 16 + 2 * p2) * 64 + n], c0i = Ci[(d * 16 + 2 * p2) * 64 + n], c1r = Cr[(d * 16 + 2 * p2 + 1) * 64 + n], c1i = Ci[(d * 16 + 2 * p2 + 1) * 64 + n];
          s00 += c0r * d0r - c0i * d0i; s01 += c0r * d1r - c0i * d1i; s10 += c1r * d0r - c1i * d0i; s11 += c1r * d1r - c1i * d1i; }
      float* kp = Kt + ((size_t)(d * 32 + tau) * 16 + 2 * p2) * 16 + 2 * q2; kp[0] = s00; kp[1] = s01; kp[16] = s10; kp[17] = s11; }
    bf16_t* Wst = (bf16_t*)(F.ws + WS_WST) + (size_t)g * 256 * 512;
    for (int pc = F.tid; pc < 32 * 64; pc += 512) { const int row = 32 * j + (pc >> 6), k0 = (pc & 63) * 8, s = k0 >> 4, q0 = k0 & 15;
        const int d = row >> 7, ri = (row >> 6) & 1, n = row & 63, e = d ? s : (CHK - 1 - s);
        const float pr = Pr[(d * 64 + n) * 33 + e], pi = Pi[(d * 64 + n) * 33 + e]; float v[8];
#pragma unroll
        for (int t = 0; t < 8; ++t) { const float br = Br[(d * 64 + n) * 16 + q0 + t], bi = Bi[(d * 64 + n) * 16 + q0 + t]; v[t] = ri ? (pr * bi + pi * br) : (pr * br - pi * bi); }
        u32x4 o; o.x = cvt_pk_bf16(v[0], v[1]); o.y = cvt_pk_bf16(v[2], v[3]); o.z = cvt_pk_bf16(v[4], v[5]); o.w = cvt_pk_bf16(v[6], v[7]);
        *(u32x4*)(Wst + (size_t)row * 512 + k0) = o; }
    bf16_t* Mo = (bf16_t*)(F.ws + WS_MO) + (size_t)g * 512 * UHK;
    for (int pc = F.tid; pc < 64 * 32; pc += 512) { const int row = 64 * j + (pc >> 5), kk = (pc & 31) * 8, d = kk >> 7, ri = (kk >> 6) & 1, n0 = kk & 63, tq = row >> 4, pp = row & 15;
        const int e = d ? (CHK - tq) : (tq + 1); float v[8];
#pragma unroll
        for (int t = 0; t < 8; ++t) { const int n = n0 + t; const float pr = Pr[(d * 64 + n) * 33 + e], pi = Pi[(d * 64 + n) * 33 + e], cr = Cr[(d * 16 + pp) * 64 + n], ci = Ci[(d * 16 + pp) * 64 + n];
            v[t] = ri ? -(cr * pi + ci * pr) : (cr * pr - ci * pi); }
        u32x4 o; o.x = cvt_pk_bf16(v[0], v[1]); o.y = cvt_pk_bf16(v[2], v[3]); o.z = cvt_pk_bf16(v[4], v[5]); o.w = cvt_pk_bf16(v[6], v[7]);
        *(u32x4*)(Mo + (size_t)row * UHK + 512 + kk) = o; }
}

__device__ __forceinline__ void p0_prologue(Frame& F) {
    for (int it = F.bid; it < 256; it += F.G) p0_ssm_item(F, it >> 3, it & 7);
    __syncthreads();
    TSUB(F, 100);
    { float* rc = (float*)(F.ws + WS_ROPE); float* rs = rc + 2048 * 16;
      for (int idx = F.bid * 512 + F.tid; idx < 2048 * 16; idx += F.G * 512) { const int i = idx & 15, pos = idx >> 4;
          const float inv = expf(-9.210340371976184f * (float)i * (1.f / 16.f)); const float a = (float)pos * inv; rc[idx] = cosf(a); rs[idx] = sinf(a); } }
    LAS float* scr = (LAS float*)(F.lds + F.wave * 16384);
    const int gw = F.bid * 8 + F.wave, NGW = F.G * 8;
    constexpr int I_A = 512, I_B = 128, I_C = 96, I_D = 128, I_E = 128, I_F = 512, I_G = 65 * 256, I_H = 65 * 128;
    constexpr int NITEMS = I_A + I_B + I_C + I_D + I_E + I_F + I_G + I_H;
    for (int it = gw; it < NITEMS; it += NGW) {
        int r = it;
        if (r < I_A) { const float* W = F.in[I_WIN]; const int kb = r / 32, nb = r % 32;
            transpose_item([&](int k, int n) -> float { if (n >= 928) return 0.f; const int src = n < 896 ? n : 896 + rope_perm_src(n - 896); return W[(size_t)k * 928 + src]; }, (bf16_t*)(F.ws + WS_WIN), 1024, kb * 64, nb * 32, scr, F.lane); continue; } r -= I_A;
        if (r < I_B) { const float* W = F.in[I_WGLU]; const int kb = r / 16, nb = r % 16;
            transpose_item([&](int k, int n) -> float { return W[(size_t)k * 512 + n]; }, (bf16_t*)(F.ws + WS_WGLU), 512, kb * 64, nb * 32, scr, F.lane); continue; } r -= I_B;
        if (r < I_C) { const float* W = F.in[I_WUQ]; const float* gq = F.in[I_QG]; const int kb = r / 24, nb = r % 24;
            transpose_item([&](int k, int n) -> float { const int hh = n / 96, jj = n % 96; const int src = jj < 64 ? n : hh * 96 + 64 + rope_perm_src(jj - 64); return W[(size_t)k * 768 + src] * gq[k]; }, (bf16_t*)(F.ws + WS_WUQ), 256, kb * 64, nb * 32, scr, F.lane); continue; } r -= I_C;
        if (r < I_D) { const float* W = F.in[I_WUKV]; const float* gk = F.in[I_KVG]; const int kb = r / 32, nb = r % 32;
            transpose_item([&](int k, int n) -> float { return k < 128 ? W[(size_t)k * 1024 + n] * gk[k] : 0.f; }, (bf16_t*)(F.ws + WS_WUKV), 256, kb * 64, nb * 32, scr, F.lane); continue; } r -= I_D;
        if (r < I_E) { const float* W = F.in[I_WR]; const int kb = r / 8, nb = r % 8;
            transpose_item([&](int k, int n) -> float { return n < 64 ? W[(size_t)k * 64 + n] : 0.f; }, (bf16_t*)(F.ws + WS_WR), 1024, kb * 64, nb * 32, scr, F.lane); continue; } r -= I_E;
        if (r < I_F) { const float* W = F.in[I_WO]; const int kb = r / 32, nb = r % 32;
            transpose_item([&](int k, int n) -> float { return W[(size_t)k * 1024 + n]; }, (bf16_t*)(F.ws + WS_WO), 1024, kb * 64, nb * 32, scr, F.lane); continue; } r -= I_F;
        if (r < I_G) { const int e = r / 256, rr = r % 256, kb = rr / 16, nb = rr % 16;
            const float* Wg = e < 64 ? F.in[I_WEG] + (size_t)e * 1024 * 256 : F.in[I_WSG]; const float* Wu = e < 64 ? F.in[I_WEU] + (size_t)e * 1024 * 256 : F.in[I_WSU];
            transpose_item([&](int k, int n) -> float { const int r = n & 255, col = 128 * (n >> 8) + 32 * (r >> 6) + (r & 31); return ((r >> 5) & 1) ? Wu[(size_t)k * 256 + col] : Wg[(size_t)k * 256 + col]; }, (bf16_t*)(F.ws + WS_WGU) + (size_t)e * 512 * 1024, 1024, kb * 64, nb * 32, scr, F.lane); continue; } r -= I_G;
        { const int e = r / 128, rr = r % 128, kb = rr / 32, nb = rr % 32;
            const float* Wd = e < 64 ? F.in[I_WED] + (size_t)e * 256 * 1024 : F.in[I_WSD];
            transpose_item([&](int k, int n) -> float { return Wd[(size_t)k * 1024 + n]; }, (bf16_t*)(F.ws + WS_WD) + (size_t)e * 1024 * 256, 256, kb * 64, nb * 32, scr, F.lane); }
    }
    TSUB(F, 101);
    { const float* x = F.in[I_X]; bf16_t* xb = (bf16_t*)(F.ws + WS_XB); const size_t N8 = (size_t)T * DM / 8, st = (size_t)F.G * 512;
      for (size_t i = (size_t)F.bid * 512 + F.tid; i < N8; i += 4 * st) {
          f32x4 a[4], b[4];
#pragma unroll
          for (int u = 0; u < 4; ++u) { const size_t ii = i + u * st < N8 ? i + u * st : i; a[u] = __builtin_nontemporal_load((const f32x4*)(x + ii * 8)); b[u] = __builtin_nontemporal_load((const f32x4*)(x + ii * 8 + 4)); }
#pragma unroll
          for (int u = 0; u < 4; ++u) if (i + u * st < N8) *(u32x4*)(xb + (i + u * st) * 8) = pack8(a[u], b[u]); } }
    TSUB(F, 102);
}

__device__ __forceinline__ void scan_unit(Frame& F, int g, int pm) {
    const float* S = (const float*)(F.ws + WS_S); bf16_t* UH = (bf16_t*)(F.ws + WS_UH);
    {
        const int n = F.tid & 63, d = (F.tid >> 6) & 1, b = pm * 4 + (F.tid >> 7);
        const SsmPar p = ssm_par(F.in[I_LRE], F.in[I_LIM], F.in[I_LDT], d, g, n); float acr, aci; ssm_pow(p, (float)CHK, acr, aci);
        float hr = 0.f, hi = 0.f;
        const size_t rbase = (size_t)g * UHR + (size_t)b * NCHK;
#pragma unroll
        for (int hb = 0; hb < 2; ++hb) {
            float sr[32], si[32];
#pragma unroll
            for (int st = 0; st < 32; ++st) { const int ci = d ? (NCHK - 1 - (hb * 32 + st)) : (hb * 32 + st);
                sr[st] = S[(rbase + ci) * 256 + d * 128 + n]; si[st] = S[(rbase + ci) * 256 + d * 128 + 64 + n]; }
#pragma unroll
            for (int st = 0; st < 32; ++st) { const int ci = d ? (NCHK - 1 - (hb * 32 + st)) : (hb * 32 + st);
                bf16_t* hp = UH + (rbase + ci) * UHK + 512 + d * 128 + n;
                hp[0] = (bf16_t)(cvt_pk_bf16(hr, 0.f) & 0xffffu); hp[64] = (bf16_t)(cvt_pk_bf16(hi, 0.f) & 0xffffu);
                const float nr = acr * hr - aci * hi + sr[st], ni = acr * hi + aci * hr + si[st]; hr = nr; hi = ni; }
        }
    }
}
__device__ __forceinline__ void mo_fill(Frame& F) {
    const float* Kt = (const float*)(F.ws + WS_KT); bf16_t* Mo = (bf16_t*)(F.ws + WS_MO);
    for (int pc = F.bid * 512 + F.tid; pc < 32 * 512 * 64; pc += F.G * 512) {
        const int k0 = (pc & 63) * 8, row = (pc >> 6) & 511, g = pc >> 15, s = k0 >> 4, q0 = k0 & 15, tq = row >> 4, pp = row & 15;
        f32x4 v0 = {0.f, 0.f, 0.f, 0.f}, v1 = {0.f, 0.f, 0.f, 0.f};
        if (tq >= s) { const float* kp = Kt + ((size_t)(g * 2 + 0) * 32 + (tq - s)) * 256 + pp * 16 + q0; v0 += *(const f32x4*)kp; v1 += *(const f32x4*)(kp + 4); }
        if (s >= tq) { const float* kp = Kt + ((size_t)(g * 2 + 1) * 32 + (s - tq)) * 256 + pp * 16 + q0; v0 += *(const f32x4*)kp; v1 += *(const f32x4*)(kp + 4); }
        *(u32x4*)(Mo + ((size_t)g * 512 + row) * UHK + k0) = pack8(v0, v1);
    }
}

__device__ __forceinline__ void p7_ln1(Frame& F) {
    const float* g1 = F.in[I_LN1G]; const float* b1 = F.in[I_LN1B]; bf16_t* x1b = (bf16_t*)(F.ws + WS_X1B);
    f32x4 gg[4], bb[4];
#pragma unroll
    for (int j = 0; j < 4; ++j) { const int c = 8 * F.lane + (j >> 1) * 512 + (j & 1) * 4; gg[j] = *(const f32x4*)(g1 + c); bb[j] = *(const f32x4*)(b1 + c); }
    for (int row = F.bid * 8 + F.wave; row < T; row += F.G * 8) {
        bf16_t* rp = x1b + (size_t)row * 1024 + 8 * F.lane; f32x4 v[4];
        { const u32x4 w0 = *(const u32x4*)rp, w1 = *(const u32x4*)(rp + 512); unpack8(w0, v[0], v[1]); unpack8(w1, v[2], v[3]); }
        float s = 0.f;
#pragma unroll
        for (int j = 0; j < 4; ++j) s += (v[j][0] + v[j][1]) + (v[j][2] + v[j][3]);
        const float mean = wave_sum(s) * (1.f / 1024.f); float q = 0.f;
#pragma unroll
        for (int j = 0; j < 4; ++j) { v[j] = v[j] - mean; q += (v[j][0] * v[j][0] + v[j][1] * v[j][1]) + (v[j][2] * v[j][2] + v[j][3] * v[j][3]); }
        const float rstd = __builtin_amdgcn_rsqf(wave_sum(q) * (1.f / 1024.f) + LN_EPS);
#pragma unroll
        for (int j = 0; j < 4; ++j) v[j] = v[j] * rstd * gg[j] + bb[j];
        *(u32x4*)rp = pack8(v[0], v[1]); *(u32x4*)(rp + 512) = pack8(v[2], v[3]);
    }
}

__device__ __forceinline__ void route_batch(Frame& F, int bt) {
    LAS int* hist = (LAS int*)(F.lds); LAS int* base = hist + 64;
    const float* LG = (const float*)(F.ws + WS_LOGIT); int* rowtok = (int*)(F.ws + WS_ROWTOK); int* tslot = (int*)(F.ws + WS_TSLOT); float* topw = (float*)(F.ws + WS_TOPW);
    {
        __syncthreads();
        if (F.tid < 64) hist[F.tid] = 0;
        __syncthreads();
        const int tok = bt * 256 + F.tid, ch = (bt * 256) / CAPC;
        int idx[6], lr[6]; float w[6];
        if (F.tid < 256) {
            float lg[64];
#pragma unroll
            for (int j = 0; j < 16; ++j) { const f32x4 v = *(const f32x4*)(LG + (size_t)tok * 64 + 4 * j); lg[4 * j] = v[0]; lg[4 * j + 1] = v[1]; lg[4 * j + 2] = v[2]; lg[4 * j + 3] = v[3]; }
            route_token(lg, F.in[I_RB], idx, w);
#pragma unroll
            for (int k = 0; k < 6; ++k) lr[k] = atomicAdd((int*)&hist[idx[k]], 1);
        }
        __syncthreads();
        if (F.tid < 64) base[F.tid] = (int)__hip_atomic_fetch_add(F.ctl + CW_CNT + 64 * (ch * 65 + F.tid), (unsigned)hist[F.tid], __ATOMIC_RELAXED, __HIP_MEMORY_SCOPE_AGENT);
        __syncthreads();
        if (F.tid < 256) {
#pragma unroll
            for (int k = 0; k < 6; ++k) { const int slot = base[idx[k]] + lr[k];
                rowtok[(size_t)(ch * 64 + idx[k]) * CAPC + slot] = tok; tslot[(size_t)tok * 8 + k] = (idx[k] << 16) | slot; topw[(size_t)tok * 8 + k] = w[k]; }
        }
    }
}

__device__ __forceinline__ void p12_combine(Frame& F, int ch) {
    const MoeTab tb = moe_tab(F.lds); const int t0 = tb.tbase[ch * 65];
    const unsigned char* Y8 = F.ws + WS_Y; const bf16_t* YS = (const bf16_t*)(F.ws + WS_YS); const bf16_t* x1b = (const bf16_t*)(F.ws + WS_X1B);
    const int* tslot = (const int*)(F.ws + WS_TSLOT); const float* topw = (const float*)(F.ws + WS_TOPW);
    const float* g2 = F.in[I_LN2G]; const float* b2 = F.in[I_LN2B];
    f32x4 gg[4], bb[4];
#pragma unroll
    for (int j = 0; j < 4; ++j) { const int c = 8 * F.lane + (j >> 1) * 512 + (j & 1) * 4; gg[j] = *(const f32x4*)(g2 + c); bb[j] = *(const f32x4*)(b2 + c); }
    constexpr int NTK = 4;
    const int stride = F.G * 8;
    for (int tk0 = F.bid * 8 + F.wave; tk0 < CAPC; tk0 += NTK * stride) {
        int ts[NTK][6]; float tw[NTK][6];
#pragma unroll
        for (int t = 0; t < NTK; ++t) { const int tk = tk0 + t * stride < CAPC ? tk0 + t * stride : tk0; const size_t tok = (size_t)ch * CAPC + tk;
#pragma unroll
            for (int k = 0; k < 6; ++k) { ts[t][k] = tslot[tok * 8 + k]; tw[t][k] = topw[tok * 8 + k]; } }
        u32x4 xw[NTK][2], sw[NTK][2]; u32x2 yw[NTK][6][2];
#pragma unroll
        for (int t = 0; t < NTK; ++t) { const int tk = tk0 + t * stride < CAPC ? tk0 + t * stride : tk0; const size_t tok = (size_t)ch * CAPC + tk;
            const bf16_t* xr = x1b + tok * 1024 + 8 * F.lane; xw[t][0] = *(const u32x4*)xr; xw[t][1] = *(const u32x4*)(xr + 512);
            const bf16_t* yr = YS + (size_t)tk * 1024 + 8 * F.lane; sw[t][0] = *(const u32x4*)yr; sw[t][1] = *(const u32x4*)(yr + 512);
#pragma unroll
            for (int k = 0; k < 6; ++k) { const int yrow = (tb.tbase[ch * 65 + (ts[t][k] >> 16)] - t0) * 256 + (ts[t][k] & 0xffff);
                const unsigned char* y8 = Y8 + (size_t)yrow * 1024 + 8 * F.lane; yw[t][k][0] = *(const u32x2*)y8; yw[t][k][1] = *(const u32x2*)(y8 + 512); } }
#pragma unroll
        for (int t = 0; t < NTK; ++t) {
            const int tk = tk0 + t * stride; if (tk >= CAPC) break;
            const size_t tok = (size_t)ch * CAPC + tk;
            f32x4 a[4]; unpack8(xw[t][0], a[0], a[1]); unpack8(xw[t][1], a[2], a[3]); a[0] *= ALPHA; a[1] *= ALPHA; a[2] *= ALPHA; a[3] *= ALPHA;
            { f32x4 y0, y1, y2, y3; unpack8(sw[t][0], y0, y1); unpack8(sw[t][1], y2, y3); a[0] += y0; a[1] += y1; a[2] += y2; a[3] += y3; }
#pragma unroll
            for (int k = 0; k < 6; ++k) { const float w = tw[t][k] * Y8_INV; f32x4 y0, y1, y2, y3; unpack8_fp8(yw[t][k][0], y0, y1); unpack8_fp8(yw[t][k][1], y2, y3);
                a[0] += y0 * w; a[1] += y1 * w; a[2] += y2 * w; a[3] += y3 * w; }
            float s = 0.f;
#pragma unroll
            for (int j = 0; j < 4; ++j) s += (a[j][0] + a[j][1]) + (a[j][2] + a[j][3]);
            const float mean = wave_sum(s) * (1.f / 1024.f); float q = 0.f;
#pragma unroll
            for (int j = 0; j < 4; ++j) { a[j] = a[j] - mean; q += (a[j][0] * a[j][0] + a[j][1] * a[j][1]) + (a[j][2] * a[j][2] + a[j][3] * a[j][3]); }
            const float rstd = __builtin_amdgcn_rsqf(wave_sum(q) * (1.f / 1024.f) + LN_EPS);
            float* orow = F.out + tok * 1024 + 8 * F.lane;
#pragma unroll
            for (int j = 0; j < 4; ++j) *(f32x4*)(orow + (j >> 1) * 512 + (j & 1) * 4) = a[j] * rstd * gg[j] + bb[j];
        }
    }
}
}

namespace fx {
constexpr int NPHASE = 11 + 2 * NCH;
struct Args { const float* in[29]; float* out; unsigned char* ws; int ph_lo, ph_hi; };

__global__ void __launch_bounds__(512, 2) fwd(Args args) {
    extern __shared__ __attribute__((aligned(16))) unsigned char lds_raw[];
    Frame F;
    F.lds = (LAS unsigned char*)lds_raw; F.ws = args.ws; F.ctl = (unsigned*)(args.ws + WS_CTL); F.out = args.out;
#pragma unroll
    for (int i = 0; i < 29; ++i) F.in[i] = args.in[i];
    F.tid = threadIdx.x; F.lane = F.tid & 63; F.wave = __builtin_amdgcn_readfirstlane(F.tid >> 6); F.G = gridDim.x; F.bid = blockIdx.x;
    volatile LAS unsigned* MISC = (volatile LAS unsigned*)(F.lds + MISC_OFF);
    if (F.tid < 32) MISC[F.tid] = 0u;
    __syncthreads();
    const int lo = args.ph_lo, hi = args.ph_hi;
    XcdBarrier bar; bar.bar = F.ctl + CW_BAR; bar.x = 0; bar.st = MISC + 8;
    if (hi - lo > 1) bar = xcd_barrier_post(F.ctl + CW_BAR, MISC + 8);
#ifndef PH_MASK
#define PH_MASK 0xFFFFFFFFu
#endif
#define IN(k) (((PH_MASK >> ((k) > 11 ? 11 + (((k) - 11) & 1) : (k))) & 1u) && lo <= (k) && (k) < hi)
#define SEAM(k) do { if (IN(k) && IN((k) + 1)) xcd_barrier(bar); if (MK_TPROBE >= 0 && blockIdx.x == 0 && threadIdx.x == 0) { const unsigned long long tn_ = __builtin_amdgcn_s_memrealtime(); \
        const unsigned long long tl_ = ((unsigned long long)MISC[17] << 32) | MISC[16]; if ((k) == MK_TPROBE && MK_TPROBE < 100) { const unsigned long long d_ = tn_ - tl_; MISC[18] = (unsigned)d_; MISC[19] = (unsigned)(d_ >> 32); } if (MK_TPROBE == 200 + (k)) { MISC[18] = MISC[22]; MISC[19] = MISC[23]; } MISC[22] = 0u; MISC[23] = 0u; MISC[16] = (unsigned)tn_; MISC[17] = (unsigned)(tn_ >> 32); } } while (0)
    unsigned char* ws = args.ws;
    bf16_t* UH = (bf16_t*)(ws + WS_UH); bf16_t* CQ = (bf16_t*)(ws + WS_CQ); bf16_t* CKVR = (bf16_t*)(ws + WS_CKVR); bf16_t* Qb = (bf16_t*)(ws + WS_Q); bf16_t* KVb = (bf16_t*)(ws + WS_KV);
    bf16_t* SPRE = (bf16_t*)(ws + WS_SPRE); bf16_t* MIX = (bf16_t*)(ws + WS_MIX);
    float* ssqq = (float*)(ws + WS_SSQQ); float* ssqkv = (float*)(ws + WS_SSQKV); const float* ropec = (const float*)(ws + WS_ROPE); const float* ropes = ropec + 2048 * 16;

    if (MK_TPROBE >= 0 && blockIdx.x == 0 && threadIdx.x == 0) { const unsigned long long tn_ = __builtin_amdgcn_s_memrealtime(); MISC[16] = (unsigned)tn_; MISC[17] = (unsigned)(tn_ >> 32); }
    if (IN(0)) { REP(0) p0_prologue(F); } SEAM(0);
    if (IN(1)) DUP2(1, {
        PlainOrder S; S.init(ws + WS_XB, 1024, ws + WS_WIN, 1024, T, 1024, F.G, F.bid);
        EpiWin E{UH, CQ, CKVR, ssqq, ssqkv, ropec, ropes};
        gemm_phase<EpiWin, PlainOrder, true, false>(F.lds, 1024, 1024, 1024, S, E);
    }); SEAM(1);
    if (IN(2)) {
        { GroupOrder S; S.init(UH, ws + WS_WST, 512, 1, F.G, F.bid); EpiSt E{(float*)(ws + WS_S)};
          gemm_phase<EpiSt, GroupOrder, true, false>(F.lds, UHK, 512, 512, S, E);
          asm volatile("s_waitcnt vmcnt(0)" ::: "memory"); __syncthreads();
          Unit u; for (int i = 0; S.next(i, u); ++i) scan_unit(F, u.i0, u.i1); }
        mo_fill(F);
        { PlainOrder S; S.init(CQ, 256, ws + WS_WUQ, 256, T, 768, F.G, F.bid); EpiQ E{Qb, ssqq, ropec, ropes};
          gemm_phase<EpiQ, PlainOrder, true, false>(F.lds, 256, 256, 256, S, E); }
        { PlainOrder S; S.init(CKVR, 256, ws + WS_WUKV, 256, T, 1024, F.G, F.bid); EpiKV E{KVb, ssqkv};
          gemm_phase<EpiKV, PlainOrder, true, false>(F.lds, 256, 256, 256, S, E); }
    } SEAM(2);
    if (IN(4)) {
#ifndef SUB4
#define SUB4 3
#endif
        if (SUB4 & 2) REP(40) for (int i = 0;; ++i) { const long L = (long)i * F.G + F.bid; if (L >= 2048) break;
            const int un = xcd_remap((int)L, 2048), pair = un >> 3, qb = un & 7, b = pair >> 3, h = pair & 7;
            att::attn_unit(ws, Qb, MIX, b * SEQ, qb * 256, h, (char*)lds_raw); }
        if (SUB4 & 1) DUP2(4, { GroupOrder S; S.init(UH, ws + WS_MO, UHK, 2, F.G, F.bid); EpiSsmOut E{UH, SPRE, F.in[I_DSK]};
          gemm_phase<EpiSsmOut, GroupOrder, true, false>(F.lds, UHK, UHK, UHK, S, E); });
    } SEAM(4);
    if (IN(5)) DUP2(5, {
        PlainOrder S; S.init(SPRE, SPRE_LD, ws + WS_WGLU, 512, T, 512, F.G, F.bid); EpiGlu E{SPRE, MIX, F.in[I_BGLU]};
        gemm_phase<EpiGlu, PlainOrder, true, false>(F.lds, SPRE_LD, 512, 512, S, E);
    }); SEAM(5);
    if (IN(6)) DUP2(6, {
        PlainOrder S; S.init(MIX, 1024, ws + WS_WO, 1024, T, 1024, F.G, F.bid); EpiWo E{F.in[I_X], (bf16_t*)(ws + WS_X1B)};
        gemm_phase<EpiWo, PlainOrder, true, false>(F.lds, 1024, 1024, 1024, S, E);
    }); SEAM(6);
    if (IN(7)) { p7_ln1(F); } SEAM(7);
    if (IN(8)) {
        PlainOrder S; S.init(ws + WS_X1B, 1024, ws + WS_WGU + (size_t)64 * 512 * 1024 * 2, 1024, T, 768, F.G, F.bid); EpiSharedRouter E{(bf16_t*)(ws + WS_HS), (float*)(ws + WS_LOGIT)};
        gemm_phase<EpiSharedRouter, PlainOrder, true, false>(F.lds, 1024, 1024, 1024, S, E);
        asm volatile("s_waitcnt vmcnt(0)" ::: "memory"); __syncthreads();
        Unit u; for (int i = 0; S.next(i, u); ++i) if (u.i1 == 2) route_batch(F, u.i0);
    } SEAM(8);
    if (IN(10)) {
        moe_build_tab(F.lds, F.ctl);
        GateUpOrder S; S.init(F.lds, ws + WS_X1B, ws + WS_WGU, (const int*)(ws + WS_ROWTOK), F.ctl, 0, F.G, F.bid); EpiGateUp E{(bf16_t*)(ws + WS_H)};
        gemm_phase<EpiGateUp, GateUpOrder, true, true>(F.lds, 1024, 1024, 1024, S, E);
    } SEAM(10);
#pragma unroll
    for (int ch = 0; ch < NCH; ++ch) {
        if (IN(11 + 2 * ch)) {
            moe_build_tab(F.lds, F.ctl);
            { DownOrder S; S.init(ws + WS_H, ws + WS_HS, ws + WS_WD, moe_tab(F.lds), ch, F.G, F.bid); EpiDown E{ws + WS_Y, (bf16_t*)(ws + WS_YS)};
              gemm_phase<EpiDown, DownOrder, true, false>(F.lds, 256, 256, 256, S, E); }
            if (ch + 1 < NCH) { GateUpOrder S; S.init(F.lds, ws + WS_X1B, ws + WS_WGU, (const int*)(ws + WS_ROWTOK), F.ctl, ch + 1, F.G, F.bid); EpiGateUp E{(bf16_t*)(ws + WS_H)};
              gemm_phase<EpiGateUp, GateUpOrder, true, true>(F.lds, 1024, 1024, 1024, S, E); }
        } SEAM(11 + 2 * ch);
        if (IN(12 + 2 * ch)) { moe_build_tab(F.lds, F.ctl); p12_combine(F, ch); } SEAM(12 + 2 * ch);
    }
    if (MK_TPROBE >= 0 && blockIdx.x == 0 && threadIdx.x == 0) { const unsigned long long d_ = ((unsigned long long)MISC[19] << 32) | MISC[18]; const unsigned long long t0_ = __builtin_amdgcn_s_memrealtime();
        while (__builtin_amdgcn_s_memrealtime() - t0_ < 8ull * d_) __builtin_amdgcn_s_sleep(8); }
#undef IN
#undef SEAM
}

#if MK_DEBUG
__global__ void dbg_cmp(int k, const unsigned char* ws, const float* out_fast, gold::Bufs B, const float* gx1, const float* gout, float* acc) {
    const int t = blockIdx.x;
    float num = 0.f, den = 0.f;
    auto bf = [](const bf16_t* p, size_t i) -> float { return __uint_as_float(((unsigned)p[i]) << 16); };
    int ncol = 0;
    switch (k) { case 0: ncol = 512; break; case 1: ncol = 256; break; case 2: ncol = 160; break; case 3: ncol = 768; break; case 4: ncol = 1024; break; case 5: ncol = 512; break; case 6: ncol = 512; break; case 7: ncol = 512; break; case 8: ncol = 1024; break; default: ncol = 1024; }
    for (int c = threadIdx.x; c < ncol; c += blockDim.x) {
        float f = 0.f, g = 0.f;
        if (k == 0) { const int gg = c >> 4, p = c & 15; f = bf((const bf16_t*)(ws + WS_UH), ((size_t)gg * UHR + (t >> 5)) * UHK + (t & 31) * 16 + p); g = B.proj[(size_t)t * 928 + c]; }
        else if (k == 1) { f = bf((const bf16_t*)(ws + WS_CQ), (size_t)t * 256 + c); g = B.proj[(size_t)t * 928 + 512 + c]; }
        else if (k == 2) { f = bf((const bf16_t*)(ws + WS_CKVR), (size_t)t * 256 + c); g = c < 128 ? B.proj[(size_t)t * 928 + 768 + c] : B.krope[(size_t)t * 32 + rope_perm_src(c - 128)]; }
        else if (k == 3) { const int hh = c / 96, jj = c % 96, src = jj < 64 ? c : hh * 96 + 64 + rope_perm_src(jj - 64); f = bf((const bf16_t*)(ws + WS_Q), (size_t)t * 768 + c); g = B.q[(size_t)t * 768 + src] * QSCALE; }
        else if (k == 4) { f = bf((const bf16_t*)(ws + WS_KV), (size_t)t * 1024 + c); g = B.kv[(size_t)t * 1024 + c]; }
        else if (k == 5) { f = bf((const bf16_t*)(ws + WS_SPRE), (size_t)t * SPRE_LD + c); g = B.spre[(size_t)t * 512 + c]; }
        else if (k == 6) { f = bf((const bf16_t*)(ws + WS_MIX), (size_t)t * 1024 + c); g = B.mix[(size_t)t * 1024 + c]; }
        else if (k == 7) { f = bf((const bf16_t*)(ws + WS_MIX), (size_t)t * 1024 + 512 + c); g = B.mix[(size_t)t * 1024 + 512 + c]; }
        else if (k == 8) { f = bf((const bf16_t*)(ws + WS_X1B), (size_t)t * 1024 + c); g = gx1[(size_t)t * 1024 + c]; }
        else { f = out_fast[(size_t)t * 1024 + c]; g = gout[(size_t)t * 1024 + c]; }
        const float d = f - g; num += d * d; den += g * g;
        if (!(fabsf(f) < 1e30f)) num += 1e30f;
    }
    num = wave_sum(num); den = wave_sum(den);
    if ((threadIdx.x & 63) == 0) { atomicAdd(acc + 2 * k, num); atomicAdd(acc + 2 * k + 1, den); }
}
__global__ void dbg_encode(const float* acc, float* out, int k0, int nk) {
    float c2 = 0.f;
    for (int k = k0; k < k0 + nk; ++k) { const float e = sqrtf(acc[2 * k] / fmaxf(acc[2 * k + 1], 1e-30f)); const float tol = (k == 9) ? 0.08f : 0.04f;
        if (!(e <= tol)) { const int bucket = !(e <= 0.5f) ? 0 : (e > 0.1f ? 1 : 2); c2 = (float)(k - k0 + 1) + 20.f * bucket; break; } }
    if (c2 == 0.f) { if (MK_DBG_NPH >= NPHASE) return; c2 = 90.f; }
    const float c = sqrtf(c2);
    for (size_t i = (size_t)blockIdx.x * blockDim.x + threadIdx.x; i < (size_t)T * 1024; i += (size_t)gridDim.x * blockDim.x) out[i] = c;
}
#endif
}

extern "C" void kernel_launch(void* const* d_in, const int* in_sizes, int n_in, void* d_out, int out_size, void* d_ws, size_t ws_size, hipStream_t stream) {
#if MK_MODE == 0
    gold::In I; const float** p = (const float**)&I;
    for (int i = 0; i < 29; ++i) p[i] = (const float*)d_in[i];
    for (int t0 = 0; t0 < 65536; t0 += 16384) gold::run(I, t0, 16384, (float*)d_ws, (float*)d_out + (size_t)t0 * 1024, (float*)d_out + (size_t)t0 * 1024, stream);
#else
    using namespace fx;
    static int grid = 0;
    if (grid == 0) {
        if (n_in != 29 || ws_size < WS_END) { fprintf(stderr, "kernel_launch: need 29 inputs and >= %zu bytes of workspace (got %d, %zu)\n", (size_t)WS_END, n_in, ws_size); grid = -1; return; }
        int dev = 0, cus = 0, per_cu = 0;
        hipGetDevice(&dev); hipDeviceGetAttribute(&cus, hipDeviceAttributeMultiprocessorCount, dev);
        if (hipFuncSetAttribute((const void*)fwd, hipFuncAttributeMaxDynamicSharedMemorySize, LDS_BYTES) != hipSuccess) { fprintf(stderr, "kernel_launch: hipFuncSetAttribute failed\n"); grid = -1; return; }
        if (hipOccupancyMaxActiveBlocksPerMultiprocessor(&per_cu, (const void*)fwd, 512, LDS_BYTES) != hipSuccess || per_cu < 1) { fprintf(stderr, "kernel_launch: occupancy query says %d\n", per_cu); }
        (void)hipGetLastError();
        grid = cus > 0 ? cus : 256;
    }
    if (grid < 0) return;
    hipMemsetAsync((char*)d_ws + WS_CTL, 0, CTL_BYTES, stream);
    Args a{};
    for (int i = 0; i < 29; ++i) a.in[i] = (const float*)d_in[i];
    a.out = (float*)d_out; a.ws = (unsigned char*)d_ws;
#if MK_MODE == 1
    for (int ph = 0; ph < NPHASE && ph < MK_DBG_NPH; ++ph) { a.ph_lo = ph; a.ph_hi = ph + 1; hipLaunchKernelGGL(fwd, dim3(grid), dim3(512), LDS_BYTES, stream, a); }
#else
    a.ph_lo = 0; a.ph_hi = NPHASE; hipLaunchKernelGGL(fwd, dim3(grid), dim3(512), LDS_BYTES, stream, a);
#endif
#if MK_DEBUG
    {
        gold::In I; const float** p = (const float**)&I;
        for (int i = 0; i < 29; ++i) p[i] = (const float*)d_in[i];
        float* gs = (float*)((char*)d_ws + WS_GOLD); float* gx1 = gs + (size_t)2048 * gold::GOLD_FLOATS_PER_TOK; float* gout = gx1 + (size_t)2048 * 1024;
        gold::Bufs B = gold::run(I, 0, 2048, gs, gx1, gout, stream);
        float* acc = (float*)((char*)d_ws + WS_CTL) + CW_DBG;
        for (int k = 0; k < 10; ++k) hipLaunchKernelGGL(dbg_cmp, dim3(2048), dim3(256), 0, stream, k, (const unsigned char*)d_ws, (const float*)d_out, B, (const float*)gx1, (const float*)gout, acc);
        hipLaunchKernelGGL(dbg_encode, dim3(1024), dim3(256), 0, stream, (const float*)acc, (float*)d_out, MK_DBG_K0, MK_DBG_NK);
    }
#endif
    const hipError_t le = hipPeekAtLastError();
    if (le != hipSuccess) fprintf(stderr, "kernel_launch: launch failed: %s\n", hipGetErrorName(le));
#endif
}
```

```cpp
#define MK_MODE 2
#include <hip/hip_runtime.h>
#include <cstdio>
#include <cstdint>
#include <cmath>
#ifndef MK_MODE
#define MK_MODE 1
#endif
#ifndef MK_DBG_NPH
#define MK_DBG_NPH 99
#endif
#ifndef MK_DBG_K0
#define MK_DBG_K0 0
#endif
#ifndef MK_DBG_NK
#define MK_DBG_NK 10
#endif
#ifndef MK_DUP
#define MK_DUP -1
#endif
#define REP(k) for (int rep_ = 0; rep_ < ((MK_DUP == (k)) ? 2 : 1); ++rep_)
#define DUP2(k, ...) do { __VA_ARGS__ if constexpr (MK_DUP == (k)) { __VA_ARGS__ } } while (0)
#ifndef MK_TPROBE
#define MK_TPROBE -1
#endif
#ifndef MK_STAG
#define MK_STAG 0
#endif
#ifndef MK_DEBUG
#define MK_DEBUG 0
#endif
namespace gold {
constexpr int D_MODEL = 1024, SEQ = 2048, D_SSM = 512, D_IN = 928, NH = 8, QLR = 256, KVLR = 128, ROPE = 32;
constexpr int NEXP = 64, TOPK = 6, DEXP = 256;
constexpr float ALPHA = 1.189207115002721f, LN_EPS = 1e-5f, RMS_EPS = 1e-6f, ATT_SCALE = 0.10206207261596577f;

__global__ void __launch_bounds__(256) sgemm(const float* __restrict__ A, int lda, const float* __restrict__ B, int ldb, float* __restrict__ C, int ldc, int M, int N, int K) {
    __shared__ float As[16][65];
    __shared__ float Bs[16][65];
    const int tid = threadIdx.x, tx = tid & 15, ty = tid >> 4;
    const int m0 = blockIdx.y * 64, n0 = blockIdx.x * 64;
    float acc[4][4];
#pragma unroll
    for (int i = 0; i < 4; ++i)
#pragma unroll
        for (int j = 0; j < 4; ++j) acc[i][j] = 0.f;
    for (int k0 = 0; k0 < K; k0 += 16) {
#pragma unroll
        for (int i = 0; i < 4; ++i) { const int idx = tid + 256 * i, r = idx >> 4, c = idx & 15; As[c][r] = A[(size_t)(m0 + r) * lda + k0 + c]; }
#pragma unroll
        for (int i = 0; i < 4; ++i) { const int idx = tid + 256 * i, r = idx >> 6, c = idx & 63; Bs[r][c] = (n0 + c < N) ? B[(size_t)(k0 + r) * ldb + n0 + c] : 0.f; }
        __syncthreads();
#pragma unroll
        for (int k = 0; k < 16; ++k) {
            float a[4], b[4];
#pragma unroll
            for (int i = 0; i < 4; ++i) a[i] = As[k][ty + 16 * i];
#pragma unroll
            for (int j = 0; j < 4; ++j) b[j] = Bs[k][tx + 16 * j];
#pragma unroll
            for (int i = 0; i < 4; ++i)
#pragma unroll
                for (int j = 0; j < 4; ++j) acc[i][j] = fmaf(a[i], b[j], acc[i][j]);
        }
        __syncthreads();
    }
#pragma unroll
    for (int i = 0; i < 4; ++i)
#pragma unroll
        for (int j = 0; j < 4; ++j) { const int c = n0 + tx + 16 * j; if (c < N) C[(size_t)(m0 + ty + 16 * i) * ldc + c] = acc[i][j]; }
}

__device__ __forceinline__ float gelu_tanh(float x) {
    const float z = 0.7978845608028654f * (x + 0.044715f * x * x * x);
    const float e = __expf(2.f * z);
    const float th = 1.f - 2.f / (1.f + e);
    return 0.5f * x * (1.f + th);
}
__device__ __forceinline__ float sigmoidf_(float x) { return 1.f / (1.f + __expf(-x)); }

struct SsmPar { float ar, ai, kr, ki; };
__device__ __forceinline__ SsmPar ssm_par(const float* lam_re, const float* lam_im, const float* log_dt, int d, int g, int n) {
    const float lr = fminf(lam_re[(d * 32 + g) * 64 + n], -1e-4f), li = lam_im[(d * 32 + g) * 64 + n];
    const float dt = expf(log_dt[d * 32 + g]);
    const float x = lr * dt, th = li * dt;
    const float em1 = expm1f(x), cs = cosf(th), sn = sinf(th), sh = sinf(0.5f * th);
    const float mag = em1 + 1.f;
    SsmPar p; p.ar = mag * cs; p.ai = mag * sn;
    const float arm1 = em1 * cs - 2.f * sh * sh;
    const float den = lr * lr + li * li;
    p.kr = (arm1 * lr + p.ai * li) / den; p.ki = (p.ai * lr - arm1 * li) / den;
    return p;
}

__global__ void __launch_bounds__(64) ssm_naive(const float* __restrict__ proj, int ldp, const float* __restrict__ lam_re, const float* __restrict__ lam_im, const float* __restrict__ log_dt,
                                                const float* __restrict__ b_re, const float* __restrict__ b_im, const float* __restrict__ c_re, const float* __restrict__ c_im,
                                                const float* __restrict__ d_skip, float* __restrict__ spre) {
    const int g = blockIdx.x, b = blockIdx.y, n = threadIdx.x;
    for (int d = 0; d < 2; ++d) {
        const SsmPar P = ssm_par(lam_re, lam_im, log_dt, d, g, n);
        float Br[16], Bi[16], Cr[16], Ci[16];
#pragma unroll
        for (int q = 0; q < 16; ++q) { const float br = b_re[((d * 32 + g) * 64 + n) * 16 + q], bi = b_im[((d * 32 + g) * 64 + n) * 16 + q];
            Br[q] = P.kr * br - P.ki * bi; Bi[q] = P.kr * bi + P.ki * br;
            Cr[q] = c_re[((d * 32 + g) * 16 + q) * 64 + n]; Ci[q] = c_im[((d * 32 + g) * 16 + q) * 64 + n]; }
        float hr = 0.f, hi = 0.f;
        for (int step = 0; step < SEQ; ++step) {
            const int t = d ? (SEQ - 1 - step) : step;
            const float* up = proj + (size_t)(b * SEQ + t) * ldp + g * 16;
            float u[16];
#pragma unroll
            for (int q = 0; q < 16; ++q) u[q] = up[q];
            float bur = 0.f, bui = 0.f;
#pragma unroll
            for (int q = 0; q < 16; ++q) { bur = fmaf(Br[q], u[q], bur); bui = fmaf(Bi[q], u[q], bui); }
            const float nr = P.ar * hr - P.ai * hi + bur, ni = P.ar * hi + P.ai * hr + bui;
            hr = nr; hi = ni;
            float y[16];
#pragma unroll
            for (int p = 0; p < 16; ++p) y[p] = Cr[p] * hr - Ci[p] * hi;
#pragma unroll
            for (int o = 1; o < 64; o <<= 1)
#pragma unroll
                for (int p = 0; p < 16; ++p) y[p] += __shfl_xor(y[p], o);
            if (n < 16) {
                float v = 0.f;
#pragma unroll
                for (int p = 0; p < 16; ++p) if (p == n) v = y[p];
                float* o = spre + (size_t)(b * SEQ + t) * 512 + g * 16 + n;
                if (d == 0) *o = v;
                else { float uu = 0.f;
#pragma unroll
                    for (int p = 0; p < 16; ++p) if (p == n) uu = u[p];
                    *o = gelu_tanh(*o + v + uu * d_skip[g * 16 + n]); }
            }
        }
    }
}
__global__ void glu_ew(const float* __restrict__ spre, const float* __restrict__ gl, const float* __restrict__ bglu, float* __restrict__ mix, int ntok) {
    const size_t i = (size_t)blockIdx.x * 256 + threadIdx.x; if (i >= (size_t)ntok * 512) return;
    const int c = (int)(i & 511); const size_t r = i >> 9;
    mix[r * 1024 + c] = spre[i] * sigmoidf_(gl[i] + bglu[c]);
}
__global__ void rmsnorm_rows(const float* __restrict__ in, int ld, int off, int n, const float* __restrict__ g, float* __restrict__ out, int ntok) {
    const int r = blockIdx.x * 256 + threadIdx.x; if (r >= ntok) return;
    const float* p = in + (size_t)r * ld + off; float s = 0.f;
    for (int j = 0; j < n; ++j) s = fmaf(p[j], p[j], s);
    const float rs = rsqrtf(s / n + RMS_EPS);
    for (int j = 0; j < n; ++j) out[(size_t)r * n + j] = p[j] * rs * g[j];
}
__device__ __forceinline__ void rope_cs(int pos, int i, float& c, float& s) {
    const float inv = expf(-9.210340371976184f * (float)i * (1.f / 16.f));
    const float a = (float)pos * inv; c = cosf(a); s = sinf(a);
}
__global__ void rope_ew(float* __restrict__ q, const float* __restrict__ proj, int ldp, float* __restrict__ krope, int ntok) {
    const int idx = blockIdx.x * 256 + threadIdx.x; if (idx >= ntok * 9 * 16) return;
    const int i = idx & 15, hh = (idx >> 4) % 9, r = idx / 144, pos = r % SEQ;
    float c, s; rope_cs(pos, i, c, s);
    if (hh < 8) { float* p = q + (size_t)r * 768 + hh * 96 + 64; const float t1 = p[i], t2 = p[i + 16]; p[i] = t1 * c - t2 * s; p[i + 16] = t1 * s + t2 * c; }
    else { const float* p = proj + (size_t)r * ldp + 896; const float t1 = p[i], t2 = p[i + 16]; krope[(size_t)r * 32 + i] = t1 * c - t2 * s; krope[(size_t)r * 32 + i + 16] = t1 * s + t2 * c; }
}
__global__ void __launch_bounds__(64) attn_naive(const float* __restrict__ q, const float* __restrict__ kv, const float* __restrict__ krope, float* __restrict__ mix) {
    const int qi = blockIdx.x * 64 + threadIdx.x, h = blockIdx.y, b = blockIdx.z;
    const size_t r = (size_t)b * SEQ + qi;
    float qv[96], o[64];
#pragma unroll
    for (int d = 0; d < 96; ++d) qv[d] = q[r * 768 + h * 96 + d] * ATT_SCALE;
#pragma unroll
    for (int d = 0; d < 64; ++d) o[d] = 0.f;
    float m = -1e30f, l = 0.f;
    for (int s = 0; s < SEQ; ++s) {
        const size_t kr = (size_t)b * SEQ + s;
        const float4* kn = (const float4*)(kv + kr * 1024 + h * 128);
        const float4* kp = (const float4*)(krope + kr * 32);
        float sc = 0.f;
#pragma unroll
        for (int d = 0; d < 16; ++d) { const float4 k4 = kn[d]; sc = fmaf(qv[4 * d], k4.x, sc); sc = fmaf(qv[4 * d + 1], k4.y, sc); sc = fmaf(qv[4 * d + 2], k4.z, sc); sc = fmaf(qv[4 * d + 3], k4.w, sc); }
#pragma unroll
        for (int d = 0; d < 8; ++d) { const float4 k4 = kp[d]; sc = fmaf(qv[64 + 4 * d], k4.x, sc); sc = fmaf(qv[64 + 4 * d + 1], k4.y, sc); sc = fmaf(qv[64 + 4 * d + 2], k4.z, sc); sc = fmaf(qv[64 + 4 * d + 3], k4.w, sc); }
        const float mn = fmaxf(m, sc), al = __expf(m - mn), p = __expf(sc - mn);
        l = l * al + p; m = mn;
        const float4* vp = (const float4*)(kv + kr * 1024 + h * 128 + 64);
#pragma unroll
        for (int d = 0; d < 16; ++d) { const float4 v4 = vp[d]; o[4 * d] = fmaf(o[4 * d], al, p * v4.x); o[4 * d + 1] = fmaf(o[4 * d + 1], al, p * v4.y); o[4 * d + 2] = fmaf(o[4 * d + 2], al, p * v4.z); o[4 * d + 3] = fmaf(o[4 * d + 3], al, p * v4.w); }
    }
    const float il = 1.f / l;
#pragma unroll
    for (int d = 0; d < 64; ++d) mix[r * 1024 + 512 + h * 64 + d] = o[d] * il;
}
__device__ __forceinline__ float wsum(float v) {
#pragma unroll
    for (int o = 1; o < 64; o <<= 1) v += __shfl_xor(v, o);
    return v;
}
__global__ void __launch_bounds__(256) ln1_rows(const float* __restrict__ x, const float* __restrict__ mixo, const float* __restrict__ g, const float* __restrict__ bb, float* __restrict__ x1, int ntok) {
    const int r = blockIdx.x * 4 + (threadIdx.x >> 6), lane = threadIdx.x & 63; if (r >= ntok) return;
    float v[16]; float s = 0.f;
#pragma unroll
    for (int j = 0; j < 16; ++j) { const int c = lane + 64 * j; v[j] = ALPHA * x[(size_t)r * 1024 + c] + mixo[(size_t)r * 1024 + c]; s += v[j]; }
    const float mean = wsum(s) * (1.f / 1024.f); float q = 0.f;
#pragma unroll
    for (int j = 0; j < 16; ++j) { v[j] -= mean; q = fmaf(v[j], v[j], q); }
    const float rstd = rsqrtf(wsum(q) * (1.f / 1024.f) + LN_EPS);
#pragma unroll
    for (int j = 0; j < 16; ++j) { const int c = lane + 64 * j; x1[(size_t)r * 1024 + c] = v[j] * rstd * g[c] + bb[c]; }
}
}

__device__ __forceinline__ void route_token(const float (&lg)[64], const float* __restrict__ rbias, int (&idx)[6], float (&w)[6]) {
    float sc[64], ch[64];
#pragma unroll
    for (int j = 0; j < 64; ++j) { sc[j] = 1.f / (1.f + __expf(-lg[j])); ch[j] = sc[j] + rbias[j]; }
    float gs[8];
#pragma unroll
    for (int g = 0; g < 8; ++g) { float m1 = -INFINITY, m2 = -INFINITY;
#pragma unroll
        for (int j = 0; j < 8; ++j) { const float v = ch[g * 8 + j]; if (v > m1) { m2 = m1; m1 = v; } else if (v > m2) m2 = v; }
        gs[g] = m1 + m2; }
    bool sel[8];
#pragma unroll
    for (int g = 0; g < 8; ++g) { int rank = 0;
#pragma unroll
        for (int o = 0; o < 8; ++o) { if (o != g && (gs[o] > gs[g] || (gs[o] == gs[g] && o < g))) ++rank; }
        sel[g] = rank < 4; }
#pragma unroll
    for (int j = 0; j < 64; ++j) if (!sel[j >> 3]) ch[j] = -INFINITY;
    float wsum_ = 0.f;
#pragma unroll
    for (int k = 0; k < 6; ++k) { float best = -INFINITY; int bi = 0;
#pragma unroll
        for (int j = 0; j < 64; ++j) if (ch[j] > best) { best = ch[j]; bi = j; }
        float sv = 0.f;
#pragma unroll
        for (int j = 0; j < 64; ++j) if (j == bi) { sv = sc[j]; ch[j] = -INFINITY; }
        idx[k] = bi; w[k] = sv; wsum_ += sv; }
    const float inv = 2.5f / (wsum_ + 1e-20f);
#pragma unroll
    for (int k = 0; k < 6; ++k) w[k] *= inv;
}

namespace gold {
__global__ void __launch_bounds__(64) route_rows(const float* __restrict__ logits, const float* __restrict__ rbias, int* __restrict__ topi, float* __restrict__ topw, int ntok) {
    const int r = blockIdx.x * 64 + threadIdx.x; if (r >= ntok) return;
    float lg[64];
#pragma unroll
    for (int j = 0; j < 16; ++j) { const float4 v = ((const float4*)(logits + (size_t)r * 64))[j]; lg[4 * j] = v.x; lg[4 * j + 1] = v.y; lg[4 * j + 2] = v.z; lg[4 * j + 3] = v.w; }
    int idx[6]; float w[6]; route_token(lg, rbias, idx, w);
#pragma unroll
    for (int k = 0; k < 6; ++k) { topi[(size_t)r * 6 + k] = idx[k]; topw[(size_t)r * 6 + k] = w[k]; }
}
__global__ void __launch_bounds__(256) moe_naive(const float* x1, const int* __restrict__ topi, const float* __restrict__ topw,
                                                  const float* __restrict__ weg, const float* __restrict__ weu, const float* __restrict__ wed,
                                                  const float* __restrict__ wsg, const float* __restrict__ wsu, const float* __restrict__ wsd,
                                                  const float* __restrict__ g2, const float* __restrict__ b2, float* out) {
    __shared__ float xs[1024]; __shared__ float hs[256]; __shared__ float red[8];
    const int r = blockIdx.x, tid = threadIdx.x;
#pragma unroll
    for (int j = 0; j < 4; ++j) xs[tid + 256 * j] = x1[(size_t)r * 1024 + tid + 256 * j];
    __syncthreads();
    float acc[4] = {0.f, 0.f, 0.f, 0.f};
    for (int ei = 0; ei < 7; ++ei) {
        const int e = ei < 6 ? topi[(size_t)r * 6 + ei] : 0; const float w = ei < 6 ? topw[(size_t)r * 6 + ei] : 1.f;
        const float* Wg = ei < 6 ? weg + (size_t)e * 1024 * 256 : wsg; const float* Wu = ei < 6 ? weu + (size_t)e * 1024 * 256 : wsu; const float* Wd = ei < 6 ? wed + (size_t)e * 256 * 1024 : wsd;
        float gg = 0.f, uu = 0.f;
        for (int k = 0; k < 1024; ++k) { const float xv = xs[k]; gg = fmaf(xv, Wg[(size_t)k * 256 + tid], gg); uu = fmaf(xv, Wu[(size_t)k * 256 + tid], uu); }
        hs[tid] = gg / (1.f + __expf(-gg)) * uu;
        __syncthreads();
        float y[4] = {0.f, 0.f, 0.f, 0.f};
        for (int i = 0; i < 256; ++i) { const float hv = hs[i];
#pragma unroll
            for (int j = 0; j < 4; ++j) y[j] = fmaf(hv, Wd[(size_t)i * 1024 + tid + 256 * j], y[j]); }
#pragma unroll
        for (int j = 0; j < 4; ++j) acc[j] = fmaf(w, y[j], acc[j]);
        __syncthreads();
    }
    float v[4]; float s = 0.f;
#pragma unroll
    for (int j = 0; j < 4; ++j) { v[j] = ALPHA * xs[tid + 256 * j] + acc[j]; s += v[j]; }
    s = wsum(s); if ((tid & 63) == 0) red[tid >> 6] = s; __syncthreads();
    const float mean = (red[0] + red[1] + red[2] + red[3]) * (1.f / 1024.f); float q = 0.f;
#pragma unroll
    for (int j = 0; j < 4; ++j) { v[j] -= mean; q = fmaf(v[j], v[j], q); }
    q = wsum(q); if ((tid & 63) == 0) red[4 + (tid >> 6)] = q; __syncthreads();
    const float rstd = rsqrtf((red[4] + red[5] + red[6] + red[7]) * (1.f / 1024.f) + LN_EPS);
#pragma unroll
    for (int j = 0; j < 4; ++j) { const int c = tid + 256 * j; out[(size_t)r * 1024 + c] = v[j] * rstd * g2[c] + b2[c]; }
}

struct In {
    const float *x, *w_in, *lam_re, *lam_im, *log_dt, *b_re, *b_im, *c_re, *c_im, *d_skip, *w_glu, *b_glu, *q_norm_g, *w_uq, *kv_norm_g, *w_ukv, *w_o, *ln1_g, *ln1_b,
                *w_router, *router_bias, *we_gate, *we_up, *we_down, *ws_gate, *ws_up, *ws_down, *ln2_g, *ln2_b;
};
constexpr size_t GOLD_FLOATS_PER_TOK = 6400;
struct Bufs { float *proj, *spre, *gl, *mix, *cqn, *ckvn, *q, *kv, *krope, *mixo, *logits; int* topi; float* topw; };
static Bufs run(const In& I, int tok0, int ntok, float* scratch, float* x1out, float* out, hipStream_t st) {
    Bufs B;
    B.proj = scratch; B.spre = B.proj + (size_t)ntok * 928; B.gl = B.spre + (size_t)ntok * 512; B.mix = B.gl + (size_t)ntok * 512;
    B.cqn = B.mix + (size_t)ntok * 1024; B.ckvn = B.cqn + (size_t)ntok * 256; B.q = B.ckvn + (size_t)ntok * 128; B.kv = B.q + (size_t)ntok * 768;
    B.krope = B.kv + (size_t)ntok * 1024; B.mixo = B.krope + (size_t)ntok * 32; B.logits = B.mixo + (size_t)ntok * 1024;
    B.topi = (int*)(B.logits + (size_t)ntok * 64); B.topw = (float*)(B.topi + (size_t)ntok * 6);
    float *proj = B.proj, *spre = B.spre, *gl = B.gl, *mix = B.mix, *cqn = B.cqn, *ckvn = B.ckvn, *q = B.q, *kv = B.kv, *krope = B.krope, *mixo = B.mixo, *logits = B.logits; int* topi = B.topi; float* topw = B.topw;
    const float* x = I.x + (size_t)tok0 * 1024; const int nb = ntok / SEQ;
    hipLaunchKernelGGL(sgemm, dim3((928 + 63) / 64, ntok / 64), dim3(256), 0, st, x, 1024, I.w_in, 928, proj, 928, ntok, 928, 1024);
    hipLaunchKernelGGL(ssm_naive, dim3(32, nb), dim3(64), 0, st, proj, 928, I.lam_re, I.lam_im, I.log_dt, I.b_re, I.b_im, I.c_re, I.c_im, I.d_skip, spre);
    hipLaunchKernelGGL(sgemm, dim3(8, ntok / 64), dim3(256), 0, st, spre, 512, I.w_glu, 512, gl, 512, ntok, 512, 512);
    hipLaunchKernelGGL(glu_ew, dim3((unsigned)(((size_t)ntok * 512 + 255) / 256)), dim3(256), 0, st, spre, gl, I.b_glu, mix, ntok);
    hipLaunchKernelGGL(rmsnorm_rows, dim3((ntok + 255) / 256), dim3(256), 0, st, proj, 928, 512, 256, I.q_norm_g, cqn, ntok);
    hipLaunchKernelGGL(rmsnorm_rows, dim3((ntok + 255) / 256), dim3(256), 0, st, proj, 928, 768, 128, I.kv_norm_g, ckvn, ntok);
    hipLaunchKernelGGL(sgemm, dim3(12, ntok / 64), dim3(256), 0, st, cqn, 256, I.w_uq, 768, q, 768, ntok, 768, 256);
    hipLaunchKernelGGL(sgemm, dim3(16, ntok / 64), dim3(256), 0, st, ckvn, 128, I.w_ukv, 1024, kv, 1024, ntok, 1024, 128);
    hipLaunchKernelGGL(rope_ew, dim3((ntok * 144 + 255) / 256), dim3(256), 0, st, q, proj, 928, krope, ntok);
    hipLaunchKernelGGL(attn_naive, dim3(SEQ / 64, 8, nb), dim3(64), 0, st, q, kv, krope, mix);
    hipLaunchKernelGGL(sgemm, dim3(16, ntok / 64), dim3(256), 0, st, mix, 1024, I.w_o, 1024, mixo, 1024, ntok, 1024, 1024);
    hipLaunchKernelGGL(ln1_rows, dim3(ntok / 4), dim3(256), 0, st, x, mixo, I.ln1_g, I.ln1_b, x1out, ntok);
    hipLaunchKernelGGL(sgemm, dim3(1, ntok / 64), dim3(256), 0, st, x1out, 1024, I.w_router, 64, logits, 64, ntok, 64, 1024);
    hipLaunchKernelGGL(route_rows, dim3(ntok / 64), dim3(64), 0, st, logits, I.router_bias, topi, topw, ntok);
    hipLaunchKernelGGL(moe_naive, dim3(ntok), dim3(256), 0, st, x1out, topi, topw, I.we_gate, I.we_up, I.we_down, I.ws_gate, I.ws_up, I.ws_down, I.ln2_g, I.ln2_b, out);
    return B;
}
}
#define GAS __attribute__((address_space(1)))
#define LAS __attribute__((address_space(3)))
typedef unsigned short bf16_t;
typedef short bf16x8 __attribute__((ext_vector_type(8)));
typedef short s16x4 __attribute__((ext_vector_type(4)));
typedef float f32x4 __attribute__((ext_vector_type(4)));
typedef float f32x2 __attribute__((ext_vector_type(2)));
typedef float f32x16 __attribute__((ext_vector_type(16)));
typedef unsigned u32x4 __attribute__((ext_vector_type(4)));
typedef unsigned u32x2 __attribute__((ext_vector_type(2)));

namespace fx {
constexpr int T = 65536, SEQ = 2048, DM = 1024, NB = 32;
constexpr int CHK = 32;
constexpr int NCHK = SEQ / CHK;
constexpr int UHR = NB * NCHK;
constexpr int UHK = CHK * 16 + 256;
constexpr int Y8_LD = 1024;
constexpr int SPRE_LD = 512;
constexpr int NCH = 2;
constexpr int CAPC = T / NCH;
constexpr int NVE = NCH * 65;
constexpr float ALPHA = 1.189207115002721f, LN_EPS = 1e-5f, RMS_EPS = 1e-6f;
constexpr float QSCALE = 0.10206207261596577f * 1.4426950408889634f;

constexpr size_t MiB = 1u << 20;
constexpr size_t WS_CTL = 0, CTL_BYTES = 1 * MiB;
constexpr size_t WS_ROPE = 1 * MiB;
constexpr size_t WS_KT = 2 * MiB;
constexpr size_t WS_WIN = 4 * MiB, WS_WGLU = 6 * MiB, WS_WUQ = 6 * MiB + 512 * 1024, WS_WUKV = 7 * MiB, WS_WO = 8 * MiB;
constexpr size_t WS_WST = 10 * MiB, WS_MO = 18 * MiB, WS_WGU = 42 * MiB  , WS_WR = 107 * MiB  , WS_WD = 107 * MiB + 512 * 1024;
constexpr size_t WS_SSQQ = 140 * MiB, WS_SSQKV = 141 * MiB, WS_TSLOT = 142 * MiB, WS_TOPW = 144 * MiB, WS_ROWTOK = 146 * MiB, WS_LOGIT = 162 * MiB;
constexpr size_t WS_XB = 178 * MiB, WS_UH = 306 * MiB, WS_CQ = 402 * MiB, WS_CKVR = 434 * MiB, WS_S = 466 * MiB, WS_Q = 530 * MiB, WS_KV = 626 * MiB, WS_SPRE = 754 * MiB, WS_MIX = 818 * MiB;
constexpr size_t WS_X1B = 178 * MiB, WS_H = 306 * MiB, WS_Y = 562 * MiB  , WS_YS = 800 * MiB  , WS_HS = 864 * MiB  ;
constexpr size_t WS_GOLD = 946 * MiB, WS_END = 1024 * MiB;
constexpr int CW_TMO = 0, CW_CODE = 1, CW_BAR = 4096, CW_CNT = 16384  , CW_DBG = 65536  ;

constexpr int RING_BYTES = 131072, TAB_OFF = RING_BYTES, IDX_OFF = TAB_OFF + 10752  , IDX_UNITS = 16, MISC_OFF = IDX_OFF + IDX_UNITS * 1024, LDS_BYTES = MISC_OFF + 256;

__device__ __forceinline__ unsigned cvt_pk_bf16(float lo, float hi) { unsigned r; asm volatile("v_cvt_pk_bf16_f32 %0, %1, %2" : "=v"(r) : "v"(lo), "v"(hi)); return r; }
__device__ __forceinline__ float bf_lo(unsigned w) { return __uint_as_float(w << 16); }
__device__ __forceinline__ float bf_hi(unsigned w) { return __uint_as_float(w & 0xffff0000u); }
__device__ __forceinline__ u32x4 pack8(const f32x4 a, const f32x4 b) { u32x4 w; w.x = cvt_pk_bf16(a[0], a[1]); w.y = cvt_pk_bf16(a[2], a[3]); w.z = cvt_pk_bf16(b[0], b[1]); w.w = cvt_pk_bf16(b[2], b[3]); return w; }
__device__ __forceinline__ void unpack8(const u32x4 w, f32x4& a, f32x4& b) { a = (f32x4){bf_lo(w.x), bf_hi(w.x), bf_lo(w.y), bf_hi(w.y)}; b = (f32x4){bf_lo(w.z), bf_hi(w.z), bf_lo(w.w), bf_hi(w.w)}; }
__device__ __forceinline__ float fast_sigmoid(float x) { return __builtin_amdgcn_rcpf(1.f + __builtin_amdgcn_exp2f(-1.4426950408889634f * x)); }
__device__ __forceinline__ float gelu_tanh_f(float x) {
    const float z2 = 1.5957691216057308f * (x + 0.044715f * x * x * x);
    return x * fast_sigmoid(z2);
}
#ifndef SC1_STORES
#define SC1_STORES 0
#endif
__device__ __forceinline__ void store16(void* p, const u32x4 v) {
#if SC1_STORES
    asm volatile("global_store_dwordx4 %0, %1, off sc1\n\ts_nop 1" :: "v"(p), "v"(v) : "memory");
#else
    *(u32x4*)p = v;
#endif
}
__device__ __forceinline__ float wave_sum(float v) {
#pragma unroll
    for (int o = 1; o < 64; o <<= 1) v += __shfl_xor(v, o);
    return v;
}

#define XB_TMO      128
#define XB_XCNT(j)  (256  + 64 * (j))
#define XB_XSUB(j)  (1280 + 64 * (j))
#define XB_XGEN(j)  (2304 + 64 * (j))
#define XB_TOP      3328
#define XB_TOPGEN   3392
#define XCD_BAR_WORDS 3456
#define XB_SPIN_CAP (1u << 18)
__device__ __forceinline__ unsigned xb_ld(unsigned* p)              { return __hip_atomic_load(p, __ATOMIC_RELAXED, __HIP_MEMORY_SCOPE_AGENT); }
__device__ __forceinline__ unsigned xb_add(unsigned* p, unsigned v) { return __hip_atomic_fetch_add(p, v, __ATOMIC_RELAXED, __HIP_MEMORY_SCOPE_AGENT); }
__device__ __forceinline__ unsigned xb_xcc_id() { return (unsigned)__builtin_amdgcn_s_getreg((3 << 11) | 20) & 0xFu; }
#define XB_SPIN(cond, bar) do { unsigned _sp = 0; while (cond) { __builtin_amdgcn_s_sleep(1); \
    if ((++_sp & 255u) == 0u) { if (xb_ld(&(bar)[XB_TMO])) break; if (_sp > XB_SPIN_CAP) { atomicAdd(&(bar)[XB_TMO], 1u); break; } } } } while (0)
struct XcdBarrier { unsigned* bar; unsigned x; volatile LAS unsigned* st; };
__device__ __forceinline__ XcdBarrier xcd_barrier_post(unsigned* bar, volatile LAS unsigned* st) {
    XcdBarrier b; b.bar = bar; b.x = xb_xcc_id(); b.st = st;
    if (threadIdx.x == 0) (void)xb_add(&bar[XB_XCNT(b.x)], 1u);
    return b;
}
__device__ __forceinline__ void xcd_barrier_complete(unsigned* bar, unsigned x, unsigned& nloc, unsigned& nx) {
    const unsigned G = gridDim.x * gridDim.y * gridDim.z;
    unsigned sum, cnt, mine, sp = 0u;
    for (;;) {
        sum = 0u; cnt = 0u; mine = 0u;
#pragma unroll
        for (unsigned j = 0; j < 16; ++j) { const unsigned c = xb_ld(&bar[XB_XCNT(j)]); sum += c; cnt += (c > 0u) ? 1u : 0u; mine = (j == x) ? c : mine; }
        if (sum == G) break;
        __builtin_amdgcn_s_sleep(1);
        if ((++sp & 255u) == 0u) { if (xb_ld(&bar[XB_TMO])) break; if (sp > XB_SPIN_CAP) { atomicAdd(&bar[XB_TMO], 1u); break; } }
    }
    nloc = mine > 0u ? mine : 1u; nx = cnt > 0u ? cnt : 1u;
}
__device__ __forceinline__ void xcd_barrier(const XcdBarrier& b) {
    asm volatile("s_waitcnt vmcnt(0)" ::: "memory");
    __syncthreads();
    if (threadIdx.x == 0) {
        unsigned* bar = b.bar;
        __builtin_amdgcn_s_waitcnt(0);
        unsigned nloc = b.st[0], nx = b.st[1];
        if (nloc == 0u) { xcd_barrier_complete(bar, b.x, nloc, nx); b.st[0] = nloc; b.st[1] = nx; }
        const unsigned old = xb_add(&bar[XB_XSUB(b.x)], 1u);
        const unsigned gen = old / nloc;
        if (old + 1u == (gen + 1u) * nloc) {
            __builtin_amdgcn_fence(__ATOMIC_RELEASE, "agent");
            asm volatile("s_waitcnt vmcnt(0)" ::: "memory");
            const unsigned og = xb_add(&bar[XB_TOP], 1u);
            const unsigned tg = og / nx;
            if (og + 1u == (tg + 1u) * nx) xb_add(&bar[XB_TOPGEN], 1u);
            else XB_SPIN(xb_ld(&bar[XB_TOPGEN]) == tg, bar);
            __builtin_amdgcn_fence(__ATOMIC_ACQUIRE, "agent");
            xb_add(&bar[XB_XGEN(b.x)], 1u);
            asm volatile("s_waitcnt vmcnt(0)" ::: "memory");
        } else {
            XB_SPIN(xb_ld(&bar[XB_XGEN(b.x)]) == gen, bar);
            __builtin_amdgcn_fence(__ATOMIC_ACQUIRE, "agent");
            asm volatile("s_waitcnt vmcnt(0)" ::: "memory");
        }
    }
    __syncthreads();
}

constexpr int BM = 256, BK = 64, HALF = 128, HTB = HALF * BK * 2, STAGE_BYTES = 8 * HTB;
__host__ __device__ __forceinline__ int lds_byte(int r, int c) { const int st = (r >> 4) * 2 + (c >> 5), rr = r & 15, cc = c & 31, ob = rr * 64 + cc * 2; return st * 1024 + (ob ^ (((ob >> 9) & 1) << 5)); }
__host__ __device__ __forceinline__ void stage_rc(int b, int& R, int& C) { const int st = b / 1024, sb = b % 1024, swz = sb ^ (((sb >> 9) & 1) << 5); R = (st >> 1) * 16 + swz / 64; C = (st & 1) * 32 + (swz % 64) / 2; }
__host__ __device__ __forceinline__ int perm32(int rho) { const int n = rho >> 4, i = rho & 15; return 8 * (i >> 2) + 4 * n + (i & 3); }
__host__ __device__ __forceinline__ int perm16x(int rho) { const int n = rho >> 4, i = rho & 15; return 16 * (i >> 2) + 4 * n + (i & 3); }

struct Unit { const char* A; const char* B; int i0, i1, i2, i3; };
__device__ __forceinline__ int xcd_remap(int L, int nwg) { const int q = nwg / 8, r = nwg % 8, xcd = L % 8, off = L / 8; return (xcd < r ? xcd * (q + 1) : r * (q + 1) + (xcd - r) * q) + off; }

template <class Epi, class Sched, bool ALIGN_EPI, bool GATHER, int STAG = 0>
__device__ __forceinline__ void gemm_phase(LAS unsigned char* lds, const int lda, const int ldb, const int K, const Sched& S, const Epi& E) {
    if constexpr (STAG > 0) { const unsigned long long t0_ = __builtin_amdgcn_s_memrealtime(), dl_ = (unsigned long long)STAG * ((blockIdx.x >> 3) & 3u); while (__builtin_amdgcn_s_memrealtime() - t0_ < dl_) __builtin_amdgcn_s_sleep(4); }
    const int tid = threadIdx.x, wid = __builtin_amdgcn_readfirstlane(tid >> 6), lane = tid & 63, wr = wid >> 2, wc = wid & 3, fr = lane & 15, fq = lane >> 4;
    const int nt = K / BK;
    unsigned voffA[2], voffB[2]; int RA[2], CA[2];
#pragma unroll
    for (int i = 0; i < 2; ++i) { int R, C; stage_rc(tid * 16 + i * 8192, R, C); const int Rb = 64 * (R >> 5) + (Epi::PERM == 2 ? perm16x(R & 31) : Epi::PERM ? perm32(R & 31) : (R & 31));
        RA[i] = R; CA[i] = C; voffA[i] = (unsigned)(R * lda + C) * 2u; voffB[i] = (unsigned)(Rb * ldb + C) * 2u; }
    const size_t kstep = (size_t)(BK * 2);
    const size_t hstepA = (size_t)HALF * lda * 2, hstepB = (size_t)(Epi::PERM == 2 ? 8 : 32) * ldb * 2;
    const unsigned ldsw = (unsigned)wid * 1024u;
    const int aoff = lds_byte(wr * 64 + fr, fq * 8), boff = lds_byte(wc * 32 + fr, fq * 8);
#define PG8_SA(b, h) (((b) * 2 + (h)) * HTB)
#define PG8_SB(b, h) ((4 + (b) * 2 + (h)) * HTB)
#define PG8_STAGE(bufoff, gbase, voff) do { _Pragma("unroll") for (int _i = 0; _i < 2; ++_i) \
        __builtin_amdgcn_global_load_lds((const unsigned*)((const char*)(gbase) + (voff)[_i]), (LAS unsigned*)(lds + (bufoff) + ldsw + _i * 8192), 16, 0, 0); } while (0)
#define PG8_STAGE_A(bufoff, base, g0, g1, h, kb) do { if constexpr (GATHER) { \
        __builtin_amdgcn_global_load_lds((const unsigned*)((base) + (kb) + (g0)), (LAS unsigned*)(lds + (bufoff) + ldsw), 16, 0, 0); \
        __builtin_amdgcn_global_load_lds((const unsigned*)((base) + (kb) + (g1)), (LAS unsigned*)(lds + (bufoff) + ldsw + 8192), 16, 0, 0); } \
      else { PG8_STAGE(bufoff, (base) + (h) * hstepA + (kb), voffA); } } while (0)
#define PG8_LDA(dst, b, h) do { _Pragma("unroll") for (int m = 0; m < 4; ++m) _Pragma("unroll") for (int k = 0; k < 2; ++k) dst[m][k] = *(const LAS bf16x8*)(lds + PG8_SA(b, h) + aoff + m * 2048 + k * 1024); } while (0)
#define PG8_LDB(dst, b, h) do { _Pragma("unroll") for (int n = 0; n < 2; ++n) _Pragma("unroll") for (int k = 0; k < 2; ++k) dst[n][k] = *(const LAS bf16x8*)(lds + PG8_SB(b, h) + boff + n * 2048 + k * 1024); } while (0)
#define PG8_MMA(ai, bj, At, Bt) do { __builtin_amdgcn_s_setprio(1); _Pragma("unroll") for (int m = 0; m < 4; ++m) _Pragma("unroll") for (int n = 0; n < 2; ++n) _Pragma("unroll") for (int k = 0; k < 2; ++k) \
        acc[ai][bj][m][n] = __builtin_amdgcn_mfma_f32_16x16x32_bf16(Bt[n][k], At[m][k], acc[ai][bj][m][n], 0, 0, 0); __builtin_amdgcn_s_setprio(0); } while (0)
#define PG8_WAIT_V(n) asm volatile("s_waitcnt vmcnt(" #n ")" ::: "memory")
#define PG8_WAIT_VN(n) asm volatile("s_waitcnt vmcnt(%0)" :: "n"(n) : "memory")
#define PG8_WAIT_L(n) asm volatile("s_waitcnt lgkmcnt(" #n ")" ::: "memory")
#define PG8_BAR __builtin_amdgcn_s_barrier()
#define PG8_SCHED __builtin_amdgcn_sched_barrier(0)
    Unit cur, nxt; int ui = 0;
    if (!S.next(0, cur)) return;
    unsigned gc00 = 0, gc01 = 0, gc10 = 0, gc11 = 0, gn00 = 0, gn01 = 0, gn10 = 0, gn11 = 0;
    if constexpr (GATHER) { S.gather(cur, RA[0], CA[0], RA[1], CA[1], gc00, gc01, gc10, gc11); gn00 = gc00; gn01 = gc01; gn10 = gc10; gn11 = gc11; }
    f32x4 acc[2][2][4][2];
#pragma unroll
    for (int a = 0; a < 2; ++a)
#pragma unroll
        for (int b = 0; b < 2; ++b)
#pragma unroll
            for (int m = 0; m < 4; ++m)
#pragma unroll
                for (int n = 0; n < 2; ++n) acc[a][b][m][n] = (f32x4){0.f, 0.f, 0.f, 0.f};
    bf16x8 At[4][2], B0[2][2], B1[2][2];
    const char* cA = cur.A; const char* cB = cur.B;
    PG8_STAGE(PG8_SB(0, 0), cB, voffB); PG8_STAGE(PG8_SB(0, 1), cB + hstepB, voffB); PG8_STAGE_A(PG8_SA(0, 0), cA, gc00, gc01, 0, 0); PG8_STAGE_A(PG8_SA(0, 1), cA, gc10, gc11, 1, 0);
    if (wr == 1) PG8_BAR;
    PG8_WAIT_V(2); PG8_BAR;
    PG8_STAGE(PG8_SB(1, 0), cB + kstep, voffB); PG8_STAGE_A(PG8_SA(1, 0), cA, gc00, gc01, 0, kstep); PG8_STAGE(PG8_SB(1, 1), cB + hstepB + kstep, voffB);
    PG8_WAIT_V(6); PG8_BAR;
    for (;;) {
        const bool has_next = S.next(ui + 1, nxt);
        if constexpr (GATHER) { if (has_next) S.gather(nxt, RA[0], CA[0], RA[1], CA[1], gn00, gn01, gn10, gn11); }
        const char* nA = has_next ? nxt.A : cA; const char* nB = has_next ? nxt.B : cB;
#pragma unroll 1
        for (int t = 0; t < nt; t += 2) {
            const bool last = (t == nt - 2);
            const size_t k1 = (size_t)(t + 1) * kstep;
            const char* a2 = last ? nA : cA; const char* b2 = last ? nB : cB + (size_t)(t + 2) * kstep;
            const size_t k2 = last ? 0 : (size_t)(t + 2) * kstep, k3 = k2 + kstep;
            const char* b3 = b2 + kstep;
            unsigned g200 = gc00, g201 = gc01, g210 = gc10, g211 = gc11;
            if constexpr (GATHER) { if (last) { g200 = gn00; g201 = gn01; g210 = gn10; g211 = gn11; } }
            PG8_LDB(B0, 0, 0); PG8_LDB(B1, 0, 1); PG8_SCHED; PG8_LDA(At, 0, 0); PG8_STAGE_A(PG8_SA(1, 1), cA, gc10, gc11, 1, k1);
            PG8_WAIT_V(8); PG8_WAIT_L(0); PG8_BAR; PG8_MMA(0, 0, At, B0); PG8_MMA(0, 1, At, B1); PG8_BAR; PG8_SCHED;
            PG8_LDA(At, 0, 1); PG8_STAGE(PG8_SB(0, 0), b2, voffB); PG8_STAGE(PG8_SB(0, 1), b2 + hstepB, voffB); PG8_STAGE_A(PG8_SA(0, 0), a2, g200, g201, 0, k2);
            PG8_WAIT_V(8); PG8_WAIT_L(0); PG8_BAR; PG8_MMA(1, 0, At, B0); PG8_MMA(1, 1, At, B1); PG8_BAR; PG8_SCHED;
            PG8_LDB(B0, 1, 0); PG8_LDB(B1, 1, 1); PG8_SCHED; PG8_LDA(At, 1, 0); PG8_STAGE_A(PG8_SA(0, 1), a2, g210, g211, 1, k2);
            PG8_WAIT_V(8); PG8_WAIT_L(0); PG8_BAR; PG8_MMA(0, 0, At, B0); PG8_MMA(0, 1, At, B1); PG8_BAR; PG8_SCHED;
            PG8_LDA(At, 1, 1); PG8_STAGE(PG8_SB(1, 0), b3, voffB); PG8_STAGE(PG8_SB(1, 1), b3 + hstepB, voffB); PG8_STAGE_A(PG8_SA(1, 0), a2, g200, g201, 0, k3);
            PG8_WAIT_V(8); PG8_WAIT_L(0); PG8_BAR; PG8_MMA(1, 0, At, B0); PG8_MMA(1, 1, At, B1); PG8_BAR; PG8_SCHED;
        }
#if defined(MK_TPROBE) && MK_TPROBE >= 200
        unsigned long long tp0_ = 0; if (blockIdx.x == 0 && wid == 0) tp0_ = __builtin_amdgcn_s_memrealtime();
#endif
        if constexpr (ALIGN_EPI) { if (wr == 0) PG8_BAR; }
        E(acc, cur, wr, wc, fr, fq);
#if defined(MK_TPROBE) && MK_TPROBE >= 200
        if (blockIdx.x == 0 && wid == 0) { asm volatile("s_waitcnt vmcnt(0)" ::: "memory"); const unsigned long long d_ = __builtin_amdgcn_s_memrealtime() - tp0_; if (lane == 0) { volatile LAS unsigned* M_ = (volatile LAS unsigned*)(lds + MISC_OFF); const unsigned long long a_ = (((unsigned long long)M_[23] << 32) | M_[22]) + d_; M_[22] = (unsigned)a_; M_[23] = (unsigned)(a_ >> 32); } }
#endif
        if (!has_next) break;
#pragma unroll
        for (int a = 0; a < 2; ++a)
#pragma unroll
            for (int b = 0; b < 2; ++b)
#pragma unroll
                for (int m = 0; m < 4; ++m)
#pragma unroll
                    for (int n = 0; n < 2; ++n) acc[a][b][m][n] = (f32x4){0.f, 0.f, 0.f, 0.f};
        cur = nxt; cA = nA; cB = nB; ++ui;
        if constexpr (GATHER) { gc00 = gn00; gc01 = gn01; gc10 = gn10; gc11 = gn11; }
        if constexpr (ALIGN_EPI) { if (wr == 1) PG8_BAR; }
    }
    PG8_WAIT_V(0);
    if constexpr (!ALIGN_EPI) { if (wr == 0) PG8_BAR; }
    PG8_BAR;
#undef PG8_SA
#undef PG8_SB
#undef PG8_STAGE
#undef PG8_STAGE_A
#undef PG8_LDA
#undef PG8_LDB
#undef PG8_MMA
#undef PG8_WAIT_V
#undef PG8_WAIT_VN
#undef PG8_WAIT_L
#undef PG8_BAR
#undef PG8_SCHED
}
}
namespace fx {
#define FX_ROWLOOP _Pragma("unroll") for (int ai = 0; ai < 2; ++ai) _Pragma("unroll") for (int m = 0; m < 4; ++m)

struct PlainOrder {
    const char* A; const char* B; int lda, ldb, nM, nN, nwg, G, c;
    __device__ __forceinline__ void init(const void* A_, int lda_, const void* B_, int ldb_, int M, int N, int G_, int c_) { A = (const char*)A_; B = (const char*)B_; lda = lda_; ldb = ldb_; nM = M / 256; nN = N / 256; nwg = nM * nN; G = G_; c = c_; }
    __device__ __forceinline__ bool next(int i, Unit& u) const {
        const long L = (long)i * G + c; if (L >= nwg) return false;
        const int wgid = xcd_remap((int)L, nwg);
        const int nig = 8 * nN, gid = wgid / nig, fm = gid * 8, gsz = (nM - fm) < 8 ? (nM - fm) : 8;
        const int pm = fm + ((wgid % nig) % gsz), pn = (wgid % nig) / gsz;
        u.A = A + (size_t)pm * 256 * lda * 2; u.B = B + (size_t)pn * 256 * ldb * 2; u.i0 = pm; u.i1 = pn; u.i2 = 0; u.i3 = 0; return true;
    }
};
struct PanelOrder {
    const char* A; const char* B; int lda, ldb, nM, nN, G, c;
    __device__ __forceinline__ void init(const void* A_, int lda_, const void* B_, int ldb_, int M, int N, int G_, int c_) { A = (const char*)A_; B = (const char*)B_; lda = lda_; ldb = ldb_; nM = M / 256; nN = N / 256; G = G_; c = c_; }
    __device__ __forceinline__ bool next(int i, Unit& u) const {
        const int j = i / nN, pn = i - j * nN, pm = c + j * G; if (pm >= nM) return false;
        u.A = A + (size_t)pm * 256 * lda * 2; u.B = B + (size_t)pn * 256 * ldb * 2; u.i0 = pm; u.i1 = pn; u.i2 = 0; u.i3 = 0; return true;
    }
};
struct GroupOrder {
    const char* A; const char* B; int ldb, nN, nwg, G, c;
    __device__ __forceinline__ void init(const void* A_, const void* B_, int ldb_, int nN_, int G_, int c_) { A = (const char*)A_; B = (const char*)B_; ldb = ldb_; nN = nN_; nwg = 32 * 8 * nN_; G = G_; c = c_; }
    __device__ __forceinline__ bool next(int i, Unit& u) const {
        const long L = (long)i * G + c; if (L >= nwg) return false;
        const int wgid = xcd_remap((int)L, nwg);
        const int per = 8 * nN, g = wgid / per, rem = wgid % per, pm = rem % 8, pn = rem / 8;
        u.A = A + ((size_t)g * UHR + (size_t)pm * 256) * UHK * 2; u.B = B + ((size_t)g * nN * 256 + (size_t)pn * 256) * ldb * 2; u.i0 = g; u.i1 = pm; u.i2 = pn; u.i3 = 0; return true;
    }
};

__device__ __forceinline__ void rope8(f32x4& v0, f32x4& v1, const float* __restrict__ ropec, const float* __restrict__ ropes, int pos, int fq) {
    const f32x4 c = *(const f32x4*)(ropec + pos * 16 + 4 * fq), s = *(const f32x4*)(ropes + pos * 16 + 4 * fq);
    const f32x4 a = v0, b = v1;
    v0 = (f32x4){a[0] * c[0] - a[1] * s[0], a[0] * s[0] + a[1] * c[0], a[2] * c[1] - a[3] * s[1], a[2] * s[1] + a[3] * c[1]};
    v1 = (f32x4){b[0] * c[2] - b[1] * s[2], b[0] * s[2] + b[1] * c[2], b[2] * c[3] - b[3] * s[3], b[2] * s[3] + b[3] * c[3]};
}
__device__ __forceinline__ float sumsq8(const f32x4 a, const f32x4 b) { return (a[0] * a[0] + a[1] * a[1]) + (a[2] * a[2] + a[3] * a[3]) + (b[0] * b[0] + b[1] * b[1]) + (b[2] * b[2] + b[3] * b[3]); }

struct EpiWin {
    static constexpr int PERM = 1; static constexpr int NST = 16;
    bf16_t* UH; bf16_t* CQ; bf16_t* CKVR; float* ssqq; float* ssqkv; const float* ropec; const float* ropes;
    __device__ __forceinline__ void operator()(const f32x4 (&acc)[2][2][4][2], const Unit& u, int wr, int wc, int fr, int fq) const {
        const int pm = u.i0, pn = u.i1, row0 = pm * 256 + wr * 64 + fr;
        if (pn < 2) {
            FX_ROWLOOP { const int row = row0 + ai * 128 + m * 16, r32 = row >> 5, tq = row & 31;
#pragma unroll
                for (int bj = 0; bj < 2; ++bj) { const int c = pn * 256 + wc * 64 + bj * 32 + 8 * fq, g = c >> 4, p0 = c & 15;
                    *(u32x4*)(UH + ((size_t)(g * UHR + r32) * UHK + tq * 16 + p0)) = pack8(acc[ai][bj][m][0], acc[ai][bj][m][1]); } }
        } else if (pn == 2) {
            FX_ROWLOOP { const int row = row0 + ai * 128 + m * 16; float ss = 0.f;
#pragma unroll
                for (int bj = 0; bj < 2; ++bj) { const int c = wc * 64 + bj * 32 + 8 * fq;
                    *(u32x4*)(CQ + (size_t)row * 256 + c) = pack8(acc[ai][bj][m][0], acc[ai][bj][m][1]); ss += sumsq8(acc[ai][bj][m][0], acc[ai][bj][m][1]); }
                ss += __shfl_xor(ss, 16); ss += __shfl_xor(ss, 32);
                if (fq == 0) ssqq[(size_t)row * 4 + wc] = ss; }
        } else {
            FX_ROWLOOP { const int row = row0 + ai * 128 + m * 16; float ss = 0.f;
#pragma unroll
                for (int bj = 0; bj < 2; ++bj) { const int c = wc * 64 + bj * 32 + 8 * fq; f32x4 v0 = acc[ai][bj][m][0], v1 = acc[ai][bj][m][1];
                    if (wc < 2) ss += sumsq8(v0, v1);
                    if (wc == 2 && bj == 0) rope8(v0, v1, ropec, ropes, row & (SEQ - 1), fq);
                    *(u32x4*)(CKVR + (size_t)row * 256 + c) = pack8(v0, v1); }
                ss += __shfl_xor(ss, 16); ss += __shfl_xor(ss, 32);
                if (fq == 0) ssqkv[(size_t)row * 4 + wc] = ss; }
        }
    }
};
struct EpiQ {
    static constexpr int PERM = 1; static constexpr int NST = 16;
    bf16_t* Q; const float* ssqq; const float* ropec; const float* ropes;
    __device__ __forceinline__ void operator()(const f32x4 (&acc)[2][2][4][2], const Unit& u, int wr, int wc, int fr, int fq) const {
        const int pm = u.i0, pn = u.i1, row0 = pm * 256 + wr * 64 + fr;
        FX_ROWLOOP { const int row = row0 + ai * 128 + m * 16; const f32x4 s4 = *(const f32x4*)(ssqq + (size_t)row * 4);
            const float rs = __builtin_amdgcn_rsqf(((s4[0] + s4[1]) + (s4[2] + s4[3])) * (1.f / 256.f) + RMS_EPS) * QSCALE;
#pragma unroll
            for (int bj = 0; bj < 2; ++bj) { const int G = 8 * pn + 2 * wc + bj, c = 256 * pn + 64 * wc + 32 * bj + 8 * fq;
                f32x4 v0 = acc[ai][bj][m][0] * rs, v1 = acc[ai][bj][m][1] * rs;
                if (G % 3 == 2) rope8(v0, v1, ropec, ropes, row & (SEQ - 1), fq);
                *(u32x4*)(Q + (size_t)row * 768 + c) = pack8(v0, v1); } }
    }
};
struct EpiKV {
    static constexpr int PERM = 1; static constexpr int NST = 16;
    bf16_t* KV; const float* ssqkv;
    __device__ __forceinline__ void operator()(const f32x4 (&acc)[2][2][4][2], const Unit& u, int wr, int wc, int fr, int fq) const {
        const int pm = u.i0, pn = u.i1, row0 = pm * 256 + wr * 64 + fr;
        FX_ROWLOOP { const int row = row0 + ai * 128 + m * 16; const f32x4 s4 = *(const f32x4*)(ssqkv + (size_t)row * 4);
            const float rs = __builtin_amdgcn_rsqf(((s4[0] + s4[1]) + (s4[2] + s4[3])) * (1.f / 128.f) + RMS_EPS);
#pragma unroll
            for (int bj = 0; bj < 2; ++bj) { const int c = 256 * pn + 64 * wc + 32 * bj + 8 * fq;
                *(u32x4*)(KV + (size_t)row * 1024 + c) = pack8(acc[ai][bj][m][0] * rs, acc[ai][bj][m][1] * rs); } }
    }
};
struct EpiSt {
    static constexpr int PERM = 0; static constexpr int NST = 32;
    float* S;
    __device__ __forceinline__ void operator()(const f32x4 (&acc)[2][2][4][2], const Unit& u, int wr, int wc, int fr, int fq) const {
        const int g = u.i0, pm = u.i1, row0 = pm * 256 + wr * 64 + fr;
        FX_ROWLOOP { const int R = row0 + ai * 128 + m * 16; float* rp = S + ((size_t)g * UHR + R) * 256 + wc * 64 + 4 * fq;
#pragma unroll
            for (int bj = 0; bj < 2; ++bj)
#pragma unroll
                for (int n = 0; n < 2; ++n) *(f32x4*)(rp + bj * 32 + n * 16) = acc[ai][bj][m][n]; }
    }
};
struct EpiSsmOut {
    static constexpr int PERM = 1; static constexpr int NST = 16;
    const bf16_t* UH; bf16_t* SPRE; const float* dskip;
    __device__ __forceinline__ void operator()(const f32x4 (&acc)[2][2][4][2], const Unit& u, int wr, int wc, int fr, int fq) const {
        const int g = u.i0, pm = u.i1, pn = u.i2, row0 = pm * 256 + wr * 64 + fr;
        const int p0 = 8 * (fq & 1);
        const f32x4 d0 = *(const f32x4*)(dskip + g * 16 + p0), d1 = *(const f32x4*)(dskip + g * 16 + p0 + 4);
        FX_ROWLOOP { const int R = row0 + ai * 128 + m * 16;
#pragma unroll
            for (int bj = 0; bj < 2; ++bj) { const int c = 256 * pn + 64 * wc + 32 * bj + 8 * fq, tq = c >> 4;
                const u32x4 uw = *(const u32x4*)(UH + ((size_t)g * UHR + R) * UHK + c); f32x4 u0, u1; unpack8(uw, u0, u1);
                f32x4 y0 = acc[ai][bj][m][0] + u0 * d0, y1 = acc[ai][bj][m][1] + u1 * d1;
#pragma unroll
                for (int j = 0; j < 4; ++j) { y0[j] = gelu_tanh_f(y0[j]); y1[j] = gelu_tanh_f(y1[j]); }
                *(u32x4*)(SPRE + ((size_t)R * 32 + tq) * SPRE_LD + g * 16 + p0) = pack8(y0, y1); } }
    }
};
struct EpiGlu {
    static constexpr int PERM = 1; static constexpr int NST = 16;
    const bf16_t* SPRE; bf16_t* MIX; const float* bglu;
    __device__ __forceinline__ void operator()(const f32x4 (&acc)[2][2][4][2], const Unit& u, int wr, int wc, int fr, int fq) const {
        const int pm = u.i0, pn = u.i1, row0 = pm * 256 + wr * 64 + fr;
#pragma unroll
        for (int bj = 0; bj < 2; ++bj) { const int c = 256 * pn + 64 * wc + 32 * bj + 8 * fq;
            const f32x4 b0 = *(const f32x4*)(bglu + c), b1 = *(const f32x4*)(bglu + c + 4);
            FX_ROWLOOP { const int row = row0 + ai * 128 + m * 16;
                const u32x4 sw = *(const u32x4*)(SPRE + (size_t)row * SPRE_LD + c); f32x4 s0, s1; unpack8(sw, s0, s1);
                f32x4 z0 = acc[ai][bj][m][0] + b0, z1 = acc[ai][bj][m][1] + b1;
#pragma unroll
                for (int j = 0; j < 4; ++j) { z0[j] = s0[j] * fast_sigmoid(z0[j]); z1[j] = s1[j] * fast_sigmoid(z1[j]); }
                *(u32x4*)(MIX + (size_t)row * 1024 + c) = pack8(z0, z1); } }
    }
};
struct EpiWo {
    static constexpr int PERM = 1; static constexpr int NST = 16;
    const float* X; bf16_t* Y;
    __device__ __forceinline__ void operator()(const f32x4 (&acc)[2][2][4][2], const Unit& u, int wr, int wc, int fr, int fq) const {
        const int pm = u.i0, pn = u.i1, row0 = pm * 256 + wr * 64 + fr;
        FX_ROWLOOP { const size_t off = (size_t)(row0 + ai * 128 + m * 16) * 1024 + 256 * pn + wc * 64 + 8 * fq;
#pragma unroll
            for (int bj = 0; bj < 2; ++bj) { const f32x4 x0 = *(const f32x4*)(X + off + bj * 32), x1 = *(const f32x4*)(X + off + bj * 32 + 4);
                *(u32x4*)(Y + off + bj * 32) = pack8(x0 * ALPHA + acc[ai][bj][m][0], x1 * ALPHA + acc[ai][bj][m][1]); } }
    }
};
struct EpiSharedRouter {
    static constexpr int PERM = 1; static constexpr int NST = 0;
    bf16_t* HS; float* LG;
    __device__ __forceinline__ void operator()(const f32x4 (&acc)[2][2][4][2], const Unit& u, int wr, int wc, int fr, int fq) const {
        const int pm = u.i0, pn = u.i1, row0 = pm * 256 + wr * 64 + fr;
        if (pn < 2) {
            const int c = 128 * pn + 32 * wc + 8 * fq;
            FX_ROWLOOP { f32x4 h0, h1;
#pragma unroll
                for (int j = 0; j < 4; ++j) { const float g0 = acc[ai][0][m][0][j], g1 = acc[ai][0][m][1][j];
                    h0[j] = g0 * fast_sigmoid(g0) * acc[ai][1][m][0][j]; h1[j] = g1 * fast_sigmoid(g1) * acc[ai][1][m][1][j]; }
                *(u32x4*)(HS + (size_t)(row0 + ai * 128 + m * 16) * 256 + c) = pack8(h0, h1); }
        } else if (wc == 0) {
            FX_ROWLOOP { float* rp = LG + (size_t)(row0 + ai * 128 + m * 16) * 64 + 8 * fq;
#pragma unroll
                for (int bj = 0; bj < 2; ++bj) { *(f32x4*)(rp + bj * 32) = acc[ai][bj][m][0]; *(f32x4*)(rp + bj * 32 + 4) = acc[ai][bj][m][1]; } }
        }
    }
};

struct MoeTab { LAS int* tbase; LAS unsigned* tab; };
__device__ __forceinline__ MoeTab moe_tab(LAS unsigned char* lds) { MoeTab t; t.tbase = (LAS int*)(lds + TAB_OFF); t.tab = (LAS unsigned*)(lds + TAB_OFF + 2304); return t; }
__device__ __forceinline__ int ve_count(const unsigned* ctl, int ve) { return (ve % 65 == 64) ? CAPC : (int)__hip_atomic_load(ctl + CW_CNT + 64 * ve, __ATOMIC_RELAXED, __HIP_MEMORY_SCOPE_AGENT); }
__device__ __forceinline__ void moe_build_tab(LAS unsigned char* lds, const unsigned* ctl) {
    const MoeTab t = moe_tab(lds); LAS int* nt = (LAS int*)(lds + TAB_OFF + 1024 + 64);
    const int tid = threadIdx.x;
    if (tid < NVE) nt[tid] = (ve_count(ctl, tid) + 255) >> 8;
    __syncthreads();
    if (tid == 0) { int s = 0; for (int v = 0; v < NVE; ++v) { t.tbase[v] = s; s += nt[v]; } t.tbase[NVE] = s; }
    __syncthreads();
    for (int v = tid; v < NVE; v += 512) { const int b = t.tbase[v], n = t.tbase[v + 1] - b; for (int j = 0; j < n; ++j) t.tab[b + j] = (unsigned)v | ((unsigned)j << 16); }
    __syncthreads();
}
struct GateUpOrder {
    const char* X1B; const char* WGU; MoeTab tb; LAS int* idx; int nunits, G, c;
    int tb0;
    __device__ __forceinline__ int tile_of(int tr) const { return tb0 + tr; }
    __device__ __forceinline__ void init(LAS unsigned char* lds, const void* x1b, const void* wgu, const int* rowtok, const unsigned* ctl, int chn, int G_, int c_) {
        X1B = (const char*)x1b; WGU = (const char*)wgu; tb = moe_tab(lds); idx = (LAS int*)(lds + IDX_OFF); G = G_; c = c_;
        tb0 = tb.tbase[chn * 65]; nunits = 2 * (tb.tbase[chn * 65 + 64] - tb0);
        __syncthreads();
        for (int i = 0; i < IDX_UNITS; ++i) { const long L = (long)i * G + c; if (L >= nunits) break;
            const int tile = tile_of(xcd_remap((int)L, nunits) >> 1); const unsigned e = tb.tab[tile]; const int ve = (int)(e & 0xffffu), tix = (int)(e >> 16), ch = ve / 65, ex = ve % 65;
            const int cnt = ve_count(ctl, ve);
            if (threadIdx.x < 256) { const int slot = tix * 256 + (int)threadIdx.x; idx[i * 256 + threadIdx.x] = slot < cnt ? rowtok[(size_t)(ch * 64 + ex) * CAPC + slot] : ch * CAPC; } }
        __syncthreads();
    }
    __device__ __forceinline__ bool next(int i, Unit& u) const {
        const long L = (long)i * G + c; if (L >= nunits) return false;
        const int wgid = xcd_remap((int)L, nunits), tile = tile_of(wgid >> 1), pn = wgid & 1;
        const int ex = (int)(tb.tab[tile] & 0xffffu) % 65;
        u.A = X1B; u.B = WGU + ((size_t)ex * 512 + (size_t)pn * 256) * 1024 * 2; u.i0 = tile * 256; u.i1 = pn; u.i2 = 0; u.i3 = i < IDX_UNITS ? i : IDX_UNITS - 1; return true;
    }
    __device__ __forceinline__ void gather(const Unit& u, int R0, int C0, int R1, int C1, unsigned& g00, unsigned& g01, unsigned& g10, unsigned& g11) const {
        const LAS int* ip = idx + u.i3 * 256;
        g00 = (unsigned)ip[R0] * 2048u + (unsigned)C0 * 2u; g01 = (unsigned)ip[R1] * 2048u + (unsigned)C1 * 2u;
        g10 = (unsigned)ip[128 + R0] * 2048u + (unsigned)C0 * 2u; g11 = (unsigned)ip[128 + R1] * 2048u + (unsigned)C1 * 2u;
    }
};
struct EpiGateUp {
    static constexpr int PERM = 1; static constexpr int NST = 8;
    bf16_t* H;
    __device__ __forceinline__ void operator()(const f32x4 (&acc)[2][2][4][2], const Unit& u, int wr, int wc, int fr, int fq) const {
        const int hrow0 = u.i0 + wr * 64 + fr, c = 128 * u.i1 + 32 * wc + 8 * fq;
        FX_ROWLOOP { f32x4 h0, h1;
#pragma unroll
            for (int j = 0; j < 4; ++j) { const float g0 = acc[ai][0][m][0][j], g1 = acc[ai][0][m][1][j];
                h0[j] = g0 * fast_sigmoid(g0) * acc[ai][1][m][0][j]; h1[j] = g1 * fast_sigmoid(g1) * acc[ai][1][m][1][j]; }
            *(u32x4*)(H + (size_t)(hrow0 + ai * 128 + m * 16) * 256 + c) = pack8(h0, h1); }
    }
};
struct DownOrder {
    const char* Hh; const char* HS; const char* WD; MoeTab tb; int t0, nunits, G, c, chn;
    __device__ __forceinline__ void init(const void* h, const void* hs, const void* wd, MoeTab tb_, int ch, int G_, int c_) { Hh = (const char*)h; HS = (const char*)hs; WD = (const char*)wd; tb = tb_; chn = ch; t0 = tb_.tbase[ch * 65]; nunits = 4 * (tb_.tbase[(ch + 1) * 65] - t0); G = G_; c = c_; }
    __device__ __forceinline__ bool next(int i, Unit& u) const {
        const long L = (long)i * G + c; if (L >= nunits) return false;
        const int wgid = xcd_remap((int)L, nunits), tile = t0 + (wgid >> 2), pn = wgid & 3;
        const int ex = (int)(tb.tab[tile] & 0xffffu) % 65;
        u.A = ex == 64 ? HS + ((size_t)chn * CAPC + (size_t)(tb.tab[tile] >> 16) * 256) * 256 * 2 : Hh + (size_t)tile * 256 * 256 * 2; u.B = WD + ((size_t)ex * 1024 + (size_t)pn * 256) * 256 * 2; u.i0 = ex == 64 ? (int)(tb.tab[tile] >> 16) * 256 : (tile - t0) * 256; u.i1 = pn; u.i2 = ex == 64; u.i3 = 0; return true;
    }
};
constexpr float Y8_SCALE = 16.f, Y8_INV = 1.f / 16.f;
__device__ __forceinline__ u32x2 pack8_fp8(const f32x4 a, const f32x4 b) {
    int w0 = 0, w1 = 0;
    w0 = __builtin_amdgcn_cvt_pk_fp8_f32(a[0] * Y8_SCALE, a[1] * Y8_SCALE, w0, false); w0 = __builtin_amdgcn_cvt_pk_fp8_f32(a[2] * Y8_SCALE, a[3] * Y8_SCALE, w0, true);
    w1 = __builtin_amdgcn_cvt_pk_fp8_f32(b[0] * Y8_SCALE, b[1] * Y8_SCALE, w1, false); w1 = __builtin_amdgcn_cvt_pk_fp8_f32(b[2] * Y8_SCALE, b[3] * Y8_SCALE, w1, true);
    u32x2 r; r.x = (unsigned)w0; r.y = (unsigned)w1; return r;
}
__device__ __forceinline__ void unpack8_fp8(const u32x2 w, f32x4& a, f32x4& b) {
    const f32x2 p0 = __builtin_amdgcn_cvt_pk_f32_fp8((int)w.x, false), p1 = __builtin_amdgcn_cvt_pk_f32_fp8((int)w.x, true);
    const f32x2 p2 = __builtin_amdgcn_cvt_pk_f32_fp8((int)w.y, false), p3 = __builtin_amdgcn_cvt_pk_f32_fp8((int)w.y, true);
    a = (f32x4){p0.x, p0.y, p1.x, p1.y}; b = (f32x4){p2.x, p2.y, p3.x, p3.y};
}
template <int STORE = 1> struct EpiDownT {
    static constexpr int PERM = 2; static constexpr int NST = 8;
    unsigned char* Y8; bf16_t* YS;
    __device__ __forceinline__ void operator()(const f32x4 (&acc)[2][2][4][2], const Unit& u, int wr, int wc, int fr, int fq) const {
        const int yrow0 = u.i0 + wr * 64 + fr, c0 = 256 * u.i1 + 64 * wc + 16 * fq;
        if (u.i2) {
            FX_ROWLOOP { bf16_t* rp = YS + (size_t)(yrow0 + ai * 128 + m * 16) * 1024 + c0;
#pragma unroll
                for (int bj = 0; bj < 2; ++bj) store16(rp + bj * 8, pack8(acc[ai][bj][m][0], acc[ai][bj][m][1])); }
        } else {
            FX_ROWLOOP { unsigned char* rp = Y8 + (size_t)(yrow0 + ai * 128 + m * 16) * Y8_LD + c0;
                const u32x2 lo = pack8_fp8(acc[ai][0][m][0], acc[ai][0][m][1]), hi = pack8_fp8(acc[ai][1][m][0], acc[ai][1][m][1]);
                u32x4 w; w.x = lo.x; w.y = lo.y; w.z = hi.x; w.w = hi.y; store16(rp, w); }
        }
    }
};
typedef EpiDownT<1> EpiDown;
}
namespace fx {
namespace att {
constexpr int NW = 8, QBLK = 32, KVBLK = 64;
constexpr int SHM_V = 16384, SHM_K = 16384;
constexpr float THRL = 8.f;
#define KSWZ(row, colB) ((row) * 256 + ((colB) ^ (((row) & 7) << 4)))
#define SBAR() __builtin_amdgcn_sched_barrier(0)
__device__ __forceinline__ int crow(int r, int hi) { return (r & 3) + 8 * (r >> 2) + 4 * hi; }
__device__ __forceinline__ void partialSM(f32x16& p0, f32x16& p1, float& m_reg, float& mn, float& alpha) {
  float pmax = p0[0];
#pragma unroll
  for (int r = 1; r < 16; ++r) pmax = fmaxf(pmax, p0[r]);
#pragma unroll
  for (int r = 0; r < 16; ++r) pmax = fmaxf(pmax, p1[r]);
  { auto rr = __builtin_amdgcn_permlane32_swap(__float_as_uint(pmax), __float_as_uint(pmax), false, false);
    pmax = fmaxf(__uint_as_float(rr[0]), __uint_as_float(rr[1])); }
  if (__builtin_expect(__all(pmax - m_reg <= THRL), 1)) { mn = m_reg; alpha = 1.f; }
  else { mn = fmaxf(m_reg, pmax); alpha = __builtin_amdgcn_exp2f(m_reg - mn); m_reg = mn; }
#pragma unroll
  for (int r = 0; r < 16; ++r) p0[r] = p0[r] - mn;
#pragma unroll
  for (int r = 0; r < 16; ++r) p1[r] = p1[r] - mn;
#pragma unroll
  for (int r = 0; r < 16; ++r) p0[r] = __builtin_amdgcn_exp2f(p0[r]);
}
__device__ __forceinline__ void finishSM(f32x16& p0, f32x16& p1, float alpha, float& l_reg, bf16x8& pa0, bf16x8& pa1, bf16x8& pa2, bf16x8& pa3) {
#pragma unroll
  for (int r = 0; r < 16; ++r) p1[r] = __builtin_amdgcn_exp2f(p1[r]);
  float ps = 0;
#pragma unroll
  for (int r = 0; r < 16; ++r) ps += p0[r];
#pragma unroll
  for (int r = 0; r < 16; ++r) ps += p1[r];
  { auto rr = __builtin_amdgcn_permlane32_swap(__float_as_uint(ps), __float_as_uint(ps), false, false);
    ps = __uint_as_float(rr[0]) + __uint_as_float(rr[1]); }
  l_reg = l_reg * alpha + ps;
#define PK4(P, BASE, OUT) do { unsigned a0 = cvt_pk_bf16(P[BASE + 0], P[BASE + 1]), a1 = cvt_pk_bf16(P[BASE + 2], P[BASE + 3]);   \
    unsigned b0 = cvt_pk_bf16(P[BASE + 4], P[BASE + 5]), b1 = cvt_pk_bf16(P[BASE + 6], P[BASE + 7]);                              \
    auto r0 = __builtin_amdgcn_permlane32_swap(a0, b0, false, false); auto r1 = __builtin_amdgcn_permlane32_swap(a1, b1, false, false); \
    u32x4 w = {r0[0], r1[0], r0[1], r1[1]}; OUT = *reinterpret_cast<bf16x8*>(&w); } while (0)
  PK4(p0, 0, pa0); PK4(p0, 8, pa1); PK4(p1, 0, pa2); PK4(p1, 8, pa3);
#undef PK4
}
__device__ __forceinline__ void qkt(f32x16& p0, f32x16& p1, const char* Ks, const bf16x8 (&qr)[6], int r32, int hi) {
  p0 = f32x16{}; p1 = f32x16{};
#pragma unroll
  for (int d0 = 0; d0 < 6; ++d0) { const int cb = (d0 * 16 + hi * 8) * 2;
    const bf16x8 b0 = *reinterpret_cast<const bf16x8*>(Ks + KSWZ(r32, cb));
    const bf16x8 b1 = *reinterpret_cast<const bf16x8*>(Ks + KSWZ(32 + r32, cb));
    p0 = __builtin_amdgcn_mfma_f32_32x32x16_bf16(b0, qr[d0], p0, 0, 0, 0);
    p1 = __builtin_amdgcn_mfma_f32_32x32x16_bf16(b1, qr[d0], p1, 0, 0, 0); }
}
__device__ __forceinline__ int v_st(int k, int c) { const int kk = (k & ~0xC) | ((k & 4) << 1) | ((k & 8) >> 1); return ((kk >> 3) * 4 + (c >> 5)) * 512 + ((kk & 7) * 32 + (c & 31)) * 2; }
__device__ __forceinline__ int v_rd_base(int lane) { return ((lane & 3) << 3) | (((lane >> 2) & 3) << 6) | (((lane >> 4) & 1) << 5) | (((lane >> 5) & 1) << 8); }
constexpr int v_rd_off(int d0, int ks, int half) { return d0 * 512 + ks * 4096 + half * 2048; }
template <int OFF> __device__ __forceinline__ s16x4 tr_read(int vb) {
  s16x4 r; asm volatile("ds_read_b64_tr_b16 %0, %1 offset:%2" : "=&v"(r) : "v"(vb), "i"(OFF) : "memory"); return r;
}
template <int D0> __device__ __forceinline__ void pv_one(f32x16& od, int vb, bf16x8 pa0, bf16x8 pa1, bf16x8 pa2, bf16x8 pa3) {
  const s16x4 l0 = tr_read<v_rd_off(D0, 0, 0)>(vb), h0 = tr_read<v_rd_off(D0, 0, 1)>(vb), l1 = tr_read<v_rd_off(D0, 1, 0)>(vb), h1 = tr_read<v_rd_off(D0, 1, 1)>(vb);
  const s16x4 l2 = tr_read<v_rd_off(D0, 2, 0)>(vb), h2 = tr_read<v_rd_off(D0, 2, 1)>(vb), l3 = tr_read<v_rd_off(D0, 3, 0)>(vb), h3 = tr_read<v_rd_off(D0, 3, 1)>(vb);
  asm volatile("s_waitcnt lgkmcnt(0)" ::: "memory"); SBAR();
#define PK(L, H) (bf16x8){L[0], L[1], L[2], L[3], H[0], H[1], H[2], H[3]}
  od = __builtin_amdgcn_mfma_f32_32x32x16_bf16(pa0, PK(l0, h0), od, 0, 0, 0);
  od = __builtin_amdgcn_mfma_f32_32x32x16_bf16(pa1, PK(l1, h1), od, 0, 0, 0);
  od = __builtin_amdgcn_mfma_f32_32x32x16_bf16(pa2, PK(l2, h2), od, 0, 0, 0);
  od = __builtin_amdgcn_mfma_f32_32x32x16_bf16(pa3, PK(l3, h3), od, 0, 0, 0);
#undef PK
}
__device__ __forceinline__ void pv_d0(f32x16 (&o)[2], int vb, bf16x8 pa0, bf16x8 pa1, bf16x8 pa2, bf16x8 pa3) {
  pv_one<0>(o[0], vb, pa0, pa1, pa2, pa3); pv_one<1>(o[1], vb, pa0, pa1, pa2, pa3);
}
__device__ __forceinline__ void attn_unit(const unsigned char* __restrict__ wsb, const bf16_t* __restrict__ Q, bf16_t* __restrict__ MIX, int tok0, int qrow0, int h, char* lds) {
  int tid = threadIdx.x; asm volatile("" : "+v"(tid));
  const int wid = __builtin_amdgcn_readfirstlane(tid >> 6), lane = tid & 63, r32 = lane & 31, hi = lane >> 5;
  char* K_lds = lds; char* V_lds = lds + 4 * SHM_K;
  float* ws = (float*)(lds + TAB_OFF) + wid * 64; float* li_l = ws; float* al_l = ws + 32;
  float m_reg = -1e30f, l_reg = 0; f32x16 o[2] = {}; bf16x8 qr[6];
  const bf16_t* Qw = Q + (size_t)(tok0 + qrow0 + wid * QBLK + r32) * 768 + h * 96 + hi * 8;
#pragma unroll
  for (int d0 = 0; d0 < 6; ++d0) qr[d0] = *reinterpret_cast<const bf16x8*>(Qw + d0 * 16);
  const int vb0 = (int)(uintptr_t)V_lds + v_rd_base(lane);
  const int ra = tid / 12, ca = tid % 12, rb = (512 + tid) / 12, cb = (512 + tid) % 12, rv = tid >> 3, cv = tid & 7;
  const unsigned kinca = ca < 8 ? 64u * 2048u : 64u * 512u, kincb = cb < 8 ? 64u * 2048u : 64u * 512u;
  const unsigned kofa = ca < 8 ? (unsigned)WS_KV + (unsigned)(((tok0 + ra) * 1024 + h * 128 + ca * 8) * 2) : (unsigned)WS_CKVR + (unsigned)(((tok0 + ra) * 256 + 128 + (ca - 8) * 8) * 2);
  const unsigned kofb = cb < 8 ? (unsigned)WS_KV + (unsigned)(((tok0 + rb) * 1024 + h * 128 + cb * 8) * 2) : (unsigned)WS_CKVR + (unsigned)(((tok0 + rb) * 256 + 128 + (cb - 8) * 8) * 2);
  const unsigned vofs = (unsigned)WS_KV + (unsigned)(((tok0 + rv) * 1024 + h * 128 + 64 + cv * 8) * 2);
  const int ksta = KSWZ(ra, ca * 16), kstb = KSWZ(rb, cb * 16), vst = v_st(rv, cv * 8);
  const bool two = wid < 4;
  bf16x8 RK0a, RK0b, RV0, RK1a, RK1b, RV1;
#define TLOAD(KA, KB, VV, t) do { KA = *reinterpret_cast<const bf16x8*>(wsb + kofa + (unsigned)(t) * kinca); if (two) KB = *reinterpret_cast<const bf16x8*>(wsb + kofb + (unsigned)(t) * kincb); \
    VV = *reinterpret_cast<const bf16x8*>(wsb + vofs + (unsigned)(t) * (64u * 2048u)); } while (0)
#define TWRITE(KA, KB, VV, t) do { const int bo_ = ((t) & 3) * SHM_K; *(bf16x8*)(K_lds + bo_ + ksta) = KA; if (two) *(bf16x8*)(K_lds + bo_ + kstb) = KB; *(bf16x8*)(V_lds + bo_ + vst) = VV; } while (0)
#define RESC(a) do { if (__any((a) < 1.f)) { if (hi == 0) al_l[r32] = (a); asm volatile("s_waitcnt lgkmcnt(0)" ::: "memory"); \
    _Pragma("unroll") for (int d = 0; d < 2; ++d) _Pragma("unroll") for (int r = 0; r < 16; ++r) o[d][r] *= al_l[crow(r, hi)]; } } while (0)
#define STEP_END() do { asm volatile("s_waitcnt lgkmcnt(0)" ::: "memory"); __builtin_amdgcn_s_barrier(); asm volatile("" ::: "memory"); } while (0)
  f32x16 pA0, pA1, pB0, pB1; float mnA, mnB, alA, alB; bf16x8 pa0, pa1, pa2, pa3; constexpr int NT = SEQ / KVBLK;
  TLOAD(RK0a, RK0b, RV0, 0); TWRITE(RK0a, RK0b, RV0, 0); TLOAD(RK1a, RK1b, RV1, 1); TLOAD(RK0a, RK0b, RV0, 2);
  STEP_END();
  qkt(pA0, pA1, K_lds, qr, r32, hi); partialSM(pA0, pA1, m_reg, mnA, alA);
  TWRITE(RK1a, RK1b, RV1, 1); TLOAD(RK1a, RK1b, RV1, 3);
  STEP_END();
  for (int s = 1; s + 1 < NT; s += 2) {
    SBAR(); qkt(pB0, pB1, K_lds + (s & 3) * SHM_K, qr, r32, hi);
    finishSM(pA0, pA1, alA, l_reg, pa0, pa1, pa2, pa3); SBAR();
    TWRITE(RK0a, RK0b, RV0, s + 1);
    if (s + 3 < NT) TLOAD(RK0a, RK0b, RV0, s + 3);
    SBAR();
    pv_d0(o, vb0 + ((s - 1) & 3) * SHM_V, pa0, pa1, pa2, pa3); partialSM(pB0, pB1, m_reg, mnB, alB);
    RESC(alB); STEP_END();
    SBAR(); qkt(pA0, pA1, K_lds + ((s + 1) & 3) * SHM_K, qr, r32, hi);
    finishSM(pB0, pB1, alB, l_reg, pa0, pa1, pa2, pa3); SBAR();
    if (s + 2 < NT) TWRITE(RK1a, RK1b, RV1, s + 2);
    if (s + 4 < NT) TLOAD(RK1a, RK1b, RV1, s + 4);
    SBAR();
    pv_d0(o, vb0 + (s & 3) * SHM_V, pa0, pa1, pa2, pa3); partialSM(pA0, pA1, m_reg, mnA, alA);
    RESC(alA); STEP_END();
  }
  SBAR(); qkt(pB0, pB1, K_lds + ((NT - 1) & 3) * SHM_K, qr, r32, hi);
  finishSM(pA0, pA1, alA, l_reg, pa0, pa1, pa2, pa3); SBAR();
  pv_d0(o, vb0 + ((NT - 2) & 3) * SHM_V, pa0, pa1, pa2, pa3); partialSM(pB0, pB1, m_reg, mnB, alB);
  RESC(alB);
  finishSM(pB0, pB1, alB, l_reg, pa0, pa1, pa2, pa3); SBAR();
  pv_d0(o, vb0 + ((NT - 1) & 3) * SHM_V, pa0, pa1, pa2, pa3);
  if (hi == 0) li_l[r32] = l_reg; asm volatile("s_waitcnt lgkmcnt(0)" ::: "memory");
  bf16_t* Ow = MIX + (size_t)(tok0 + qrow0 + wid * QBLK) * 1024 + 512 + h * 64 + r32;
#pragma unroll
  for (int r = 0; r < 16; ++r) { const int orow = crow(r, hi); const float rl = __builtin_amdgcn_rcpf(li_l[orow]);
#pragma unroll
    for (int d0 = 0; d0 < 2; ++d0) Ow[(size_t)orow * 1024 + d0 * 32] = (bf16_t)(cvt_pk_bf16(o[d0][r] * rl, 0.f) & 0xffffu); }
  STEP_END();
#undef TLOAD
#undef TWRITE
#undef RESC
#undef STEP_END
}
#undef KSWZ
#undef SBAR
}

struct Frame {
    LAS unsigned char* lds; unsigned* ctl; unsigned char* ws; float* out; const float* in[29];
    int tid, lane, wave, G, bid;
};
enum { I_X = 0, I_WIN, I_LRE, I_LIM, I_LDT, I_BRE, I_BIM, I_CRE, I_CIM, I_DSK, I_WGLU, I_BGLU, I_QG, I_WUQ, I_KVG, I_WUKV, I_WO, I_LN1G, I_LN1B, I_WR, I_RB, I_WEG, I_WEU, I_WED, I_WSG, I_WSU, I_WSD, I_LN2G, I_LN2B };

#ifndef MK_TPROBE
#define MK_TPROBE -1
#endif
#define TSUB(F, id) do { if (MK_TPROBE >= 100) { __syncthreads(); if (blockIdx.x == 0 && threadIdx.x == 0) { volatile LAS unsigned* M_ = (volatile LAS unsigned*)((F).lds + MISC_OFF); const unsigned long long tn_ = __builtin_amdgcn_s_memrealtime(); \
    const unsigned long long tl_ = ((unsigned long long)M_[17] << 32) | M_[16]; if ((id) == MK_TPROBE) { const unsigned long long d_ = tn_ - tl_; M_[18] = (unsigned)d_; M_[19] = (unsigned)(d_ >> 32); } M_[16] = (unsigned)tn_; M_[17] = (unsigned)(tn_ >> 32); } } } while (0)
__device__ __forceinline__ int fresh_lane() { int l = (int)(threadIdx.x & 63u); asm volatile("" : "+v"(l)); return l; }
template <class F> __device__ __forceinline__ void transpose_load(const F& f, int k0, int n0, int lane, float (&tv)[32]) {
#pragma unroll
    for (int i = 0; i < 32; ++i) tv[i] = f(k0 + 2 * i + (lane >> 5), n0 + (lane & 31));
}
__device__ __forceinline__ void transpose_store(const float (&tv)[32], bf16_t* Bt, int ldk, int k0, int n0, LAS float* scr, int lane) {
#pragma unroll
    for (int i = 0; i < 32; ++i) scr[(2 * i + (lane >> 5)) * 33 + (lane & 31)] = tv[i];
    asm volatile("s_waitcnt lgkmcnt(0)" ::: "memory");
    const int c = lane & 7;
#pragma unroll
    for (int j = 0; j < 4; ++j) { const int n = (lane >> 3) + 8 * j; const LAS float* s = scr + (8 * c) * 33 + n;
        u32x4 o; o.x = cvt_pk_bf16(s[0 * 33], s[1 * 33]); o.y = cvt_pk_bf16(s[2 * 33], s[3 * 33]); o.z = cvt_pk_bf16(s[4 * 33], s[5 * 33]); o.w = cvt_pk_bf16(s[6 * 33], s[7 * 33]);
        *(u32x4*)(Bt + (size_t)(n0 + n) * ldk + k0 + 8 * c) = o; }
    asm volatile("s_waitcnt lgkmcnt(0)" ::: "memory");
}
template <class F> __device__ __forceinline__ void transpose_item(const F& f, bf16_t* Bt, int ldk, int k0, int n0, LAS float* scr, int lane) {
    float tv[32]; transpose_load(f, k0, n0, lane, tv); transpose_store(tv, Bt, ldk, k0, n0, scr, lane);
}
__device__ __forceinline__ int rope_perm_src(int p) { return (p & 1) ? 16 + (p >> 1) : (p >> 1); }
struct SsmPar { float lr, li, dt, kr, ki; };
__device__ __forceinline__ SsmPar ssm_par(const float* lam_re, const float* lam_im, const float* log_dt, int d, int g, int n) {
    SsmPar p; p.lr = fminf(lam_re[(d * 32 + g) * 64 + n], -1e-4f); p.li = lam_im[(d * 32 + g) * 64 + n]; p.dt = expf(log_dt[d * 32 + g]);
    const float x = p.lr * p.dt, th = p.li * p.dt;
    const float em1 = expm1f(x), cs = cosf(th), sn = sinf(th), sh = sinf(0.5f * th);
    const float ai = (em1 + 1.f) * sn, arm1 = em1 * cs - 2.f * sh * sh, den = p.lr * p.lr + p.li * p.li;
    p.kr = (arm1 * p.lr + ai * p.li) / den; p.ki = (ai * p.lr - arm1 * p.li) / den; return p;
}
__device__ __forceinline__ void ssm_pow_xt(float x, float th, float e, float& pr, float& pi) {
    const float mag = __builtin_amdgcn_exp2f(x * e * 1.4426950408889634f); double trd = (double)th * (double)e * 0.15915494309189535; trd -= rint(trd); const float tr = (float)trd;
    pr = mag * __builtin_amdgcn_cosf(tr); pi = mag * __builtin_amdgcn_sinf(tr);
}
__device__ __forceinline__ void ssm_pow(const SsmPar& p, float e, float& pr, float& pi) { ssm_pow_xt(p.lr * p.dt, p.li * p.dt, e, pr, pi); }

__device__ __forceinline__ void p0_ssm_item(Frame& F, int g, int j) {
    LAS float* Pr = (LAS float*)F.lds;
    LAS float* Pi = Pr + 2 * 64 * 33;
    LAS float* Br = Pi + 2 * 64 * 33;
    LAS float* Bi = Br + 2 * 64 * 16;
    LAS float* Cr = Bi + 2 * 64 * 16;
    LAS float* Ci = Cr + 2 * 16 * 64;
    LAS float* Par = Ci + 2 * 16 * 64;
    const float* lam_re = F.in[I_LRE]; const float* lam_im = F.in[I_LIM]; const float* log_dt = F.in[I_LDT];
    __syncthreads();
    if (F.tid < 128) { const SsmPar p = ssm_par(lam_re, lam_im, log_dt, F.tid >> 6, g, F.tid & 63); Par[F.tid * 4] = p.lr * p.dt; Par[F.tid * 4 + 1] = p.li * p.dt; Par[F.tid * 4 + 2] = p.kr; Par[F.tid * 4 + 3] = p.ki; }
    for (int idx = F.tid; idx < 2 * 16 * 64; idx += 512) { const int n = idx & 63, pp = (idx >> 6) & 15, d = idx >> 10;
        Cr[idx] = F.in[I_CRE][((d * 32 + g) * 16 + pp) * 64 + n]; Ci[idx] = F.in[I_CIM][((d * 32 + g) * 16 + pp) * 64 + n]; }
    __syncthreads();
    for (int idx = F.tid; idx < 2 * 64 * 33; idx += 512) { const int tau = idx % 33, dn = idx / 33; float pr, pi; ssm_pow_xt(Par[dn * 4], Par[dn * 4 + 1], (float)tau, pr, pi); Pr[idx] = pr; Pi[idx] = pi; }
    for (int idx = F.tid; idx < 2 * 64 * 16; idx += 512) { const int q = idx & 15, dn = idx >> 4, n = dn & 63, d = dn >> 6; const float kr = Par[dn * 4 + 2], ki = Par[dn * 4 + 3];
        const float br = F.in[I_BRE][((d * 32 + g) * 64 + n) * 16 + q], bi = F.in[I_BIM][((d * 32 + g) * 64 + n) * 16 + q];
        Br[idx] = kr * br - ki * bi; Bi[idx] = kr * bi + ki * br; }
    __syncthreads();
    float* Kt = (float*)(F.ws + WS_KT) + (size_t)g * 16384;
    { const int blk = 512 * j + F.tid;
      const int q2 = blk & 7, p2 = (blk >> 3) & 7, tau = (blk >> 6) & 31, d = blk >> 11; float s00 = 0.f, s01 = 0.f, s10 = 0.f, s11 = 0.f;
      for (int n = 0; n < 64; ++n) { const float pr = Pr[(d * 64 + n) * 33 + tau], pi = Pi[(d * 64 + n) * 33 + tau];
          const float b0r = Br[(d * 64 + n) * 16 + 2 * q2], b0i = Bi[(d * 64 + n) * 16 + 2 * q2], b1r = Br[(d * 64 + n) * 16 + 2 * q2 + 1], b1i = Bi[(d * 64 + n) * 16 + 2 * q2 + 1];
          const float d0r = pr * b0r - pi * b0i, d0i = pr * b0i + pi * b0r, d1r = pr * b1r - pi * b1i, d1i = pr * b1i + pi * b1r;
          const float c0r = Cr[(d * 16 + 2 * p2) * 64 + n], c0i = Ci[(d * 16 + 2 * p2) * 64 + n], c1r = Cr[(d * 16 + 2 * p2 + 1) * 64 + n], c1i = Ci[(d * 16 + 2 * p2 + 1) * 64 + n];
          s00 += c0r * d0r - c0i * d0i; s01 += c0r * d1r - c0i * d1i; s10 += c1r * d0r - c1i * d0i; s11 += c1r * d1r - c1i * d1i; }
      float* kp = Kt + ((size_t)(d * 32 + tau) * 16 + 2 * p2) * 16 + 2 * q2; kp[0] = s00; kp[1] = s01; kp[16] = s10; kp[17] = s11; }
    bf16_t* Wst = (bf16_t*)(F.ws + WS_WST) + (size_t)g * 256 * 512;
    for (int pc = F.tid; pc < 32 * 64; pc += 512) { const int row = 32 * j + (pc >> 6), k0 = (pc & 63) * 8, s = k0 >> 4, q0 = k0 & 15;
        const int d = row >> 7, ri = (row >> 6) & 1, n = row & 63, e = d ? s : (CHK - 1 - s);
        const float pr = Pr[(d * 64 + n) * 33 + e], pi = Pi[(d * 64 + n) * 33 + e]; float v[8];
#pragma unroll
        for (int t = 0; t < 8; ++t) { const float br = Br[(d * 64 + n) * 16 + q0 + t], bi = Bi[(d * 64 + n) * 16 + q0 + t]; v[t] = ri ? (pr * bi + pi * br) : (pr * br - pi * bi); }
        u32x4 o; o.x = cvt_pk_bf16(v[0], v[1]); o.y = cvt_pk_bf16(v[2], v[3]); o.z = cvt_pk_bf16(v[4], v[5]); o.w = cvt_pk_bf16(v[6], v[7]);
        *(u32x4*)(Wst + (size_t)row * 512 + k0) = o; }
    bf16_t* Mo = (bf16_t*)(F.ws + WS_MO) + (size_t)g * 512 * UHK;
    for (int pc = F.tid; pc < 64 * 32; pc += 512) { const int row = 64 * j + (pc >> 5), kk = (pc & 31) * 8, d = kk >> 7, ri = (kk >> 6) & 1, n0 = kk & 63, tq = row >> 4, pp = row & 15;
        const int e = d ? (CHK - tq) : (tq + 1); float v[8];
#pragma unroll
        for (int t = 0; t < 8; ++t) { const int n = n0 + t; const float pr = Pr[(d * 64 + n) * 33 + e], pi = Pi[(d * 64 + n) * 33 + e], cr = Cr[(d * 16 + pp) * 64 + n], ci = Ci[(d * 16 + pp) * 64 + n];
            v[t] = ri ? -(cr * pi + ci * pr) : (cr * pr - ci * pi); }
        u32x4 o; o.x = cvt_pk_bf16(v[0], v[1]); o.y = cvt_pk_bf16(v[2], v[3]); o.z = cvt_pk_bf16(v[4], v[5]); o.w = cvt_pk_bf16(v[6], v[7]);
        *(u32x4*)(Mo + (size_t)row * UHK + 512 + kk) = o; }
}

template <int PART> __device__ __forceinline__ void p0_prologue(Frame& F) {
    const int lane = fresh_lane();
    if (PART == 1) {
        for (int it = F.bid; it < 256; it += F.G) p0_ssm_item(F, it >> 3, it & 7);
        __syncthreads();
    }
    if (PART == 0) {
        float* rc = (float*)(F.ws + WS_ROPE); float* rs = rc + 2048 * 16;
        for (int idx = F.bid * 512 + F.tid; idx < 2048 * 16; idx += F.G * 512) { const int i = idx & 15, pos = idx >> 4;
            const float inv = expf(-9.210340371976184f * (float)i * (1.f / 16.f)); const float a = (float)pos * inv; rc[idx] = cosf(a); rs[idx] = sinf(a); } }
    LAS float* scr = (LAS float*)(F.lds + F.wave * 16384);
    const int gw = F.bid * 8 + F.wave, NGW = F.G * 8;
    constexpr int I_A = 512, I_B = 128, I_C = 96, I_D = 128, I_E = 128, I_F = 512, I_G = 65 * 256, I_H = 65 * 128;
    constexpr int NITEMS = I_A + I_B + I_C + I_D + I_E + I_F + I_G + I_H;
    for (int it = (PART == 0 ? gw : I_A + gw); it < (PART == 0 ? I_A : NITEMS); it += NGW) {
        int r = it;
        if (r < I_A) { const float* W = F.in[I_WIN]; const int kb = r / 32, nb = r % 32;
            transpose_item([&](int k, int n) -> float { if (n >= 928) return 0.f; const int src = n < 896 ? n : 896 + rope_perm_src(n - 896); return W[(size_t)k * 928 + src]; }, (bf16_t*)(F.ws + WS_WIN), 1024, kb * 64, nb * 32, scr, lane); continue; } r -= I_A;
        if (r < I_B) { const float* W = F.in[I_WGLU]; const int kb = r / 16, nb = r % 16;
            transpose_item([&](int k, int n) -> float { return W[(size_t)k * 512 + n]; }, (bf16_t*)(F.ws + WS_WGLU), 512, kb * 64, nb * 32, scr, lane); continue; } r -= I_B;
        if (r < I_C) { const float* W = F.in[I_WUQ]; const float* gq = F.in[I_QG]; const int kb = r / 24, nb = r % 24;
            transpose_item([&](int k, int n) -> float { const int hh = n / 96, jj = n % 96; const int src = jj < 64 ? n : hh * 96 + 64 + rope_perm_src(jj - 64); return W[(size_t)k * 768 + src] * gq[k]; }, (bf16_t*)(F.ws + WS_WUQ), 256, kb * 64, nb * 32, scr, lane); continue; } r -= I_C;
        if (r < I_D) { const float* W = F.in[I_WUKV]; const float* gk = F.in[I_KVG]; const int kb = r / 32, nb = r % 32;
            transpose_item([&](int k, int n) -> float { return k < 128 ? W[(size_t)k * 1024 + n] * gk[k] : 0.f; }, (bf16_t*)(F.ws + WS_WUKV), 256, kb * 64, nb * 32, scr, lane); continue; } r -= I_D;
        if (r < I_E) { const float* W = F.in[I_WR]; const int kb = r / 8, nb = r % 8;
            transpose_item([&](int k, int n) -> float { return n < 64 ? W[(size_t)k * 64 + n] : 0.f; }, (bf16_t*)(F.ws + WS_WR), 1024, kb * 64, nb * 32, scr, lane); continue; } r -= I_E;
        if (r < I_F) { const float* W = F.in[I_WO]; const int kb = r / 32, nb = r % 32;
            transpose_item([&](int k, int n) -> float { return W[(size_t)k * 1024 + n]; }, (bf16_t*)(F.ws + WS_WO), 1024, kb * 64, nb * 32, scr, lane); continue; } r -= I_F;
        const int it2 = it + NGW; const bool has2 = it2 < NITEMS; float tv0[32], tv1[32];
        auto geom = [&](int rr_, const float*& W0, const float*& W1, bf16_t*& dst, int& ldk, int& k0, int& n0, bool& gu) {
            if (rr_ < I_G) { const int e = rr_ / 256, q = rr_ % 256; gu = true; k0 = (q / 16) * 64; n0 = (q % 16) * 32; ldk = 1024;
                W0 = e < 64 ? F.in[I_WEG] + (size_t)e * 1024 * 256 : F.in[I_WSG]; W1 = e < 64 ? F.in[I_WEU] + (size_t)e * 1024 * 256 : F.in[I_WSU]; dst = (bf16_t*)(F.ws + WS_WGU) + (size_t)e * 512 * 1024; }
            else { const int q_ = rr_ - I_G, e = q_ / 128, q = q_ % 128; gu = false; k0 = (q / 32) * 64; n0 = (q % 32) * 32; ldk = 256;
                W0 = e < 64 ? F.in[I_WED] + (size_t)e * 256 * 1024 : F.in[I_WSD]; W1 = W0; dst = (bf16_t*)(F.ws + WS_WD) + (size_t)e * 1024 * 256; } };
        auto val = [&](bool gu, const float* W0, const float* W1, int k, int n) -> float { if (gu) { const int r_ = n & 255, col = 128 * (n >> 8) + 32 * (r_ >> 6) + (r_ & 31); return ((r_ >> 5) & 1) ? W1[(size_t)k * 256 + col] : W0[(size_t)k * 256 + col]; } return W0[(size_t)k * 1024 + n]; };
        const float *Wa0, *Wa1, *Wb0, *Wb1; bf16_t *da, *db; int lka, ka, na, lkb, kb_, nb_; bool gua, gub;
        geom(r, Wa0, Wa1, da, lka, ka, na, gua);
        transpose_load([&](int k, int n) -> float { return val(gua, Wa0, Wa1, k, n); }, ka, na, lane, tv0);
        if (has2) { geom(it2 - (I_A + I_B + I_C + I_D + I_E + I_F), Wb0, Wb1, db, lkb, kb_, nb_, gub); transpose_load([&](int k, int n) -> float { return val(gub, Wb0, Wb1, k, n); }, kb_, nb_, lane, tv1); }
        transpose_store(tv0, da, lka, ka, na, scr, lane);
        if (has2) transpose_store(tv1, db, lkb, kb_, nb_, scr, lane);
        it += NGW;
    }
    if (PART == 0) {
      const float* x = F.in[I_X]; bf16_t* xb = (bf16_t*)(F.ws + WS_XB); const size_t N8 = (size_t)T * DM / 8, st = (size_t)F.G * 512;
      for (size_t i = (size_t)F.bid * 512 + F.tid; i < N8; i += 4 * st) {
          f32x4 a[4], b[4];
#pragma unroll
          for (int u = 0; u < 4; ++u) { const size_t ii = i + u * st < N8 ? i + u * st : i; a[u] = __builtin_nontemporal_load((const f32x4*)(x + ii * 8)); b[u] = __builtin_nontemporal_load((const f32x4*)(x + ii * 8 + 4)); }
#pragma unroll
          for (int u = 0; u < 4; ++u) if (i + u * st < N8) *(u32x4*)(xb + (i + u * st) * 8) = pack8(a[u], b[u]); } }
    if (PART == 1) { asm volatile("s_waitcnt vmcnt(0) lgkmcnt(0)" ::: "memory"); __syncthreads(); }
}

__device__ __forceinline__ void scan_unit(Frame& F, int g, int pm) {
    const float* S = (const float*)(F.ws + WS_S); bf16_t* UH = (bf16_t*)(F.ws + WS_UH);
    {
        const int n = F.tid & 63, d = (F.tid >> 6) & 1, b = pm * 4 + (F.tid >> 7);
        const SsmPar p = ssm_par(F.in[I_LRE], F.in[I_LIM], F.in[I_LDT], d, g, n); float acr, aci; ssm_pow(p, (float)CHK, acr, aci);
        float hr = 0.f, hi = 0.f;
        const size_t rbase = (size_t)g * UHR + (size_t)b * NCHK;
#pragma unroll
        for (int hb = 0; hb < 2; ++hb) {
            float sr[32], si[32];
#pragma unroll
            for (int st = 0; st < 32; ++st) { const int ci = d ? (NCHK - 1 - (hb * 32 + st)) : (hb * 32 + st);
                sr[st] = S[(rbase + ci) * 256 + d * 128 + n]; si[st] = S[(rbase + ci) * 256 + d * 128 + 64 + n]; }
#pragma unroll
            for (int st = 0; st < 32; ++st) { const int ci = d ? (NCHK - 1 - (hb * 32 + st)) : (hb * 32 + st);
                bf16_t* hp = UH + (rbase + ci) * UHK + 512 + d * 128 + n;
                hp[0] = (bf16_t)(cvt_pk_bf16(hr, 0.f) & 0xffffu); hp[64] = (bf16_t)(cvt_pk_bf16(hi, 0.f) & 0xffffu);
                const float nr = acr * hr - aci * hi + sr[st], ni = acr * hi + aci * hr + si[st]; hr = nr; hi = ni; }
        }
    }
}
__device__ __forceinline__ void mo_fill(Frame& F) {
    const float* Kt = (const float*)(F.ws + WS_KT); bf16_t* Mo = (bf16_t*)(F.ws + WS_MO);
    for (int pc = F.bid * 512 + F.tid; pc < 32 * 512 * 64; pc += F.G * 512) {
        const int k0 = (pc & 63) * 8, row = (pc >> 6) & 511, g = pc >> 15, s = k0 >> 4, q0 = k0 & 15, tq = row >> 4, pp = row & 15;
        f32x4 v0 = {0.f, 0.f, 0.f, 0.f}, v1 = {0.f, 0.f, 0.f, 0.f};
        if (tq >= s) { const float* kp = Kt + ((size_t)(g * 2 + 0) * 32 + (tq - s)) * 256 + pp * 16 + q0; v0 += *(const f32x4*)kp; v1 += *(const f32x4*)(kp + 4); }
        if (s >= tq) { const float* kp = Kt + ((size_t)(g * 2 + 1) * 32 + (s - tq)) * 256 + pp * 16 + q0; v0 += *(const f32x4*)kp; v1 += *(const f32x4*)(kp + 4); }
        *(u32x4*)(Mo + ((size_t)g * 512 + row) * UHK + k0) = pack8(v0, v1);
    }
}

__device__ __forceinline__ void p7_ln1(Frame& F) {
    const int lane = fresh_lane();
    const float* g1 = F.in[I_LN1G]; const float* b1 = F.in[I_LN1B]; bf16_t* x1b = (bf16_t*)(F.ws + WS_X1B);
    f32x4 gg[4], bb[4];
#pragma unroll
    for (int j = 0; j < 4; ++j) { const int c = 8 * lane + (j >> 1) * 512 + (j & 1) * 4; gg[j] = *(const f32x4*)(g1 + c); bb[j] = *(const f32x4*)(b1 + c); }
    for (int pm = F.bid; pm < T / 256; pm += F.G)
    for (int row = pm * 256 + F.wave; row < pm * 256 + 256; row += 8) {
        bf16_t* rp = x1b + (size_t)row * 1024 + 8 * lane; f32x4 v[4];
        { const u32x4 w0 = *(const u32x4*)rp, w1 = *(const u32x4*)(rp + 512); unpack8(w0, v[0], v[1]); unpack8(w1, v[2], v[3]); }
        float s = 0.f;
#pragma unroll
        for (int j = 0; j < 4; ++j) s += (v[j][0] + v[j][1]) + (v[j][2] + v[j][3]);
        const float mean = wave_sum(s) * (1.f / 1024.f); float q = 0.f;
#pragma unroll
        for (int j = 0; j < 4; ++j) { v[j] = v[j] - mean; q += (v[j][0] * v[j][0] + v[j][1] * v[j][1]) + (v[j][2] * v[j][2] + v[j][3] * v[j][3]); }
        const float rstd = __builtin_amdgcn_rsqf(wave_sum(q) * (1.f / 1024.f) + LN_EPS);
#pragma unroll
        for (int j = 0; j < 4; ++j) v[j] = v[j] * rstd * gg[j] + bb[j];
        *(u32x4*)rp = pack8(v[0], v[1]); *(u32x4*)(rp + 512) = pack8(v[2], v[3]);
    }
}

__device__ __forceinline__ void route_batch(Frame& F, int bt) {
    LAS int* hist = (LAS int*)(F.lds); LAS int* base = hist + 64;
    const float* LG = (const float*)(F.ws + WS_LOGIT); int* rowtok = (int*)(F.ws + WS_ROWTOK); int* tslot = (int*)(F.ws + WS_TSLOT); float* topw = (float*)(F.ws + WS_TOPW);
    {
        __syncthreads();
        if (F.tid < 64) hist[F.tid] = 0;
        __syncthreads();
        const int tok = bt * 256 + F.tid, ch = (bt * 256) / CAPC;
        int idx[6], lr[6]; float w[6];
        if (F.tid < 256) {
            float lg[64];
#pragma unroll
            for (int j = 0; j < 16; ++j) { const f32x4 v = *(const f32x4*)(LG + (size_t)tok * 64 + 4 * j); lg[4 * j] = v[0]; lg[4 * j + 1] = v[1]; lg[4 * j + 2] = v[2]; lg[4 * j + 3] = v[3]; }
            route_token(lg, F.in[I_RB], idx, w);
#pragma unroll
            for (int k = 0; k < 6; ++k) lr[k] = atomicAdd((int*)&hist[idx[k]], 1);
        }
        __syncthreads();
        if (F.tid < 64) base[F.tid] = (int)__hip_atomic_fetch_add(F.ctl + CW_CNT + 64 * (ch * 65 + F.tid), (unsigned)hist[F.tid], __ATOMIC_RELAXED, __HIP_MEMORY_SCOPE_AGENT);
        __syncthreads();
        if (F.tid < 256) {
#pragma unroll
            for (int k = 0; k < 6; ++k) { const int slot = base[idx[k]] + lr[k];
                rowtok[(size_t)(ch * 64 + idx[k]) * CAPC + slot] = tok; tslot[(size_t)tok * 8 + k] = (idx[k] << 16) | slot; topw[(size_t)tok * 8 + k] = w[k]; }
        }
    }
}

__device__ __forceinline__ void p12_combine(Frame& F, int ch) {
    const int lane = fresh_lane();
    const MoeTab tb = moe_tab(F.lds); const int t0 = tb.tbase[ch * 65];
    const unsigned char* Y8 = F.ws + WS_Y; const bf16_t* YS = (const bf16_t*)(F.ws + WS_YS); const bf16_t* x1b = (const bf16_t*)(F.ws + WS_X1B);
    const int* tslot = (const int*)(F.ws + WS_TSLOT); const float* topw = (const float*)(F.ws + WS_TOPW);
    const float* g2 = F.in[I_LN2G]; const float* b2 = F.in[I_LN2B];
    f32x4 gg[4], bb[4];
#pragma unroll
    for (int j = 0; j < 4; ++j) { const int c = 8 * lane + (j >> 1) * 512 + (j & 1) * 4; gg[j] = *(const f32x4*)(g2 + c); bb[j] = *(const f32x4*)(b2 + c); }
    constexpr int NTK = 4;
    const int stride = F.G * 8;
    for (int tk0 = F.bid * 8 + F.wave; tk0 < CAPC; tk0 += NTK * stride) {
        int ts[NTK][6]; float tw[NTK][6];
#pragma unroll
        for (int t = 0; t < NTK; ++t) { const int tk = tk0 + t * stride < CAPC ? tk0 + t * stride : tk0; const size_t tok = (size_t)ch * CAPC + tk;
#pragma unroll
            for (int k = 0; k < 6; ++k) { ts[t][k] = tslot[tok * 8 + k]; tw[t][k] = topw[tok * 8 + k]; } }
        u32x4 xw[NTK][2], sw[NTK][2]; u32x2 yw[NTK][6][2];
#pragma unroll
        for (int t = 0; t < NTK; ++t) { const int tk = tk0 + t * stride < CAPC ? tk0 + t * stride : tk0; const size_t tok = (size_t)ch * CAPC + tk;
            const bf16_t* xr = x1b + tok * 1024 + 8 * lane; xw[t][0] = *(const u32x4*)xr; xw[t][1] = *(const u32x4*)(xr + 512);
            const bf16_t* yr = YS + (size_t)tk * 1024 + 8 * lane; sw[t][0] = *(const u32x4*)yr; sw[t][1] = *(const u32x4*)(yr + 512);
#pragma unroll
            for (int k = 0; k < 6; ++k) { const int yrow = (tb.tbase[ch * 65 + (ts[t][k] >> 16)] - t0) * 256 + (ts[t][k] & 0xffff);
                const unsigned char* y8 = Y8 + (size_t)yrow * Y8_LD + 8 * lane; yw[t][k][0] = *(const u32x2*)y8; yw[t][k][1] = *(const u32x2*)(y8 + 512); } }
#pragma unroll
        for (int t = 0; t < NTK; ++t) {
            const int tk = tk0 + t * stride; if (tk >= CAPC) break;
            const size_t tok = (size_t)ch * CAPC + tk;
            f32x4 a[4]; unpack8(xw[t][0], a[0], a[1]); unpack8(xw[t][1], a[2], a[3]); a[0] *= ALPHA; a[1] *= ALPHA; a[2] *= ALPHA; a[3] *= ALPHA;
            { f32x4 y0, y1, y2, y3; unpack8(sw[t][0], y0, y1); unpack8(sw[t][1], y2, y3); a[0] += y0; a[1] += y1; a[2] += y2; a[3] += y3; }
#pragma unroll
            for (int k = 0; k < 6; ++k) { const float w = tw[t][k] * Y8_INV; f32x4 y0, y1, y2, y3; unpack8_fp8(yw[t][k][0], y0, y1); unpack8_fp8(yw[t][k][1], y2, y3);
                a[0] += y0 * w; a[1] += y1 * w; a[2] += y2 * w; a[3] += y3 * w; }
            float s = 0.f;
#pragma unroll
            for (int j = 0; j < 4; ++j) s += (a[j][0] + a[j][1]) + (a[j][2] + a[j][3]);
            const float mean = wave_sum(s) * (1.f / 1024.f); float q = 0.f;
#pragma unroll
            for (int j = 0; j < 4; ++j) { a[j] = a[j] - mean; q += (a[j][0] * a[j][0] + a[j][1] * a[j][1]) + (a[j][2] * a[j][2] + a[j][3] * a[j][3]); }
            const float rstd = __builtin_amdgcn_rsqf(wave_sum(q) * (1.f / 1024.f) + LN_EPS);
            float* orow = F.out + tok * 1024 + 8 * lane;
#pragma unroll
            for (int j = 0; j < 4; ++j) *(f32x4*)(orow + (j >> 1) * 512 + (j & 1) * 4) = a[j] * rstd * gg[j] + bb[j];
        }
    }
}
}

namespace fx {
constexpr int NPHASE = 11 + 2 * NCH;
struct Args { const float* in[29]; float* out; unsigned char* ws; int ph_lo, ph_hi; };

__global__ void __launch_bounds__(512, 2) fwd(Args args) {
    extern __shared__ __attribute__((aligned(16))) unsigned char lds_raw[];
    Frame F;
    F.lds = (LAS unsigned char*)lds_raw; F.ws = args.ws; F.ctl = (unsigned*)(args.ws + WS_CTL); F.out = args.out;
#pragma unroll
    for (int i = 0; i < 29; ++i) F.in[i] = args.in[i];
    F.tid = threadIdx.x; F.lane = F.tid & 63; F.wave = __builtin_amdgcn_readfirstlane(F.tid >> 6); F.G = gridDim.x; F.bid = blockIdx.x;
    volatile LAS unsigned* MISC = (volatile LAS unsigned*)(F.lds + MISC_OFF);
    if (F.tid < 32) MISC[F.tid] = 0u;
    __syncthreads();
    const int lo = args.ph_lo, hi = args.ph_hi;
    XcdBarrier bar; bar.bar = F.ctl + CW_BAR; bar.x = 0; bar.st = MISC + 8;
    if (hi - lo > 1) bar = xcd_barrier_post(F.ctl + CW_BAR, MISC + 8);
#ifndef PH_MASK
#define PH_MASK 0xFFFFFFFFu
#endif
#define IN(k) (((PH_MASK >> ((k) > 11 ? 11 + (((k) - 11) & 1) : (k))) & 1u) && lo <= (k) && (k) < hi)
#define SEAM(k) do { if (IN(k) && IN((k) + 1)) xcd_barrier(bar); if (MK_TPROBE >= 300 && blockIdx.x == 0 && threadIdx.x == 0) { const unsigned long long cn_ = __builtin_amdgcn_s_memtime(); \
        const unsigned long long cl_ = ((unsigned long long)MISC[25] << 32) | MISC[24]; if ((k) + 300 == MK_TPROBE) { const unsigned long long dc_ = cn_ - cl_; MISC[26] = (unsigned)dc_; MISC[27] = (unsigned)(dc_ >> 32); } MISC[24] = (unsigned)cn_; MISC[25] = (unsigned)(cn_ >> 32); } \
     if (MK_TPROBE >= 0 && blockIdx.x == 0 && threadIdx.x == 0) { const unsigned long long tn_ = __builtin_amdgcn_s_memrealtime(); \
        const unsigned long long tl_ = ((unsigned long long)MISC[17] << 32) | MISC[16]; if (((k) == MK_TPROBE && MK_TPROBE < 100) || (k) + 300 == MK_TPROBE) { const unsigned long long d_ = tn_ - tl_; MISC[18] = (unsigned)d_; MISC[19] = (unsigned)(d_ >> 32); } if (MK_TPROBE == 200 + (k)) { MISC[18] = MISC[22]; MISC[19] = MISC[23]; } MISC[22] = 0u; MISC[23] = 0u; MISC[16] = (unsigned)tn_; MISC[17] = (unsigned)(tn_ >> 32); } } while (0)
    unsigned char* ws = args.ws;
    bf16_t* UH = (bf16_t*)(ws + WS_UH); bf16_t* CQ = (bf16_t*)(ws + WS_CQ); bf16_t* CKVR = (bf16_t*)(ws + WS_CKVR); bf16_t* Qb = (bf16_t*)(ws + WS_Q); bf16_t* KVb = (bf16_t*)(ws + WS_KV);
    bf16_t* SPRE = (bf16_t*)(ws + WS_SPRE); bf16_t* MIX = (bf16_t*)(ws + WS_MIX);
    float* ssqq = (float*)(ws + WS_SSQQ); float* ssqkv = (float*)(ws + WS_SSQKV); const float* ropec = (const float*)(ws + WS_ROPE); const float* ropes = ropec + 2048 * 16;

    if (MK_TPROBE >= 0 && blockIdx.x == 0 && threadIdx.x == 0) { const unsigned long long tn_ = __builtin_amdgcn_s_memrealtime(); MISC[16] = (unsigned)tn_; MISC[17] = (unsigned)(tn_ >> 32); }
    if (MK_TPROBE == 500 && threadIdx.x == 0) __hip_atomic_store(F.ctl + CW_DBG + 64 + blockIdx.x, 1u + xb_xcc_id(), __ATOMIC_RELAXED, __HIP_MEMORY_SCOPE_AGENT);
    if (IN(0)) { p0_prologue<0>(F); } SEAM(0);
    if (IN(1)) {
        const bool conv_first = ((F.bid >> 3) & 1) != 0;
        if (conv_first) p0_prologue<1>(F);
        { PlainOrder S; S.init(ws + WS_XB, 1024, ws + WS_WIN, 1024, T, 1024, F.G, F.bid);
          EpiWin E{UH, CQ, CKVR, ssqq, ssqkv, ropec, ropes};
          gemm_phase<EpiWin, PlainOrder, true, false>(F.lds, 1024, 1024, 1024, S, E); }
        if (!conv_first) p0_prologue<1>(F);
    } SEAM(1);
    if (IN(2)) {
        { GroupOrder S; S.init(UH, ws + WS_WST, 512, 1, F.G, F.bid); EpiSt E{(float*)(ws + WS_S)};
          gemm_phase<EpiSt, GroupOrder, true, false>(F.lds, UHK, 512, 512, S, E);
          asm volatile("s_waitcnt vmcnt(0)" ::: "memory"); __syncthreads();
          Unit u; for (int i = 0; S.next(i, u); ++i) scan_unit(F, u.i0, u.i1); }
        mo_fill(F);
        { PlainOrder S; S.init(CQ, 256, ws + WS_WUQ, 256, T, 768, F.G, F.bid); EpiQ E{Qb, ssqq, ropec, ropes};
          gemm_phase<EpiQ, PlainOrder, true, false>(F.lds, 256, 256, 256, S, E); }
        { PlainOrder S; S.init(CKVR, 256, ws + WS_WUKV, 256, T, 1024, F.G, F.bid); EpiKV E{KVb, ssqkv};
          gemm_phase<EpiKV, PlainOrder, true, false>(F.lds, 256, 256, 256, S, E); }
    } SEAM(2);
    if (IN(4)) {
#ifndef SUB4
#define SUB4 3
#endif
        if (SUB4 & 2) REP(40) for (int i = 0;; ++i) { const long L = (long)i * F.G + F.bid; if (L >= 2048) break;
            const int un = xcd_remap((int)L, 2048), pair = un >> 3, qb = un & 7, b = pair >> 3, h = pair & 7;
            att::attn_unit(ws, Qb, MIX, b * SEQ, qb * 256, h, (char*)lds_raw); }
        if (SUB4 & 1) DUP2(4, { GroupOrder S; S.init(UH, ws + WS_MO, UHK, 2, F.G, F.bid); EpiSsmOut E{UH, SPRE, F.in[I_DSK]};
          gemm_phase<EpiSsmOut, GroupOrder, true, false>(F.lds, UHK, UHK, UHK, S, E); });
    } SEAM(4);
    if (IN(5)) {
        { PanelOrder S; S.init(SPRE, SPRE_LD, ws + WS_WGLU, 512, T, 512, F.G, F.bid); EpiGlu E{SPRE, MIX, F.in[I_BGLU]};
          gemm_phase<EpiGlu, PanelOrder, true, false>(F.lds, SPRE_LD, 512, 512, S, E); }
        asm volatile("s_waitcnt vmcnt(0)" ::: "memory"); __syncthreads();
        { PanelOrder S; S.init(MIX, 1024, ws + WS_WO, 1024, T, 1024, F.G, F.bid); EpiWo E{F.in[I_X], (bf16_t*)(ws + WS_X1B)};
          gemm_phase<EpiWo, PanelOrder, true, false>(F.lds, 1024, 1024, 1024, S, E); }
        asm volatile("s_waitcnt vmcnt(0)" ::: "memory"); __syncthreads();
        p7_ln1(F);
        asm volatile("s_waitcnt vmcnt(0)" ::: "memory"); __syncthreads();
        { PanelOrder S; S.init(ws + WS_X1B, 1024, ws + WS_WGU + (size_t)64 * 512 * 1024 * 2, 1024, T, 768, F.G, F.bid); EpiSharedRouter E{(bf16_t*)(ws + WS_HS), (float*)(ws + WS_LOGIT)};
          gemm_phase<EpiSharedRouter, PanelOrder, true, false>(F.lds, 1024, 1024, 1024, S, E);
          asm volatile("s_waitcnt vmcnt(0)" ::: "memory"); __syncthreads();
          Unit u; for (int i = 0; S.next(i, u); ++i) if (u.i1 == 2) route_batch(F, u.i0); }
    } SEAM(8);
    if (IN(10)) {
        moe_build_tab(F.lds, F.ctl);
        GateUpOrder S; S.init(F.lds, ws + WS_X1B, ws + WS_WGU, (const int*)(ws + WS_ROWTOK), F.ctl, 0, F.G, F.bid); EpiGateUp E{(bf16_t*)(ws + WS_H)};
        gemm_phase<EpiGateUp, GateUpOrder, true, true>(F.lds, 1024, 1024, 1024, S, E);
    } SEAM(10);
#pragma unroll
    for (int ch = 0; ch < NCH; ++ch) {
        if (IN(11 + 2 * ch)) {
            moe_build_tab(F.lds, F.ctl);
            { DownOrder S; S.init(ws + WS_H, ws + WS_HS, ws + WS_WD, moe_tab(F.lds), ch, F.G, F.bid); EpiDown E{ws + WS_Y, (bf16_t*)(ws + WS_YS)};
              gemm_phase<EpiDown, DownOrder, true, false, MK_STAG>(F.lds, 256, 256, 256, S, E); }
            if (ch + 1 < NCH) { GateUpOrder S; S.init(F.lds, ws + WS_X1B, ws + WS_WGU, (const int*)(ws + WS_ROWTOK), F.ctl, ch + 1, F.G, F.bid); EpiGateUp E{(bf16_t*)(ws + WS_H)};
              gemm_phase<EpiGateUp, GateUpOrder, true, true>(F.lds, 1024, 1024, 1024, S, E); }
        } SEAM(11 + 2 * ch);
        if (IN(12 + 2 * ch)) { moe_build_tab(F.lds, F.ctl); p12_combine(F, ch); } SEAM(12 + 2 * ch);
    }
    if (MK_TPROBE == 500 && blockIdx.x == 0 && threadIdx.x == 0) { unsigned bad = 0; for (unsigned b = 8; b < gridDim.x; ++b) bad += __hip_atomic_load(F.ctl + CW_DBG + 64 + b, __ATOMIC_RELAXED, __HIP_MEMORY_SCOPE_AGENT) != __hip_atomic_load(F.ctl + CW_DBG + 64 + (b & 7u), __ATOMIC_RELAXED, __HIP_MEMORY_SCOPE_AGENT);
        const unsigned long long t0_ = __builtin_amdgcn_s_memrealtime(); if (bad) while (__builtin_amdgcn_s_memrealtime() - t0_ < 100000ull) __builtin_amdgcn_s_sleep(8); }
    if (MK_TPROBE >= 0 && MK_TPROBE != 500 && blockIdx.x == 0 && threadIdx.x == 0) { const unsigned long long d_ = ((unsigned long long)MISC[19] << 32) | MISC[18]; const unsigned long long t0_ = __builtin_amdgcn_s_memrealtime();
        unsigned long long wait_ = 8ull * d_; if (MK_TPROBE >= 300) { const unsigned long long dc_ = ((unsigned long long)MISC[27] << 32) | MISC[26]; wait_ = d_ ? (dc_ * 100ull / d_) * 100ull : 0ull; }
        while (__builtin_amdgcn_s_memrealtime() - t0_ < wait_) __builtin_amdgcn_s_sleep(8); }
#undef IN
#undef SEAM
}

#if MK_DEBUG
__global__ void dbg_cmp(int k, const unsigned char* ws, const float* out_fast, gold::Bufs B, const float* gx1, const float* gout, float* acc) {
    const int t = blockIdx.x;
    float num = 0.f, den = 0.f;
    auto bf = [](const bf16_t* p, size_t i) -> float { return __uint_as_float(((unsigned)p[i]) << 16); };
    int ncol = 0;
    switch (k) { case 0: ncol = 512; break; case 1: ncol = 256; break; case 2: ncol = 160; break; case 3: ncol = 768; break; case 4: ncol = 1024; break; case 5: ncol = 512; break; case 6: ncol = 512; break; case 7: ncol = 512; break; case 8: ncol = 1024; break; default: ncol = 1024; }
    for (int c = threadIdx.x; c < ncol; c += blockDim.x) {
        float f = 0.f, g = 0.f;
        if (k == 0) { const int gg = c >> 4, p = c & 15; f = bf((const bf16_t*)(ws + WS_UH), ((size_t)gg * UHR + (t >> 5)) * UHK + (t & 31) * 16 + p); g = B.proj[(size_t)t * 928 + c]; }
        else if (k == 1) { f = bf((const bf16_t*)(ws + WS_CQ), (size_t)t * 256 + c); g = B.proj[(size_t)t * 928 + 512 + c]; }
        else if (k == 2) { f = bf((const bf16_t*)(ws + WS_CKVR), (size_t)t * 256 + c); g = c < 128 ? B.proj[(size_t)t * 928 + 768 + c] : B.krope[(size_t)t * 32 + rope_perm_src(c - 128)]; }
        else if (k == 3) { const int hh = c / 96, jj = c % 96, src = jj < 64 ? c : hh * 96 + 64 + rope_perm_src(jj - 64); f = bf((const bf16_t*)(ws + WS_Q), (size_t)t * 768 + c); g = B.q[(size_t)t * 768 + src] * QSCALE; }
        else if (k == 4) { f = bf((const bf16_t*)(ws + WS_KV), (size_t)t * 1024 + c); g = B.kv[(size_t)t * 1024 + c]; }
        else if (k == 5) { f = bf((const bf16_t*)(ws + WS_SPRE), (size_t)t * SPRE_LD + c); g = B.spre[(size_t)t * 512 + c]; }
        else if (k == 6) { f = bf((const bf16_t*)(ws + WS_MIX), (size_t)t * 1024 + c); g = B.mix[(size_t)t * 1024 + c]; }
        else if (k == 7) { f = bf((const bf16_t*)(ws + WS_MIX), (size_t)t * 1024 + 512 + c); g = B.mix[(size_t)t * 1024 + 512 + c]; }
        else if (k == 8) { f = bf((const bf16_t*)(ws + WS_X1B), (size_t)t * 1024 + c); g = gx1[(size_t)t * 1024 + c]; }
        else { f = out_fast[(size_t)t * 1024 + c]; g = gout[(size_t)t * 1024 + c]; }
        const float d = f - g; num += d * d; den += g * g;
        if (!(fabsf(f) < 1e30f)) num += 1e30f;
    }
    num = wave_sum(num); den = wave_sum(den);
    if ((threadIdx.x & 63) == 0) { atomicAdd(acc + 2 * k, num); atomicAdd(acc + 2 * k + 1, den); }
}
__global__ void dbg_encode(const float* acc, float* out, int k0, int nk) {
    float c2 = 0.f;
    for (int k = k0; k < k0 + nk; ++k) { const float e = sqrtf(acc[2 * k] / fmaxf(acc[2 * k + 1], 1e-30f)); const float tol = (k == 9) ? 0.08f : 0.04f;
        if (!(e <= tol)) { const int bucket = !(e <= 0.5f) ? 0 : (e > 0.1f ? 1 : 2); c2 = (float)(k - k0 + 1) + 20.f * bucket; break; } }
    if (c2 == 0.f) { if (MK_DBG_NPH >= NPHASE) return; c2 = 90.f; }
    const float c = sqrtf(c2);
    for (size_t i = (size_t)blockIdx.x * blockDim.x + threadIdx.x; i < (size_t)T * 1024; i += (size_t)gridDim.x * blockDim.x) out[i] = c;
}
#endif
}

extern "C" void kernel_launch(void* const* d_in, const int* in_sizes, int n_in, void* d_out, int out_size, void* d_ws, size_t ws_size, hipStream_t stream) {
#if MK_MODE == 0
    gold::In I; const float** p = (const float**)&I;
    for (int i = 0; i < 29; ++i) p[i] = (const float*)d_in[i];
    for (int t0 = 0; t0 < 65536; t0 += 16384) gold::run(I, t0, 16384, (float*)d_ws, (float*)d_out + (size_t)t0 * 1024, (float*)d_out + (size_t)t0 * 1024, stream);
#else
    using namespace fx;
    static int grid = 0;
    if (grid == 0) {
        if (n_in != 29 || ws_size < WS_END) { fprintf(stderr, "kernel_launch: need 29 inputs and >= %zu bytes of workspace (got %d, %zu)\n", (size_t)WS_END, n_in, ws_size); grid = -1; return; }
        int dev = 0, cus = 0, per_cu = 0;
        hipGetDevice(&dev); hipDeviceGetAttribute(&cus, hipDeviceAttributeMultiprocessorCount, dev);
        if (hipFuncSetAttribute((const void*)fwd, hipFuncAttributeMaxDynamicSharedMemorySize, LDS_BYTES) != hipSuccess) { fprintf(stderr, "kernel_launch: hipFuncSetAttribute failed\n"); grid = -1; return; }
        if (hipOccupancyMaxActiveBlocksPerMultiprocessor(&per_cu, (const void*)fwd, 512, LDS_BYTES) != hipSuccess || per_cu < 1) { fprintf(stderr, "kernel_launch: occupancy query says %d\n", per_cu); }
        (void)hipGetLastError();
        grid = cus > 0 ? cus : 256;
    }
    if (grid < 0) return;
    hipMemsetAsync((char*)d_ws + WS_CTL, 0, CTL_BYTES, stream);
    Args a{};
    for (int i = 0; i < 29; ++i) a.in[i] = (const float*)d_in[i];
    a.out = (float*)d_out; a.ws = (unsigned char*)d_ws;
#if MK_MODE == 1
    for (int ph = 0; ph < NPHASE && ph < MK_DBG_NPH; ++ph) { a.ph_lo = ph; a.ph_hi = ph + 1; hipLaunchKernelGGL(fwd, dim3(grid), dim3(512), LDS_BYTES, stream, a); }
#else
    a.ph_lo = 0; a.ph_hi = NPHASE; hipLaunchKernelGGL(fwd, dim3(grid), dim3(512), LDS_BYTES, stream, a);
#endif
#if MK_DEBUG
    {
        gold::In I; const float** p = (const float**)&I;
        for (int i = 0; i < 29; ++i) p[i] = (const float*)d_in[i];
        float* gs = (float*)((char*)d_ws + WS_GOLD); float* gx1 = gs + (size_t)2048 * gold::GOLD_FLOATS_PER_TOK; float* gout = gx1 + (size_t)2048 * 1024;
        gold::Bufs B = gold::run(I, 0, 2048, gs, gx1, gout, stream);
        float* acc = (float*)((char*)d_ws + WS_CTL) + CW_DBG;
        for (int k = 0; k < 10; ++k) hipLaunchKernelGGL(dbg_cmp, dim3(2048), dim3(256), 0, stream, k, (const unsigned char*)d_ws, (const float*)d_out, B, (const float*)gx1, (const float*)gout, acc);
        hipLaunchKernelGGL(dbg_encode, dim3(1024), dim3(256), 0, stream, (const float*)acc, (float*)d_out, MK_DBG_K0, MK_DBG_NK);
    }
#endif
    const hipError_t le = hipPeekAtLastError();
    if (le != hipSuccess) fprintf(stderr, "kernel_launch: launch failed: %s\n", hipGetErrorName(le));
#endif
}
```

```cpp
#define MK_MODE 2
#include <hip/hip_runtime.h>
#include <cstdio>
#include <cstdint>
#include <cmath>
#ifndef MK_MODE
#define MK_MODE 1
#endif
#ifndef MK_DBG_NPH
#define MK_DBG_NPH 99
#endif
#ifndef MK_DBG_K0
#define MK_DBG_K0 0
#endif
#ifndef MK_DBG_NK
#define MK_DBG_NK 10
#endif
#ifndef MK_DUP
#define MK_DUP -1
#endif
#define REP(k) for (int rep_ = 0; rep_ < ((MK_DUP == (k)) ? 2 : 1); ++rep_)
#define DUP2(k, ...) do { __VA_ARGS__ if constexpr (MK_DUP == (k)) { __VA_ARGS__ } } while (0)
#ifndef MK_TPROBE
#define MK_TPROBE -1
#endif
#ifndef MK_STAG
#define MK_STAG 0
#endif
#ifndef MK_DEBUG
#define MK_DEBUG 0
#endif
namespace gold {
constexpr int D_MODEL = 1024, SEQ = 2048, D_SSM = 512, D_IN = 928, NH = 8, QLR = 256, KVLR = 128, ROPE = 32;
constexpr int NEXP = 64, TOPK = 6, DEXP = 256;
constexpr float ALPHA = 1.189207115002721f, LN_EPS = 1e-5f, RMS_EPS = 1e-6f, ATT_SCALE = 0.10206207261596577f;

__global__ void __launch_bounds__(256) sgemm(const float* __restrict__ A, int lda, const float* __restrict__ B, int ldb, float* __restrict__ C, int ldc, int M, int N, int K) {
    __shared__ float As[16][65];
    __shared__ float Bs[16][65];
    const int tid = threadIdx.x, tx = tid & 15, ty = tid >> 4;
    const int m0 = blockIdx.y * 64, n0 = blockIdx.x * 64;
    float acc[4][4];
#pragma unroll
    for (int i = 0; i < 4; ++i)
#pragma unroll
        for (int j = 0; j < 4; ++j) acc[i][j] = 0.f;
    for (int k0 = 0; k0 < K; k0 += 16) {
#pragma unroll
        for (int i = 0; i < 4; ++i) { const int idx = tid + 256 * i, r = idx >> 4, c = idx & 15; As[c][r] = A[(size_t)(m0 + r) * lda + k0 + c]; }
#pragma unroll
        for (int i = 0; i < 4; ++i) { const int idx = tid + 256 * i, r = idx >> 6, c = idx & 63; Bs[r][c] = (n0 + c < N) ? B[(size_t)(k0 + r) * ldb + n0 + c] : 0.f; }
        __syncthreads();
#pragma unroll
        for (int k = 0; k < 16; ++k) {
            float a[4], b[4];
#pragma unroll
            for (int i = 0; i < 4; ++i) a[i] = As[k][ty + 16 * i];
#pragma unroll
            for (int j = 0; j < 4; ++j) b[j] = Bs[k][tx + 16 * j];
#pragma unroll
            for (int i = 0; i < 4; ++i)
#pragma unroll
                for (int j = 0; j < 4; ++j) acc[i][j] = fmaf(a[i], b[j], acc[i][j]);
        }
        __syncthreads();
    }
#pragma unroll
    for (int i = 0; i < 4; ++i)
#pragma unroll
        for (int j = 0; j < 4; ++j) { const int c = n0 + tx + 16 * j; if (c < N) C[(size_t)(m0 + ty + 16 * i) * ldc + c] = acc[i][j]; }
}

__device__ __forceinline__ float gelu_tanh(float x) {
    const float z = 0.7978845608028654f * (x + 0.044715f * x * x * x);
    const float e = __expf(2.f * z);
    const float th = 1.f - 2.f / (1.f + e);
    return 0.5f * x * (1.f + th);
}
__device__ __forceinline__ float sigmoidf_(float x) { return 1.f / (1.f + __expf(-x)); }

struct SsmPar { float ar, ai, kr, ki; };
__device__ __forceinline__ SsmPar ssm_par(const float* lam_re, const float* lam_im, const float* log_dt, int d, int g, int n) {
    const float lr = fminf(lam_re[(d * 32 + g) * 64 + n], -1e-4f), li = lam_im[(d * 32 + g) * 64 + n];
    const float dt = expf(log_dt[d * 32 + g]);
    const float x = lr * dt, th = li * dt;
    const float em1 = expm1f(x), cs = cosf(th), sn = sinf(th), sh = sinf(0.5f * th);
    const float mag = em1 + 1.f;
    SsmPar p; p.ar = mag * cs; p.ai = mag * sn;
    const float arm1 = em1 * cs - 2.f * sh * sh;
    const float den = lr * lr + li * li;
    p.kr = (arm1 * lr + p.ai * li) / den; p.ki = (p.ai * lr - arm1 * li) / den;
    return p;
}

__global__ void __launch_bounds__(64) ssm_naive(const float* __restrict__ proj, int ldp, const float* __restrict__ lam_re, const float* __restrict__ lam_im, const float* __restrict__ log_dt,
                                                const float* __restrict__ b_re, const float* __restrict__ b_im, const float* __restrict__ c_re, const float* __restrict__ c_im,
                                                const float* __restrict__ d_skip, float* __restrict__ spre) {
    const int g = blockIdx.x, b = blockIdx.y, n = threadIdx.x;
    for (int d = 0; d < 2; ++d) {
        const SsmPar P = ssm_par(lam_re, lam_im, log_dt, d, g, n);
        float Br[16], Bi[16], Cr[16], Ci[16];
#pragma unroll
        for (int q = 0; q < 16; ++q) { const float br = b_re[((d * 32 + g) * 64 + n) * 16 + q], bi = b_im[((d * 32 + g) * 64 + n) * 16 + q];
            Br[q] = P.kr * br - P.ki * bi; Bi[q] = P.kr * bi + P.ki * br;
            Cr[q] = c_re[((d * 32 + g) * 16 + q) * 64 + n]; Ci[q] = c_im[((d * 32 + g) * 16 + q) * 64 + n]; }
        float hr = 0.f, hi = 0.f;
        for (int step = 0; step < SEQ; ++step) {
            const int t = d ? (SEQ - 1 - step) : step;
            const float* up = proj + (size_t)(b * SEQ + t) * ldp + g * 16;
            float u[16];
#pragma unroll
            for (int q = 0; q < 16; ++q) u[q] = up[q];
            float bur = 0.f, bui = 0.f;
#pragma unroll
            for (int q = 0; q < 16; ++q) { bur = fmaf(Br[q], u[q], bur); bui = fmaf(Bi[q], u[q], bui); }
            const float nr = P.ar * hr - P.ai * hi + bur, ni = P.ar * hi + P.ai * hr + bui;
            hr = nr; hi = ni;
            float y[16];
#pragma unroll
            for (int p = 0; p < 16; ++p) y[p] = Cr[p] * hr - Ci[p] * hi;
#pragma unroll
            for (int o = 1; o < 64; o <<= 1)
#pragma unroll
                for (int p = 0; p < 16; ++p) y[p] += __shfl_xor(y[p], o);
            if (n < 16) {
                float v = 0.f;
#pragma unroll
                for (int p = 0; p < 16; ++p) if (p == n) v = y[p];
                float* o = spre + (size_t)(b * SEQ + t) * 512 + g * 16 + n;
                if (d == 0) *o = v;
                else { float uu = 0.f;
#pragma unroll
                    for (int p = 0; p < 16; ++p) if (p == n) uu = u[p];
                    *o = gelu_tanh(*o + v + uu * d_skip[g * 16 + n]); }
            }
        }
    }
}
__global__ void glu_ew(const float* __restrict__ spre, const float* __restrict__ gl, const float* __restrict__ bglu, float* __restrict__ mix, int ntok) {
    const size_t i = (size_t)blockIdx.x * 256 + threadIdx.x; if (i >= (size_t)ntok * 512) return;
    const int c = (int)(i & 511); const size_t r = i >> 9;
    mix[r * 1024 + c] = spre[i] * sigmoidf_(gl[i] + bglu[c]);
}
__global__ void rmsnorm_rows(const float* __restrict__ in, int ld, int off, int n, const float* __restrict__ g, float* __restrict__ out, int ntok) {
    const int r = blockIdx.x * 256 + threadIdx.x; if (r >= ntok) return;
    const float* p = in + (size_t)r * ld + off; float s = 0.f;
    for (int j = 0; j < n; ++j) s = fmaf(p[j], p[j], s);
    const float rs = rsqrtf(s / n + RMS_EPS);
    for (int j = 0; j < n; ++j) out[(size_t)r * n + j] = p[j] * rs * g[j];
}
__device__ __forceinline__ void rope_cs(int pos, int i, float& c, float& s) {
    const float inv = expf(-9.210340371976184f * (float)i * (1.f / 16.f));
    const float a = (float)pos * inv; c = cosf(a); s = sinf(a);
}
__global__ void rope_ew(float* __restrict__ q, const float* __restrict__ proj, int ldp, float* __restrict__ krope, int ntok) {
    const int idx = blockIdx.x * 256 + threadIdx.x; if (idx >= ntok * 9 * 16) return;
    const int i = idx & 15, hh = (idx >> 4) % 9, r = idx / 144, pos = r % SEQ;
    float c, s; rope_cs(pos, i, c, s);
    if (hh < 8) { float* p = q + (size_t)r * 768 + hh * 96 + 64; const float t1 = p[i], t2 = p[i + 16]; p[i] = t1 * c - t2 * s; p[i + 16] = t1 * s + t2 * c; }
    else { const float* p = proj + (size_t)r * ldp + 896; const float t1 = p[i], t2 = p[i + 16]; krope[(size_t)r * 32 + i] = t1 * c - t2 * s; krope[(size_t)r * 32 + i + 16] = t1 * s + t2 * c; }
}
__global__ void __launch_bounds__(64) attn_naive(const float* __restrict__ q, const float* __restrict__ kv, const float* __restrict__ krope, float* __restrict__ mix) {
    const int qi = blockIdx.x * 64 + threadIdx.x, h = blockIdx.y, b = blockIdx.z;
    const size_t r = (size_t)b * SEQ + qi;
    float qv[96], o[64];
#pragma unroll
    for (int d = 0; d < 96; ++d) qv[d] = q[r * 768 + h * 96 + d] * ATT_SCALE;
#pragma unroll
    for (int d = 0; d < 64; ++d) o[d] = 0.f;
    float m = -1e30f, l = 0.f;
    for (int s = 0; s < SEQ; ++s) {
        const size_t kr = (size_t)b * SEQ + s;
        const float4* kn = (const float4*)(kv + kr * 1024 + h * 128);
        const float4* kp = (const float4*)(krope + kr * 32);
        float sc = 0.f;
#pragma unroll
        for (int d = 0; d < 16; ++d) { const float4 k4 = kn[d]; sc = fmaf(qv[4 * d], k4.x, sc); sc = fmaf(qv[4 * d + 1], k4.y, sc); sc = fmaf(qv[4 * d + 2], k4.z, sc); sc = fmaf(qv[4 * d + 3], k4.w, sc); }
#pragma unroll
        for (int d = 0; d < 8; ++d) { const float4 k4 = kp[d]; sc = fmaf(qv[64 + 4 * d], k4.x, sc); sc = fmaf(qv[64 + 4 * d + 1], k4.y, sc); sc = fmaf(qv[64 + 4 * d + 2], k4.z, sc); sc = fmaf(qv[64 + 4 * d + 3], k4.w, sc); }
        const float mn = fmaxf(m, sc), al = __expf(m - mn), p = __expf(sc - mn);
        l = l * al + p; m = mn;
        const float4* vp = (const float4*)(kv + kr * 1024 + h * 128 + 64);
#pragma unroll
        for (int d = 0; d < 16; ++d) { const float4 v4 = vp[d]; o[4 * d] = fmaf(o[4 * d], al, p * v4.x); o[4 * d + 1] = fmaf(o[4 * d + 1], al, p * v4.y); o[4 * d + 2] = fmaf(o[4 * d + 2], al, p * v4.z); o[4 * d + 3] = fmaf(o[4 * d + 3], al, p * v4.w); }
    }
    const float il = 1.f / l;
#pragma unroll
    for (int d = 0; d < 64; ++d) mix[r * 1024 + 512 + h * 64 + d] = o[d] * il;
}
__device__ __forceinline__ float wsum(float v) {
#pragma unroll
    for (int o = 1; o < 64; o <<= 1) v += __shfl_xor(v, o);
    return v;
}
__global__ void __launch_bounds__(256) ln1_rows(const float* __restrict__ x, const float* __restrict__ mixo, const float* __restrict__ g, const float* __restrict__ bb, float* __restrict__ x1, int ntok) {
    const int r = blockIdx.x * 4 + (threadIdx.x >> 6), lane = threadIdx.x & 63; if (r >= ntok) return;
    float v[16]; float s = 0.f;
#pragma unroll
    for (int j = 0; j < 16; ++j) { const int c = lane + 64 * j; v[j] = ALPHA * x[(size_t)r * 1024 + c] + mixo[(size_t)r * 1024 + c]; s += v[j]; }
    const float mean = wsum(s) * (1.f / 1024.f); float q = 0.f;
#pragma unroll
    for (int j = 0; j < 16; ++j) { v[j] -= mean; q = fmaf(v[j], v[j], q); }
    const float rstd = rsqrtf(wsum(q) * (1.f / 1024.f) + LN_EPS);
#pragma unroll
    for (int j = 0; j < 16; ++j) { const int c = lane + 64 * j; x1[(size_t)r * 1024 + c] = v[j] * rstd * g[c] + bb[c]; }
}
}

__device__ __forceinline__ void route_token(const float (&lg)[64], const float* __restrict__ rbias, int (&idx)[6], float (&w)[6]) {
    float sc[64], ch[64];
#pragma unroll
    for (int j = 0; j < 64; ++j) { sc[j] = 1.f / (1.f + __expf(-lg[j])); ch[j] = sc[j] + rbias[j]; }
    float gs[8];
#pragma unroll
    for (int g = 0; g < 8; ++g) { float m1 = -INFINITY, m2 = -INFINITY;
#pragma unroll
        for (int j = 0; j < 8; ++j) { const float v = ch[g * 8 + j]; if (v > m1) { m2 = m1; m1 = v; } else if (v > m2) m2 = v; }
        gs[g] = m1 + m2; }
    bool sel[8];
#pragma unroll
    for (int g = 0; g < 8; ++g) { int rank = 0;
#pragma unroll
        for (int o = 0; o < 8; ++o) { if (o != g && (gs[o] > gs[g] || (gs[o] == gs[g] && o < g))) ++rank; }
        sel[g] = rank < 4; }
#pragma unroll
    for (int j = 0; j < 64; ++j) if (!sel[j >> 3]) ch[j] = -INFINITY;
    float wsum_ = 0.f;
#pragma unroll
    for (int k = 0; k < 6; ++k) { float best = -INFINITY; int bi = 0;
#pragma unroll
        for (int j = 0; j < 64; ++j) if (ch[j] > best) { best = ch[j]; bi = j; }
        float sv = 0.f;
#pragma unroll
        for (int j = 0; j < 64; ++j) if (j == bi) { sv = sc[j]; ch[j] = -INFINITY; }
        idx[k] = bi; w[k] = sv; wsum_ += sv; }
    const float inv = 2.5f / (wsum_ + 1e-20f);
#pragma unroll
    for (int k = 0; k < 6; ++k) w[k] *= inv;
}

namespace gold {
__global__ void __launch_bounds__(64) route_rows(const float* __restrict__ logits, const float* __restrict__ rbias, int* __restrict__ topi, float* __restrict__ topw, int ntok) {
    const int r = blockIdx.x * 64 + threadIdx.x; if (r >= ntok) return;
    float lg[64];
#pragma unroll
    for (int j = 0; j < 16; ++j) { const float4 v = ((const float4*)(logits + (size_t)r * 64))[j]; lg[4 * j] = v.x; lg[4 * j + 1] = v.y; lg[4 * j + 2] = v.z; lg[4 * j + 3] = v.w; }
    int idx[6]; float w[6]; route_token(lg, rbias, idx, w);
#pragma unroll
    for (int k = 0; k < 6; ++k) { topi[(size_t)r * 6 + k] = idx[k]; topw[(size_t)r * 6 + k] = w[k]; }
}
__global__ void __launch_bounds__(256) moe_naive(const float* x1, const int* __restrict__ topi, const float* __restrict__ topw,
                                                  const float* __restrict__ weg, const float* __restrict__ weu, const float* __restrict__ wed,
                                                  const float* __restrict__ wsg, const float* __restrict__ wsu, const float* __restrict__ wsd,
                                                  const float* __restrict__ g2, const float* __restrict__ b2, float* out) {
    __shared__ float xs[1024]; __shared__ float hs[256]; __shared__ float red[8];
    const int r = blockIdx.x, tid = threadIdx.x;
#pragma unroll
    for (int j = 0; j < 4; ++j) xs[tid + 256 * j] = x1[(size_t)r * 1024 + tid + 256 * j];
    __syncthreads();
    float acc[4] = {0.f, 0.f, 0.f, 0.f};
    for (int ei = 0; ei < 7; ++ei) {
        const int e = ei < 6 ? topi[(size_t)r * 6 + ei] : 0; const float w = ei < 6 ? topw[(size_t)r * 6 + ei] : 1.f;
        const float* Wg = ei < 6 ? weg + (size_t)e * 1024 * 256 : wsg; const float* Wu = ei < 6 ? weu + (size_t)e * 1024 * 256 : wsu; const float* Wd = ei < 6 ? wed + (size_t)e * 256 * 1024 : wsd;
        float gg = 0.f, uu = 0.f;
        for (int k = 0; k < 1024; ++k) { const float xv = xs[k]; gg = fmaf(xv, Wg[(size_t)k * 256 + tid], gg); uu = fmaf(xv, Wu[(size_t)k * 256 + tid], uu); }
        hs[tid] = gg / (1.f + __expf(-gg)) * uu;
        __syncthreads();
        float y[4] = {0.f, 0.f, 0.f, 0.f};
        for (int i = 0; i < 256; ++i) { const float hv = hs[i];
#pragma unroll
            for (int j = 0; j < 4; ++j) y[j] = fmaf(hv, Wd[(size_t)i * 1024 + tid + 256 * j], y[j]); }
#pragma unroll
        for (int j = 0; j < 4; ++j) acc[j] = fmaf(w, y[j], acc[j]);
        __syncthreads();
    }
    float v[4]; float s = 0.f;
#pragma unroll
    for (int j = 0; j < 4; ++j) { v[j] = ALPHA * xs[tid + 256 * j] + acc[j]; s += v[j]; }
    s = wsum(s); if ((tid & 63) == 0) red[tid >> 6] = s; __syncthreads();
    const float mean = (red[0] + red[1] + red[2] + red[3]) * (1.f / 1024.f); float q = 0.f;
#pragma unroll
    for (int j = 0; j < 4; ++j) { v[j] -= mean; q = fmaf(v[j], v[j], q); }
    q = wsum(q); if ((tid & 63) == 0) red[4 + (tid >> 6)] = q; __syncthreads();
    const float rstd = rsqrtf((red[4] + red[5] + red[6] + red[7]) * (1.f / 1024.f) + LN_EPS);
#pragma unroll
    for (int j = 0; j < 4; ++j) { const int c = tid + 256 * j; out[(size_t)r * 1024 + c] = v[j] * rstd * g2[c] + b2[c]; }
}

struct In {
    const float *x, *w_in, *lam_re, *lam_im, *log_dt, *b_re, *b_im, *c_re, *c_im, *d_skip, *w_glu, *b_glu, *q_norm_g, *w_uq, *kv_norm_g, *w_ukv, *w_o, *ln1_g, *ln1_b,
                *w_router, *router_bias, *we_gate, *we_up, *we_down, *ws_gate, *ws_up, *ws_down, *ln2_g, *ln2_b;
};
constexpr size_t GOLD_FLOATS_PER_TOK = 6400;
struct Bufs { float *proj, *spre, *gl, *mix, *cqn, *ckvn, *q, *kv, *krope, *mixo, *logits; int* topi; float* topw; };
static Bufs run(const In& I, int tok0, int ntok, float* scratch, float* x1out, float* out, hipStream_t st) {
    Bufs B;
    B.proj = scratch; B.spre = B.proj + (size_t)ntok * 928; B.gl = B.spre + (size_t)ntok * 512; B.mix = B.gl + (size_t)ntok * 512;
    B.cqn = B.mix + (size_t)ntok * 1024; B.ckvn = B.cqn + (size_t)ntok * 256; B.q = B.ckvn + (size_t)ntok * 128; B.kv = B.q + (size_t)ntok * 768;
    B.krope = B.kv + (size_t)ntok * 1024; B.mixo = B.krope + (size_t)ntok * 32; B.logits = B.mixo + (size_t)ntok * 1024;
    B.topi = (int*)(B.logits + (size_t)ntok * 64); B.topw = (float*)(B.topi + (size_t)ntok * 6);
    float *proj = B.proj, *spre = B.spre, *gl = B.gl, *mix = B.mix, *cqn = B.cqn, *ckvn = B.ckvn, *q = B.q, *kv = B.kv, *krope = B.krope, *mixo = B.mixo, *logits = B.logits; int* topi = B.topi; float* topw = B.topw;
    const float* x = I.x + (size_t)tok0 * 1024; const int nb = ntok / SEQ;
    hipLaunchKernelGGL(sgemm, dim3((928 + 63) / 64, ntok / 64), dim3(256), 0, st, x, 1024, I.w_in, 928, proj, 928, ntok, 928, 1024);
    hipLaunchKernelGGL(ssm_naive, dim3(32, nb), dim3(64), 0, st, proj, 928, I.lam_re, I.lam_im, I.log_dt, I.b_re, I.b_im, I.c_re, I.c_im, I.d_skip, spre);
    hipLaunchKernelGGL(sgemm, dim3(8, ntok / 64), dim3(256), 0, st, spre, 512, I.w_glu, 512, gl, 512, ntok, 512, 512);
    hipLaunchKernelGGL(glu_ew, dim3((unsigned)(((size_t)ntok * 512 + 255) / 256)), dim3(256), 0, st, spre, gl, I.b_glu, mix, ntok);
    hipLaunchKernelGGL(rmsnorm_rows, dim3((ntok + 255) / 256), dim3(256), 0, st, proj, 928, 512, 256, I.q_norm_g, cqn, ntok);
    hipLaunchKernelGGL(rmsnorm_rows, dim3((ntok + 255) / 256), dim3(256), 0, st, proj, 928, 768, 128, I.kv_norm_g, ckvn, ntok);
    hipLaunchKernelGGL(sgemm, dim3(12, ntok / 64), dim3(256), 0, st, cqn, 256, I.w_uq, 768, q, 768, ntok, 768, 256);
    hipLaunchKernelGGL(sgemm, dim3(16, ntok / 64), dim3(256), 0, st, ckvn, 128, I.w_ukv, 1024, kv, 1024, ntok, 1024, 128);
    hipLaunchKernelGGL(rope_ew, dim3((ntok * 144 + 255) / 256), dim3(256), 0, st, q, proj, 928, krope, ntok);
    hipLaunchKernelGGL(attn_naive, dim3(SEQ / 64, 8, nb), dim3(64), 0, st, q, kv, krope, mix);
    hipLaunchKernelGGL(sgemm, dim3(16, ntok / 64), dim3(256), 0, st, mix, 1024, I.w_o, 1024, mixo, 1024, ntok, 1024, 1024);
    hipLaunchKernelGGL(ln1_rows, dim3(ntok / 4), dim3(256), 0, st, x, mixo, I.ln1_g, I.ln1_b, x1out, ntok);
    hipLaunchKernelGGL(sgemm, dim3(1, ntok / 64), dim3(256), 0, st, x1out, 1024, I.w_router, 64, logits, 64, ntok, 64, 1024);
    hipLaunchKernelGGL(route_rows, dim3(ntok / 64), dim3(64), 0, st, logits, I.router_bias, topi, topw, ntok);
    hipLaunchKernelGGL(moe_naive, dim3(ntok), dim3(256), 0, st, x1out, topi, topw, I.we_gate, I.we_up, I.we_down, I.ws_gate, I.ws_up, I.ws_down, I.ln2_g, I.ln2_b, out);
    return B;
}
}
#define GAS __attribute__((address_space(1)))
#define LAS __attribute__((address_space(3)))
typedef unsigned short bf16_t;
typedef short bf16x8 __attribute__((ext_vector_type(8)));
typedef short s16x4 __attribute__((ext_vector_type(4)));
typedef float f32x4 __attribute__((ext_vector_type(4)));
typedef float f32x2 __attribute__((ext_vector_type(2)));
typedef float f32x16 __attribute__((ext_vector_type(16)));
typedef unsigned u32x4 __attribute__((ext_vector_type(4)));
typedef unsigned u32x2 __attribute__((ext_vector_type(2)));

namespace fx {
constexpr int T = 65536, SEQ = 2048, DM = 1024, NB = 32;
constexpr int CHK = 32;
constexpr int NCHK = SEQ / CHK;
constexpr int UHR = NB * NCHK;
constexpr int UHK = CHK * 16 + 256;
constexpr int Y8_LD = 1024;
constexpr int SPRE_LD = 512;
constexpr int NCH = 2;
constexpr int CAPC = T / NCH;
constexpr int NVE = NCH * 65;
constexpr float ALPHA = 1.189207115002721f, LN_EPS = 1e-5f, RMS_EPS = 1e-6f;
constexpr float QSCALE = 0.10206207261596577f * 1.4426950408889634f;

constexpr size_t MiB = 1u << 20;
constexpr size_t WS_CTL = 0, CTL_BYTES = 1 * MiB;
constexpr size_t WS_ROPE = 1 * MiB;
constexpr size_t WS_KT = 2 * MiB;
constexpr size_t WS_WIN = 4 * MiB, WS_WGLU = 6 * MiB, WS_WUQ = 6 * MiB + 512 * 1024, WS_WUKV = 7 * MiB, WS_WO = 8 * MiB;
constexpr size_t WS_WST = 10 * MiB, WS_MO = 18 * MiB, WS_WGU = 42 * MiB  , WS_WR = 107 * MiB  , WS_WD = 107 * MiB + 512 * 1024;
constexpr size_t WS_SSQQ = 140 * MiB, WS_SSQKV = 141 * MiB, WS_TSLOT = 142 * MiB, WS_TOPW = 144 * MiB, WS_ROWTOK = 146 * MiB, WS_LOGIT = 162 * MiB;
constexpr size_t WS_XB = 178 * MiB, WS_UH = 306 * MiB, WS_CQ = 402 * MiB, WS_CKVR = 434 * MiB, WS_S = 466 * MiB, WS_Q = 530 * MiB, WS_KV = 626 * MiB, WS_SPRE = 754 * MiB, WS_MIX = 818 * MiB;
constexpr size_t WS_X1B = 178 * MiB, WS_H = 306 * MiB, WS_Y = 562 * MiB  , WS_YS = 800 * MiB  , WS_HS = 864 * MiB  ;
constexpr size_t WS_GOLD = 946 * MiB, WS_END = 1024 * MiB;
constexpr int CW_TMO = 0, CW_CODE = 1, CW_BAR = 4096, CW_CNT = 16384  , CW_DBG = 65536  ;

constexpr int RING_BYTES = 131072, TAB_OFF = RING_BYTES, IDX_OFF = TAB_OFF + 10752  , IDX_UNITS = 16, MISC_OFF = IDX_OFF + IDX_UNITS * 1024, LDS_BYTES = MISC_OFF + 256;

__device__ __forceinline__ unsigned cvt_pk_bf16(float lo, float hi) { unsigned r; asm volatile("v_cvt_pk_bf16_f32 %0, %1, %2" : "=v"(r) : "v"(lo), "v"(hi)); return r; }
__device__ __forceinline__ float bf_lo(unsigned w) { return __uint_as_float(w << 16); }
__device__ __forceinline__ float bf_hi(unsigned w) { return __uint_as_float(w & 0xffff0000u); }
__device__ __forceinline__ u32x4 pack8(const f32x4 a, const f32x4 b) { u32x4 w; w.x = cvt_pk_bf16(a[0], a[1]); w.y = cvt_pk_bf16(a[2], a[3]); w.z = cvt_pk_bf16(b[0], b[1]); w.w = cvt_pk_bf16(b[2], b[3]); return w; }
__device__ __forceinline__ void unpack8(const u32x4 w, f32x4& a, f32x4& b) { a = (f32x4){bf_lo(w.x), bf_hi(w.x), bf_lo(w.y), bf_hi(w.y)}; b = (f32x4){bf_lo(w.z), bf_hi(w.z), bf_lo(w.w), bf_hi(w.w)}; }
__device__ __forceinline__ float fast_sigmoid(float x) { return __builtin_amdgcn_rcpf(1.f + __builtin_amdgcn_exp2f(-1.4426950408889634f * x)); }
__device__ __forceinline__ float gelu_tanh_f(float x) {
    const float z2 = 1.5957691216057308f * (x + 0.044715f * x * x * x);
    return x * fast_sigmoid(z2);
}
#ifndef SC1_STORES
#define SC1_STORES 0
#endif
__device__ __forceinline__ void store16(void* p, const u32x4 v) {
#if SC1_STORES
    asm volatile("global_store_dwordx4 %0, %1, off sc1\n\ts_nop 1" :: "v"(p), "v"(v) : "memory");
#else
    *(u32x4*)p = v;
#endif
}
__device__ __forceinline__ u32x4 ror8_x4(const u32x4 v) { u32x4 r;
    r.x = (unsigned)__builtin_amdgcn_update_dpp(0, (int)v.x, 0x128, 0xF, 0xF, false); r.y = (unsigned)__builtin_amdgcn_update_dpp(0, (int)v.y, 0x128, 0xF, 0xF, false);
    r.z = (unsigned)__builtin_amdgcn_update_dpp(0, (int)v.z, 0x128, 0xF, 0xF, false); r.w = (unsigned)__builtin_amdgcn_update_dpp(0, (int)v.w, 0x128, 0xF, 0xF, false); return r; }
__device__ __forceinline__ void store_lines16(bf16_t* rowp, size_t ld, const u32x4 X, const u32x4 Y, int fr, int fq) {
    const bool lo = fr < 8; const u32x4 S = lo ? Y : X, R = ror8_x4(S);
    const u32x4 A1 = lo ? X : R, A2 = lo ? R : Y;
    bf16_t* p = rowp + (size_t)(fr & 7) * ld + (lo ? 8 * fq : 32 + 8 * fq);
    *(u32x4*)p = A1; *(u32x4*)(p + 8 * ld) = A2;
}
__device__ __forceinline__ float wave_sum(float v) {
#pragma unroll
    for (int o = 1; o < 64; o <<= 1) v += __shfl_xor(v, o);
    return v;
}

#define XB_TMO      128
#define XB_XCNT(j)  (256  + 64 * (j))
#define XB_XSUB(j)  (1280 + 64 * (j))
#define XB_XGEN(j)  (2304 + 64 * (j))
#define XB_TOP      3328
#define XB_TOPGEN   3392
#define XCD_BAR_WORDS 3456
#define XB_SPIN_CAP (1u << 18)
__device__ __forceinline__ unsigned xb_ld(unsigned* p)              { return __hip_atomic_load(p, __ATOMIC_RELAXED, __HIP_MEMORY_SCOPE_AGENT); }
__device__ __forceinline__ unsigned xb_add(unsigned* p, unsigned v) { return __hip_atomic_fetch_add(p, v, __ATOMIC_RELAXED, __HIP_MEMORY_SCOPE_AGENT); }
__device__ __forceinline__ unsigned xb_xcc_id() { return (unsigned)__builtin_amdgcn_s_getreg((3 << 11) | 20) & 0xFu; }
#define XB_SPIN(cond, bar) do { unsigned _sp = 0; while (cond) { __builtin_amdgcn_s_sleep(1); \
    if ((++_sp & 255u) == 0u) { if (xb_ld(&(bar)[XB_TMO])) break; if (_sp > XB_SPIN_CAP) { atomicAdd(&(bar)[XB_TMO], 1u); break; } } } } while (0)
struct XcdBarrier { unsigned* bar; unsigned x; volatile LAS unsigned* st; };
__device__ __forceinline__ XcdBarrier xcd_barrier_post(unsigned* bar, volatile LAS unsigned* st) {
    XcdBarrier b; b.bar = bar; b.x = xb_xcc_id(); b.st = st;
    if (threadIdx.x == 0) (void)xb_add(&bar[XB_XCNT(b.x)], 1u);
    return b;
}
__device__ __forceinline__ void xcd_barrier_complete(unsigned* bar, unsigned x, unsigned& nloc, unsigned& nx) {
    const unsigned G = gridDim.x * gridDim.y * gridDim.z;
    unsigned sum, cnt, mine, sp = 0u;
    for (;;) {
        sum = 0u; cnt = 0u; mine = 0u;
#pragma unroll
        for (unsigned j = 0; j < 16; ++j) { const unsigned c = xb_ld(&bar[XB_XCNT(j)]); sum += c; cnt += (c > 0u) ? 1u : 0u; mine = (j == x) ? c : mine; }
        if (sum == G) break;
        __builtin_amdgcn_s_sleep(1);
        if ((++sp & 255u) == 0u) { if (xb_ld(&bar[XB_TMO])) break; if (sp > XB_SPIN_CAP) { atomicAdd(&bar[XB_TMO], 1u); break; } }
    }
    nloc = mine > 0u ? mine : 1u; nx = cnt > 0u ? cnt : 1u;
}
__device__ __forceinline__ void xcd_barrier(const XcdBarrier& b) {
    asm volatile("s_waitcnt vmcnt(0)" ::: "memory");
    __syncthreads();
    if (threadIdx.x == 0) {
        unsigned* bar = b.bar;
        __builtin_amdgcn_s_waitcnt(0);
        unsigned nloc = b.st[0], nx = b.st[1];
        if (nloc == 0u) { xcd_barrier_complete(bar, b.x, nloc, nx); b.st[0] = nloc; b.st[1] = nx; }
        const unsigned old = xb_add(&bar[XB_XSUB(b.x)], 1u);
        const unsigned gen = old / nloc;
        if (old + 1u == (gen + 1u) * nloc) {
            __builtin_amdgcn_fence(__ATOMIC_RELEASE, "agent");
            asm volatile("s_waitcnt vmcnt(0)" ::: "memory");
            const unsigned og = xb_add(&bar[XB_TOP], 1u);
            const unsigned tg = og / nx;
            if (og + 1u == (tg + 1u) * nx) xb_add(&bar[XB_TOPGEN], 1u);
            else XB_SPIN(xb_ld(&bar[XB_TOPGEN]) == tg, bar);
            __builtin_amdgcn_fence(__ATOMIC_ACQUIRE, "agent");
            xb_add(&bar[XB_XGEN(b.x)], 1u);
            asm volatile("s_waitcnt vmcnt(0)" ::: "memory");
        } else {
            XB_SPIN(xb_ld(&bar[XB_XGEN(b.x)]) == gen, bar);
            __builtin_amdgcn_fence(__ATOMIC_ACQUIRE, "agent");
            asm volatile("s_waitcnt vmcnt(0)" ::: "memory");
        }
    }
    __syncthreads();
}

constexpr int BM = 256, BK = 64, HALF = 128, HTB = HALF * BK * 2, STAGE_BYTES = 8 * HTB;
__host__ __device__ __forceinline__ int lds_byte(int r, int c) { const int st = (r >> 4) * 2 + (c >> 5), rr = r & 15, cc = c & 31, ob = rr * 64 + cc * 2; return st * 1024 + (ob ^ (((ob >> 9) & 1) << 5)); }
__host__ __device__ __forceinline__ void stage_rc(int b, int& R, int& C) { const int st = b / 1024, sb = b % 1024, swz = sb ^ (((sb >> 9) & 1) << 5); R = (st >> 1) * 16 + swz / 64; C = (st & 1) * 32 + (swz % 64) / 2; }
__host__ __device__ __forceinline__ int perm32(int rho) { const int n = rho >> 4, i = rho & 15; return 8 * (i >> 2) + 4 * n + (i & 3); }
__host__ __device__ __forceinline__ int perm16x(int rho) { const int n = rho >> 4, i = rho & 15; return 16 * (i >> 2) + 4 * n + (i & 3); }

struct Unit { const char* A; const char* B; int i0, i1, i2, i3; };
__device__ __forceinline__ int xcd_remap(int L, int nwg) { const int q = nwg / 8, r = nwg % 8, xcd = L % 8, off = L / 8; return (xcd < r ? xcd * (q + 1) : r * (q + 1) + (xcd - r) * q) + off; }

template <class Epi, class Sched, bool ALIGN_EPI, bool GATHER, int STAG = 0, int AMODE = 0>
__device__ __forceinline__ void gemm_phase(LAS unsigned char* lds, const int lda, const int ldb, const int K, const Sched& S, const Epi& E) {
    if constexpr (STAG > 0) { const unsigned long long t0_ = __builtin_amdgcn_s_memrealtime(), dl_ = (unsigned long long)STAG * ((blockIdx.x >> 3) & 3u); while (__builtin_amdgcn_s_memrealtime() - t0_ < dl_) __builtin_amdgcn_s_sleep(4); }
    const int tid = threadIdx.x, wid = __builtin_amdgcn_readfirstlane(tid >> 6), lane = tid & 63, wr = wid >> 2, wc = wid & 3, fr = lane & 15, fq = lane >> 4;
    const int nt = K / BK;
    unsigned voffA[2], voffB[2]; int RA[2], CA[2];
#pragma unroll
    for (int i = 0; i < 2; ++i) { int R, C; stage_rc(tid * 16 + i * 8192, R, C); const int Rb = 64 * (R >> 5) + (Epi::PERM == 2 ? perm16x(R & 31) : Epi::PERM ? perm32(R & 31) : (R & 31));
        RA[i] = R; CA[i] = C; voffA[i] = AMODE == 1 ? (unsigned)((R >> 4) * 8192 + (R & 7) * 1024 + (C >> 5) * 128 + ((R >> 3) & 1) * 64 + (C & 31) * 2) : (unsigned)(R * lda + C) * 2u; voffB[i] = (unsigned)(Rb * ldb + C) * 2u; }
    const size_t kstep = (size_t)(BK * 2), kstepA = AMODE == 1 ? 256 : kstep;
    const size_t hstepA = (size_t)HALF * lda * 2, hstepB = (size_t)(Epi::PERM == 2 ? 8 : 32) * ldb * 2;
    const unsigned ldsw = (unsigned)wid * 1024u;
    const int aoff = lds_byte(wr * 64 + fr, fq * 8), boff = lds_byte(wc * 32 + fr, fq * 8);
#define PG8_SA(b, h) (((b) * 2 + (h)) * HTB)
#define PG8_SB(b, h) ((4 + (b) * 2 + (h)) * HTB)
#define PG8_STAGE(bufoff, gbase, voff) do { _Pragma("unroll") for (int _i = 0; _i < 2; ++_i) \
        __builtin_amdgcn_global_load_lds((const unsigned*)((const char*)(gbase) + (voff)[_i]), (LAS unsigned*)(lds + (bufoff) + ldsw + _i * 8192), 16, 0, 0); } while (0)
#define PG8_STAGE_A(bufoff, base, g0, g1, h, kb) do { if constexpr (GATHER) { \
        __builtin_amdgcn_global_load_lds((const unsigned*)((base) + (kb) + (g0)), (LAS unsigned*)(lds + (bufoff) + ldsw), 16, 0, 0); \
        __builtin_amdgcn_global_load_lds((const unsigned*)((base) + (kb) + (g1)), (LAS unsigned*)(lds + (bufoff) + ldsw + 8192), 16, 0, 0); } \
      else { PG8_STAGE(bufoff, (base) + (h) * hstepA + (kb), voffA); } } while (0)
#define PG8_LDA(dst, b, h) do { _Pragma("unroll") for (int m = 0; m < 4; ++m) _Pragma("unroll") for (int k = 0; k < 2; ++k) dst[m][k] = *(const LAS bf16x8*)(lds + PG8_SA(b, h) + aoff + m * 2048 + k * 1024); } while (0)
#define PG8_LDB(dst, b, h) do { _Pragma("unroll") for (int n = 0; n < 2; ++n) _Pragma("unroll") for (int k = 0; k < 2; ++k) dst[n][k] = *(const LAS bf16x8*)(lds + PG8_SB(b, h) + boff + n * 2048 + k * 1024); } while (0)
#define PG8_MMA(ai, bj, At, Bt) do { __builtin_amdgcn_s_setprio(1); _Pragma("unroll") for (int m = 0; m < 4; ++m) _Pragma("unroll") for (int n = 0; n < 2; ++n) _Pragma("unroll") for (int k = 0; k < 2; ++k) \
        acc[ai][bj][m][n] = __builtin_amdgcn_mfma_f32_16x16x32_bf16(Bt[n][k], At[m][k], acc[ai][bj][m][n], 0, 0, 0); __builtin_amdgcn_s_setprio(0); } while (0)
#define PG8_WAIT_V(n) asm volatile("s_waitcnt vmcnt(" #n ")" ::: "memory")
#define PG8_WAIT_VN(n) asm volatile("s_waitcnt vmcnt(%0)" :: "n"(n) : "memory")
#define PG8_WAIT_L(n) asm volatile("s_waitcnt lgkmcnt(" #n ")" ::: "memory")
#define PG8_BAR __builtin_amdgcn_s_barrier()
#define PG8_SCHED __builtin_amdgcn_sched_barrier(0)
    Unit cur, nxt; int ui = 0;
    if (!S.next(0, cur)) return;
    unsigned gc00 = 0, gc01 = 0, gc10 = 0, gc11 = 0, gn00 = 0, gn01 = 0, gn10 = 0, gn11 = 0;
    if constexpr (GATHER) { S.gather(cur, RA[0], CA[0], RA[1], CA[1], gc00, gc01, gc10, gc11); gn00 = gc00; gn01 = gc01; gn10 = gc10; gn11 = gc11; }
    f32x4 acc[2][2][4][2];
#pragma unroll
    for (int a = 0; a < 2; ++a)
#pragma unroll
        for (int b = 0; b < 2; ++b)
#pragma unroll
            for (int m = 0; m < 4; ++m)
#pragma unroll
                for (int n = 0; n < 2; ++n) acc[a][b][m][n] = (f32x4){0.f, 0.f, 0.f, 0.f};
    bf16x8 At[4][2], B0[2][2], B1[2][2];
    const char* cA = cur.A; const char* cB = cur.B;
    PG8_STAGE(PG8_SB(0, 0), cB, voffB); PG8_STAGE(PG8_SB(0, 1), cB + hstepB, voffB); PG8_STAGE_A(PG8_SA(0, 0), cA, gc00, gc01, 0, 0); PG8_STAGE_A(PG8_SA(0, 1), cA, gc10, gc11, 1, 0);
    if (wr == 1) PG8_BAR;
    PG8_WAIT_V(2); PG8_BAR;
    PG8_STAGE(PG8_SB(1, 0), cB + kstep, voffB); PG8_STAGE_A(PG8_SA(1, 0), cA, gc00, gc01, 0, kstepA); PG8_STAGE(PG8_SB(1, 1), cB + hstepB + kstep, voffB);
    PG8_WAIT_V(6); PG8_BAR;
    for (;;) {
        const bool has_next = S.next(ui + 1, nxt);
        if constexpr (GATHER) { if (has_next) S.gather(nxt, RA[0], CA[0], RA[1], CA[1], gn00, gn01, gn10, gn11); }
        const char* nA = has_next ? nxt.A : cA; const char* nB = has_next ? nxt.B : cB;
#pragma unroll 1
        for (int t = 0; t < nt; t += 2) {
            const bool last = (t == nt - 2);
            const size_t k1 = (size_t)(t + 1) * kstepA;
            const char* a2 = last ? nA : cA; const char* b2 = last ? nB : cB + (size_t)(t + 2) * kstep;
            const size_t k2 = last ? 0 : (size_t)(t + 2) * kstepA, k3 = k2 + kstepA;
            const char* b3 = b2 + kstep;
            unsigned g200 = gc00, g201 = gc01, g210 = gc10, g211 = gc11;
            if constexpr (GATHER) { if (last) { g200 = gn00; g201 = gn01; g210 = gn10; g211 = gn11; } }
            PG8_LDB(B0, 0, 0); PG8_LDB(B1, 0, 1); PG8_SCHED; PG8_LDA(At, 0, 0); PG8_STAGE_A(PG8_SA(1, 1), cA, gc10, gc11, 1, k1);
            PG8_WAIT_V(8); PG8_WAIT_L(0); PG8_BAR; PG8_MMA(0, 0, At, B0); PG8_MMA(0, 1, At, B1); PG8_BAR; PG8_SCHED;
            PG8_LDA(At, 0, 1); PG8_STAGE(PG8_SB(0, 0), b2, voffB); PG8_STAGE(PG8_SB(0, 1), b2 + hstepB, voffB); PG8_STAGE_A(PG8_SA(0, 0), a2, g200, g201, 0, k2);
            PG8_WAIT_V(8); PG8_WAIT_L(0); PG8_BAR; PG8_MMA(1, 0, At, B0); PG8_MMA(1, 1, At, B1); PG8_BAR; PG8_SCHED;
            PG8_LDB(B0, 1, 0); PG8_LDB(B1, 1, 1); PG8_SCHED; PG8_LDA(At, 1, 0); PG8_STAGE_A(PG8_SA(0, 1), a2, g210, g211, 1, k2);
            PG8_WAIT_V(8); PG8_WAIT_L(0); PG8_BAR; PG8_MMA(0, 0, At, B0); PG8_MMA(0, 1, At, B1); PG8_BAR; PG8_SCHED;
            PG8_LDA(At, 1, 1); PG8_STAGE(PG8_SB(1, 0), b3, voffB); PG8_STAGE(PG8_SB(1, 1), b3 + hstepB, voffB); PG8_STAGE_A(PG8_SA(1, 0), a2, g200, g201, 0, k3);
            PG8_WAIT_V(8); PG8_WAIT_L(0); PG8_BAR; PG8_MMA(1, 0, At, B0); PG8_MMA(1, 1, At, B1); PG8_BAR; PG8_SCHED;
        }
#if defined(MK_TPROBE) && MK_TPROBE >= 200
        unsigned long long tp0_ = 0; if (blockIdx.x == 0 && wid == 0) tp0_ = __builtin_amdgcn_s_memrealtime();
#endif
        if constexpr (ALIGN_EPI) { if (wr == 0) PG8_BAR; }
        E(acc, cur, wr, wc, fr, fq);
#if defined(MK_TPROBE) && MK_TPROBE >= 200
        if (blockIdx.x == 0 && wid == 0) { asm volatile("s_waitcnt vmcnt(0)" ::: "memory"); const unsigned long long d_ = __builtin_amdgcn_s_memrealtime() - tp0_; if (lane == 0) { volatile LAS unsigned* M_ = (volatile LAS unsigned*)(lds + MISC_OFF); const unsigned long long a_ = (((unsigned long long)M_[23] << 32) | M_[22]) + d_; M_[22] = (unsigned)a_; M_[23] = (unsigned)(a_ >> 32); } }
#endif
        if (!has_next) break;
#pragma unroll
        for (int a = 0; a < 2; ++a)
#pragma unroll
            for (int b = 0; b < 2; ++b)
#pragma unroll
                for (int m = 0; m < 4; ++m)
#pragma unroll
                    for (int n = 0; n < 2; ++n) acc[a][b][m][n] = (f32x4){0.f, 0.f, 0.f, 0.f};
        cur = nxt; cA = nA; cB = nB; ++ui;
        if constexpr (GATHER) { gc00 = gn00; gc01 = gn01; gc10 = gn10; gc11 = gn11; }
        if constexpr (ALIGN_EPI) { if (wr == 1) PG8_BAR; }
    }
    PG8_WAIT_V(0);
    if constexpr (!ALIGN_EPI) { if (wr == 0) PG8_BAR; }
    PG8_BAR;
#undef PG8_SA
#undef PG8_SB
#undef PG8_STAGE
#undef PG8_STAGE_A
#undef PG8_LDA
#undef PG8_LDB
#undef PG8_MMA
#undef PG8_WAIT_V
#undef PG8_WAIT_VN
#undef PG8_WAIT_L
#undef PG8_BAR
#undef PG8_SCHED
}
}
namespace fx {
#define FX_ROWLOOP _Pragma("unroll") for (int ai = 0; ai < 2; ++ai) _Pragma("unroll") for (int m = 0; m < 4; ++m)

struct PlainOrder {
    const char* A; const char* B; int lda, ldb, nM, nN, nwg, G, c;
    __device__ __forceinline__ void init(const void* A_, int lda_, const void* B_, int ldb_, int M, int N, int G_, int c_) { A = (const char*)A_; B = (const char*)B_; lda = lda_; ldb = ldb_; nM = M / 256; nN = N / 256; nwg = nM * nN; G = G_; c = c_; }
    __device__ __forceinline__ bool next(int i, Unit& u) const {
        const long L = (long)i * G + c; if (L >= nwg) return false;
        const int wgid = xcd_remap((int)L, nwg);
        const int nig = 8 * nN, gid = wgid / nig, fm = gid * 8, gsz = (nM - fm) < 8 ? (nM - fm) : 8;
        const int pm = fm + ((wgid % nig) % gsz), pn = (wgid % nig) / gsz;
        u.A = A + (size_t)pm * 256 * lda * 2; u.B = B + (size_t)pn * 256 * ldb * 2; u.i0 = pm; u.i1 = pn; u.i2 = 0; u.i3 = 0; return true;
    }
};
struct PanelOrder {
    const char* A; const char* B; int lda, ldb, nM, nN, G, c;
    __device__ __forceinline__ void init(const void* A_, int lda_, const void* B_, int ldb_, int M, int N, int G_, int c_) { A = (const char*)A_; B = (const char*)B_; lda = lda_; ldb = ldb_; nM = M / 256; nN = N / 256; G = G_; c = c_; }
    __device__ __forceinline__ bool next(int i, Unit& u) const {
        const int j = i / nN, pn = i - j * nN, pm = c + j * G; if (pm >= nM) return false;
        u.A = A + (size_t)pm * 256 * lda * 2; u.B = B + (size_t)pn * 256 * ldb * 2; u.i0 = pm; u.i1 = pn; u.i2 = 0; u.i3 = 0; return true;
    }
};
struct GroupOrder {
    const char* A; const char* B; int ldb, nN, nwg, G, c;
    __device__ __forceinline__ void init(const void* A_, const void* B_, int ldb_, int nN_, int G_, int c_) { A = (const char*)A_; B = (const char*)B_; ldb = ldb_; nN = nN_; nwg = 32 * 8 * nN_; G = G_; c = c_; }
    __device__ __forceinline__ bool next(int i, Unit& u) const {
        const long L = (long)i * G + c; if (L >= nwg) return false;
        const int wgid = xcd_remap((int)L, nwg);
        const int per = 8 * nN, g = wgid / per, rem = wgid % per, pm = rem % 8, pn = rem / 8;
        u.A = A + ((size_t)g * UHR + (size_t)pm * 256) * UHK * 2; u.B = B + ((size_t)g * nN * 256 + (size_t)pn * 256) * ldb * 2; u.i0 = g; u.i1 = pm; u.i2 = pn; u.i3 = 0; return true;
    }
};

__device__ __forceinline__ void rope8(f32x4& v0, f32x4& v1, const float* __restrict__ ropec, const float* __restrict__ ropes, int pos, int fq) {
    const f32x4 c = *(const f32x4*)(ropec + pos * 16 + 4 * fq), s = *(const f32x4*)(ropes + pos * 16 + 4 * fq);
    const f32x4 a = v0, b = v1;
    v0 = (f32x4){a[0] * c[0] - a[1] * s[0], a[0] * s[0] + a[1] * c[0], a[2] * c[1] - a[3] * s[1], a[2] * s[1] + a[3] * c[1]};
    v1 = (f32x4){b[0] * c[2] - b[1] * s[2], b[0] * s[2] + b[1] * c[2], b[2] * c[3] - b[3] * s[3], b[2] * s[3] + b[3] * c[3]};
}
__device__ __forceinline__ float sumsq8(const f32x4 a, const f32x4 b) { return (a[0] * a[0] + a[1] * a[1]) + (a[2] * a[2] + a[3] * a[3]) + (b[0] * b[0] + b[1] * b[1]) + (b[2] * b[2] + b[3] * b[3]); }

struct EpiWin {
    static constexpr int PERM = 1; static constexpr int NST = 16;
    bf16_t* UH; bf16_t* CQ; bf16_t* CKVR; float* ssqq; float* ssqkv; const float* ropec; const float* ropes;
    __device__ __forceinline__ void operator()(const f32x4 (&acc)[2][2][4][2], const Unit& u, int wr, int wc, int fr, int fq) const {
        const int pm = u.i0, pn = u.i1, row0 = pm * 256 + wr * 64 + fr;
        if (pn < 2) {
            FX_ROWLOOP { const int row = row0 + ai * 128 + m * 16, r32 = row >> 5, tq = row & 31;
#pragma unroll
                for (int bj = 0; bj < 2; ++bj) { const int c = pn * 256 + wc * 64 + bj * 32 + 8 * fq, g = c >> 4, p0 = c & 15;
                    *(u32x4*)(UH + ((size_t)(g * UHR + r32) * UHK + tq * 16 + p0)) = pack8(acc[ai][bj][m][0], acc[ai][bj][m][1]); } }
        } else if (pn == 2) {
            FX_ROWLOOP { const int row = row0 + ai * 128 + m * 16; float ss = sumsq8(acc[ai][0][m][0], acc[ai][0][m][1]) + sumsq8(acc[ai][1][m][0], acc[ai][1][m][1]);
                store_lines16(CQ + (size_t)(row - fr) * 256 + 64 * wc, 256, pack8(acc[ai][0][m][0], acc[ai][0][m][1]), pack8(acc[ai][1][m][0], acc[ai][1][m][1]), fr, fq);
                ss += __shfl_xor(ss, 16); ss += __shfl_xor(ss, 32);
                if (fq == 0) ssqq[(size_t)row * 4 + wc] = ss; }
        } else {
            FX_ROWLOOP { const int row = row0 + ai * 128 + m * 16; float ss = 0.f; u32x4 w[2];
#pragma unroll
                for (int bj = 0; bj < 2; ++bj) { f32x4 v0 = acc[ai][bj][m][0], v1 = acc[ai][bj][m][1];
                    if (wc < 2) ss += sumsq8(v0, v1);
                    if (wc == 2 && bj == 0) rope8(v0, v1, ropec, ropes, row & (SEQ - 1), fq);
                    w[bj] = pack8(v0, v1); }
                store_lines16(CKVR + (size_t)(row - fr) * 256 + 64 * wc, 256, w[0], w[1], fr, fq);
                ss += __shfl_xor(ss, 16); ss += __shfl_xor(ss, 32);
                if (fq == 0) ssqkv[(size_t)row * 4 + wc] = ss; }
        }
    }
};
struct EpiQ {
    static constexpr int PERM = 1; static constexpr int NST = 16;
    bf16_t* Q; const float* ssqq; const float* ropec; const float* ropes;
    __device__ __forceinline__ void operator()(const f32x4 (&acc)[2][2][4][2], const Unit& u, int wr, int wc, int fr, int fq) const {
        const int pm = u.i0, pn = u.i1, row0 = pm * 256 + wr * 64;
        FX_ROWLOOP { const int row = row0 + fr + ai * 128 + m * 16; const f32x4 s4 = *(const f32x4*)(ssqq + (size_t)row * 4);
            const float rs = __builtin_amdgcn_rsqf(((s4[0] + s4[1]) + (s4[2] + s4[3])) * (1.f / 256.f) + RMS_EPS) * QSCALE;
            u32x4 w[2];
#pragma unroll
            for (int bj = 0; bj < 2; ++bj) { const int G = 8 * pn + 2 * wc + bj;
                f32x4 v0 = acc[ai][bj][m][0] * rs, v1 = acc[ai][bj][m][1] * rs;
                if (G % 3 == 2) rope8(v0, v1, ropec, ropes, row & (SEQ - 1), fq);
                w[bj] = pack8(v0, v1); }
            store_lines16(Q + (size_t)(row0 + ai * 128 + m * 16) * 768 + 256 * pn + 64 * wc, 768, w[0], w[1], fr, fq); }
    }
};
struct EpiKV {
    static constexpr int PERM = 1; static constexpr int NST = 16;
    bf16_t* KV; const float* ssqkv;
    __device__ __forceinline__ void operator()(const f32x4 (&acc)[2][2][4][2], const Unit& u, int wr, int wc, int fr, int fq) const {
        const int pm = u.i0, pn = u.i1, row0 = pm * 256 + wr * 64;
        FX_ROWLOOP { const int row = row0 + fr + ai * 128 + m * 16; const f32x4 s4 = *(const f32x4*)(ssqkv + (size_t)row * 4);
            const float rs = __builtin_amdgcn_rsqf(((s4[0] + s4[1]) + (s4[2] + s4[3])) * (1.f / 128.f) + RMS_EPS);
            store_lines16(KV + (size_t)(row0 + ai * 128 + m * 16) * 1024 + 256 * pn + 64 * wc, 1024, pack8(acc[ai][0][m][0] * rs, acc[ai][0][m][1] * rs), pack8(acc[ai][1][m][0] * rs, acc[ai][1][m][1] * rs), fr, fq); }
    }
};
struct EpiSt {
    static constexpr int PERM = 1; static constexpr int NST = 16;
    bf16_t* S;
    __device__ __forceinline__ void operator()(const f32x4 (&acc)[2][2][4][2], const Unit& u, int wr, int wc, int fr, int fq) const {
        const int g = u.i0, pm = u.i1, row0 = pm * 256 + wr * 64;
        FX_ROWLOOP store_lines16(S + ((size_t)g * UHR + row0 + ai * 128 + m * 16) * 256 + 64 * wc, 256, pack8(acc[ai][0][m][0], acc[ai][0][m][1]), pack8(acc[ai][1][m][0], acc[ai][1][m][1]), fr, fq);
    }
};
struct EpiSsmOut {
    static constexpr int PERM = 1; static constexpr int NST = 16;
    const bf16_t* UH; bf16_t* SPRE; const float* dskip;
    __device__ __forceinline__ void operator()(const f32x4 (&acc)[2][2][4][2], const Unit& u, int wr, int wc, int fr, int fq) const {
        const int g = u.i0, pm = u.i1, pn = u.i2, row0 = pm * 256 + wr * 64 + fr;
        const int p0 = 8 * (fq & 1);
        const f32x4 d0 = *(const f32x4*)(dskip + g * 16 + p0), d1 = *(const f32x4*)(dskip + g * 16 + p0 + 4);
        FX_ROWLOOP { const int R = row0 + ai * 128 + m * 16;
#pragma unroll
            for (int bj = 0; bj < 2; ++bj) { const int c = 256 * pn + 64 * wc + 32 * bj + 8 * fq, tq = c >> 4;
                const u32x4 uw = *(const u32x4*)(UH + ((size_t)g * UHR + R) * UHK + c); f32x4 u0, u1; unpack8(uw, u0, u1);
                f32x4 y0 = acc[ai][bj][m][0] + u0 * d0, y1 = acc[ai][bj][m][1] + u1 * d1;
#pragma unroll
                for (int j = 0; j < 4; ++j) { y0[j] = gelu_tanh_f(y0[j]); y1[j] = gelu_tanh_f(y1[j]); }
                *(u32x4*)(SPRE + ((size_t)R * 32 + tq) * SPRE_LD + g * 16 + p0) = pack8(y0, y1); } }
    }
};
struct EpiGlu {
    static constexpr int PERM = 1; static constexpr int NST = 16;
    const bf16_t* SPRE; bf16_t* MIX; const float* bglu;
    __device__ __forceinline__ void operator()(const f32x4 (&acc)[2][2][4][2], const Unit& u, int wr, int wc, int fr, int fq) const {
        const int pm = u.i0, pn = u.i1, row0 = pm * 256 + wr * 64;
        f32x4 b0[2], b1[2];
#pragma unroll
        for (int bj = 0; bj < 2; ++bj) { const int c = 256 * pn + 64 * wc + 32 * bj + 8 * fq; b0[bj] = *(const f32x4*)(bglu + c); b1[bj] = *(const f32x4*)(bglu + c + 4); }
        FX_ROWLOOP { const int row = row0 + fr + ai * 128 + m * 16; u32x4 w[2];
#pragma unroll
            for (int bj = 0; bj < 2; ++bj) { const int c = 256 * pn + 64 * wc + 32 * bj + 8 * fq;
                const u32x4 sw = *(const u32x4*)(SPRE + (size_t)row * SPRE_LD + c); f32x4 s0, s1; unpack8(sw, s0, s1);
                f32x4 z0 = acc[ai][bj][m][0] + b0[bj], z1 = acc[ai][bj][m][1] + b1[bj];
#pragma unroll
                for (int j = 0; j < 4; ++j) { z0[j] = s0[j] * fast_sigmoid(z0[j]); z1[j] = s1[j] * fast_sigmoid(z1[j]); }
                w[bj] = pack8(z0, z1); }
            store_lines16(MIX + (size_t)(row0 + ai * 128 + m * 16) * 1024 + 256 * pn + 64 * wc, 1024, w[0], w[1], fr, fq); }
    }
};
struct EpiWo {
    static constexpr int PERM = 1; static constexpr int NST = 16;
    const float* X; bf16_t* Y;
    __device__ __forceinline__ void operator()(const f32x4 (&acc)[2][2][4][2], const Unit& u, int wr, int wc, int fr, int fq) const {
        const int pm = u.i0, pn = u.i1, row0 = pm * 256 + wr * 64;
        FX_ROWLOOP { const size_t off = (size_t)(row0 + fr + ai * 128 + m * 16) * 1024 + 256 * pn + wc * 64 + 8 * fq; u32x4 w[2];
#pragma unroll
            for (int bj = 0; bj < 2; ++bj) { const f32x4 x0 = *(const f32x4*)(X + off + bj * 32), x1 = *(const f32x4*)(X + off + bj * 32 + 4);
                w[bj] = pack8(x0 * ALPHA + acc[ai][bj][m][0], x1 * ALPHA + acc[ai][bj][m][1]); }
            store_lines16(Y + (size_t)(row0 + ai * 128 + m * 16) * 1024 + 256 * pn + 64 * wc, 1024, w[0], w[1], fr, fq); }
    }
};
__device__ __forceinline__ size_t h_off(int row, int col) { return (size_t)(row >> 4) * 4096 + (size_t)(row & 7) * 512 + (size_t)(col >> 5) * 64 + (size_t)((row >> 3) & 1) * 32 + (size_t)(col & 31); }
struct EpiSharedRouter {
    static constexpr int PERM = 1; static constexpr int NST = 0;
    bf16_t* HS; float* LG;
    __device__ __forceinline__ void operator()(const f32x4 (&acc)[2][2][4][2], const Unit& u, int wr, int wc, int fr, int fq) const {
        const int pm = u.i0, pn = u.i1, row0 = pm * 256 + wr * 64 + fr;
        if (pn < 2) {
            const int c = 128 * pn + 32 * wc + 8 * fq;
            FX_ROWLOOP { f32x4 h0, h1;
#pragma unroll
                for (int j = 0; j < 4; ++j) { const float g0 = acc[ai][0][m][0][j], g1 = acc[ai][0][m][1][j];
                    h0[j] = g0 * fast_sigmoid(g0) * acc[ai][1][m][0][j]; h1[j] = g1 * fast_sigmoid(g1) * acc[ai][1][m][1][j]; }
                *(u32x4*)(HS + h_off(row0 + ai * 128 + m * 16, c)) = pack8(h0, h1); }
        } else if (wc == 0) {
            FX_ROWLOOP { float* rp = LG + (size_t)(row0 + ai * 128 + m * 16) * 64 + 8 * fq;
#pragma unroll
                for (int bj = 0; bj < 2; ++bj) { *(f32x4*)(rp + bj * 32) = acc[ai][bj][m][0]; *(f32x4*)(rp + bj * 32 + 4) = acc[ai][bj][m][1]; } }
        }
    }
};

struct MoeTab { LAS int* tbase; LAS unsigned* tab; };
__device__ __forceinline__ MoeTab moe_tab(LAS unsigned char* lds) { MoeTab t; t.tbase = (LAS int*)(lds + TAB_OFF); t.tab = (LAS unsigned*)(lds + TAB_OFF + 2304); return t; }
__device__ __forceinline__ int ve_count(const unsigned* ctl, int ve) { return (ve % 65 == 64) ? CAPC : (int)__hip_atomic_load(ctl + CW_CNT + 64 * ve, __ATOMIC_RELAXED, __HIP_MEMORY_SCOPE_AGENT); }
__device__ __forceinline__ void moe_build_tab(LAS unsigned char* lds, const unsigned* ctl) {
    const MoeTab t = moe_tab(lds); LAS int* nt = (LAS int*)(lds + TAB_OFF + 1024 + 64);
    const int tid = threadIdx.x;
    if (tid < NVE) nt[tid] = (ve_count(ctl, tid) + 255) >> 8;
    __syncthreads();
    if (tid == 0) { int s = 0; for (int v = 0; v < NVE; ++v) { t.tbase[v] = s; s += nt[v]; } t.tbase[NVE] = s; }
    __syncthreads();
    for (int v = tid; v < NVE; v += 512) { const int b = t.tbase[v], n = t.tbase[v + 1] - b; for (int j = 0; j < n; ++j) t.tab[b + j] = (unsigned)v | ((unsigned)j << 16); }
    __syncthreads();
}
struct GateUpOrder {
    const char* X1B; const char* WGU; MoeTab tb; LAS int* idx; int nunits, G, c;
    int tb0;
    __device__ __forceinline__ int tile_of(int tr) const { return tb0 + tr; }
    __device__ __forceinline__ void init(LAS unsigned char* lds, const void* x1b, const void* wgu, const int* rowtok, const unsigned* ctl, int chn, int G_, int c_) {
        X1B = (const char*)x1b; WGU = (const char*)wgu; tb = moe_tab(lds); idx = (LAS int*)(lds + IDX_OFF); G = G_; c = c_;
        tb0 = tb.tbase[chn * 65]; nunits = 2 * (tb.tbase[chn * 65 + 64] - tb0);
        __syncthreads();
        for (int i = 0; i < IDX_UNITS; ++i) { const long L = (long)i * G + c; if (L >= nunits) break;
            const int tile = tile_of(xcd_remap((int)L, nunits) >> 1); const unsigned e = tb.tab[tile]; const int ve = (int)(e & 0xffffu), tix = (int)(e >> 16), ch = ve / 65, ex = ve % 65;
            const int cnt = ve_count(ctl, ve);
            if (threadIdx.x < 256) { const int slot = tix * 256 + (int)threadIdx.x; idx[i * 256 + threadIdx.x] = slot < cnt ? rowtok[(size_t)(ch * 64 + ex) * CAPC + slot] : ch * CAPC; } }
        __syncthreads();
    }
    __device__ __forceinline__ bool next(int i, Unit& u) const {
        const long L = (long)i * G + c; if (L >= nunits) return false;
        const int wgid = xcd_remap((int)L, nunits), tile = tile_of(wgid >> 1), pn = wgid & 1;
        const int ex = (int)(tb.tab[tile] & 0xffffu) % 65;
        u.A = X1B; u.B = WGU + ((size_t)ex * 512 + (size_t)pn * 256) * 1024 * 2; u.i0 = tile * 256; u.i1 = pn; u.i2 = 0; u.i3 = i < IDX_UNITS ? i : IDX_UNITS - 1; return true;
    }
    __device__ __forceinline__ void gather(const Unit& u, int R0, int C0, int R1, int C1, unsigned& g00, unsigned& g01, unsigned& g10, unsigned& g11) const {
        const LAS int* ip = idx + u.i3 * 256;
        g00 = (unsigned)ip[R0] * 2048u + (unsigned)C0 * 2u; g01 = (unsigned)ip[R1] * 2048u + (unsigned)C1 * 2u;
        g10 = (unsigned)ip[128 + R0] * 2048u + (unsigned)C0 * 2u; g11 = (unsigned)ip[128 + R1] * 2048u + (unsigned)C1 * 2u;
    }
};
struct EpiGateUp {
    static constexpr int PERM = 1; static constexpr int NST = 8;
    bf16_t* H;
    __device__ __forceinline__ void operator()(const f32x4 (&acc)[2][2][4][2], const Unit& u, int wr, int wc, int fr, int fq) const {
        const int hrow0 = u.i0 + wr * 64 + fr, c = 128 * u.i1 + 32 * wc + 8 * fq;
        FX_ROWLOOP { f32x4 h0, h1;
#pragma unroll
            for (int j = 0; j < 4; ++j) { const float g0 = acc[ai][0][m][0][j], g1 = acc[ai][0][m][1][j];
                h0[j] = g0 * fast_sigmoid(g0) * acc[ai][1][m][0][j]; h1[j] = g1 * fast_sigmoid(g1) * acc[ai][1][m][1][j]; }
            *(u32x4*)(H + h_off(hrow0 + ai * 128 + m * 16, c)) = pack8(h0, h1); }
    }
};
struct DownOrder {
    const char* Hh; const char* HS; const char* WD; MoeTab tb; int t0, nunits, G, c, chn;
    __device__ __forceinline__ void init(const void* h, const void* hs, const void* wd, MoeTab tb_, int ch, int G_, int c_) { Hh = (const char*)h; HS = (const char*)hs; WD = (const char*)wd; tb = tb_; chn = ch; t0 = tb_.tbase[ch * 65]; nunits = 4 * (tb_.tbase[(ch + 1) * 65] - t0); G = G_; c = c_; }
    __device__ __forceinline__ bool next(int i, Unit& u) const {
        const long L = (long)i * G + c; if (L >= nunits) return false;
        const int wgid = xcd_remap((int)L, nunits), tile = t0 + (wgid >> 2), pn = wgid & 3;
        const int ex = (int)(tb.tab[tile] & 0xffffu) % 65;
        u.A = ex == 64 ? HS + ((size_t)chn * CAPC + (size_t)(tb.tab[tile] >> 16) * 256) * 256 * 2 : Hh + (size_t)tile * 256 * 256 * 2; u.B = WD + ((size_t)ex * 1024 + (size_t)pn * 256) * 256 * 2; u.i0 = ex == 64 ? (int)(tb.tab[tile] >> 16) * 256 : (tile - t0) * 256; u.i1 = pn; u.i2 = ex == 64; u.i3 = 0; return true;
    }
};
constexpr float Y8_SCALE = 16.f, Y8_INV = 1.f / 16.f;
__device__ __forceinline__ u32x2 pack8_fp8(const f32x4 a, const f32x4 b) {
    int w0 = 0, w1 = 0;
    w0 = __builtin_amdgcn_cvt_pk_fp8_f32(a[0] * Y8_SCALE, a[1] * Y8_SCALE, w0, false); w0 = __builtin_amdgcn_cvt_pk_fp8_f32(a[2] * Y8_SCALE, a[3] * Y8_SCALE, w0, true);
    w1 = __builtin_amdgcn_cvt_pk_fp8_f32(b[0] * Y8_SCALE, b[1] * Y8_SCALE, w1, false); w1 = __builtin_amdgcn_cvt_pk_fp8_f32(b[2] * Y8_SCALE, b[3] * Y8_SCALE, w1, true);
    u32x2 r; r.x = (unsigned)w0; r.y = (unsigned)w1; return r;
}
__device__ __forceinline__ void unpack8_fp8(const u32x2 w, f32x4& a, f32x4& b) {
    const f32x2 p0 = __builtin_amdgcn_cvt_pk_f32_fp8((int)w.x, false), p1 = __builtin_amdgcn_cvt_pk_f32_fp8((int)w.x, true);
    const f32x2 p2 = __builtin_amdgcn_cvt_pk_f32_fp8((int)w.y, false), p3 = __builtin_amdgcn_cvt_pk_f32_fp8((int)w.y, true);
    a = (f32x4){p0.x, p0.y, p1.x, p1.y}; b = (f32x4){p2.x, p2.y, p3.x, p3.y};
}
__device__ __forceinline__ size_t y8_off(int row, int col) { return (size_t)row * 1024 + (size_t)col; }
template <int STORE = 1> struct EpiDownT {
    static constexpr int PERM = 2; static constexpr int NST = 8;
    unsigned char* Y8; bf16_t* YS;
    __device__ __forceinline__ void operator()(const f32x4 (&acc)[2][2][4][2], const Unit& u, int wr, int wc, int fr, int fq) const {
        const int yrow0 = u.i0 + wr * 64, c0 = 256 * u.i1 + 64 * wc + 16 * fq;
        if (u.i2) {
            const bool lo = fr < 8;
            FX_ROWLOOP { const u32x4 X = pack8(acc[ai][0][m][0], acc[ai][0][m][1]), Y = pack8(acc[ai][1][m][0], acc[ai][1][m][1]);
                const u32x4 S = lo ? Y : X, R = ror8_x4(S); const u32x4 A1 = lo ? X : R, A2 = lo ? R : Y;
                bf16_t* p = YS + (size_t)(yrow0 + ai * 128 + m * 16 + (fr & 7)) * 1024 + c0 + (lo ? 0 : 8);
                *(u32x4*)p = A1; *(u32x4*)(p + 8 * 1024) = A2; }
        } else {
            FX_ROWLOOP { unsigned char* rp = Y8 + y8_off(yrow0 + ai * 128 + m * 16 + fr, c0);
                const u32x2 lo = pack8_fp8(acc[ai][0][m][0], acc[ai][0][m][1]), hi = pack8_fp8(acc[ai][1][m][0], acc[ai][1][m][1]);
                u32x4 w; w.x = lo.x; w.y = lo.y; w.z = hi.x; w.w = hi.y; *(u32x4*)rp = w; }
        }
    }
};
typedef EpiDownT<1> EpiDown;
}
namespace fx {
namespace att {
constexpr int NW = 8, QBLK = 32, KVBLK = 64;
constexpr int SHM_V = 16384, SHM_K = 16384;
constexpr float THRL = 8.f;
#define KSWZ(row, colB) ((row) * 256 + ((colB) ^ (((row) & 7) << 4)))
#define SBAR() __builtin_amdgcn_sched_barrier(0)
__device__ __forceinline__ int crow(int r, int hi) { return (r & 3) + 8 * (r >> 2) + 4 * hi; }
__device__ __forceinline__ void partialSM(f32x16& p0, f32x16& p1, float& m_reg, float& mn, float& alpha) {
  float pmax = p0[0];
#pragma unroll
  for (int r = 1; r < 16; ++r) pmax = fmaxf(pmax, p0[r]);
#pragma unroll
  for (int r = 0; r < 16; ++r) pmax = fmaxf(pmax, p1[r]);
  { auto rr = __builtin_amdgcn_permlane32_swap(__float_as_uint(pmax), __float_as_uint(pmax), false, false);
    pmax = fmaxf(__uint_as_float(rr[0]), __uint_as_float(rr[1])); }
  if (__builtin_expect(__all(pmax - m_reg <= THRL), 1)) { mn = m_reg; alpha = 1.f; }
  else { mn = fmaxf(m_reg, pmax); alpha = __builtin_amdgcn_exp2f(m_reg - mn); m_reg = mn; }
#pragma unroll
  for (int r = 0; r < 16; ++r) p0[r] = p0[r] - mn;
#pragma unroll
  for (int r = 0; r < 16; ++r) p1[r] = p1[r] - mn;
#pragma unroll
  for (int r = 0; r < 16; ++r) p0[r] = __builtin_amdgcn_exp2f(p0[r]);
}
__device__ __forceinline__ void finishSM(f32x16& p0, f32x16& p1, float alpha, float& l_reg, bf16x8& pa0, bf16x8& pa1, bf16x8& pa2, bf16x8& pa3) {
#pragma unroll
  for (int r = 0; r < 16; ++r) p1[r] = __builtin_amdgcn_exp2f(p1[r]);
  float ps = 0;
#pragma unroll
  for (int r = 0; r < 16; ++r) ps += p0[r];
#pragma unroll
  for (int r = 0; r < 16; ++r) ps += p1[r];
  { auto rr = __builtin_amdgcn_permlane32_swap(__float_as_uint(ps), __float_as_uint(ps), false, false);
    ps = __uint_as_float(rr[0]) + __uint_as_float(rr[1]); }
  l_reg = l_reg * alpha + ps;
#define PK4(P, BASE, OUT) do { unsigned a0 = cvt_pk_bf16(P[BASE + 0], P[BASE + 1]), a1 = cvt_pk_bf16(P[BASE + 2], P[BASE + 3]);   \
    unsigned b0 = cvt_pk_bf16(P[BASE + 4], P[BASE + 5]), b1 = cvt_pk_bf16(P[BASE + 6], P[BASE + 7]);                              \
    auto r0 = __builtin_amdgcn_permlane32_swap(a0, b0, false, false); auto r1 = __builtin_amdgcn_permlane32_swap(a1, b1, false, false); \
    u32x4 w = {r0[0], r1[0], r0[1], r1[1]}; OUT = *reinterpret_cast<bf16x8*>(&w); } while (0)
  PK4(p0, 0, pa0); PK4(p0, 8, pa1); PK4(p1, 0, pa2); PK4(p1, 8, pa3);
#undef PK4
}
__device__ __forceinline__ void qkt(f32x16& p0, f32x16& p1, const char* Ks, const bf16x8 (&qr)[6], int r32, int hi) {
  p0 = f32x16{}; p1 = f32x16{};
#pragma unroll
  for (int d0 = 0; d0 < 6; ++d0) { const int cb = (d0 * 16 + hi * 8) * 2;
    const bf16x8 b0 = *reinterpret_cast<const bf16x8*>(Ks + KSWZ(r32, cb));
    const bf16x8 b1 = *reinterpret_cast<const bf16x8*>(Ks + KSWZ(32 + r32, cb));
    p0 = __builtin_amdgcn_mfma_f32_32x32x16_bf16(b0, qr[d0], p0, 0, 0, 0);
    p1 = __builtin_amdgcn_mfma_f32_32x32x16_bf16(b1, qr[d0], p1, 0, 0, 0); }
}
__device__ __forceinline__ int v_st(int k, int c) { const int kk = (k & ~0xC) | ((k & 4) << 1) | ((k & 8) >> 1); return ((kk >> 3) * 4 + (c >> 5)) * 512 + ((kk & 7) * 32 + (c & 31)) * 2; }
__device__ __forceinline__ int v_rd_base(int lane) { return ((lane & 3) << 3) | (((lane >> 2) & 3) << 6) | (((lane >> 4) & 1) << 5) | (((lane >> 5) & 1) << 8); }
constexpr int v_rd_off(int d0, int ks, int half) { return d0 * 512 + ks * 4096 + half * 2048; }
template <int OFF> __device__ __forceinline__ s16x4 tr_read(int vb) {
  s16x4 r; asm volatile("ds_read_b64_tr_b16 %0, %1 offset:%2" : "=&v"(r) : "v"(vb), "i"(OFF) : "memory"); return r;
}
template <int D0> __device__ __forceinline__ void pv_one(f32x16& od, int vb, bf16x8 pa0, bf16x8 pa1, bf16x8 pa2, bf16x8 pa3) {
  const s16x4 l0 = tr_read<v_rd_off(D0, 0, 0)>(vb), h0 = tr_read<v_rd_off(D0, 0, 1)>(vb), l1 = tr_read<v_rd_off(D0, 1, 0)>(vb), h1 = tr_read<v_rd_off(D0, 1, 1)>(vb);
  const s16x4 l2 = tr_read<v_rd_off(D0, 2, 0)>(vb), h2 = tr_read<v_rd_off(D0, 2, 1)>(vb), l3 = tr_read<v_rd_off(D0, 3, 0)>(vb), h3 = tr_read<v_rd_off(D0, 3, 1)>(vb);
  asm volatile("s_waitcnt lgkmcnt(0)" ::: "memory"); SBAR();
#define PK(L, H) (bf16x8){L[0], L[1], L[2], L[3], H[0], H[1], H[2], H[3]}
  od = __builtin_amdgcn_mfma_f32_32x32x16_bf16(pa0, PK(l0, h0), od, 0, 0, 0);
  od = __builtin_amdgcn_mfma_f32_32x32x16_bf16(pa1, PK(l1, h1), od, 0, 0, 0);
  od = __builtin_amdgcn_mfma_f32_32x32x16_bf16(pa2, PK(l2, h2), od, 0, 0, 0);
  od = __builtin_amdgcn_mfma_f32_32x32x16_bf16(pa3, PK(l3, h3), od, 0, 0, 0);
#undef PK
}
__device__ __forceinline__ void pv_d0(f32x16 (&o)[2], int vb, bf16x8 pa0, bf16x8 pa1, bf16x8 pa2, bf16x8 pa3) {
  pv_one<0>(o[0], vb, pa0, pa1, pa2, pa3); pv_one<1>(o[1], vb, pa0, pa1, pa2, pa3);
}
__device__ __forceinline__ void attn_unit(const unsigned char* __restrict__ wsb, const bf16_t* __restrict__ Q, bf16_t* __restrict__ MIX, int tok0, int qrow0, int h, char* lds) {
  int tid = threadIdx.x; asm volatile("" : "+v"(tid));
  const int wid = __builtin_amdgcn_readfirstlane(tid >> 6), lane = tid & 63, r32 = lane & 31, hi = lane >> 5;
  char* K_lds = lds; char* V_lds = lds + 4 * SHM_K;
  float* ws = (float*)(lds + TAB_OFF) + wid * 64; float* li_l = ws; float* al_l = ws + 32;
  float m_reg = -1e30f, l_reg = 0; f32x16 o[2] = {}; bf16x8 qr[6];
  const bf16_t* Qw = Q + (size_t)(tok0 + qrow0 + wid * QBLK + r32) * 768 + h * 96 + hi * 8;
#pragma unroll
  for (int d0 = 0; d0 < 6; ++d0) qr[d0] = *reinterpret_cast<const bf16x8*>(Qw + d0 * 16);
  const int vb0 = (int)(uintptr_t)V_lds + v_rd_base(lane);
  const int ra = tid / 12, ca = tid % 12, rb = (512 + tid) / 12, cb = (512 + tid) % 12, rv = tid >> 3, cv = tid & 7;
  const unsigned kinca = ca < 8 ? 64u * 2048u : 64u * 512u, kincb = cb < 8 ? 64u * 2048u : 64u * 512u;
  const unsigned kofa = ca < 8 ? (unsigned)WS_KV + (unsigned)(((tok0 + ra) * 1024 + h * 128 + ca * 8) * 2) : (unsigned)WS_CKVR + (unsigned)(((tok0 + ra) * 256 + 128 + (ca - 8) * 8) * 2);
  const unsigned kofb = cb < 8 ? (unsigned)WS_KV + (unsigned)(((tok0 + rb) * 1024 + h * 128 + cb * 8) * 2) : (unsigned)WS_CKVR + (unsigned)(((tok0 + rb) * 256 + 128 + (cb - 8) * 8) * 2);
  const unsigned vofs = (unsigned)WS_KV + (unsigned)(((tok0 + rv) * 1024 + h * 128 + 64 + cv * 8) * 2);
  const int ksta = KSWZ(ra, ca * 16), kstb = KSWZ(rb, cb * 16), vst = v_st(rv, cv * 8);
  const bool two = wid < 4;
  bf16x8 RK0a, RK0b, RV0, RK1a, RK1b, RV1;
#define TLOAD(KA, KB, VV, t) do { KA = *reinterpret_cast<const bf16x8*>(wsb + kofa + (unsigned)(t) * kinca); if (two) KB = *reinterpret_cast<const bf16x8*>(wsb + kofb + (unsigned)(t) * kincb); \
    VV = *reinterpret_cast<const bf16x8*>(wsb + vofs + (unsigned)(t) * (64u * 2048u)); } while (0)
#define TWRITE(KA, KB, VV, t) do { const int bo_ = ((t) & 3) * SHM_K; *(bf16x8*)(K_lds + bo_ + ksta) = KA; if (two) *(bf16x8*)(K_lds + bo_ + kstb) = KB; *(bf16x8*)(V_lds + bo_ + vst) = VV; } while (0)
#define RESC(a) do { if (__any((a) < 1.f)) { if (hi == 0) al_l[r32] = (a); asm volatile("s_waitcnt lgkmcnt(0)" ::: "memory"); \
    _Pragma("unroll") for (int d = 0; d < 2; ++d) _Pragma("unroll") for (int r = 0; r < 16; ++r) o[d][r] *= al_l[crow(r, hi)]; } } while (0)
#define STEP_END() do { asm volatile("s_waitcnt lgkmcnt(0)" ::: "memory"); __builtin_amdgcn_s_barrier(); asm volatile("" ::: "memory"); } while (0)
  f32x16 pA0, pA1, pB0, pB1; float mnA, mnB, alA, alB; bf16x8 pa0, pa1, pa2, pa3; constexpr int NT = SEQ / KVBLK;
  TLOAD(RK0a, RK0b, RV0, 0); TWRITE(RK0a, RK0b, RV0, 0); TLOAD(RK1a, RK1b, RV1, 1); TLOAD(RK0a, RK0b, RV0, 2);
  STEP_END();
  qkt(pA0, pA1, K_lds, qr, r32, hi); partialSM(pA0, pA1, m_reg, mnA, alA);
  TWRITE(RK1a, RK1b, RV1, 1); TLOAD(RK1a, RK1b, RV1, 3);
  STEP_END();
  for (int s = 1; s + 1 < NT; s += 2) {
    SBAR(); qkt(pB0, pB1, K_lds + (s & 3) * SHM_K, qr, r32, hi);
    finishSM(pA0, pA1, alA, l_reg, pa0, pa1, pa2, pa3); SBAR();
    TWRITE(RK0a, RK0b, RV0, s + 1);
    if (s + 3 < NT) TLOAD(RK0a, RK0b, RV0, s + 3);
    SBAR();
    pv_d0(o, vb0 + ((s - 1) & 3) * SHM_V, pa0, pa1, pa2, pa3); partialSM(pB0, pB1, m_reg, mnB, alB);
    RESC(alB); STEP_END();
    SBAR(); qkt(pA0, pA1, K_lds + ((s + 1) & 3) * SHM_K, qr, r32, hi);
    finishSM(pB0, pB1, alB, l_reg, pa0, pa1, pa2, pa3); SBAR();
    if (s + 2 < NT) TWRITE(RK1a, RK1b, RV1, s + 2);
    if (s + 4 < NT) TLOAD(RK1a, RK1b, RV1, s + 4);
    SBAR();
    pv_d0(o, vb0 + (s & 3) * SHM_V, pa0, pa1, pa2, pa3); partialSM(pA0, pA1, m_reg, mnA, alA);
    RESC(alA); STEP_END();
  }
  SBAR(); qkt(pB0, pB1, K_lds + ((NT - 1) & 3) * SHM_K, qr, r32, hi);
  finishSM(pA0, pA1, alA, l_reg, pa0, pa1, pa2, pa3); SBAR();
  pv_d0(o, vb0 + ((NT - 2) & 3) * SHM_V, pa0, pa1, pa2, pa3); partialSM(pB0, pB1, m_reg, mnB, alB);
  RESC(alB);
  finishSM(pB0, pB1, alB, l_reg, pa0, pa1, pa2, pa3); SBAR();
  pv_d0(o, vb0 + ((NT - 1) & 3) * SHM_V, pa0, pa1, pa2, pa3);
  if (hi == 0) li_l[r32] = l_reg; asm volatile("s_waitcnt lgkmcnt(0)" ::: "memory");
  bf16_t* Ow = MIX + (size_t)(tok0 + qrow0 + wid * QBLK) * 1024 + 512 + h * 64 + r32;
#pragma unroll
  for (int r = 0; r < 16; ++r) { const int orow = crow(r, hi); const float rl = __builtin_amdgcn_rcpf(li_l[orow]);
#pragma unroll
    for (int d0 = 0; d0 < 2; ++d0) Ow[(size_t)orow * 1024 + d0 * 32] = (bf16_t)(cvt_pk_bf16(o[d0][r] * rl, 0.f) & 0xffffu); }
  STEP_END();
#undef TLOAD
#undef TWRITE
#undef RESC
#undef STEP_END
}
#undef KSWZ
#undef SBAR
}

struct Frame {
    LAS unsigned char* lds; unsigned* ctl; unsigned char* ws; float* out; const float* in[29];
    int tid, lane, wave, G, bid;
};
enum { I_X = 0, I_WIN, I_LRE, I_LIM, I_LDT, I_BRE, I_BIM, I_CRE, I_CIM, I_DSK, I_WGLU, I_BGLU, I_QG, I_WUQ, I_KVG, I_WUKV, I_WO, I_LN1G, I_LN1B, I_WR, I_RB, I_WEG, I_WEU, I_WED, I_WSG, I_WSU, I_WSD, I_LN2G, I_LN2B };

#ifndef MK_TPROBE
#define MK_TPROBE -1
#endif
#define TSUB(F, id) do { if (MK_TPROBE >= 100) { __syncthreads(); if (blockIdx.x == 0 && threadIdx.x == 0) { volatile LAS unsigned* M_ = (volatile LAS unsigned*)((F).lds + MISC_OFF); const unsigned long long tn_ = __builtin_amdgcn_s_memrealtime(); \
    const unsigned long long tl_ = ((unsigned long long)M_[17] << 32) | M_[16]; if ((id) == MK_TPROBE) { const unsigned long long d_ = tn_ - tl_; M_[18] = (unsigned)d_; M_[19] = (unsigned)(d_ >> 32); } M_[16] = (unsigned)tn_; M_[17] = (unsigned)(tn_ >> 32); } } } while (0)
__device__ __forceinline__ int fresh_lane() { int l = (int)(threadIdx.x & 63u); asm volatile("" : "+v"(l)); return l; }
template <class F> __device__ __forceinline__ void transpose_load(const F& f, int k0, int n0, int lane, float (&tv)[32]) {
#pragma unroll
    for (int i = 0; i < 32; ++i) tv[i] = f(k0 + 2 * i + (lane >> 5), n0 + (lane & 31));
}
__device__ __forceinline__ void transpose_store(const float (&tv)[32], bf16_t* Bt, int ldk, int k0, int n0, LAS float* scr, int lane) {
#pragma unroll
    for (int i = 0; i < 32; ++i) scr[(2 * i + (lane >> 5)) * 33 + (lane & 31)] = tv[i];
    asm volatile("s_waitcnt lgkmcnt(0)" ::: "memory");
    const int c = lane & 7;
#pragma unroll
    for (int j = 0; j < 4; ++j) { const int n = (lane >> 3) + 8 * j; const LAS float* s = scr + (8 * c) * 33 + n;
        u32x4 o; o.x = cvt_pk_bf16(s[0 * 33], s[1 * 33]); o.y = cvt_pk_bf16(s[2 * 33], s[3 * 33]); o.z = cvt_pk_bf16(s[4 * 33], s[5 * 33]); o.w = cvt_pk_bf16(s[6 * 33], s[7 * 33]);
        *(u32x4*)(Bt + (size_t)(n0 + n) * ldk + k0 + 8 * c) = o; }
    asm volatile("s_waitcnt lgkmcnt(0)" ::: "memory");
}
template <class F> __device__ __forceinline__ void transpose_item(const F& f, bf16_t* Bt, int ldk, int k0, int n0, LAS float* scr, int lane) {
    float tv[32]; transpose_load(f, k0, n0, lane, tv); transpose_store(tv, Bt, ldk, k0, n0, scr, lane);
}
__device__ __forceinline__ int rope_perm_src(int p) { return (p & 1) ? 16 + (p >> 1) : (p >> 1); }
struct SsmPar { float lr, li, dt, kr, ki; };
__device__ __forceinline__ SsmPar ssm_par(const float* lam_re, const float* lam_im, const float* log_dt, int d, int g, int n) {
    SsmPar p; p.lr = fminf(lam_re[(d * 32 + g) * 64 + n], -1e-4f); p.li = lam_im[(d * 32 + g) * 64 + n]; p.dt = expf(log_dt[d * 32 + g]);
    const float x = p.lr * p.dt, th = p.li * p.dt;
    const float em1 = expm1f(x), cs = cosf(th), sn = sinf(th), sh = sinf(0.5f * th);
    const float ai = (em1 + 1.f) * sn, arm1 = em1 * cs - 2.f * sh * sh, den = p.lr * p.lr + p.li * p.li;
    p.kr = (arm1 * p.lr + ai * p.li) / den; p.ki = (ai * p.lr - arm1 * p.li) / den; return p;
}
__device__ __forceinline__ void ssm_pow_xt(float x, float th, float e, float& pr, float& pi) {
    const float mag = __builtin_amdgcn_exp2f(x * e * 1.4426950408889634f); double trd = (double)th * (double)e * 0.15915494309189535; trd -= rint(trd); const float tr = (float)trd;
    pr = mag * __builtin_amdgcn_cosf(tr); pi = mag * __builtin_amdgcn_sinf(tr);
}
__device__ __forceinline__ void ssm_pow(const SsmPar& p, float e, float& pr, float& pi) { ssm_pow_xt(p.lr * p.dt, p.li * p.dt, e, pr, pi); }

__device__ __forceinline__ void p0_ssm_item(Frame& F, int g, int j) {
    LAS float* Pr = (LAS float*)F.lds;
    LAS float* Pi = Pr + 2 * 64 * 33;
    LAS float* Br = Pi + 2 * 64 * 33;
    LAS float* Bi = Br + 2 * 64 * 16;
    LAS float* Cr = Bi + 2 * 64 * 16;
    LAS float* Ci = Cr + 2 * 16 * 64;
    LAS float* Par = Ci + 2 * 16 * 64;
    const float* lam_re = F.in[I_LRE]; const float* lam_im = F.in[I_LIM]; const float* log_dt = F.in[I_LDT];
    __syncthreads();
    if (F.tid < 128) { const SsmPar p = ssm_par(lam_re, lam_im, log_dt, F.tid >> 6, g, F.tid & 63); Par[F.tid * 4] = p.lr * p.dt; Par[F.tid * 4 + 1] = p.li * p.dt; Par[F.tid * 4 + 2] = p.kr; Par[F.tid * 4 + 3] = p.ki; }
    for (int idx = F.tid; idx < 2 * 16 * 64; idx += 512) { const int n = idx & 63, pp = (idx >> 6) & 15, d = idx >> 10;
        Cr[idx] = F.in[I_CRE][((d * 32 + g) * 16 + pp) * 64 + n]; Ci[idx] = F.in[I_CIM][((d * 32 + g) * 16 + pp) * 64 + n]; }
    __syncthreads();
    for (int idx = F.tid; idx < 2 * 64 * 33; idx += 512) { const int tau = idx % 33, dn = idx / 33; float pr, pi; ssm_pow_xt(Par[dn * 4], Par[dn * 4 + 1], (float)tau, pr, pi); Pr[idx] = pr; Pi[idx] = pi; }
    for (int idx = F.tid; idx < 2 * 64 * 16; idx += 512) { const int q = idx & 15, dn = idx >> 4, n = dn & 63, d = dn >> 6; const float kr = Par[dn * 4 + 2], ki = Par[dn * 4 + 3];
        const float br = F.in[I_BRE][((d * 32 + g) * 64 + n) * 16 + q], bi = F.in[I_BIM][((d * 32 + g) * 64 + n) * 16 + q];
        Br[idx] = kr * br - ki * bi; Bi[idx] = kr * bi + ki * br; }
    __syncthreads();
    float* Kt = (float*)(F.ws + WS_KT) + (size_t)g * 16384;
    { const int blk = 512 * j + F.tid;
      const int q2 = blk & 7, p2 = (blk >> 3) & 7, tau = (blk >> 6) & 31, d = blk >> 11; float s00 = 0.f, s01 = 0.f, s10 = 0.f, s11 = 0.f;
      for (int n = 0; n < 64; ++n) { const float pr = Pr[(d * 64 + n) * 33 + tau], pi = Pi[(d * 64 + n) * 33 + tau];
          const float b0r = Br[(d * 64 + n) * 16 + 2 * q2], b0i = Bi[(d * 64 + n) * 16 + 2 * q2], b1r = Br[(d * 64 + n) * 16 + 2 * q2 + 1], b1i = Bi[(d * 64 + n) * 16 + 2 * q2 + 1];
          const float d0r = pr * b0r - pi * b0i, d0i = pr * b0i + pi * b0r, d1r = pr * b1r - pi * b1i, d1i = pr * b1i + pi * b1r;
          const float c0r = Cr[(d * 16 + 2 * p2) * 64 + n], c0i = Ci[(d * 16 + 2 * p2) * 64 + n], c1r = Cr[(d * 16 + 2 * p2 + 1) * 64 + n], c1i = Ci[(d * 16 + 2 * p2 + 1) * 64 + n];
          s00 += c0r * d0r - c0i * d0i; s01 += c0r * d1r - c0i * d1i; s10 += c1r * d0r - c1i * d0i; s11 += c1r * d1r - c1i * d1i; }
      float* kp = Kt + ((size_t)(d * 32 + tau) * 16 + 2 * p2) * 16 + 2 * q2; kp[0] = s00; kp[1] = s01; kp[16] = s10; kp[17] = s11; }
    bf16_t* Wst = (bf16_t*)(F.ws + WS_WST) + (size_t)g * 256 * 512;
    for (int pc = F.tid; pc < 32 * 64; pc += 512) { const int row = 32 * j + (pc >> 6), k0 = (pc & 63) * 8, s = k0 >> 4, q0 = k0 & 15;
        const int d = row >> 7, ri = (row >> 6) & 1, n = row & 63, e = d ? s : (CHK - 1 - s);
        const float pr = Pr[(d * 64 + n) * 33 + e], pi = Pi[(d * 64 + n) * 33 + e]; float v[8];
#pragma unroll
        for (int t = 0; t < 8; ++t) { const float br = Br[(d * 64 + n) * 16 + q0 + t], bi = Bi[(d * 64 + n) * 16 + q0 + t]; v[t] = ri ? (pr * bi + pi * br) : (pr * br - pi * bi); }
        u32x4 o; o.x = cvt_pk_bf16(v[0], v[1]); o.y = cvt_pk_bf16(v[2], v[3]); o.z = cvt_pk_bf16(v[4], v[5]); o.w = cvt_pk_bf16(v[6], v[7]);
        *(u32x4*)(Wst + (size_t)row * 512 + k0) = o; }
    bf16_t* Mo = (bf16_t*)(F.ws + WS_MO) + (size_t)g * 512 * UHK;
    for (int pc = F.tid; pc < 64 * 32; pc += 512) { const int row = 64 * j + (pc >> 5), kk = (pc & 31) * 8, d = kk >> 7, ri = (kk >> 6) & 1, n0 = kk & 63, tq = row >> 4, pp = row & 15;
        const int e = d ? (CHK - tq) : (tq + 1); float v[8];
#pragma unroll
        for (int t = 0; t < 8; ++t) { const int n = n0 + t; const float pr = Pr[(d * 64 + n) * 33 + e], pi = Pi[(d * 64 + n) * 33 + e], cr = Cr[(d * 16 + pp) * 64 + n], ci = Ci[(d * 16 + pp) * 64 + n];
            v[t] = ri ? -(cr * pi + ci * pr) : (cr * pr - ci * pi); }
        u32x4 o; o.x = cvt_pk_bf16(v[0], v[1]); o.y = cvt_pk_bf16(v[2], v[3]); o.z = cvt_pk_bf16(v[4], v[5]); o.w = cvt_pk_bf16(v[6], v[7]);
        *(u32x4*)(Mo + (size_t)row * UHK + 512 + kk) = o; }
}

template <int PART> __device__ __forceinline__ void p0_prologue(Frame& F) {
    const int lane = fresh_lane();
    if (PART == 1) {
        for (int it = F.bid; it < 256; it += F.G) p0_ssm_item(F, it >> 3, it & 7);
        __syncthreads();
    }
    if (PART == 0) {
        float* rc = (float*)(F.ws + WS_ROPE); float* rs = rc + 2048 * 16;
        for (int idx = F.bid * 512 + F.tid; idx < 2048 * 16; idx += F.G * 512) { const int i = idx & 15, pos = idx >> 4;
            const float inv = expf(-9.210340371976184f * (float)i * (1.f / 16.f)); const float a = (float)pos * inv; rc[idx] = cosf(a); rs[idx] = sinf(a); } }
    LAS float* scr = (LAS float*)(F.lds + F.wave * 16384);
    const int gw = F.bid * 8 + F.wave, NGW = F.G * 8;
    constexpr int I_A = 512, I_B = 128, I_C = 96, I_D = 128, I_E = 128, I_F = 512, I_G = 65 * 256, I_H = 65 * 128;
    constexpr int NITEMS = I_A + I_B + I_C + I_D + I_E + I_F + I_G + I_H;
    for (int it = (PART == 0 ? gw : I_A + gw); it < (PART == 0 ? I_A : NITEMS); it += NGW) {
        int r = it;
        if (r < I_A) { const float* W = F.in[I_WIN]; const int kb = r / 32, nb = r % 32;
            transpose_item([&](int k, int n) -> float { if (n >= 928) return 0.f; const int src = n < 896 ? n : 896 + rope_perm_src(n - 896); return W[(size_t)k * 928 + src]; }, (bf16_t*)(F.ws + WS_WIN), 1024, kb * 64, nb * 32, scr, lane); continue; } r -= I_A;
        if (r < I_B) { const float* W = F.in[I_WGLU]; const int kb = r / 16, nb = r % 16;
            transpose_item([&](int k, int n) -> float { return W[(size_t)k * 512 + n]; }, (bf16_t*)(F.ws + WS_WGLU), 512, kb * 64, nb * 32, scr, lane); continue; } r -= I_B;
        if (r < I_C) { const float* W = F.in[I_WUQ]; const float* gq = F.in[I_QG]; const int kb = r / 24, nb = r % 24;
            transpose_item([&](int k, int n) -> float { const int hh = n / 96, jj = n % 96; const int src = jj < 64 ? n : hh * 96 + 64 + rope_perm_src(jj - 64); return W[(size_t)k * 768 + src] * gq[k]; }, (bf16_t*)(F.ws + WS_WUQ), 256, kb * 64, nb * 32, scr, lane); continue; } r -= I_C;
        if (r < I_D) { const float* W = F.in[I_WUKV]; const float* gk = F.in[I_KVG]; const int kb = r / 32, nb = r % 32;
            transpose_item([&](int k, int n) -> float { return k < 128 ? W[(size_t)k * 1024 + n] * gk[k] : 0.f; }, (bf16_t*)(F.ws + WS_WUKV), 256, kb * 64, nb * 32, scr, lane); continue; } r -= I_D;
        if (r < I_E) { const float* W = F.in[I_WR]; const int kb = r / 8, nb = r % 8;
            transpose_item([&](int k, int n) -> float { return n < 64 ? W[(size_t)k * 64 + n] : 0.f; }, (bf16_t*)(F.ws + WS_WR), 1024, kb * 64, nb * 32, scr, lane); continue; } r -= I_E;
        if (r < I_F) { const float* W = F.in[I_WO]; const int kb = r / 32, nb = r % 32;
            transpose_item([&](int k, int n) -> float { return W[(size_t)k * 1024 + n]; }, (bf16_t*)(F.ws + WS_WO), 1024, kb * 64, nb * 32, scr, lane); continue; } r -= I_F;
        const int it2 = it + NGW; const bool has2 = it2 < NITEMS; float tv0[32], tv1[32];
        auto geom = [&](int rr_, const float*& W0, const float*& W1, bf16_t*& dst, int& ldk, int& k0, int& n0, bool& gu) {
            if (rr_ < I_G) { const int e = rr_ / 256, q = rr_ % 256; gu = true; k0 = (q / 16) * 64; n0 = (q % 16) * 32; ldk = 1024;
                W0 = e < 64 ? F.in[I_WEG] + (size_t)e * 1024 * 256 : F.in[I_WSG]; W1 = e < 64 ? F.in[I_WEU] + (size_t)e * 1024 * 256 : F.in[I_WSU]; dst = (bf16_t*)(F.ws + WS_WGU) + (size_t)e * 512 * 1024; }
            else { const int q_ = rr_ - I_G, e = q_ / 128, q = q_ % 128; gu = false; k0 = (q / 32) * 64; n0 = (q % 32) * 32; ldk = 256;
                W0 = e < 64 ? F.in[I_WED] + (size_t)e * 256 * 1024 : F.in[I_WSD]; W1 = W0; dst = (bf16_t*)(F.ws + WS_WD) + (size_t)e * 1024 * 256; } };
        auto val = [&](bool gu, const float* W0, const float* W1, int k, int n) -> float { if (gu) { const int r_ = n & 255, col = 128 * (n >> 8) + 32 * (r_ >> 6) + (r_ & 31); return ((r_ >> 5) & 1) ? W1[(size_t)k * 256 + col] : W0[(size_t)k * 256 + col]; } return W0[(size_t)k * 1024 + n]; };
        const float *Wa0, *Wa1, *Wb0, *Wb1; bf16_t *da, *db; int lka, ka, na, lkb, kb_, nb_; bool gua, gub;
        geom(r, Wa0, Wa1, da, lka, ka, na, gua);
        transpose_load([&](int k, int n) -> float { return val(gua, Wa0, Wa1, k, n); }, ka, na, lane, tv0);
        if (has2) { geom(it2 - (I_A + I_B + I_C + I_D + I_E + I_F), Wb0, Wb1, db, lkb, kb_, nb_, gub); transpose_load([&](int k, int n) -> float { return val(gub, Wb0, Wb1, k, n); }, kb_, nb_, lane, tv1); }
        transpose_store(tv0, da, lka, ka, na, scr, lane);
        if (has2) transpose_store(tv1, db, lkb, kb_, nb_, scr, lane);
        it += NGW;
    }
    if (PART == 0) {
      const float* x = F.in[I_X]; bf16_t* xb = (bf16_t*)(F.ws + WS_XB); const size_t N8 = (size_t)T * DM / 8, st = (size_t)F.G * 512;
      for (size_t i = (size_t)F.bid * 512 + F.tid; i < N8; i += 4 * st) {
          f32x4 a[4], b[4];
#pragma unroll
          for (int u = 0; u < 4; ++u) { const size_t ii = i + u * st < N8 ? i + u * st : i; a[u] = __builtin_nontemporal_load((const f32x4*)(x + ii * 8)); b[u] = __builtin_nontemporal_load((const f32x4*)(x + ii * 8 + 4)); }
#pragma unroll
          for (int u = 0; u < 4; ++u) if (i + u * st < N8) *(u32x4*)(xb + (i + u * st) * 8) = pack8(a[u], b[u]); } }
    if (PART == 1) { asm volatile("s_waitcnt vmcnt(0) lgkmcnt(0)" ::: "memory"); __syncthreads(); }
}

__device__ __forceinline__ void scan_unit(Frame& F, int g, int pm) {
    const bf16_t* S = (const bf16_t*)(F.ws + WS_S); bf16_t* UH = (bf16_t*)(F.ws + WS_UH);
    {
        const int n = F.tid & 63, d = (F.tid >> 6) & 1, b = pm * 4 + (F.tid >> 7);
        const SsmPar p = ssm_par(F.in[I_LRE], F.in[I_LIM], F.in[I_LDT], d, g, n); float acr, aci; ssm_pow(p, (float)CHK, acr, aci);
        float hr = 0.f, hi = 0.f;
        const size_t rbase = (size_t)g * UHR + (size_t)b * NCHK;
#pragma unroll
        for (int hb = 0; hb < 2; ++hb) {
            float sr[32], si[32];
#pragma unroll
            for (int st = 0; st < 32; ++st) { const int ci = d ? (NCHK - 1 - (hb * 32 + st)) : (hb * 32 + st);
                sr[st] = __uint_as_float((unsigned)S[(rbase + ci) * 256 + d * 128 + n] << 16); si[st] = __uint_as_float((unsigned)S[(rbase + ci) * 256 + d * 128 + 64 + n] << 16); }
#pragma unroll
            for (int st = 0; st < 32; ++st) { const int ci = d ? (NCHK - 1 - (hb * 32 + st)) : (hb * 32 + st);
                bf16_t* hp = UH + (rbase + ci) * UHK + 512 + d * 128 + n;
                hp[0] = (bf16_t)(cvt_pk_bf16(hr, 0.f) & 0xffffu); hp[64] = (bf16_t)(cvt_pk_bf16(hi, 0.f) & 0xffffu);
                const float nr = acr * hr - aci * hi + sr[st], ni = acr * hi + aci * hr + si[st]; hr = nr; hi = ni; }
        }
    }
}
__device__ __forceinline__ void mo_fill(Frame& F) {
    const float* Kt = (const float*)(F.ws + WS_KT); bf16_t* Mo = (bf16_t*)(F.ws + WS_MO);
    for (int pc = F.bid * 512 + F.tid; pc < 32 * 512 * 64; pc += F.G * 512) {
        const int k0 = (pc & 63) * 8, row = (pc >> 6) & 511, g = pc >> 15, s = k0 >> 4, q0 = k0 & 15, tq = row >> 4, pp = row & 15;
        f32x4 v0 = {0.f, 0.f, 0.f, 0.f}, v1 = {0.f, 0.f, 0.f, 0.f};
        if (tq >= s) { const float* kp = Kt + ((size_t)(g * 2 + 0) * 32 + (tq - s)) * 256 + pp * 16 + q0; v0 += *(const f32x4*)kp; v1 += *(const f32x4*)(kp + 4); }
        if (s >= tq) { const float* kp = Kt + ((size_t)(g * 2 + 1) * 32 + (s - tq)) * 256 + pp * 16 + q0; v0 += *(const f32x4*)kp; v1 += *(const f32x4*)(kp + 4); }
        *(u32x4*)(Mo + ((size_t)g * 512 + row) * UHK + k0) = pack8(v0, v1);
    }
}

__device__ __forceinline__ void p7_ln1(Frame& F) {
    const int lane = fresh_lane();
    const float* g1 = F.in[I_LN1G]; const float* b1 = F.in[I_LN1B]; bf16_t* x1b = (bf16_t*)(F.ws + WS_X1B);
    f32x4 gg[4], bb[4];
#pragma unroll
    for (int j = 0; j < 4; ++j) { const int c = 8 * lane + (j >> 1) * 512 + (j & 1) * 4; gg[j] = *(const f32x4*)(g1 + c); bb[j] = *(const f32x4*)(b1 + c); }
    for (int pm = F.bid; pm < T / 256; pm += F.G)
    for (int row0 = pm * 256 + F.wave; row0 < pm * 256 + 256; row0 += 32) {
        u32x4 w0[4], w1[4];
#pragma unroll
        for (int j = 0; j < 4; ++j) { const bf16_t* rp = x1b + (size_t)(row0 + 8 * j) * 1024 + 8 * lane; w0[j] = *(const u32x4*)rp; w1[j] = *(const u32x4*)(rp + 512); }
#pragma unroll
        for (int j = 0; j < 4; ++j) {
            bf16_t* rp = x1b + (size_t)(row0 + 8 * j) * 1024 + 8 * lane; f32x4 v[4]; unpack8(w0[j], v[0], v[1]); unpack8(w1[j], v[2], v[3]);
            float s = 0.f;
#pragma unroll
            for (int q = 0; q < 4; ++q) s += (v[q][0] + v[q][1]) + (v[q][2] + v[q][3]);
            const float mean = wave_sum(s) * (1.f / 1024.f); float qq = 0.f;
#pragma unroll
            for (int q = 0; q < 4; ++q) { v[q] = v[q] - mean; qq += (v[q][0] * v[q][0] + v[q][1] * v[q][1]) + (v[q][2] * v[q][2] + v[q][3] * v[q][3]); }
            const float rstd = __builtin_amdgcn_rsqf(wave_sum(qq) * (1.f / 1024.f) + LN_EPS);
#pragma unroll
            for (int q = 0; q < 4; ++q) v[q] = v[q] * rstd * gg[q] + bb[q];
            *(u32x4*)rp = pack8(v[0], v[1]); *(u32x4*)(rp + 512) = pack8(v[2], v[3]);
        }
    }
}

__device__ __forceinline__ void route_batch(Frame& F, int bt) {
    LAS int* hist = (LAS int*)(F.lds); LAS int* base = hist + 64;
    const float* LG = (const float*)(F.ws + WS_LOGIT); int* rowtok = (int*)(F.ws + WS_ROWTOK); int* tslot = (int*)(F.ws + WS_TSLOT); float* topw = (float*)(F.ws + WS_TOPW);
    {
        __syncthreads();
        if (F.tid < 64) hist[F.tid] = 0;
        __syncthreads();
        const int tok = bt * 256 + F.tid, ch = (bt * 256) / CAPC;
        int idx[6], lr[6]; float w[6];
        if (F.tid < 256) {
            float lg[64];
#pragma unroll
            for (int j = 0; j < 16; ++j) { const f32x4 v = *(const f32x4*)(LG + (size_t)tok * 64 + 4 * j); lg[4 * j] = v[0]; lg[4 * j + 1] = v[1]; lg[4 * j + 2] = v[2]; lg[4 * j + 3] = v[3]; }
            route_token(lg, F.in[I_RB], idx, w);
#pragma unroll
            for (int k = 0; k < 6; ++k) lr[k] = atomicAdd((int*)&hist[idx[k]], 1);
        }
        __syncthreads();
        if (F.tid < 64) base[F.tid] = (int)__hip_atomic_fetch_add(F.ctl + CW_CNT + 64 * (ch * 65 + F.tid), (unsigned)hist[F.tid], __ATOMIC_RELAXED, __HIP_MEMORY_SCOPE_AGENT);
        __syncthreads();
        if (F.tid < 256) {
#pragma unroll
            for (int k = 0; k < 6; ++k) { const int slot = base[idx[k]] + lr[k];
                rowtok[(size_t)(ch * 64 + idx[k]) * CAPC + slot] = tok; tslot[(size_t)tok * 8 + k] = (idx[k] << 16) | slot; topw[(size_t)tok * 8 + k] = w[k]; }
        }
    }
}

__device__ __forceinline__ void p12_combine(Frame& F, int ch) {
    const int lane = fresh_lane();
    const MoeTab tb = moe_tab(F.lds); const int t0 = tb.tbase[ch * 65];
    const unsigned char* Y8 = F.ws + WS_Y; const bf16_t* YS = (const bf16_t*)(F.ws + WS_YS); const bf16_t* x1b = (const bf16_t*)(F.ws + WS_X1B);
    const int* tslot = (const int*)(F.ws + WS_TSLOT); const float* topw = (const float*)(F.ws + WS_TOPW);
    const float* g2 = F.in[I_LN2G]; const float* b2 = F.in[I_LN2B];
    f32x4 gg[4], bb[4];
#pragma unroll
    for (int j = 0; j < 4; ++j) { const int c = 8 * lane + (j >> 1) * 512 + (j & 1) * 4; gg[j] = *(const f32x4*)(g2 + c); bb[j] = *(const f32x4*)(b2 + c); }
    constexpr int NTK = 4;
    const int stride = F.G * 8;
    for (int tk0 = F.bid * 8 + F.wave; tk0 < CAPC; tk0 += NTK * stride) {
        int ts[NTK][6]; float tw[NTK][6];
#pragma unroll
        for (int t = 0; t < NTK; ++t) { const int tk = tk0 + t * stride < CAPC ? tk0 + t * stride : tk0; const size_t tok = (size_t)ch * CAPC + tk;
#pragma unroll
            for (int k = 0; k < 6; ++k) { ts[t][k] = tslot[tok * 8 + k]; tw[t][k] = topw[tok * 8 + k]; } }
        u32x4 xw[NTK][2], sw[NTK][2]; u32x2 yw[NTK][6][2];
#pragma unroll
        for (int t = 0; t < NTK; ++t) { const int tk = tk0 + t * stride < CAPC ? tk0 + t * stride : tk0; const size_t tok = (size_t)ch * CAPC + tk;
            const bf16_t* xr = x1b + tok * 1024 + 8 * lane; xw[t][0] = *(const u32x4*)xr; xw[t][1] = *(const u32x4*)(xr + 512);
            const bf16_t* yr = YS + (size_t)tk * 1024 + 8 * lane; sw[t][0] = *(const u32x4*)yr; sw[t][1] = *(const u32x4*)(yr + 512);
#pragma unroll
            for (int k = 0; k < 6; ++k) { const int yrow = (tb.tbase[ch * 65 + (ts[t][k] >> 16)] - t0) * 256 + (ts[t][k] & 0xffff);
                const unsigned char* y8 = Y8 + y8_off(yrow, 8 * lane); yw[t][k][0] = *(const u32x2*)y8; yw[t][k][1] = *(const u32x2*)(y8 + 512); } }
#pragma unroll
        for (int t = 0; t < NTK; ++t) {
            const int tk = tk0 + t * stride; if (tk >= CAPC) break;
            const size_t tok = (size_t)ch * CAPC + tk;
            f32x4 a[4]; unpack8(xw[t][0], a[0], a[1]); unpack8(xw[t][1], a[2], a[3]); a[0] *= ALPHA; a[1] *= ALPHA; a[2] *= ALPHA; a[3] *= ALPHA;
            { f32x4 y0, y1, y2, y3; unpack8(sw[t][0], y0, y1); unpack8(sw[t][1], y2, y3); a[0] += y0; a[1] += y1; a[2] += y2; a[3] += y3; }
#pragma unroll
            for (int k = 0; k < 6; ++k) { const float w = tw[t][k] * Y8_INV; f32x4 y0, y1, y2, y3; unpack8_fp8(yw[t][k][0], y0, y1); unpack8_fp8(yw[t][k][1], y2, y3);
                a[0] += y0 * w; a[1] += y1 * w; a[2] += y2 * w; a[3] += y3 * w; }
            float s = 0.f;
#pragma unroll
            for (int j = 0; j < 4; ++j) s += (a[j][0] + a[j][1]) + (a[j][2] + a[j][3]);
            const float mean = wave_sum(s) * (1.f / 1024.f); float q = 0.f;
#pragma unroll
            for (int j = 0; j < 4; ++j) { a[j] = a[j] - mean; q += (a[j][0] * a[j][0] + a[j][1] * a[j][1]) + (a[j][2] * a[j][2] + a[j][3] * a[j][3]); }
            const float rstd = __builtin_amdgcn_rsqf(wave_sum(q) * (1.f / 1024.f) + LN_EPS);
            float* orow = F.out + tok * 1024 + 8 * lane;
#pragma unroll
            for (int j = 0; j < 4; ++j) *(f32x4*)(orow + (j >> 1) * 512 + (j & 1) * 4) = a[j] * rstd * gg[j] + bb[j];
        }
    }
}
}

namespace fx {
constexpr int NPHASE = 11 + 2 * NCH;
struct Args { const float* in[29]; float* out; unsigned char* ws; int ph_lo, ph_hi; };

__global__ void __launch_bounds__(512, 2) fwd(Args args) {
    extern __shared__ __attribute__((aligned(16))) unsigned char lds_raw[];
    Frame F;
    F.lds = (LAS unsigned char*)lds_raw; F.ws = args.ws; F.ctl = (unsigned*)(args.ws + WS_CTL); F.out = args.out;
#pragma unroll
    for (int i = 0; i < 29; ++i) F.in[i] = args.in[i];
    F.tid = threadIdx.x; F.lane = F.tid & 63; F.wave = __builtin_amdgcn_readfirstlane(F.tid >> 6); F.G = gridDim.x; F.bid = blockIdx.x;
    volatile LAS unsigned* MISC = (volatile LAS unsigned*)(F.lds + MISC_OFF);
    if (F.tid < 32) MISC[F.tid] = 0u;
    __syncthreads();
    const int lo = args.ph_lo, hi = args.ph_hi;
    XcdBarrier bar; bar.bar = F.ctl + CW_BAR; bar.x = 0; bar.st = MISC + 8;
    if (hi - lo > 1) bar = xcd_barrier_post(F.ctl + CW_BAR, MISC + 8);
#ifndef PH_MASK
#define PH_MASK 0xFFFFFFFFu
#endif
#define IN(k) (((PH_MASK >> ((k) > 11 ? 11 + (((k) - 11) & 1) : (k))) & 1u) && lo <= (k) && (k) < hi)
#define SEAM(k) do { if (IN(k) && IN((k) + 1)) xcd_barrier(bar); if (MK_TPROBE >= 300 && blockIdx.x == 0 && threadIdx.x == 0) { const unsigned long long cn_ = __builtin_amdgcn_s_memtime(); \
        const unsigned long long cl_ = ((unsigned long long)MISC[25] << 32) | MISC[24]; if ((k) + 300 == MK_TPROBE) { const unsigned long long dc_ = cn_ - cl_; MISC[26] = (unsigned)dc_; MISC[27] = (unsigned)(dc_ >> 32); } MISC[24] = (unsigned)cn_; MISC[25] = (unsigned)(cn_ >> 32); } \
     if (MK_TPROBE >= 0 && blockIdx.x == 0 && threadIdx.x == 0) { const unsigned long long tn_ = __builtin_amdgcn_s_memrealtime(); \
        const unsigned long long tl_ = ((unsigned long long)MISC[17] << 32) | MISC[16]; if (((k) == MK_TPROBE && MK_TPROBE < 100) || (k) + 300 == MK_TPROBE) { const unsigned long long d_ = tn_ - tl_; MISC[18] = (unsigned)d_; MISC[19] = (unsigned)(d_ >> 32); } if (MK_TPROBE == 200 + (k)) { MISC[18] = MISC[22]; MISC[19] = MISC[23]; } MISC[22] = 0u; MISC[23] = 0u; MISC[16] = (unsigned)tn_; MISC[17] = (unsigned)(tn_ >> 32); } } while (0)
    unsigned char* ws = args.ws;
    bf16_t* UH = (bf16_t*)(ws + WS_UH); bf16_t* CQ = (bf16_t*)(ws + WS_CQ); bf16_t* CKVR = (bf16_t*)(ws + WS_CKVR); bf16_t* Qb = (bf16_t*)(ws + WS_Q); bf16_t* KVb = (bf16_t*)(ws + WS_KV);
    bf16_t* SPRE = (bf16_t*)(ws + WS_SPRE); bf16_t* MIX = (bf16_t*)(ws + WS_MIX);
    float* ssqq = (float*)(ws + WS_SSQQ); float* ssqkv = (float*)(ws + WS_SSQKV); const float* ropec = (const float*)(ws + WS_ROPE); const float* ropes = ropec + 2048 * 16;

    if (MK_TPROBE >= 0 && blockIdx.x == 0 && threadIdx.x == 0) { const unsigned long long tn_ = __builtin_amdgcn_s_memrealtime(); MISC[16] = (unsigned)tn_; MISC[17] = (unsigned)(tn_ >> 32); }
    if (MK_TPROBE == 500 && threadIdx.x == 0) __hip_atomic_store(F.ctl + CW_DBG + 64 + blockIdx.x, 1u + xb_xcc_id(), __ATOMIC_RELAXED, __HIP_MEMORY_SCOPE_AGENT);
    if (IN(0)) { p0_prologue<0>(F); } SEAM(0);
    if (IN(1)) {
        const bool conv_first = ((F.bid >> 3) & 1) != 0;
        if (conv_first) p0_prologue<1>(F);
        { PlainOrder S; S.init(ws + WS_XB, 1024, ws + WS_WIN, 1024, T, 1024, F.G, F.bid);
          EpiWin E{UH, CQ, CKVR, ssqq, ssqkv, ropec, ropes};
          gemm_phase<EpiWin, PlainOrder, true, false>(F.lds, 1024, 1024, 1024, S, E); }
        if (!conv_first) p0_prologue<1>(F);
    } SEAM(1);
    if (IN(2)) {
        { GroupOrder S; S.init(UH, ws + WS_WST, 512, 1, F.G, F.bid); EpiSt E{(bf16_t*)(ws + WS_S)};
          gemm_phase<EpiSt, GroupOrder, true, false>(F.lds, UHK, 512, 512, S, E);
          asm volatile("s_waitcnt vmcnt(0)" ::: "memory"); __syncthreads();
          Unit u; for (int i = 0; S.next(i, u); ++i) scan_unit(F, u.i0, u.i1); }
        mo_fill(F);
        { PlainOrder S; S.init(CQ, 256, ws + WS_WUQ, 256, T, 768, F.G, F.bid); EpiQ E{Qb, ssqq, ropec, ropes};
          gemm_phase<EpiQ, PlainOrder, true, false>(F.lds, 256, 256, 256, S, E); }
        { PlainOrder S; S.init(CKVR, 256, ws + WS_WUKV, 256, T, 1024, F.G, F.bid); EpiKV E{KVb, ssqkv};
          gemm_phase<EpiKV, PlainOrder, true, false>(F.lds, 256, 256, 256, S, E); }
    } SEAM(2);
    if (IN(4)) {
#ifndef SUB4
#define SUB4 3
#endif
        if (SUB4 & 2) REP(40) for (int i = 0;; ++i) { const long L = (long)i * F.G + F.bid; if (L >= 2048) break;
            const int un = xcd_remap((int)L, 2048), pair = un >> 3, qb = un & 7, b = pair >> 3, h = pair & 7;
            att::attn_unit(ws, Qb, MIX, b * SEQ, qb * 256, h, (char*)lds_raw); }
        if (SUB4 & 1) DUP2(4, { GroupOrder S; S.init(UH, ws + WS_MO, UHK, 2, F.G, F.bid); EpiSsmOut E{UH, SPRE, F.in[I_DSK]};
          gemm_phase<EpiSsmOut, GroupOrder, true, false>(F.lds, UHK, UHK, UHK, S, E); });
    } SEAM(4);
    if (IN(5)) {
        { PanelOrder S; S.init(SPRE, SPRE_LD, ws + WS_WGLU, 512, T, 512, F.G, F.bid); EpiGlu E{SPRE, MIX, F.in[I_BGLU]};
          gemm_phase<EpiGlu, PanelOrder, true, false>(F.lds, SPRE_LD, 512, 512, S, E); }
        asm volatile("s_waitcnt vmcnt(0)" ::: "memory"); __syncthreads();
        { PanelOrder S; S.init(MIX, 1024, ws + WS_WO, 1024, T, 1024, F.G, F.bid); EpiWo E{F.in[I_X], (bf16_t*)(ws + WS_X1B)};
          gemm_phase<EpiWo, PanelOrder, true, false>(F.lds, 1024, 1024, 1024, S, E); }
        asm volatile("s_waitcnt vmcnt(0)" ::: "memory"); __syncthreads();
        p7_ln1(F);
        asm volatile("s_waitcnt vmcnt(0)" ::: "memory"); __syncthreads();
        { PanelOrder S; S.init(ws + WS_X1B, 1024, ws + WS_WGU + (size_t)64 * 512 * 1024 * 2, 1024, T, 768, F.G, F.bid); EpiSharedRouter E{(bf16_t*)(ws + WS_HS), (float*)(ws + WS_LOGIT)};
          gemm_phase<EpiSharedRouter, PanelOrder, true, false>(F.lds, 1024, 1024, 1024, S, E);
          asm volatile("s_waitcnt vmcnt(0)" ::: "memory"); __syncthreads();
          Unit u; for (int i = 0; S.next(i, u); ++i) if (u.i1 == 2) route_batch(F, u.i0); }
    } SEAM(8);
    if (IN(10)) {
        moe_build_tab(F.lds, F.ctl);
        GateUpOrder S; S.init(F.lds, ws + WS_X1B, ws + WS_WGU, (const int*)(ws + WS_ROWTOK), F.ctl, 0, F.G, F.bid); EpiGateUp E{(bf16_t*)(ws + WS_H)};
        gemm_phase<EpiGateUp, GateUpOrder, true, true>(F.lds, 1024, 1024, 1024, S, E);
    } SEAM(10);
#pragma unroll
    for (int ch = 0; ch < NCH; ++ch) {
        if (IN(11 + 2 * ch)) {
            moe_build_tab(F.lds, F.ctl);
            { DownOrder S; S.init(ws + WS_H, ws + WS_HS, ws + WS_WD, moe_tab(F.lds), ch, F.G, F.bid); EpiDown E{ws + WS_Y, (bf16_t*)(ws + WS_YS)};
              gemm_phase<EpiDown, DownOrder, true, false, 0, 1>(F.lds, 256, 256, 256, S, E); }
            if (ch + 1 < NCH) { GateUpOrder S; S.init(F.lds, ws + WS_X1B, ws + WS_WGU, (const int*)(ws + WS_ROWTOK), F.ctl, ch + 1, F.G, F.bid); EpiGateUp E{(bf16_t*)(ws + WS_H)};
              gemm_phase<EpiGateUp, GateUpOrder, true, true>(F.lds, 1024, 1024, 1024, S, E); }
        } SEAM(11 + 2 * ch);
        if (IN(12 + 2 * ch)) { moe_build_tab(F.lds, F.ctl); p12_combine(F, ch); } SEAM(12 + 2 * ch);
    }
    if (MK_TPROBE == 500 && blockIdx.x == 0 && threadIdx.x == 0) { unsigned bad = 0; for (unsigned b = 8; b < gridDim.x; ++b) bad += __hip_atomic_load(F.ctl + CW_DBG + 64 + b, __ATOMIC_RELAXED, __HIP_MEMORY_SCOPE_AGENT) != __hip_atomic_load(F.ctl + CW_DBG + 64 + (b & 7u), __ATOMIC_RELAXED, __HIP_MEMORY_SCOPE_AGENT);
        const unsigned long long t0_ = __builtin_amdgcn_s_memrealtime(); if (bad) while (__builtin_amdgcn_s_memrealtime() - t0_ < 100000ull) __builtin_amdgcn_s_sleep(8); }
    if (MK_TPROBE >= 0 && MK_TPROBE != 500 && blockIdx.x == 0 && threadIdx.x == 0) { const unsigned long long d_ = ((unsigned long long)MISC[19] << 32) | MISC[18]; const unsigned long long t0_ = __builtin_amdgcn_s_memrealtime();
        unsigned long long wait_ = 8ull * d_; if (MK_TPROBE >= 300) { const unsigned long long dc_ = ((unsigned long long)MISC[27] << 32) | MISC[26]; wait_ = d_ ? (dc_ * 100ull / d_) * 100ull : 0ull; }
        while (__builtin_amdgcn_s_memrealtime() - t0_ < wait_) __builtin_amdgcn_s_sleep(8); }
#undef IN
#undef SEAM
}

#if MK_DEBUG
__global__ void dbg_cmp(int k, const unsigned char* ws, const float* out_fast, gold::Bufs B, const float* gx1, const float* gout, float* acc) {
    const int t = blockIdx.x;
    float num = 0.f, den = 0.f;
    auto bf = [](const bf16_t* p, size_t i) -> float { return __uint_as_float(((unsigned)p[i]) << 16); };
    int ncol = 0;
    switch (k) { case 0: ncol = 512; break; case 1: ncol = 256; break; case 2: ncol = 160; break; case 3: ncol = 768; break; case 4: ncol = 1024; break; case 5: ncol = 512; break; case 6: ncol = 512; break; case 7: ncol = 512; break; case 8: ncol = 1024; break; default: ncol = 1024; }
    for (int c = threadIdx.x; c < ncol; c += blockDim.x) {
        float f = 0.f, g = 0.f;
        if (k == 0) { const int gg = c >> 4, p = c & 15; f = bf((const bf16_t*)(ws + WS_UH), ((size_t)gg * UHR + (t >> 5)) * UHK + (t & 31) * 16 + p); g = B.proj[(size_t)t * 928 + c]; }
        else if (k == 1) { f = bf((const bf16_t*)(ws + WS_CQ), (size_t)t * 256 + c); g = B.proj[(size_t)t * 928 + 512 + c]; }
        else if (k == 2) { f = bf((const bf16_t*)(ws + WS_CKVR), (size_t)t * 256 + c); g = c < 128 ? B.proj[(size_t)t * 928 + 768 + c] : B.krope[(size_t)t * 32 + rope_perm_src(c - 128)]; }
        else if (k == 3) { const int hh = c / 96, jj = c % 96, src = jj < 64 ? c : hh * 96 + 64 + rope_perm_src(jj - 64); f = bf((const bf16_t*)(ws + WS_Q), (size_t)t * 768 + c); g = B.q[(size_t)t * 768 + src] * QSCALE; }
        else if (k == 4) { f = bf((const bf16_t*)(ws + WS_KV), (size_t)t * 1024 + c); g = B.kv[(size_t)t * 1024 + c]; }
        else if (k == 5) { f = bf((const bf16_t*)(ws + WS_SPRE), (size_t)t * SPRE_LD + c); g = B.spre[(size_t)t * 512 + c]; }
        else if (k == 6) { f = bf((const bf16_t*)(ws + WS_MIX), (size_t)t * 1024 + c); g = B.mix[(size_t)t * 1024 + c]; }
        else if (k == 7) { f = bf((const bf16_t*)(ws + WS_MIX), (size_t)t * 1024 + 512 + c); g = B.mix[(size_t)t * 1024 + 512 + c]; }
        else if (k == 8) { f = bf((const bf16_t*)(ws + WS_X1B), (size_t)t * 1024 + c); g = gx1[(size_t)t * 1024 + c]; }
        else { f = out_fast[(size_t)t * 1024 + c]; g = gout[(size_t)t * 1024 + c]; }
        const float d = f - g; num += d * d; den += g * g;
        if (!(fabsf(f) < 1e30f)) num += 1e30f;
    }
    num = wave_sum(num); den = wave_sum(den);
    if ((threadIdx.x & 63) == 0) { atomicAdd(acc + 2 * k, num); atomicAdd(acc + 2 * k + 1, den); }
}
__global__ void dbg_encode(const float* acc, float* out, int k0, int nk) {
    float c2 = 0.f;
    for (int k = k0; k < k0 + nk; ++k) { const float e = sqrtf(acc[2 * k] / fmaxf(acc[2 * k + 1], 1e-30f)); const float tol = (k == 9) ? 0.08f : 0.04f;
        if (!(e <= tol)) { const int bucket = !(e <= 0.5f) ? 0 : (e > 0.1f ? 1 : 2); c2 = (float)(k - k0 + 1) + 20.f * bucket; break; } }
    if (c2 == 0.f) { if (MK_DBG_NPH >= NPHASE) return; c2 = 90.f; }
    const float c = sqrtf(c2);
    for (size_t i = (size_t)blockIdx.x * blockDim.x + threadIdx.x; i < (size_t)T * 1024; i += (size_t)gridDim.x * blockDim.x) out[i] = c;
}
#endif
}

extern "C" void kernel_launch(void* const* d_in, const int* in_sizes, int n_in, void* d_out, int out_size, void* d_ws, size_t ws_size, hipStream_t stream) {
#if MK_MODE == 0
    gold::In I; const float** p = (const float**)&I;
    for (int i = 0; i < 29; ++i) p[i] = (const float*)d_in[i];
    for (int t0 = 0; t0 < 65536; t0 += 16384) gold::run(I, t0, 16384, (float*)d_ws, (float*)d_out + (size_t)t0 * 1024, (float*)d_out + (size_t)t0 * 1024, stream);
#else
    using namespace fx;
    static int grid = 0;
    if (grid == 0) {
        if (n_in != 29 || ws_size < WS_END) { fprintf(stderr, "kernel_launch: need 29 inputs and >= %zu bytes of workspace (got %d, %zu)\n", (size_t)WS_END, n_in, ws_size); grid = -1; return; }
        int dev = 0, cus = 0, per_cu = 0;
        hipGetDevice(&dev); hipDeviceGetAttribute(&cus, hipDeviceAttributeMultiprocessorCount, dev);
        if (hipFuncSetAttribute((const void*)fwd, hipFuncAttributeMaxDynamicSharedMemorySize, LDS_BYTES) != hipSuccess) { fprintf(stderr, "kernel_launch: hipFuncSetAttribute failed\n"); grid = -1; return; }
        if (hipOccupancyMaxActiveBlocksPerMultiprocessor(&per_cu, (const void*)fwd, 512, LDS_BYTES) != hipSuccess || per_cu < 1) { fprintf(stderr, "kernel_launch: occupancy query says %d\n", per_cu); }
        (void)hipGetLastError();
        grid = cus > 0 ? cus : 256;
    }
    if (grid < 0) return;
    hipMemsetAsync((char*)d_ws + WS_CTL, 0, CTL_BYTES, stream);
    Args a{};
    for (int i = 0; i < 29; ++i) a.in[i] = (const float*)d_in[i];
    a.out = (float*)d_out; a.ws = (unsigned char*)d_ws;
#if MK_MODE == 1
    for (int ph = 0; ph < NPHASE && ph < MK_DBG_NPH; ++ph) { a.ph_lo = ph; a.ph_hi = ph + 1; hipLaunchKernelGGL(fwd, dim3(grid), dim3(512), LDS_BYTES, stream, a); }
#else
    a.ph_lo = 0; a.ph_hi = NPHASE; hipLaunchKernelGGL(fwd, dim3(grid), dim3(512), LDS_BYTES, stream, a);
#endif
#if MK_DEBUG
    {
        gold::In I; const float** p = (const float**)&I;
        for (int i = 0; i < 29; ++i) p[i] = (const float*)d_in[i];
        float* gs = (float*)((char*)d_ws + WS_GOLD); float* gx1 = gs + (size_t)2048 * gold::GOLD_FLOATS_PER_TOK; float* gout = gx1 + (size_t)2048 * 1024;
        gold::Bufs B = gold::run(I, 0, 2048, gs, gx1, gout, stream);
        float* acc = (float*)((char*)d_ws + WS_CTL) + CW_DBG;
        for (int k = 0; k < 10; ++k) hipLaunchKernelGGL(dbg_cmp, dim3(2048), dim3(256), 0, stream, k, (const unsigned char*)d_ws, (const float*)d_out, B, (const float*)gx1, (const float*)gout, acc);
        hipLaunchKernelGGL(dbg_encode, dim3(1024), dim3(256), 0, stream, (const float*)acc, (float*)d_out, MK_DBG_K0, MK_DBG_NK);
    }
#endif
    const hipError_t le = hipPeekAtLastError();
    if (le != hipSuccess) fprintf(stderr, "kernel_launch: launch failed: %s\n", hipGetErrorName(le));
#endif
}
```

```cpp
#define MK_MODE 2
#include <hip/hip_runtime.h>
#include <cstdio>
#include <cstdint>
#include <cmath>
#ifndef MK_MODE
#define MK_MODE 1
#endif
#ifndef MK_DBG_NPH
#define MK_DBG_NPH 99
#endif
#ifndef MK_DBG_K0
#define MK_DBG_K0 0
#endif
#ifndef MK_DBG_NK
#define MK_DBG_NK 10
#endif
#ifndef MK_DUP
#define MK_DUP -1
#endif
#define REP(k) for (int rep_ = 0; rep_ < ((MK_DUP == (k)) ? 2 : 1); ++rep_)
#define DUP2(k, ...) do { __VA_ARGS__ if constexpr (MK_DUP == (k)) { __VA_ARGS__ } } while (0)
#ifndef MK_TPROBE
#define MK_TPROBE -1
#endif
#ifndef MK_STAG
#define MK_STAG 0
#endif
#ifndef MK_DEBUG
#define MK_DEBUG 0
#endif
namespace gold {
constexpr int D_MODEL = 1024, SEQ = 2048, D_SSM = 512, D_IN = 928, NH = 8, QLR = 256, KVLR = 128, ROPE = 32;
constexpr int NEXP = 64, TOPK = 6, DEXP = 256;
constexpr float ALPHA = 1.189207115002721f, LN_EPS = 1e-5f, RMS_EPS = 1e-6f, ATT_SCALE = 0.10206207261596577f;

__global__ void __launch_bounds__(256) sgemm(const float* __restrict__ A, int lda, const float* __restrict__ B, int ldb, float* __restrict__ C, int ldc, int M, int N, int K) {
    __shared__ float As[16][65];
    __shared__ float Bs[16][65];
    const int tid = threadIdx.x, tx = tid & 15, ty = tid >> 4;
    const int m0 = blockIdx.y * 64, n0 = blockIdx.x * 64;
    float acc[4][4];
#pragma unroll
    for (int i = 0; i < 4; ++i)
#pragma unroll
        for (int j = 0; j < 4; ++j) acc[i][j] = 0.f;
    for (int k0 = 0; k0 < K; k0 += 16) {
#pragma unroll
        for (int i = 0; i < 4; ++i) { const int idx = tid + 256 * i, r = idx >> 4, c = idx & 15; As[c][r] = A[(size_t)(m0 + r) * lda + k0 + c]; }
#pragma unroll
        for (int i = 0; i < 4; ++i) { const int idx = tid + 256 * i, r = idx >> 6, c = idx & 63; Bs[r][c] = (n0 + c < N) ? B[(size_t)(k0 + r) * ldb + n0 + c] : 0.f; }
        __syncthreads();
#pragma unroll
        for (int k = 0; k < 16; ++k) {
            float a[4], b[4];
#pragma unroll
            for (int i = 0; i < 4; ++i) a[i] = As[k][ty + 16 * i];
#pragma unroll
            for (int j = 0; j < 4; ++j) b[j] = Bs[k][tx + 16 * j];
#pragma unroll
            for (int i = 0; i < 4; ++i)
#pragma unroll
                for (int j = 0; j < 4; ++j) acc[i][j] = fmaf(a[i], b[j], acc[i][j]);
        }
        __syncthreads();
    }
#pragma unroll
    for (int i = 0; i < 4; ++i)
#pragma unroll
        for (int j = 0; j < 4; ++j) { const int c = n0 + tx + 16 * j; if (c < N) C[(size_t)(m0 + ty + 16 * i) * ldc + c] = acc[i][j]; }
}

__device__ __forceinline__ float gelu_tanh(float x) {
    const float z = 0.7978845608028654f * (x + 0.044715f * x * x * x);
    const float e = __expf(2.f * z);
    const float th = 1.f - 2.f / (1.f + e);
    return 0.5f * x * (1.f + th);
}
__device__ __forceinline__ float sigmoidf_(float x) { return 1.f / (1.f + __expf(-x)); }

struct SsmPar { float ar, ai, kr, ki; };
__device__ __forceinline__ SsmPar ssm_par(const float* lam_re, const float* lam_im, const float* log_dt, int d, int g, int n) {
    const float lr = fminf(lam_re[(d * 32 + g) * 64 + n], -1e-4f), li = lam_im[(d * 32 + g) * 64 + n];
    const float dt = expf(log_dt[d * 32 + g]);
    const float x = lr * dt, th = li * dt;
    const float em1 = expm1f(x), cs = cosf(th), sn = sinf(th), sh = sinf(0.5f * th);
    const float mag = em1 + 1.f;
    SsmPar p; p.ar = mag * cs; p.ai = mag * sn;
    const float arm1 = em1 * cs - 2.f * sh * sh;
    const float den = lr * lr + li * li;
    p.kr = (arm1 * lr + p.ai * li) / den; p.ki = (p.ai * lr - arm1 * li) / den;
    return p;
}

__global__ void __launch_bounds__(64) ssm_naive(const float* __restrict__ proj, int ldp, const float* __restrict__ lam_re, const float* __restrict__ lam_im, const float* __restrict__ log_dt,
                                                const float* __restrict__ b_re, const float* __restrict__ b_im, const float* __restrict__ c_re, const float* __restrict__ c_im,
                                                const float* __restrict__ d_skip, float* __restrict__ spre) {
    const int g = blockIdx.x, b = blockIdx.y, n = threadIdx.x;
    for (int d = 0; d < 2; ++d) {
        const SsmPar P = ssm_par(lam_re, lam_im, log_dt, d, g, n);
        float Br[16], Bi[16], Cr[16], Ci[16];
#pragma unroll
        for (int q = 0; q < 16; ++q) { const float br = b_re[((d * 32 + g) * 64 + n) * 16 + q], bi = b_im[((d * 32 + g) * 64 + n) * 16 + q];
            Br[q] = P.kr * br - P.ki * bi; Bi[q] = P.kr * bi + P.ki * br;
            Cr[q] = c_re[((d * 32 + g) * 16 + q) * 64 + n]; Ci[q] = c_im[((d * 32 + g) * 16 + q) * 64 + n]; }
        float hr = 0.f, hi = 0.f;
        for (int step = 0; step < SEQ; ++step) {
            const int t = d ? (SEQ - 1 - step) : step;
            const float* up = proj + (size_t)(b * SEQ + t) * ldp + g * 16;
            float u[16];
#pragma unroll
            for (int q = 0; q < 16; ++q) u[q] = up[q];
            float bur = 0.f, bui = 0.f;
#pragma unroll
            for (int q = 0; q < 16; ++q) { bur = fmaf(Br[q], u[q], bur); bui = fmaf(Bi[q], u[q], bui); }
            const float nr = P.ar * hr - P.ai * hi + bur, ni = P.ar * hi + P.ai * hr + bui;
            hr = nr; hi = ni;
            float y[16];
#pragma unroll
            for (int p = 0; p < 16; ++p) y[p] = Cr[p] * hr - Ci[p] * hi;
#pragma unroll
            for (int o = 1; o < 64; o <<= 1)
#pragma unroll
                for (int p = 0; p < 16; ++p) y[p] += __shfl_xor(y[p], o);
            if (n < 16) {
                float v = 0.f;
#pragma unroll
                for (int p = 0; p < 16; ++p) if (p == n) v = y[p];
                float* o = spre + (size_t)(b * SEQ + t) * 512 + g * 16 + n;
                if (d == 0) *o = v;
                else { float uu = 0.f;
#pragma unroll
                    for (int p = 0; p < 16; ++p) if (p == n) uu = u[p];
                    *o = gelu_tanh(*o + v + uu * d_skip[g * 16 + n]); }
            }
        }
    }
}
__global__ void glu_ew(const float* __restrict__ spre, const float* __restrict__ gl, const float* __restrict__ bglu, float* __restrict__ mix, int ntok) {
    const size_t i = (size_t)blockIdx.x * 256 + threadIdx.x; if (i >= (size_t)ntok * 512) return;
    const int c = (int)(i & 511); const size_t r = i >> 9;
    mix[r * 1024 + c] = spre[i] * sigmoidf_(gl[i] + bglu[c]);
}
__global__ void rmsnorm_rows(const float* __restrict__ in, int ld, int off, int n, const float* __restrict__ g, float* __restrict__ out, int ntok) {
    const int r = blockIdx.x * 256 + threadIdx.x; if (r >= ntok) return;
    const float* p = in + (size_t)r * ld + off; float s = 0.f;
    for (int j = 0; j < n; ++j) s = fmaf(p[j], p[j], s);
    const float rs = rsqrtf(s / n + RMS_EPS);
    for (int j = 0; j < n; ++j) out[(size_t)r * n + j] = p[j] * rs * g[j];
}
__device__ __forceinline__ void rope_cs(int pos, int i, float& c, float& s) {
    const float inv = expf(-9.210340371976184f * (float)i * (1.f / 16.f));
    const float a = (float)pos * inv; c = cosf(a); s = sinf(a);
}
__global__ void rope_ew(float* __restrict__ q, const float* __restrict__ proj, int ldp, float* __restrict__ krope, int ntok) {
    const int idx = blockIdx.x * 256 + threadIdx.x; if (idx >= ntok * 9 * 16) return;
    const int i = idx & 15, hh = (idx >> 4) % 9, r = idx / 144, pos = r % SEQ;
    float c, s; rope_cs(pos, i, c, s);
    if (hh < 8) { float* p = q + (size_t)r * 768 + hh * 96 + 64; const float t1 = p[i], t2 = p[i + 16]; p[i] = t1 * c - t2 * s; p[i + 16] = t1 * s + t2 * c; }
    else { const float* p = proj + (size_t)r * ldp + 896; const float t1 = p[i], t2 = p[i + 16]; krope[(size_t)r * 32 + i] = t1 * c - t2 * s; krope[(size_t)r * 32 + i + 16] = t1 * s + t2 * c; }
}
__global__ void __launch_bounds__(64) attn_naive(const float* __restrict__ q, const float* __restrict__ kv, const float* __restrict__ krope, float* __restrict__ mix) {
    const int qi = blockIdx.x * 64 + threadIdx.x, h = blockIdx.y, b = blockIdx.z;
    const size_t r = (size_t)b * SEQ + qi;
    float qv[96], o[64];
#pragma unroll
    for (int d = 0; d < 96; ++d) qv[d] = q[r * 768 + h * 96 + d] * ATT_SCALE;
#pragma unroll
    for (int d = 0; d < 64; ++d) o[d] = 0.f;
    float m = -1e30f, l = 0.f;
    for (int s = 0; s < SEQ; ++s) {
        const size_t kr = (size_t)b * SEQ + s;
        const float4* kn = (const float4*)(kv + kr * 1024 + h * 128);
        const float4* kp = (const float4*)(krope + kr * 32);
        float sc = 0.f;
#pragma unroll
        for (int d = 0; d < 16; ++d) { const float4 k4 = kn[d]; sc = fmaf(qv[4 * d], k4.x, sc); sc = fmaf(qv[4 * d + 1], k4.y, sc); sc = fmaf(qv[4 * d + 2], k4.z, sc); sc = fmaf(qv[4 * d + 3], k4.w, sc); }
#pragma unroll
        for (int d = 0; d < 8; ++d) { const float4 k4 = kp[d]; sc = fmaf(qv[64 + 4 * d], k4.x, sc); sc = fmaf(qv[64 + 4 * d + 1], k4.y, sc); sc = fmaf(qv[64 + 4 * d + 2], k4.z, sc); sc = fmaf(qv[64 + 4 * d + 3], k4.w, sc); }
        const float mn = fmaxf(m, sc), al = __expf(m - mn), p = __expf(sc - mn);
        l = l * al + p; m = mn;
        const float4* vp = (const float4*)(kv + kr * 1024 + h * 128 + 64);
#pragma unroll
        for (int d = 0; d < 16; ++d) { const float4 v4 = vp[d]; o[4 * d] = fmaf(o[4 * d], al, p * v4.x); o[4 * d + 1] = fmaf(o[4 * d + 1], al, p * v4.y); o[4 * d + 2] = fmaf(o[4 * d + 2], al, p * v4.z); o[4 * d + 3] = fmaf(o[4 * d + 3], al, p * v4.w); }
    }
    const float il = 1.f / l;
#pragma unroll
    for (int d = 0; d < 64; ++d) mix[r * 1024 + 512 + h * 64 + d] = o[d] * il;
}
__device__ __forceinline__ float wsum(float v) {
#pragma unroll
    for (int o = 1; o < 64; o <<= 1) v += __shfl_xor(v, o);
    return v;
}
__global__ void __launch_bounds__(256) ln1_rows(const float* __restrict__ x, const float* __restrict__ mixo, const float* __restrict__ g, const float* __restrict__ bb, float* __restrict__ x1, int ntok) {
    const int r = blockIdx.x * 4 + (threadIdx.x >> 6), lane = threadIdx.x & 63; if (r >= ntok) return;
    float v[16]; float s = 0.f;
#pragma unroll
    for (int j = 0; j < 16; ++j) { const int c = lane + 64 * j; v[j] = ALPHA * x[(size_t)r * 1024 + c] + mixo[(size_t)r * 1024 + c]; s += v[j]; }
    const float mean = wsum(s) * (1.f / 1024.f); float q = 0.f;
#pragma unroll
    for (int j = 0; j < 16; ++j) { v[j] -= mean; q = fmaf(v[j], v[j], q); }
    const float rstd = rsqrtf(wsum(q) * (1.f / 1024.f) + LN_EPS);
#pragma unroll
    for (int j = 0; j < 16; ++j) { const int c = lane + 64 * j; x1[(size_t)r * 1024 + c] = v[j] * rstd * g[c] + bb[c]; }
}
}

__device__ __forceinline__ void route_token(const float (&lg)[64], const float* __restrict__ rbias, int (&idx)[6], float (&w)[6]) {
    float sc[64], ch[64];
#pragma unroll
    for (int j = 0; j < 64; ++j) { sc[j] = 1.f / (1.f + __expf(-lg[j])); ch[j] = sc[j] + rbias[j]; }
    float gs[8];
#pragma unroll
    for (int g = 0; g < 8; ++g) { float m1 = -INFINITY, m2 = -INFINITY;
#pragma unroll
        for (int j = 0; j < 8; ++j) { const float v = ch[g * 8 + j]; if (v > m1) { m2 = m1; m1 = v; } else if (v > m2) m2 = v; }
        gs[g] = m1 + m2; }
    bool sel[8];
#pragma unroll
    for (int g = 0; g < 8; ++g) { int rank = 0;
#pragma unroll
        for (int o = 0; o < 8; ++o) { if (o != g && (gs[o] > gs[g] || (gs[o] == gs[g] && o < g))) ++rank; }
        sel[g] = rank < 4; }
#pragma unroll
    for (int j = 0; j < 64; ++j) if (!sel[j >> 3]) ch[j] = -INFINITY;
    float wsum_ = 0.f;
#pragma unroll
    for (int k = 0; k < 6; ++k) { float best = -INFINITY; int bi = 0;
#pragma unroll
        for (int j = 0; j < 64; ++j) if (ch[j] > best) { best = ch[j]; bi = j; }
        float sv = 0.f;
#pragma unroll
        for (int j = 0; j < 64; ++j) if (j == bi) { sv = sc[j]; ch[j] = -INFINITY; }
        idx[k] = bi; w[k] = sv; wsum_ += sv; }
    const float inv = 2.5f / (wsum_ + 1e-20f);
#pragma unroll
    for (int k = 0; k < 6; ++k) w[k] *= inv;
}

namespace gold {
__global__ void __launch_bounds__(64) route_rows(const float* __restrict__ logits, const float* __restrict__ rbias, int* __restrict__ topi, float* __restrict__ topw, int ntok) {
    const int r = blockIdx.x * 64 + threadIdx.x; if (r >= ntok) return;
    float lg[64];
#pragma unroll
    for (int j = 0; j < 16; ++j) { const float4 v = ((const float4*)(logits + (size_t)r * 64))[j]; lg[4 * j] = v.x; lg[4 * j + 1] = v.y; lg[4 * j + 2] = v.z; lg[4 * j + 3] = v.w; }
    int idx[6]; float w[6]; route_token(lg, rbias, idx, w);
#pragma unroll
    for (int k = 0; k < 6; ++k) { topi[(size_t)r * 6 + k] = idx[k]; topw[(size_t)r * 6 + k] = w[k]; }
}
__global__ void __launch_bounds__(256) moe_naive(const float* x1, const int* __restrict__ topi, const float* __restrict__ topw,
                                                  const float* __restrict__ weg, const float* __restrict__ weu, const float* __restrict__ wed,
                                                  const float* __restrict__ wsg, const float* __restrict__ wsu, const float* __restrict__ wsd,
                                                  const float* __restrict__ g2, const float* __restrict__ b2, float* out) {
    __shared__ float xs[1024]; __shared__ float hs[256]; __shared__ float red[8];
    const int r = blockIdx.x, tid = threadIdx.x;
#pragma unroll
    for (int j = 0; j < 4; ++j) xs[tid + 256 * j] = x1[(size_t)r * 1024 + tid + 256 * j];
    __syncthreads();
    float acc[4] = {0.f, 0.f, 0.f, 0.f};
    for (int ei = 0; ei < 7; ++ei) {
        const int e = ei < 6 ? topi[(size_t)r * 6 + ei] : 0; const float w = ei < 6 ? topw[(size_t)r * 6 + ei] : 1.f;
        const float* Wg = ei < 6 ? weg + (size_t)e * 1024 * 256 : wsg; const float* Wu = ei < 6 ? weu + (size_t)e * 1024 * 256 : wsu; const float* Wd = ei < 6 ? wed + (size_t)e * 256 * 1024 : wsd;
        float gg = 0.f, uu = 0.f;
        for (int k = 0; k < 1024; ++k) { const float xv = xs[k]; gg = fmaf(xv, Wg[(size_t)k * 256 + tid], gg); uu = fmaf(xv, Wu[(size_t)k * 256 + tid], uu); }
        hs[tid] = gg / (1.f + __expf(-gg)) * uu;
        __syncthreads();
        float y[4] = {0.f, 0.f, 0.f, 0.f};
        for (int i = 0; i < 256; ++i) { const float hv = hs[i];
#pragma unroll
            for (int j = 0; j < 4; ++j) y[j] = fmaf(hv, Wd[(size_t)i * 1024 + tid + 256 * j], y[j]); }
#pragma unroll
        for (int j = 0; j < 4; ++j) acc[j] = fmaf(w, y[j], acc[j]);
        __syncthreads();
    }
    float v[4]; float s = 0.f;
#pragma unroll
    for (int j = 0; j < 4; ++j) { v[j] = ALPHA * xs[tid + 256 * j] + acc[j]; s += v[j]; }
    s = wsum(s); if ((tid & 63) == 0) red[tid >> 6] = s; __syncthreads();
    const float mean = (red[0] + red[1] + red[2] + red[3]) * (1.f / 1024.f); float q = 0.f;
#pragma unroll
    for (int j = 0; j < 4; ++j) { v[j] -= mean; q = fmaf(v[j], v[j], q); }
    q = wsum(q); if ((tid & 63) == 0) red[4 + (tid >> 6)] = q; __syncthreads();
    const float rstd = rsqrtf((red[4] + red[5] + red[6] + red[7]) * (1.f / 1024.f) + LN_EPS);
#pragma unroll
    for (int j = 0; j < 4; ++j) { const int c = tid + 256 * j; out[(size_t)r * 1024 + c] = v[j] * rstd * g2[c] + b2[c]; }
}

struct In {
    const float *x, *w_in, *lam_re, *lam_im, *log_dt, *b_re, *b_im, *c_re, *c_im, *d_skip, *w_glu, *b_glu, *q_norm_g, *w_uq, *kv_norm_g, *w_ukv, *w_o, *ln1_g, *ln1_b,
                *w_router, *router_bias, *we_gate, *we_up, *we_down, *ws_gate, *ws_up, *ws_down, *ln2_g, *ln2_b;
};
constexpr size_t GOLD_FLOATS_PER_TOK = 6400;
struct Bufs { float *proj, *spre, *gl, *mix, *cqn, *ckvn, *q, *kv, *krope, *mixo, *logits; int* topi; float* topw; };
static Bufs run(const In& I, int tok0, int ntok, float* scratch, float* x1out, float* out, hipStream_t st) {
    Bufs B;
    B.proj = scratch; B.spre = B.proj + (size_t)ntok * 928; B.gl = B.spre + (size_t)ntok * 512; B.mix = B.gl + (size_t)ntok * 512;
    B.cqn = B.mix + (size_t)ntok * 1024; B.ckvn = B.cqn + (size_t)ntok * 256; B.q = B.ckvn + (size_t)ntok * 128; B.kv = B.q + (size_t)ntok * 768;
    B.krope = B.kv + (size_t)ntok * 1024; B.mixo = B.krope + (size_t)ntok * 32; B.logits = B.mixo + (size_t)ntok * 1024;
    B.topi = (int*)(B.logits + (size_t)ntok * 64); B.topw = (float*)(B.topi + (size_t)ntok * 6);
    float *proj = B.proj, *spre = B.spre, *gl = B.gl, *mix = B.mix, *cqn = B.cqn, *ckvn = B.ckvn, *q = B.q, *kv = B.kv, *krope = B.krope, *mixo = B.mixo, *logits = B.logits; int* topi = B.topi; float* topw = B.topw;
    const float* x = I.x + (size_t)tok0 * 1024; const int nb = ntok / SEQ;
    hipLaunchKernelGGL(sgemm, dim3((928 + 63) / 64, ntok / 64), dim3(256), 0, st, x, 1024, I.w_in, 928, proj, 928, ntok, 928, 1024);
    hipLaunchKernelGGL(ssm_naive, dim3(32, nb), dim3(64), 0, st, proj, 928, I.lam_re, I.lam_im, I.log_dt, I.b_re, I.b_im, I.c_re, I.c_im, I.d_skip, spre);
    hipLaunchKernelGGL(sgemm, dim3(8, ntok / 64), dim3(256), 0, st, spre, 512, I.w_glu, 512, gl, 512, ntok, 512, 512);
    hipLaunchKernelGGL(glu_ew, dim3((unsigned)(((size_t)ntok * 512 + 255) / 256)), dim3(256), 0, st, spre, gl, I.b_glu, mix, ntok);
    hipLaunchKernelGGL(rmsnorm_rows, dim3((ntok + 255) / 256), dim3(256), 0, st, proj, 928, 512, 256, I.q_norm_g, cqn, ntok);
    hipLaunchKernelGGL(rmsnorm_rows, dim3((ntok + 255) / 256), dim3(256), 0, st, proj, 928, 768, 128, I.kv_norm_g, ckvn, ntok);
    hipLaunchKernelGGL(sgemm, dim3(12, ntok / 64), dim3(256), 0, st, cqn, 256, I.w_uq, 768, q, 768, ntok, 768, 256);
    hipLaunchKernelGGL(sgemm, dim3(16, ntok / 64), dim3(256), 0, st, ckvn, 128, I.w_ukv, 1024, kv, 1024, ntok, 1024, 128);
    hipLaunchKernelGGL(rope_ew, dim3((ntok * 144 + 255) / 256), dim3(256), 0, st, q, proj, 928, krope, ntok);
    hipLaunchKernelGGL(attn_naive, dim3(SEQ / 64, 8, nb), dim3(64), 0, st, q, kv, krope, mix);
    hipLaunchKernelGGL(sgemm, dim3(16, ntok / 64), dim3(256), 0, st, mix, 1024, I.w_o, 1024, mixo, 1024, ntok, 1024, 1024);
    hipLaunchKernelGGL(ln1_rows, dim3(ntok / 4), dim3(256), 0, st, x, mixo, I.ln1_g, I.ln1_b, x1out, ntok);
    hipLaunchKernelGGL(sgemm, dim3(1, ntok / 64), dim3(256), 0, st, x1out, 1024, I.w_router, 64, logits, 64, ntok, 64, 1024);
    hipLaunchKernelGGL(route_rows, dim3(ntok / 64), dim3(64), 0, st, logits, I.router_bias, topi, topw, ntok);
    hipLaunchKernelGGL(moe_naive, dim3(ntok), dim3(256), 0, st, x1out, topi, topw, I.we_gate, I.we_up, I.we_down, I.ws_gate, I.ws_up, I.ws_down, I.ln2_g, I.ln2_b, out);
    return B;
}
}
#define GAS __attribute__((address_space(1)))
#define LAS __attribute__((address_space(3)))
typedef unsigned short bf16_t;
typedef short bf16x8 __attribute__((ext_vector_type(8)));
typedef short s16x4 __attribute__((ext_vector_type(4)));
typedef float f32x4 __attribute__((ext_vector_type(4)));
typedef float f32x2 __attribute__((ext_vector_type(2)));
typedef float f32x16 __attribute__((ext_vector_type(16)));
typedef unsigned u32x4 __attribute__((ext_vector_type(4)));
typedef unsigned u32x2 __attribute__((ext_vector_type(2)));

namespace fx {
constexpr int T = 65536, SEQ = 2048, DM = 1024, NB = 32;
constexpr int CHK = 32;
constexpr int NCHK = SEQ / CHK;
constexpr int UHR = NB * NCHK;
constexpr int UHK = CHK * 16 + 256;
constexpr int Y8_LD = 1024;
constexpr int SPRE_LD = 512;
constexpr int NCH = 2;
constexpr int CAPC = T / NCH;
constexpr int NVE = NCH * 65;
constexpr float ALPHA = 1.189207115002721f, LN_EPS = 1e-5f, RMS_EPS = 1e-6f;
constexpr float QSCALE = 0.10206207261596577f * 1.4426950408889634f;

constexpr size_t MiB = 1u << 20;
constexpr size_t WS_CTL = 0, CTL_BYTES = 1 * MiB;
constexpr size_t WS_ROPE = 1 * MiB;
constexpr size_t WS_KT = 2 * MiB;
constexpr size_t WS_WIN = 4 * MiB, WS_WGLU = 6 * MiB, WS_WUQ = 6 * MiB + 512 * 1024, WS_WUKV = 7 * MiB, WS_WO = 8 * MiB;
constexpr size_t WS_WST = 10 * MiB, WS_MO = 18 * MiB, WS_WGU = 42 * MiB  , WS_WR = 107 * MiB  , WS_WD = 107 * MiB + 512 * 1024;
constexpr size_t WS_SSQQ = 140 * MiB, WS_SSQKV = 141 * MiB, WS_TSLOT = 142 * MiB, WS_TOPW = 144 * MiB, WS_ROWTOK = 146 * MiB, WS_LOGIT = 162 * MiB;
constexpr size_t WS_XB = 178 * MiB, WS_UH = 306 * MiB, WS_CQ = 402 * MiB, WS_CKVR = 434 * MiB, WS_S = 466 * MiB, WS_Q = 530 * MiB, WS_KV = 626 * MiB, WS_SPRE = 754 * MiB, WS_MIX = 818 * MiB;
constexpr size_t WS_X1B = 178 * MiB, WS_H = 306 * MiB, WS_Y = 562 * MiB  , WS_YS = 800 * MiB  , WS_HS = 864 * MiB  ;
constexpr size_t WS_GOLD = 946 * MiB, WS_END = 1024 * MiB;
constexpr int CW_TMO = 0, CW_CODE = 1, CW_BAR = 4096, CW_CNT = 16384  , CW_DBG = 65536  ;

constexpr int RING_BYTES = 131072, TAB_OFF = RING_BYTES, IDX_OFF = TAB_OFF + 10752  , IDX_UNITS = 16, MISC_OFF = IDX_OFF + IDX_UNITS * 1024, LDS_BYTES = MISC_OFF + 256;

__device__ __forceinline__ unsigned cvt_pk_bf16(float lo, float hi) { unsigned r; asm volatile("v_cvt_pk_bf16_f32 %0, %1, %2" : "=v"(r) : "v"(lo), "v"(hi)); return r; }
__device__ __forceinline__ float bf_lo(unsigned w) { return __uint_as_float(w << 16); }
__device__ __forceinline__ float bf_hi(unsigned w) { return __uint_as_float(w & 0xffff0000u); }
__device__ __forceinline__ u32x4 pack8(const f32x4 a, const f32x4 b) { u32x4 w; w.x = cvt_pk_bf16(a[0], a[1]); w.y = cvt_pk_bf16(a[2], a[3]); w.z = cvt_pk_bf16(b[0], b[1]); w.w = cvt_pk_bf16(b[2], b[3]); return w; }
__device__ __forceinline__ void unpack8(const u32x4 w, f32x4& a, f32x4& b) { a = (f32x4){bf_lo(w.x), bf_hi(w.x), bf_lo(w.y), bf_hi(w.y)}; b = (f32x4){bf_lo(w.z), bf_hi(w.z), bf_lo(w.w), bf_hi(w.w)}; }
__device__ __forceinline__ float fast_sigmoid(float x) { return __builtin_amdgcn_rcpf(1.f + __builtin_amdgcn_exp2f(-1.4426950408889634f * x)); }
__device__ __forceinline__ float gelu_tanh_f(float x) {
    const float z2 = 1.5957691216057308f * (x + 0.044715f * x * x * x);
    return x * fast_sigmoid(z2);
}
#ifndef SC1_STORES
#define SC1_STORES 0
#endif
__device__ __forceinline__ void store16(void* p, const u32x4 v) {
#if SC1_STORES
    asm volatile("global_store_dwordx4 %0, %1, off sc1\n\ts_nop 1" :: "v"(p), "v"(v) : "memory");
#else
    *(u32x4*)p = v;
#endif
}
__device__ __forceinline__ u32x4 ror8_x4(const u32x4 v) { u32x4 r;
    r.x = (unsigned)__builtin_amdgcn_update_dpp(0, (int)v.x, 0x128, 0xF, 0xF, false); r.y = (unsigned)__builtin_amdgcn_update_dpp(0, (int)v.y, 0x128, 0xF, 0xF, false);
    r.z = (unsigned)__builtin_amdgcn_update_dpp(0, (int)v.z, 0x128, 0xF, 0xF, false); r.w = (unsigned)__builtin_amdgcn_update_dpp(0, (int)v.w, 0x128, 0xF, 0xF, false); return r; }
__device__ __forceinline__ void store_lines16(bf16_t* rowp, size_t ld, const u32x4 X, const u32x4 Y, int fr, int fq) {
    const bool lo = fr < 8; const u32x4 S = lo ? Y : X, R = ror8_x4(S);
    const u32x4 A1 = lo ? X : R, A2 = lo ? R : Y;
    bf16_t* p = rowp + (size_t)(fr & 7) * ld + (lo ? 8 * fq : 32 + 8 * fq);
    *(u32x4*)p = A1; *(u32x4*)(p + 8 * ld) = A2;
}
__device__ __forceinline__ float wave_sum(float v) {
#pragma unroll
    for (int o = 1; o < 64; o <<= 1) v += __shfl_xor(v, o);
    return v;
}

#define XB_TMO      128
#define XB_XCNT(j)  (256  + 64 * (j))
#define XB_XSUB(j)  (1280 + 64 * (j))
#define XB_XGEN(j)  (2304 + 64 * (j))
#define XB_TOP      3328
#define XB_TOPGEN   3392
#define XCD_BAR_WORDS 3456
#define XB_SPIN_CAP (1u << 18)
__device__ __forceinline__ unsigned xb_ld(unsigned* p)              { return __hip_atomic_load(p, __ATOMIC_RELAXED, __HIP_MEMORY_SCOPE_AGENT); }
__device__ __forceinline__ unsigned xb_add(unsigned* p, unsigned v) { return __hip_atomic_fetch_add(p, v, __ATOMIC_RELAXED, __HIP_MEMORY_SCOPE_AGENT); }
__device__ __forceinline__ unsigned xb_xcc_id() { return (unsigned)__builtin_amdgcn_s_getreg((3 << 11) | 20) & 0xFu; }
#define XB_SPIN(cond, bar) do { unsigned _sp = 0; while (cond) { __builtin_amdgcn_s_sleep(1); \
    if ((++_sp & 255u) == 0u) { if (xb_ld(&(bar)[XB_TMO])) break; if (_sp > XB_SPIN_CAP) { atomicAdd(&(bar)[XB_TMO], 1u); break; } } } } while (0)
struct XcdBarrier { unsigned* bar; unsigned x; volatile LAS unsigned* st; };
__device__ __forceinline__ XcdBarrier xcd_barrier_post(unsigned* bar, volatile LAS unsigned* st) {
    XcdBarrier b; b.bar = bar; b.x = xb_xcc_id(); b.st = st;
    if (threadIdx.x == 0) (void)xb_add(&bar[XB_XCNT(b.x)], 1u);
    return b;
}
__device__ __forceinline__ void xcd_barrier_complete(unsigned* bar, unsigned x, unsigned& nloc, unsigned& nx) {
    const unsigned G = gridDim.x * gridDim.y * gridDim.z;
    unsigned sum, cnt, mine, sp = 0u;
    for (;;) {
        sum = 0u; cnt = 0u; mine = 0u;
#pragma unroll
        for (unsigned j = 0; j < 16; ++j) { const unsigned c = xb_ld(&bar[XB_XCNT(j)]); sum += c; cnt += (c > 0u) ? 1u : 0u; mine = (j == x) ? c : mine; }
        if (sum == G) break;
        __builtin_amdgcn_s_sleep(1);
        if ((++sp & 255u) == 0u) { if (xb_ld(&bar[XB_TMO])) break; if (sp > XB_SPIN_CAP) { atomicAdd(&bar[XB_TMO], 1u); break; } }
    }
    nloc = mine > 0u ? mine : 1u; nx = cnt > 0u ? cnt : 1u;
}
__device__ __forceinline__ void xcd_barrier(const XcdBarrier& b) {
    asm volatile("s_waitcnt vmcnt(0)" ::: "memory");
    __syncthreads();
    if (threadIdx.x == 0) {
        unsigned* bar = b.bar;
        __builtin_amdgcn_s_waitcnt(0);
        unsigned nloc = b.st[0], nx = b.st[1];
        if (nloc == 0u) { xcd_barrier_complete(bar, b.x, nloc, nx); b.st[0] = nloc; b.st[1] = nx; }
        const unsigned old = xb_add(&bar[XB_XSUB(b.x)], 1u);
        const unsigned gen = old / nloc;
        if (old + 1u == (gen + 1u) * nloc) {
            __builtin_amdgcn_fence(__ATOMIC_RELEASE, "agent");
            asm volatile("s_waitcnt vmcnt(0)" ::: "memory");
            const unsigned og = xb_add(&bar[XB_TOP], 1u);
            const unsigned tg = og / nx;
            if (og + 1u == (tg + 1u) * nx) xb_add(&bar[XB_TOPGEN], 1u);
            else XB_SPIN(xb_ld(&bar[XB_TOPGEN]) == tg, bar);
            __builtin_amdgcn_fence(__ATOMIC_ACQUIRE, "agent");
            xb_add(&bar[XB_XGEN(b.x)], 1u);
            asm volatile("s_waitcnt vmcnt(0)" ::: "memory");
        } else {
            XB_SPIN(xb_ld(&bar[XB_XGEN(b.x)]) == gen, bar);
            __builtin_amdgcn_fence(__ATOMIC_ACQUIRE, "agent");
            asm volatile("s_waitcnt vmcnt(0)" ::: "memory");
        }
    }
    __syncthreads();
}

constexpr int BM = 256, BK = 64, HALF = 128, HTB = HALF * BK * 2, STAGE_BYTES = 8 * HTB;
__host__ __device__ __forceinline__ int lds_byte(int r, int c) { const int st = (r >> 4) * 2 + (c >> 5), rr = r & 15, cc = c & 31, ob = rr * 64 + cc * 2; return st * 1024 + (ob ^ (((ob >> 9) & 1) << 5)); }
__host__ __device__ __forceinline__ void stage_rc(int b, int& R, int& C) { const int st = b / 1024, sb = b % 1024, swz = sb ^ (((sb >> 9) & 1) << 5); R = (st >> 1) * 16 + swz / 64; C = (st & 1) * 32 + (swz % 64) / 2; }
__host__ __device__ __forceinline__ int perm32(int rho) { const int n = rho >> 4, i = rho & 15; return 8 * (i >> 2) + 4 * n + (i & 3); }
__host__ __device__ __forceinline__ int perm16x(int rho) { const int n = rho >> 4, i = rho & 15; return 16 * (i >> 2) + 4 * n + (i & 3); }

struct Unit { const char* A; const char* B; int i0, i1, i2, i3; };
__device__ __forceinline__ int xcd_remap(int L, int nwg) { const int q = nwg / 8, r = nwg % 8, xcd = L % 8, off = L / 8; return (xcd < r ? xcd * (q + 1) : r * (q + 1) + (xcd - r) * q) + off; }

template <class Epi, class Sched, bool ALIGN_EPI, bool GATHER, int STAG = 0, int AMODE = 0>
__device__ __forceinline__ void gemm_phase(LAS unsigned char* lds, const int lda, const int ldb, const int K, const Sched& S, const Epi& E) {
    if constexpr (STAG > 0) { const unsigned long long t0_ = __builtin_amdgcn_s_memrealtime(), dl_ = (unsigned long long)STAG * ((blockIdx.x >> 3) & 3u); while (__builtin_amdgcn_s_memrealtime() - t0_ < dl_) __builtin_amdgcn_s_sleep(4); }
    const int tid = threadIdx.x, wid = __builtin_amdgcn_readfirstlane(tid >> 6), lane = tid & 63, wr = wid >> 2, wc = wid & 3, fr = lane & 15, fq = lane >> 4;
    const int nt = K / BK;
    unsigned voffA[2], voffB[2]; int RA[2], CA[2];
#pragma unroll
    for (int i = 0; i < 2; ++i) { int R, C; stage_rc(tid * 16 + i * 8192, R, C); const int Rb = 64 * (R >> 5) + (Epi::PERM == 2 ? perm16x(R & 31) : Epi::PERM ? perm32(R & 31) : (R & 31));
        RA[i] = R; CA[i] = C; voffA[i] = AMODE == 1 ? (unsigned)((R >> 4) * 8192 + (R & 7) * 1024 + (C >> 5) * 128 + ((R >> 3) & 1) * 64 + (C & 31) * 2) : (unsigned)(R * lda + C) * 2u; voffB[i] = (unsigned)(Rb * ldb + C) * 2u; }
    const size_t kstep = (size_t)(BK * 2), kstepA = AMODE == 1 ? 256 : kstep;
    const size_t hstepA = (size_t)HALF * lda * 2, hstepB = (size_t)(Epi::PERM == 2 ? 8 : 32) * ldb * 2;
    const unsigned ldsw = (unsigned)wid * 1024u;
    const int aoff = lds_byte(wr * 64 + fr, fq * 8), boff = lds_byte(wc * 32 + fr, fq * 8);
#define PG8_SA(b, h) (((b) * 2 + (h)) * HTB)
#define PG8_SB(b, h) ((4 + (b) * 2 + (h)) * HTB)
#define PG8_STAGE(bufoff, gbase, voff) do { _Pragma("unroll") for (int _i = 0; _i < 2; ++_i) \
        __builtin_amdgcn_global_load_lds((const unsigned*)((const char*)(gbase) + (voff)[_i]), (LAS unsigned*)(lds + (bufoff) + ldsw + _i * 8192), 16, 0, 0); } while (0)
#define PG8_STAGE_A(bufoff, base, g0, g1, h, kb) do { if constexpr (GATHER) { \
        __builtin_amdgcn_global_load_lds((const unsigned*)((base) + (kb) + (g0)), (LAS unsigned*)(lds + (bufoff) + ldsw), 16, 0, 0); \
        __builtin_amdgcn_global_load_lds((const unsigned*)((base) + (kb) + (g1)), (LAS unsigned*)(lds + (bufoff) + ldsw + 8192), 16, 0, 0); } \
      else { PG8_STAGE(bufoff, (base) + (h) * hstepA + (kb), voffA); } } while (0)
#define PG8_LDA(dst, b, h) do { _Pragma("unroll") for (int m = 0; m < 4; ++m) _Pragma("unroll") for (int k = 0; k < 2; ++k) dst[m][k] = *(const LAS bf16x8*)(lds + PG8_SA(b, h) + aoff + m * 2048 + k * 1024); } while (0)
#define PG8_LDB(dst, b, h) do { _Pragma("unroll") for (int n = 0; n < 2; ++n) _Pragma("unroll") for (int k = 0; k < 2; ++k) dst[n][k] = *(const LAS bf16x8*)(lds + PG8_SB(b, h) + boff + n * 2048 + k * 1024); } while (0)
#define PG8_MMA(ai, bj, At, Bt) do { __builtin_amdgcn_s_setprio(1); _Pragma("unroll") for (int m = 0; m < 4; ++m) _Pragma("unroll") for (int n = 0; n < 2; ++n) _Pragma("unroll") for (int k = 0; k < 2; ++k) \
        acc[ai][bj][m][n] = __builtin_amdgcn_mfma_f32_16x16x32_bf16(Bt[n][k], At[m][k], acc[ai][bj][m][n], 0, 0, 0); __builtin_amdgcn_s_setprio(0); } while (0)
#define PG8_WAIT_V(n) asm volatile("s_waitcnt vmcnt(" #n ")" ::: "memory")
#define PG8_WAIT_VN(n) asm volatile("s_waitcnt vmcnt(%0)" :: "n"(n) : "memory")
#define PG8_WAIT_L(n) asm volatile("s_waitcnt lgkmcnt(" #n ")" ::: "memory")
#define PG8_BAR __builtin_amdgcn_s_barrier()
#define PG8_SCHED __builtin_amdgcn_sched_barrier(0)
    Unit cur, nxt; int ui = 0;
    if (!S.next(0, cur)) return;
    unsigned gc00 = 0, gc01 = 0, gc10 = 0, gc11 = 0, gn00 = 0, gn01 = 0, gn10 = 0, gn11 = 0;
    if constexpr (GATHER) { S.gather(cur, RA[0], CA[0], RA[1], CA[1], gc00, gc01, gc10, gc11); gn00 = gc00; gn01 = gc01; gn10 = gc10; gn11 = gc11; }
    f32x4 acc[2][2][4][2];
#pragma unroll
    for (int a = 0; a < 2; ++a)
#pragma unroll
        for (int b = 0; b < 2; ++b)
#pragma unroll
            for (int m = 0; m < 4; ++m)
#pragma unroll
                for (int n = 0; n < 2; ++n) acc[a][b][m][n] = (f32x4){0.f, 0.f, 0.f, 0.f};
    bf16x8 At[4][2], B0[2][2], B1[2][2];
    const char* cA = cur.A; const char* cB = cur.B;
    PG8_STAGE(PG8_SB(0, 0), cB, voffB); PG8_STAGE(PG8_SB(0, 1), cB + hstepB, voffB); PG8_STAGE_A(PG8_SA(0, 0), cA, gc00, gc01, 0, 0); PG8_STAGE_A(PG8_SA(0, 1), cA, gc10, gc11, 1, 0);
    if (wr == 1) PG8_BAR;
    PG8_WAIT_V(2); PG8_BAR;
    PG8_STAGE(PG8_SB(1, 0), cB + kstep, voffB); PG8_STAGE_A(PG8_SA(1, 0), cA, gc00, gc01, 0, kstepA); PG8_STAGE(PG8_SB(1, 1), cB + hstepB + kstep, voffB);
    PG8_WAIT_V(6); PG8_BAR;
    for (;;) {
        const bool has_next = S.next(ui + 1, nxt);
        if constexpr (GATHER) { if (has_next) S.gather(nxt, RA[0], CA[0], RA[1], CA[1], gn00, gn01, gn10, gn11); }
        const char* nA = has_next ? nxt.A : cA; const char* nB = has_next ? nxt.B : cB;
#pragma unroll 1
        for (int t = 0; t < nt; t += 2) {
            const bool last = (t == nt - 2);
            const size_t k1 = (size_t)(t + 1) * kstepA;
            const char* a2 = last ? nA : cA; const char* b2 = last ? nB : cB + (size_t)(t + 2) * kstep;
            const size_t k2 = last ? 0 : (size_t)(t + 2) * kstepA, k3 = k2 + kstepA;
            const char* b3 = b2 + kstep;
            unsigned g200 = gc00, g201 = gc01, g210 = gc10, g211 = gc11;
            if constexpr (GATHER) { if (last) { g200 = gn00; g201 = gn01; g210 = gn10; g211 = gn11; } }
            PG8_LDB(B0, 0, 0); PG8_LDB(B1, 0, 1); PG8_SCHED; PG8_LDA(At, 0, 0); PG8_STAGE_A(PG8_SA(1, 1), cA, gc10, gc11, 1, k1);
            PG8_WAIT_V(8); PG8_WAIT_L(0); PG8_BAR; PG8_MMA(0, 0, At, B0); PG8_MMA(0, 1, At, B1); PG8_BAR; PG8_SCHED;
            PG8_LDA(At, 0, 1); PG8_STAGE(PG8_SB(0, 0), b2, voffB); PG8_STAGE(PG8_SB(0, 1), b2 + hstepB, voffB); PG8_STAGE_A(PG8_SA(0, 0), a2, g200, g201, 0, k2);
            PG8_WAIT_V(8); PG8_WAIT_L(0); PG8_BAR; PG8_MMA(1, 0, At, B0); PG8_MMA(1, 1, At, B1); PG8_BAR; PG8_SCHED;
            PG8_LDB(B0, 1, 0); PG8_LDB(B1, 1, 1); PG8_SCHED; PG8_LDA(At, 1, 0); PG8_STAGE_A(PG8_SA(0, 1), a2, g210, g211, 1, k2);
            PG8_WAIT_V(8); PG8_WAIT_L(0); PG8_BAR; PG8_MMA(0, 0, At, B0); PG8_MMA(0, 1, At, B1); PG8_BAR; PG8_SCHED;
            PG8_LDA(At, 1, 1); PG8_STAGE(PG8_SB(1, 0), b3, voffB); PG8_STAGE(PG8_SB(1, 1), b3 + hstepB, voffB); PG8_STAGE_A(PG8_SA(1, 0), a2, g200, g201, 0, k3);
            PG8_WAIT_V(8); PG8_WAIT_L(0); PG8_BAR; PG8_MMA(1, 0, At, B0); PG8_MMA(1, 1, At, B1); PG8_BAR; PG8_SCHED;
        }
#if defined(MK_TPROBE) && MK_TPROBE >= 200
        unsigned long long tp0_ = 0; if (blockIdx.x == 0 && wid == 0) tp0_ = __builtin_amdgcn_s_memrealtime();
#endif
        if constexpr (ALIGN_EPI) { if (wr == 0) PG8_BAR; }
        E(acc, cur, wr, wc, fr, fq);
#if defined(MK_TPROBE) && MK_TPROBE >= 200
        if (blockIdx.x == 0 && wid == 0) { asm volatile("s_waitcnt vmcnt(0)" ::: "memory"); const unsigned long long d_ = __builtin_amdgcn_s_memrealtime() - tp0_; if (lane == 0) { volatile LAS unsigned* M_ = (volatile LAS unsigned*)(lds + MISC_OFF); const unsigned long long a_ = (((unsigned long long)M_[23] << 32) | M_[22]) + d_; M_[22] = (unsigned)a_; M_[23] = (unsigned)(a_ >> 32); } }
#endif
        if (!has_next) break;
#pragma unroll
        for (int a = 0; a < 2; ++a)
#pragma unroll
            for (int b = 0; b < 2; ++b)
#pragma unroll
                for (int m = 0; m < 4; ++m)
#pragma unroll
                    for (int n = 0; n < 2; ++n) acc[a][b][m][n] = (f32x4){0.f, 0.f, 0.f, 0.f};
        cur = nxt; cA = nA; cB = nB; ++ui;
        if constexpr (GATHER) { gc00 = gn00; gc01 = gn01; gc10 = gn10; gc11 = gn11; }
        if constexpr (ALIGN_EPI) { if (wr == 1) PG8_BAR; }
    }
    PG8_WAIT_V(0);
    if constexpr (!ALIGN_EPI) { if (wr == 0) PG8_BAR; }
    PG8_BAR;
#undef PG8_SA
#undef PG8_SB
#undef PG8_STAGE
#undef PG8_STAGE_A
#undef PG8_LDA
#undef PG8_LDB
#undef PG8_MMA
#undef PG8_WAIT_V
#undef PG8_WAIT_VN
#undef PG8_WAIT_L
#undef PG8_BAR
#undef PG8_SCHED
}
}
namespace fx {
#define FX_ROWLOOP _Pragma("unroll") for (int ai = 0; ai < 2; ++ai) _Pragma("unroll") for (int m = 0; m < 4; ++m)

struct PlainOrder {
    const char* A; const char* B; int lda, ldb, nM, nN, nwg, G, c;
    __device__ __forceinline__ void init(const void* A_, int lda_, const void* B_, int ldb_, int M, int N, int G_, int c_) { A = (const char*)A_; B = (const char*)B_; lda = lda_; ldb = ldb_; nM = M / 256; nN = N / 256; nwg = nM * nN; G = G_; c = c_; }
    __device__ __forceinline__ bool next(int i, Unit& u) const {
        const long L = (long)i * G + c; if (L >= nwg) return false;
        const int wgid = xcd_remap((int)L, nwg);
        const int nig = 8 * nN, gid = wgid / nig, fm = gid * 8, gsz = (nM - fm) < 8 ? (nM - fm) : 8;
        const int pm = fm + ((wgid % nig) % gsz), pn = (wgid % nig) / gsz;
        u.A = A + (size_t)pm * 256 * lda * 2; u.B = B + (size_t)pn * 256 * ldb * 2; u.i0 = pm; u.i1 = pn; u.i2 = 0; u.i3 = 0; return true;
    }
};
struct PanelOrder {
    const char* A; const char* B; int lda, ldb, nM, nN, G, c;
    __device__ __forceinline__ void init(const void* A_, int lda_, const void* B_, int ldb_, int M, int N, int G_, int c_) { A = (const char*)A_; B = (const char*)B_; lda = lda_; ldb = ldb_; nM = M / 256; nN = N / 256; G = G_; c = c_; }
    __device__ __forceinline__ bool next(int i, Unit& u) const {
        const int j = i / nN, pn = i - j * nN, pm = c + j * G; if (pm >= nM) return false;
        u.A = A + (size_t)pm * 256 * lda * 2; u.B = B + (size_t)pn * 256 * ldb * 2; u.i0 = pm; u.i1 = pn; u.i2 = 0; u.i3 = 0; return true;
    }
};
struct GroupOrder {
    const char* A; const char* B; int ldb, nN, nwg, G, c;
    __device__ __forceinline__ void init(const void* A_, const void* B_, int ldb_, int nN_, int G_, int c_) { A = (const char*)A_; B = (const char*)B_; ldb = ldb_; nN = nN_; nwg = 32 * 8 * nN_; G = G_; c = c_; }
    __device__ __forceinline__ bool next(int i, Unit& u) const {
        const long L = (long)i * G + c; if (L >= nwg) return false;
        const int wgid = xcd_remap((int)L, nwg);
        const int per = 8 * nN, g = wgid / per, rem = wgid % per, pm = rem % 8, pn = rem / 8;
        u.A = A + ((size_t)g * UHR + (size_t)pm * 256) * UHK * 2; u.B = B + ((size_t)g * nN * 256 + (size_t)pn * 256) * ldb * 2; u.i0 = g; u.i1 = pm; u.i2 = pn; u.i3 = 0; return true;
    }
};

__device__ __forceinline__ void rope8(f32x4& v0, f32x4& v1, const float* __restrict__ ropec, const float* __restrict__ ropes, int pos, int fq) {
    const f32x4 c = *(const f32x4*)(ropec + pos * 16 + 4 * fq), s = *(const f32x4*)(ropes + pos * 16 + 4 * fq);
    const f32x4 a = v0, b = v1;
    v0 = (f32x4){a[0] * c[0] - a[1] * s[0], a[0] * s[0] + a[1] * c[0], a[2] * c[1] - a[3] * s[1], a[2] * s[1] + a[3] * c[1]};
    v1 = (f32x4){b[0] * c[2] - b[1] * s[2], b[0] * s[2] + b[1] * c[2], b[2] * c[3] - b[3] * s[3], b[2] * s[3] + b[3] * c[3]};
}
__device__ __forceinline__ float sumsq8(const f32x4 a, const f32x4 b) { return (a[0] * a[0] + a[1] * a[1]) + (a[2] * a[2] + a[3] * a[3]) + (b[0] * b[0] + b[1] * b[1]) + (b[2] * b[2] + b[3] * b[3]); }

struct EpiWin {
    static constexpr int PERM = 1; static constexpr int NST = 16;
    bf16_t* UH; bf16_t* CQ; bf16_t* CKVR; float* ssqq; float* ssqkv; const float* ropec; const float* ropes;
    __device__ __forceinline__ void operator()(const f32x4 (&acc)[2][2][4][2], const Unit& u, int wr, int wc, int fr, int fq) const {
        const int pm = u.i0, pn = u.i1, row0 = pm * 256 + wr * 64 + fr;
        if (pn < 2) {
            FX_ROWLOOP { const int row = row0 + ai * 128 + m * 16, r32 = row >> 5, tq = row & 31;
#pragma unroll
                for (int bj = 0; bj < 2; ++bj) { const int c = pn * 256 + wc * 64 + bj * 32 + 8 * fq, g = c >> 4, p0 = c & 15;
                    *(u32x4*)(UH + ((size_t)(g * UHR + r32) * UHK + tq * 16 + p0)) = pack8(acc[ai][bj][m][0], acc[ai][bj][m][1]); } }
        } else if (pn == 2) {
            FX_ROWLOOP { const int row = row0 + ai * 128 + m * 16; float ss = sumsq8(acc[ai][0][m][0], acc[ai][0][m][1]) + sumsq8(acc[ai][1][m][0], acc[ai][1][m][1]);
                store_lines16(CQ + (size_t)(row - fr) * 256 + 64 * wc, 256, pack8(acc[ai][0][m][0], acc[ai][0][m][1]), pack8(acc[ai][1][m][0], acc[ai][1][m][1]), fr, fq);
                ss += __shfl_xor(ss, 16); ss += __shfl_xor(ss, 32);
                if (fq == 0) ssqq[(size_t)row * 4 + wc] = ss; }
        } else {
            FX_ROWLOOP { const int row = row0 + ai * 128 + m * 16; float ss = 0.f; u32x4 w[2];
#pragma unroll
                for (int bj = 0; bj < 2; ++bj) { f32x4 v0 = acc[ai][bj][m][0], v1 = acc[ai][bj][m][1];
                    if (wc < 2) ss += sumsq8(v0, v1);
                    if (wc == 2 && bj == 0) rope8(v0, v1, ropec, ropes, row & (SEQ - 1), fq);
                    w[bj] = pack8(v0, v1); }
                store_lines16(CKVR + (size_t)(row - fr) * 256 + 64 * wc, 256, w[0], w[1], fr, fq);
                ss += __shfl_xor(ss, 16); ss += __shfl_xor(ss, 32);
                if (fq == 0) ssqkv[(size_t)row * 4 + wc] = ss; }
        }
    }
};
struct EpiQ {
    static constexpr int PERM = 1; static constexpr int NST = 16;
    bf16_t* Q; const float* ssqq; const float* ropec; const float* ropes;
    __device__ __forceinline__ void operator()(const f32x4 (&acc)[2][2][4][2], const Unit& u, int wr, int wc, int fr, int fq) const {
        const int pm = u.i0, pn = u.i1, row0 = pm * 256 + wr * 64;
        FX_ROWLOOP { const int row = row0 + fr + ai * 128 + m * 16; const f32x4 s4 = *(const f32x4*)(ssqq + (size_t)row * 4);
            const float rs = __builtin_amdgcn_rsqf(((s4[0] + s4[1]) + (s4[2] + s4[3])) * (1.f / 256.f) + RMS_EPS) * QSCALE;
            u32x4 w[2];
#pragma unroll
            for (int bj = 0; bj < 2; ++bj) { const int G = 8 * pn + 2 * wc + bj;
                f32x4 v0 = acc[ai][bj][m][0] * rs, v1 = acc[ai][bj][m][1] * rs;
                if (G % 3 == 2) rope8(v0, v1, ropec, ropes, row & (SEQ - 1), fq);
                w[bj] = pack8(v0, v1); }
            store_lines16(Q + (size_t)(row0 + ai * 128 + m * 16) * 768 + 256 * pn + 64 * wc, 768, w[0], w[1], fr, fq); }
    }
};
struct EpiKV {
    static constexpr int PERM = 1; static constexpr int NST = 16;
    bf16_t* KV; const float* ssqkv;
    __device__ __forceinline__ void operator()(const f32x4 (&acc)[2][2][4][2], const Unit& u, int wr, int wc, int fr, int fq) const {
        const int pm = u.i0, pn = u.i1, row0 = pm * 256 + wr * 64;
        FX_ROWLOOP { const int row = row0 + fr + ai * 128 + m * 16; const f32x4 s4 = *(const f32x4*)(ssqkv + (size_t)row * 4);
            const float rs = __builtin_amdgcn_rsqf(((s4[0] + s4[1]) + (s4[2] + s4[3])) * (1.f / 128.f) + RMS_EPS);
            store_lines16(KV + (size_t)(row0 + ai * 128 + m * 16) * 1024 + 256 * pn + 64 * wc, 1024, pack8(acc[ai][0][m][0] * rs, acc[ai][0][m][1] * rs), pack8(acc[ai][1][m][0] * rs, acc[ai][1][m][1] * rs), fr, fq); }
    }
};
struct EpiSt {
    static constexpr int PERM = 1; static constexpr int NST = 16;
    bf16_t* S;
    __device__ __forceinline__ void operator()(const f32x4 (&acc)[2][2][4][2], const Unit& u, int wr, int wc, int fr, int fq) const {
        const int g = u.i0, pm = u.i1, row0 = pm * 256 + wr * 64;
        FX_ROWLOOP store_lines16(S + ((size_t)g * UHR + row0 + ai * 128 + m * 16) * 256 + 64 * wc, 256, pack8(acc[ai][0][m][0], acc[ai][0][m][1]), pack8(acc[ai][1][m][0], acc[ai][1][m][1]), fr, fq);
    }
};
struct EpiSsmOut {
    static constexpr int PERM = 1; static constexpr int NST = 16;
    bf16_t* SPRE;
    __device__ __forceinline__ void operator()(const f32x4 (&acc)[2][2][4][2], const Unit& u, int wr, int wc, int fr, int fq) const {
        const int g = u.i0, pm = u.i1, pn = u.i2, row0 = pm * 256 + wr * 64 + fr;
        const int p0 = 8 * (fq & 1);
        FX_ROWLOOP { const int R = row0 + ai * 128 + m * 16;
#pragma unroll
            for (int bj = 0; bj < 2; ++bj) { const int c = 256 * pn + 64 * wc + 32 * bj + 8 * fq, tq = c >> 4;
                f32x4 y0 = acc[ai][bj][m][0], y1 = acc[ai][bj][m][1];
#pragma unroll
                for (int j = 0; j < 4; ++j) { y0[j] = gelu_tanh_f(y0[j]); y1[j] = gelu_tanh_f(y1[j]); }
                *(u32x4*)(SPRE + ((size_t)R * 32 + tq) * SPRE_LD + g * 16 + p0) = pack8(y0, y1); } }
    }
};
struct EpiGlu {
    static constexpr int PERM = 1; static constexpr int NST = 16;
    const bf16_t* SPRE; bf16_t* MIX; const float* bglu;
    __device__ __forceinline__ void operator()(const f32x4 (&acc)[2][2][4][2], const Unit& u, int wr, int wc, int fr, int fq) const {
        const int pm = u.i0, pn = u.i1, row0 = pm * 256 + wr * 64;
        f32x4 b0[2], b1[2];
#pragma unroll
        for (int bj = 0; bj < 2; ++bj) { const int c = 256 * pn + 64 * wc + 32 * bj + 8 * fq; b0[bj] = *(const f32x4*)(bglu + c); b1[bj] = *(const f32x4*)(bglu + c + 4); }
        FX_ROWLOOP { const int row = row0 + fr + ai * 128 + m * 16; u32x4 w[2];
#pragma unroll
            for (int bj = 0; bj < 2; ++bj) { const int c = 256 * pn + 64 * wc + 32 * bj + 8 * fq;
                const u32x4 sw = *(const u32x4*)(SPRE + (size_t)row * SPRE_LD + c); f32x4 s0, s1; unpack8(sw, s0, s1);
                f32x4 z0 = acc[ai][bj][m][0] + b0[bj], z1 = acc[ai][bj][m][1] + b1[bj];
#pragma unroll
                for (int j = 0; j < 4; ++j) { z0[j] = s0[j] * fast_sigmoid(z0[j]); z1[j] = s1[j] * fast_sigmoid(z1[j]); }
                w[bj] = pack8(z0, z1); }
            store_lines16(MIX + (size_t)(row0 + ai * 128 + m * 16) * 1024 + 256 * pn + 64 * wc, 1024, w[0], w[1], fr, fq); }
    }
};
struct EpiWo {
    static constexpr int PERM = 1; static constexpr int NST = 16;
    bf16_t* XY;
    __device__ __forceinline__ void operator()(const f32x4 (&acc)[2][2][4][2], const Unit& u, int wr, int wc, int fr, int fq) const {
        const int pm = u.i0, pn = u.i1, row0 = pm * 256 + wr * 64;
        u32x4 xw[2][4][2];
#pragma unroll
        for (int ai = 0; ai < 2; ++ai)
#pragma unroll
            for (int m = 0; m < 4; ++m)
#pragma unroll
                for (int bj = 0; bj < 2; ++bj) xw[ai][m][bj] = *(const u32x4*)(XY + (size_t)(row0 + fr + ai * 128 + m * 16) * 1024 + 256 * pn + wc * 64 + bj * 32 + 8 * fq);
        asm volatile("s_waitcnt vmcnt(0)" ::: "memory");
        FX_ROWLOOP { u32x4 w[2];
#pragma unroll
            for (int bj = 0; bj < 2; ++bj) { f32x4 x0, x1; unpack8(xw[ai][m][bj], x0, x1); w[bj] = pack8(x0 * ALPHA + acc[ai][bj][m][0], x1 * ALPHA + acc[ai][bj][m][1]); }
            store_lines16(XY + (size_t)(row0 + ai * 128 + m * 16) * 1024 + 256 * pn + 64 * wc, 1024, w[0], w[1], fr, fq); }
    }
};
__device__ __forceinline__ size_t h_off(int row, int col) { return (size_t)(row >> 4) * 4096 + (size_t)(row & 7) * 512 + (size_t)(col >> 5) * 64 + (size_t)((row >> 3) & 1) * 32 + (size_t)(col & 31); }
struct EpiSharedRouter {
    static constexpr int PERM = 1; static constexpr int NST = 0;
    bf16_t* HS; float* LG;
    __device__ __forceinline__ void operator()(const f32x4 (&acc)[2][2][4][2], const Unit& u, int wr, int wc, int fr, int fq) const {
        const int pm = u.i0, pn = u.i1, row0 = pm * 256 + wr * 64 + fr;
        if (pn < 2) {
            const int c = 128 * pn + 32 * wc + 8 * fq;
            FX_ROWLOOP { f32x4 h0, h1;
#pragma unroll
                for (int j = 0; j < 4; ++j) { const float g0 = acc[ai][0][m][0][j], g1 = acc[ai][0][m][1][j];
                    h0[j] = g0 * fast_sigmoid(g0) * acc[ai][1][m][0][j]; h1[j] = g1 * fast_sigmoid(g1) * acc[ai][1][m][1][j]; }
                *(u32x4*)(HS + h_off(row0 + ai * 128 + m * 16, c)) = pack8(h0, h1); }
        } else if (wc == 0) {
            FX_ROWLOOP { float* rp = LG + (size_t)(row0 + ai * 128 + m * 16) * 64 + 8 * fq;
#pragma unroll
                for (int bj = 0; bj < 2; ++bj) { *(f32x4*)(rp + bj * 32) = acc[ai][bj][m][0]; *(f32x4*)(rp + bj * 32 + 4) = acc[ai][bj][m][1]; } }
        }
    }
};

struct MoeTab { LAS int* tbase; LAS unsigned* tab; };
__device__ __forceinline__ MoeTab moe_tab(LAS unsigned char* lds) { MoeTab t; t.tbase = (LAS int*)(lds + TAB_OFF); t.tab = (LAS unsigned*)(lds + TAB_OFF + 2304); return t; }
__device__ __forceinline__ int ve_count(const unsigned* ctl, int ve) { return (ve % 65 == 64) ? CAPC : (int)__hip_atomic_load(ctl + CW_CNT + 64 * ve, __ATOMIC_RELAXED, __HIP_MEMORY_SCOPE_AGENT); }
__device__ __forceinline__ void moe_build_tab(LAS unsigned char* lds, const unsigned* ctl) {
    const MoeTab t = moe_tab(lds); LAS int* nt = (LAS int*)(lds + TAB_OFF + 1024 + 64);
    const int tid = threadIdx.x;
    if (tid < NVE) nt[tid] = (ve_count(ctl, tid) + 255) >> 8;
    __syncthreads();
    if (tid == 0) { int s = 0; for (int v = 0; v < NVE; ++v) { t.tbase[v] = s; s += nt[v]; } t.tbase[NVE] = s; }
    __syncthreads();
    for (int v = tid; v < NVE; v += 512) { const int b = t.tbase[v], n = t.tbase[v + 1] - b; for (int j = 0; j < n; ++j) t.tab[b + j] = (unsigned)v | ((unsigned)j << 16); }
    __syncthreads();
}
struct GateUpOrder {
    const char* X1B; const char* WGU; MoeTab tb; LAS int* idx; int nunits, G, c;
    int tb0;
    __device__ __forceinline__ int tile_of(int tr) const { return tb0 + tr; }
    __device__ __forceinline__ void init(LAS unsigned char* lds, const void* x1b, const void* wgu, const int* rowtok, const unsigned* ctl, int chn, int G_, int c_) {
        X1B = (const char*)x1b; WGU = (const char*)wgu; tb = moe_tab(lds); idx = (LAS int*)(lds + IDX_OFF); G = G_; c = c_;
        tb0 = tb.tbase[chn * 65]; nunits = 2 * (tb.tbase[chn * 65 + 64] - tb0);
        __syncthreads();
        for (int i = 0; i < IDX_UNITS; ++i) { const long L = (long)i * G + c; if (L >= nunits) break;
            const int tile = tile_of(xcd_remap((int)L, nunits) >> 1); const unsigned e = tb.tab[tile]; const int ve = (int)(e & 0xffffu), tix = (int)(e >> 16), ch = ve / 65, ex = ve % 65;
            const int cnt = ve_count(ctl, ve);
            if (threadIdx.x < 256) { const int slot = tix * 256 + (int)threadIdx.x; idx[i * 256 + threadIdx.x] = slot < cnt ? rowtok[(size_t)(ch * 64 + ex) * CAPC + slot] : ch * CAPC; } }
        __syncthreads();
    }
    __device__ __forceinline__ bool next(int i, Unit& u) const {
        const long L = (long)i * G + c; if (L >= nunits) return false;
        const int wgid = xcd_remap((int)L, nunits), tile = tile_of(wgid >> 1), pn = wgid & 1;
        const int ex = (int)(tb.tab[tile] & 0xffffu) % 65;
        u.A = X1B; u.B = WGU + ((size_t)ex * 512 + (size_t)pn * 256) * 1024 * 2; u.i0 = tile * 256; u.i1 = pn; u.i2 = 0; u.i3 = i < IDX_UNITS ? i : IDX_UNITS - 1; return true;
    }
    __device__ __forceinline__ void gather(const Unit& u, int R0, int C0, int R1, int C1, unsigned& g00, unsigned& g01, unsigned& g10, unsigned& g11) const {
        const LAS int* ip = idx + u.i3 * 256;
        g00 = (unsigned)ip[R0] * 2048u + (unsigned)C0 * 2u; g01 = (unsigned)ip[R1] * 2048u + (unsigned)C1 * 2u;
        g10 = (unsigned)ip[128 + R0] * 2048u + (unsigned)C0 * 2u; g11 = (unsigned)ip[128 + R1] * 2048u + (unsigned)C1 * 2u;
    }
};
struct EpiGateUp {
    static constexpr int PERM = 1; static constexpr int NST = 8;
    bf16_t* H;
    __device__ __forceinline__ void operator()(const f32x4 (&acc)[2][2][4][2], const Unit& u, int wr, int wc, int fr, int fq) const {
        const int hrow0 = u.i0 + wr * 64 + fr, c = 128 * u.i1 + 32 * wc + 8 * fq;
        FX_ROWLOOP { f32x4 h0, h1;
#pragma unroll
            for (int j = 0; j < 4; ++j) { const float g0 = acc[ai][0][m][0][j], g1 = acc[ai][0][m][1][j];
                h0[j] = g0 * fast_sigmoid(g0) * acc[ai][1][m][0][j]; h1[j] = g1 * fast_sigmoid(g1) * acc[ai][1][m][1][j]; }
            *(u32x4*)(H + h_off(hrow0 + ai * 128 + m * 16, c)) = pack8(h0, h1); }
    }
};
struct DownOrder {
    const char* Hh; const char* HS; const char* WD; MoeTab tb; int t0, nunits, G, c, chn;
    __device__ __forceinline__ void init(const void* h, const void* hs, const void* wd, MoeTab tb_, int ch, int G_, int c_) { Hh = (const char*)h; HS = (const char*)hs; WD = (const char*)wd; tb = tb_; chn = ch; t0 = tb_.tbase[ch * 65]; nunits = 4 * (tb_.tbase[(ch + 1) * 65] - t0); G = G_; c = c_; }
    __device__ __forceinline__ bool next(int i, Unit& u) const {
        const long L = (long)i * G + c; if (L >= nunits) return false;
        const int wgid = xcd_remap((int)L, nunits), tile = t0 + (wgid >> 2), pn = wgid & 3;
        const int ex = (int)(tb.tab[tile] & 0xffffu) % 65;
        u.A = ex == 64 ? HS + ((size_t)chn * CAPC + (size_t)(tb.tab[tile] >> 16) * 256) * 256 * 2 : Hh + (size_t)tile * 256 * 256 * 2; u.B = WD + ((size_t)ex * 1024 + (size_t)pn * 256) * 256 * 2; u.i0 = ex == 64 ? (int)(tb.tab[tile] >> 16) * 256 : (tile - t0) * 256; u.i1 = pn; u.i2 = ex == 64; u.i3 = 0; return true;
    }
};
constexpr float Y8_SCALE = 16.f, Y8_INV = 1.f / 16.f;
__device__ __forceinline__ u32x2 pack8_fp8(const f32x4 a, const f32x4 b) {
    int w0 = 0, w1 = 0;
    w0 = __builtin_amdgcn_cvt_pk_fp8_f32(a[0] * Y8_SCALE, a[1] * Y8_SCALE, w0, false); w0 = __builtin_amdgcn_cvt_pk_fp8_f32(a[2] * Y8_SCALE, a[3] * Y8_SCALE, w0, true);
    w1 = __builtin_amdgcn_cvt_pk_fp8_f32(b[0] * Y8_SCALE, b[1] * Y8_SCALE, w1, false); w1 = __builtin_amdgcn_cvt_pk_fp8_f32(b[2] * Y8_SCALE, b[3] * Y8_SCALE, w1, true);
    u32x2 r; r.x = (unsigned)w0; r.y = (unsigned)w1; return r;
}
__device__ __forceinline__ void unpack8_fp8(const u32x2 w, f32x4& a, f32x4& b) {
    const f32x2 p0 = __builtin_amdgcn_cvt_pk_f32_fp8((int)w.x, false), p1 = __builtin_amdgcn_cvt_pk_f32_fp8((int)w.x, true);
    const f32x2 p2 = __builtin_amdgcn_cvt_pk_f32_fp8((int)w.y, false), p3 = __builtin_amdgcn_cvt_pk_f32_fp8((int)w.y, true);
    a = (f32x4){p0.x, p0.y, p1.x, p1.y}; b = (f32x4){p2.x, p2.y, p3.x, p3.y};
}
__device__ __forceinline__ size_t y8_off(int row, int col) { return (size_t)row * 1024 + (size_t)col; }
template <int STORE = 1> struct EpiDownT {
    static constexpr int PERM = 2; static constexpr int NST = 8;
    unsigned char* Y8; bf16_t* YS;
    __device__ __forceinline__ void operator()(const f32x4 (&acc)[2][2][4][2], const Unit& u, int wr, int wc, int fr, int fq) const {
        const int yrow0 = u.i0 + wr * 64, c0 = 256 * u.i1 + 64 * wc + 16 * fq;
        if (u.i2) {
            const bool lo = fr < 8;
            FX_ROWLOOP { const u32x4 X = pack8(acc[ai][0][m][0], acc[ai][0][m][1]), Y = pack8(acc[ai][1][m][0], acc[ai][1][m][1]);
                const u32x4 S = lo ? Y : X, R = ror8_x4(S); const u32x4 A1 = lo ? X : R, A2 = lo ? R : Y;
                bf16_t* p = YS + (size_t)(yrow0 + ai * 128 + m * 16 + (fr & 7)) * 1024 + c0 + (lo ? 0 : 8);
                *(u32x4*)p = A1; *(u32x4*)(p + 8 * 1024) = A2; }
        } else {
            FX_ROWLOOP { unsigned char* rp = Y8 + y8_off(yrow0 + ai * 128 + m * 16 + fr, c0);
                const u32x2 lo = pack8_fp8(acc[ai][0][m][0], acc[ai][0][m][1]), hi = pack8_fp8(acc[ai][1][m][0], acc[ai][1][m][1]);
                u32x4 w; w.x = lo.x; w.y = lo.y; w.z = hi.x; w.w = hi.y; *(u32x4*)rp = w; }
        }
    }
};
typedef EpiDownT<1> EpiDown;
}
namespace fx {
namespace att {
constexpr int NW = 8, QBLK = 32, KVBLK = 64;
constexpr int SHM_V = 16384, SHM_K = 16384;
constexpr float THRL = 8.f;
#define KSWZ(row, colB) ((row) * 256 + ((colB) ^ (((row) & 7) << 4)))
#define SBAR() __builtin_amdgcn_sched_barrier(0)
__device__ __forceinline__ int crow(int r, int hi) { return (r & 3) + 8 * (r >> 2) + 4 * hi; }
__device__ __forceinline__ void partialSM(f32x16& p0, f32x16& p1, float& m_reg, float& mn, float& alpha) {
  float pmax = p0[0];
#pragma unroll
  for (int r = 1; r < 16; ++r) pmax = fmaxf(pmax, p0[r]);
#pragma unroll
  for (int r = 0; r < 16; ++r) pmax = fmaxf(pmax, p1[r]);
  { auto rr = __builtin_amdgcn_permlane32_swap(__float_as_uint(pmax), __float_as_uint(pmax), false, false);
    pmax = fmaxf(__uint_as_float(rr[0]), __uint_as_float(rr[1])); }
  if (__builtin_expect(__all(pmax - m_reg <= THRL), 1)) { mn = m_reg; alpha = 1.f; }
  else { mn = fmaxf(m_reg, pmax); alpha = __builtin_amdgcn_exp2f(m_reg - mn); m_reg = mn; }
#pragma unroll
  for (int r = 0; r < 16; ++r) p0[r] = p0[r] - mn;
#pragma unroll
  for (int r = 0; r < 16; ++r) p1[r] = p1[r] - mn;
#pragma unroll
  for (int r = 0; r < 16; ++r) p0[r] = __builtin_amdgcn_exp2f(p0[r]);
}
__device__ __forceinline__ void finishSM(f32x16& p0, f32x16& p1, float alpha, float& l_reg, bf16x8& pa0, bf16x8& pa1, bf16x8& pa2, bf16x8& pa3) {
#pragma unroll
  for (int r = 0; r < 16; ++r) p1[r] = __builtin_amdgcn_exp2f(p1[r]);
  float ps = 0;
#pragma unroll
  for (int r = 0; r < 16; ++r) ps += p0[r];
#pragma unroll
  for (int r = 0; r < 16; ++r) ps += p1[r];
  { auto rr = __builtin_amdgcn_permlane32_swap(__float_as_uint(ps), __float_as_uint(ps), false, false);
    ps = __uint_as_float(rr[0]) + __uint_as_float(rr[1]); }
  l_reg = l_reg * alpha + ps;
#define PK4(P, BASE, OUT) do { unsigned a0 = cvt_pk_bf16(P[BASE + 0], P[BASE + 1]), a1 = cvt_pk_bf16(P[BASE + 2], P[BASE + 3]);   \
    unsigned b0 = cvt_pk_bf16(P[BASE + 4], P[BASE + 5]), b1 = cvt_pk_bf16(P[BASE + 6], P[BASE + 7]);                              \
    auto r0 = __builtin_amdgcn_permlane32_swap(a0, b0, false, false); auto r1 = __builtin_amdgcn_permlane32_swap(a1, b1, false, false); \
    u32x4 w = {r0[0], r1[0], r0[1], r1[1]}; OUT = *reinterpret_cast<bf16x8*>(&w); } while (0)
  PK4(p0, 0, pa0); PK4(p0, 8, pa1); PK4(p1, 0, pa2); PK4(p1, 8, pa3);
#undef PK4
}
__device__ __forceinline__ void qkt(f32x16& p0, f32x16& p1, const char* Ks, const bf16x8 (&qr)[6], int r32, int hi) {
  p0 = f32x16{}; p1 = f32x16{};
#pragma unroll
  for (int d0 = 0; d0 < 6; ++d0) { const int cb = (d0 * 16 + hi * 8) * 2;
    const bf16x8 b0 = *reinterpret_cast<const bf16x8*>(Ks + KSWZ(r32, cb));
    const bf16x8 b1 = *reinterpret_cast<const bf16x8*>(Ks + KSWZ(32 + r32, cb));
    p0 = __builtin_amdgcn_mfma_f32_32x32x16_bf16(b0, qr[d0], p0, 0, 0, 0);
    p1 = __builtin_amdgcn_mfma_f32_32x32x16_bf16(b1, qr[d0], p1, 0, 0, 0); }
}
__device__ __forceinline__ int v_st(int k, int c) { const int kk = (k & ~0xC) | ((k & 4) << 1) | ((k & 8) >> 1); return ((kk >> 3) * 4 + (c >> 5)) * 512 + ((kk & 7) * 32 + (c & 31)) * 2; }
__device__ __forceinline__ int v_rd_base(int lane) { return ((lane & 3) << 3) | (((lane >> 2) & 3) << 6) | (((lane >> 4) & 1) << 5) | (((lane >> 5) & 1) << 8); }
constexpr int v_rd_off(int d0, int ks, int half) { return d0 * 512 + ks * 4096 + half * 2048; }
template <int OFF> __device__ __forceinline__ s16x4 tr_read(int vb) {
  s16x4 r; asm volatile("ds_read_b64_tr_b16 %0, %1 offset:%2" : "=&v"(r) : "v"(vb), "i"(OFF) : "memory"); return r;
}
template <int D0> __device__ __forceinline__ void pv_one(f32x16& od, int vb, bf16x8 pa0, bf16x8 pa1, bf16x8 pa2, bf16x8 pa3) {
  const s16x4 l0 = tr_read<v_rd_off(D0, 0, 0)>(vb), h0 = tr_read<v_rd_off(D0, 0, 1)>(vb), l1 = tr_read<v_rd_off(D0, 1, 0)>(vb), h1 = tr_read<v_rd_off(D0, 1, 1)>(vb);
  const s16x4 l2 = tr_read<v_rd_off(D0, 2, 0)>(vb), h2 = tr_read<v_rd_off(D0, 2, 1)>(vb), l3 = tr_read<v_rd_off(D0, 3, 0)>(vb), h3 = tr_read<v_rd_off(D0, 3, 1)>(vb);
  asm volatile("s_waitcnt lgkmcnt(0)" ::: "memory"); SBAR();
#define PK(L, H) (bf16x8){L[0], L[1], L[2], L[3], H[0], H[1], H[2], H[3]}
  od = __builtin_amdgcn_mfma_f32_32x32x16_bf16(pa0, PK(l0, h0), od, 0, 0, 0);
  od = __builtin_amdgcn_mfma_f32_32x32x16_bf16(pa1, PK(l1, h1), od, 0, 0, 0);
  od = __builtin_amdgcn_mfma_f32_32x32x16_bf16(pa2, PK(l2, h2), od, 0, 0, 0);
  od = __builtin_amdgcn_mfma_f32_32x32x16_bf16(pa3, PK(l3, h3), od, 0, 0, 0);
#undef PK
}
__device__ __forceinline__ void pv_d0(f32x16 (&o)[2], int vb, bf16x8 pa0, bf16x8 pa1, bf16x8 pa2, bf16x8 pa3) {
  pv_one<0>(o[0], vb, pa0, pa1, pa2, pa3); pv_one<1>(o[1], vb, pa0, pa1, pa2, pa3);
}
__device__ __forceinline__ void attn_unit(const unsigned char* __restrict__ wsb, const bf16_t* __restrict__ Q, bf16_t* __restrict__ MIX, int tok0, int qrow0, int h, char* lds) {
  int tid = threadIdx.x; asm volatile("" : "+v"(tid));
  const int wid = __builtin_amdgcn_readfirstlane(tid >> 6), lane = tid & 63, r32 = lane & 31, hi = lane >> 5;
  char* K_lds = lds; char* V_lds = lds + 4 * SHM_K;
  float* ws = (float*)(lds + TAB_OFF) + wid * 64; float* li_l = ws; float* al_l = ws + 32;
  float m_reg = -1e30f, l_reg = 0; f32x16 o[2] = {}; bf16x8 qr[6];
  const bf16_t* Qw = Q + (size_t)(tok0 + qrow0 + wid * QBLK + r32) * 768 + h * 96 + hi * 8;
#pragma unroll
  for (int d0 = 0; d0 < 6; ++d0) qr[d0] = *reinterpret_cast<const bf16x8*>(Qw + d0 * 16);
  const int vb0 = (int)(uintptr_t)V_lds + v_rd_base(lane);
  const int ra = tid / 12, ca = tid % 12, rb = (512 + tid) / 12, cb = (512 + tid) % 12, rv = tid >> 3, cv = tid & 7;
  const unsigned kinca = ca < 8 ? 64u * 2048u : 64u * 512u, kincb = cb < 8 ? 64u * 2048u : 64u * 512u;
  const unsigned kofa = ca < 8 ? (unsigned)WS_KV + (unsigned)(((tok0 + ra) * 1024 + h * 128 + ca * 8) * 2) : (unsigned)WS_CKVR + (unsigned)(((tok0 + ra) * 256 + 128 + (ca - 8) * 8) * 2);
  const unsigned kofb = cb < 8 ? (unsigned)WS_KV + (unsigned)(((tok0 + rb) * 1024 + h * 128 + cb * 8) * 2) : (unsigned)WS_CKVR + (unsigned)(((tok0 + rb) * 256 + 128 + (cb - 8) * 8) * 2);
  const unsigned vofs = (unsigned)WS_KV + (unsigned)(((tok0 + rv) * 1024 + h * 128 + 64 + cv * 8) * 2);
  const int ksta = KSWZ(ra, ca * 16), kstb = KSWZ(rb, cb * 16), vst = v_st(rv, cv * 8);
  const bool two = wid < 4;
  bf16x8 RK0a, RK0b, RV0, RK1a, RK1b, RV1;
#define TLOAD(KA, KB, VV, t) do { KA = *reinterpret_cast<const bf16x8*>(wsb + kofa + (unsigned)(t) * kinca); if (two) KB = *reinterpret_cast<const bf16x8*>(wsb + kofb + (unsigned)(t) * kincb); \
    VV = *reinterpret_cast<const bf16x8*>(wsb + vofs + (unsigned)(t) * (64u * 2048u)); } while (0)
#define TWRITE(KA, KB, VV, t) do { const int bo_ = ((t) & 3) * SHM_K; *(bf16x8*)(K_lds + bo_ + ksta) = KA; if (two) *(bf16x8*)(K_lds + bo_ + kstb) = KB; *(bf16x8*)(V_lds + bo_ + vst) = VV; } while (0)
#define RESC(a) do { if (__any((a) < 1.f)) { if (hi == 0) al_l[r32] = (a); asm volatile("s_waitcnt lgkmcnt(0)" ::: "memory"); \
    _Pragma("unroll") for (int d = 0; d < 2; ++d) _Pragma("unroll") for (int r = 0; r < 16; ++r) o[d][r] *= al_l[crow(r, hi)]; } } while (0)
#define STEP_END() do { asm volatile("s_waitcnt lgkmcnt(0)" ::: "memory"); __builtin_amdgcn_s_barrier(); asm volatile("" ::: "memory"); } while (0)
  f32x16 pA0, pA1, pB0, pB1; float mnA, mnB, alA, alB; bf16x8 pa0, pa1, pa2, pa3; constexpr int NT = SEQ / KVBLK;
  TLOAD(RK0a, RK0b, RV0, 0); TWRITE(RK0a, RK0b, RV0, 0); TLOAD(RK1a, RK1b, RV1, 1); TLOAD(RK0a, RK0b, RV0, 2);
  STEP_END();
  qkt(pA0, pA1, K_lds, qr, r32, hi); partialSM(pA0, pA1, m_reg, mnA, alA);
  TWRITE(RK1a, RK1b, RV1, 1); TLOAD(RK1a, RK1b, RV1, 3);
  STEP_END();
  for (int s = 1; s + 1 < NT; s += 2) {
    SBAR(); qkt(pB0, pB1, K_lds + (s & 3) * SHM_K, qr, r32, hi);
    finishSM(pA0, pA1, alA, l_reg, pa0, pa1, pa2, pa3); SBAR();
    TWRITE(RK0a, RK0b, RV0, s + 1);
    if (s + 3 < NT) TLOAD(RK0a, RK0b, RV0, s + 3);
    SBAR();
    pv_d0(o, vb0 + ((s - 1) & 3) * SHM_V, pa0, pa1, pa2, pa3); partialSM(pB0, pB1, m_reg, mnB, alB);
    RESC(alB); STEP_END();
    SBAR(); qkt(pA0, pA1, K_lds + ((s + 1) & 3) * SHM_K, qr, r32, hi);
    finishSM(pB0, pB1, alB, l_reg, pa0, pa1, pa2, pa3); SBAR();
    if (s + 2 < NT) TWRITE(RK1a, RK1b, RV1, s + 2);
    if (s + 4 < NT) TLOAD(RK1a, RK1b, RV1, s + 4);
    SBAR();
    pv_d0(o, vb0 + (s & 3) * SHM_V, pa0, pa1, pa2, pa3); partialSM(pA0, pA1, m_reg, mnA, alA);
    RESC(alA); STEP_END();
  }
  SBAR(); qkt(pB0, pB1, K_lds + ((NT - 1) & 3) * SHM_K, qr, r32, hi);
  finishSM(pA0, pA1, alA, l_reg, pa0, pa1, pa2, pa3); SBAR();
  pv_d0(o, vb0 + ((NT - 2) & 3) * SHM_V, pa0, pa1, pa2, pa3); partialSM(pB0, pB1, m_reg, mnB, alB);
  RESC(alB);
  finishSM(pB0, pB1, alB, l_reg, pa0, pa1, pa2, pa3); SBAR();
  pv_d0(o, vb0 + ((NT - 1) & 3) * SHM_V, pa0, pa1, pa2, pa3);
  if (hi == 0) li_l[r32] = l_reg; asm volatile("s_waitcnt lgkmcnt(0)" ::: "memory");
  bf16_t* Ow = MIX + (size_t)(tok0 + qrow0 + wid * QBLK) * 1024 + 512 + h * 64 + r32;
#pragma unroll
  for (int r = 0; r < 16; ++r) { const int orow = crow(r, hi); const float rl = __builtin_amdgcn_rcpf(li_l[orow]);
#pragma unroll
    for (int d0 = 0; d0 < 2; ++d0) Ow[(size_t)orow * 1024 + d0 * 32] = (bf16_t)(cvt_pk_bf16(o[d0][r] * rl, 0.f) & 0xffffu); }
  STEP_END();
#undef TLOAD
#undef TWRITE
#undef RESC
#undef STEP_END
}
#undef KSWZ
#undef SBAR
}

struct Frame {
    LAS unsigned char* lds; unsigned* ctl; unsigned char* ws; float* out; const float* in[29];
    int tid, lane, wave, G, bid;
};
enum { I_X = 0, I_WIN, I_LRE, I_LIM, I_LDT, I_BRE, I_BIM, I_CRE, I_CIM, I_DSK, I_WGLU, I_BGLU, I_QG, I_WUQ, I_KVG, I_WUKV, I_WO, I_LN1G, I_LN1B, I_WR, I_RB, I_WEG, I_WEU, I_WED, I_WSG, I_WSU, I_WSD, I_LN2G, I_LN2B };

#ifndef MK_TPROBE
#define MK_TPROBE -1
#endif
#define TSUB(F, id) do { if (MK_TPROBE >= 100) { __syncthreads(); if (blockIdx.x == 0 && threadIdx.x == 0) { volatile LAS unsigned* M_ = (volatile LAS unsigned*)((F).lds + MISC_OFF); const unsigned long long tn_ = __builtin_amdgcn_s_memrealtime(); \
    const unsigned long long tl_ = ((unsigned long long)M_[17] << 32) | M_[16]; if ((id) == MK_TPROBE) { const unsigned long long d_ = tn_ - tl_; M_[18] = (unsigned)d_; M_[19] = (unsigned)(d_ >> 32); } M_[16] = (unsigned)tn_; M_[17] = (unsigned)(tn_ >> 32); } } } while (0)
__device__ __forceinline__ int fresh_lane() { int l = (int)(threadIdx.x & 63u); asm volatile("" : "+v"(l)); return l; }
template <class F> __device__ __forceinline__ void transpose_load(const F& f, int k0, int n0, int lane, float (&tv)[32]) {
#pragma unroll
    for (int i = 0; i < 32; ++i) tv[i] = f(k0 + 2 * i + (lane >> 5), n0 + (lane & 31));
}
__device__ __forceinline__ void transpose_store(const float (&tv)[32], bf16_t* Bt, int ldk, int k0, int n0, LAS float* scr, int lane) {
#pragma unroll
    for (int i = 0; i < 32; ++i) scr[(2 * i + (lane >> 5)) * 33 + (lane & 31)] = tv[i];
    asm volatile("s_waitcnt lgkmcnt(0)" ::: "memory");
    const int c = lane & 7;
#pragma unroll
    for (int j = 0; j < 4; ++j) { const int n = (lane >> 3) + 8 * j; const LAS float* s = scr + (8 * c) * 33 + n;
        u32x4 o; o.x = cvt_pk_bf16(s[0 * 33], s[1 * 33]); o.y = cvt_pk_bf16(s[2 * 33], s[3 * 33]); o.z = cvt_pk_bf16(s[4 * 33], s[5 * 33]); o.w = cvt_pk_bf16(s[6 * 33], s[7 * 33]);
        *(u32x4*)(Bt + (size_t)(n0 + n) * ldk + k0 + 8 * c) = o; }
    asm volatile("s_waitcnt lgkmcnt(0)" ::: "memory");
}
template <class F> __device__ __forceinline__ void transpose_item(const F& f, bf16_t* Bt, int ldk, int k0, int n0, LAS float* scr, int lane) {
    float tv[32]; transpose_load(f, k0, n0, lane, tv); transpose_store(tv, Bt, ldk, k0, n0, scr, lane);
}
__device__ __forceinline__ int rope_perm_src(int p) { return (p & 1) ? 16 + (p >> 1) : (p >> 1); }
struct SsmPar { float lr, li, dt, kr, ki; };
__device__ __forceinline__ SsmPar ssm_par(const float* lam_re, const float* lam_im, const float* log_dt, int d, int g, int n) {
    SsmPar p; p.lr = fminf(lam_re[(d * 32 + g) * 64 + n], -1e-4f); p.li = lam_im[(d * 32 + g) * 64 + n]; p.dt = expf(log_dt[d * 32 + g]);
    const float x = p.lr * p.dt, th = p.li * p.dt;
    const float em1 = expm1f(x), cs = cosf(th), sn = sinf(th), sh = sinf(0.5f * th);
    const float ai = (em1 + 1.f) * sn, arm1 = em1 * cs - 2.f * sh * sh, den = p.lr * p.lr + p.li * p.li;
    p.kr = (arm1 * p.lr + ai * p.li) / den; p.ki = (ai * p.lr - arm1 * p.li) / den; return p;
}
__device__ __forceinline__ void ssm_pow_xt(float x, float th, float e, float& pr, float& pi) {
    const float mag = __builtin_amdgcn_exp2f(x * e * 1.4426950408889634f); double trd = (double)th * (double)e * 0.15915494309189535; trd -= rint(trd); const float tr = (float)trd;
    pr = mag * __builtin_amdgcn_cosf(tr); pi = mag * __builtin_amdgcn_sinf(tr);
}
__device__ __forceinline__ void ssm_pow(const SsmPar& p, float e, float& pr, float& pi) { ssm_pow_xt(p.lr * p.dt, p.li * p.dt, e, pr, pi); }

__device__ __forceinline__ void p0_ssm_item(Frame& F, int g, int j) {
    LAS float* Pr = (LAS float*)F.lds;
    LAS float* Pi = Pr + 2 * 64 * 33;
    LAS float* Br = Pi + 2 * 64 * 33;
    LAS float* Bi = Br + 2 * 64 * 16;
    LAS float* Cr = Bi + 2 * 64 * 16;
    LAS float* Ci = Cr + 2 * 16 * 64;
    LAS float* Par = Ci + 2 * 16 * 64;
    const float* lam_re = F.in[I_LRE]; const float* lam_im = F.in[I_LIM]; const float* log_dt = F.in[I_LDT];
    __syncthreads();
    if (F.tid < 128) { const SsmPar p = ssm_par(lam_re, lam_im, log_dt, F.tid >> 6, g, F.tid & 63); Par[F.tid * 4] = p.lr * p.dt; Par[F.tid * 4 + 1] = p.li * p.dt; Par[F.tid * 4 + 2] = p.kr; Par[F.tid * 4 + 3] = p.ki; }
    for (int idx = F.tid; idx < 2 * 16 * 64; idx += 512) { const int n = idx & 63, pp = (idx >> 6) & 15, d = idx >> 10;
        Cr[idx] = F.in[I_CRE][((d * 32 + g) * 16 + pp) * 64 + n]; Ci[idx] = F.in[I_CIM][((d * 32 + g) * 16 + pp) * 64 + n]; }
    __syncthreads();
    for (int idx = F.tid; idx < 2 * 64 * 33; idx += 512) { const int tau = idx % 33, dn = idx / 33; float pr, pi; ssm_pow_xt(Par[dn * 4], Par[dn * 4 + 1], (float)tau, pr, pi); Pr[idx] = pr; Pi[idx] = pi; }
    for (int idx = F.tid; idx < 2 * 64 * 16; idx += 512) { const int q = idx & 15, dn = idx >> 4, n = dn & 63, d = dn >> 6; const float kr = Par[dn * 4 + 2], ki = Par[dn * 4 + 3];
        const float br = F.in[I_BRE][((d * 32 + g) * 64 + n) * 16 + q], bi = F.in[I_BIM][((d * 32 + g) * 64 + n) * 16 + q];
        Br[idx] = kr * br - ki * bi; Bi[idx] = kr * bi + ki * br; }
    __syncthreads();
    float* Kt = (float*)(F.ws + WS_KT) + (size_t)g * 16384;
    { const int blk = 512 * j + F.tid;
      const int q2 = blk & 7, p2 = (blk >> 3) & 7, tau = (blk >> 6) & 31, d = blk >> 11; float s00 = 0.f, s01 = 0.f, s10 = 0.f, s11 = 0.f;
      for (int n = 0; n < 64; ++n) { const float pr = Pr[(d * 64 + n) * 33 + tau], pi = Pi[(d * 64 + n) * 33 + tau];
          const float b0r = Br[(d * 64 + n) * 16 + 2 * q2], b0i = Bi[(d * 64 + n) * 16 + 2 * q2], b1r = Br[(d * 64 + n) * 16 + 2 * q2 + 1], b1i = Bi[(d * 64 + n) * 16 + 2 * q2 + 1];
          const float d0r = pr * b0r - pi * b0i, d0i = pr * b0i + pi * b0r, d1r = pr * b1r - pi * b1i, d1i = pr * b1i + pi * b1r;
          const float c0r = Cr[(d * 16 + 2 * p2) * 64 + n], c0i = Ci[(d * 16 + 2 * p2) * 64 + n], c1r = Cr[(d * 16 + 2 * p2 + 1) * 64 + n], c1i = Ci[(d * 16 + 2 * p2 + 1) * 64 + n];
          s00 += c0r * d0r - c0i * d0i; s01 += c0r * d1r - c0i * d1i; s10 += c1r * d0r - c1i * d0i; s11 += c1r * d1r - c1i * d1i; }
      float* kp = Kt + ((size_t)(d * 32 + tau) * 16 + 2 * p2) * 16 + 2 * q2; kp[0] = s00; kp[1] = s01; kp[16] = s10; kp[17] = s11; }
    bf16_t* Wst = (bf16_t*)(F.ws + WS_WST) + (size_t)g * 256 * 512;
    for (int pc = F.tid; pc < 32 * 64; pc += 512) { const int row = 32 * j + (pc >> 6), k0 = (pc & 63) * 8, s = k0 >> 4, q0 = k0 & 15;
        const int d = row >> 7, ri = (row >> 6) & 1, n = row & 63, e = d ? s : (CHK - 1 - s);
        const float pr = Pr[(d * 64 + n) * 33 + e], pi = Pi[(d * 64 + n) * 33 + e]; float v[8];
#pragma unroll
        for (int t = 0; t < 8; ++t) { const float br = Br[(d * 64 + n) * 16 + q0 + t], bi = Bi[(d * 64 + n) * 16 + q0 + t]; v[t] = ri ? (pr * bi + pi * br) : (pr * br - pi * bi); }
        u32x4 o; o.x = cvt_pk_bf16(v[0], v[1]); o.y = cvt_pk_bf16(v[2], v[3]); o.z = cvt_pk_bf16(v[4], v[5]); o.w = cvt_pk_bf16(v[6], v[7]);
        *(u32x4*)(Wst + (size_t)row * 512 + k0) = o; }
    bf16_t* Mo = (bf16_t*)(F.ws + WS_MO) + (size_t)g * 512 * UHK;
    for (int pc = F.tid; pc < 64 * 32; pc += 512) { const int row = 64 * j + (pc >> 5), kk = (pc & 31) * 8, d = kk >> 7, ri = (kk >> 6) & 1, n0 = kk & 63, tq = row >> 4, pp = row & 15;
        const int e = d ? (CHK - tq) : (tq + 1); float v[8];
#pragma unroll
        for (int t = 0; t < 8; ++t) { const int n = n0 + t; const float pr = Pr[(d * 64 + n) * 33 + e], pi = Pi[(d * 64 + n) * 33 + e], cr = Cr[(d * 16 + pp) * 64 + n], ci = Ci[(d * 16 + pp) * 64 + n];
            v[t] = ri ? -(cr * pi + ci * pr) : (cr * pr - ci * pi); }
        u32x4 o; o.x = cvt_pk_bf16(v[0], v[1]); o.y = cvt_pk_bf16(v[2], v[3]); o.z = cvt_pk_bf16(v[4], v[5]); o.w = cvt_pk_bf16(v[6], v[7]);
        *(u32x4*)(Mo + (size_t)row * UHK + 512 + kk) = o; }
}

template <int PART> __device__ __forceinline__ void p0_prologue(Frame& F) {
    const int lane = fresh_lane();
    if (PART == 1) {
        for (int it = F.bid; it < 256; it += F.G) p0_ssm_item(F, it >> 3, it & 7);
        __syncthreads();
    }
    if (PART == 0) {
        float* rc = (float*)(F.ws + WS_ROPE); float* rs = rc + 2048 * 16;
        for (int idx = F.bid * 512 + F.tid; idx < 2048 * 16; idx += F.G * 512) { const int i = idx & 15, pos = idx >> 4;
            const float inv = expf(-9.210340371976184f * (float)i * (1.f / 16.f)); const float a = (float)pos * inv; rc[idx] = cosf(a); rs[idx] = sinf(a); } }
    LAS float* scr = (LAS float*)(F.lds + F.wave * 16384);
    const int gw = F.bid * 8 + F.wave, NGW = F.G * 8;
    constexpr int I_A = 512, I_B = 128, I_C = 96, I_D = 128, I_E = 128, I_F = 512, I_G = 65 * 256, I_H = 65 * 128;
    constexpr int NITEMS = I_A + I_B + I_C + I_D + I_E + I_F + I_G + I_H;
    for (int it = (PART == 0 ? gw : I_A + gw); it < (PART == 0 ? I_A : NITEMS); it += NGW) {
        int r = it;
        if (r < I_A) { const float* W = F.in[I_WIN]; const int kb = r / 32, nb = r % 32;
            transpose_item([&](int k, int n) -> float { if (n >= 928) return 0.f; const int src = n < 896 ? n : 896 + rope_perm_src(n - 896); return W[(size_t)k * 928 + src]; }, (bf16_t*)(F.ws + WS_WIN), 1024, kb * 64, nb * 32, scr, lane); continue; } r -= I_A;
        if (r < I_B) { const float* W = F.in[I_WGLU]; const int kb = r / 16, nb = r % 16;
            transpose_item([&](int k, int n) -> float { return W[(size_t)k * 512 + n]; }, (bf16_t*)(F.ws + WS_WGLU), 512, kb * 64, nb * 32, scr, lane); continue; } r -= I_B;
        if (r < I_C) { const float* W = F.in[I_WUQ]; const float* gq = F.in[I_QG]; const int kb = r / 24, nb = r % 24;
            transpose_item([&](int k, int n) -> float { const int hh = n / 96, jj = n % 96; const int src = jj < 64 ? n : hh * 96 + 64 + rope_perm_src(jj - 64); return W[(size_t)k * 768 + src] * gq[k]; }, (bf16_t*)(F.ws + WS_WUQ), 256, kb * 64, nb * 32, scr, lane); continue; } r -= I_C;
        if (r < I_D) { const float* W = F.in[I_WUKV]; const float* gk = F.in[I_KVG]; const int kb = r / 32, nb = r % 32;
            transpose_item([&](int k, int n) -> float { return k < 128 ? W[(size_t)k * 1024 + n] * gk[k] : 0.f; }, (bf16_t*)(F.ws + WS_WUKV), 256, kb * 64, nb * 32, scr, lane); continue; } r -= I_D;
        if (r < I_E) { const float* W = F.in[I_WR]; const int kb = r / 8, nb = r % 8;
            transpose_item([&](int k, int n) -> float { return n < 64 ? W[(size_t)k * 64 + n] : 0.f; }, (bf16_t*)(F.ws + WS_WR), 1024, kb * 64, nb * 32, scr, lane); continue; } r -= I_E;
        if (r < I_F) { const float* W = F.in[I_WO]; const int kb = r / 32, nb = r % 32;
            transpose_item([&](int k, int n) -> float { return W[(size_t)k * 1024 + n]; }, (bf16_t*)(F.ws + WS_WO), 1024, kb * 64, nb * 32, scr, lane); continue; } r -= I_F;
        const int it2 = it + NGW; const bool has2 = it2 < NITEMS; float tv0[32], tv1[32];
        auto geom = [&](int rr_, const float*& W0, const float*& W1, bf16_t*& dst, int& ldk, int& k0, int& n0, bool& gu) {
            if (rr_ < I_G) { const int e = rr_ / 256, q = rr_ % 256; gu = true; k0 = (q / 16) * 64; n0 = (q % 16) * 32; ldk = 1024;
                W0 = e < 64 ? F.in[I_WEG] + (size_t)e * 1024 * 256 : F.in[I_WSG]; W1 = e < 64 ? F.in[I_WEU] + (size_t)e * 1024 * 256 : F.in[I_WSU]; dst = (bf16_t*)(F.ws + WS_WGU) + (size_t)e * 512 * 1024; }
            else { const int q_ = rr_ - I_G, e = q_ / 128, q = q_ % 128; gu = false; k0 = (q / 32) * 64; n0 = (q % 32) * 32; ldk = 256;
                W0 = e < 64 ? F.in[I_WED] + (size_t)e * 256 * 1024 : F.in[I_WSD]; W1 = W0; dst = (bf16_t*)(F.ws + WS_WD) + (size_t)e * 1024 * 256; } };
        auto val = [&](bool gu, const float* W0, const float* W1, int k, int n) -> float { if (gu) { const int r_ = n & 255, col = 128 * (n >> 8) + 32 * (r_ >> 6) + (r_ & 31); return ((r_ >> 5) & 1) ? W1[(size_t)k * 256 + col] : W0[(size_t)k * 256 + col]; } return W0[(size_t)k * 1024 + n]; };
        const float *Wa0, *Wa1, *Wb0, *Wb1; bf16_t *da, *db; int lka, ka, na, lkb, kb_, nb_; bool gua, gub;
        geom(r, Wa0, Wa1, da, lka, ka, na, gua);
        transpose_load([&](int k, int n) -> float { return val(gua, Wa0, Wa1, k, n); }, ka, na, lane, tv0);
        if (has2) { geom(it2 - (I_A + I_B + I_C + I_D + I_E + I_F), Wb0, Wb1, db, lkb, kb_, nb_, gub); transpose_load([&](int k, int n) -> float { return val(gub, Wb0, Wb1, k, n); }, kb_, nb_, lane, tv1); }
        transpose_store(tv0, da, lka, ka, na, scr, lane);
        if (has2) transpose_store(tv1, db, lkb, kb_, nb_, scr, lane);
        it += NGW;
    }
    if (PART == 0) {
      const float* x = F.in[I_X]; bf16_t* xb = (bf16_t*)(F.ws + WS_XB); const size_t N8 = (size_t)T * DM / 8, st = (size_t)F.G * 512;
      for (size_t i = (size_t)F.bid * 512 + F.tid; i < N8; i += 4 * st) {
          f32x4 a[4], b[4];
#pragma unroll
          for (int u = 0; u < 4; ++u) { const size_t ii = i + u * st < N8 ? i + u * st : i; a[u] = __builtin_nontemporal_load((const f32x4*)(x + ii * 8)); b[u] = __builtin_nontemporal_load((const f32x4*)(x + ii * 8 + 4)); }
#pragma unroll
          for (int u = 0; u < 4; ++u) if (i + u * st < N8) *(u32x4*)(xb + (i + u * st) * 8) = pack8(a[u], b[u]); } }
    if (PART == 1) { asm volatile("s_waitcnt vmcnt(0) lgkmcnt(0)" ::: "memory"); __syncthreads(); }
}

__device__ __forceinline__ void scan_unit(Frame& F, int g, int pm) {
    const bf16_t* S = (const bf16_t*)(F.ws + WS_S); bf16_t* UH = (bf16_t*)(F.ws + WS_UH);
    {
        const int n = F.tid & 63, d = (F.tid >> 6) & 1, b = pm * 4 + (F.tid >> 7);
        const SsmPar p = ssm_par(F.in[I_LRE], F.in[I_LIM], F.in[I_LDT], d, g, n); float acr, aci; ssm_pow(p, (float)CHK, acr, aci);
        float hr = 0.f, hi = 0.f;
        const size_t rbase = (size_t)g * UHR + (size_t)b * NCHK;
#pragma unroll
        for (int hb = 0; hb < 2; ++hb) {
            float sr[32], si[32];
#pragma unroll
            for (int st = 0; st < 32; ++st) { const int ci = d ? (NCHK - 1 - (hb * 32 + st)) : (hb * 32 + st);
                sr[st] = __uint_as_float((unsigned)S[(rbase + ci) * 256 + d * 128 + n] << 16); si[st] = __uint_as_float((unsigned)S[(rbase + ci) * 256 + d * 128 + 64 + n] << 16); }
#pragma unroll
            for (int st = 0; st < 32; ++st) { const int ci = d ? (NCHK - 1 - (hb * 32 + st)) : (hb * 32 + st);
                bf16_t* hp = UH + (rbase + ci) * UHK + 512 + d * 128 + n;
                hp[0] = (bf16_t)(cvt_pk_bf16(hr, 0.f) & 0xffffu); hp[64] = (bf16_t)(cvt_pk_bf16(hi, 0.f) & 0xffffu);
                const float nr = acr * hr - aci * hi + sr[st], ni = acr * hi + aci * hr + si[st]; hr = nr; hi = ni; }
        }
    }
}
__device__ __forceinline__ void mo_fill(Frame& F) {
    const float* Kt = (const float*)(F.ws + WS_KT); bf16_t* Mo = (bf16_t*)(F.ws + WS_MO);
    for (int pc = F.bid * 512 + F.tid; pc < 32 * 512 * 64; pc += F.G * 512) {
        const int k0 = (pc & 63) * 8, row = (pc >> 6) & 511, g = pc >> 15, s = k0 >> 4, q0 = k0 & 15, tq = row >> 4, pp = row & 15;
        f32x4 v0 = {0.f, 0.f, 0.f, 0.f}, v1 = {0.f, 0.f, 0.f, 0.f};
        if (tq >= s) { const float* kp = Kt + ((size_t)(g * 2 + 0) * 32 + (tq - s)) * 256 + pp * 16 + q0; v0 += *(const f32x4*)kp; v1 += *(const f32x4*)(kp + 4); }
        if (s >= tq) { const float* kp = Kt + ((size_t)(g * 2 + 1) * 32 + (s - tq)) * 256 + pp * 16 + q0; v0 += *(const f32x4*)kp; v1 += *(const f32x4*)(kp + 4); }
        if (s == tq && (pp >> 3) == (q0 >> 3)) { const float dsk = F.in[I_DSK][g * 16 + pp];
#pragma unroll
            for (int j = 0; j < 4; ++j) { if (q0 + j == pp) v0[j] += dsk; if (q0 + 4 + j == pp) v1[j] += dsk; } }
        *(u32x4*)(Mo + ((size_t)g * 512 + row) * UHK + k0) = pack8(v0, v1);
    }
}

__device__ __forceinline__ void p7_ln1(Frame& F) {
    const int lane = fresh_lane();
    const float* g1 = F.in[I_LN1G]; const float* b1 = F.in[I_LN1B]; bf16_t* x1b = (bf16_t*)(F.ws + WS_X1B);
    f32x4 gg[4], bb[4];
#pragma unroll
    for (int j = 0; j < 4; ++j) { const int c = 8 * lane + (j >> 1) * 512 + (j & 1) * 4; gg[j] = *(const f32x4*)(g1 + c); bb[j] = *(const f32x4*)(b1 + c); }
    for (int pm = F.bid; pm < T / 256; pm += F.G)
    for (int row0 = pm * 256 + F.wave; row0 < pm * 256 + 256; row0 += 32) {
        u32x4 w0[4], w1[4];
#pragma unroll
        for (int j = 0; j < 4; ++j) { const bf16_t* rp = x1b + (size_t)(row0 + 8 * j) * 1024 + 8 * lane; w0[j] = *(const u32x4*)rp; w1[j] = *(const u32x4*)(rp + 512); }
#pragma unroll
        for (int j = 0; j < 4; ++j) {
            bf16_t* rp = x1b + (size_t)(row0 + 8 * j) * 1024 + 8 * lane; f32x4 v[4]; unpack8(w0[j], v[0], v[1]); unpack8(w1[j], v[2], v[3]);
            float s = 0.f;
#pragma unroll
            for (int q = 0; q < 4; ++q) s += (v[q][0] + v[q][1]) + (v[q][2] + v[q][3]);
            const float mean = wave_sum(s) * (1.f / 1024.f); float qq = 0.f;
#pragma unroll
            for (int q = 0; q < 4; ++q) { v[q] = v[q] - mean; qq += (v[q][0] * v[q][0] + v[q][1] * v[q][1]) + (v[q][2] * v[q][2] + v[q][3] * v[q][3]); }
            const float rstd = __builtin_amdgcn_rsqf(wave_sum(qq) * (1.f / 1024.f) + LN_EPS);
#pragma unroll
            for (int q = 0; q < 4; ++q) v[q] = v[q] * rstd * gg[q] + bb[q];
            *(u32x4*)rp = pack8(v[0], v[1]); *(u32x4*)(rp + 512) = pack8(v[2], v[3]);
        }
    }
}

__device__ __forceinline__ void route_batch(Frame& F, int bt) {
    LAS int* hist = (LAS int*)(F.lds); LAS int* base = hist + 64;
    const float* LG = (const float*)(F.ws + WS_LOGIT); int* rowtok = (int*)(F.ws + WS_ROWTOK); int* tslot = (int*)(F.ws + WS_TSLOT); float* topw = (float*)(F.ws + WS_TOPW);
    {
        __syncthreads();
        if (F.tid < 64) hist[F.tid] = 0;
        __syncthreads();
        const int tok = bt * 256 + F.tid, ch = (bt * 256) / CAPC;
        int idx[6], lr[6]; float w[6];
        if (F.tid < 256) {
            float lg[64];
#pragma unroll
            for (int j = 0; j < 16; ++j) { const f32x4 v = *(const f32x4*)(LG + (size_t)tok * 64 + 4 * j); lg[4 * j] = v[0]; lg[4 * j + 1] = v[1]; lg[4 * j + 2] = v[2]; lg[4 * j + 3] = v[3]; }
            route_token(lg, F.in[I_RB], idx, w);
#pragma unroll
            for (int k = 0; k < 6; ++k) lr[k] = atomicAdd((int*)&hist[idx[k]], 1);
        }
        __syncthreads();
        if (F.tid < 64) base[F.tid] = (int)__hip_atomic_fetch_add(F.ctl + CW_CNT + 64 * (ch * 65 + F.tid), (unsigned)hist[F.tid], __ATOMIC_RELAXED, __HIP_MEMORY_SCOPE_AGENT);
        __syncthreads();
        if (F.tid < 256) {
#pragma unroll
            for (int k = 0; k < 6; ++k) { const int slot = base[idx[k]] + lr[k];
                rowtok[(size_t)(ch * 64 + idx[k]) * CAPC + slot] = tok; tslot[(size_t)tok * 8 + k] = (idx[k] << 16) | slot; topw[(size_t)tok * 8 + k] = w[k]; }
        }
    }
}

__device__ __forceinline__ void p12_combine(Frame& F, int ch) {
    const int lane = fresh_lane();
    const MoeTab tb = moe_tab(F.lds); const int t0 = tb.tbase[ch * 65];
    const unsigned char* Y8 = F.ws + WS_Y; const bf16_t* YS = (const bf16_t*)(F.ws + WS_YS); const bf16_t* x1b = (const bf16_t*)(F.ws + WS_X1B);
    const int* tslot = (const int*)(F.ws + WS_TSLOT); const float* topw = (const float*)(F.ws + WS_TOPW);
    const float* g2 = F.in[I_LN2G]; const float* b2 = F.in[I_LN2B];
    f32x4 gg[4], bb[4];
#pragma unroll
    for (int j = 0; j < 4; ++j) { const int c = 8 * lane + (j >> 1) * 512 + (j & 1) * 4; gg[j] = *(const f32x4*)(g2 + c); bb[j] = *(const f32x4*)(b2 + c); }
    constexpr int NTK = 4;
    const int stride = F.G * 8;
    for (int tk0 = F.bid * 8 + F.wave; tk0 < CAPC; tk0 += NTK * stride) {
        int ts[NTK][6]; float tw[NTK][6];
#pragma unroll
        for (int t = 0; t < NTK; ++t) { const int tk = tk0 + t * stride < CAPC ? tk0 + t * stride : tk0; const size_t tok = (size_t)ch * CAPC + tk;
#pragma unroll
            for (int k = 0; k < 6; ++k) { ts[t][k] = tslot[tok * 8 + k]; tw[t][k] = topw[tok * 8 + k]; } }
        u32x4 xw[NTK][2], sw[NTK][2]; u32x2 yw[NTK][6][2];
#pragma unroll
        for (int t = 0; t < NTK; ++t) { const int tk = tk0 + t * stride < CAPC ? tk0 + t * stride : tk0; const size_t tok = (size_t)ch * CAPC + tk;
            const bf16_t* xr = x1b + tok * 1024 + 8 * lane; xw[t][0] = *(const u32x4*)xr; xw[t][1] = *(const u32x4*)(xr + 512);
            const bf16_t* yr = YS + (size_t)tk * 1024 + 8 * lane; sw[t][0] = *(const u32x4*)yr; sw[t][1] = *(const u32x4*)(yr + 512);
#pragma unroll
            for (int k = 0; k < 6; ++k) { const int yrow = (tb.tbase[ch * 65 + (ts[t][k] >> 16)] - t0) * 256 + (ts[t][k] & 0xffff);
                const unsigned char* y8 = Y8 + y8_off(yrow, 8 * lane); yw[t][k][0] = *(const u32x2*)y8; yw[t][k][1] = *(const u32x2*)(y8 + 512); } }
#pragma unroll
        for (int t = 0; t < NTK; ++t) {
            const int tk = tk0 + t * stride; if (tk >= CAPC) break;
            const size_t tok = (size_t)ch * CAPC + tk;
            f32x4 a[4]; unpack8(xw[t][0], a[0], a[1]); unpack8(xw[t][1], a[2], a[3]); a[0] *= ALPHA; a[1] *= ALPHA; a[2] *= ALPHA; a[3] *= ALPHA;
            { f32x4 y0, y1, y2, y3; unpack8(sw[t][0], y0, y1); unpack8(sw[t][1], y2, y3); a[0] += y0; a[1] += y1; a[2] += y2; a[3] += y3; }
#pragma unroll
            for (int k = 0; k < 6; ++k) { const float w = tw[t][k] * Y8_INV; f32x4 y0, y1, y2, y3; unpack8_fp8(yw[t][k][0], y0, y1); unpack8_fp8(yw[t][k][1], y2, y3);
                a[0] += y0 * w; a[1] += y1 * w; a[2] += y2 * w; a[3] += y3 * w; }
            float s = 0.f;
#pragma unroll
            for (int j = 0; j < 4; ++j) s += (a[j][0] + a[j][1]) + (a[j][2] + a[j][3]);
            const float mean = wave_sum(s) * (1.f / 1024.f); float q = 0.f;
#pragma unroll
            for (int j = 0; j < 4; ++j) { a[j] = a[j] - mean; q += (a[j][0] * a[j][0] + a[j][1] * a[j][1]) + (a[j][2] * a[j][2] + a[j][3] * a[j][3]); }
            const float rstd = __builtin_amdgcn_rsqf(wave_sum(q) * (1.f / 1024.f) + LN_EPS);
            float* orow = F.out + tok * 1024 + 8 * lane;
#pragma unroll
            for (int j = 0; j < 4; ++j) *(f32x4*)(orow + (j >> 1) * 512 + (j & 1) * 4) = a[j] * rstd * gg[j] + bb[j];
        }
    }
}
}

namespace fx {
constexpr int NPHASE = 11 + 2 * NCH;
struct Args { const float* in[29]; float* out; unsigned char* ws; int ph_lo, ph_hi; };

__global__ void __launch_bounds__(512, 2) fwd(Args args) {
    extern __shared__ __attribute__((aligned(16))) unsigned char lds_raw[];
    Frame F;
    F.lds = (LAS unsigned char*)lds_raw; F.ws = args.ws; F.ctl = (unsigned*)(args.ws + WS_CTL); F.out = args.out;
#pragma unroll
    for (int i = 0; i < 29; ++i) F.in[i] = args.in[i];
    F.tid = threadIdx.x; F.lane = F.tid & 63; F.wave = __builtin_amdgcn_readfirstlane(F.tid >> 6); F.G = gridDim.x; F.bid = blockIdx.x;
    volatile LAS unsigned* MISC = (volatile LAS unsigned*)(F.lds + MISC_OFF);
    if (F.tid < 32) MISC[F.tid] = 0u;
    __syncthreads();
    const int lo = args.ph_lo, hi = args.ph_hi;
    XcdBarrier bar; bar.bar = F.ctl + CW_BAR; bar.x = 0; bar.st = MISC + 8;
    if (hi - lo > 1) bar = xcd_barrier_post(F.ctl + CW_BAR, MISC + 8);
#ifndef PH_MASK
#define PH_MASK 0xFFFFFFFFu
#endif
#define IN(k) (((PH_MASK >> ((k) > 11 ? 11 + (((k) - 11) & 1) : (k))) & 1u) && lo <= (k) && (k) < hi)
#define SEAM(k) do { if (IN(k) && IN((k) + 1)) xcd_barrier(bar); if (MK_TPROBE >= 300 && blockIdx.x == 0 && threadIdx.x == 0) { const unsigned long long cn_ = __builtin_amdgcn_s_memtime(); \
        const unsigned long long cl_ = ((unsigned long long)MISC[25] << 32) | MISC[24]; if ((k) + 300 == MK_TPROBE) { const unsigned long long dc_ = cn_ - cl_; MISC[26] = (unsigned)dc_; MISC[27] = (unsigned)(dc_ >> 32); } MISC[24] = (unsigned)cn_; MISC[25] = (unsigned)(cn_ >> 32); } \
     if (MK_TPROBE >= 0 && blockIdx.x == 0 && threadIdx.x == 0) { const unsigned long long tn_ = __builtin_amdgcn_s_memrealtime(); \
        const unsigned long long tl_ = ((unsigned long long)MISC[17] << 32) | MISC[16]; if (((k) == MK_TPROBE && MK_TPROBE < 100) || (k) + 300 == MK_TPROBE) { const unsigned long long d_ = tn_ - tl_; MISC[18] = (unsigned)d_; MISC[19] = (unsigned)(d_ >> 32); } if (MK_TPROBE == 200 + (k)) { MISC[18] = MISC[22]; MISC[19] = MISC[23]; } MISC[22] = 0u; MISC[23] = 0u; MISC[16] = (unsigned)tn_; MISC[17] = (unsigned)(tn_ >> 32); } } while (0)
    unsigned char* ws = args.ws;
    bf16_t* UH = (bf16_t*)(ws + WS_UH); bf16_t* CQ = (bf16_t*)(ws + WS_CQ); bf16_t* CKVR = (bf16_t*)(ws + WS_CKVR); bf16_t* Qb = (bf16_t*)(ws + WS_Q); bf16_t* KVb = (bf16_t*)(ws + WS_KV);
    bf16_t* SPRE = (bf16_t*)(ws + WS_SPRE); bf16_t* MIX = (bf16_t*)(ws + WS_MIX);
    float* ssqq = (float*)(ws + WS_SSQQ); float* ssqkv = (float*)(ws + WS_SSQKV); const float* ropec = (const float*)(ws + WS_ROPE); const float* ropes = ropec + 2048 * 16;

    if (MK_TPROBE >= 0 && blockIdx.x == 0 && threadIdx.x == 0) { const unsigned long long tn_ = __builtin_amdgcn_s_memrealtime(); MISC[16] = (unsigned)tn_; MISC[17] = (unsigned)(tn_ >> 32); }
    if (MK_TPROBE == 500 && threadIdx.x == 0) __hip_atomic_store(F.ctl + CW_DBG + 64 + blockIdx.x, 1u + xb_xcc_id(), __ATOMIC_RELAXED, __HIP_MEMORY_SCOPE_AGENT);
    if (IN(0)) { p0_prologue<0>(F); } SEAM(0);
    if (IN(1)) {
        const bool conv_first = ((F.bid >> 3) & 1) != 0;
        if (conv_first) p0_prologue<1>(F);
        { PlainOrder S; S.init(ws + WS_XB, 1024, ws + WS_WIN, 1024, T, 1024, F.G, F.bid);
          EpiWin E{UH, CQ, CKVR, ssqq, ssqkv, ropec, ropes};
          gemm_phase<EpiWin, PlainOrder, true, false>(F.lds, 1024, 1024, 1024, S, E); }
        if (!conv_first) p0_prologue<1>(F);
    } SEAM(1);
    if (IN(2)) {
        { GroupOrder S; S.init(UH, ws + WS_WST, 512, 1, F.G, F.bid); EpiSt E{(bf16_t*)(ws + WS_S)};
          gemm_phase<EpiSt, GroupOrder, true, false>(F.lds, UHK, 512, 512, S, E);
          asm volatile("s_waitcnt vmcnt(0)" ::: "memory"); __syncthreads();
          Unit u; for (int i = 0; S.next(i, u); ++i) scan_unit(F, u.i0, u.i1); }
        mo_fill(F);
        { PlainOrder S; S.init(CQ, 256, ws + WS_WUQ, 256, T, 768, F.G, F.bid); EpiQ E{Qb, ssqq, ropec, ropes};
          gemm_phase<EpiQ, PlainOrder, true, false>(F.lds, 256, 256, 256, S, E); }
        { PlainOrder S; S.init(CKVR, 256, ws + WS_WUKV, 256, T, 1024, F.G, F.bid); EpiKV E{KVb, ssqkv};
          gemm_phase<EpiKV, PlainOrder, true, false>(F.lds, 256, 256, 128, S, E); }
    } SEAM(2);
    if (IN(4)) {
#ifndef SUB4
#define SUB4 3
#endif
        if (SUB4 & 2) REP(40) for (int i = 0;; ++i) { const long L = (long)i * F.G + F.bid; if (L >= 2048) break;
            const int un = xcd_remap((int)L, 2048), pair = un >> 3, qb = un & 7, b = pair >> 3, h = pair & 7;
            att::attn_unit(ws, Qb, MIX, b * SEQ, qb * 256, h, (char*)lds_raw); }
        if (SUB4 & 1) DUP2(4, { GroupOrder S; S.init(UH, ws + WS_MO, UHK, 2, F.G, F.bid); EpiSsmOut E{SPRE};
          gemm_phase<EpiSsmOut, GroupOrder, true, false>(F.lds, UHK, UHK, UHK, S, E); });
    } SEAM(4);
    if (IN(5)) {
        { PanelOrder S; S.init(SPRE, SPRE_LD, ws + WS_WGLU, 512, T, 512, F.G, F.bid); EpiGlu E{SPRE, MIX, F.in[I_BGLU]};
          gemm_phase<EpiGlu, PanelOrder, true, false>(F.lds, SPRE_LD, 512, 512, S, E); }
        asm volatile("s_waitcnt vmcnt(0)" ::: "memory"); __syncthreads();
        { PanelOrder S; S.init(MIX, 1024, ws + WS_WO, 1024, T, 1024, F.G, F.bid); EpiWo E{(bf16_t*)(ws + WS_X1B)};
          gemm_phase<EpiWo, PanelOrder, true, false>(F.lds, 1024, 1024, 1024, S, E); }
        asm volatile("s_waitcnt vmcnt(0)" ::: "memory"); __syncthreads();
        p7_ln1(F);
        asm volatile("s_waitcnt vmcnt(0)" ::: "memory"); __syncthreads();
        { PanelOrder S; S.init(ws + WS_X1B, 1024, ws + WS_WGU + (size_t)64 * 512 * 1024 * 2, 1024, T, 768, F.G, F.bid); EpiSharedRouter E{(bf16_t*)(ws + WS_HS), (float*)(ws + WS_LOGIT)};
          gemm_phase<EpiSharedRouter, PanelOrder, true, false>(F.lds, 1024, 1024, 1024, S, E);
          asm volatile("s_waitcnt vmcnt(0)" ::: "memory"); __syncthreads();
          Unit u; for (int i = 0; S.next(i, u); ++i) if (u.i1 == 2) route_batch(F, u.i0); }
    } SEAM(8);
    if (IN(10)) {
        moe_build_tab(F.lds, F.ctl);
        GateUpOrder S; S.init(F.lds, ws + WS_X1B, ws + WS_WGU, (const int*)(ws + WS_ROWTOK), F.ctl, 0, F.G, F.bid); EpiGateUp E{(bf16_t*)(ws + WS_H)};
        gemm_phase<EpiGateUp, GateUpOrder, true, true>(F.lds, 1024, 1024, 1024, S, E);
    } SEAM(10);
#pragma unroll
    for (int ch = 0; ch < NCH; ++ch) {
        if (IN(11 + 2 * ch)) {
            moe_build_tab(F.lds, F.ctl);
            { DownOrder S; S.init(ws + WS_H, ws + WS_HS, ws + WS_WD, moe_tab(F.lds), ch, F.G, F.bid); EpiDown E{ws + WS_Y, (bf16_t*)(ws + WS_YS)};
              gemm_phase<EpiDown, DownOrder, true, false, 0, 1>(F.lds, 256, 256, 256, S, E); }
            if (ch + 1 < NCH) { GateUpOrder S; S.init(F.lds, ws + WS_X1B, ws + WS_WGU, (const int*)(ws + WS_ROWTOK), F.ctl, ch + 1, F.G, F.bid); EpiGateUp E{(bf16_t*)(ws + WS_H)};
              gemm_phase<EpiGateUp, GateUpOrder, true, true>(F.lds, 1024, 1024, 1024, S, E); }
        } SEAM(11 + 2 * ch);
        if (IN(12 + 2 * ch)) { moe_build_tab(F.lds, F.ctl); p12_combine(F, ch); } SEAM(12 + 2 * ch);
    }
    if (MK_TPROBE == 500 && blockIdx.x == 0 && threadIdx.x == 0) { unsigned bad = 0; for (unsigned b = 8; b < gridDim.x; ++b) bad += __hip_atomic_load(F.ctl + CW_DBG + 64 + b, __ATOMIC_RELAXED, __HIP_MEMORY_SCOPE_AGENT) != __hip_atomic_load(F.ctl + CW_DBG + 64 + (b & 7u), __ATOMIC_RELAXED, __HIP_MEMORY_SCOPE_AGENT);
        const unsigned long long t0_ = __builtin_amdgcn_s_memrealtime(); if (bad) while (__builtin_amdgcn_s_memrealtime() - t0_ < 100000ull) __builtin_amdgcn_s_sleep(8); }
    if (MK_TPROBE >= 0 && MK_TPROBE != 500 && blockIdx.x == 0 && threadIdx.x == 0) { const unsigned long long d_ = ((unsigned long long)MISC[19] << 32) | MISC[18]; const unsigned long long t0_ = __builtin_amdgcn_s_memrealtime();
        unsigned long long wait_ = 8ull * d_; if (MK_TPROBE >= 300) { const unsigned long long dc_ = ((unsigned long long)MISC[27] << 32) | MISC[26]; wait_ = d_ ? (dc_ * 100ull / d_) * 100ull : 0ull; }
        while (__builtin_amdgcn_s_memrealtime() - t0_ < wait_) __builtin_amdgcn_s_sleep(8); }
#undef IN
#undef SEAM
}

#if MK_DEBUG
__global__ void dbg_cmp(int k, const unsigned char* ws, const float* out_fast, gold::Bufs B, const float* gx1, const float* gout, float* acc) {
    const int t = blockIdx.x;
    float num = 0.f, den = 0.f;
    auto bf = [](const bf16_t* p, size_t i) -> float { return __uint_as_float(((unsigned)p[i]) << 16); };
    int ncol = 0;
    switch (k) { case 0: ncol = 512; break; case 1: ncol = 256; break; case 2: ncol = 160; break; case 3: ncol = 768; break; case 4: ncol = 1024; break; case 5: ncol = 512; break; case 6: ncol = 512; break; case 7: ncol = 512; break; case 8: ncol = 1024; break; default: ncol = 1024; }
    for (int c = threadIdx.x; c < ncol; c += blockDim.x) {
        float f = 0.f, g = 0.f;
        if (k == 0) { const int gg = c >> 4, p = c & 15; f = bf((const bf16_t*)(ws + WS_UH), ((size_t)gg * UHR + (t >> 5)) * UHK + (t & 31) * 16 + p); g = B.proj[(size_t)t * 928 + c]; }
        else if (k == 1) { f = bf((const bf16_t*)(ws + WS_CQ), (size_t)t * 256 + c); g = B.proj[(size_t)t * 928 + 512 + c]; }
        else if (k == 2) { f = bf((const bf16_t*)(ws + WS_CKVR), (size_t)t * 256 + c); g = c < 128 ? B.proj[(size_t)t * 928 + 768 + c] : B.krope[(size_t)t * 32 + rope_perm_src(c - 128)]; }
        else if (k == 3) { const int hh = c / 96, jj = c % 96, src = jj < 64 ? c : hh * 96 + 64 + rope_perm_src(jj - 64); f = bf((const bf16_t*)(ws + WS_Q), (size_t)t * 768 + c); g = B.q[(size_t)t * 768 + src] * QSCALE; }
        else if (k == 4) { f = bf((const bf16_t*)(ws + WS_KV), (size_t)t * 1024 + c); g = B.kv[(size_t)t * 1024 + c]; }
        else if (k == 5) { f = bf((const bf16_t*)(ws + WS_SPRE), (size_t)t * SPRE_LD + c); g = B.spre[(size_t)t * 512 + c]; }
        else if (k == 6) { f = bf((const bf16_t*)(ws + WS_MIX), (size_t)t * 1024 + c); g = B.mix[(size_t)t * 1024 + c]; }
        else if (k == 7) { f = bf((const bf16_t*)(ws + WS_MIX), (size_t)t * 1024 + 512 + c); g = B.mix[(size_t)t * 1024 + 512 + c]; }
        else if (k == 8) { f = bf((const bf16_t*)(ws + WS_X1B), (size_t)t * 1024 + c); g = gx1[(size_t)t * 1024 + c]; }
        else { f = out_fast[(size_t)t * 1024 + c]; g = gout[(size_t)t * 1024 + c]; }
        const float d = f - g; num += d * d; den += g * g;
        if (!(fabsf(f) < 1e30f)) num += 1e30f;
    }
    num = wave_sum(num); den = wave_sum(den);
    if ((threadIdx.x & 63) == 0) { atomicAdd(acc + 2 * k, num); atomicAdd(acc + 2 * k + 1, den); }
}
__global__ void dbg_encode(const float* acc, float* out, int k0, int nk) {
    float c2 = 0.f;
    for (int k = k0; k < k0 + nk; ++k) { const float e = sqrtf(acc[2 * k] / fmaxf(acc[2 * k + 1], 1e-30f)); const float tol = (k == 9) ? 0.08f : 0.04f;
        if (!(e <= tol)) { const int bucket = !(e <= 0.5f) ? 0 : (e > 0.1f ? 1 : 2); c2 = (float)(k - k0 + 1) + 20.f * bucket; break; } }
    if (c2 == 0.f) { if (MK_DBG_NPH >= NPHASE) return; c2 = 90.f; }
    const float c = sqrtf(c2);
    for (size_t i = (size_t)blockIdx.x * blockDim.x + threadIdx.x; i < (size_t)T * 1024; i += (size_t)gridDim.x * blockDim.x) out[i] = c;
}
#endif
}

extern "C" void kernel_launch(void* const* d_in, const int* in_sizes, int n_in, void* d_out, int out_size, void* d_ws, size_t ws_size, hipStream_t stream) {
#if MK_MODE == 0
    gold::In I; const float** p = (const float**)&I;
    for (int i = 0; i < 29; ++i) p[i] = (const float*)d_in[i];
    for (int t0 = 0; t0 < 65536; t0 += 16384) gold::run(I, t0, 16384, (float*)d_ws, (float*)d_out + (size_t)t0 * 1024, (float*)d_out + (size_t)t0 * 1024, stream);
#else
    using namespace fx;
    static int grid = 0;
    if (grid == 0) {
        if (n_in != 29 || ws_size < WS_END) { fprintf(stderr, "kernel_launch: need 29 inputs and >= %zu bytes of workspace (got %d, %zu)\n", (size_t)WS_END, n_in, ws_size); grid = -1; return; }
        int dev = 0, cus = 0, per_cu = 0;
        hipGetDevice(&dev); hipDeviceGetAttribute(&cus, hipDeviceAttributeMultiprocessorCount, dev);
        if (hipFuncSetAttribute((const void*)fwd, hipFuncAttributeMaxDynamicSharedMemorySize, LDS_BYTES) != hipSuccess) { fprintf(stderr, "kernel_launch: hipFuncSetAttribute failed\n"); grid = -1; return; }
        if (hipOccupancyMaxActiveBlocksPerMultiprocessor(&per_cu, (const void*)fwd, 512, LDS_BYTES) != hipSuccess || per_cu < 1) { fprintf(stderr, "kernel_launch: occupancy query says %d\n", per_cu); }
        (void)hipGetLastError();
        grid = cus > 0 ? cus : 256;
    }
    if (grid < 0) return;
    hipMemsetAsync((char*)d_ws + WS_CTL, 0, CTL_BYTES, stream);
    Args a{};
    for (int i = 0; i < 29; ++i) a.in[i] = (const float*)d_in[i];
    a.out = (float*)d_out; a.ws = (unsigned char*)d_ws;
#if MK_MODE == 1
    for (int ph = 0; ph < NPHASE && ph < MK_DBG_NPH; ++ph) { a.ph_lo = ph; a.ph_hi = ph + 1; hipLaunchKernelGGL(fwd, dim3(grid), dim3(512), LDS_BYTES, stream, a); }
#else
    a.ph_lo = 0; a.ph_hi = NPHASE; hipLaunchKernelGGL(fwd, dim3(grid), dim3(512), LDS_BYTES, stream, a);
#endif
#if MK_DEBUG
    {
        gold::In I; const float** p = (const float**)&I;
        for (int i = 0; i < 29; ++i) p[i] = (const float*)d_in[i];
        float* gs = (float*)((char*)d_ws + WS_GOLD); float* gx1 = gs + (size_t)2048 * gold::GOLD_FLOATS_PER_TOK; float* gout = gx1 + (size_t)2048 * 1024;
        gold::Bufs B = gold::run(I, 0, 2048, gs, gx1, gout, stream);
        float* acc = (float*)((char*)d_ws + WS_CTL) + CW_DBG;
        for (int k = 0; k < 10; ++k) hipLaunchKernelGGL(dbg_cmp, dim3(2048), dim3(256), 0, stream, k, (const unsigned char*)d_ws, (const float*)d_out, B, (const float*)gx1, (const float*)gout, acc);
        hipLaunchKernelGGL(dbg_encode, dim3(1024), dim3(256), 0, stream, (const float*)acc, (float*)d_out, MK_DBG_K0, MK_DBG_NK);
    }
#endif
    const hipError_t le = hipPeekAtLastError();
    if (le != hipSuccess) fprintf(stderr, "kernel_launch: launch failed: %s\n", hipGetErrorName(le));
#endif
}
```

```cpp
#define MK_MODE 2
#include <hip/hip_runtime.h>
#include <cstdio>
#include <cstdint>
#include <cmath>
#ifndef MK_MODE
#define MK_MODE 1
#endif
#ifndef MK_DBG_NPH
#define MK_DBG_NPH 99
#endif
#ifndef MK_DBG_K0
#define MK_DBG_K0 0
#endif
#ifndef MK_DBG_NK
#define MK_DBG_NK 10
#endif
#ifndef MK_DUP
#define MK_DUP -1
#endif
#define REP(k) for (int rep_ = 0; rep_ < ((MK_DUP == (k)) ? 2 : 1); ++rep_)
#define DUP2(k, ...) do { __VA_ARGS__ if constexpr (MK_DUP == (k)) { __VA_ARGS__ } } while (0)
#ifndef MK_TPROBE
#define MK_TPROBE -1
#endif
#ifndef MK_STAG
#define MK_STAG 0
#endif
#ifndef MK_DEBUG
#define MK_DEBUG 0
#endif
namespace gold {
constexpr int D_MODEL = 1024, SEQ = 2048, D_SSM = 512, D_IN = 928, NH = 8, QLR = 256, KVLR = 128, ROPE = 32;
constexpr int NEXP = 64, TOPK = 6, DEXP = 256;
constexpr float ALPHA = 1.189207115002721f, LN_EPS = 1e-5f, RMS_EPS = 1e-6f, ATT_SCALE = 0.10206207261596577f;

__global__ void __launch_bounds__(256) sgemm(const float* __restrict__ A, int lda, const float* __restrict__ B, int ldb, float* __restrict__ C, int ldc, int M, int N, int K) {
    __shared__ float As[16][65];
    __shared__ float Bs[16][65];
    const int tid = threadIdx.x, tx = tid & 15, ty = tid >> 4;
    const int m0 = blockIdx.y * 64, n0 = blockIdx.x * 64;
    float acc[4][4];
#pragma unroll
    for (int i = 0; i < 4; ++i)
#pragma unroll
        for (int j = 0; j < 4; ++j) acc[i][j] = 0.f;
    for (int k0 = 0; k0 < K; k0 += 16) {
#pragma unroll
        for (int i = 0; i < 4; ++i) { const int idx = tid + 256 * i, r = idx >> 4, c = idx & 15; As[c][r] = A[(size_t)(m0 + r) * lda + k0 + c]; }
#pragma unroll
        for (int i = 0; i < 4; ++i) { const int idx = tid + 256 * i, r = idx >> 6, c = idx & 63; Bs[r][c] = (n0 + c < N) ? B[(size_t)(k0 + r) * ldb + n0 + c] : 0.f; }
        __syncthreads();
#pragma unroll
        for (int k = 0; k < 16; ++k) {
            float a[4], b[4];
#pragma unroll
            for (int i = 0; i < 4; ++i) a[i] = As[k][ty + 16 * i];
#pragma unroll
            for (int j = 0; j < 4; ++j) b[j] = Bs[k][tx + 16 * j];
#pragma unroll
            for (int i = 0; i < 4; ++i)
#pragma unroll
                for (int j = 0; j < 4; ++j) acc[i][j] = fmaf(a[i], b[j], acc[i][j]);
        }
        __syncthreads();
    }
#pragma unroll
    for (int i = 0; i < 4; ++i)
#pragma unroll
        for (int j = 0; j < 4; ++j) { const int c = n0 + tx + 16 * j; if (c < N) C[(size_t)(m0 + ty + 16 * i) * ldc + c] = acc[i][j]; }
}

__device__ __forceinline__ float gelu_tanh(float x) {
    const float z = 0.7978845608028654f * (x + 0.044715f * x * x * x);
    const float e = __expf(2.f * z);
    const float th = 1.f - 2.f / (1.f + e);
    return 0.5f * x * (1.f + th);
}
__device__ __forceinline__ float sigmoidf_(float x) { return 1.f / (1.f + __expf(-x)); }

struct SsmPar { float ar, ai, kr, ki; };
__device__ __forceinline__ SsmPar ssm_par(const float* lam_re, const float* lam_im, const float* log_dt, int d, int g, int n) {
    const float lr = fminf(lam_re[(d * 32 + g) * 64 + n], -1e-4f), li = lam_im[(d * 32 + g) * 64 + n];
    const float dt = expf(log_dt[d * 32 + g]);
    const float x = lr * dt, th = li * dt;
    const float em1 = expm1f(x), cs = cosf(th), sn = sinf(th), sh = sinf(0.5f * th);
    const float mag = em1 + 1.f;
    SsmPar p; p.ar = mag * cs; p.ai = mag * sn;
    const float arm1 = em1 * cs - 2.f * sh * sh;
    const float den = lr * lr + li * li;
    p.kr = (arm1 * lr + p.ai * li) / den; p.ki = (p.ai * lr - arm1 * li) / den;
    return p;
}

__global__ void __launch_bounds__(64) ssm_naive(const float* __restrict__ proj, int ldp, const float* __restrict__ lam_re, const float* __restrict__ lam_im, const float* __restrict__ log_dt,
                                                const float* __restrict__ b_re, const float* __restrict__ b_im, const float* __restrict__ c_re, const float* __restrict__ c_im,
                                                const float* __restrict__ d_skip, float* __restrict__ spre) {
    const int g = blockIdx.x, b = blockIdx.y, n = threadIdx.x;
    for (int d = 0; d < 2; ++d) {
        const SsmPar P = ssm_par(lam_re, lam_im, log_dt, d, g, n);
        float Br[16], Bi[16], Cr[16], Ci[16];
#pragma unroll
        for (int q = 0; q < 16; ++q) { const float br = b_re[((d * 32 + g) * 64 + n) * 16 + q], bi = b_im[((d * 32 + g) * 64 + n) * 16 + q];
            Br[q] = P.kr * br - P.ki * bi; Bi[q] = P.kr * bi + P.ki * br;
            Cr[q] = c_re[((d * 32 + g) * 16 + q) * 64 + n]; Ci[q] = c_im[((d * 32 + g) * 16 + q) * 64 + n]; }
        float hr = 0.f, hi = 0.f;
        for (int step = 0; step < SEQ; ++step) {
            const int t = d ? (SEQ - 1 - step) : step;
            const float* up = proj + (size_t)(b * SEQ + t) * ldp + g * 16;
            float u[16];
#pragma unroll
            for (int q = 0; q < 16; ++q) u[q] = up[q];
            float bur = 0.f, bui = 0.f;
#pragma unroll
            for (int q = 0; q < 16; ++q) { bur = fmaf(Br[q], u[q], bur); bui = fmaf(Bi[q], u[q], bui); }
            const float nr = P.ar * hr - P.ai * hi + bur, ni = P.ar * hi + P.ai * hr + bui;
            hr = nr; hi = ni;
            float y[16];
#pragma unroll
            for (int p = 0; p < 16; ++p) y[p] = Cr[p] * hr - Ci[p] * hi;
#pragma unroll
            for (int o = 1; o < 64; o <<= 1)
#pragma unroll
                for (int p = 0; p < 16; ++p) y[p] += __shfl_xor(y[p], o);
            if (n < 16) {
                float v = 0.f;
#pragma unroll
                for (int p = 0; p < 16; ++p) if (p == n) v = y[p];
                float* o = spre + (size_t)(b * SEQ + t) * 512 + g * 16 + n;
                if (d == 0) *o = v;
                else { float uu = 0.f;
#pragma unroll
                    for (int p = 0; p < 16; ++p) if (p == n) uu = u[p];
                    *o = gelu_tanh(*o + v + uu * d_skip[g * 16 + n]); }
            }
        }
    }
}
__global__ void glu_ew(const float* __restrict__ spre, const float* __restrict__ gl, const float* __restrict__ bglu, float* __restrict__ mix, int ntok) {
    const size_t i = (size_t)blockIdx.x * 256 + threadIdx.x; if (i >= (size_t)ntok * 512) return;
    const int c = (int)(i & 511); const size_t r = i >> 9;
    mix[r * 1024 + c] = spre[i] * sigmoidf_(gl[i] + bglu[c]);
}
__global__ void rmsnorm_rows(const float* __restrict__ in, int ld, int off, int n, const float* __restrict__ g, float* __restrict__ out, int ntok) {
    const int r = blockIdx.x * 256 + threadIdx.x; if (r >= ntok) return;
    const float* p = in + (size_t)r * ld + off; float s = 0.f;
    for (int j = 0; j < n; ++j) s = fmaf(p[j], p[j], s);
    const float rs = rsqrtf(s / n + RMS_EPS);
    for (int j = 0; j < n; ++j) out[(size_t)r * n + j] = p[j] * rs * g[j];
}
__device__ __forceinline__ void rope_cs(int pos, int i, float& c, float& s) {
    const float inv = expf(-9.210340371976184f * (float)i * (1.f / 16.f));
    const float a = (float)pos * inv; c = cosf(a); s = sinf(a);
}
__global__ void rope_ew(float* __restrict__ q, const float* __restrict__ proj, int ldp, float* __restrict__ krope, int ntok) {
    const int idx = blockIdx.x * 256 + threadIdx.x; if (idx >= ntok * 9 * 16) return;
    const int i = idx & 15, hh = (idx >> 4) % 9, r = idx / 144, pos = r % SEQ;
    float c, s; rope_cs(pos, i, c, s);
    if (hh < 8) { float* p = q + (size_t)r * 768 + hh * 96 + 64; const float t1 = p[i], t2 = p[i + 16]; p[i] = t1 * c - t2 * s; p[i + 16] = t1 * s + t2 * c; }
    else { const float* p = proj + (size_t)r * ldp + 896; const float t1 = p[i], t2 = p[i + 16]; krope[(size_t)r * 32 + i] = t1 * c - t2 * s; krope[(size_t)r * 32 + i + 16] = t1 * s + t2 * c; }
}
__global__ void __launch_bounds__(64) attn_naive(const float* __restrict__ q, const float* __restrict__ kv, const float* __restrict__ krope, float* __restrict__ mix) {
    const int qi = blockIdx.x * 64 + threadIdx.x, h = blockIdx.y, b = blockIdx.z;
    const size_t r = (size_t)b * SEQ + qi;
    float qv[96], o[64];
#pragma unroll
    for (int d = 0; d < 96; ++d) qv[d] = q[r * 768 + h * 96 + d] * ATT_SCALE;
#pragma unroll
    for (int d = 0; d < 64; ++d) o[d] = 0.f;
    float m = -1e30f, l = 0.f;
    for (int s = 0; s < SEQ; ++s) {
        const size_t kr = (size_t)b * SEQ + s;
        const float4* kn = (const float4*)(kv + kr * 1024 + h * 128);
        const float4* kp = (const float4*)(krope + kr * 32);
        float sc = 0.f;
#pragma unroll
        for (int d = 0; d < 16; ++d) { const float4 k4 = kn[d]; sc = fmaf(qv[4 * d], k4.x, sc); sc = fmaf(qv[4 * d + 1], k4.y, sc); sc = fmaf(qv[4 * d + 2], k4.z, sc); sc = fmaf(qv[4 * d + 3], k4.w, sc); }
#pragma unroll
        for (int d = 0; d < 8; ++d) { const float4 k4 = kp[d]; sc = fmaf(qv[64 + 4 * d], k4.x, sc); sc = fmaf(qv[64 + 4 * d + 1], k4.y, sc); sc = fmaf(qv[64 + 4 * d + 2], k4.z, sc); sc = fmaf(qv[64 + 4 * d + 3], k4.w, sc); }
        const float mn = fmaxf(m, sc), al = __expf(m - mn), p = __expf(sc - mn);
        l = l * al + p; m = mn;
        const float4* vp = (const float4*)(kv + kr * 1024 + h * 128 + 64);
#pragma unroll
        for (int d = 0; d < 16; ++d) { const float4 v4 = vp[d]; o[4 * d] = fmaf(o[4 * d], al, p * v4.x); o[4 * d + 1] = fmaf(o[4 * d + 1], al, p * v4.y); o[4 * d + 2] = fmaf(o[4 * d + 2], al, p * v4.z); o[4 * d + 3] = fmaf(o[4 * d + 3], al, p * v4.w); }
    }
    const float il = 1.f / l;
#pragma unroll
    for (int d = 0; d < 64; ++d) mix[r * 1024 + 512 + h * 64 + d] = o[d] * il;
}
__device__ __forceinline__ float wsum(float v) {
#pragma unroll
    for (int o = 1; o < 64; o <<= 1) v += __shfl_xor(v, o);
    return v;
}
__global__ void __launch_bounds__(256) ln1_rows(const float* __restrict__ x, const float* __restrict__ mixo, const float* __restrict__ g, const float* __restrict__ bb, float* __restrict__ x1, int ntok) {
    const int r = blockIdx.x * 4 + (threadIdx.x >> 6), lane = threadIdx.x & 63; if (r >= ntok) return;
    float v[16]; float s = 0.f;
#pragma unroll
    for (int j = 0; j < 16; ++j) { const int c = lane + 64 * j; v[j] = ALPHA * x[(size_t)r * 1024 + c] + mixo[(size_t)r * 1024 + c]; s += v[j]; }
    const float mean = wsum(s) * (1.f / 1024.f); float q = 0.f;
#pragma unroll
    for (int j = 0; j < 16; ++j) { v[j] -= mean; q = fmaf(v[j], v[j], q); }
    const float rstd = rsqrtf(wsum(q) * (1.f / 1024.f) + LN_EPS);
#pragma unroll
    for (int j = 0; j < 16; ++j) { const int c = lane + 64 * j; x1[(size_t)r * 1024 + c] = v[j] * rstd * g[c] + bb[c]; }
}
}

__device__ __forceinline__ void route_token(const float (&lg)[64], const float* __restrict__ rbias, int (&idx)[6], float (&w)[6]) {
    float sc[64], ch[64];
#pragma unroll
    for (int j = 0; j < 64; ++j) { sc[j] = 1.f / (1.f + __expf(-lg[j])); ch[j] = sc[j] + rbias[j]; }
    float gs[8];
#pragma unroll
    for (int g = 0; g < 8; ++g) { float m1 = -INFINITY, m2 = -INFINITY;
#pragma unroll
        for (int j = 0; j < 8; ++j) { const float v = ch[g * 8 + j]; if (v > m1) { m2 = m1; m1 = v; } else if (v > m2) m2 = v; }
        gs[g] = m1 + m2; }
    bool sel[8];
#pragma unroll
    for (int g = 0; g < 8; ++g) { int rank = 0;
#pragma unroll
        for (int o = 0; o < 8; ++o) { if (o != g && (gs[o] > gs[g] || (gs[o] == gs[g] && o < g))) ++rank; }
        sel[g] = rank < 4; }
#pragma unroll
    for (int j = 0; j < 64; ++j) if (!sel[j >> 3]) ch[j] = -INFINITY;
    float wsum_ = 0.f;
#pragma unroll
    for (int k = 0; k < 6; ++k) { float best = -INFINITY; int bi = 0;
#pragma unroll
        for (int j = 0; j < 64; ++j) if (ch[j] > best) { best = ch[j]; bi = j; }
        float sv = 0.f;
#pragma unroll
        for (int j = 0; j < 64; ++j) if (j == bi) { sv = sc[j]; ch[j] = -INFINITY; }
        idx[k] = bi; w[k] = sv; wsum_ += sv; }
    const float inv = 2.5f / (wsum_ + 1e-20f);
#pragma unroll
    for (int k = 0; k < 6; ++k) w[k] *= inv;
}

namespace gold {
__global__ void __launch_bounds__(64) route_rows(const float* __restrict__ logits, const float* __restrict__ rbias, int* __restrict__ topi, float* __restrict__ topw, int ntok) {
    const int r = blockIdx.x * 64 + threadIdx.x; if (r >= ntok) return;
    float lg[64];
#pragma unroll
    for (int j = 0; j < 16; ++j) { const float4 v = ((const float4*)(logits + (size_t)r * 64))[j]; lg[4 * j] = v.x; lg[4 * j + 1] = v.y; lg[4 * j + 2] = v.z; lg[4 * j + 3] = v.w; }
    int idx[6]; float w[6]; route_token(lg, rbias, idx, w);
#pragma unroll
    for (int k = 0; k < 6; ++k) { topi[(size_t)r * 6 + k] = idx[k]; topw[(size_t)r * 6 + k] = w[k]; }
}
__global__ void __launch_bounds__(256) moe_naive(const float* x1, const int* __restrict__ topi, const float* __restrict__ topw,
                                                  const float* __restrict__ weg, const float* __restrict__ weu, const float* __restrict__ wed,
                                                  const float* __restrict__ wsg, const float* __restrict__ wsu, const float* __restrict__ wsd,
                                                  const float* __restrict__ g2, const float* __restrict__ b2, float* out) {
    __shared__ float xs[1024]; __shared__ float hs[256]; __shared__ float red[8];
    const int r = blockIdx.x, tid = threadIdx.x;
#pragma unroll
    for (int j = 0; j < 4; ++j) xs[tid + 256 * j] = x1[(size_t)r * 1024 + tid + 256 * j];
    __syncthreads();
    float acc[4] = {0.f, 0.f, 0.f, 0.f};
    for (int ei = 0; ei < 7; ++ei) {
        const int e = ei < 6 ? topi[(size_t)r * 6 + ei] : 0; const float w = ei < 6 ? topw[(size_t)r * 6 + ei] : 1.f;
        const float* Wg = ei < 6 ? weg + (size_t)e * 1024 * 256 : wsg; const float* Wu = ei < 6 ? weu + (size_t)e * 1024 * 256 : wsu; const float* Wd = ei < 6 ? wed + (size_t)e * 256 * 1024 : wsd;
        float gg = 0.f, uu = 0.f;
        for (int k = 0; k < 1024; ++k) { const float xv = xs[k]; gg = fmaf(xv, Wg[(size_t)k * 256 + tid], gg); uu = fmaf(xv, Wu[(size_t)k * 256 + tid], uu); }
        hs[tid] = gg / (1.f + __expf(-gg)) * uu;
        __syncthreads();
        float y[4] = {0.f, 0.f, 0.f, 0.f};
        for (int i = 0; i < 256; ++i) { const float hv = hs[i];
#pragma unroll
            for (int j = 0; j < 4; ++j) y[j] = fmaf(hv, Wd[(size_t)i * 1024 + tid + 256 * j], y[j]); }
#pragma unroll
        for (int j = 0; j < 4; ++j) acc[j] = fmaf(w, y[j], acc[j]);
        __syncthreads();
    }
    float v[4]; float s = 0.f;
#pragma unroll
    for (int j = 0; j < 4; ++j) { v[j] = ALPHA * xs[tid + 256 * j] + acc[j]; s += v[j]; }
    s = wsum(s); if ((tid & 63) == 0) red[tid >> 6] = s; __syncthreads();
    const float mean = (red[0] + red[1] + red[2] + red[3]) * (1.f / 1024.f); float q = 0.f;
#pragma unroll
    for (int j = 0; j < 4; ++j) { v[j] -= mean; q = fmaf(v[j], v[j], q); }
    q = wsum(q); if ((tid & 63) == 0) red[4 + (tid >> 6)] = q; __syncthreads();
    const float rstd = rsqrtf((red[4] + red[5] + red[6] + red[7]) * (1.f / 1024.f) + LN_EPS);
#pragma unroll
    for (int j = 0; j < 4; ++j) { const int c = tid + 256 * j; out[(size_t)r * 1024 + c] = v[j] * rstd * g2[c] + b2[c]; }
}

struct In {
    const float *x, *w_in, *lam_re, *lam_im, *log_dt, *b_re, *b_im, *c_re, *c_im, *d_skip, *w_glu, *b_glu, *q_norm_g, *w_uq, *kv_norm_g, *w_ukv, *w_o, *ln1_g, *ln1_b,
                *w_router, *router_bias, *we_gate, *we_up, *we_down, *ws_gate, *ws_up, *ws_down, *ln2_g, *ln2_b;
};
constexpr size_t GOLD_FLOATS_PER_TOK = 6400;
struct Bufs { float *proj, *spre, *gl, *mix, *cqn, *ckvn, *q, *kv, *krope, *mixo, *logits; int* topi; float* topw; };
static Bufs run(const In& I, int tok0, int ntok, float* scratch, float* x1out, float* out, hipStream_t st) {
    Bufs B;
    B.proj = scratch; B.spre = B.proj + (size_t)ntok * 928; B.gl = B.spre + (size_t)ntok * 512; B.mix = B.gl + (size_t)ntok * 512;
    B.cqn = B.mix + (size_t)ntok * 1024; B.ckvn = B.cqn + (size_t)ntok * 256; B.q = B.ckvn + (size_t)ntok * 128; B.kv = B.q + (size_t)ntok * 768;
    B.krope = B.kv + (size_t)ntok * 1024; B.mixo = B.krope + (size_t)ntok * 32; B.logits = B.mixo + (size_t)ntok * 1024;
    B.topi = (int*)(B.logits + (size_t)ntok * 64); B.topw = (float*)(B.topi + (size_t)ntok * 6);
    float *proj = B.proj, *spre = B.spre, *gl = B.gl, *mix = B.mix, *cqn = B.cqn, *ckvn = B.ckvn, *q = B.q, *kv = B.kv, *krope = B.krope, *mixo = B.mixo, *logits = B.logits; int* topi = B.topi; float* topw = B.topw;
    const float* x = I.x + (size_t)tok0 * 1024; const int nb = ntok / SEQ;
    hipLaunchKernelGGL(sgemm, dim3((928 + 63) / 64, ntok / 64), dim3(256), 0, st, x, 1024, I.w_in, 928, proj, 928, ntok, 928, 1024);
    hipLaunchKernelGGL(ssm_naive, dim3(32, nb), dim3(64), 0, st, proj, 928, I.lam_re, I.lam_im, I.log_dt, I.b_re, I.b_im, I.c_re, I.c_im, I.d_skip, spre);
    hipLaunchKernelGGL(sgemm, dim3(8, ntok / 64), dim3(256), 0, st, spre, 512, I.w_glu, 512, gl, 512, ntok, 512, 512);
    hipLaunchKernelGGL(glu_ew, dim3((unsigned)(((size_t)ntok * 512 + 255) / 256)), dim3(256), 0, st, spre, gl, I.b_glu, mix, ntok);
    hipLaunchKernelGGL(rmsnorm_rows, dim3((ntok + 255) / 256), dim3(256), 0, st, proj, 928, 512, 256, I.q_norm_g, cqn, ntok);
    hipLaunchKernelGGL(rmsnorm_rows, dim3((ntok + 255) / 256), dim3(256), 0, st, proj, 928, 768, 128, I.kv_norm_g, ckvn, ntok);
    hipLaunchKernelGGL(sgemm, dim3(12, ntok / 64), dim3(256), 0, st, cqn, 256, I.w_uq, 768, q, 768, ntok, 768, 256);
    hipLaunchKernelGGL(sgemm, dim3(16, ntok / 64), dim3(256), 0, st, ckvn, 128, I.w_ukv, 1024, kv, 1024, ntok, 1024, 128);
    hipLaunchKernelGGL(rope_ew, dim3((ntok * 144 + 255) / 256), dim3(256), 0, st, q, proj, 928, krope, ntok);
    hipLaunchKernelGGL(attn_naive, dim3(SEQ / 64, 8, nb), dim3(64), 0, st, q, kv, krope, mix);
    hipLaunchKernelGGL(sgemm, dim3(16, ntok / 64), dim3(256), 0, st, mix, 1024, I.w_o, 1024, mixo, 1024, ntok, 1024, 1024);
    hipLaunchKernelGGL(ln1_rows, dim3(ntok / 4), dim3(256), 0, st, x, mixo, I.ln1_g, I.ln1_b, x1out, ntok);
    hipLaunchKernelGGL(sgemm, dim3(1, ntok / 64), dim3(256), 0, st, x1out, 1024, I.w_router, 64, logits, 64, ntok, 64, 1024);
    hipLaunchKernelGGL(route_rows, dim3(ntok / 64), dim3(64), 0, st, logits, I.router_bias, topi, topw, ntok);
    hipLaunchKernelGGL(moe_naive, dim3(ntok), dim3(256), 0, st, x1out, topi, topw, I.we_gate, I.we_up, I.we_down, I.ws_gate, I.ws_up, I.ws_down, I.ln2_g, I.ln2_b, out);
    return B;
}
}
#define GAS __attribute__((address_space(1)))
#define LAS __attribute__((address_space(3)))
typedef unsigned short bf16_t;
typedef short bf16x8 __attribute__((ext_vector_type(8)));
typedef short s16x4 __attribute__((ext_vector_type(4)));
typedef float f32x4 __attribute__((ext_vector_type(4)));
typedef float f32x2 __attribute__((ext_vector_type(2)));
typedef float f32x16 __attribute__((ext_vector_type(16)));
typedef unsigned u32x4 __attribute__((ext_vector_type(4)));
typedef unsigned u32x2 __attribute__((ext_vector_type(2)));

namespace fx {
constexpr int T = 65536, SEQ = 2048, DM = 1024, NB = 32;
constexpr int CHK = 32;
constexpr int NCHK = SEQ / CHK;
constexpr int UHR = NB * NCHK;
constexpr int UHK = CHK * 16 + 256;
constexpr int Y8_LD = 1024;
constexpr int SPRE_LD = 512;
constexpr int NCH = 2;
constexpr int CAPC = T / NCH;
constexpr int NVE = NCH * 65;
constexpr float ALPHA = 1.189207115002721f, LN_EPS = 1e-5f, RMS_EPS = 1e-6f;
constexpr float QSCALE = 0.10206207261596577f * 1.4426950408889634f;

constexpr size_t MiB = 1u << 20;
constexpr size_t WS_CTL = 0, CTL_BYTES = 1 * MiB;
constexpr size_t WS_ROPE = 1 * MiB;
constexpr size_t WS_KT = 2 * MiB;
constexpr size_t WS_WIN = 4 * MiB, WS_WGLU = 6 * MiB, WS_WUQ = 6 * MiB + 512 * 1024, WS_WUKV = 7 * MiB, WS_WO = 8 * MiB;
constexpr size_t WS_WST = 10 * MiB, WS_MO = 18 * MiB, WS_WGU = 42 * MiB  , WS_WR = 107 * MiB  , WS_WD = 107 * MiB + 512 * 1024;
constexpr size_t WS_SSQQ = 140 * MiB, WS_SSQKV = 141 * MiB, WS_TSLOT = 142 * MiB, WS_TOPW = 144 * MiB, WS_ROWTOK = 146 * MiB, WS_LOGIT = 162 * MiB;
constexpr size_t WS_XB = 178 * MiB, WS_UH = 306 * MiB, WS_CQ = 402 * MiB, WS_CKVR = 434 * MiB, WS_S = 466 * MiB, WS_Q = 530 * MiB, WS_KV = 626 * MiB, WS_SPRE = 754 * MiB, WS_MIX = 818 * MiB;
constexpr size_t WS_X1B = 178 * MiB, WS_H = 306 * MiB, WS_Y = 562 * MiB  , WS_YS = 800 * MiB  , WS_HS = 864 * MiB  ;
constexpr size_t WS_GOLD = 946 * MiB, WS_END = 1024 * MiB;
constexpr int CW_TMO = 0, CW_CODE = 1, CW_BAR = 4096, CW_CNT = 16384  , CW_DBG = 65536  , CW_QUEUE = 32768  ;

constexpr int RING_BYTES = 131072, TAB_OFF = RING_BYTES, IDX_OFF = TAB_OFF + 10752  , IDX_UNITS = 16, MISC_OFF = IDX_OFF + IDX_UNITS * 1024, LDS_BYTES = MISC_OFF + 256;

__device__ __forceinline__ unsigned cvt_pk_bf16(float lo, float hi) { unsigned r; asm volatile("v_cvt_pk_bf16_f32 %0, %1, %2" : "=v"(r) : "v"(lo), "v"(hi)); return r; }
__device__ __forceinline__ float bf_lo(unsigned w) { return __uint_as_float(w << 16); }
__device__ __forceinline__ float bf_hi(unsigned w) { return __uint_as_float(w & 0xffff0000u); }
__device__ __forceinline__ u32x4 pack8(const f32x4 a, const f32x4 b) { u32x4 w; w.x = cvt_pk_bf16(a[0], a[1]); w.y = cvt_pk_bf16(a[2], a[3]); w.z = cvt_pk_bf16(b[0], b[1]); w.w = cvt_pk_bf16(b[2], b[3]); return w; }
__device__ __forceinline__ void unpack8(const u32x4 w, f32x4& a, f32x4& b) { a = (f32x4){bf_lo(w.x), bf_hi(w.x), bf_lo(w.y), bf_hi(w.y)}; b = (f32x4){bf_lo(w.z), bf_hi(w.z), bf_lo(w.w), bf_hi(w.w)}; }
__device__ __forceinline__ float fast_sigmoid(float x) { return __builtin_amdgcn_rcpf(1.f + __builtin_amdgcn_exp2f(-1.4426950408889634f * x)); }
__device__ __forceinline__ float gelu_tanh_f(float x) {
    const float z2 = 1.5957691216057308f * (x + 0.044715f * x * x * x);
    return x * fast_sigmoid(z2);
}
#ifndef SC1_STORES
#define SC1_STORES 0
#endif
__device__ __forceinline__ void store16(void* p, const u32x4 v) {
#if SC1_STORES
    asm volatile("global_store_dwordx4 %0, %1, off sc1\n\ts_nop 1" :: "v"(p), "v"(v) : "memory");
#else
    *(u32x4*)p = v;
#endif
}
__device__ __forceinline__ u32x4 ror8_x4(const u32x4 v) { u32x4 r;
    r.x = (unsigned)__builtin_amdgcn_update_dpp(0, (int)v.x, 0x128, 0xF, 0xF, false); r.y = (unsigned)__builtin_amdgcn_update_dpp(0, (int)v.y, 0x128, 0xF, 0xF, false);
    r.z = (unsigned)__builtin_amdgcn_update_dpp(0, (int)v.z, 0x128, 0xF, 0xF, false); r.w = (unsigned)__builtin_amdgcn_update_dpp(0, (int)v.w, 0x128, 0xF, 0xF, false); return r; }
__device__ __forceinline__ void store_lines16(bf16_t* rowp, size_t ld, const u32x4 X, const u32x4 Y, int fr, int fq) {
    const bool lo = fr < 8; const u32x4 S = lo ? Y : X, R = ror8_x4(S);
    const u32x4 A1 = lo ? X : R, A2 = lo ? R : Y;
    bf16_t* p = rowp + (size_t)(fr & 7) * ld + (lo ? 8 * fq : 32 + 8 * fq);
    *(u32x4*)p = A1; *(u32x4*)(p + 8 * ld) = A2;
}
__device__ __forceinline__ float wave_sum(float v) {
#pragma unroll
    for (int o = 1; o < 64; o <<= 1) v += __shfl_xor(v, o);
    return v;
}

#define XB_TMO      128
#define XB_XCNT(j)  (256  + 64 * (j))
#define XB_XSUB(j)  (1280 + 64 * (j))
#define XB_XGEN(j)  (2304 + 64 * (j))
#define XB_TOP      3328
#define XB_TOPGEN   3392
#define XCD_BAR_WORDS 3456
#define XB_SPIN_CAP (1u << 18)
__device__ __forceinline__ unsigned xb_ld(unsigned* p)              { return __hip_atomic_load(p, __ATOMIC_RELAXED, __HIP_MEMORY_SCOPE_AGENT); }
__device__ __forceinline__ unsigned xb_add(unsigned* p, unsigned v) { return __hip_atomic_fetch_add(p, v, __ATOMIC_RELAXED, __HIP_MEMORY_SCOPE_AGENT); }
__device__ __forceinline__ unsigned xb_xcc_id() { return (unsigned)__builtin_amdgcn_s_getreg((3 << 11) | 20) & 0xFu; }
#define XB_SPIN(cond, bar) do { unsigned _sp = 0; while (cond) { __builtin_amdgcn_s_sleep(1); \
    if ((++_sp & 255u) == 0u) { if (xb_ld(&(bar)[XB_TMO])) break; if (_sp > XB_SPIN_CAP) { atomicAdd(&(bar)[XB_TMO], 1u); break; } } } } while (0)
struct XcdBarrier { unsigned* bar; unsigned x; volatile LAS unsigned* st; };
__device__ __forceinline__ XcdBarrier xcd_barrier_post(unsigned* bar, volatile LAS unsigned* st) {
    XcdBarrier b; b.bar = bar; b.x = xb_xcc_id(); b.st = st;
    if (threadIdx.x == 0) (void)xb_add(&bar[XB_XCNT(b.x)], 1u);
    return b;
}
__device__ __forceinline__ void xcd_barrier_complete(unsigned* bar, unsigned x, unsigned& nloc, unsigned& nx) {
    const unsigned G = gridDim.x * gridDim.y * gridDim.z;
    unsigned sum, cnt, mine, sp = 0u;
    for (;;) {
        sum = 0u; cnt = 0u; mine = 0u;
#pragma unroll
        for (unsigned j = 0; j < 16; ++j) { const unsigned c = xb_ld(&bar[XB_XCNT(j)]); sum += c; cnt += (c > 0u) ? 1u : 0u; mine = (j == x) ? c : mine; }
        if (sum == G) break;
        __builtin_amdgcn_s_sleep(1);
        if ((++sp & 255u) == 0u) { if (xb_ld(&bar[XB_TMO])) break; if (sp > XB_SPIN_CAP) { atomicAdd(&bar[XB_TMO], 1u); break; } }
    }
    nloc = mine > 0u ? mine : 1u; nx = cnt > 0u ? cnt : 1u;
}
__device__ __forceinline__ void xcd_barrier(const XcdBarrier& b) {
    asm volatile("s_waitcnt vmcnt(0)" ::: "memory");
    __syncthreads();
    if (threadIdx.x == 0) {
        unsigned* bar = b.bar;
        __builtin_amdgcn_s_waitcnt(0);
        unsigned nloc = b.st[0], nx = b.st[1];
        if (nloc == 0u) { xcd_barrier_complete(bar, b.x, nloc, nx); b.st[0] = nloc; b.st[1] = nx; }
        const unsigned old = xb_add(&bar[XB_XSUB(b.x)], 1u);
        const unsigned gen = old / nloc;
        if (old + 1u == (gen + 1u) * nloc) {
            __builtin_amdgcn_fence(__ATOMIC_RELEASE, "agent");
            asm volatile("s_waitcnt vmcnt(0)" ::: "memory");
            const unsigned og = xb_add(&bar[XB_TOP], 1u);
            const unsigned tg = og / nx;
            if (og + 1u == (tg + 1u) * nx) xb_add(&bar[XB_TOPGEN], 1u);
            else XB_SPIN(xb_ld(&bar[XB_TOPGEN]) == tg, bar);
            __builtin_amdgcn_fence(__ATOMIC_ACQUIRE, "agent");
            xb_add(&bar[XB_XGEN(b.x)], 1u);
            asm volatile("s_waitcnt vmcnt(0)" ::: "memory");
        } else {
            XB_SPIN(xb_ld(&bar[XB_XGEN(b.x)]) == gen, bar);
            __builtin_amdgcn_fence(__ATOMIC_ACQUIRE, "agent");
            asm volatile("s_waitcnt vmcnt(0)" ::: "memory");
        }
    }
    __syncthreads();
}

constexpr int BM = 256, BK = 64, HALF = 128, HTB = HALF * BK * 2, STAGE_BYTES = 8 * HTB;
__host__ __device__ __forceinline__ int lds_byte(int r, int c) { const int st = (r >> 4) * 2 + (c >> 5), rr = r & 15, cc = c & 31, ob = rr * 64 + cc * 2; return st * 1024 + (ob ^ (((ob >> 9) & 1) << 5)); }
__host__ __device__ __forceinline__ void stage_rc(int b, int& R, int& C) { const int st = b / 1024, sb = b % 1024, swz = sb ^ (((sb >> 9) & 1) << 5); R = (st >> 1) * 16 + swz / 64; C = (st & 1) * 32 + (swz % 64) / 2; }
__host__ __device__ __forceinline__ int perm32(int rho) { const int n = rho >> 4, i = rho & 15; return 8 * (i >> 2) + 4 * n + (i & 3); }
__host__ __device__ __forceinline__ int perm16x(int rho) { const int n = rho >> 4, i = rho & 15; return 16 * (i >> 2) + 4 * n + (i & 3); }

struct Unit { const char* A; const char* B; int i0, i1, i2, i3; };
__device__ __forceinline__ int xcd_remap(int L, int nwg) { const int q = nwg / 8, r = nwg % 8, xcd = L % 8, off = L / 8; return (xcd < r ? xcd * (q + 1) : r * (q + 1) + (xcd - r) * q) + off; }

template <class Epi, class Sched, bool ALIGN_EPI, bool GATHER, int STAG = 0, int AMODE = 0>
__device__ __forceinline__ void gemm_phase(LAS unsigned char* lds, const int lda, const int ldb, const int K, const Sched& S, const Epi& E) {
    if constexpr (STAG > 0) { const unsigned long long t0_ = __builtin_amdgcn_s_memrealtime(), dl_ = (unsigned long long)STAG * ((blockIdx.x >> 3) & 3u); while (__builtin_amdgcn_s_memrealtime() - t0_ < dl_) __builtin_amdgcn_s_sleep(4); }
    const int tid = threadIdx.x, wid = __builtin_amdgcn_readfirstlane(tid >> 6), lane = tid & 63, wr = wid >> 2, wc = wid & 3, fr = lane & 15, fq = lane >> 4;
    const int nt = K / BK;
    unsigned voffA[2], voffB[2]; int RA[2], CA[2];
#pragma unroll
    for (int i = 0; i < 2; ++i) { int R, C; stage_rc(tid * 16 + i * 8192, R, C); const int Rb = 64 * (R >> 5) + (Epi::PERM == 2 ? perm16x(R & 31) : Epi::PERM ? perm32(R & 31) : (R & 31));
        RA[i] = R; CA[i] = C; voffA[i] = AMODE == 1 ? (unsigned)((R >> 4) * 8192 + (R & 7) * 1024 + (C >> 5) * 128 + ((R >> 3) & 1) * 64 + (C & 31) * 2) : (unsigned)(R * lda + C) * 2u; voffB[i] = (unsigned)(Rb * ldb + C) * 2u; }
    const size_t kstep = (size_t)(BK * 2), kstepA = AMODE == 1 ? 256 : kstep;
    const size_t hstepA = (size_t)HALF * lda * 2, hstepB = (size_t)(Epi::PERM == 2 ? 8 : 32) * ldb * 2;
    const unsigned ldsw = (unsigned)wid * 1024u;
    const int aoff = lds_byte(wr * 64 + fr, fq * 8), boff = lds_byte(wc * 32 + fr, fq * 8);
#define PG8_SA(b, h) (((b) * 2 + (h)) * HTB)
#define PG8_SB(b, h) ((4 + (b) * 2 + (h)) * HTB)
#define PG8_STAGE(bufoff, gbase, voff) do { _Pragma("unroll") for (int _i = 0; _i < 2; ++_i) \
        __builtin_amdgcn_global_load_lds((const unsigned*)((const char*)(gbase) + (voff)[_i]), (LAS unsigned*)(lds + (bufoff) + ldsw + _i * 8192), 16, 0, 0); } while (0)
#define PG8_STAGE_A(bufoff, base, g0, g1, h, kb) do { if constexpr (GATHER) { \
        __builtin_amdgcn_global_load_lds((const unsigned*)((base) + (kb) + (g0)), (LAS unsigned*)(lds + (bufoff) + ldsw), 16, 0, 0); \
        __builtin_amdgcn_global_load_lds((const unsigned*)((base) + (kb) + (g1)), (LAS unsigned*)(lds + (bufoff) + ldsw + 8192), 16, 0, 0); } \
      else { PG8_STAGE(bufoff, (base) + (h) * hstepA + (kb), voffA); } } while (0)
#define PG8_LDA(dst, b, h) do { _Pragma("unroll") for (int m = 0; m < 4; ++m) _Pragma("unroll") for (int k = 0; k < 2; ++k) dst[m][k] = *(const LAS bf16x8*)(lds + PG8_SA(b, h) + aoff + m * 2048 + k * 1024); } while (0)
#define PG8_LDB(dst, b, h) do { _Pragma("unroll") for (int n = 0; n < 2; ++n) _Pragma("unroll") for (int k = 0; k < 2; ++k) dst[n][k] = *(const LAS bf16x8*)(lds + PG8_SB(b, h) + boff + n * 2048 + k * 1024); } while (0)
#define PG8_MMA(ai, bj, At, Bt) do { __builtin_amdgcn_s_setprio(1); _Pragma("unroll") for (int m = 0; m < 4; ++m) _Pragma("unroll") for (int n = 0; n < 2; ++n) _Pragma("unroll") for (int k = 0; k < 2; ++k) \
        acc[ai][bj][m][n] = __builtin_amdgcn_mfma_f32_16x16x32_bf16(Bt[n][k], At[m][k], acc[ai][bj][m][n], 0, 0, 0); __builtin_amdgcn_s_setprio(0); } while (0)
#define PG8_WAIT_V(n) asm volatile("s_waitcnt vmcnt(" #n ")" ::: "memory")
#define PG8_WAIT_VN(n) asm volatile("s_waitcnt vmcnt(%0)" :: "n"(n) : "memory")
#define PG8_WAIT_L(n) asm volatile("s_waitcnt lgkmcnt(" #n ")" ::: "memory")
#define PG8_BAR __builtin_amdgcn_s_barrier()
#define PG8_SCHED __builtin_amdgcn_sched_barrier(0)
    Unit cur, nxt; int ui = 0;
    if (!S.next(0, cur)) return;
    unsigned gc00 = 0, gc01 = 0, gc10 = 0, gc11 = 0, gn00 = 0, gn01 = 0, gn10 = 0, gn11 = 0;
    if constexpr (GATHER) { S.gather(cur, RA[0], CA[0], RA[1], CA[1], gc00, gc01, gc10, gc11); gn00 = gc00; gn01 = gc01; gn10 = gc10; gn11 = gc11; }
    f32x4 acc[2][2][4][2];
#pragma unroll
    for (int a = 0; a < 2; ++a)
#pragma unroll
        for (int b = 0; b < 2; ++b)
#pragma unroll
            for (int m = 0; m < 4; ++m)
#pragma unroll
                for (int n = 0; n < 2; ++n) acc[a][b][m][n] = (f32x4){0.f, 0.f, 0.f, 0.f};
    bf16x8 At[4][2], B0[2][2], B1[2][2];
    const char* cA = cur.A; const char* cB = cur.B;
    PG8_STAGE(PG8_SB(0, 0), cB, voffB); PG8_STAGE(PG8_SB(0, 1), cB + hstepB, voffB); PG8_STAGE_A(PG8_SA(0, 0), cA, gc00, gc01, 0, 0); PG8_STAGE_A(PG8_SA(0, 1), cA, gc10, gc11, 1, 0);
    if (wr == 1) PG8_BAR;
    PG8_WAIT_V(2); PG8_BAR;
    PG8_STAGE(PG8_SB(1, 0), cB + kstep, voffB); PG8_STAGE_A(PG8_SA(1, 0), cA, gc00, gc01, 0, kstepA); PG8_STAGE(PG8_SB(1, 1), cB + hstepB + kstep, voffB);
    PG8_WAIT_V(6); PG8_BAR;
    for (;;) {
        const bool has_next = S.next(ui + 1, nxt);
        if constexpr (GATHER) { if (has_next) S.gather(nxt, RA[0], CA[0], RA[1], CA[1], gn00, gn01, gn10, gn11); }
        const char* nA = has_next ? nxt.A : cA; const char* nB = has_next ? nxt.B : cB;
#pragma unroll 1
        for (int t = 0; t < nt; t += 2) {
            const bool last = (t == nt - 2);
            const size_t k1 = (size_t)(t + 1) * kstepA;
            const char* a2 = last ? nA : cA; const char* b2 = last ? nB : cB + (size_t)(t + 2) * kstep;
            const size_t k2 = last ? 0 : (size_t)(t + 2) * kstepA, k3 = k2 + kstepA;
            const char* b3 = b2 + kstep;
            unsigned g200 = gc00, g201 = gc01, g210 = gc10, g211 = gc11;
            if constexpr (GATHER) { if (last) { g200 = gn00; g201 = gn01; g210 = gn10; g211 = gn11; } }
            PG8_LDB(B0, 0, 0); PG8_LDB(B1, 0, 1); PG8_SCHED; PG8_LDA(At, 0, 0); PG8_STAGE_A(PG8_SA(1, 1), cA, gc10, gc11, 1, k1);
            PG8_WAIT_V(8); PG8_WAIT_L(0); PG8_BAR; PG8_MMA(0, 0, At, B0); PG8_MMA(0, 1, At, B1); PG8_BAR; PG8_SCHED;
            PG8_LDA(At, 0, 1); PG8_STAGE(PG8_SB(0, 0), b2, voffB); PG8_STAGE(PG8_SB(0, 1), b2 + hstepB, voffB); PG8_STAGE_A(PG8_SA(0, 0), a2, g200, g201, 0, k2);
            PG8_WAIT_V(8); PG8_WAIT_L(0); PG8_BAR; PG8_MMA(1, 0, At, B0); PG8_MMA(1, 1, At, B1); PG8_BAR; PG8_SCHED;
            PG8_LDB(B0, 1, 0); PG8_LDB(B1, 1, 1); PG8_SCHED; PG8_LDA(At, 1, 0); PG8_STAGE_A(PG8_SA(0, 1), a2, g210, g211, 1, k2);
            PG8_WAIT_V(8); PG8_WAIT_L(0); PG8_BAR; PG8_MMA(0, 0, At, B0); PG8_MMA(0, 1, At, B1); PG8_BAR; PG8_SCHED;
            PG8_LDA(At, 1, 1); PG8_STAGE(PG8_SB(1, 0), b3, voffB); PG8_STAGE(PG8_SB(1, 1), b3 + hstepB, voffB); PG8_STAGE_A(PG8_SA(1, 0), a2, g200, g201, 0, k3);
            PG8_WAIT_V(8); PG8_WAIT_L(0); PG8_BAR; PG8_MMA(1, 0, At, B0); PG8_MMA(1, 1, At, B1); PG8_BAR; PG8_SCHED;
        }
#if defined(MK_TPROBE) && MK_TPROBE >= 200
        unsigned long long tp0_ = 0; if (blockIdx.x == 0 && wid == 0) tp0_ = __builtin_amdgcn_s_memrealtime();
#endif
        if constexpr (ALIGN_EPI) { if (wr == 0) PG8_BAR; }
        E(acc, cur, wr, wc, fr, fq);
#if defined(MK_TPROBE) && MK_TPROBE >= 200
        if (blockIdx.x == 0 && wid == 0) { asm volatile("s_waitcnt vmcnt(0)" ::: "memory"); const unsigned long long d_ = __builtin_amdgcn_s_memrealtime() - tp0_; if (lane == 0) { volatile LAS unsigned* M_ = (volatile LAS unsigned*)(lds + MISC_OFF); const unsigned long long a_ = (((unsigned long long)M_[23] << 32) | M_[22]) + d_; M_[22] = (unsigned)a_; M_[23] = (unsigned)(a_ >> 32); } }
#endif
        if (!has_next) break;
#pragma unroll
        for (int a = 0; a < 2; ++a)
#pragma unroll
            for (int b = 0; b < 2; ++b)
#pragma unroll
                for (int m = 0; m < 4; ++m)
#pragma unroll
                    for (int n = 0; n < 2; ++n) acc[a][b][m][n] = (f32x4){0.f, 0.f, 0.f, 0.f};
        cur = nxt; cA = nA; cB = nB; ++ui;
        if constexpr (GATHER) { gc00 = gn00; gc01 = gn01; gc10 = gn10; gc11 = gn11; }
        if constexpr (ALIGN_EPI) { if (wr == 1) PG8_BAR; }
    }
    PG8_WAIT_V(0);
    if constexpr (!ALIGN_EPI) { if (wr == 0) PG8_BAR; }
    PG8_BAR;
#undef PG8_SA
#undef PG8_SB
#undef PG8_STAGE
#undef PG8_STAGE_A
#undef PG8_LDA
#undef PG8_LDB
#undef PG8_MMA
#undef PG8_WAIT_V
#undef PG8_WAIT_VN
#undef PG8_WAIT_L
#undef PG8_BAR
#undef PG8_SCHED
}
}
namespace fx {
#define FX_ROWLOOP _Pragma("unroll") for (int ai = 0; ai < 2; ++ai) _Pragma("unroll") for (int m = 0; m < 4; ++m)

struct PlainOrder {
    const char* A; const char* B; int lda, ldb, nM, nN, nwg, G, c;
    __device__ __forceinline__ void init(const void* A_, int lda_, const void* B_, int ldb_, int M, int N, int G_, int c_) { A = (const char*)A_; B = (const char*)B_; lda = lda_; ldb = ldb_; nM = M / 256; nN = N / 256; nwg = nM * nN; G = G_; c = c_; }
    __device__ __forceinline__ bool next(int i, Unit& u) const {
        const long L = (long)i * G + c; if (L >= nwg) return false;
        const int wgid = xcd_remap((int)L, nwg);
        const int nig = 8 * nN, gid = wgid / nig, fm = gid * 8, gsz = (nM - fm) < 8 ? (nM - fm) : 8;
        const int pm = fm + ((wgid % nig) % gsz), pn = (wgid % nig) / gsz;
        u.A = A + (size_t)pm * 256 * lda * 2; u.B = B + (size_t)pn * 256 * ldb * 2; u.i0 = pm; u.i1 = pn; u.i2 = 0; u.i3 = 0; return true;
    }
};
struct PanelOrder {
    const char* A; const char* B; int lda, ldb, nM, nN, G, c;
    __device__ __forceinline__ void init(const void* A_, int lda_, const void* B_, int ldb_, int M, int N, int G_, int c_) { A = (const char*)A_; B = (const char*)B_; lda = lda_; ldb = ldb_; nM = M / 256; nN = N / 256; G = G_; c = c_; }
    __device__ __forceinline__ bool next(int i, Unit& u) const {
        const int j = i / nN, pn = i - j * nN, pm = c + j * G; if (pm >= nM) return false;
        u.A = A + (size_t)pm * 256 * lda * 2; u.B = B + (size_t)pn * 256 * ldb * 2; u.i0 = pm; u.i1 = pn; u.i2 = 0; u.i3 = 0; return true;
    }
};
struct GroupOrder {
    const char* A; const char* B; int ldb, nN, nwg, G, c;
    __device__ __forceinline__ void init(const void* A_, const void* B_, int ldb_, int nN_, int G_, int c_) { A = (const char*)A_; B = (const char*)B_; ldb = ldb_; nN = nN_; nwg = 32 * 8 * nN_; G = G_; c = c_; }
    __device__ __forceinline__ bool next(int i, Unit& u) const {
        const long L = (long)i * G + c; if (L >= nwg) return false;
        const int wgid = xcd_remap((int)L, nwg);
        const int per = 8 * nN, g = wgid / per, rem = wgid % per, pm = rem % 8, pn = rem / 8;
        u.A = A + ((size_t)g * UHR + (size_t)pm * 256) * UHK * 2; u.B = B + ((size_t)g * nN * 256 + (size_t)pn * 256) * ldb * 2; u.i0 = g; u.i1 = pm; u.i2 = pn; u.i3 = 0; return true;
    }
};

__device__ __forceinline__ void rope8(f32x4& v0, f32x4& v1, const float* __restrict__ ropec, const float* __restrict__ ropes, int pos, int fq) {
    const f32x4 c = *(const f32x4*)(ropec + pos * 16 + 4 * fq), s = *(const f32x4*)(ropes + pos * 16 + 4 * fq);
    const f32x4 a = v0, b = v1;
    v0 = (f32x4){a[0] * c[0] - a[1] * s[0], a[0] * s[0] + a[1] * c[0], a[2] * c[1] - a[3] * s[1], a[2] * s[1] + a[3] * c[1]};
    v1 = (f32x4){b[0] * c[2] - b[1] * s[2], b[0] * s[2] + b[1] * c[2], b[2] * c[3] - b[3] * s[3], b[2] * s[3] + b[3] * c[3]};
}
__device__ __forceinline__ float sumsq8(const f32x4 a, const f32x4 b) { return (a[0] * a[0] + a[1] * a[1]) + (a[2] * a[2] + a[3] * a[3]) + (b[0] * b[0] + b[1] * b[1]) + (b[2] * b[2] + b[3] * b[3]); }

struct EpiWin {
    static constexpr int PERM = 1; static constexpr int NST = 16;
    bf16_t* UH; bf16_t* CQ; bf16_t* CKVR; float* ssqq; float* ssqkv; const float* ropec; const float* ropes;
    __device__ __forceinline__ void operator()(const f32x4 (&acc)[2][2][4][2], const Unit& u, int wr, int wc, int fr, int fq) const {
        const int pm = u.i0, pn = u.i1, row0 = pm * 256 + wr * 64 + fr;
        if (pn < 2) {
            FX_ROWLOOP { const int row = row0 + ai * 128 + m * 16, r32 = row >> 5, tq = row & 31;
#pragma unroll
                for (int bj = 0; bj < 2; ++bj) { const int c = pn * 256 + wc * 64 + bj * 32 + 8 * fq, g = c >> 4, p0 = c & 15;
                    *(u32x4*)(UH + ((size_t)(g * UHR + r32) * UHK + tq * 16 + p0)) = pack8(acc[ai][bj][m][0], acc[ai][bj][m][1]); } }
        } else if (pn == 2) {
            FX_ROWLOOP { const int row = row0 + ai * 128 + m * 16; float ss = sumsq8(acc[ai][0][m][0], acc[ai][0][m][1]) + sumsq8(acc[ai][1][m][0], acc[ai][1][m][1]);
                store_lines16(CQ + (size_t)(row - fr) * 256 + 64 * wc, 256, pack8(acc[ai][0][m][0], acc[ai][0][m][1]), pack8(acc[ai][1][m][0], acc[ai][1][m][1]), fr, fq);
                ss += __shfl_xor(ss, 16); ss += __shfl_xor(ss, 32);
                if (fq == 0) ssqq[(size_t)row * 4 + wc] = ss; }
        } else {
            FX_ROWLOOP { const int row = row0 + ai * 128 + m * 16; float ss = 0.f; u32x4 w[2];
#pragma unroll
                for (int bj = 0; bj < 2; ++bj) { f32x4 v0 = acc[ai][bj][m][0], v1 = acc[ai][bj][m][1];
                    if (wc < 2) ss += sumsq8(v0, v1);
                    if (wc == 2 && bj == 0) rope8(v0, v1, ropec, ropes, row & (SEQ - 1), fq);
                    w[bj] = pack8(v0, v1); }
                store_lines16(CKVR + (size_t)(row - fr) * 256 + 64 * wc, 256, w[0], w[1], fr, fq);
                ss += __shfl_xor(ss, 16); ss += __shfl_xor(ss, 32);
                if (fq == 0) ssqkv[(size_t)row * 4 + wc] = ss; }
        }
    }
};
struct EpiQ {
    static constexpr int PERM = 1; static constexpr int NST = 16;
    bf16_t* Q; const float* ssqq; const float* ropec; const float* ropes;
    __device__ __forceinline__ void operator()(const f32x4 (&acc)[2][2][4][2], const Unit& u, int wr, int wc, int fr, int fq) const {
        const int pm = u.i0, pn = u.i1, row0 = pm * 256 + wr * 64;
        FX_ROWLOOP { const int row = row0 + fr + ai * 128 + m * 16; const f32x4 s4 = *(const f32x4*)(ssqq + (size_t)row * 4);
            const float rs = __builtin_amdgcn_rsqf(((s4[0] + s4[1]) + (s4[2] + s4[3])) * (1.f / 256.f) + RMS_EPS) * QSCALE;
            u32x4 w[2];
#pragma unroll
            for (int bj = 0; bj < 2; ++bj) { const int G = 8 * pn + 2 * wc + bj;
                f32x4 v0 = acc[ai][bj][m][0] * rs, v1 = acc[ai][bj][m][1] * rs;
                if (G % 3 == 2) rope8(v0, v1, ropec, ropes, row & (SEQ - 1), fq);
                w[bj] = pack8(v0, v1); }
            store_lines16(Q + (size_t)(row0 + ai * 128 + m * 16) * 768 + 256 * pn + 64 * wc, 768, w[0], w[1], fr, fq); }
    }
};
struct EpiKV {
    static constexpr int PERM = 1; static constexpr int NST = 16;
    bf16_t* KV; const float* ssqkv;
    __device__ __forceinline__ void operator()(const f32x4 (&acc)[2][2][4][2], const Unit& u, int wr, int wc, int fr, int fq) const {
        const int pm = u.i0, pn = u.i1, row0 = pm * 256 + wr * 64;
        FX_ROWLOOP { const int row = row0 + fr + ai * 128 + m * 16; const f32x4 s4 = *(const f32x4*)(ssqkv + (size_t)row * 4);
            const float rs = __builtin_amdgcn_rsqf(((s4[0] + s4[1]) + (s4[2] + s4[3])) * (1.f / 128.f) + RMS_EPS);
            store_lines16(KV + (size_t)(row0 + ai * 128 + m * 16) * 1024 + 256 * pn + 64 * wc, 1024, pack8(acc[ai][0][m][0] * rs, acc[ai][0][m][1] * rs), pack8(acc[ai][1][m][0] * rs, acc[ai][1][m][1] * rs), fr, fq); }
    }
};
struct EpiSt {
    static constexpr int PERM = 1; static constexpr int NST = 16;
    bf16_t* S;
    __device__ __forceinline__ void operator()(const f32x4 (&acc)[2][2][4][2], const Unit& u, int wr, int wc, int fr, int fq) const {
        const int g = u.i0, pm = u.i1, row0 = pm * 256 + wr * 64;
        FX_ROWLOOP store_lines16(S + ((size_t)g * UHR + row0 + ai * 128 + m * 16) * 256 + 64 * wc, 256, pack8(acc[ai][0][m][0], acc[ai][0][m][1]), pack8(acc[ai][1][m][0], acc[ai][1][m][1]), fr, fq);
    }
};
struct EpiSsmOut {
    static constexpr int PERM = 1; static constexpr int NST = 16;
    bf16_t* SPRE;
    __device__ __forceinline__ void operator()(const f32x4 (&acc)[2][2][4][2], const Unit& u, int wr, int wc, int fr, int fq) const {
        const int g = u.i0, pm = u.i1, pn = u.i2, row0 = pm * 256 + wr * 64 + fr;
        const int p0 = 8 * (fq & 1);
        FX_ROWLOOP { const int R = row0 + ai * 128 + m * 16;
#pragma unroll
            for (int bj = 0; bj < 2; ++bj) { const int c = 256 * pn + 64 * wc + 32 * bj + 8 * fq, tq = c >> 4;
                f32x4 y0 = acc[ai][bj][m][0], y1 = acc[ai][bj][m][1];
#pragma unroll
                for (int j = 0; j < 4; ++j) { y0[j] = gelu_tanh_f(y0[j]); y1[j] = gelu_tanh_f(y1[j]); }
                *(u32x4*)(SPRE + ((size_t)R * 32 + tq) * SPRE_LD + g * 16 + p0) = pack8(y0, y1); } }
    }
};
struct EpiGlu {
    static constexpr int PERM = 1; static constexpr int NST = 16;
    const bf16_t* SPRE; bf16_t* MIX; const float* bglu;
    __device__ __forceinline__ void operator()(const f32x4 (&acc)[2][2][4][2], const Unit& u, int wr, int wc, int fr, int fq) const {
        const int pm = u.i0, pn = u.i1, row0 = pm * 256 + wr * 64;
        f32x4 b0[2], b1[2];
#pragma unroll
        for (int bj = 0; bj < 2; ++bj) { const int c = 256 * pn + 64 * wc + 32 * bj + 8 * fq; b0[bj] = *(const f32x4*)(bglu + c); b1[bj] = *(const f32x4*)(bglu + c + 4); }
        FX_ROWLOOP { const int row = row0 + fr + ai * 128 + m * 16; u32x4 w[2];
#pragma unroll
            for (int bj = 0; bj < 2; ++bj) { const int c = 256 * pn + 64 * wc + 32 * bj + 8 * fq;
                const u32x4 sw = *(const u32x4*)(SPRE + (size_t)row * SPRE_LD + c); f32x4 s0, s1; unpack8(sw, s0, s1);
                f32x4 z0 = acc[ai][bj][m][0] + b0[bj], z1 = acc[ai][bj][m][1] + b1[bj];
#pragma unroll
                for (int j = 0; j < 4; ++j) { z0[j] = s0[j] * fast_sigmoid(z0[j]); z1[j] = s1[j] * fast_sigmoid(z1[j]); }
                w[bj] = pack8(z0, z1); }
            store_lines16(MIX + (size_t)(row0 + ai * 128 + m * 16) * 1024 + 256 * pn + 64 * wc, 1024, w[0], w[1], fr, fq); }
    }
};
struct EpiWo {
    static constexpr int PERM = 1; static constexpr int NST = 16;
    bf16_t* XY;
    __device__ __forceinline__ void operator()(const f32x4 (&acc)[2][2][4][2], const Unit& u, int wr, int wc, int fr, int fq) const {
        const int pm = u.i0, pn = u.i1, row0 = pm * 256 + wr * 64;
        u32x4 xw[2][4][2];
#pragma unroll
        for (int ai = 0; ai < 2; ++ai)
#pragma unroll
            for (int m = 0; m < 4; ++m)
#pragma unroll
                for (int bj = 0; bj < 2; ++bj) xw[ai][m][bj] = *(const u32x4*)(XY + (size_t)(row0 + fr + ai * 128 + m * 16) * 1024 + 256 * pn + wc * 64 + bj * 32 + 8 * fq);
        asm volatile("s_waitcnt vmcnt(0)" ::: "memory");
        FX_ROWLOOP { u32x4 w[2];
#pragma unroll
            for (int bj = 0; bj < 2; ++bj) { f32x4 x0, x1; unpack8(xw[ai][m][bj], x0, x1); w[bj] = pack8(x0 * ALPHA + acc[ai][bj][m][0], x1 * ALPHA + acc[ai][bj][m][1]); }
            store_lines16(XY + (size_t)(row0 + ai * 128 + m * 16) * 1024 + 256 * pn + 64 * wc, 1024, w[0], w[1], fr, fq); }
    }
};
__device__ __forceinline__ size_t h_off(int row, int col) { return (size_t)(row >> 4) * 4096 + (size_t)(row & 7) * 512 + (size_t)(col >> 5) * 64 + (size_t)((row >> 3) & 1) * 32 + (size_t)(col & 31); }
struct EpiSharedRouter {
    static constexpr int PERM = 1; static constexpr int NST = 0;
    bf16_t* HS; float* LG;
    __device__ __forceinline__ void operator()(const f32x4 (&acc)[2][2][4][2], const Unit& u, int wr, int wc, int fr, int fq) const {
        const int pm = u.i0, pn = u.i1, row0 = pm * 256 + wr * 64 + fr;
        if (pn < 2) {
            const int c = 128 * pn + 32 * wc + 8 * fq;
            FX_ROWLOOP { f32x4 h0, h1;
#pragma unroll
                for (int j = 0; j < 4; ++j) { const float g0 = acc[ai][0][m][0][j], g1 = acc[ai][0][m][1][j];
                    h0[j] = g0 * fast_sigmoid(g0) * acc[ai][1][m][0][j]; h1[j] = g1 * fast_sigmoid(g1) * acc[ai][1][m][1][j]; }
                *(u32x4*)(HS + h_off(row0 + ai * 128 + m * 16, c)) = pack8(h0, h1); }
        } else if (wc == 0) {
            FX_ROWLOOP { float* rp = LG + (size_t)(row0 + ai * 128 + m * 16) * 64 + 8 * fq;
#pragma unroll
                for (int bj = 0; bj < 2; ++bj) { *(f32x4*)(rp + bj * 32) = acc[ai][bj][m][0]; *(f32x4*)(rp + bj * 32 + 4) = acc[ai][bj][m][1]; } }
        }
    }
};

struct MoeTab { LAS int* tbase; LAS unsigned* tab; };
__device__ __forceinline__ MoeTab moe_tab(LAS unsigned char* lds) { MoeTab t; t.tbase = (LAS int*)(lds + TAB_OFF); t.tab = (LAS unsigned*)(lds + TAB_OFF + 2304); return t; }
__device__ __forceinline__ int ve_count(const unsigned* ctl, int ve) { return (ve % 65 == 64) ? CAPC : (int)__hip_atomic_load(ctl + CW_CNT + 64 * ve, __ATOMIC_RELAXED, __HIP_MEMORY_SCOPE_AGENT); }
__device__ __forceinline__ void moe_build_tab(LAS unsigned char* lds, const unsigned* ctl) {
    const MoeTab t = moe_tab(lds); LAS int* nt = (LAS int*)(lds + TAB_OFF + 1024 + 64);
    const int tid = threadIdx.x;
    if (tid < NVE) nt[tid] = (ve_count(ctl, tid) + 255) >> 8;
    __syncthreads();
    if (tid <= NVE) { int s = 0; for (int v = 0; v < tid; ++v) s += nt[v]; t.tbase[tid] = s; }
    __syncthreads();
    for (int v = tid; v < NVE; v += 512) { const int b = t.tbase[v], n = t.tbase[v + 1] - b; for (int j = 0; j < n; ++j) t.tab[b + j] = (unsigned)v | ((unsigned)j << 16); }
    __syncthreads();
}
struct GateUpOrder {
    const char* X1B; const char* WGU; MoeTab tb; LAS int* idx; int nunits, G, c;
    int tb0;
    __device__ __forceinline__ int tile_of(int tr) const { return tb0 + tr; }
    __device__ __forceinline__ void init(LAS unsigned char* lds, const void* x1b, const void* wgu, const int* rowtok, const unsigned* ctl, int chn, int G_, int c_) {
        X1B = (const char*)x1b; WGU = (const char*)wgu; tb = moe_tab(lds); idx = (LAS int*)(lds + IDX_OFF); G = G_; c = c_;
        tb0 = tb.tbase[chn * 65]; nunits = 2 * (tb.tbase[chn * 65 + 64] - tb0);
        __syncthreads();
        int vals[IDX_UNITS / 2];
#pragma unroll
        for (int i2 = 0; i2 < IDX_UNITS / 2; ++i2) { const int i = 2 * i2 + (int)(threadIdx.x >> 8); const long L = (long)i * G + c; vals[i2] = 0;
            if (L < nunits) { const int tile = tile_of(xcd_remap((int)L, nunits) >> 1); const unsigned e = tb.tab[tile]; const int ve = (int)(e & 0xffffu), tix = (int)(e >> 16), ch = ve / 65, ex = ve % 65;
                const int cnt = ve_count(ctl, ve), slot = tix * 256 + (int)(threadIdx.x & 255);
                vals[i2] = slot < cnt ? rowtok[(size_t)(ch * 64 + ex) * CAPC + slot] : ch * CAPC; } }
#pragma unroll
        for (int i2 = 0; i2 < IDX_UNITS / 2; ++i2) idx[(2 * i2 + (int)(threadIdx.x >> 8)) * 256 + (threadIdx.x & 255)] = vals[i2];
        __syncthreads();
    }
    __device__ __forceinline__ bool next(int i, Unit& u) const {
        const long L = (long)i * G + c; if (L >= nunits) return false;
        const int wgid = xcd_remap((int)L, nunits), tile = tile_of(wgid >> 1), pn = wgid & 1;
        const int ex = (int)(tb.tab[tile] & 0xffffu) % 65;
        u.A = X1B; u.B = WGU + ((size_t)ex * 512 + (size_t)pn * 256) * 1024 * 2; u.i0 = tile * 256; u.i1 = pn; u.i2 = 0; u.i3 = i < IDX_UNITS ? i : IDX_UNITS - 1; return true;
    }
    __device__ __forceinline__ void gather(const Unit& u, int R0, int C0, int R1, int C1, unsigned& g00, unsigned& g01, unsigned& g10, unsigned& g11) const {
        const LAS int* ip = idx + u.i3 * 256;
        g00 = (unsigned)ip[R0] * 2048u + (unsigned)C0 * 2u; g01 = (unsigned)ip[R1] * 2048u + (unsigned)C1 * 2u;
        g10 = (unsigned)ip[128 + R0] * 2048u + (unsigned)C0 * 2u; g11 = (unsigned)ip[128 + R1] * 2048u + (unsigned)C1 * 2u;
    }
};
struct EpiGateUp {
    static constexpr int PERM = 1; static constexpr int NST = 8;
    bf16_t* H;
    __device__ __forceinline__ void operator()(const f32x4 (&acc)[2][2][4][2], const Unit& u, int wr, int wc, int fr, int fq) const {
        const int hrow0 = u.i0 + wr * 64 + fr, c = 128 * u.i1 + 32 * wc + 8 * fq;
        FX_ROWLOOP { f32x4 h0, h1;
#pragma unroll
            for (int j = 0; j < 4; ++j) { const float g0 = acc[ai][0][m][0][j], g1 = acc[ai][0][m][1][j];
                h0[j] = g0 * fast_sigmoid(g0) * acc[ai][1][m][0][j]; h1[j] = g1 * fast_sigmoid(g1) * acc[ai][1][m][1][j]; }
            *(u32x4*)(H + h_off(hrow0 + ai * 128 + m * 16, c)) = pack8(h0, h1); }
    }
};
struct DownOrder {
    const char* Hh; const char* HS; const char* WD; MoeTab tb; int t0, nunits, G, c, chn;
    __device__ __forceinline__ void init(const void* h, const void* hs, const void* wd, MoeTab tb_, int ch, int G_, int c_) { Hh = (const char*)h; HS = (const char*)hs; WD = (const char*)wd; tb = tb_; chn = ch; t0 = tb_.tbase[ch * 65]; nunits = 4 * (tb_.tbase[(ch + 1) * 65] - t0); G = G_; c = c_; }
    __device__ __forceinline__ bool next(int i, Unit& u) const {
        const long L = (long)i * G + c; if (L >= nunits) return false;
        const int wgid = xcd_remap((int)L, nunits), tile = t0 + (wgid >> 2), pn = wgid & 3;
        const int ex = (int)(tb.tab[tile] & 0xffffu) % 65;
        u.A = ex == 64 ? HS + ((size_t)chn * CAPC + (size_t)(tb.tab[tile] >> 16) * 256) * 256 * 2 : Hh + (size_t)tile * 256 * 256 * 2; u.B = WD + ((size_t)ex * 1024 + (size_t)pn * 256) * 256 * 2; u.i0 = ex == 64 ? (int)(tb.tab[tile] >> 16) * 256 : (tile - t0) * 256; u.i1 = pn; u.i2 = ex == 64; u.i3 = 0; return true;
    }
};
constexpr float Y8_SCALE = 16.f, Y8_INV = 1.f / 16.f;
__device__ __forceinline__ u32x2 pack8_fp8(const f32x4 a, const f32x4 b) {
    int w0 = 0, w1 = 0;
    w0 = __builtin_amdgcn_cvt_pk_fp8_f32(a[0] * Y8_SCALE, a[1] * Y8_SCALE, w0, false); w0 = __builtin_amdgcn_cvt_pk_fp8_f32(a[2] * Y8_SCALE, a[3] * Y8_SCALE, w0, true);
    w1 = __builtin_amdgcn_cvt_pk_fp8_f32(b[0] * Y8_SCALE, b[1] * Y8_SCALE, w1, false); w1 = __builtin_amdgcn_cvt_pk_fp8_f32(b[2] * Y8_SCALE, b[3] * Y8_SCALE, w1, true);
    u32x2 r; r.x = (unsigned)w0; r.y = (unsigned)w1; return r;
}
__device__ __forceinline__ void unpack8_fp8(const u32x2 w, f32x4& a, f32x4& b) {
    const f32x2 p0 = __builtin_amdgcn_cvt_pk_f32_fp8((int)w.x, false), p1 = __builtin_amdgcn_cvt_pk_f32_fp8((int)w.x, true);
    const f32x2 p2 = __builtin_amdgcn_cvt_pk_f32_fp8((int)w.y, false), p3 = __builtin_amdgcn_cvt_pk_f32_fp8((int)w.y, true);
    a = (f32x4){p0.x, p0.y, p1.x, p1.y}; b = (f32x4){p2.x, p2.y, p3.x, p3.y};
}
__device__ __forceinline__ size_t y8_off(int row, int col) { return (size_t)row * 1024 + (size_t)col; }
template <int STORE = 1> struct EpiDownT {
    static constexpr int PERM = 2; static constexpr int NST = 8;
    unsigned char* Y8; bf16_t* YS;
    __device__ __forceinline__ void operator()(const f32x4 (&acc)[2][2][4][2], const Unit& u, int wr, int wc, int fr, int fq) const {
        const int yrow0 = u.i0 + wr * 64, c0 = 256 * u.i1 + 64 * wc + 16 * fq;
        if (u.i2) {
            const bool lo = fr < 8;
            FX_ROWLOOP { const u32x4 X = pack8(acc[ai][0][m][0], acc[ai][0][m][1]), Y = pack8(acc[ai][1][m][0], acc[ai][1][m][1]);
                const u32x4 S = lo ? Y : X, R = ror8_x4(S); const u32x4 A1 = lo ? X : R, A2 = lo ? R : Y;
                bf16_t* p = YS + (size_t)(yrow0 + ai * 128 + m * 16 + (fr & 7)) * 1024 + c0 + (lo ? 0 : 8);
                *(u32x4*)p = A1; *(u32x4*)(p + 8 * 1024) = A2; }
        } else {
            FX_ROWLOOP { unsigned char* rp = Y8 + y8_off(yrow0 + ai * 128 + m * 16 + fr, c0);
                const u32x2 lo = pack8_fp8(acc[ai][0][m][0], acc[ai][0][m][1]), hi = pack8_fp8(acc[ai][1][m][0], acc[ai][1][m][1]);
                u32x4 w; w.x = lo.x; w.y = lo.y; w.z = hi.x; w.w = hi.y; *(u32x4*)rp = w; }
        }
    }
};
typedef EpiDownT<1> EpiDown;
}
namespace fx {
namespace att {
constexpr int NW = 8, QBLK = 32, KVBLK = 64;
constexpr int SHM_V = 16384, SHM_K = 16384;
constexpr float THRL = 8.f;
#define KSWZ(row, colB) ((row) * 256 + ((colB) ^ (((row) & 7) << 4)))
#define SBAR() __builtin_amdgcn_sched_barrier(0)
__device__ __forceinline__ int crow(int r, int hi) { return (r & 3) + 8 * (r >> 2) + 4 * hi; }
__device__ __forceinline__ void partialSM(f32x16& p0, f32x16& p1, float& m_reg, float& mn, float& alpha) {
  float pmax = p0[0];
#pragma unroll
  for (int r = 1; r < 16; ++r) pmax = fmaxf(pmax, p0[r]);
#pragma unroll
  for (int r = 0; r < 16; ++r) pmax = fmaxf(pmax, p1[r]);
  { auto rr = __builtin_amdgcn_permlane32_swap(__float_as_uint(pmax), __float_as_uint(pmax), false, false);
    pmax = fmaxf(__uint_as_float(rr[0]), __uint_as_float(rr[1])); }
  if (__builtin_expect(__all(pmax - m_reg <= THRL), 1)) { mn = m_reg; alpha = 1.f; }
  else { mn = fmaxf(m_reg, pmax); alpha = __builtin_amdgcn_exp2f(m_reg - mn); m_reg = mn; }
#pragma unroll
  for (int r = 0; r < 16; ++r) p0[r] = p0[r] - mn;
#pragma unroll
  for (int r = 0; r < 16; ++r) p1[r] = p1[r] - mn;
#pragma unroll
  for (int r = 0; r < 16; ++r) p0[r] = __builtin_amdgcn_exp2f(p0[r]);
}
__device__ __forceinline__ void finishSM(f32x16& p0, f32x16& p1, float alpha, float& l_reg, bf16x8& pa0, bf16x8& pa1, bf16x8& pa2, bf16x8& pa3) {
#pragma unroll
  for (int r = 0; r < 16; ++r) p1[r] = __builtin_amdgcn_exp2f(p1[r]);
  float ps = 0;
#pragma unroll
  for (int r = 0; r < 16; ++r) ps += p0[r];
#pragma unroll
  for (int r = 0; r < 16; ++r) ps += p1[r];
  { auto rr = __builtin_amdgcn_permlane32_swap(__float_as_uint(ps), __float_as_uint(ps), false, false);
    ps = __uint_as_float(rr[0]) + __uint_as_float(rr[1]); }
  l_reg = l_reg * alpha + ps;
#define PK4(P, BASE, OUT) do { unsigned a0 = cvt_pk_bf16(P[BASE + 0], P[BASE + 1]), a1 = cvt_pk_bf16(P[BASE + 2], P[BASE + 3]);   \
    unsigned b0 = cvt_pk_bf16(P[BASE + 4], P[BASE + 5]), b1 = cvt_pk_bf16(P[BASE + 6], P[BASE + 7]);                              \
    auto r0 = __builtin_amdgcn_permlane32_swap(a0, b0, false, false); auto r1 = __builtin_amdgcn_permlane32_swap(a1, b1, false, false); \
    u32x4 w = {r0[0], r1[0], r0[1], r1[1]}; OUT = *reinterpret_cast<bf16x8*>(&w); } while (0)
  PK4(p0, 0, pa0); PK4(p0, 8, pa1); PK4(p1, 0, pa2); PK4(p1, 8, pa3);
#undef PK4
}
__device__ __forceinline__ void qkt(f32x16& p0, f32x16& p1, const char* Ks, const bf16x8 (&qr)[6], int r32, int hi) {
  p0 = f32x16{}; p1 = f32x16{};
#pragma unroll
  for (int d0 = 0; d0 < 6; ++d0) { const int cb = (d0 * 16 + hi * 8) * 2;
    const bf16x8 b0 = *reinterpret_cast<const bf16x8*>(Ks + KSWZ(r32, cb));
    const bf16x8 b1 = *reinterpret_cast<const bf16x8*>(Ks + KSWZ(32 + r32, cb));
    p0 = __builtin_amdgcn_mfma_f32_32x32x16_bf16(b0, qr[d0], p0, 0, 0, 0);
    p1 = __builtin_amdgcn_mfma_f32_32x32x16_bf16(b1, qr[d0], p1, 0, 0, 0); }
}
__device__ __forceinline__ int v_st(int k, int c) { const int kk = (k & ~0xC) | ((k & 4) << 1) | ((k & 8) >> 1); return ((kk >> 3) * 4 + (c >> 5)) * 512 + ((kk & 7) * 32 + (c & 31)) * 2; }
__device__ __forceinline__ int v_rd_base(int lane) { return ((lane & 3) << 3) | (((lane >> 2) & 3) << 6) | (((lane >> 4) & 1) << 5) | (((lane >> 5) & 1) << 8); }
constexpr int v_rd_off(int d0, int ks, int half) { return d0 * 512 + ks * 4096 + half * 2048; }
template <int OFF> __device__ __forceinline__ s16x4 tr_read(int vb) {
  s16x4 r; asm volatile("ds_read_b64_tr_b16 %0, %1 offset:%2" : "=&v"(r) : "v"(vb), "i"(OFF) : "memory"); return r;
}
template <int D0> __device__ __forceinline__ void pv_one(f32x16& od, int vb, bf16x8 pa0, bf16x8 pa1, bf16x8 pa2, bf16x8 pa3) {
  const s16x4 l0 = tr_read<v_rd_off(D0, 0, 0)>(vb), h0 = tr_read<v_rd_off(D0, 0, 1)>(vb), l1 = tr_read<v_rd_off(D0, 1, 0)>(vb), h1 = tr_read<v_rd_off(D0, 1, 1)>(vb);
  const s16x4 l2 = tr_read<v_rd_off(D0, 2, 0)>(vb), h2 = tr_read<v_rd_off(D0, 2, 1)>(vb), l3 = tr_read<v_rd_off(D0, 3, 0)>(vb), h3 = tr_read<v_rd_off(D0, 3, 1)>(vb);
  asm volatile("s_waitcnt lgkmcnt(0)" ::: "memory"); SBAR();
#define PK(L, H) (bf16x8){L[0], L[1], L[2], L[3], H[0], H[1], H[2], H[3]}
  od = __builtin_amdgcn_mfma_f32_32x32x16_bf16(pa0, PK(l0, h0), od, 0, 0, 0);
  od = __builtin_amdgcn_mfma_f32_32x32x16_bf16(pa1, PK(l1, h1), od, 0, 0, 0);
  od = __builtin_amdgcn_mfma_f32_32x32x16_bf16(pa2, PK(l2, h2), od, 0, 0, 0);
  od = __builtin_amdgcn_mfma_f32_32x32x16_bf16(pa3, PK(l3, h3), od, 0, 0, 0);
#undef PK
}
__device__ __forceinline__ void pv_d0(f32x16 (&o)[2], int vb, bf16x8 pa0, bf16x8 pa1, bf16x8 pa2, bf16x8 pa3) {
  pv_one<0>(o[0], vb, pa0, pa1, pa2, pa3); pv_one<1>(o[1], vb, pa0, pa1, pa2, pa3);
}
__device__ __forceinline__ void attn_unit(const unsigned char* __restrict__ wsb, const bf16_t* __restrict__ Q, bf16_t* __restrict__ MIX, int tok0, int qrow0, int h, char* lds) {
  int tid = threadIdx.x; asm volatile("" : "+v"(tid));
  const int wid = __builtin_amdgcn_readfirstlane(tid >> 6), lane = tid & 63, r32 = lane & 31, hi = lane >> 5;
  char* K_lds = lds; char* V_lds = lds + 4 * SHM_K;
  float* ws = (float*)(lds + TAB_OFF) + wid * 64; float* li_l = ws; float* al_l = ws + 32;
  float m_reg = -1e30f, l_reg = 0; f32x16 o[2] = {}; bf16x8 qr[6];
  const bf16_t* Qw = Q + (size_t)(tok0 + qrow0 + wid * QBLK + r32) * 768 + h * 96 + hi * 8;
#pragma unroll
  for (int d0 = 0; d0 < 6; ++d0) qr[d0] = *reinterpret_cast<const bf16x8*>(Qw + d0 * 16);
  const int vb0 = (int)(uintptr_t)V_lds + v_rd_base(lane);
  const int ra = tid / 12, ca = tid % 12, rb = (512 + tid) / 12, cb = (512 + tid) % 12, rv = tid >> 3, cv = tid & 7;
  const unsigned kinca = ca < 8 ? 64u * 2048u : 64u * 512u, kincb = cb < 8 ? 64u * 2048u : 64u * 512u;
  const unsigned kofa = ca < 8 ? (unsigned)WS_KV + (unsigned)(((tok0 + ra) * 1024 + h * 128 + ca * 8) * 2) : (unsigned)WS_CKVR + (unsigned)(((tok0 + ra) * 256 + 128 + (ca - 8) * 8) * 2);
  const unsigned kofb = cb < 8 ? (unsigned)WS_KV + (unsigned)(((tok0 + rb) * 1024 + h * 128 + cb * 8) * 2) : (unsigned)WS_CKVR + (unsigned)(((tok0 + rb) * 256 + 128 + (cb - 8) * 8) * 2);
  const unsigned vofs = (unsigned)WS_KV + (unsigned)(((tok0 + rv) * 1024 + h * 128 + 64 + cv * 8) * 2);
  const int ksta = KSWZ(ra, ca * 16), kstb = KSWZ(rb, cb * 16), vst = v_st(rv, cv * 8);
  const bool two = wid < 4;
  bf16x8 RK0a, RK0b, RV0, RK1a, RK1b, RV1;
#define TLOAD(KA, KB, VV, t) do { KA = *reinterpret_cast<const bf16x8*>(wsb + kofa + (unsigned)(t) * kinca); if (two) KB = *reinterpret_cast<const bf16x8*>(wsb + kofb + (unsigned)(t) * kincb); \
    VV = *reinterpret_cast<const bf16x8*>(wsb + vofs + (unsigned)(t) * (64u * 2048u)); } while (0)
#define TWRITE(KA, KB, VV, t) do { const int bo_ = ((t) & 3) * SHM_K; *(bf16x8*)(K_lds + bo_ + ksta) = KA; if (two) *(bf16x8*)(K_lds + bo_ + kstb) = KB; *(bf16x8*)(V_lds + bo_ + vst) = VV; } while (0)
#define RESC(a) do { if (__any((a) < 1.f)) { if (hi == 0) al_l[r32] = (a); asm volatile("s_waitcnt lgkmcnt(0)" ::: "memory"); \
    _Pragma("unroll") for (int d = 0; d < 2; ++d) _Pragma("unroll") for (int r = 0; r < 16; ++r) o[d][r] *= al_l[crow(r, hi)]; } } while (0)
#define STEP_END() do { asm volatile("s_waitcnt lgkmcnt(0)" ::: "memory"); __builtin_amdgcn_s_barrier(); asm volatile("" ::: "memory"); } while (0)
  f32x16 pA0, pA1, pB0, pB1; float mnA, mnB, alA, alB; bf16x8 pa0, pa1, pa2, pa3; constexpr int NT = SEQ / KVBLK;
  TLOAD(RK0a, RK0b, RV0, 0); TWRITE(RK0a, RK0b, RV0, 0); TLOAD(RK1a, RK1b, RV1, 1); TLOAD(RK0a, RK0b, RV0, 2);
  STEP_END();
  qkt(pA0, pA1, K_lds, qr, r32, hi); partialSM(pA0, pA1, m_reg, mnA, alA);
  TWRITE(RK1a, RK1b, RV1, 1); TLOAD(RK1a, RK1b, RV1, 3);
  STEP_END();
  for (int s = 1; s + 1 < NT; s += 2) {
    SBAR(); qkt(pB0, pB1, K_lds + (s & 3) * SHM_K, qr, r32, hi);
    finishSM(pA0, pA1, alA, l_reg, pa0, pa1, pa2, pa3); SBAR();
    TWRITE(RK0a, RK0b, RV0, s + 1);
    if (s + 3 < NT) TLOAD(RK0a, RK0b, RV0, s + 3);
    SBAR();
    pv_d0(o, vb0 + ((s - 1) & 3) * SHM_V, pa0, pa1, pa2, pa3); partialSM(pB0, pB1, m_reg, mnB, alB);
    RESC(alB); STEP_END();
    SBAR(); qkt(pA0, pA1, K_lds + ((s + 1) & 3) * SHM_K, qr, r32, hi);
    finishSM(pB0, pB1, alB, l_reg, pa0, pa1, pa2, pa3); SBAR();
    if (s + 2 < NT) TWRITE(RK1a, RK1b, RV1, s + 2);
    if (s + 4 < NT) TLOAD(RK1a, RK1b, RV1, s + 4);
    SBAR();
    pv_d0(o, vb0 + (s & 3) * SHM_V, pa0, pa1, pa2, pa3); partialSM(pA0, pA1, m_reg, mnA, alA);
    RESC(alA); STEP_END();
  }
  SBAR(); qkt(pB0, pB1, K_lds + ((NT - 1) & 3) * SHM_K, qr, r32, hi);
  finishSM(pA0, pA1, alA, l_reg, pa0, pa1, pa2, pa3); SBAR();
  pv_d0(o, vb0 + ((NT - 2) & 3) * SHM_V, pa0, pa1, pa2, pa3); partialSM(pB0, pB1, m_reg, mnB, alB);
  RESC(alB);
  finishSM(pB0, pB1, alB, l_reg, pa0, pa1, pa2, pa3); SBAR();
  pv_d0(o, vb0 + ((NT - 1) & 3) * SHM_V, pa0, pa1, pa2, pa3);
  if (hi == 0) li_l[r32] = l_reg;
  STEP_END();
  char* st = lds + wid * 4096;
#pragma unroll
  for (int r = 0; r < 16; ++r) { const int orow = crow(r, hi); const float rl = __builtin_amdgcn_rcpf(li_l[orow]);
#pragma unroll
    for (int d0 = 0; d0 < 2; ++d0) *(bf16_t*)(st + orow * 128 + (d0 * 32 + r32) * 2) = (bf16_t)(cvt_pk_bf16(o[d0][r] * rl, 0.f) & 0xffffu); }
  asm volatile("s_waitcnt lgkmcnt(0)" ::: "memory");
  bf16_t* Ow = MIX + (size_t)(tok0 + qrow0 + wid * QBLK) * 1024 + 512 + h * 64;
#pragma unroll
  for (int j = 0; j < 4; ++j) { const int q = lane + 64 * j; const u32x4 v = *(const u32x4*)(st + (q >> 3) * 128 + (q & 7) * 16); *(u32x4*)(Ow + (size_t)(q >> 3) * 1024 + (q & 7) * 8) = v; }
  STEP_END();
#undef TLOAD
#undef TWRITE
#undef RESC
#undef STEP_END
}
#undef KSWZ
#undef SBAR
}

struct Frame {
    LAS unsigned char* lds; unsigned* ctl; unsigned char* ws; float* out; const float* in[29];
    int tid, lane, wave, G, bid;
};
enum { I_X = 0, I_WIN, I_LRE, I_LIM, I_LDT, I_BRE, I_BIM, I_CRE, I_CIM, I_DSK, I_WGLU, I_BGLU, I_QG, I_WUQ, I_KVG, I_WUKV, I_WO, I_LN1G, I_LN1B, I_WR, I_RB, I_WEG, I_WEU, I_WED, I_WSG, I_WSU, I_WSD, I_LN2G, I_LN2B };

#ifndef MK_TPROBE
#define MK_TPROBE -1
#endif
#define TSUB(F, id) do { if (MK_TPROBE >= 100) { __syncthreads(); if (blockIdx.x == 0 && threadIdx.x == 0) { volatile LAS unsigned* M_ = (volatile LAS unsigned*)((F).lds + MISC_OFF); const unsigned long long tn_ = __builtin_amdgcn_s_memrealtime(); \
    const unsigned long long tl_ = ((unsigned long long)M_[17] << 32) | M_[16]; if ((id) == MK_TPROBE) { const unsigned long long d_ = tn_ - tl_; M_[18] = (unsigned)d_; M_[19] = (unsigned)(d_ >> 32); } M_[16] = (unsigned)tn_; M_[17] = (unsigned)(tn_ >> 32); } } } while (0)
__device__ __forceinline__ int fresh_lane() { int l = (int)(threadIdx.x & 63u); asm volatile("" : "+v"(l)); return l; }
template <class F> __device__ __forceinline__ void transpose_load(const F& f, int k0, int n0, int lane, float (&tv)[32]) {
#pragma unroll
    for (int i = 0; i < 32; ++i) tv[i] = f(k0 + 2 * i + (lane >> 5), n0 + (lane & 31));
}
__device__ __forceinline__ void transpose_store(const float (&tv)[32], bf16_t* Bt, int ldk, int k0, int n0, LAS float* scr, int lane) {
#pragma unroll
    for (int i = 0; i < 32; ++i) scr[(2 * i + (lane >> 5)) * 33 + (lane & 31)] = tv[i];
    asm volatile("s_waitcnt lgkmcnt(0)" ::: "memory");
    const int c = lane & 7;
#pragma unroll
    for (int j = 0; j < 4; ++j) { const int n = (lane >> 3) + 8 * j; const LAS float* s = scr + (8 * c) * 33 + n;
        u32x4 o; o.x = cvt_pk_bf16(s[0 * 33], s[1 * 33]); o.y = cvt_pk_bf16(s[2 * 33], s[3 * 33]); o.z = cvt_pk_bf16(s[4 * 33], s[5 * 33]); o.w = cvt_pk_bf16(s[6 * 33], s[7 * 33]);
        *(u32x4*)(Bt + (size_t)(n0 + n) * ldk + k0 + 8 * c) = o; }
    asm volatile("s_waitcnt lgkmcnt(0)" ::: "memory");
}
template <class F> __device__ __forceinline__ void transpose_item(const F& f, bf16_t* Bt, int ldk, int k0, int n0, LAS float* scr, int lane) {
    float tv[32]; transpose_load(f, k0, n0, lane, tv); transpose_store(tv, Bt, ldk, k0, n0, scr, lane);
}
__device__ __forceinline__ int rope_perm_src(int p) { return (p & 1) ? 16 + (p >> 1) : (p >> 1); }
struct SsmPar { float lr, li, dt, kr, ki; };
__device__ __forceinline__ SsmPar ssm_par(const float* lam_re, const float* lam_im, const float* log_dt, int d, int g, int n) {
    SsmPar p; p.lr = fminf(lam_re[(d * 32 + g) * 64 + n], -1e-4f); p.li = lam_im[(d * 32 + g) * 64 + n]; p.dt = expf(log_dt[d * 32 + g]);
    const float x = p.lr * p.dt, th = p.li * p.dt;
    const float em1 = expm1f(x), cs = cosf(th), sn = sinf(th), sh = sinf(0.5f * th);
    const float ai = (em1 + 1.f) * sn, arm1 = em1 * cs - 2.f * sh * sh, den = p.lr * p.lr + p.li * p.li;
    p.kr = (arm1 * p.lr + ai * p.li) / den; p.ki = (ai * p.lr - arm1 * p.li) / den; return p;
}
__device__ __forceinline__ void ssm_pow_xt(float x, float th, float e, float& pr, float& pi) {
    const float mag = __builtin_amdgcn_exp2f(x * e * 1.4426950408889634f); double trd = (double)th * (double)e * 0.15915494309189535; trd -= rint(trd); const float tr = (float)trd;
    pr = mag * __builtin_amdgcn_cosf(tr); pi = mag * __builtin_amdgcn_sinf(tr);
}
__device__ __forceinline__ void ssm_pow(const SsmPar& p, float e, float& pr, float& pi) { ssm_pow_xt(p.lr * p.dt, p.li * p.dt, e, pr, pi); }

__device__ __forceinline__ void p0_ssm_item(Frame& F, int g, int j) {
    LAS float* Pr = (LAS float*)F.lds;
    LAS float* Pi = Pr + 2 * 64 * 33;
    LAS float* Br = Pi + 2 * 64 * 33;
    LAS float* Bi = Br + 2 * 64 * 16;
    LAS float* Cr = Bi + 2 * 64 * 16;
    LAS float* Ci = Cr + 2 * 16 * 64;
    LAS float* Par = Ci + 2 * 16 * 64;
    const float* lam_re = F.in[I_LRE]; const float* lam_im = F.in[I_LIM]; const float* log_dt = F.in[I_LDT];
    __syncthreads();
    if (F.tid < 128) { const SsmPar p = ssm_par(lam_re, lam_im, log_dt, F.tid >> 6, g, F.tid & 63); Par[F.tid * 4] = p.lr * p.dt; Par[F.tid * 4 + 1] = p.li * p.dt; Par[F.tid * 4 + 2] = p.kr; Par[F.tid * 4 + 3] = p.ki; }
    for (int idx = F.tid; idx < 2 * 16 * 64; idx += 512) { const int n = idx & 63, pp = (idx >> 6) & 15, d = idx >> 10;
        Cr[idx] = F.in[I_CRE][((d * 32 + g) * 16 + pp) * 64 + n]; Ci[idx] = F.in[I_CIM][((d * 32 + g) * 16 + pp) * 64 + n]; }
    __syncthreads();
    for (int idx = F.tid; idx < 2 * 64 * 33; idx += 512) { const int tau = idx % 33, dn = idx / 33; float pr, pi; ssm_pow_xt(Par[dn * 4], Par[dn * 4 + 1], (float)tau, pr, pi); Pr[idx] = pr; Pi[idx] = pi; }
    for (int idx = F.tid; idx < 2 * 64 * 16; idx += 512) { const int q = idx & 15, dn = idx >> 4, n = dn & 63, d = dn >> 6; const float kr = Par[dn * 4 + 2], ki = Par[dn * 4 + 3];
        const float br = F.in[I_BRE][((d * 32 + g) * 64 + n) * 16 + q], bi = F.in[I_BIM][((d * 32 + g) * 64 + n) * 16 + q];
        Br[idx] = kr * br - ki * bi; Bi[idx] = kr * bi + ki * br; }
    __syncthreads();
    float* Kt = (float*)(F.ws + WS_KT) + (size_t)g * 16384;
    { const int blk = 512 * j + F.tid;
      const int q2 = blk & 7, p2 = (blk >> 3) & 7, tau = (blk >> 6) & 31, d = blk >> 11; float s00 = 0.f, s01 = 0.f, s10 = 0.f, s11 = 0.f;
      for (int n = 0; n < 64; ++n) { const float pr = Pr[(d * 64 + n) * 33 + tau], pi = Pi[(d * 64 + n) * 33 + tau];
          const float b0r = Br[(d * 64 + n) * 16 + 2 * q2], b0i = Bi[(d * 64 + n) * 16 + 2 * q2], b1r = Br[(d * 64 + n) * 16 + 2 * q2 + 1], b1i = Bi[(d * 64 + n) * 16 + 2 * q2 + 1];
          const float d0r = pr * b0r - pi * b0i, d0i = pr * b0i + pi * b0r, d1r = pr * b1r - pi * b1i, d1i = pr * b1i + pi * b1r;
          const float c0r = Cr[(d * 16 + 2 * p2) * 64 + n], c0i = Ci[(d * 16 + 2 * p2) * 64 + n], c1r = Cr[(d * 16 + 2 * p2 + 1) * 64 + n], c1i = Ci[(d * 16 + 2 * p2 + 1) * 64 + n];
          s00 += c0r * d0r - c0i * d0i; s01 += c0r * d1r - c0i * d1i; s10 += c1r * d0r - c1i * d0i; s11 += c1r * d1r - c1i * d1i; }
      float* kp = Kt + ((size_t)(d * 32 + tau) * 16 + 2 * p2) * 16 + 2 * q2; kp[0] = s00; kp[1] = s01; kp[16] = s10; kp[17] = s11; }
    bf16_t* Wst = (bf16_t*)(F.ws + WS_WST) + (size_t)g * 256 * 512;
    for (int pc = F.tid; pc < 32 * 64; pc += 512) { const int row = 32 * j + (pc >> 6), k0 = (pc & 63) * 8, s = k0 >> 4, q0 = k0 & 15;
        const int d = row >> 7, ri = (row >> 6) & 1, n = row & 63, e = d ? s : (CHK - 1 - s);
        const float pr = Pr[(d * 64 + n) * 33 + e], pi = Pi[(d * 64 + n) * 33 + e]; float v[8];
#pragma unroll
        for (int t = 0; t < 8; ++t) { const float br = Br[(d * 64 + n) * 16 + q0 + t], bi = Bi[(d * 64 + n) * 16 + q0 + t]; v[t] = ri ? (pr * bi + pi * br) : (pr * br - pi * bi); }
        u32x4 o; o.x = cvt_pk_bf16(v[0], v[1]); o.y = cvt_pk_bf16(v[2], v[3]); o.z = cvt_pk_bf16(v[4], v[5]); o.w = cvt_pk_bf16(v[6], v[7]);
        *(u32x4*)(Wst + (size_t)row * 512 + k0) = o; }
    bf16_t* Mo = (bf16_t*)(F.ws + WS_MO) + (size_t)g * 512 * UHK;
    for (int pc = F.tid; pc < 64 * 32; pc += 512) { const int row = 64 * j + (pc >> 5), kk = (pc & 31) * 8, d = kk >> 7, ri = (kk >> 6) & 1, n0 = kk & 63, tq = row >> 4, pp = row & 15;
        const int e = d ? (CHK - tq) : (tq + 1); float v[8];
#pragma unroll
        for (int t = 0; t < 8; ++t) { const int n = n0 + t; const float pr = Pr[(d * 64 + n) * 33 + e], pi = Pi[(d * 64 + n) * 33 + e], cr = Cr[(d * 16 + pp) * 64 + n], ci = Ci[(d * 16 + pp) * 64 + n];
            v[t] = ri ? -(cr * pi + ci * pr) : (cr * pr - ci * pi); }
        u32x4 o; o.x = cvt_pk_bf16(v[0], v[1]); o.y = cvt_pk_bf16(v[2], v[3]); o.z = cvt_pk_bf16(v[4], v[5]); o.w = cvt_pk_bf16(v[6], v[7]);
        *(u32x4*)(Mo + (size_t)row * UHK + 512 + kk) = o; }
}

template <int PART> __device__ __forceinline__ void p0_prologue(Frame& F) {
    const int lane = fresh_lane();
    if (PART == 1) {
        for (int it = F.bid; it < 256; it += F.G) p0_ssm_item(F, it >> 3, it & 7);
        __syncthreads();
    }
    if (PART == 0) {
        float* rc = (float*)(F.ws + WS_ROPE); float* rs = rc + 2048 * 16;
        for (int idx = F.bid * 512 + F.tid; idx < 2048 * 16; idx += F.G * 512) { const int i = idx & 15, pos = idx >> 4;
            const float inv = expf(-9.210340371976184f * (float)i * (1.f / 16.f)); const float a = (float)pos * inv; rc[idx] = cosf(a); rs[idx] = sinf(a); } }
    LAS float* scr = (LAS float*)(F.lds + F.wave * 16384);
    const int gw = F.bid * 8 + F.wave, NGW = F.G * 8;
    constexpr int I_A = 512, I_B = 128, I_C = 96, I_D = 128, I_E = 128, I_F = 512, I_G = 65 * 256, I_H = 65 * 128;
    constexpr int NITEMS = I_A + I_B + I_C + I_D + I_E + I_F + I_G + I_H;
    for (int it = (PART == 0 ? gw : I_A + gw); it < (PART == 0 ? I_A : NITEMS); it += NGW) {
        int r = it;
        if (r < I_A) { const float* W = F.in[I_WIN]; const int kb = r / 32, nb = r % 32;
            transpose_item([&](int k, int n) -> float { if (n >= 928) return 0.f; const int src = n < 896 ? n : 896 + rope_perm_src(n - 896); return W[(size_t)k * 928 + src]; }, (bf16_t*)(F.ws + WS_WIN), 1024, kb * 64, nb * 32, scr, lane); continue; } r -= I_A;
        if (r < I_B) { const float* W = F.in[I_WGLU]; const int kb = r / 16, nb = r % 16;
            transpose_item([&](int k, int n) -> float { return W[(size_t)k * 512 + n]; }, (bf16_t*)(F.ws + WS_WGLU), 512, kb * 64, nb * 32, scr, lane); continue; } r -= I_B;
        if (r < I_C) { const float* W = F.in[I_WUQ]; const float* gq = F.in[I_QG]; const int kb = r / 24, nb = r % 24;
            transpose_item([&](int k, int n) -> float { const int hh = n / 96, jj = n % 96; const int src = jj < 64 ? n : hh * 96 + 64 + rope_perm_src(jj - 64); return W[(size_t)k * 768 + src] * gq[k]; }, (bf16_t*)(F.ws + WS_WUQ), 256, kb * 64, nb * 32, scr, lane); continue; } r -= I_C;
        if (r < I_D) { const float* W = F.in[I_WUKV]; const float* gk = F.in[I_KVG]; const int kb = r / 32, nb = r % 32;
            transpose_item([&](int k, int n) -> float { return k < 128 ? W[(size_t)k * 1024 + n] * gk[k] : 0.f; }, (bf16_t*)(F.ws + WS_WUKV), 256, kb * 64, nb * 32, scr, lane); continue; } r -= I_D;
        if (r < I_E) { const float* W = F.in[I_WR]; const int kb = r / 8, nb = r % 8;
            transpose_item([&](int k, int n) -> float { return n < 64 ? W[(size_t)k * 64 + n] : 0.f; }, (bf16_t*)(F.ws + WS_WR), 1024, kb * 64, nb * 32, scr, lane); continue; } r -= I_E;
        if (r < I_F) { const float* W = F.in[I_WO]; const int kb = r / 32, nb = r % 32;
            transpose_item([&](int k, int n) -> float { return W[(size_t)k * 1024 + n]; }, (bf16_t*)(F.ws + WS_WO), 1024, kb * 64, nb * 32, scr, lane); continue; } r -= I_F;
        const int it2 = it + NGW; const bool has2 = it2 < NITEMS; float tv0[32], tv1[32];
        auto geom = [&](int rr_, const float*& W0, const float*& W1, bf16_t*& dst, int& ldk, int& k0, int& n0, bool& gu) {
            if (rr_ < I_G) { const int e = rr_ / 256, q = rr_ % 256; gu = true; k0 = (q / 16) * 64; n0 = (q % 16) * 32; ldk = 1024;
                W0 = e < 64 ? F.in[I_WEG] + (size_t)e * 1024 * 256 : F.in[I_WSG]; W1 = e < 64 ? F.in[I_WEU] + (size_t)e * 1024 * 256 : F.in[I_WSU]; dst = (bf16_t*)(F.ws + WS_WGU) + (size_t)e * 512 * 1024; }
            else { const int q_ = rr_ - I_G, e = q_ / 128, q = q_ % 128; gu = false; k0 = (q / 32) * 64; n0 = (q % 32) * 32; ldk = 256;
                W0 = e < 64 ? F.in[I_WED] + (size_t)e * 256 * 1024 : F.in[I_WSD]; W1 = W0; dst = (bf16_t*)(F.ws + WS_WD) + (size_t)e * 1024 * 256; } };
        auto val = [&](bool gu, const float* W0, const float* W1, int k, int n) -> float { if (gu) { const int r_ = n & 255, col = 128 * (n >> 8) + 32 * (r_ >> 6) + (r_ & 31); return ((r_ >> 5) & 1) ? W1[(size_t)k * 256 + col] : W0[(size_t)k * 256 + col]; } return W0[(size_t)k * 1024 + n]; };
        const float *Wa0, *Wa1, *Wb0, *Wb1; bf16_t *da, *db; int lka, ka, na, lkb, kb_, nb_; bool gua, gub;
        geom(r, Wa0, Wa1, da, lka, ka, na, gua);
        transpose_load([&](int k, int n) -> float { return val(gua, Wa0, Wa1, k, n); }, ka, na, lane, tv0);
        if (has2) { geom(it2 - (I_A + I_B + I_C + I_D + I_E + I_F), Wb0, Wb1, db, lkb, kb_, nb_, gub); transpose_load([&](int k, int n) -> float { return val(gub, Wb0, Wb1, k, n); }, kb_, nb_, lane, tv1); }
        transpose_store(tv0, da, lka, ka, na, scr, lane);
        if (has2) transpose_store(tv1, db, lkb, kb_, nb_, scr, lane);
        it += NGW;
    }
    if (PART == 0) {
      const float* x = F.in[I_X]; bf16_t* xb = (bf16_t*)(F.ws + WS_XB); const size_t N8 = (size_t)T * DM / 8, st = (size_t)F.G * 512;
      for (size_t i = (size_t)F.bid * 512 + F.tid; i < N8; i += 4 * st) {
          f32x4 a[4], b[4];
#pragma unroll
          for (int u = 0; u < 4; ++u) { const size_t ii = i + u * st < N8 ? i + u * st : i; a[u] = __builtin_nontemporal_load((const f32x4*)(x + ii * 8)); b[u] = __builtin_nontemporal_load((const f32x4*)(x + ii * 8 + 4)); }
#pragma unroll
          for (int u = 0; u < 4; ++u) if (i + u * st < N8) *(u32x4*)(xb + (i + u * st) * 8) = pack8(a[u], b[u]); } }
    if (PART == 1) { asm volatile("s_waitcnt vmcnt(0) lgkmcnt(0)" ::: "memory"); __syncthreads(); }
}

__device__ __forceinline__ void scan_unit(Frame& F, int g, int pm) {
    const bf16_t* S = (const bf16_t*)(F.ws + WS_S); bf16_t* UH = (bf16_t*)(F.ws + WS_UH);
    {
        const int n = F.tid & 63, d = (F.tid >> 6) & 1, b = pm * 4 + (F.tid >> 7);
        const SsmPar p = ssm_par(F.in[I_LRE], F.in[I_LIM], F.in[I_LDT], d, g, n); float acr, aci; ssm_pow(p, (float)CHK, acr, aci);
        float hr = 0.f, hi = 0.f;
        const size_t rbase = (size_t)g * UHR + (size_t)b * NCHK;
#pragma unroll
        for (int hb = 0; hb < 2; ++hb) {
            float sr[32], si[32];
#pragma unroll
            for (int st = 0; st < 32; ++st) { const int ci = d ? (NCHK - 1 - (hb * 32 + st)) : (hb * 32 + st);
                sr[st] = __uint_as_float((unsigned)S[(rbase + ci) * 256 + d * 128 + n] << 16); si[st] = __uint_as_float((unsigned)S[(rbase + ci) * 256 + d * 128 + 64 + n] << 16); }
#pragma unroll
            for (int st = 0; st < 32; ++st) { const int ci = d ? (NCHK - 1 - (hb * 32 + st)) : (hb * 32 + st);
                bf16_t* hp = UH + (rbase + ci) * UHK + 512 + d * 128 + n;
                hp[0] = (bf16_t)(cvt_pk_bf16(hr, 0.f) & 0xffffu); hp[64] = (bf16_t)(cvt_pk_bf16(hi, 0.f) & 0xffffu);
                const float nr = acr * hr - aci * hi + sr[st], ni = acr * hi + aci * hr + si[st]; hr = nr; hi = ni; }
        }
    }
}
__device__ __forceinline__ void mo_fill(Frame& F) {
    const float* Kt = (const float*)(F.ws + WS_KT); bf16_t* Mo = (bf16_t*)(F.ws + WS_MO);
    for (int pc = F.bid * 512 + F.tid; pc < 32 * 512 * 64; pc += F.G * 512) {
        const int k0 = (pc & 63) * 8, row = (pc >> 6) & 511, g = pc >> 15, s = k0 >> 4, q0 = k0 & 15, tq = row >> 4, pp = row & 15;
        f32x4 v0 = {0.f, 0.f, 0.f, 0.f}, v1 = {0.f, 0.f, 0.f, 0.f};
        if (tq >= s) { const float* kp = Kt + ((size_t)(g * 2 + 0) * 32 + (tq - s)) * 256 + pp * 16 + q0; v0 += *(const f32x4*)kp; v1 += *(const f32x4*)(kp + 4); }
        if (s >= tq) { const float* kp = Kt + ((size_t)(g * 2 + 1) * 32 + (s - tq)) * 256 + pp * 16 + q0; v0 += *(const f32x4*)kp; v1 += *(const f32x4*)(kp + 4); }
        if (s == tq && (pp >> 3) == (q0 >> 3)) { const float dsk = F.in[I_DSK][g * 16 + pp];
#pragma unroll
            for (int j = 0; j < 4; ++j) { if (q0 + j == pp) v0[j] += dsk; if (q0 + 4 + j == pp) v1[j] += dsk; } }
        *(u32x4*)(Mo + ((size_t)g * 512 + row) * UHK + k0) = pack8(v0, v1);
    }
}

__device__ __forceinline__ void p7_ln1(Frame& F) {
    const int lane = fresh_lane();
    const float* g1 = F.in[I_LN1G]; const float* b1 = F.in[I_LN1B]; bf16_t* x1b = (bf16_t*)(F.ws + WS_X1B);
    f32x4 gg[4], bb[4];
#pragma unroll
    for (int j = 0; j < 4; ++j) { const int c = 8 * lane + (j >> 1) * 512 + (j & 1) * 4; gg[j] = *(const f32x4*)(g1 + c); bb[j] = *(const f32x4*)(b1 + c); }
    for (int pm = F.bid; pm < T / 256; pm += F.G)
    for (int row0 = pm * 256 + F.wave; row0 < pm * 256 + 256; row0 += 32) {
        u32x4 w0[4], w1[4];
#pragma unroll
        for (int j = 0; j < 4; ++j) { const bf16_t* rp = x1b + (size_t)(row0 + 8 * j) * 1024 + 8 * lane; w0[j] = *(const u32x4*)rp; w1[j] = *(const u32x4*)(rp + 512); }
#pragma unroll
        for (int j = 0; j < 4; ++j) {
            bf16_t* rp = x1b + (size_t)(row0 + 8 * j) * 1024 + 8 * lane; f32x4 v[4]; unpack8(w0[j], v[0], v[1]); unpack8(w1[j], v[2], v[3]);
            float s = 0.f;
#pragma unroll
            for (int q = 0; q < 4; ++q) s += (v[q][0] + v[q][1]) + (v[q][2] + v[q][3]);
            const float mean = wave_sum(s) * (1.f / 1024.f); float qq = 0.f;
#pragma unroll
            for (int q = 0; q < 4; ++q) { v[q] = v[q] - mean; qq += (v[q][0] * v[q][0] + v[q][1] * v[q][1]) + (v[q][2] * v[q][2] + v[q][3] * v[q][3]); }
            const float rstd = __builtin_amdgcn_rsqf(wave_sum(qq) * (1.f / 1024.f) + LN_EPS);
#pragma unroll
            for (int q = 0; q < 4; ++q) v[q] = v[q] * rstd * gg[q] + bb[q];
            *(u32x4*)rp = pack8(v[0], v[1]); *(u32x4*)(rp + 512) = pack8(v[2], v[3]);
        }
    }
}

__device__ __forceinline__ void route_batch(Frame& F, int bt) {
    LAS int* hist = (LAS int*)(F.lds); LAS int* base = hist + 64;
    const float* LG = (const float*)(F.ws + WS_LOGIT); int* rowtok = (int*)(F.ws + WS_ROWTOK); int* tslot = (int*)(F.ws + WS_TSLOT); float* topw = (float*)(F.ws + WS_TOPW);
    {
        __syncthreads();
        if (F.tid < 64) hist[F.tid] = 0;
        __syncthreads();
        const int tok = bt * 256 + F.tid, ch = (bt * 256) / CAPC;
        int idx[6], lr[6]; float w[6];
        if (F.tid < 256) {
            float lg[64];
#pragma unroll
            for (int j = 0; j < 16; ++j) { const f32x4 v = *(const f32x4*)(LG + (size_t)tok * 64 + 4 * j); lg[4 * j] = v[0]; lg[4 * j + 1] = v[1]; lg[4 * j + 2] = v[2]; lg[4 * j + 3] = v[3]; }
            route_token(lg, F.in[I_RB], idx, w);
#pragma unroll
            for (int k = 0; k < 6; ++k) lr[k] = atomicAdd((int*)&hist[idx[k]], 1);
        }
        __syncthreads();
        if (F.tid < 64) base[F.tid] = (int)__hip_atomic_fetch_add(F.ctl + CW_CNT + 64 * (ch * 65 + F.tid), (unsigned)hist[F.tid], __ATOMIC_RELAXED, __HIP_MEMORY_SCOPE_AGENT);
        __syncthreads();
        if (F.tid < 256) {
#pragma unroll
            for (int k = 0; k < 6; ++k) { const int slot = base[idx[k]] + lr[k];
                rowtok[(size_t)(ch * 64 + idx[k]) * CAPC + slot] = tok; tslot[(size_t)tok * 8 + k] = (idx[k] << 16) | slot; topw[(size_t)tok * 8 + k] = w[k]; }
        }
    }
}

__device__ __forceinline__ void p12_combine(Frame& F, int ch) {
    const int lane = fresh_lane();
    const MoeTab tb = moe_tab(F.lds); const int t0 = tb.tbase[ch * 65];
    const unsigned char* Y8 = F.ws + WS_Y; const bf16_t* YS = (const bf16_t*)(F.ws + WS_YS); const bf16_t* x1b = (const bf16_t*)(F.ws + WS_X1B);
    const int* tslot = (const int*)(F.ws + WS_TSLOT); const float* topw = (const float*)(F.ws + WS_TOPW);
    const float* g2 = F.in[I_LN2G]; const float* b2 = F.in[I_LN2B];
    f32x4 gg[4], bb[4];
#pragma unroll
    for (int j = 0; j < 4; ++j) { const int c = 8 * lane + (j >> 1) * 512 + (j & 1) * 4; gg[j] = *(const f32x4*)(g2 + c); bb[j] = *(const f32x4*)(b2 + c); }
    constexpr int NTK = 4;
    const int stride = F.G * 8;
    for (int tk0 = F.bid * 8 + F.wave; tk0 < CAPC; tk0 += NTK * stride) {
        int ts[NTK][6]; float tw[NTK][6];
#pragma unroll
        for (int t = 0; t < NTK; ++t) { const int tk = tk0 + t * stride < CAPC ? tk0 + t * stride : tk0; const size_t tok = (size_t)ch * CAPC + tk;
#pragma unroll
            for (int k = 0; k < 6; ++k) { ts[t][k] = tslot[tok * 8 + k]; tw[t][k] = topw[tok * 8 + k]; } }
        u32x4 xw[NTK][2], sw[NTK][2]; u32x2 yw[NTK][6][2];
#pragma unroll
        for (int t = 0; t < NTK; ++t) { const int tk = tk0 + t * stride < CAPC ? tk0 + t * stride : tk0; const size_t tok = (size_t)ch * CAPC + tk;
            const bf16_t* xr = x1b + tok * 1024 + 8 * lane; xw[t][0] = *(const u32x4*)xr; xw[t][1] = *(const u32x4*)(xr + 512);
            const bf16_t* yr = YS + (size_t)tk * 1024 + 8 * lane; sw[t][0] = *(const u32x4*)yr; sw[t][1] = *(const u32x4*)(yr + 512);
#pragma unroll
            for (int k = 0; k < 6; ++k) { const int yrow = (tb.tbase[ch * 65 + (ts[t][k] >> 16)] - t0) * 256 + (ts[t][k] & 0xffff);
                const unsigned char* y8 = Y8 + y8_off(yrow, 8 * lane); yw[t][k][0] = *(const u32x2*)y8; yw[t][k][1] = *(const u32x2*)(y8 + 512); } }
#pragma unroll
        for (int t = 0; t < NTK; ++t) {
            const int tk = tk0 + t * stride; if (tk >= CAPC) break;
            const size_t tok = (size_t)ch * CAPC + tk;
            f32x4 a[4]; unpack8(xw[t][0], a[0], a[1]); unpack8(xw[t][1], a[2], a[3]); a[0] *= ALPHA; a[1] *= ALPHA; a[2] *= ALPHA; a[3] *= ALPHA;
            { f32x4 y0, y1, y2, y3; unpack8(sw[t][0], y0, y1); unpack8(sw[t][1], y2, y3); a[0] += y0; a[1] += y1; a[2] += y2; a[3] += y3; }
#pragma unroll
            for (int k = 0; k < 6; ++k) { const float w = tw[t][k] * Y8_INV; f32x4 y0, y1, y2, y3; unpack8_fp8(yw[t][k][0], y0, y1); unpack8_fp8(yw[t][k][1], y2, y3);
                a[0] += y0 * w; a[1] += y1 * w; a[2] += y2 * w; a[3] += y3 * w; }
            float s = 0.f;
#pragma unroll
            for (int j = 0; j < 4; ++j) s += (a[j][0] + a[j][1]) + (a[j][2] + a[j][3]);
            const float mean = wave_sum(s) * (1.f / 1024.f); float q = 0.f;
#pragma unroll
            for (int j = 0; j < 4; ++j) { a[j] = a[j] - mean; q += (a[j][0] * a[j][0] + a[j][1] * a[j][1]) + (a[j][2] * a[j][2] + a[j][3] * a[j][3]); }
            const float rstd = __builtin_amdgcn_rsqf(wave_sum(q) * (1.f / 1024.f) + LN_EPS);
            float* orow = F.out + tok * 1024 + 8 * lane;
#pragma unroll
            for (int j = 0; j < 4; ++j) *(f32x4*)(orow + (j >> 1) * 512 + (j & 1) * 4) = a[j] * rstd * gg[j] + bb[j];
        }
    }
}
}

namespace fx {
constexpr int NPHASE = 11 + 2 * NCH;
struct Args { const float* in[29]; float* out; unsigned char* ws; int ph_lo, ph_hi; };

__global__ void __launch_bounds__(512, 2) fwd(Args args) {
    extern __shared__ __attribute__((aligned(16))) unsigned char lds_raw[];
    Frame F;
    F.lds = (LAS unsigned char*)lds_raw; F.ws = args.ws; F.ctl = (unsigned*)(args.ws + WS_CTL); F.out = args.out;
#pragma unroll
    for (int i = 0; i < 29; ++i) F.in[i] = args.in[i];
    F.tid = threadIdx.x; F.lane = F.tid & 63; F.wave = __builtin_amdgcn_readfirstlane(F.tid >> 6); F.G = gridDim.x; F.bid = blockIdx.x;
    volatile LAS unsigned* MISC = (volatile LAS unsigned*)(F.lds + MISC_OFF);
    if (F.tid < 32) MISC[F.tid] = 0u;
    __syncthreads();
    const int lo = args.ph_lo, hi = args.ph_hi;
    XcdBarrier bar; bar.bar = F.ctl + CW_BAR; bar.x = 0; bar.st = MISC + 8;
    if (hi - lo > 1) bar = xcd_barrier_post(F.ctl + CW_BAR, MISC + 8);
#ifndef PH_MASK
#define PH_MASK 0xFFFFFFFFu
#endif
#define IN(k) (((PH_MASK >> ((k) > 11 ? 11 + (((k) - 11) & 1) : (k))) & 1u) && lo <= (k) && (k) < hi)
#define SEAM(k) do { if (IN(k) && IN((k) + 1)) xcd_barrier(bar); if (MK_TPROBE >= 300 && blockIdx.x == 0 && threadIdx.x == 0) { const unsigned long long cn_ = __builtin_amdgcn_s_memtime(); \
        const unsigned long long cl_ = ((unsigned long long)MISC[25] << 32) | MISC[24]; if ((k) + 300 == MK_TPROBE) { const unsigned long long dc_ = cn_ - cl_; MISC[26] = (unsigned)dc_; MISC[27] = (unsigned)(dc_ >> 32); } MISC[24] = (unsigned)cn_; MISC[25] = (unsigned)(cn_ >> 32); } \
     if (MK_TPROBE >= 0 && blockIdx.x == 0 && threadIdx.x == 0) { const unsigned long long tn_ = __builtin_amdgcn_s_memrealtime(); \
        const unsigned long long tl_ = ((unsigned long long)MISC[17] << 32) | MISC[16]; if (((k) == MK_TPROBE && MK_TPROBE < 100) || (k) + 300 == MK_TPROBE) { const unsigned long long d_ = tn_ - tl_; MISC[18] = (unsigned)d_; MISC[19] = (unsigned)(d_ >> 32); } if (MK_TPROBE == 200 + (k)) { MISC[18] = MISC[22]; MISC[19] = MISC[23]; } MISC[22] = 0u; MISC[23] = 0u; MISC[16] = (unsigned)tn_; MISC[17] = (unsigned)(tn_ >> 32); } } while (0)
    unsigned char* ws = args.ws;
    bf16_t* UH = (bf16_t*)(ws + WS_UH); bf16_t* CQ = (bf16_t*)(ws + WS_CQ); bf16_t* CKVR = (bf16_t*)(ws + WS_CKVR); bf16_t* Qb = (bf16_t*)(ws + WS_Q); bf16_t* KVb = (bf16_t*)(ws + WS_KV);
    bf16_t* SPRE = (bf16_t*)(ws + WS_SPRE); bf16_t* MIX = (bf16_t*)(ws + WS_MIX);
    float* ssqq = (float*)(ws + WS_SSQQ); float* ssqkv = (float*)(ws + WS_SSQKV); const float* ropec = (const float*)(ws + WS_ROPE); const float* ropes = ropec + 2048 * 16;

    if (MK_TPROBE >= 0 && blockIdx.x == 0 && threadIdx.x == 0) { const unsigned long long tn_ = __builtin_amdgcn_s_memrealtime(); MISC[16] = (unsigned)tn_; MISC[17] = (unsigned)(tn_ >> 32); }
    if (MK_TPROBE == 500 && threadIdx.x == 0) __hip_atomic_store(F.ctl + CW_DBG + 64 + blockIdx.x, 1u + xb_xcc_id(), __ATOMIC_RELAXED, __HIP_MEMORY_SCOPE_AGENT);
    if (IN(0)) { p0_prologue<0>(F); } SEAM(0);
    if (IN(1)) {
        const bool conv_first = ((F.bid >> 3) & 1) != 0;
        if (conv_first) p0_prologue<1>(F);
        { PlainOrder S; S.init(ws + WS_XB, 1024, ws + WS_WIN, 1024, T, 1024, F.G, F.bid);
          EpiWin E{UH, CQ, CKVR, ssqq, ssqkv, ropec, ropes};
          gemm_phase<EpiWin, PlainOrder, true, false>(F.lds, 1024, 1024, 1024, S, E); }
        if (!conv_first) p0_prologue<1>(F);
    } SEAM(1);
    if (IN(2)) {
        { GroupOrder S; S.init(UH, ws + WS_WST, 512, 1, F.G, F.bid); EpiSt E{(bf16_t*)(ws + WS_S)};
          gemm_phase<EpiSt, GroupOrder, true, false>(F.lds, UHK, 512, 512, S, E);
          asm volatile("s_waitcnt vmcnt(0)" ::: "memory"); __syncthreads();
          Unit u; for (int i = 0; S.next(i, u); ++i) scan_unit(F, u.i0, u.i1); }
        mo_fill(F);
        { PlainOrder S; S.init(CQ, 256, ws + WS_WUQ, 256, T, 768, F.G, F.bid); EpiQ E{Qb, ssqq, ropec, ropes};
          gemm_phase<EpiQ, PlainOrder, true, false>(F.lds, 256, 256, 256, S, E); }
        { PlainOrder S; S.init(CKVR, 256, ws + WS_WUKV, 256, T, 1024, F.G, F.bid); EpiKV E{KVb, ssqkv};
          gemm_phase<EpiKV, PlainOrder, true, false>(F.lds, 256, 256, 128, S, E); }
    } SEAM(2);
    if (IN(4)) {
#ifndef SUB4
#define SUB4 3
#endif
        if (SUB4 & 2) REP(40) for (int i = 0;; ++i) { const long L = (long)i * F.G + F.bid; if (L >= 2048) break;
            const int un = xcd_remap((int)L, 2048), pair = un >> 3, qb = un & 7, b = pair >> 3, h = pair & 7;
            att::attn_unit(ws, Qb, MIX, b * SEQ, qb * 256, h, (char*)lds_raw); }
        if (SUB4 & 1) DUP2(4, { GroupOrder S; S.init(UH, ws + WS_MO, UHK, 2, F.G, F.bid); EpiSsmOut E{SPRE};
          gemm_phase<EpiSsmOut, GroupOrder, true, false>(F.lds, UHK, UHK, UHK, S, E); });
    } SEAM(4);
    if (IN(5)) {
        { PanelOrder S; S.init(SPRE, SPRE_LD, ws + WS_WGLU, 512, T, 512, F.G, F.bid); EpiGlu E{SPRE, MIX, F.in[I_BGLU]};
          gemm_phase<EpiGlu, PanelOrder, true, false>(F.lds, SPRE_LD, 512, 512, S, E); }
        asm volatile("s_waitcnt vmcnt(0)" ::: "memory"); __syncthreads();
        { PanelOrder S; S.init(MIX, 1024, ws + WS_WO, 1024, T, 1024, F.G, F.bid); EpiWo E{(bf16_t*)(ws + WS_X1B)};
          gemm_phase<EpiWo, PanelOrder, true, false>(F.lds, 1024, 1024, 1024, S, E); }
        asm volatile("s_waitcnt vmcnt(0)" ::: "memory"); __syncthreads();
        p7_ln1(F);
        asm volatile("s_waitcnt vmcnt(0)" ::: "memory"); __syncthreads();
        { PanelOrder S; S.init(ws + WS_X1B, 1024, ws + WS_WGU + (size_t)64 * 512 * 1024 * 2, 1024, T, 768, F.G, F.bid); EpiSharedRouter E{(bf16_t*)(ws + WS_HS), (float*)(ws + WS_LOGIT)};
          gemm_phase<EpiSharedRouter, PanelOrder, true, false>(F.lds, 1024, 1024, 1024, S, E);
          asm volatile("s_waitcnt vmcnt(0)" ::: "memory"); __syncthreads();
          Unit u; for (int i = 0; S.next(i, u); ++i) if (u.i1 == 2) route_batch(F, u.i0); }
    } SEAM(8);
    if (IN(10)) {
        moe_build_tab(F.lds, F.ctl);
        GateUpOrder S; S.init(F.lds, ws + WS_X1B, ws + WS_WGU, (const int*)(ws + WS_ROWTOK), F.ctl, 0, F.G, F.bid); EpiGateUp E{(bf16_t*)(ws + WS_H)};
        gemm_phase<EpiGateUp, GateUpOrder, true, true>(F.lds, 1024, 1024, 1024, S, E);
    } SEAM(10);
#pragma unroll
    for (int ch = 0; ch < NCH; ++ch) {
        if (IN(11 + 2 * ch)) {
            moe_build_tab(F.lds, F.ctl);
            if (ch + 1 < NCH) { GateUpOrder S; S.init(F.lds, ws + WS_X1B, ws + WS_WGU, (const int*)(ws + WS_ROWTOK), F.ctl, ch + 1, F.G, F.bid); EpiGateUp E{(bf16_t*)(ws + WS_H)};
              gemm_phase<EpiGateUp, GateUpOrder, true, true>(F.lds, 1024, 1024, 1024, S, E); }
            { DownOrder S; S.init(ws + WS_H, ws + WS_HS, ws + WS_WD, moe_tab(F.lds), ch, F.G, F.bid); EpiDown E{ws + WS_Y, (bf16_t*)(ws + WS_YS)};
              gemm_phase<EpiDown, DownOrder, true, false, 0, 1>(F.lds, 256, 256, 256, S, E); }
        } SEAM(11 + 2 * ch);
        if (IN(12 + 2 * ch)) { moe_build_tab(F.lds, F.ctl); p12_combine(F, ch); } SEAM(12 + 2 * ch);
    }
    if (MK_TPROBE == 500 && blockIdx.x == 0 && threadIdx.x == 0) { unsigned bad = 0; for (unsigned b = 8; b < gridDim.x; ++b) bad += __hip_atomic_load(F.ctl + CW_DBG + 64 + b, __ATOMIC_RELAXED, __HIP_MEMORY_SCOPE_AGENT) != __hip_atomic_load(F.ctl + CW_DBG + 64 + (b & 7u), __ATOMIC_RELAXED, __HIP_MEMORY_SCOPE_AGENT);
        const unsigned long long t0_ = __builtin_amdgcn_s_memrealtime(); if (bad) while (__builtin_amdgcn_s_memrealtime() - t0_ < 100000ull) __builtin_amdgcn_s_sleep(8); }
    if (MK_TPROBE >= 0 && MK_TPROBE != 500 && blockIdx.x == 0 && threadIdx.x == 0) { const unsigned long long d_ = ((unsigned long long)MISC[19] << 32) | MISC[18]; const unsigned long long t0_ = __builtin_amdgcn_s_memrealtime();
        unsigned long long wait_ = 8ull * d_; if (MK_TPROBE >= 300) { const unsigned long long dc_ = ((unsigned long long)MISC[27] << 32) | MISC[26]; wait_ = d_ ? (dc_ * 100ull / d_) * 100ull : 0ull; }
        while (__builtin_amdgcn_s_memrealtime() - t0_ < wait_) __builtin_amdgcn_s_sleep(8); }
#undef IN
#undef SEAM
}

#if MK_DEBUG
__global__ void dbg_cmp(int k, const unsigned char* ws, const float* out_fast, gold::Bufs B, const float* gx1, const float* gout, float* acc) {
    const int t = blockIdx.x;
    float num = 0.f, den = 0.f;
    auto bf = [](const bf16_t* p, size_t i) -> float { return __uint_as_float(((unsigned)p[i]) << 16); };
    int ncol = 0;
    switch (k) { case 0: ncol = 512; break; case 1: ncol = 256; break; case 2: ncol = 160; break; case 3: ncol = 768; break; case 4: ncol = 1024; break; case 5: ncol = 512; break; case 6: ncol = 512; break; case 7: ncol = 512; break; case 8: ncol = 1024; break; default: ncol = 1024; }
    for (int c = threadIdx.x; c < ncol; c += blockDim.x) {
        float f = 0.f, g = 0.f;
        if (k == 0) { const int gg = c >> 4, p = c & 15; f = bf((const bf16_t*)(ws + WS_UH), ((size_t)gg * UHR + (t >> 5)) * UHK + (t & 31) * 16 + p); g = B.proj[(size_t)t * 928 + c]; }
        else if (k == 1) { f = bf((const bf16_t*)(ws + WS_CQ), (size_t)t * 256 + c); g = B.proj[(size_t)t * 928 + 512 + c]; }
        else if (k == 2) { f = bf((const bf16_t*)(ws + WS_CKVR), (size_t)t * 256 + c); g = c < 128 ? B.proj[(size_t)t * 928 + 768 + c] : B.krope[(size_t)t * 32 + rope_perm_src(c - 128)]; }
        else if (k == 3) { const int hh = c / 96, jj = c % 96, src = jj < 64 ? c : hh * 96 + 64 + rope_perm_src(jj - 64); f = bf((const bf16_t*)(ws + WS_Q), (size_t)t * 768 + c); g = B.q[(size_t)t * 768 + src] * QSCALE; }
        else if (k == 4) { f = bf((const bf16_t*)(ws + WS_KV), (size_t)t * 1024 + c); g = B.kv[(size_t)t * 1024 + c]; }
        else if (k == 5) { f = bf((const bf16_t*)(ws + WS_SPRE), (size_t)t * SPRE_LD + c); g = B.spre[(size_t)t * 512 + c]; }
        else if (k == 6) { f = bf((const bf16_t*)(ws + WS_MIX), (size_t)t * 1024 + c); g = B.mix[(size_t)t * 1024 + c]; }
        else if (k == 7) { f = bf((const bf16_t*)(ws + WS_MIX), (size_t)t * 1024 + 512 + c); g = B.mix[(size_t)t * 1024 + 512 + c]; }
        else if (k == 8) { f = bf((const bf16_t*)(ws + WS_X1B), (size_t)t * 1024 + c); g = gx1[(size_t)t * 1024 + c]; }
        else { f = out_fast[(size_t)t * 1024 + c]; g = gout[(size_t)t * 1024 + c]; }
        const float d = f - g; num += d * d; den += g * g;
        if (!(fabsf(f) < 1e30f)) num += 1e30f;
    }
    num = wave_sum(num); den = wave_sum(den);
    if ((threadIdx.x & 63) == 0) { atomicAdd(acc + 2 * k, num); atomicAdd(acc + 2 * k + 1, den); }
}
__global__ void dbg_encode(const float* acc, float* out, int k0, int nk) {
    float c2 = 0.f;
    for (int k = k0; k < k0 + nk; ++k) { const float e = sqrtf(acc[2 * k] / fmaxf(acc[2 * k + 1], 1e-30f)); const float tol = (k == 9) ? 0.08f : 0.04f;
        if (!(e <= tol)) { const int bucket = !(e <= 0.5f) ? 0 : (e > 0.1f ? 1 : 2); c2 = (float)(k - k0 + 1) + 20.f * bucket; break; } }
    if (c2 == 0.f) { if (MK_DBG_NPH >= NPHASE) return; c2 = 90.f; }
    const float c = sqrtf(c2);
    for (size_t i = (size_t)blockIdx.x * blockDim.x + threadIdx.x; i < (size_t)T * 1024; i += (size_t)gridDim.x * blockDim.x) out[i] = c;
}
#endif
}

extern "C" void kernel_launch(void* const* d_in, const int* in_sizes, int n_in, void* d_out, int out_size, void* d_ws, size_t ws_size, hipStream_t stream) {
#if MK_MODE == 0
    gold::In I; const float** p = (const float**)&I;
    for (int i = 0; i < 29; ++i) p[i] = (const float*)d_in[i];
    for (int t0 = 0; t0 < 65536; t0 += 16384) gold::run(I, t0, 16384, (float*)d_ws, (float*)d_out + (size_t)t0 * 1024, (float*)d_out + (size_t)t0 * 1024, stream);
#else
    using namespace fx;
    static int grid = 0;
    if (grid == 0) {
        if (n_in != 29 || ws_size < WS_END) { fprintf(stderr, "kernel_launch: need 29 inputs and >= %zu bytes of workspace (got %d, %zu)\n", (size_t)WS_END, n_in, ws_size); grid = -1; return; }
        int dev = 0, cus = 0, per_cu = 0;
        hipGetDevice(&dev); hipDeviceGetAttribute(&cus, hipDeviceAttributeMultiprocessorCount, dev);
        if (hipFuncSetAttribute((const void*)fwd, hipFuncAttributeMaxDynamicSharedMemorySize, LDS_BYTES) != hipSuccess) { fprintf(stderr, "kernel_launch: hipFuncSetAttribute failed\n"); grid = -1; return; }
        if (hipOccupancyMaxActiveBlocksPerMultiprocessor(&per_cu, (const void*)fwd, 512, LDS_BYTES) != hipSuccess || per_cu < 1) { fprintf(stderr, "kernel_launch: occupancy query says %d\n", per_cu); }
        (void)hipGetLastError();
        grid = cus > 0 ? cus : 256;
    }
    if (grid < 0) return;
    hipMemsetAsync((char*)d_ws + WS_CTL, 0, CTL_BYTES, stream);
    Args a{};
    for (int i = 0; i < 29; ++i) a.in[i] = (const float*)d_in[i];
    a.out = (float*)d_out; a.ws = (unsigned char*)d_ws;
#if MK_MODE == 1
    for (int ph = 0; ph < NPHASE && ph < MK_DBG_NPH; ++ph) { a.ph_lo = ph; a.ph_hi = ph + 1; hipLaunchKernelGGL(fwd, dim3(grid), dim3(512), LDS_BYTES, stream, a); }
#else
    a.ph_lo = 0; a.ph_hi = NPHASE; hipLaunchKernelGGL(fwd, dim3(grid), dim3(512), LDS_BYTES, stream, a);
#endif
#if MK_DEBUG
    {
        gold::In I; const float** p = (const float**)&I;
        for (int i = 0; i < 29; ++i) p[i] = (const float*)d_in[i];
        float* gs = (float*)((char*)d_ws + WS_GOLD); float* gx1 = gs + (size_t)2048 * gold::GOLD_FLOATS_PER_TOK; float* gout = gx1 + (size_t)2048 * 1024;
        gold::Bufs B = gold::run(I, 0, 2048, gs, gx1, gout, stream);
        float* acc = (float*)((char*)d_ws + WS_CTL) + CW_DBG;
        for (int k = 0; k < 10; ++k) hipLaunchKernelGGL(dbg_cmp, dim3(2048), dim3(256), 0, stream, k, (const unsigned char*)d_ws, (const float*)d_out, B, (const float*)gx1, (const float*)gout, acc);
        hipLaunchKernelGGL(dbg_encode, dim3(1024), dim3(256), 0, stream, (const float*)acc, (float*)d_out, MK_DBG_K0, MK_DBG_NK);
    }
#endif
    const hipError_t le = hipPeekAtLastError();
    if (le != hipSuccess) fprintf(stderr, "kernel_launch: launch failed: %s\n", hipGetErrorName(le));
#endif
}
```

```cpp
#define MK_MODE 2
#include <hip/hip_runtime.h>
#include <cstdio>
#include <cstdint>
#include <cmath>
#ifndef MK_MODE
#define MK_MODE 1
#endif
#ifndef MK_DBG_NPH
#define MK_DBG_NPH 99
#endif
#ifndef MK_DBG_K0
#define MK_DBG_K0 0
#endif
#ifndef MK_DBG_NK
#define MK_DBG_NK 10
#endif
#ifndef MK_DUP
#define MK_DUP -1
#endif
#define REP(k) for (int rep_ = 0; rep_ < ((MK_DUP == (k)) ? 2 : 1); ++rep_)
#define DUP2(k, ...) do { __VA_ARGS__ if constexpr (MK_DUP == (k)) { __VA_ARGS__ } } while (0)
#ifndef MK_TPROBE
#define MK_TPROBE -1
#endif
#ifndef MK_STAG
#define MK_STAG 0
#endif
#ifndef MK_DEBUG
#define MK_DEBUG 0
#endif
namespace gold {
constexpr int D_MODEL = 1024, SEQ = 2048, D_SSM = 512, D_IN = 928, NH = 8, QLR = 256, KVLR = 128, ROPE = 32;
constexpr int NEXP = 64, TOPK = 6, DEXP = 256;
constexpr float ALPHA = 1.189207115002721f, LN_EPS = 1e-5f, RMS_EPS = 1e-6f, ATT_SCALE = 0.10206207261596577f;

__global__ void __launch_bounds__(256) sgemm(const float* __restrict__ A, int lda, const float* __restrict__ B, int ldb, float* __restrict__ C, int ldc, int M, int N, int K) {
    __shared__ float As[16][65];
    __shared__ float Bs[16][65];
    const int tid = threadIdx.x, tx = tid & 15, ty = tid >> 4;
    const int m0 = blockIdx.y * 64, n0 = blockIdx.x * 64;
    float acc[4][4];
#pragma unroll
    for (int i = 0; i < 4; ++i)
#pragma unroll
        for (int j = 0; j < 4; ++j) acc[i][j] = 0.f;
    for (int k0 = 0; k0 < K; k0 += 16) {
#pragma unroll
        for (int i = 0; i < 4; ++i) { const int idx = tid + 256 * i, r = idx >> 4, c = idx & 15; As[c][r] = A[(size_t)(m0 + r) * lda + k0 + c]; }
#pragma unroll
        for (int i = 0; i < 4; ++i) { const int idx = tid + 256 * i, r = idx >> 6, c = idx & 63; Bs[r][c] = (n0 + c < N) ? B[(size_t)(k0 + r) * ldb + n0 + c] : 0.f; }
        __syncthreads();
#pragma unroll
        for (int k = 0; k < 16; ++k) {
            float a[4], b[4];
#pragma unroll
            for (int i = 0; i < 4; ++i) a[i] = As[k][ty + 16 * i];
#pragma unroll
            for (int j = 0; j < 4; ++j) b[j] = Bs[k][tx + 16 * j];
#pragma unroll
            for (int i = 0; i < 4; ++i)
#pragma unroll
                for (int j = 0; j < 4; ++j) acc[i][j] = fmaf(a[i], b[j], acc[i][j]);
        }
        __syncthreads();
    }
#pragma unroll
    for (int i = 0; i < 4; ++i)
#pragma unroll
        for (int j = 0; j < 4; ++j) { const int c = n0 + tx + 16 * j; if (c < N) C[(size_t)(m0 + ty + 16 * i) * ldc + c] = acc[i][j]; }
}

__device__ __forceinline__ float gelu_tanh(float x) {
    const float z = 0.7978845608028654f * (x + 0.044715f * x * x * x);
    const float e = __expf(2.f * z);
    const float th = 1.f - 2.f / (1.f + e);
    return 0.5f * x * (1.f + th);
}
__device__ __forceinline__ float sigmoidf_(float x) { return 1.f / (1.f + __expf(-x)); }

struct SsmPar { float ar, ai, kr, ki; };
__device__ __forceinline__ SsmPar ssm_par(const float* lam_re, const float* lam_im, const float* log_dt, int d, int g, int n) {
    const float lr = fminf(lam_re[(d * 32 + g) * 64 + n], -1e-4f), li = lam_im[(d * 32 + g) * 64 + n];
    const float dt = expf(log_dt[d * 32 + g]);
    const float x = lr * dt, th = li * dt;
    const float em1 = expm1f(x), cs = cosf(th), sn = sinf(th), sh = sinf(0.5f * th);
    const float mag = em1 + 1.f;
    SsmPar p; p.ar = mag * cs; p.ai = mag * sn;
    const float arm1 = em1 * cs - 2.f * sh * sh;
    const float den = lr * lr + li * li;
    p.kr = (arm1 * lr + p.ai * li) / den; p.ki = (p.ai * lr - arm1 * li) / den;
    return p;
}

__global__ void __launch_bounds__(64) ssm_naive(const float* __restrict__ proj, int ldp, const float* __restrict__ lam_re, const float* __restrict__ lam_im, const float* __restrict__ log_dt,
                                                const float* __restrict__ b_re, const float* __restrict__ b_im, const float* __restrict__ c_re, const float* __restrict__ c_im,
                                                const float* __restrict__ d_skip, float* __restrict__ spre) {
    const int g = blockIdx.x, b = blockIdx.y, n = threadIdx.x;
    for (int d = 0; d < 2; ++d) {
        const SsmPar P = ssm_par(lam_re, lam_im, log_dt, d, g, n);
        float Br[16], Bi[16], Cr[16], Ci[16];
#pragma unroll
        for (int q = 0; q < 16; ++q) { const float br = b_re[((d * 32 + g) * 64 + n) * 16 + q], bi = b_im[((d * 32 + g) * 64 + n) * 16 + q];
            Br[q] = P.kr * br - P.ki * bi; Bi[q] = P.kr * bi + P.ki * br;
            Cr[q] = c_re[((d * 32 + g) * 16 + q) * 64 + n]; Ci[q] = c_im[((d * 32 + g) * 16 + q) * 64 + n]; }
        float hr = 0.f, hi = 0.f;
        for (int step = 0; step < SEQ; ++step) {
            const int t = d ? (SEQ - 1 - step) : step;
            const float* up = proj + (size_t)(b * SEQ + t) * ldp + g * 16;
            float u[16];
#pragma unroll
            for (int q = 0; q < 16; ++q) u[q] = up[q];
            float bur = 0.f, bui = 0.f;
#pragma unroll
            for (int q = 0; q < 16; ++q) { bur = fmaf(Br[q], u[q], bur); bui = fmaf(Bi[q], u[q], bui); }
            const float nr = P.ar * hr - P.ai * hi + bur, ni = P.ar * hi + P.ai * hr + bui;
            hr = nr; hi = ni;
            float y[16];
#pragma unroll
            for (int p = 0; p < 16; ++p) y[p] = Cr[p] * hr - Ci[p] * hi;
#pragma unroll
            for (int o = 1; o < 64; o <<= 1)
#pragma unroll
                for (int p = 0; p < 16; ++p) y[p] += __shfl_xor(y[p], o);
            if (n < 16) {
                float v = 0.f;
#pragma unroll
                for (int p = 0; p < 16; ++p) if (p == n) v = y[p];
                float* o = spre + (size_t)(b * SEQ + t) * 512 + g * 16 + n;
                if (d == 0) *o = v;
                else { float uu = 0.f;
#pragma unroll
                    for (int p = 0; p < 16; ++p) if (p == n) uu = u[p];
                    *o = gelu_tanh(*o + v + uu * d_skip[g * 16 + n]); }
            }
        }
    }
}
__global__ void glu_ew(const float* __restrict__ spre, const float* __restrict__ gl, const float* __restrict__ bglu, float* __restrict__ mix, int ntok) {
    const size_t i = (size_t)blockIdx.x * 256 + threadIdx.x; if (i >= (size_t)ntok * 512) return;
    const int c = (int)(i & 511); const size_t r = i >> 9;
    mix[r * 1024 + c] = spre[i] * sigmoidf_(gl[i] + bglu[c]);
}
__global__ void rmsnorm_rows(const float* __restrict__ in, int ld, int off, int n, const float* __restrict__ g, float* __restrict__ out, int ntok) {
    const int r = blockIdx.x * 256 + threadIdx.x; if (r >= ntok) return;
    const float* p = in + (size_t)r * ld + off; float s = 0.f;
    for (int j = 0; j < n; ++j) s = fmaf(p[j], p[j], s);
    const float rs = rsqrtf(s / n + RMS_EPS);
    for (int j = 0; j < n; ++j) out[(size_t)r * n + j] = p[j] * rs * g[j];
}
__device__ __forceinline__ void rope_cs(int pos, int i, float& c, float& s) {
    const float inv = expf(-9.210340371976184f * (float)i * (1.f / 16.f));
    const float a = (float)pos * inv; c = cosf(a); s = sinf(a);
}
__global__ void rope_ew(float* __restrict__ q, const float* __restrict__ proj, int ldp, float* __restrict__ krope, int ntok) {
    const int idx = blockIdx.x * 256 + threadIdx.x; if (idx >= ntok * 9 * 16) return;
    const int i = idx & 15, hh = (idx >> 4) % 9, r = idx / 144, pos = r % SEQ;
    float c, s; rope_cs(pos, i, c, s);
    if (hh < 8) { float* p = q + (size_t)r * 768 + hh * 96 + 64; const float t1 = p[i], t2 = p[i + 16]; p[i] = t1 * c - t2 * s; p[i + 16] = t1 * s + t2 * c; }
    else { const float* p = proj + (size_t)r * ldp + 896; const float t1 = p[i], t2 = p[i + 16]; krope[(size_t)r * 32 + i] = t1 * c - t2 * s; krope[(size_t)r * 32 + i + 16] = t1 * s + t2 * c; }
}
__global__ void __launch_bounds__(64) attn_naive(const float* __restrict__ q, const float* __restrict__ kv, const float* __restrict__ krope, float* __restrict__ mix) {
    const int qi = blockIdx.x * 64 + threadIdx.x, h = blockIdx.y, b = blockIdx.z;
    const size_t r = (size_t)b * SEQ + qi;
    float qv[96], o[64];
#pragma unroll
    for (int d = 0; d < 96; ++d) qv[d] = q[r * 768 + h * 96 + d] * ATT_SCALE;
#pragma unroll
    for (int d = 0; d < 64; ++d) o[d] = 0.f;
    float m = -1e30f, l = 0.f;
    for (int s = 0; s < SEQ; ++s) {
        const size_t kr = (size_t)b * SEQ + s;
        const float4* kn = (const float4*)(kv + kr * 1024 + h * 128);
        const float4* kp = (const float4*)(krope + kr * 32);
        float sc = 0.f;
#pragma unroll
        for (int d = 0; d < 16; ++d) { const float4 k4 = kn[d]; sc = fmaf(qv[4 * d], k4.x, sc); sc = fmaf(qv[4 * d + 1], k4.y, sc); sc = fmaf(qv[4 * d + 2], k4.z, sc); sc = fmaf(qv[4 * d + 3], k4.w, sc); }
#pragma unroll
        for (int d = 0; d < 8; ++d) { const float4 k4 = kp[d]; sc = fmaf(qv[64 + 4 * d], k4.x, sc); sc = fmaf(qv[64 + 4 * d + 1], k4.y, sc); sc = fmaf(qv[64 + 4 * d + 2], k4.z, sc); sc = fmaf(qv[64 + 4 * d + 3], k4.w, sc); }
        const float mn = fmaxf(m, sc), al = __expf(m - mn), p = __expf(sc - mn);
        l = l * al + p; m = mn;
        const float4* vp = (const float4*)(kv + kr * 1024 + h * 128 + 64);
#pragma unroll
        for (int d = 0; d < 16; ++d) { const float4 v4 = vp[d]; o[4 * d] = fmaf(o[4 * d], al, p * v4.x); o[4 * d + 1] = fmaf(o[4 * d + 1], al, p * v4.y); o[4 * d + 2] = fmaf(o[4 * d + 2], al, p * v4.z); o[4 * d + 3] = fmaf(o[4 * d + 3], al, p * v4.w); }
    }
    const float il = 1.f / l;
#pragma unroll
    for (int d = 0; d < 64; ++d) mix[r * 1024 + 512 + h * 64 + d] = o[d] * il;
}
__device__ __forceinline__ float wsum(float v) {
#pragma unroll
    for (int o = 1; o < 64; o <<= 1) v += __shfl_xor(v, o);
    return v;
}
__global__ void __launch_bounds__(256) ln1_rows(const float* __restrict__ x, const float* __restrict__ mixo, const float* __restrict__ g, const float* __restrict__ bb, float* __restrict__ x1, int ntok) {
    const int r = blockIdx.x * 4 + (threadIdx.x >> 6), lane = threadIdx.x & 63; if (r >= ntok) return;
    float v[16]; float s = 0.f;
#pragma unroll
    for (int j = 0; j < 16; ++j) { const int c = lane + 64 * j; v[j] = ALPHA * x[(size_t)r * 1024 + c] + mixo[(size_t)r * 1024 + c]; s += v[j]; }
    const float mean = wsum(s) * (1.f / 1024.f); float q = 0.f;
#pragma unroll
    for (int j = 0; j < 16; ++j) { v[j] -= mean; q = fmaf(v[j], v[j], q); }
    const float rstd = rsqrtf(wsum(q) * (1.f / 1024.f) + LN_EPS);
#pragma unroll
    for (int j = 0; j < 16; ++j) { const int c = lane + 64 * j; x1[(size_t)r * 1024 + c] = v[j] * rstd * g[c] + bb[c]; }
}
}

__device__ __forceinline__ void route_token(const float (&lg)[64], const float* __restrict__ rbias, int (&idx)[6], float (&w)[6]) {
    float sc[64], ch[64];
#pragma unroll
    for (int j = 0; j < 64; ++j) { sc[j] = 1.f / (1.f + __expf(-lg[j])); ch[j] = sc[j] + rbias[j]; }
    float gs[8];
#pragma unroll
    for (int g = 0; g < 8; ++g) { float m1 = -INFINITY, m2 = -INFINITY;
#pragma unroll
        for (int j = 0; j < 8; ++j) { const float v = ch[g * 8 + j]; if (v > m1) { m2 = m1; m1 = v; } else if (v > m2) m2 = v; }
        gs[g] = m1 + m2; }
    bool sel[8];
#pragma unroll
    for (int g = 0; g < 8; ++g) { int rank = 0;
#pragma unroll
        for (int o = 0; o < 8; ++o) { if (o != g && (gs[o] > gs[g] || (gs[o] == gs[g] && o < g))) ++rank; }
        sel[g] = rank < 4; }
#pragma unroll
    for (int j = 0; j < 64; ++j) if (!sel[j >> 3]) ch[j] = -INFINITY;
    float wsum_ = 0.f;
#pragma unroll
    for (int k = 0; k < 6; ++k) { float best = -INFINITY; int bi = 0;
#pragma unroll
        for (int j = 0; j < 64; ++j) if (ch[j] > best) { best = ch[j]; bi = j; }
        float sv = 0.f;
#pragma unroll
        for (int j = 0; j < 64; ++j) if (j == bi) { sv = sc[j]; ch[j] = -INFINITY; }
        idx[k] = bi; w[k] = sv; wsum_ += sv; }
    const float inv = 2.5f / (wsum_ + 1e-20f);
#pragma unroll
    for (int k = 0; k < 6; ++k) w[k] *= inv;
}

namespace gold {
__global__ void __launch_bounds__(64) route_rows(const float* __restrict__ logits, const float* __restrict__ rbias, int* __restrict__ topi, float* __restrict__ topw, int ntok) {
    const int r = blockIdx.x * 64 + threadIdx.x; if (r >= ntok) return;
    float lg[64];
#pragma unroll
    for (int j = 0; j < 16; ++j) { const float4 v = ((const float4*)(logits + (size_t)r * 64))[j]; lg[4 * j] = v.x; lg[4 * j + 1] = v.y; lg[4 * j + 2] = v.z; lg[4 * j + 3] = v.w; }
    int idx[6]; float w[6]; route_token(lg, rbias, idx, w);
#pragma unroll
    for (int k = 0; k < 6; ++k) { topi[(size_t)r * 6 + k] = idx[k]; topw[(size_t)r * 6 + k] = w[k]; }
}
__global__ void __launch_bounds__(256) moe_naive(const float* x1, const int* __restrict__ topi, const float* __restrict__ topw,
                                                  const float* __restrict__ weg, const float* __restrict__ weu, const float* __restrict__ wed,
                                                  const float* __restrict__ wsg, const float* __restrict__ wsu, const float* __restrict__ wsd,
                                                  const float* __restrict__ g2, const float* __restrict__ b2, float* out) {
    __shared__ float xs[1024]; __shared__ float hs[256]; __shared__ float red[8];
    const int r = blockIdx.x, tid = threadIdx.x;
#pragma unroll
    for (int j = 0; j < 4; ++j) xs[tid + 256 * j] = x1[(size_t)r * 1024 + tid + 256 * j];
    __syncthreads();
    float acc[4] = {0.f, 0.f, 0.f, 0.f};
    for (int ei = 0; ei < 7; ++ei) {
        const int e = ei < 6 ? topi[(size_t)r * 6 + ei] : 0; const float w = ei < 6 ? topw[(size_t)r * 6 + ei] : 1.f;
        const float* Wg = ei < 6 ? weg + (size_t)e * 1024 * 256 : wsg; const float* Wu = ei < 6 ? weu + (size_t)e * 1024 * 256 : wsu; const float* Wd = ei < 6 ? wed + (size_t)e * 256 * 1024 : wsd;
        float gg = 0.f, uu = 0.f;
        for (int k = 0; k < 1024; ++k) { const float xv = xs[k]; gg = fmaf(xv, Wg[(size_t)k * 256 + tid], gg); uu = fmaf(xv, Wu[(size_t)k * 256 + tid], uu); }
        hs[tid] = gg / (1.f + __expf(-gg)) * uu;
        __syncthreads();
        float y[4] = {0.f, 0.f, 0.f, 0.f};
        for (int i = 0; i < 256; ++i) { const float hv = hs[i];
#pragma unroll
            for (int j = 0; j < 4; ++j) y[j] = fmaf(hv, Wd[(size_t)i * 1024 + tid + 256 * j], y[j]); }
#pragma unroll
        for (int j = 0; j < 4; ++j) acc[j] = fmaf(w, y[j], acc[j]);
        __syncthreads();
    }
    float v[4]; float s = 0.f;
#pragma unroll
    for (int j = 0; j < 4; ++j) { v[j] = ALPHA * xs[tid + 256 * j] + acc[j]; s += v[j]; }
    s = wsum(s); if ((tid & 63) == 0) red[tid >> 6] = s; __syncthreads();
    const float mean = (red[0] + red[1] + red[2] + red[3]) * (1.f / 1024.f); float q = 0.f;
#pragma unroll
    for (int j = 0; j < 4; ++j) { v[j] -= mean; q = fmaf(v[j], v[j], q); }
    q = wsum(q); if ((tid & 63) == 0) red[4 + (tid >> 6)] = q; __syncthreads();
    const float rstd = rsqrtf((red[4] + red[5] + red[6] + red[7]) * (1.f / 1024.f) + LN_EPS);
#pragma unroll
    for (int j = 0; j < 4; ++j) { const int c = tid + 256 * j; out[(size_t)r * 1024 + c] = v[j] * rstd * g2[c] + b2[c]; }
}

struct In {
    const float *x, *w_in, *lam_re, *lam_im, *log_dt, *b_re, *b_im, *c_re, *c_im, *d_skip, *w_glu, *b_glu, *q_norm_g, *w_uq, *kv_norm_g, *w_ukv, *w_o, *ln1_g, *ln1_b,
                *w_router, *router_bias, *we_gate, *we_up, *we_down, *ws_gate, *ws_up, *ws_down, *ln2_g, *ln2_b;
};
constexpr size_t GOLD_FLOATS_PER_TOK = 6400;
struct Bufs { float *proj, *spre, *gl, *mix, *cqn, *ckvn, *q, *kv, *krope, *mixo, *logits; int* topi; float* topw; };
static Bufs run(const In& I, int tok0, int ntok, float* scratch, float* x1out, float* out, hipStream_t st) {
    Bufs B;
    B.proj = scratch; B.spre = B.proj + (size_t)ntok * 928; B.gl = B.spre + (size_t)ntok * 512; B.mix = B.gl + (size_t)ntok * 512;
    B.cqn = B.mix + (size_t)ntok * 1024; B.ckvn = B.cqn + (size_t)ntok * 256; B.q = B.ckvn + (size_t)ntok * 128; B.kv = B.q + (size_t)ntok * 768;
    B.krope = B.kv + (size_t)ntok * 1024; B.mixo = B.krope + (size_t)ntok * 32; B.logits = B.mixo + (size_t)ntok * 1024;
    B.topi = (int*)(B.logits + (size_t)ntok * 64); B.topw = (float*)(B.topi + (size_t)ntok * 6);
    float *proj = B.proj, *spre = B.spre, *gl = B.gl, *mix = B.mix, *cqn = B.cqn, *ckvn = B.ckvn, *q = B.q, *kv = B.kv, *krope = B.krope, *mixo = B.mixo, *logits = B.logits; int* topi = B.topi; float* topw = B.topw;
    const float* x = I.x + (size_t)tok0 * 1024; const int nb = ntok / SEQ;
    hipLaunchKernelGGL(sgemm, dim3((928 + 63) / 64, ntok / 64), dim3(256), 0, st, x, 1024, I.w_in, 928, proj, 928, ntok, 928, 1024);
    hipLaunchKernelGGL(ssm_naive, dim3(32, nb), dim3(64), 0, st, proj, 928, I.lam_re, I.lam_im, I.log_dt, I.b_re, I.b_im, I.c_re, I.c_im, I.d_skip, spre);
    hipLaunchKernelGGL(sgemm, dim3(8, ntok / 64), dim3(256), 0, st, spre, 512, I.w_glu, 512, gl, 512, ntok, 512, 512);
    hipLaunchKernelGGL(glu_ew, dim3((unsigned)(((size_t)ntok * 512 + 255) / 256)), dim3(256), 0, st, spre, gl, I.b_glu, mix, ntok);
    hipLaunchKernelGGL(rmsnorm_rows, dim3((ntok + 255) / 256), dim3(256), 0, st, proj, 928, 512, 256, I.q_norm_g, cqn, ntok);
    hipLaunchKernelGGL(rmsnorm_rows, dim3((ntok + 255) / 256), dim3(256), 0, st, proj, 928, 768, 128, I.kv_norm_g, ckvn, ntok);
    hipLaunchKernelGGL(sgemm, dim3(12, ntok / 64), dim3(256), 0, st, cqn, 256, I.w_uq, 768, q, 768, ntok, 768, 256);
    hipLaunchKernelGGL(sgemm, dim3(16, ntok / 64), dim3(256), 0, st, ckvn, 128, I.w_ukv, 1024, kv, 1024, ntok, 1024, 128);
    hipLaunchKernelGGL(rope_ew, dim3((ntok * 144 + 255) / 256), dim3(256), 0, st, q, proj, 928, krope, ntok);
    hipLaunchKernelGGL(attn_naive, dim3(SEQ / 64, 8, nb), dim3(64), 0, st, q, kv, krope, mix);
    hipLaunchKernelGGL(sgemm, dim3(16, ntok / 64), dim3(256), 0, st, mix, 1024, I.w_o, 1024, mixo, 1024, ntok, 1024, 1024);
    hipLaunchKernelGGL(ln1_rows, dim3(ntok / 4), dim3(256), 0, st, x, mixo, I.ln1_g, I.ln1_b, x1out, ntok);
    hipLaunchKernelGGL(sgemm, dim3(1, ntok / 64), dim3(256), 0, st, x1out, 1024, I.w_router, 64, logits, 64, ntok, 64, 1024);
    hipLaunchKernelGGL(route_rows, dim3(ntok / 64), dim3(64), 0, st, logits, I.router_bias, topi, topw, ntok);
    hipLaunchKernelGGL(moe_naive, dim3(ntok), dim3(256), 0, st, x1out, topi, topw, I.we_gate, I.we_up, I.we_down, I.ws_gate, I.ws_up, I.ws_down, I.ln2_g, I.ln2_b, out);
    return B;
}
}
#define GAS __attribute__((address_space(1)))
#define LAS __attribute__((address_space(3)))
typedef unsigned short bf16_t;
typedef short bf16x8 __attribute__((ext_vector_type(8)));
typedef short s16x4 __attribute__((ext_vector_type(4)));
typedef float f32x4 __attribute__((ext_vector_type(4)));
typedef float f32x2 __attribute__((ext_vector_type(2)));
typedef float f32x16 __attribute__((ext_vector_type(16)));
typedef unsigned u32x4 __attribute__((ext_vector_type(4)));
typedef unsigned u32x2 __attribute__((ext_vector_type(2)));

namespace fx {
constexpr int T = 65536, SEQ = 2048, DM = 1024, NB = 32;
constexpr int CHK = 32;
constexpr int NCHK = SEQ / CHK;
constexpr int UHR = NB * NCHK;
constexpr int UHK = CHK * 16 + 256;
constexpr int Y8_LD = 1024;
constexpr int SPRE_LD = 512;
constexpr int NCH = 2;
constexpr int CAPC = T / NCH;
constexpr int NVE = NCH * 65;
constexpr float ALPHA = 1.189207115002721f, LN_EPS = 1e-5f, RMS_EPS = 1e-6f;
constexpr float QSCALE = 0.10206207261596577f * 1.4426950408889634f;

constexpr size_t MiB = 1u << 20;
constexpr size_t WS_CTL = 0, CTL_BYTES = 1 * MiB;
constexpr size_t WS_ROPE = 1 * MiB;
constexpr size_t WS_KT = 2 * MiB;
constexpr size_t WS_WIN = 4 * MiB, WS_WGLU = 6 * MiB, WS_WUQ = 6 * MiB + 512 * 1024, WS_WUKV = 7 * MiB, WS_WO = 8 * MiB;
constexpr size_t WS_WST = 10 * MiB, WS_MO = 18 * MiB, WS_WGU = 42 * MiB  , WS_WR = 107 * MiB  , WS_WD = 107 * MiB + 512 * 1024;
constexpr size_t WS_SSQQ = 140 * MiB, WS_SSQKV = 141 * MiB, WS_TSLOT = 142 * MiB, WS_TOPW = 144 * MiB, WS_ROWTOK = 146 * MiB, WS_LOGIT = 162 * MiB;
constexpr size_t WS_XB = 178 * MiB, WS_UH = 306 * MiB, WS_CQ = 402 * MiB, WS_CKVR = 434 * MiB, WS_S = 466 * MiB, WS_Q = 530 * MiB, WS_KV = 626 * MiB, WS_SPRE = 754 * MiB, WS_MIX = 818 * MiB;
constexpr size_t WS_X1B = 178 * MiB, WS_H = 306 * MiB, WS_Y = 562 * MiB  , WS_YS = 800 * MiB  , WS_HS = 864 * MiB  ;
constexpr size_t WS_GOLD = 946 * MiB, WS_END = 1024 * MiB;
constexpr int CW_TMO = 0, CW_CODE = 1, CW_BAR = 4096, CW_CNT = 16384  , CW_DBG = 65536  , CW_QUEUE = 32768  ;

constexpr int RING_BYTES = 131072, TAB_OFF = RING_BYTES, IDX_OFF = TAB_OFF + 10752  , IDX_UNITS = 16, MISC_OFF = IDX_OFF + IDX_UNITS * 1024, LDS_BYTES = MISC_OFF + 256;

__device__ __forceinline__ unsigned cvt_pk_bf16(float lo, float hi) { unsigned r; asm volatile("v_cvt_pk_bf16_f32 %0, %1, %2" : "=v"(r) : "v"(lo), "v"(hi)); return r; }
__device__ __forceinline__ float bf_lo(unsigned w) { return __uint_as_float(w << 16); }
__device__ __forceinline__ float bf_hi(unsigned w) { return __uint_as_float(w & 0xffff0000u); }
__device__ __forceinline__ u32x4 pack8(const f32x4 a, const f32x4 b) { u32x4 w; w.x = cvt_pk_bf16(a[0], a[1]); w.y = cvt_pk_bf16(a[2], a[3]); w.z = cvt_pk_bf16(b[0], b[1]); w.w = cvt_pk_bf16(b[2], b[3]); return w; }
__device__ __forceinline__ void unpack8(const u32x4 w, f32x4& a, f32x4& b) { a = (f32x4){bf_lo(w.x), bf_hi(w.x), bf_lo(w.y), bf_hi(w.y)}; b = (f32x4){bf_lo(w.z), bf_hi(w.z), bf_lo(w.w), bf_hi(w.w)}; }
__device__ __forceinline__ float fast_sigmoid(float x) { return __builtin_amdgcn_rcpf(1.f + __builtin_amdgcn_exp2f(-1.4426950408889634f * x)); }
__device__ __forceinline__ float gelu_tanh_f(float x) {
    const float z2 = 1.5957691216057308f * (x + 0.044715f * x * x * x);
    return x * fast_sigmoid(z2);
}
#ifndef SC1_STORES
#define SC1_STORES 0
#endif
__device__ __forceinline__ void store16(void* p, const u32x4 v) {
#if SC1_STORES
    asm volatile("global_store_dwordx4 %0, %1, off sc1\n\ts_nop 1" :: "v"(p), "v"(v) : "memory");
#else
    *(u32x4*)p = v;
#endif
}
__device__ __forceinline__ u32x4 ror8_x4(const u32x4 v) { u32x4 r;
    r.x = (unsigned)__builtin_amdgcn_update_dpp(0, (int)v.x, 0x128, 0xF, 0xF, false); r.y = (unsigned)__builtin_amdgcn_update_dpp(0, (int)v.y, 0x128, 0xF, 0xF, false);
    r.z = (unsigned)__builtin_amdgcn_update_dpp(0, (int)v.z, 0x128, 0xF, 0xF, false); r.w = (unsigned)__builtin_amdgcn_update_dpp(0, (int)v.w, 0x128, 0xF, 0xF, false); return r; }
__device__ __forceinline__ void store_lines16(bf16_t* rowp, size_t ld, const u32x4 X, const u32x4 Y, int fr, int fq) {
    const bool lo = fr < 8; const u32x4 S = lo ? Y : X, R = ror8_x4(S);
    const u32x4 A1 = lo ? X : R, A2 = lo ? R : Y;
    bf16_t* p = rowp + (size_t)(fr & 7) * ld + (lo ? 8 * fq : 32 + 8 * fq);
    *(u32x4*)p = A1; *(u32x4*)(p + 8 * ld) = A2;
}
__device__ __forceinline__ float wave_sum(float v) {
#pragma unroll
    for (int o = 1; o < 64; o <<= 1) v += __shfl_xor(v, o);
    return v;
}

#define XB_TMO      128
#define XB_XCNT(j)  (256  + 64 * (j))
#define XB_XSUB(j)  (1280 + 64 * (j))
#define XB_XGEN(j)  (2304 + 64 * (j))
#define XB_TOP      3328
#define XB_TOPGEN   3392
#define XCD_BAR_WORDS 3456
#define XB_SPIN_CAP (1u << 18)
__device__ __forceinline__ unsigned xb_ld(unsigned* p)              { return __hip_atomic_load(p, __ATOMIC_RELAXED, __HIP_MEMORY_SCOPE_AGENT); }
__device__ __forceinline__ unsigned xb_add(unsigned* p, unsigned v) { return __hip_atomic_fetch_add(p, v, __ATOMIC_RELAXED, __HIP_MEMORY_SCOPE_AGENT); }
__device__ __forceinline__ unsigned xb_xcc_id() { return (unsigned)__builtin_amdgcn_s_getreg((3 << 11) | 20) & 0xFu; }
#define XB_SPIN(cond, bar) do { unsigned _sp = 0; while (cond) { __builtin_amdgcn_s_sleep(1); \
    if ((++_sp & 255u) == 0u) { if (xb_ld(&(bar)[XB_TMO])) break; if (_sp > XB_SPIN_CAP) { atomicAdd(&(bar)[XB_TMO], 1u); break; } } } } while (0)
struct XcdBarrier { unsigned* bar; unsigned x; volatile LAS unsigned* st; };
__device__ __forceinline__ XcdBarrier xcd_barrier_post(unsigned* bar, volatile LAS unsigned* st) {
    XcdBarrier b; b.bar = bar; b.x = xb_xcc_id(); b.st = st;
    if (threadIdx.x == 0) (void)xb_add(&bar[XB_XCNT(b.x)], 1u);
    return b;
}
__device__ __forceinline__ void xcd_barrier_complete(unsigned* bar, unsigned x, unsigned& nloc, unsigned& nx) {
    const unsigned G = gridDim.x * gridDim.y * gridDim.z;
    unsigned sum, cnt, mine, sp = 0u;
    for (;;) {
        sum = 0u; cnt = 0u; mine = 0u;
#pragma unroll
        for (unsigned j = 0; j < 16; ++j) { const unsigned c = xb_ld(&bar[XB_XCNT(j)]); sum += c; cnt += (c > 0u) ? 1u : 0u; mine = (j == x) ? c : mine; }
        if (sum == G) break;
        __builtin_amdgcn_s_sleep(1);
        if ((++sp & 255u) == 0u) { if (xb_ld(&bar[XB_TMO])) break; if (sp > XB_SPIN_CAP) { atomicAdd(&bar[XB_TMO], 1u); break; } }
    }
    nloc = mine > 0u ? mine : 1u; nx = cnt > 0u ? cnt : 1u;
}
__device__ __forceinline__ void xcd_barrier(const XcdBarrier& b) {
    asm volatile("s_waitcnt vmcnt(0)" ::: "memory");
    __syncthreads();
    if (threadIdx.x == 0) {
        unsigned* bar = b.bar;
        __builtin_amdgcn_s_waitcnt(0);
        unsigned nloc = b.st[0], nx = b.st[1];
        if (nloc == 0u) { xcd_barrier_complete(bar, b.x, nloc, nx); b.st[0] = nloc; b.st[1] = nx; }
        const unsigned old = xb_add(&bar[XB_XSUB(b.x)], 1u);
        const unsigned gen = old / nloc;
        if (old + 1u == (gen + 1u) * nloc) {
            __builtin_amdgcn_fence(__ATOMIC_RELEASE, "agent");
            asm volatile("s_waitcnt vmcnt(0)" ::: "memory");
            const unsigned og = xb_add(&bar[XB_TOP], 1u);
            const unsigned tg = og / nx;
            if (og + 1u == (tg + 1u) * nx) xb_add(&bar[XB_TOPGEN], 1u);
            else XB_SPIN(xb_ld(&bar[XB_TOPGEN]) == tg, bar);
            __builtin_amdgcn_fence(__ATOMIC_ACQUIRE, "agent");
            xb_add(&bar[XB_XGEN(b.x)], 1u);
            asm volatile("s_waitcnt vmcnt(0)" ::: "memory");
        } else {
            XB_SPIN(xb_ld(&bar[XB_XGEN(b.x)]) == gen, bar);
            __builtin_amdgcn_fence(__ATOMIC_ACQUIRE, "agent");
            asm volatile("s_waitcnt vmcnt(0)" ::: "memory");
        }
    }
    __syncthreads();
}

constexpr int BM = 256, BK = 64, HALF = 128, HTB = HALF * BK * 2, STAGE_BYTES = 8 * HTB;
__host__ __device__ __forceinline__ int lds_byte(int r, int c) { const int st = (r >> 4) * 2 + (c >> 5), rr = r & 15, cc = c & 31, ob = rr * 64 + cc * 2; return st * 1024 + (ob ^ (((ob >> 9) & 1) << 5)); }
__host__ __device__ __forceinline__ void stage_rc(int b, int& R, int& C) { const int st = b / 1024, sb = b % 1024, swz = sb ^ (((sb >> 9) & 1) << 5); R = (st >> 1) * 16 + swz / 64; C = (st & 1) * 32 + (swz % 64) / 2; }
__host__ __device__ __forceinline__ int perm32(int rho) { const int n = rho >> 4, i = rho & 15; return 8 * (i >> 2) + 4 * n + (i & 3); }
__host__ __device__ __forceinline__ int perm16x(int rho) { const int n = rho >> 4, i = rho & 15; return 16 * (i >> 2) + 4 * n + (i & 3); }

struct Unit { const char* A; const char* B; int i0, i1, i2, i3; };
__device__ __forceinline__ int xcd_remap(int L, int nwg) { const int q = nwg / 8, r = nwg % 8, xcd = L % 8, off = L / 8; return (xcd < r ? xcd * (q + 1) : r * (q + 1) + (xcd - r) * q) + off; }

template <class Epi, class Sched, bool ALIGN_EPI, bool GATHER, int STAG = 0, int AMODE = 0>
__device__ __forceinline__ void gemm_phase(LAS unsigned char* lds, const int lda, const int ldb, const int K, const Sched& S, const Epi& E) {
    if constexpr (STAG > 0) { const unsigned long long t0_ = __builtin_amdgcn_s_memrealtime(), dl_ = (unsigned long long)STAG * ((blockIdx.x >> 3) & 3u); while (__builtin_amdgcn_s_memrealtime() - t0_ < dl_) __builtin_amdgcn_s_sleep(4); }
    int tid = threadIdx.x; asm volatile("" : "+v"(tid));
    const int wid = __builtin_amdgcn_readfirstlane(tid >> 6), lane = tid & 63, wr = wid >> 2, wc = wid & 3, fr = lane & 15, fq = lane >> 4;
    const int nt = K / BK;
    unsigned voffA[2], voffB[2]; int RA[2], CA[2];
#pragma unroll
    for (int i = 0; i < 2; ++i) { int R, C; stage_rc(tid * 16 + i * 8192, R, C); const int Rb = 64 * (R >> 5) + (Epi::PERM == 2 ? perm16x(R & 31) : Epi::PERM ? perm32(R & 31) : (R & 31));
        RA[i] = R; CA[i] = C; voffA[i] = AMODE == 1 ? (unsigned)((R >> 4) * 8192 + (R & 7) * 1024 + (C >> 5) * 128 + ((R >> 3) & 1) * 64 + (C & 31) * 2) : (unsigned)(R * lda + C) * 2u; voffB[i] = (unsigned)(Rb * ldb + C) * 2u; }
    const size_t kstep = (size_t)(BK * 2), kstepA = AMODE == 1 ? 256 : kstep;
    const size_t hstepA = (size_t)HALF * lda * 2, hstepB = (size_t)(Epi::PERM == 2 ? 8 : 32) * ldb * 2;
    const unsigned ldsw = (unsigned)wid * 1024u;
    const int aoff = lds_byte(wr * 64 + fr, fq * 8), boff = lds_byte(wc * 32 + fr, fq * 8);
#define PG8_SA(b, h) (((b) * 2 + (h)) * HTB)
#define PG8_SB(b, h) ((4 + (b) * 2 + (h)) * HTB)
#define PG8_STAGE(bufoff, gbase, voff) do { _Pragma("unroll") for (int _i = 0; _i < 2; ++_i) \
        __builtin_amdgcn_global_load_lds((const unsigned*)((const char*)(gbase) + (voff)[_i]), (LAS unsigned*)(lds + (bufoff) + ldsw + _i * 8192), 16, 0, 0); } while (0)
#define PG8_STAGE_A(bufoff, base, g0, g1, h, kb) do { if constexpr (GATHER) { \
        __builtin_amdgcn_global_load_lds((const unsigned*)((base) + (kb) + (g0)), (LAS unsigned*)(lds + (bufoff) + ldsw), 16, 0, 0); \
        __builtin_amdgcn_global_load_lds((const unsigned*)((base) + (kb) + (g1)), (LAS unsigned*)(lds + (bufoff) + ldsw + 8192), 16, 0, 0); } \
      else { PG8_STAGE(bufoff, (base) + (h) * hstepA + (kb), voffA); } } while (0)
#define PG8_LDA(dst, b, h) do { _Pragma("unroll") for (int m = 0; m < 4; ++m) _Pragma("unroll") for (int k = 0; k < 2; ++k) dst[m][k] = *(const LAS bf16x8*)(lds + PG8_SA(b, h) + aoff + m * 2048 + k * 1024); } while (0)
#define PG8_LDB(dst, b, h) do { _Pragma("unroll") for (int n = 0; n < 2; ++n) _Pragma("unroll") for (int k = 0; k < 2; ++k) dst[n][k] = *(const LAS bf16x8*)(lds + PG8_SB(b, h) + boff + n * 2048 + k * 1024); } while (0)
#define PG8_MMA(ai, bj, At, Bt) do { __builtin_amdgcn_s_setprio(1); _Pragma("unroll") for (int m = 0; m < 4; ++m) _Pragma("unroll") for (int n = 0; n < 2; ++n) _Pragma("unroll") for (int k = 0; k < 2; ++k) \
        acc[ai][bj][m][n] = __builtin_amdgcn_mfma_f32_16x16x32_bf16(Bt[n][k], At[m][k], acc[ai][bj][m][n], 0, 0, 0); __builtin_amdgcn_s_setprio(0); } while (0)
#define PG8_WAIT_V(n) asm volatile("s_waitcnt vmcnt(" #n ")" ::: "memory")
#define PG8_WAIT_VN(n) asm volatile("s_waitcnt vmcnt(%0)" :: "n"(n) : "memory")
#define PG8_WAIT_L(n) asm volatile("s_waitcnt lgkmcnt(" #n ")" ::: "memory")
#define PG8_BAR __builtin_amdgcn_s_barrier()
#define PG8_SCHED __builtin_amdgcn_sched_barrier(0)
    Unit cur, nxt; int ui = 0;
    if (!S.next(0, cur)) return;
    unsigned gc00 = 0, gc01 = 0, gc10 = 0, gc11 = 0, gn00 = 0, gn01 = 0, gn10 = 0, gn11 = 0;
    if constexpr (GATHER) { S.gather(cur, RA[0], CA[0], RA[1], CA[1], gc00, gc01, gc10, gc11); gn00 = gc00; gn01 = gc01; gn10 = gc10; gn11 = gc11; }
    f32x4 acc[2][2][4][2];
#pragma unroll
    for (int a = 0; a < 2; ++a)
#pragma unroll
        for (int b = 0; b < 2; ++b)
#pragma unroll
            for (int m = 0; m < 4; ++m)
#pragma unroll
                for (int n = 0; n < 2; ++n) acc[a][b][m][n] = (f32x4){0.f, 0.f, 0.f, 0.f};
    bf16x8 At[4][2], B0[2][2], B1[2][2];
    const char* cA = cur.A; const char* cB = cur.B;
    PG8_STAGE(PG8_SB(0, 0), cB, voffB); PG8_STAGE(PG8_SB(0, 1), cB + hstepB, voffB); PG8_STAGE_A(PG8_SA(0, 0), cA, gc00, gc01, 0, 0); PG8_STAGE_A(PG8_SA(0, 1), cA, gc10, gc11, 1, 0);
    if (wr == 1) PG8_BAR;
    PG8_WAIT_V(2); PG8_BAR;
    PG8_STAGE(PG8_SB(1, 0), cB + kstep, voffB); PG8_STAGE_A(PG8_SA(1, 0), cA, gc00, gc01, 0, kstepA); PG8_STAGE(PG8_SB(1, 1), cB + hstepB + kstep, voffB);
    PG8_WAIT_V(6); PG8_BAR;
    for (;;) {
        const bool has_next = S.next(ui + 1, nxt);
        if constexpr (GATHER) { if (has_next) S.gather(nxt, RA[0], CA[0], RA[1], CA[1], gn00, gn01, gn10, gn11); }
        const char* nA = has_next ? nxt.A : cA; const char* nB = has_next ? nxt.B : cB;
#pragma unroll 1
        for (int t = 0; t < nt; t += 2) {
            const bool last = (t == nt - 2);
            const size_t k1 = (size_t)(t + 1) * kstepA;
            const char* a2 = last ? nA : cA; const char* b2 = last ? nB : cB + (size_t)(t + 2) * kstep;
            const size_t k2 = last ? 0 : (size_t)(t + 2) * kstepA, k3 = k2 + kstepA;
            const char* b3 = b2 + kstep;
            unsigned g200 = gc00, g201 = gc01, g210 = gc10, g211 = gc11;
            if constexpr (GATHER) { if (last) { g200 = gn00; g201 = gn01; g210 = gn10; g211 = gn11; } }
            PG8_LDB(B0, 0, 0); PG8_LDB(B1, 0, 1); PG8_SCHED; PG8_LDA(At, 0, 0); PG8_STAGE_A(PG8_SA(1, 1), cA, gc10, gc11, 1, k1);
            PG8_WAIT_V(8); PG8_WAIT_L(0); PG8_BAR; PG8_MMA(0, 0, At, B0); PG8_MMA(0, 1, At, B1); PG8_BAR; PG8_SCHED;
            PG8_LDA(At, 0, 1); PG8_STAGE(PG8_SB(0, 0), b2, voffB); PG8_STAGE(PG8_SB(0, 1), b2 + hstepB, voffB); PG8_STAGE_A(PG8_SA(0, 0), a2, g200, g201, 0, k2);
            PG8_WAIT_V(8); PG8_WAIT_L(0); PG8_BAR; PG8_MMA(1, 0, At, B0); PG8_MMA(1, 1, At, B1); PG8_BAR; PG8_SCHED;
            PG8_LDB(B0, 1, 0); PG8_LDB(B1, 1, 1); PG8_SCHED; PG8_LDA(At, 1, 0); PG8_STAGE_A(PG8_SA(0, 1), a2, g210, g211, 1, k2);
            PG8_WAIT_V(8); PG8_WAIT_L(0); PG8_BAR; PG8_MMA(0, 0, At, B0); PG8_MMA(0, 1, At, B1); PG8_BAR; PG8_SCHED;
            PG8_LDA(At, 1, 1); PG8_STAGE(PG8_SB(1, 0), b3, voffB); PG8_STAGE(PG8_SB(1, 1), b3 + hstepB, voffB); PG8_STAGE_A(PG8_SA(1, 0), a2, g200, g201, 0, k3);
            PG8_WAIT_V(8); PG8_WAIT_L(0); PG8_BAR; PG8_MMA(1, 0, At, B0); PG8_MMA(1, 1, At, B1); PG8_BAR; PG8_SCHED;
        }
#if defined(MK_TPROBE) && MK_TPROBE >= 200
        unsigned long long tp0_ = 0; if (blockIdx.x == 0 && wid == 0) tp0_ = __builtin_amdgcn_s_memrealtime();
#endif
        if constexpr (ALIGN_EPI) { if (wr == 0) PG8_BAR; }
        E(acc, cur, wr, wc, fr, fq);
#if defined(MK_TPROBE) && MK_TPROBE >= 200
        if (blockIdx.x == 0 && wid == 0) { asm volatile("s_waitcnt vmcnt(0)" ::: "memory"); const unsigned long long d_ = __builtin_amdgcn_s_memrealtime() - tp0_; if (lane == 0) { volatile LAS unsigned* M_ = (volatile LAS unsigned*)(lds + MISC_OFF); const unsigned long long a_ = (((unsigned long long)M_[23] << 32) | M_[22]) + d_; M_[22] = (unsigned)a_; M_[23] = (unsigned)(a_ >> 32); } }
#endif
        if (!has_next) break;
#pragma unroll
        for (int a = 0; a < 2; ++a)
#pragma unroll
            for (int b = 0; b < 2; ++b)
#pragma unroll
                for (int m = 0; m < 4; ++m)
#pragma unroll
                    for (int n = 0; n < 2; ++n) acc[a][b][m][n] = (f32x4){0.f, 0.f, 0.f, 0.f};
        cur = nxt; cA = nA; cB = nB; ++ui;
        if constexpr (GATHER) { gc00 = gn00; gc01 = gn01; gc10 = gn10; gc11 = gn11; }
        if constexpr (ALIGN_EPI) { if (wr == 1) PG8_BAR; }
    }
    PG8_WAIT_V(0);
    if constexpr (!ALIGN_EPI) { if (wr == 0) PG8_BAR; }
    PG8_BAR;
#undef PG8_SA
#undef PG8_SB
#undef PG8_STAGE
#undef PG8_STAGE_A
#undef PG8_LDA
#undef PG8_LDB
#undef PG8_MMA
#undef PG8_WAIT_V
#undef PG8_WAIT_VN
#undef PG8_WAIT_L
#undef PG8_BAR
#undef PG8_SCHED
}
}
namespace fx {
#define FX_ROWLOOP _Pragma("unroll") for (int ai = 0; ai < 2; ++ai) _Pragma("unroll") for (int m = 0; m < 4; ++m)

struct PlainOrder {
    const char* A; const char* B; int lda, ldb, nM, nN, nwg, G, c;
    __device__ __forceinline__ void init(const void* A_, int lda_, const void* B_, int ldb_, int M, int N, int G_, int c_) { A = (const char*)A_; B = (const char*)B_; lda = lda_; ldb = ldb_; nM = M / 256; nN = N / 256; nwg = nM * nN; G = G_; c = c_; }
    __device__ __forceinline__ bool next(int i, Unit& u) const {
        const long L = (long)i * G + c; if (L >= nwg) return false;
        const int wgid = xcd_remap((int)L, nwg);
        const int nig = 8 * nN, gid = wgid / nig, fm = gid * 8, gsz = (nM - fm) < 8 ? (nM - fm) : 8;
        const int pm = fm + ((wgid % nig) % gsz), pn = (wgid % nig) / gsz;
        u.A = A + (size_t)pm * 256 * lda * 2; u.B = B + (size_t)pn * 256 * ldb * 2; u.i0 = pm; u.i1 = pn; u.i2 = 0; u.i3 = 0; return true;
    }
};
struct PanelOrder {
    const char* A; const char* B; int lda, ldb, nM, nN, G, c;
    __device__ __forceinline__ void init(const void* A_, int lda_, const void* B_, int ldb_, int M, int N, int G_, int c_) { A = (const char*)A_; B = (const char*)B_; lda = lda_; ldb = ldb_; nM = M / 256; nN = N / 256; G = G_; c = c_; }
    __device__ __forceinline__ bool next(int i, Unit& u) const {
        const int j = i / nN, pn = i - j * nN, pm = c + j * G; if (pm >= nM) return false;
        u.A = A + (size_t)pm * 256 * lda * 2; u.B = B + (size_t)pn * 256 * ldb * 2; u.i0 = pm; u.i1 = pn; u.i2 = 0; u.i3 = 0; return true;
    }
};
struct GroupOrder {
    const char* A; const char* B; int ldb, nN, nwg, G, c;
    __device__ __forceinline__ void init(const void* A_, const void* B_, int ldb_, int nN_, int G_, int c_) { A = (const char*)A_; B = (const char*)B_; ldb = ldb_; nN = nN_; nwg = 32 * 8 * nN_; G = G_; c = c_; }
    __device__ __forceinline__ bool next(int i, Unit& u) const {
        const long L = (long)i * G + c; if (L >= nwg) return false;
        const int wgid = xcd_remap((int)L, nwg);
        const int per = 8 * nN, g = wgid / per, rem = wgid % per, pm = rem % 8, pn = rem / 8;
        u.A = A + ((size_t)g * UHR + (size_t)pm * 256) * UHK * 2; u.B = B + ((size_t)g * nN * 256 + (size_t)pn * 256) * ldb * 2; u.i0 = g; u.i1 = pm; u.i2 = pn; u.i3 = 0; return true;
    }
};

__device__ __forceinline__ void rope8(f32x4& v0, f32x4& v1, const float* __restrict__ ropec, const float* __restrict__ ropes, int pos, int fq) {
    const f32x4 c = *(const f32x4*)(ropec + pos * 16 + 4 * fq), s = *(const f32x4*)(ropes + pos * 16 + 4 * fq);
    const f32x4 a = v0, b = v1;
    v0 = (f32x4){a[0] * c[0] - a[1] * s[0], a[0] * s[0] + a[1] * c[0], a[2] * c[1] - a[3] * s[1], a[2] * s[1] + a[3] * c[1]};
    v1 = (f32x4){b[0] * c[2] - b[1] * s[2], b[0] * s[2] + b[1] * c[2], b[2] * c[3] - b[3] * s[3], b[2] * s[3] + b[3] * c[3]};
}
__device__ __forceinline__ float sumsq8(const f32x4 a, const f32x4 b) { return (a[0] * a[0] + a[1] * a[1]) + (a[2] * a[2] + a[3] * a[3]) + (b[0] * b[0] + b[1] * b[1]) + (b[2] * b[2] + b[3] * b[3]); }

struct EpiWin {
    static constexpr int PERM = 1; static constexpr int NST = 16;
    bf16_t* UH; bf16_t* CQ; bf16_t* CKVR; float* ssqq; float* ssqkv; const float* ropec; const float* ropes;
    __device__ __forceinline__ void operator()(const f32x4 (&acc)[2][2][4][2], const Unit& u, int wr, int wc, int fr, int fq) const {
        const int pm = u.i0, pn = u.i1, row0 = pm * 256 + wr * 64 + fr;
        if (pn < 2) {
            FX_ROWLOOP { const int row = row0 + ai * 128 + m * 16, r32 = row >> 5, tq = row & 31;
#pragma unroll
                for (int bj = 0; bj < 2; ++bj) { const int c = pn * 256 + wc * 64 + bj * 32 + 8 * fq, g = c >> 4, p0 = c & 15;
                    *(u32x4*)(UH + ((size_t)(g * UHR + r32) * UHK + tq * 16 + p0)) = pack8(acc[ai][bj][m][0], acc[ai][bj][m][1]); } }
        } else if (pn == 2) {
            FX_ROWLOOP { const int row = row0 + ai * 128 + m * 16; float ss = sumsq8(acc[ai][0][m][0], acc[ai][0][m][1]) + sumsq8(acc[ai][1][m][0], acc[ai][1][m][1]);
                store_lines16(CQ + (size_t)(row - fr) * 256 + 64 * wc, 256, pack8(acc[ai][0][m][0], acc[ai][0][m][1]), pack8(acc[ai][1][m][0], acc[ai][1][m][1]), fr, fq);
                ss += __shfl_xor(ss, 16); ss += __shfl_xor(ss, 32);
                if (fq == 0) ssqq[(size_t)row * 4 + wc] = ss; }
        } else {
            FX_ROWLOOP { const int row = row0 + ai * 128 + m * 16; float ss = 0.f; u32x4 w[2];
#pragma unroll
                for (int bj = 0; bj < 2; ++bj) { f32x4 v0 = acc[ai][bj][m][0], v1 = acc[ai][bj][m][1];
                    if (wc < 2) ss += sumsq8(v0, v1);
                    if (wc == 2 && bj == 0) rope8(v0, v1, ropec, ropes, row & (SEQ - 1), fq);
                    w[bj] = pack8(v0, v1); }
                store_lines16(CKVR + (size_t)(row - fr) * 256 + 64 * wc, 256, w[0], w[1], fr, fq);
                ss += __shfl_xor(ss, 16); ss += __shfl_xor(ss, 32);
                if (fq == 0) ssqkv[(size_t)row * 4 + wc] = ss; }
        }
    }
};
struct EpiQ {
    static constexpr int PERM = 1; static constexpr int NST = 16;
    bf16_t* Q; const float* ssqq; const float* ropec; const float* ropes;
    __device__ __forceinline__ void operator()(const f32x4 (&acc)[2][2][4][2], const Unit& u, int wr, int wc, int fr, int fq) const {
        const int pm = u.i0, pn = u.i1, row0 = pm * 256 + wr * 64;
        FX_ROWLOOP { const int row = row0 + fr + ai * 128 + m * 16; const f32x4 s4 = *(const f32x4*)(ssqq + (size_t)row * 4);
            const float rs = __builtin_amdgcn_rsqf(((s4[0] + s4[1]) + (s4[2] + s4[3])) * (1.f / 256.f) + RMS_EPS) * QSCALE;
            u32x4 w[2];
#pragma unroll
            for (int bj = 0; bj < 2; ++bj) { const int G = 8 * pn + 2 * wc + bj;
                f32x4 v0 = acc[ai][bj][m][0] * rs, v1 = acc[ai][bj][m][1] * rs;
                if (G % 3 == 2) rope8(v0, v1, ropec, ropes, row & (SEQ - 1), fq);
                w[bj] = pack8(v0, v1); }
            store_lines16(Q + (size_t)(row0 + ai * 128 + m * 16) * 768 + 256 * pn + 64 * wc, 768, w[0], w[1], fr, fq); }
    }
};
struct EpiKV {
    static constexpr int PERM = 1; static constexpr int NST = 16;
    bf16_t* KV; const float* ssqkv;
    __device__ __forceinline__ void operator()(const f32x4 (&acc)[2][2][4][2], const Unit& u, int wr, int wc, int fr, int fq) const {
        const int pm = u.i0, pn = u.i1, row0 = pm * 256 + wr * 64;
        FX_ROWLOOP { const int row = row0 + fr + ai * 128 + m * 16; const f32x4 s4 = *(const f32x4*)(ssqkv + (size_t)row * 4);
            const float rs = __builtin_amdgcn_rsqf(((s4[0] + s4[1]) + (s4[2] + s4[3])) * (1.f / 128.f) + RMS_EPS);
            store_lines16(KV + (size_t)(row0 + ai * 128 + m * 16) * 1024 + 256 * pn + 64 * wc, 1024, pack8(acc[ai][0][m][0] * rs, acc[ai][0][m][1] * rs), pack8(acc[ai][1][m][0] * rs, acc[ai][1][m][1] * rs), fr, fq); }
    }
};
struct EpiSt {
    static constexpr int PERM = 1; static constexpr int NST = 16;
    bf16_t* S;
    __device__ __forceinline__ void operator()(const f32x4 (&acc)[2][2][4][2], const Unit& u, int wr, int wc, int fr, int fq) const {
        const int g = u.i0, pm = u.i1, row0 = pm * 256 + wr * 64;
        FX_ROWLOOP store_lines16(S + ((size_t)g * UHR + row0 + ai * 128 + m * 16) * 256 + 64 * wc, 256, pack8(acc[ai][0][m][0], acc[ai][0][m][1]), pack8(acc[ai][1][m][0], acc[ai][1][m][1]), fr, fq);
    }
};
struct EpiSsmOut {
    static constexpr int PERM = 1; static constexpr int NST = 16;
    bf16_t* SPRE;
    __device__ __forceinline__ void operator()(const f32x4 (&acc)[2][2][4][2], const Unit& u, int wr, int wc, int fr, int fq) const {
        const int g = u.i0, pm = u.i1, pn = u.i2, row0 = pm * 256 + wr * 64 + fr;
        const int p0 = 8 * (fq & 1);
        FX_ROWLOOP { const int R = row0 + ai * 128 + m * 16;
#pragma unroll
            for (int bj = 0; bj < 2; ++bj) { const int c = 256 * pn + 64 * wc + 32 * bj + 8 * fq, tq = c >> 4;
                f32x4 y0 = acc[ai][bj][m][0], y1 = acc[ai][bj][m][1];
#pragma unroll
                for (int j = 0; j < 4; ++j) { y0[j] = gelu_tanh_f(y0[j]); y1[j] = gelu_tanh_f(y1[j]); }
                *(u32x4*)(SPRE + ((size_t)R * 32 + tq) * SPRE_LD + g * 16 + p0) = pack8(y0, y1); } }
    }
};
struct EpiGlu {
    static constexpr int PERM = 1; static constexpr int NST = 16;
    const bf16_t* SPRE; bf16_t* MIX; const float* bglu;
    __device__ __forceinline__ void operator()(const f32x4 (&acc)[2][2][4][2], const Unit& u, int wr, int wc, int fr, int fq) const {
        const int pm = u.i0, pn = u.i1, row0 = pm * 256 + wr * 64;
        f32x4 b0[2], b1[2];
#pragma unroll
        for (int bj = 0; bj < 2; ++bj) { const int c = 256 * pn + 64 * wc + 32 * bj + 8 * fq; b0[bj] = *(const f32x4*)(bglu + c); b1[bj] = *(const f32x4*)(bglu + c + 4); }
        FX_ROWLOOP { const int row = row0 + fr + ai * 128 + m * 16; u32x4 w[2];
#pragma unroll
            for (int bj = 0; bj < 2; ++bj) { const int c = 256 * pn + 64 * wc + 32 * bj + 8 * fq;
                const u32x4 sw = *(const u32x4*)(SPRE + (size_t)row * SPRE_LD + c); f32x4 s0, s1; unpack8(sw, s0, s1);
                f32x4 z0 = acc[ai][bj][m][0] + b0[bj], z1 = acc[ai][bj][m][1] + b1[bj];
#pragma unroll
                for (int j = 0; j < 4; ++j) { z0[j] = s0[j] * fast_sigmoid(z0[j]); z1[j] = s1[j] * fast_sigmoid(z1[j]); }
                w[bj] = pack8(z0, z1); }
            store_lines16(MIX + (size_t)(row0 + ai * 128 + m * 16) * 1024 + 256 * pn + 64 * wc, 1024, w[0], w[1], fr, fq); }
    }
};
struct EpiWo {
    static constexpr int PERM = 1; static constexpr int NST = 16;
    bf16_t* XY;
    __device__ __forceinline__ void operator()(const f32x4 (&acc)[2][2][4][2], const Unit& u, int wr, int wc, int fr, int fq) const {
        const int pm = u.i0, pn = u.i1, row0 = pm * 256 + wr * 64;
        u32x4 xw[2][4][2];
#pragma unroll
        for (int ai = 0; ai < 2; ++ai)
#pragma unroll
            for (int m = 0; m < 4; ++m)
#pragma unroll
                for (int bj = 0; bj < 2; ++bj) xw[ai][m][bj] = *(const u32x4*)(XY + (size_t)(row0 + fr + ai * 128 + m * 16) * 1024 + 256 * pn + wc * 64 + bj * 32 + 8 * fq);
        asm volatile("s_waitcnt vmcnt(0)" ::: "memory");
        FX_ROWLOOP { u32x4 w[2];
#pragma unroll
            for (int bj = 0; bj < 2; ++bj) { f32x4 x0, x1; unpack8(xw[ai][m][bj], x0, x1); w[bj] = pack8(x0 * ALPHA + acc[ai][bj][m][0], x1 * ALPHA + acc[ai][bj][m][1]); }
            store_lines16(XY + (size_t)(row0 + ai * 128 + m * 16) * 1024 + 256 * pn + 64 * wc, 1024, w[0], w[1], fr, fq); }
    }
};
__device__ __forceinline__ size_t h_off(int row, int col) { return (size_t)(row >> 4) * 4096 + (size_t)(row & 7) * 512 + (size_t)(col >> 5) * 64 + (size_t)((row >> 3) & 1) * 32 + (size_t)(col & 31); }
struct EpiSharedRouter {
    static constexpr int PERM = 1; static constexpr int NST = 0;
    bf16_t* HS; float* LG;
    __device__ __forceinline__ void operator()(const f32x4 (&acc)[2][2][4][2], const Unit& u, int wr, int wc, int fr, int fq) const {
        const int pm = u.i0, pn = u.i1, row0 = pm * 256 + wr * 64 + fr;
        if (pn < 2) {
            const int c = 128 * pn + 32 * wc + 8 * fq;
            FX_ROWLOOP { f32x4 h0, h1;
#pragma unroll
                for (int j = 0; j < 4; ++j) { const float g0 = acc[ai][0][m][0][j], g1 = acc[ai][0][m][1][j];
                    h0[j] = g0 * fast_sigmoid(g0) * acc[ai][1][m][0][j]; h1[j] = g1 * fast_sigmoid(g1) * acc[ai][1][m][1][j]; }
                *(u32x4*)(HS + h_off(row0 + ai * 128 + m * 16, c)) = pack8(h0, h1); }
        } else if (wc == 0) {
            FX_ROWLOOP { float* rp = LG + (size_t)(row0 + ai * 128 + m * 16) * 64 + 8 * fq;
#pragma unroll
                for (int bj = 0; bj < 2; ++bj) { *(f32x4*)(rp + bj * 32) = acc[ai][bj][m][0]; *(f32x4*)(rp + bj * 32 + 4) = acc[ai][bj][m][1]; } }
        }
    }
};

struct MoeTab { LAS int* tbase; LAS unsigned* tab; };
__device__ __forceinline__ MoeTab moe_tab(LAS unsigned char* lds) { MoeTab t; t.tbase = (LAS int*)(lds + TAB_OFF); t.tab = (LAS unsigned*)(lds + TAB_OFF + 2304); return t; }
__device__ __forceinline__ int ve_count(const unsigned* ctl, int ve) { return (ve % 65 == 64) ? CAPC : (int)__hip_atomic_load(ctl + CW_CNT + 64 * ve, __ATOMIC_RELAXED, __HIP_MEMORY_SCOPE_AGENT); }
__device__ __forceinline__ void moe_build_tab(LAS unsigned char* lds, const unsigned* ctl) {
    const MoeTab t = moe_tab(lds); LAS int* nt = (LAS int*)(lds + TAB_OFF + 1024 + 64);
    const int tid = threadIdx.x;
    if (tid < NVE) nt[tid] = (ve_count(ctl, tid) + 255) >> 8;
    __syncthreads();
    if (tid <= NVE) { int s = 0; for (int v = 0; v < tid; ++v) s += nt[v]; t.tbase[tid] = s; }
    __syncthreads();
    for (int v = tid; v < NVE; v += 512) { const int b = t.tbase[v], n = t.tbase[v + 1] - b; for (int j = 0; j < n; ++j) t.tab[b + j] = (unsigned)v | ((unsigned)j << 16); }
    __syncthreads();
}
struct GateUpOrder {
    const char* X1B; const char* WGU; MoeTab tb; LAS int* idx; int nunits, G, c;
    int tb0;
    __device__ __forceinline__ int tile_of(int tr) const { return tb0 + tr; }
    __device__ __forceinline__ void init(LAS unsigned char* lds, const void* x1b, const void* wgu, const int* rowtok, const unsigned* ctl, int chn, int G_, int c_) {
        X1B = (const char*)x1b; WGU = (const char*)wgu; tb = moe_tab(lds); idx = (LAS int*)(lds + IDX_OFF); G = G_; c = c_;
        tb0 = tb.tbase[chn * 65]; nunits = 2 * (tb.tbase[chn * 65 + 64] - tb0);
        __syncthreads();
        int vals[IDX_UNITS / 2];
#pragma unroll
        for (int i2 = 0; i2 < IDX_UNITS / 2; ++i2) { const int i = 2 * i2 + (int)(threadIdx.x >> 8); const long L = (long)i * G + c; vals[i2] = 0;
            if (L < nunits) { const int tile = tile_of(xcd_remap((int)L, nunits) >> 1); const unsigned e = tb.tab[tile]; const int ve = (int)(e & 0xffffu), tix = (int)(e >> 16), ch = ve / 65, ex = ve % 65;
                const int cnt = ve_count(ctl, ve), slot = tix * 256 + (int)(threadIdx.x & 255);
                vals[i2] = slot < cnt ? rowtok[(size_t)(ch * 64 + ex) * CAPC + slot] : ch * CAPC; } }
#pragma unroll
        for (int i2 = 0; i2 < IDX_UNITS / 2; ++i2) idx[(2 * i2 + (int)(threadIdx.x >> 8)) * 256 + (threadIdx.x & 255)] = vals[i2];
        __syncthreads();
    }
    __device__ __forceinline__ bool next(int i, Unit& u) const {
        const long L = (long)i * G + c; if (L >= nunits) return false;
        const int wgid = xcd_remap((int)L, nunits), tile = tile_of(wgid >> 1), pn = wgid & 1;
        const int ex = (int)(tb.tab[tile] & 0xffffu) % 65;
        u.A = X1B; u.B = WGU + ((size_t)ex * 512 + (size_t)pn * 256) * 1024 * 2; u.i0 = tile * 256; u.i1 = pn; u.i2 = 0; u.i3 = i < IDX_UNITS ? i : IDX_UNITS - 1; return true;
    }
    __device__ __forceinline__ void gather(const Unit& u, int R0, int C0, int R1, int C1, unsigned& g00, unsigned& g01, unsigned& g10, unsigned& g11) const {
        const LAS int* ip = idx + u.i3 * 256;
        g00 = (unsigned)ip[R0] * 2048u + (unsigned)C0 * 2u; g01 = (unsigned)ip[R1] * 2048u + (unsigned)C1 * 2u;
        g10 = (unsigned)ip[128 + R0] * 2048u + (unsigned)C0 * 2u; g11 = (unsigned)ip[128 + R1] * 2048u + (unsigned)C1 * 2u;
    }
};
struct EpiGateUp {
    static constexpr int PERM = 1; static constexpr int NST = 8;
    bf16_t* H;
    __device__ __forceinline__ void operator()(const f32x4 (&acc)[2][2][4][2], const Unit& u, int wr, int wc, int fr, int fq) const {
        const int hrow0 = u.i0 + wr * 64 + fr, c = 128 * u.i1 + 32 * wc + 8 * fq;
        FX_ROWLOOP { f32x4 h0, h1;
#pragma unroll
            for (int j = 0; j < 4; ++j) { const float g0 = acc[ai][0][m][0][j], g1 = acc[ai][0][m][1][j];
                h0[j] = g0 * fast_sigmoid(g0) * acc[ai][1][m][0][j]; h1[j] = g1 * fast_sigmoid(g1) * acc[ai][1][m][1][j]; }
            *(u32x4*)(H + h_off(hrow0 + ai * 128 + m * 16, c)) = pack8(h0, h1); }
    }
};
struct DownOrder {
    const char* Hh; const char* HS; const char* WD; MoeTab tb; int t0, nunits, G, c, chn;
    __device__ __forceinline__ void init(const void* h, const void* hs, const void* wd, MoeTab tb_, int ch, int G_, int c_) { Hh = (const char*)h; HS = (const char*)hs; WD = (const char*)wd; tb = tb_; chn = ch; t0 = tb_.tbase[ch * 65]; nunits = 4 * (tb_.tbase[(ch + 1) * 65] - t0); G = G_; c = c_; }
    __device__ __forceinline__ bool next(int i, Unit& u) const {
        const long L = (long)i * G + c; if (L >= nunits) return false;
        const int wgid = xcd_remap((int)L, nunits), tile = t0 + (wgid >> 2), pn = wgid & 3;
        const int ex = (int)(tb.tab[tile] & 0xffffu) % 65;
        u.A = ex == 64 ? HS + ((size_t)chn * CAPC + (size_t)(tb.tab[tile] >> 16) * 256) * 256 * 2 : Hh + (size_t)tile * 256 * 256 * 2; u.B = WD + ((size_t)ex * 1024 + (size_t)pn * 256) * 256 * 2; u.i0 = ex == 64 ? (int)(tb.tab[tile] >> 16) * 256 : (tile - t0) * 256; u.i1 = pn; u.i2 = ex == 64; u.i3 = 0; return true;
    }
};
constexpr float Y8_SCALE = 16.f, Y8_INV = 1.f / 16.f;
__device__ __forceinline__ u32x2 pack8_fp8(const f32x4 a, const f32x4 b) {
    int w0 = 0, w1 = 0;
    w0 = __builtin_amdgcn_cvt_pk_fp8_f32(a[0] * Y8_SCALE, a[1] * Y8_SCALE, w0, false); w0 = __builtin_amdgcn_cvt_pk_fp8_f32(a[2] * Y8_SCALE, a[3] * Y8_SCALE, w0, true);
    w1 = __builtin_amdgcn_cvt_pk_fp8_f32(b[0] * Y8_SCALE, b[1] * Y8_SCALE, w1, false); w1 = __builtin_amdgcn_cvt_pk_fp8_f32(b[2] * Y8_SCALE, b[3] * Y8_SCALE, w1, true);
    u32x2 r; r.x = (unsigned)w0; r.y = (unsigned)w1; return r;
}
__device__ __forceinline__ void unpack8_fp8(const u32x2 w, f32x4& a, f32x4& b) {
    const f32x2 p0 = __builtin_amdgcn_cvt_pk_f32_fp8((int)w.x, false), p1 = __builtin_amdgcn_cvt_pk_f32_fp8((int)w.x, true);
    const f32x2 p2 = __builtin_amdgcn_cvt_pk_f32_fp8((int)w.y, false), p3 = __builtin_amdgcn_cvt_pk_f32_fp8((int)w.y, true);
    a = (f32x4){p0.x, p0.y, p1.x, p1.y}; b = (f32x4){p2.x, p2.y, p3.x, p3.y};
}
__device__ __forceinline__ size_t y8_off(int row, int col) { return (size_t)row * 1024 + (size_t)col; }
template <int STORE = 1> struct EpiDownT {
    static constexpr int PERM = 2; static constexpr int NST = 8;
    unsigned char* Y8; bf16_t* YS; LAS unsigned char* lds;
    __device__ __forceinline__ void operator()(const f32x4 (&acc)[2][2][4][2], const Unit& u, int wr, int wc, int fr, int fq) const {
        const int yrow0 = u.i0 + wr * 64, c0 = 256 * u.i1 + 64 * wc + 16 * fq;
        if (u.i2) {
            const bool lo = fr < 8;
            FX_ROWLOOP { const u32x4 X = pack8(acc[ai][0][m][0], acc[ai][0][m][1]), Y = pack8(acc[ai][1][m][0], acc[ai][1][m][1]);
                const u32x4 S = lo ? Y : X, R = ror8_x4(S); const u32x4 A1 = lo ? X : R, A2 = lo ? R : Y;
                bf16_t* p = YS + (size_t)(yrow0 + ai * 128 + m * 16 + (fr & 7)) * 1024 + c0 + (lo ? 0 : 8);
                *(u32x4*)p = A1; *(u32x4*)(p + 8 * 1024) = A2; }
        } else {
            FX_ROWLOOP { unsigned char* rp = Y8 + y8_off(yrow0 + ai * 128 + m * 16 + fr, c0);
                const u32x2 lo = pack8_fp8(acc[ai][0][m][0], acc[ai][0][m][1]), hi = pack8_fp8(acc[ai][1][m][0], acc[ai][1][m][1]);
                u32x4 w; w.x = lo.x; w.y = lo.y; w.z = hi.x; w.w = hi.y; *(u32x4*)rp = w; }
        }
    }
};
typedef EpiDownT<1> EpiDown;
}
namespace fx {
namespace att {
constexpr int NW = 8, QBLK = 32, KVBLK = 64;
constexpr int SHM_V = 16384, SHM_K = 16384;
constexpr float THRL = 8.f;
#define KSWZ(row, colB) ((row) * 256 + ((colB) ^ (((row) & 7) << 4)))
#define SBAR() __builtin_amdgcn_sched_barrier(0)
__device__ __forceinline__ int crow(int r, int hi) { return (r & 3) + 8 * (r >> 2) + 4 * hi; }
__device__ __forceinline__ float bf16_round(float x) { return __uint_as_float(cvt_pk_bf16(x, 0.f) << 16); }
template <bool FIRST> __device__ __forceinline__ void partialSM(f32x16& p0, f32x16& p1, float& m_reg, float& alpha, bf16x8& qm, int hi) {
  float mx0 = fmaxf(p0[0], p0[1]), mx1 = fmaxf(p0[8], p0[9]), mx2 = fmaxf(p1[0], p1[1]), mx3 = fmaxf(p1[8], p1[9]);
#pragma unroll
  for (int r = 2; r < 8; ++r) { mx0 = fmaxf(mx0, p0[r]); mx1 = fmaxf(mx1, p0[8 + r]); mx2 = fmaxf(mx2, p1[r]); mx3 = fmaxf(mx3, p1[8 + r]); }
  float pmax = fmaxf(fmaxf(mx0, mx1), fmaxf(mx2, mx3));
  { auto rr = __builtin_amdgcn_permlane32_swap(__float_as_uint(pmax), __float_as_uint(pmax), false, false);
    pmax = fmaxf(__uint_as_float(rr[0]), __uint_as_float(rr[1])); }
  if (!FIRST && __builtin_expect(__all(pmax <= THRL), 1)) { alpha = 1.f; }
  else {
    const float mnew = bf16_round(FIRST ? pmax : m_reg + fmaxf(pmax, 0.f)), delta = mnew - m_reg;
    alpha = FIRST ? 1.f : __builtin_amdgcn_exp2f(-delta); m_reg = mnew;
    qm[0] = hi == 0 ? (short)(cvt_pk_bf16(-mnew, 0.f) & 0xffffu) : (short)0;
#pragma unroll
    for (int r = 0; r < 16; ++r) p0[r] = p0[r] - delta;
#pragma unroll
    for (int r = 0; r < 16; ++r) p1[r] = p1[r] - delta;
  }
#pragma unroll
  for (int r = 0; r < 16; ++r) p0[r] = __builtin_amdgcn_exp2f(p0[r]);
}
__device__ __forceinline__ void finishSM(f32x16& p0, f32x16& p1, float alpha, float& l_reg, bf16x8& pa0, bf16x8& pa1, bf16x8& pa2, bf16x8& pa3) {
#pragma unroll
  for (int r = 0; r < 16; ++r) p1[r] = __builtin_amdgcn_exp2f(p1[r]);
  float ps0 = p0[0], ps1 = p0[8], ps2 = p1[0], ps3 = p1[8];
#pragma unroll
  for (int r = 1; r < 8; ++r) { ps0 += p0[r]; ps1 += p0[8 + r]; ps2 += p1[r]; ps3 += p1[8 + r]; }
  float ps = (ps0 + ps1) + (ps2 + ps3);
  { auto rr = __builtin_amdgcn_permlane32_swap(__float_as_uint(ps), __float_as_uint(ps), false, false);
    ps = __uint_as_float(rr[0]) + __uint_as_float(rr[1]); }
  l_reg = l_reg * alpha + ps;
#define PK4(P, BASE, OUT) do { unsigned a0 = cvt_pk_bf16(P[BASE + 0], P[BASE + 1]), a1 = cvt_pk_bf16(P[BASE + 2], P[BASE + 3]);   \
    unsigned b0 = cvt_pk_bf16(P[BASE + 4], P[BASE + 5]), b1 = cvt_pk_bf16(P[BASE + 6], P[BASE + 7]);                              \
    auto r0 = __builtin_amdgcn_permlane32_swap(a0, b0, false, false); auto r1 = __builtin_amdgcn_permlane32_swap(a1, b1, false, false); \
    u32x4 w = {r0[0], r1[0], r0[1], r1[1]}; OUT = *reinterpret_cast<bf16x8*>(&w); } while (0)
  PK4(p0, 0, pa0); PK4(p0, 8, pa1); PK4(p1, 0, pa2); PK4(p1, 8, pa3);
#undef PK4
}
__device__ __forceinline__ void qkt(f32x16& p0, f32x16& p1, const char* Ks, const bf16x8 (&qr)[6], const bf16x8 kone, const bf16x8 qm, int r32, int hi) {
  p0 = f32x16{}; p1 = f32x16{};
#pragma unroll
  for (int d0 = 0; d0 < 6; ++d0) { const int cb = (d0 * 16 + hi * 8) * 2;
    const bf16x8 b0 = *reinterpret_cast<const bf16x8*>(Ks + KSWZ(r32, cb));
    const bf16x8 b1 = *reinterpret_cast<const bf16x8*>(Ks + KSWZ(32 + r32, cb));
    p0 = __builtin_amdgcn_mfma_f32_32x32x16_bf16(b0, qr[d0], p0, 0, 0, 0);
    p1 = __builtin_amdgcn_mfma_f32_32x32x16_bf16(b1, qr[d0], p1, 0, 0, 0); }
  p0 = __builtin_amdgcn_mfma_f32_32x32x16_bf16(kone, qm, p0, 0, 0, 0);
  p1 = __builtin_amdgcn_mfma_f32_32x32x16_bf16(kone, qm, p1, 0, 0, 0);
}
__device__ __forceinline__ int v_st(int k, int c) { const int kk = (k & ~0xC) | ((k & 4) << 1) | ((k & 8) >> 1); return ((kk >> 3) * 4 + (c >> 5)) * 512 + ((kk & 7) * 32 + (c & 31)) * 2; }
__device__ __forceinline__ int v_rd_base(int lane) { return ((lane & 3) << 3) | (((lane >> 2) & 3) << 6) | (((lane >> 4) & 1) << 5) | (((lane >> 5) & 1) << 8); }
constexpr int v_rd_off(int d0, int ks, int half) { return d0 * 512 + ks * 4096 + half * 2048; }
template <int OFF> __device__ __forceinline__ s16x4 tr_read(int vb) {
  s16x4 r; asm volatile("ds_read_b64_tr_b16 %0, %1 offset:%2" : "=&v"(r) : "v"(vb), "i"(OFF) : "memory"); return r;
}
template <int D0> __device__ __forceinline__ void pv_one(f32x16& od, int vb, bf16x8 pa0, bf16x8 pa1, bf16x8 pa2, bf16x8 pa3) {
  const s16x4 l0 = tr_read<v_rd_off(D0, 0, 0)>(vb), h0 = tr_read<v_rd_off(D0, 0, 1)>(vb), l1 = tr_read<v_rd_off(D0, 1, 0)>(vb), h1 = tr_read<v_rd_off(D0, 1, 1)>(vb);
  const s16x4 l2 = tr_read<v_rd_off(D0, 2, 0)>(vb), h2 = tr_read<v_rd_off(D0, 2, 1)>(vb), l3 = tr_read<v_rd_off(D0, 3, 0)>(vb), h3 = tr_read<v_rd_off(D0, 3, 1)>(vb);
  asm volatile("s_waitcnt lgkmcnt(0)" ::: "memory"); SBAR();
#define PK(L, H) (bf16x8){L[0], L[1], L[2], L[3], H[0], H[1], H[2], H[3]}
  od = __builtin_amdgcn_mfma_f32_32x32x16_bf16(pa0, PK(l0, h0), od, 0, 0, 0);
  od = __builtin_amdgcn_mfma_f32_32x32x16_bf16(pa1, PK(l1, h1), od, 0, 0, 0);
  od = __builtin_amdgcn_mfma_f32_32x32x16_bf16(pa2, PK(l2, h2), od, 0, 0, 0);
  od = __builtin_amdgcn_mfma_f32_32x32x16_bf16(pa3, PK(l3, h3), od, 0, 0, 0);
#undef PK
}
__device__ __forceinline__ void pv_d0(f32x16 (&o)[2], int vb, bf16x8 pa0, bf16x8 pa1, bf16x8 pa2, bf16x8 pa3) {
  pv_one<0>(o[0], vb, pa0, pa1, pa2, pa3); pv_one<1>(o[1], vb, pa0, pa1, pa2, pa3);
}
__device__ __forceinline__ void attn_unit(const unsigned char* __restrict__ wsb, const bf16_t* __restrict__ Q, bf16_t* __restrict__ MIX, int tok0, int qrow0, int h, char* lds) {
  int tid = threadIdx.x; asm volatile("" : "+v"(tid));
  const int wid = __builtin_amdgcn_readfirstlane(tid >> 6), lane = tid & 63, r32 = lane & 31, hi = lane >> 5;
  char* K_lds = lds; char* V_lds = lds + 4 * SHM_K;
  float* ws = (float*)(lds + TAB_OFF) + wid * 64; float* li_l = ws; float* al_l = ws + 32;
  float m_reg = 0.f, l_reg = 0; f32x16 o[2] = {}; bf16x8 qr[6];
  const bf16_t* Qw = Q + (size_t)(tok0 + qrow0 + wid * QBLK + r32) * 768 + h * 96 + hi * 8;
#pragma unroll
  for (int d0 = 0; d0 < 6; ++d0) qr[d0] = *reinterpret_cast<const bf16x8*>(Qw + d0 * 16);
  const int vb0 = (int)(uintptr_t)V_lds + v_rd_base(lane);
  const int ra = tid / 12, ca = tid % 12, rb = (512 + tid) / 12, cb = (512 + tid) % 12, rv = tid >> 3, cv = tid & 7;
  const unsigned kinca = ca < 8 ? 64u * 2048u : 64u * 512u, kincb = cb < 8 ? 64u * 2048u : 64u * 512u;
  const unsigned kofa = ca < 8 ? (unsigned)WS_KV + (unsigned)(((tok0 + ra) * 1024 + h * 128 + ca * 8) * 2) : (unsigned)WS_CKVR + (unsigned)(((tok0 + ra) * 256 + 128 + (ca - 8) * 8) * 2);
  const unsigned kofb = cb < 8 ? (unsigned)WS_KV + (unsigned)(((tok0 + rb) * 1024 + h * 128 + cb * 8) * 2) : (unsigned)WS_CKVR + (unsigned)(((tok0 + rb) * 256 + 128 + (cb - 8) * 8) * 2);
  const unsigned vofs = (unsigned)WS_KV + (unsigned)(((tok0 + rv) * 1024 + h * 128 + 64 + cv * 8) * 2);
  const int ksta = KSWZ(ra, ca * 16), kstb = KSWZ(rb, cb * 16), vst = v_st(rv, cv * 8);
  const bool two = wid < 4;
  bf16x8 RK0a, RK0b, RV0, RK1a, RK1b, RV1;
#define TLOAD(KA, KB, VV, t) do { KA = *reinterpret_cast<const bf16x8*>(wsb + kofa + (unsigned)(t) * kinca); if (two) KB = *reinterpret_cast<const bf16x8*>(wsb + kofb + (unsigned)(t) * kincb); \
    VV = *reinterpret_cast<const bf16x8*>(wsb + vofs + (unsigned)(t) * (64u * 2048u)); } while (0)
#define TWRITE(KA, KB, VV, b) do { constexpr int bo_ = (b) * SHM_K; *(bf16x8*)(K_lds + bo_ + ksta) = KA; if (two) *(bf16x8*)(K_lds + bo_ + kstb) = KB; *(bf16x8*)(V_lds + bo_ + vst) = VV; } while (0)
#define RESC(a) do { if (__any((a) < 1.f)) { if (hi == 0) al_l[r32] = (a); asm volatile("s_waitcnt lgkmcnt(0)" ::: "memory"); \
    _Pragma("unroll") for (int d = 0; d < 2; ++d) _Pragma("unroll") for (int r = 0; r < 16; ++r) o[d][r] *= al_l[crow(r, hi)]; } } while (0)
#define STEP_END() do { asm volatile("s_waitcnt lgkmcnt(0)" ::: "memory"); __builtin_amdgcn_s_barrier(); asm volatile("" ::: "memory"); } while (0)
  f32x16 pA0, pA1, pB0, pB1; float alA, alB; bf16x8 pa0, pa1, pa2, pa3; constexpr int NT = SEQ / KVBLK;
  bf16x8 kone = {}, qm = {}; kone[0] = hi == 0 ? (short)0x3F80 : (short)0;
  m_reg = 0.f;
#define ATT_STEP(PC0, PC1, ALC, PP0, PP1, ALP, KB, VB, WB, RKA, RKB, RVV, S) do { \
    SBAR(); qkt(PC0, PC1, K_lds + (KB) * SHM_K, qr, kone, qm, r32, hi); \
    finishSM(PP0, PP1, ALP, l_reg, pa0, pa1, pa2, pa3); SBAR(); \
    if ((S) + 1 < NT) TWRITE(RKA, RKB, RVV, WB); \
    if ((S) + 3 < NT) TLOAD(RKA, RKB, RVV, (S) + 3); \
    SBAR(); \
    pv_d0(o, vb0 + (VB) * SHM_V, pa0, pa1, pa2, pa3); partialSM<false>(PC0, PC1, m_reg, ALC, qm, hi); \
    RESC(ALC); STEP_END(); } while (0)
  TLOAD(RK0a, RK0b, RV0, 0); TWRITE(RK0a, RK0b, RV0, 0); TLOAD(RK1a, RK1b, RV1, 1); TLOAD(RK0a, RK0b, RV0, 2);
  STEP_END();
  qkt(pA0, pA1, K_lds, qr, kone, qm, r32, hi); partialSM<true>(pA0, pA1, m_reg, alA, qm, hi);
  TWRITE(RK1a, RK1b, RV1, 1); TLOAD(RK1a, RK1b, RV1, 3);
  STEP_END();
  for (int s = 1; s + 3 < NT - 2; s += 4) {
    ATT_STEP(pB0, pB1, alB, pA0, pA1, alA, 1, 0, 2, RK0a, RK0b, RV0, s);
    ATT_STEP(pA0, pA1, alA, pB0, pB1, alB, 2, 1, 3, RK1a, RK1b, RV1, s + 1);
    ATT_STEP(pB0, pB1, alB, pA0, pA1, alA, 3, 2, 0, RK0a, RK0b, RV0, s + 2);
    ATT_STEP(pA0, pA1, alA, pB0, pB1, alB, 0, 3, 1, RK1a, RK1b, RV1, s + 3);
  }
  ATT_STEP(pB0, pB1, alB, pA0, pA1, alA, 1, 0, 2, RK0a, RK0b, RV0, NT - 3);
  ATT_STEP(pA0, pA1, alA, pB0, pB1, alB, 2, 1, 3, RK1a, RK1b, RV1, NT - 2);
  SBAR(); qkt(pB0, pB1, K_lds + 3 * SHM_K, qr, kone, qm, r32, hi);
  finishSM(pA0, pA1, alA, l_reg, pa0, pa1, pa2, pa3); SBAR();
  pv_d0(o, vb0 + 2 * SHM_V, pa0, pa1, pa2, pa3); partialSM<false>(pB0, pB1, m_reg, alB, qm, hi);
  RESC(alB);
  finishSM(pB0, pB1, alB, l_reg, pa0, pa1, pa2, pa3); SBAR();
  pv_d0(o, vb0 + 3 * SHM_V, pa0, pa1, pa2, pa3);
  if (hi == 0) li_l[r32] = l_reg;
  STEP_END();
  char* st = lds + wid * 4096;
#pragma unroll
  for (int r = 0; r < 16; ++r) { const int orow = crow(r, hi); const float rl = __builtin_amdgcn_rcpf(li_l[orow]);
#pragma unroll
    for (int d0 = 0; d0 < 2; ++d0) *(bf16_t*)(st + orow * 128 + (d0 * 32 + r32) * 2) = (bf16_t)(cvt_pk_bf16(o[d0][r] * rl, 0.f) & 0xffffu); }
  asm volatile("s_waitcnt lgkmcnt(0)" ::: "memory");
  bf16_t* Ow = MIX + (size_t)(tok0 + qrow0 + wid * QBLK) * 1024 + 512 + h * 64;
#pragma unroll
  for (int j = 0; j < 4; ++j) { const int q = lane + 64 * j; const u32x4 v = *(const u32x4*)(st + (q >> 3) * 128 + (q & 7) * 16); *(u32x4*)(Ow + (size_t)(q >> 3) * 1024 + (q & 7) * 8) = v; }
  STEP_END();
#undef TLOAD
#undef TWRITE
#undef RESC
#undef STEP_END
#undef ATT_STEP
}
#undef KSWZ
#undef SBAR
}

struct Frame {
    LAS unsigned char* lds; unsigned* ctl; unsigned char* ws; float* out; const float* in[29];
    int tid, lane, wave, G, bid;
};
enum { I_X = 0, I_WIN, I_LRE, I_LIM, I_LDT, I_BRE, I_BIM, I_CRE, I_CIM, I_DSK, I_WGLU, I_BGLU, I_QG, I_WUQ, I_KVG, I_WUKV, I_WO, I_LN1G, I_LN1B, I_WR, I_RB, I_WEG, I_WEU, I_WED, I_WSG, I_WSU, I_WSD, I_LN2G, I_LN2B };

#ifndef MK_TPROBE
#define MK_TPROBE -1
#endif
#define TSUB(F, id) do { if (MK_TPROBE >= 100) { __syncthreads(); if (blockIdx.x == 0 && threadIdx.x == 0) { volatile LAS unsigned* M_ = (volatile LAS unsigned*)((F).lds + MISC_OFF); const unsigned long long tn_ = __builtin_amdgcn_s_memrealtime(); \
    const unsigned long long tl_ = ((unsigned long long)M_[17] << 32) | M_[16]; if ((id) == MK_TPROBE) { const unsigned long long d_ = tn_ - tl_; M_[18] = (unsigned)d_; M_[19] = (unsigned)(d_ >> 32); } M_[16] = (unsigned)tn_; M_[17] = (unsigned)(tn_ >> 32); } } } while (0)
__device__ __forceinline__ int fresh_lane() { int l = (int)(threadIdx.x & 63u); asm volatile("" : "+v"(l)); return l; }
template <class F> __device__ __forceinline__ void transpose_load(const F& f, int k0, int n0, int lane, float (&tv)[32]) {
#pragma unroll
    for (int i = 0; i < 32; ++i) tv[i] = f(k0 + 2 * i + (lane >> 5), n0 + (lane & 31));
}
__device__ __forceinline__ void transpose_store(const float (&tv)[32], bf16_t* Bt, int ldk, int k0, int n0, LAS float* scr, int lane) {
#pragma unroll
    for (int i = 0; i < 32; ++i) scr[(2 * i + (lane >> 5)) * 33 + (lane & 31)] = tv[i];
    asm volatile("s_waitcnt lgkmcnt(0)" ::: "memory");
    const int c = lane & 7;
#pragma unroll
    for (int j = 0; j < 4; ++j) { const int n = (lane >> 3) + 8 * j; const LAS float* s = scr + (8 * c) * 33 + n;
        u32x4 o; o.x = cvt_pk_bf16(s[0 * 33], s[1 * 33]); o.y = cvt_pk_bf16(s[2 * 33], s[3 * 33]); o.z = cvt_pk_bf16(s[4 * 33], s[5 * 33]); o.w = cvt_pk_bf16(s[6 * 33], s[7 * 33]);
        *(u32x4*)(Bt + (size_t)(n0 + n) * ldk + k0 + 8 * c) = o; }
    asm volatile("s_waitcnt lgkmcnt(0)" ::: "memory");
}
template <class F> __device__ __forceinline__ void transpose_item(const F& f, bf16_t* Bt, int ldk, int k0, int n0, LAS float* scr, int lane) {
    float tv[32]; transpose_load(f, k0, n0, lane, tv); transpose_store(tv, Bt, ldk, k0, n0, scr, lane);
}
__device__ __forceinline__ int rope_perm_src(int p) { return (p & 1) ? 16 + (p >> 1) : (p >> 1); }
struct SsmPar { float lr, li, dt, kr, ki; };
__device__ __forceinline__ SsmPar ssm_par(const float* lam_re, const float* lam_im, const float* log_dt, int d, int g, int n) {
    SsmPar p; p.lr = fminf(lam_re[(d * 32 + g) * 64 + n], -1e-4f); p.li = lam_im[(d * 32 + g) * 64 + n]; p.dt = expf(log_dt[d * 32 + g]);
    const float x = p.lr * p.dt, th = p.li * p.dt;
    const float em1 = expm1f(x), cs = cosf(th), sn = sinf(th), sh = sinf(0.5f * th);
    const float ai = (em1 + 1.f) * sn, arm1 = em1 * cs - 2.f * sh * sh, den = p.lr * p.lr + p.li * p.li;
    p.kr = (arm1 * p.lr + ai * p.li) / den; p.ki = (ai * p.lr - arm1 * p.li) / den; return p;
}
__device__ __forceinline__ void ssm_pow_xt(float x, float th, float e, float& pr, float& pi) {
    const float mag = __builtin_amdgcn_exp2f(x * e * 1.4426950408889634f); double trd = (double)th * (double)e * 0.15915494309189535; trd -= rint(trd); const float tr = (float)trd;
    pr = mag * __builtin_amdgcn_cosf(tr); pi = mag * __builtin_amdgcn_sinf(tr);
}
__device__ __forceinline__ void ssm_pow(const SsmPar& p, float e, float& pr, float& pi) { ssm_pow_xt(p.lr * p.dt, p.li * p.dt, e, pr, pi); }

__device__ __forceinline__ void p0_ssm_item(Frame& F, int g, int j) {
    LAS float* Pr = (LAS float*)F.lds;
    LAS float* Pi = Pr + 2 * 64 * 33;
    LAS float* Br = Pi + 2 * 64 * 33;
    LAS float* Bi = Br + 2 * 64 * 16;
    LAS float* Cr = Bi + 2 * 64 * 16;
    LAS float* Ci = Cr + 2 * 16 * 64;
    LAS float* Par = Ci + 2 * 16 * 64;
    const float* lam_re = F.in[I_LRE]; const float* lam_im = F.in[I_LIM]; const float* log_dt = F.in[I_LDT];
    __syncthreads();
    if (F.tid < 128) { const SsmPar p = ssm_par(lam_re, lam_im, log_dt, F.tid >> 6, g, F.tid & 63); Par[F.tid * 4] = p.lr * p.dt; Par[F.tid * 4 + 1] = p.li * p.dt; Par[F.tid * 4 + 2] = p.kr; Par[F.tid * 4 + 3] = p.ki; }
    for (int idx = F.tid; idx < 2 * 16 * 64; idx += 512) { const int n = idx & 63, pp = (idx >> 6) & 15, d = idx >> 10;
        Cr[idx] = F.in[I_CRE][((d * 32 + g) * 16 + pp) * 64 + n]; Ci[idx] = F.in[I_CIM][((d * 32 + g) * 16 + pp) * 64 + n]; }
    __syncthreads();
    for (int idx = F.tid; idx < 2 * 64 * 33; idx += 512) { const int tau = idx % 33, dn = idx / 33; float pr, pi; ssm_pow_xt(Par[dn * 4], Par[dn * 4 + 1], (float)tau, pr, pi); Pr[idx] = pr; Pi[idx] = pi; }
    for (int idx = F.tid; idx < 2 * 64 * 16; idx += 512) { const int q = idx & 15, dn = idx >> 4, n = dn & 63, d = dn >> 6; const float kr = Par[dn * 4 + 2], ki = Par[dn * 4 + 3];
        const float br = F.in[I_BRE][((d * 32 + g) * 64 + n) * 16 + q], bi = F.in[I_BIM][((d * 32 + g) * 64 + n) * 16 + q];
        Br[idx] = kr * br - ki * bi; Bi[idx] = kr * bi + ki * br; }
    __syncthreads();
    float* Kt = (float*)(F.ws + WS_KT) + (size_t)g * 16384;
    { const int blk = 512 * j + F.tid;
      const int q2 = blk & 7, p2 = (blk >> 3) & 7, tau = (blk >> 6) & 31, d = blk >> 11; float s00 = 0.f, s01 = 0.f, s10 = 0.f, s11 = 0.f;
      for (int n = 0; n < 64; ++n) { const float pr = Pr[(d * 64 + n) * 33 + tau], pi = Pi[(d * 64 + n) * 33 + tau];
          const float b0r = Br[(d * 64 + n) * 16 + 2 * q2], b0i = Bi[(d * 64 + n) * 16 + 2 * q2], b1r = Br[(d * 64 + n) * 16 + 2 * q2 + 1], b1i = Bi[(d * 64 + n) * 16 + 2 * q2 + 1];
          const float d0r = pr * b0r - pi * b0i, d0i = pr * b0i + pi * b0r, d1r = pr * b1r - pi * b1i, d1i = pr * b1i + pi * b1r;
          const float c0r = Cr[(d * 16 + 2 * p2) * 64 + n], c0i = Ci[(d * 16 + 2 * p2) * 64 + n], c1r = Cr[(d * 16 + 2 * p2 + 1) * 64 + n], c1i = Ci[(d * 16 + 2 * p2 + 1) * 64 + n];
          s00 += c0r * d0r - c0i * d0i; s01 += c0r * d1r - c0i * d1i; s10 += c1r * d0r - c1i * d0i; s11 += c1r * d1r - c1i * d1i; }
      float* kp = Kt + ((size_t)(d * 32 + tau) * 16 + 2 * p2) * 16 + 2 * q2; kp[0] = s00; kp[1] = s01; kp[16] = s10; kp[17] = s11; }
    bf16_t* Wst = (bf16_t*)(F.ws + WS_WST) + (size_t)g * 256 * 512;
    for (int pc = F.tid; pc < 32 * 64; pc += 512) { const int row = 32 * j + (pc >> 6), k0 = (pc & 63) * 8, s = k0 >> 4, q0 = k0 & 15;
        const int d = row >> 7, ri = (row >> 6) & 1, n = row & 63, e = d ? s : (CHK - 1 - s);
        const float pr = Pr[(d * 64 + n) * 33 + e], pi = Pi[(d * 64 + n) * 33 + e]; float v[8];
#pragma unroll
        for (int t = 0; t < 8; ++t) { const float br = Br[(d * 64 + n) * 16 + q0 + t], bi = Bi[(d * 64 + n) * 16 + q0 + t]; v[t] = ri ? (pr * bi + pi * br) : (pr * br - pi * bi); }
        u32x4 o; o.x = cvt_pk_bf16(v[0], v[1]); o.y = cvt_pk_bf16(v[2], v[3]); o.z = cvt_pk_bf16(v[4], v[5]); o.w = cvt_pk_bf16(v[6], v[7]);
        *(u32x4*)(Wst + (size_t)row * 512 + k0) = o; }
    bf16_t* Mo = (bf16_t*)(F.ws + WS_MO) + (size_t)g * 512 * UHK;
    for (int pc = F.tid; pc < 64 * 32; pc += 512) { const int row = 64 * j + (pc >> 5), kk = (pc & 31) * 8, d = kk >> 7, ri = (kk >> 6) & 1, n0 = kk & 63, tq = row >> 4, pp = row & 15;
        const int e = d ? (CHK - tq) : (tq + 1); float v[8];
#pragma unroll
        for (int t = 0; t < 8; ++t) { const int n = n0 + t; const float pr = Pr[(d * 64 + n) * 33 + e], pi = Pi[(d * 64 + n) * 33 + e], cr = Cr[(d * 16 + pp) * 64 + n], ci = Ci[(d * 16 + pp) * 64 + n];
            v[t] = ri ? -(cr * pi + ci * pr) : (cr * pr - ci * pi); }
        u32x4 o; o.x = cvt_pk_bf16(v[0], v[1]); o.y = cvt_pk_bf16(v[2], v[3]); o.z = cvt_pk_bf16(v[4], v[5]); o.w = cvt_pk_bf16(v[6], v[7]);
        *(u32x4*)(Mo + (size_t)row * UHK + 512 + kk) = o; }
}

template <int PART> __device__ __forceinline__ void p0_prologue(Frame& F) {
    const int lane = fresh_lane();
    if (PART == 1) {
        for (int it = F.bid; it < 256; it += F.G) p0_ssm_item(F, it >> 3, it & 7);
        __syncthreads();
    }
    if (PART == 0) {
        float* rc = (float*)(F.ws + WS_ROPE); float* rs = rc + 2048 * 16;
        for (int idx = F.bid * 512 + F.tid; idx < 2048 * 16; idx += F.G * 512) { const int i = idx & 15, pos = idx >> 4;
            const float inv = expf(-9.210340371976184f * (float)i * (1.f / 16.f)); const float a = (float)pos * inv; rc[idx] = cosf(a); rs[idx] = sinf(a); } }
    LAS float* scr = (LAS float*)(F.lds + F.wave * 16384);
    const int gw = F.bid * 8 + F.wave, NGW = F.G * 8;
    constexpr int I_A = 512, I_B = 128, I_C = 96, I_D = 128, I_E = 128, I_F = 512, I_G = 65 * 256, I_H = 65 * 128;
    constexpr int NITEMS = I_A + I_B + I_C + I_D + I_E + I_F + I_G + I_H;
    for (int it = (PART == 0 ? gw : I_A + gw); it < (PART == 0 ? I_A : NITEMS); it += NGW) {
        int r = it;
        if (r < I_A) { const float* W = F.in[I_WIN]; const int kb = r / 32, nb = r % 32;
            transpose_item([&](int k, int n) -> float { if (n >= 928) return 0.f; const int src = n < 896 ? n : 896 + rope_perm_src(n - 896); return W[(size_t)k * 928 + src]; }, (bf16_t*)(F.ws + WS_WIN), 1024, kb * 64, nb * 32, scr, lane); continue; } r -= I_A;
        if (r < I_B) { const float* W = F.in[I_WGLU]; const int kb = r / 16, nb = r % 16;
            transpose_item([&](int k, int n) -> float { return W[(size_t)k * 512 + n]; }, (bf16_t*)(F.ws + WS_WGLU), 512, kb * 64, nb * 32, scr, lane); continue; } r -= I_B;
        if (r < I_C) { const float* W = F.in[I_WUQ]; const float* gq = F.in[I_QG]; const int kb = r / 24, nb = r % 24;
            transpose_item([&](int k, int n) -> float { const int hh = n / 96, jj = n % 96; const int src = jj < 64 ? n : hh * 96 + 64 + rope_perm_src(jj - 64); return W[(size_t)k * 768 + src] * gq[k]; }, (bf16_t*)(F.ws + WS_WUQ), 256, kb * 64, nb * 32, scr, lane); continue; } r -= I_C;
        if (r < I_D) { const float* W = F.in[I_WUKV]; const float* gk = F.in[I_KVG]; const int kb = r / 32, nb = r % 32;
            transpose_item([&](int k, int n) -> float { return k < 128 ? W[(size_t)k * 1024 + n] * gk[k] : 0.f; }, (bf16_t*)(F.ws + WS_WUKV), 256, kb * 64, nb * 32, scr, lane); continue; } r -= I_D;
        if (r < I_E) { const float* W = F.in[I_WR]; const int kb = r / 8, nb = r % 8;
            transpose_item([&](int k, int n) -> float { return n < 64 ? W[(size_t)k * 64 + n] : 0.f; }, (bf16_t*)(F.ws + WS_WR), 1024, kb * 64, nb * 32, scr, lane); continue; } r -= I_E;
        if (r < I_F) { const float* W = F.in[I_WO]; const int kb = r / 32, nb = r % 32;
            transpose_item([&](int k, int n) -> float { return W[(size_t)k * 1024 + n]; }, (bf16_t*)(F.ws + WS_WO), 1024, kb * 64, nb * 32, scr, lane); continue; } r -= I_F;
        const int it2 = it + NGW; const bool has2 = it2 < NITEMS; float tv0[32], tv1[32];
        auto geom = [&](int rr_, const float*& W0, const float*& W1, bf16_t*& dst, int& ldk, int& k0, int& n0, bool& gu) {
            if (rr_ < I_G) { const int e = rr_ / 256, q = rr_ % 256; gu = true; k0 = (q / 16) * 64; n0 = (q % 16) * 32; ldk = 1024;
                W0 = e < 64 ? F.in[I_WEG] + (size_t)e * 1024 * 256 : F.in[I_WSG]; W1 = e < 64 ? F.in[I_WEU] + (size_t)e * 1024 * 256 : F.in[I_WSU]; dst = (bf16_t*)(F.ws + WS_WGU) + (size_t)e * 512 * 1024; }
            else { const int q_ = rr_ - I_G, e = q_ / 128, q = q_ % 128; gu = false; k0 = (q / 32) * 64; n0 = (q % 32) * 32; ldk = 256;
                W0 = e < 64 ? F.in[I_WED] + (size_t)e * 256 * 1024 : F.in[I_WSD]; W1 = W0; dst = (bf16_t*)(F.ws + WS_WD) + (size_t)e * 1024 * 256; } };
        auto val = [&](bool gu, const float* W0, const float* W1, int k, int n) -> float { if (gu) { const int r_ = n & 255, col = 128 * (n >> 8) + 32 * (r_ >> 6) + (r_ & 31); return ((r_ >> 5) & 1) ? W1[(size_t)k * 256 + col] : W0[(size_t)k * 256 + col]; } return W0[(size_t)k * 1024 + n]; };
        const float *Wa0, *Wa1, *Wb0, *Wb1; bf16_t *da, *db; int lka, ka, na, lkb, kb_, nb_; bool gua, gub;
        geom(r, Wa0, Wa1, da, lka, ka, na, gua);
        transpose_load([&](int k, int n) -> float { return val(gua, Wa0, Wa1, k, n); }, ka, na, lane, tv0);
        if (has2) { geom(it2 - (I_A + I_B + I_C + I_D + I_E + I_F), Wb0, Wb1, db, lkb, kb_, nb_, gub); transpose_load([&](int k, int n) -> float { return val(gub, Wb0, Wb1, k, n); }, kb_, nb_, lane, tv1); }
        transpose_store(tv0, da, lka, ka, na, scr, lane);
        if (has2) transpose_store(tv1, db, lkb, kb_, nb_, scr, lane);
        it += NGW;
    }
    if (PART == 0) {
      const float* x = F.in[I_X]; bf16_t* xb = (bf16_t*)(F.ws + WS_XB); const size_t N8 = (size_t)T * DM / 8, st = (size_t)F.G * 512;
      for (size_t i = (size_t)F.bid * 512 + F.tid; i < N8; i += 4 * st) {
          f32x4 a[4], b[4];
#pragma unroll
          for (int u = 0; u < 4; ++u) { const size_t ii = i + u * st < N8 ? i + u * st : i; a[u] = __builtin_nontemporal_load((const f32x4*)(x + ii * 8)); b[u] = __builtin_nontemporal_load((const f32x4*)(x + ii * 8 + 4)); }
#pragma unroll
          for (int u = 0; u < 4; ++u) if (i + u * st < N8) *(u32x4*)(xb + (i + u * st) * 8) = pack8(a[u], b[u]); } }
    if (PART == 1) { asm volatile("s_waitcnt vmcnt(0) lgkmcnt(0)" ::: "memory"); __syncthreads(); }
}

__device__ __forceinline__ void scan_unit(Frame& F, int g, int pm) {
    const bf16_t* S = (const bf16_t*)(F.ws + WS_S); bf16_t* UH = (bf16_t*)(F.ws + WS_UH);
    {
        const int n = F.tid & 63, d = (F.tid >> 6) & 1, b = pm * 4 + (F.tid >> 7);
        const SsmPar p = ssm_par(F.in[I_LRE], F.in[I_LIM], F.in[I_LDT], d, g, n); float acr, aci; ssm_pow(p, (float)CHK, acr, aci);
        float hr = 0.f, hi = 0.f;
        const size_t rbase = (size_t)g * UHR + (size_t)b * NCHK;
#pragma unroll
        for (int hb = 0; hb < 2; ++hb) {
            float sr[32], si[32];
#pragma unroll
            for (int st = 0; st < 32; ++st) { const int ci = d ? (NCHK - 1 - (hb * 32 + st)) : (hb * 32 + st);
                sr[st] = __uint_as_float((unsigned)S[(rbase + ci) * 256 + d * 128 + n] << 16); si[st] = __uint_as_float((unsigned)S[(rbase + ci) * 256 + d * 128 + 64 + n] << 16); }
#pragma unroll
            for (int st = 0; st < 32; ++st) { const int ci = d ? (NCHK - 1 - (hb * 32 + st)) : (hb * 32 + st);
                bf16_t* hp = UH + (rbase + ci) * UHK + 512 + d * 128 + n;
                hp[0] = (bf16_t)(cvt_pk_bf16(hr, 0.f) & 0xffffu); hp[64] = (bf16_t)(cvt_pk_bf16(hi, 0.f) & 0xffffu);
                const float nr = acr * hr - aci * hi + sr[st], ni = acr * hi + aci * hr + si[st]; hr = nr; hi = ni; }
        }
    }
}
__device__ __forceinline__ void mo_fill(Frame& F) {
    const float* Kt = (const float*)(F.ws + WS_KT); bf16_t* Mo = (bf16_t*)(F.ws + WS_MO);
    for (int pc = F.bid * 512 + F.tid; pc < 32 * 512 * 64; pc += F.G * 512) {
        const int k0 = (pc & 63) * 8, row = (pc >> 6) & 511, g = pc >> 15, s = k0 >> 4, q0 = k0 & 15, tq = row >> 4, pp = row & 15;
        f32x4 v0 = {0.f, 0.f, 0.f, 0.f}, v1 = {0.f, 0.f, 0.f, 0.f};
        if (tq >= s) { const float* kp = Kt + ((size_t)(g * 2 + 0) * 32 + (tq - s)) * 256 + pp * 16 + q0; v0 += *(const f32x4*)kp; v1 += *(const f32x4*)(kp + 4); }
        if (s >= tq) { const float* kp = Kt + ((size_t)(g * 2 + 1) * 32 + (s - tq)) * 256 + pp * 16 + q0; v0 += *(const f32x4*)kp; v1 += *(const f32x4*)(kp + 4); }
        if (s == tq && (pp >> 3) == (q0 >> 3)) { const float dsk = F.in[I_DSK][g * 16 + pp];
#pragma unroll
            for (int j = 0; j < 4; ++j) { if (q0 + j == pp) v0[j] += dsk; if (q0 + 4 + j == pp) v1[j] += dsk; } }
        *(u32x4*)(Mo + ((size_t)g * 512 + row) * UHK + k0) = pack8(v0, v1);
    }
}

__device__ __forceinline__ void p7_ln1(Frame& F) {
    const int lane = fresh_lane();
    const float* g1 = F.in[I_LN1G]; const float* b1 = F.in[I_LN1B]; bf16_t* x1b = (bf16_t*)(F.ws + WS_X1B);
    f32x4 gg[4], bb[4];
#pragma unroll
    for (int j = 0; j < 4; ++j) { const int c = 8 * lane + (j >> 1) * 512 + (j & 1) * 4; gg[j] = *(const f32x4*)(g1 + c); bb[j] = *(const f32x4*)(b1 + c); }
    for (int pm = F.bid; pm < T / 256; pm += F.G)
    for (int row0 = pm * 256 + F.wave; row0 < pm * 256 + 256; row0 += 32) {
        u32x4 w0[4], w1[4];
#pragma unroll
        for (int j = 0; j < 4; ++j) { const bf16_t* rp = x1b + (size_t)(row0 + 8 * j) * 1024 + 8 * lane; w0[j] = *(const u32x4*)rp; w1[j] = *(const u32x4*)(rp + 512); }
#pragma unroll
        for (int j = 0; j < 4; ++j) {
            bf16_t* rp = x1b + (size_t)(row0 + 8 * j) * 1024 + 8 * lane; f32x4 v[4]; unpack8(w0[j], v[0], v[1]); unpack8(w1[j], v[2], v[3]);
            float s = 0.f;
#pragma unroll
            for (int q = 0; q < 4; ++q) s += (v[q][0] + v[q][1]) + (v[q][2] + v[q][3]);
            const float mean = wave_sum(s) * (1.f / 1024.f); float qq = 0.f;
#pragma unroll
            for (int q = 0; q < 4; ++q) { v[q] = v[q] - mean; qq += (v[q][0] * v[q][0] + v[q][1] * v[q][1]) + (v[q][2] * v[q][2] + v[q][3] * v[q][3]); }
            const float rstd = __builtin_amdgcn_rsqf(wave_sum(qq) * (1.f / 1024.f) + LN_EPS);
#pragma unroll
            for (int q = 0; q < 4; ++q) v[q] = v[q] * rstd * gg[q] + bb[q];
            *(u32x4*)rp = pack8(v[0], v[1]); *(u32x4*)(rp + 512) = pack8(v[2], v[3]);
        }
    }
}

__device__ __forceinline__ void route_batch(Frame& F, int bt) {
    LAS int* hist = (LAS int*)(F.lds); LAS int* base = hist + 64;
    const float* LG = (const float*)(F.ws + WS_LOGIT); int* rowtok = (int*)(F.ws + WS_ROWTOK); int* tslot = (int*)(F.ws + WS_TSLOT); float* topw = (float*)(F.ws + WS_TOPW);
    {
        __syncthreads();
        if (F.tid < 64) hist[F.tid] = 0;
        __syncthreads();
        const int tok = bt * 256 + F.tid, ch = (bt * 256) / CAPC;
        int idx[6], lr[6]; float w[6];
        if (F.tid < 256) {
            float lg[64];
#pragma unroll
            for (int j = 0; j < 16; ++j) { const f32x4 v = *(const f32x4*)(LG + (size_t)tok * 64 + 4 * j); lg[4 * j] = v[0]; lg[4 * j + 1] = v[1]; lg[4 * j + 2] = v[2]; lg[4 * j + 3] = v[3]; }
            route_token(lg, F.in[I_RB], idx, w);
#pragma unroll
            for (int k = 0; k < 6; ++k) lr[k] = atomicAdd((int*)&hist[idx[k]], 1);
        }
        __syncthreads();
        if (F.tid < 64) base[F.tid] = (int)__hip_atomic_fetch_add(F.ctl + CW_CNT + 64 * (ch * 65 + F.tid), (unsigned)hist[F.tid], __ATOMIC_RELAXED, __HIP_MEMORY_SCOPE_AGENT);
        __syncthreads();
        if (F.tid < 256) {
#pragma unroll
            for (int k = 0; k < 6; ++k) { const int slot = base[idx[k]] + lr[k];
                rowtok[(size_t)(ch * 64 + idx[k]) * CAPC + slot] = tok; tslot[(size_t)tok * 8 + k] = (idx[k] << 16) | slot; topw[(size_t)tok * 8 + k] = w[k]; }
        }
    }
}

__device__ __forceinline__ void p12_combine(Frame& F, int ch) {
    const int lane = fresh_lane();
    const MoeTab tb = moe_tab(F.lds); const int t0 = tb.tbase[ch * 65];
    const unsigned char* Y8 = F.ws + WS_Y; const bf16_t* YS = (const bf16_t*)(F.ws + WS_YS); const bf16_t* x1b = (const bf16_t*)(F.ws + WS_X1B);
    const int* tslot = (const int*)(F.ws + WS_TSLOT); const float* topw = (const float*)(F.ws + WS_TOPW);
    const float* g2 = F.in[I_LN2G]; const float* b2 = F.in[I_LN2B];
    f32x4 gg[4], bb[4];
#pragma unroll
    for (int j = 0; j < 4; ++j) { const int c = 8 * lane + (j >> 1) * 512 + (j & 1) * 4; gg[j] = *(const f32x4*)(g2 + c); bb[j] = *(const f32x4*)(b2 + c); }
    constexpr int NTK = 4;
    const int stride = F.G * 8;
    for (int tk0 = F.bid * 8 + F.wave; tk0 < CAPC; tk0 += NTK * stride) {
        int ts[NTK][6]; float tw[NTK][6];
#pragma unroll
        for (int t = 0; t < NTK; ++t) { const int tk = tk0 + t * stride < CAPC ? tk0 + t * stride : tk0; const size_t tok = (size_t)ch * CAPC + tk;
#pragma unroll
            for (int k = 0; k < 6; ++k) { ts[t][k] = tslot[tok * 8 + k]; tw[t][k] = topw[tok * 8 + k]; } }
        u32x4 xw[NTK][2], sw[NTK][2]; u32x2 yw[NTK][6][2];
#pragma unroll
        for (int t = 0; t < NTK; ++t) { const int tk = tk0 + t * stride < CAPC ? tk0 + t * stride : tk0; const size_t tok = (size_t)ch * CAPC + tk;
            const bf16_t* xr = x1b + tok * 1024 + 8 * lane; xw[t][0] = *(const u32x4*)xr; xw[t][1] = *(const u32x4*)(xr + 512);
            const bf16_t* yr = YS + (size_t)tk * 1024 + 8 * lane; sw[t][0] = *(const u32x4*)yr; sw[t][1] = *(const u32x4*)(yr + 512);
#pragma unroll
            for (int k = 0; k < 6; ++k) { const int yrow = (tb.tbase[ch * 65 + (ts[t][k] >> 16)] - t0) * 256 + (ts[t][k] & 0xffff);
                const unsigned char* y8 = Y8 + y8_off(yrow, 8 * lane); yw[t][k][0] = *(const u32x2*)y8; yw[t][k][1] = *(const u32x2*)(y8 + 512); } }
#pragma unroll
        for (int t = 0; t < NTK; ++t) {
            const int tk = tk0 + t * stride; if (tk >= CAPC) break;
            const size_t tok = (size_t)ch * CAPC + tk;
            f32x4 a[4]; unpack8(xw[t][0], a[0], a[1]); unpack8(xw[t][1], a[2], a[3]); a[0] *= ALPHA; a[1] *= ALPHA; a[2] *= ALPHA; a[3] *= ALPHA;
            { f32x4 y0, y1, y2, y3; unpack8(sw[t][0], y0, y1); unpack8(sw[t][1], y2, y3); a[0] += y0; a[1] += y1; a[2] += y2; a[3] += y3; }
#pragma unroll
            for (int k = 0; k < 6; ++k) { const float w = tw[t][k] * Y8_INV; f32x4 y0, y1, y2, y3; unpack8_fp8(yw[t][k][0], y0, y1); unpack8_fp8(yw[t][k][1], y2, y3);
                a[0] += y0 * w; a[1] += y1 * w; a[2] += y2 * w; a[3] += y3 * w; }
            float s = 0.f;
#pragma unroll
            for (int j = 0; j < 4; ++j) s += (a[j][0] + a[j][1]) + (a[j][2] + a[j][3]);
            const float mean = wave_sum(s) * (1.f / 1024.f); float q = 0.f;
#pragma unroll
            for (int j = 0; j < 4; ++j) { a[j] = a[j] - mean; q += (a[j][0] * a[j][0] + a[j][1] * a[j][1]) + (a[j][2] * a[j][2] + a[j][3] * a[j][3]); }
            const float rstd = __builtin_amdgcn_rsqf(wave_sum(q) * (1.f / 1024.f) + LN_EPS);
            float* orow = F.out + tok * 1024 + 8 * lane;
#pragma unroll
            for (int j = 0; j < 4; ++j) *(f32x4*)(orow + (j >> 1) * 512 + (j & 1) * 4) = a[j] * rstd * gg[j] + bb[j];
        }
    }
}
}

namespace fx {
constexpr int NPHASE = 11 + 2 * NCH;
struct Args { const float* in[29]; float* out; unsigned char* ws; int ph_lo, ph_hi; };

__global__ void __launch_bounds__(512, 2) fwd(Args args) {
    extern __shared__ __attribute__((aligned(16))) unsigned char lds_raw[];
    Frame F;
    F.lds = (LAS unsigned char*)lds_raw; F.ws = args.ws; F.ctl = (unsigned*)(args.ws + WS_CTL); F.out = args.out;
#pragma unroll
    for (int i = 0; i < 29; ++i) F.in[i] = args.in[i];
    F.tid = threadIdx.x; F.lane = 0; F.wave = __builtin_amdgcn_readfirstlane(F.tid >> 6); F.G = gridDim.x; F.bid = blockIdx.x;
    volatile LAS unsigned* MISC = (volatile LAS unsigned*)(F.lds + MISC_OFF);
    if (F.tid < 32) MISC[F.tid] = 0u;
    __syncthreads();
    const int lo = args.ph_lo, hi = args.ph_hi;
    XcdBarrier bar; bar.bar = F.ctl + CW_BAR; bar.x = 0; bar.st = MISC + 8;
    if (hi - lo > 1) bar = xcd_barrier_post(F.ctl + CW_BAR, MISC + 8);
#ifndef PH_MASK
#define PH_MASK 0xFFFFFFFFu
#endif
#define IN(k) (((PH_MASK >> ((k) > 11 ? 11 + (((k) - 11) & 1) : (k))) & 1u) && lo <= (k) && (k) < hi)
#define SEAM(k) do { if (IN(k) && IN((k) + 1)) xcd_barrier(bar); if (MK_TPROBE >= 300 && blockIdx.x == 0 && threadIdx.x == 0) { const unsigned long long cn_ = __builtin_amdgcn_s_memtime(); \
        const unsigned long long cl_ = ((unsigned long long)MISC[25] << 32) | MISC[24]; if ((k) + 300 == MK_TPROBE) { const unsigned long long dc_ = cn_ - cl_; MISC[26] = (unsigned)dc_; MISC[27] = (unsigned)(dc_ >> 32); } MISC[24] = (unsigned)cn_; MISC[25] = (unsigned)(cn_ >> 32); } \
     if (MK_TPROBE >= 0 && blockIdx.x == 0 && threadIdx.x == 0) { const unsigned long long tn_ = __builtin_amdgcn_s_memrealtime(); \
        const unsigned long long tl_ = ((unsigned long long)MISC[17] << 32) | MISC[16]; if (((k) == MK_TPROBE && MK_TPROBE < 100) || (k) + 300 == MK_TPROBE) { const unsigned long long d_ = tn_ - tl_; MISC[18] = (unsigned)d_; MISC[19] = (unsigned)(d_ >> 32); } if (MK_TPROBE == 200 + (k)) { MISC[18] = MISC[22]; MISC[19] = MISC[23]; } MISC[22] = 0u; MISC[23] = 0u; MISC[16] = (unsigned)tn_; MISC[17] = (unsigned)(tn_ >> 32); } } while (0)
    unsigned char* ws = args.ws;
    bf16_t* UH = (bf16_t*)(ws + WS_UH); bf16_t* CQ = (bf16_t*)(ws + WS_CQ); bf16_t* CKVR = (bf16_t*)(ws + WS_CKVR); bf16_t* Qb = (bf16_t*)(ws + WS_Q); bf16_t* KVb = (bf16_t*)(ws + WS_KV);
    bf16_t* SPRE = (bf16_t*)(ws + WS_SPRE); bf16_t* MIX = (bf16_t*)(ws + WS_MIX);
    float* ssqq = (float*)(ws + WS_SSQQ); float* ssqkv = (float*)(ws + WS_SSQKV); const float* ropec = (const float*)(ws + WS_ROPE); const float* ropes = ropec + 2048 * 16;

    if (MK_TPROBE >= 0 && blockIdx.x == 0 && threadIdx.x == 0) { const unsigned long long tn_ = __builtin_amdgcn_s_memrealtime(); MISC[16] = (unsigned)tn_; MISC[17] = (unsigned)(tn_ >> 32); }
    if (MK_TPROBE == 500 && threadIdx.x == 0) __hip_atomic_store(F.ctl + CW_DBG + 64 + blockIdx.x, 1u + xb_xcc_id(), __ATOMIC_RELAXED, __HIP_MEMORY_SCOPE_AGENT);
    if (IN(0)) { p0_prologue<0>(F); } SEAM(0);
    if (IN(1)) {
        const bool conv_first = ((F.bid >> 3) & 1) != 0;
        if (conv_first) p0_prologue<1>(F);
        { PlainOrder S; S.init(ws + WS_XB, 1024, ws + WS_WIN, 1024, T, 1024, F.G, F.bid);
          EpiWin E{UH, CQ, CKVR, ssqq, ssqkv, ropec, ropes};
          gemm_phase<EpiWin, PlainOrder, true, false>(F.lds, 1024, 1024, 1024, S, E); }
        if (!conv_first) p0_prologue<1>(F);
    } SEAM(1);
    if (IN(2)) {
        { GroupOrder S; S.init(UH, ws + WS_WST, 512, 1, F.G, F.bid); EpiSt E{(bf16_t*)(ws + WS_S)};
          gemm_phase<EpiSt, GroupOrder, true, false>(F.lds, UHK, 512, 512, S, E);
          asm volatile("s_waitcnt vmcnt(0)" ::: "memory"); __syncthreads();
          Unit u; for (int i = 0; S.next(i, u); ++i) scan_unit(F, u.i0, u.i1); }
        mo_fill(F);
        { PlainOrder S; S.init(CQ, 256, ws + WS_WUQ, 256, T, 768, F.G, F.bid); EpiQ E{Qb, ssqq, ropec, ropes};
          gemm_phase<EpiQ, PlainOrder, true, false>(F.lds, 256, 256, 256, S, E); }
        { PlainOrder S; S.init(CKVR, 256, ws + WS_WUKV, 256, T, 1024, F.G, F.bid); EpiKV E{KVb, ssqkv};
          gemm_phase<EpiKV, PlainOrder, true, false>(F.lds, 256, 256, 128, S, E); }
    } SEAM(2);
    if (IN(4)) {
#ifndef SUB4
#define SUB4 3
#endif
        if (SUB4 & 2) REP(40) for (int i = 0;; ++i) { const long L = (long)i * F.G + F.bid; if (L >= 2048) break;
            const int un = xcd_remap((int)L, 2048), pair = un >> 3, qb = un & 7, b = pair >> 3, h = pair & 7;
            att::attn_unit(ws, Qb, MIX, b * SEQ, qb * 256, h, (char*)lds_raw); }
        if (SUB4 & 1) DUP2(4, { GroupOrder S; S.init(UH, ws + WS_MO, UHK, 2, F.G, F.bid); EpiSsmOut E{SPRE};
          gemm_phase<EpiSsmOut, GroupOrder, true, false>(F.lds, UHK, UHK, UHK, S, E); });
    } SEAM(4);
    if (IN(5)) {
        { PanelOrder S; S.init(SPRE, SPRE_LD, ws + WS_WGLU, 512, T, 512, F.G, F.bid); EpiGlu E{SPRE, MIX, F.in[I_BGLU]};
          gemm_phase<EpiGlu, PanelOrder, true, false>(F.lds, SPRE_LD, 512, 512, S, E); }
        asm volatile("s_waitcnt vmcnt(0)" ::: "memory"); __syncthreads();
        { PanelOrder S; S.init(MIX, 1024, ws + WS_WO, 1024, T, 1024, F.G, F.bid); EpiWo E{(bf16_t*)(ws + WS_X1B)};
          gemm_phase<EpiWo, PanelOrder, true, false>(F.lds, 1024, 1024, 1024, S, E); }
        asm volatile("s_waitcnt vmcnt(0)" ::: "memory"); __syncthreads();
        p7_ln1(F);
        asm volatile("s_waitcnt vmcnt(0)" ::: "memory"); __syncthreads();
        { PanelOrder S; S.init(ws + WS_X1B, 1024, ws + WS_WGU + (size_t)64 * 512 * 1024 * 2, 1024, T, 768, F.G, F.bid); EpiSharedRouter E{(bf16_t*)(ws + WS_HS), (float*)(ws + WS_LOGIT)};
          gemm_phase<EpiSharedRouter, PanelOrder, true, false>(F.lds, 1024, 1024, 1024, S, E);
          asm volatile("s_waitcnt vmcnt(0)" ::: "memory"); __syncthreads();
          Unit u; for (int i = 0; S.next(i, u); ++i) if (u.i1 == 2) route_batch(F, u.i0); }
    } SEAM(8);
    if (IN(10)) {
        moe_build_tab(F.lds, F.ctl);
        GateUpOrder S; S.init(F.lds, ws + WS_X1B, ws + WS_WGU, (const int*)(ws + WS_ROWTOK), F.ctl, 0, F.G, F.bid); EpiGateUp E{(bf16_t*)(ws + WS_H)};
        gemm_phase<EpiGateUp, GateUpOrder, true, true>(F.lds, 1024, 1024, 1024, S, E);
    } SEAM(10);
#pragma unroll
    for (int ch = 0; ch < NCH; ++ch) {
        if (IN(11 + 2 * ch)) {
            moe_build_tab(F.lds, F.ctl);
            if (ch + 1 < NCH) { GateUpOrder S; S.init(F.lds, ws + WS_X1B, ws + WS_WGU, (const int*)(ws + WS_ROWTOK), F.ctl, ch + 1, F.G, F.bid); EpiGateUp E{(bf16_t*)(ws + WS_H)};
              gemm_phase<EpiGateUp, GateUpOrder, true, true>(F.lds, 1024, 1024, 1024, S, E); }
            { DownOrder S; S.init(ws + WS_H, ws + WS_HS, ws + WS_WD, moe_tab(F.lds), ch, F.G, F.bid); EpiDown E{ws + WS_Y, (bf16_t*)(ws + WS_YS), F.lds};
              gemm_phase<EpiDown, DownOrder, true, false, 0, 1>(F.lds, 256, 256, 256, S, E); }
        } SEAM(11 + 2 * ch);
        if (IN(12 + 2 * ch)) { moe_build_tab(F.lds, F.ctl); p12_combine(F, ch); } SEAM(12 + 2 * ch);
    }
    if (MK_TPROBE == 500 && blockIdx.x == 0 && threadIdx.x == 0) { unsigned bad = 0; for (unsigned b = 8; b < gridDim.x; ++b) bad += __hip_atomic_load(F.ctl + CW_DBG + 64 + b, __ATOMIC_RELAXED, __HIP_MEMORY_SCOPE_AGENT) != __hip_atomic_load(F.ctl + CW_DBG + 64 + (b & 7u), __ATOMIC_RELAXED, __HIP_MEMORY_SCOPE_AGENT);
        const unsigned long long t0_ = __builtin_amdgcn_s_memrealtime(); if (bad) while (__builtin_amdgcn_s_memrealtime() - t0_ < 100000ull) __builtin_amdgcn_s_sleep(8); }
    if (MK_TPROBE >= 0 && MK_TPROBE != 500 && blockIdx.x == 0 && threadIdx.x == 0) { const unsigned long long d_ = ((unsigned long long)MISC[19] << 32) | MISC[18]; const unsigned long long t0_ = __builtin_amdgcn_s_memrealtime();
        unsigned long long wait_ = 8ull * d_; if (MK_TPROBE >= 300) { const unsigned long long dc_ = ((unsigned long long)MISC[27] << 32) | MISC[26]; wait_ = d_ ? (dc_ * 100ull / d_) * 100ull : 0ull; }
        while (__builtin_amdgcn_s_memrealtime() - t0_ < wait_) __builtin_amdgcn_s_sleep(8); }
#undef IN
#undef SEAM
}

#if MK_DEBUG
__global__ void dbg_cmp(int k, const unsigned char* ws, const float* out_fast, gold::Bufs B, const float* gx1, const float* gout, float* acc) {
    const int t = blockIdx.x;
    float num = 0.f, den = 0.f;
    auto bf = [](const bf16_t* p, size_t i) -> float { return __uint_as_float(((unsigned)p[i]) << 16); };
    int ncol = 0;
    switch (k) { case 0: ncol = 512; break; case 1: ncol = 256; break; case 2: ncol = 160; break; case 3: ncol = 768; break; case 4: ncol = 1024; break; case 5: ncol = 512; break; case 6: ncol = 512; break; case 7: ncol = 512; break; case 8: ncol = 1024; break; default: ncol = 1024; }
    for (int c = threadIdx.x; c < ncol; c += blockDim.x) {
        float f = 0.f, g = 0.f;
        if (k == 0) { const int gg = c >> 4, p = c & 15; f = bf((const bf16_t*)(ws + WS_UH), ((size_t)gg * UHR + (t >> 5)) * UHK + (t & 31) * 16 + p); g = B.proj[(size_t)t * 928 + c]; }
        else if (k == 1) { f = bf((const bf16_t*)(ws + WS_CQ), (size_t)t * 256 + c); g = B.proj[(size_t)t * 928 + 512 + c]; }
        else if (k == 2) { f = bf((const bf16_t*)(ws + WS_CKVR), (size_t)t * 256 + c); g = c < 128 ? B.proj[(size_t)t * 928 + 768 + c] : B.krope[(size_t)t * 32 + rope_perm_src(c - 128)]; }
        else if (k == 3) { const int hh = c / 96, jj = c % 96, src = jj < 64 ? c : hh * 96 + 64 + rope_perm_src(jj - 64); f = bf((const bf16_t*)(ws + WS_Q), (size_t)t * 768 + c); g = B.q[(size_t)t * 768 + src] * QSCALE; }
        else if (k == 4) { f = bf((const bf16_t*)(ws + WS_KV), (size_t)t * 1024 + c); g = B.kv[(size_t)t * 1024 + c]; }
        else if (k == 5) { f = bf((const bf16_t*)(ws + WS_SPRE), (size_t)t * SPRE_LD + c); g = B.spre[(size_t)t * 512 + c]; }
        else if (k == 6) { f = bf((const bf16_t*)(ws + WS_MIX), (size_t)t * 1024 + c); g = B.mix[(size_t)t * 1024 + c]; }
        else if (k == 7) { f = bf((const bf16_t*)(ws + WS_MIX), (size_t)t * 1024 + 512 + c); g = B.mix[(size_t)t * 1024 + 512 + c]; }
        else if (k == 8) { f = bf((const bf16_t*)(ws + WS_X1B), (size_t)t * 1024 + c); g = gx1[(size_t)t * 1024 + c]; }
        else { f = out_fast[(size_t)t * 1024 + c]; g = gout[(size_t)t * 1024 + c]; }
        const float d = f - g; num += d * d; den += g * g;
        if (!(fabsf(f) < 1e30f)) num += 1e30f;
    }
    num = wave_sum(num); den = wave_sum(den);
    if ((threadIdx.x & 63) == 0) { atomicAdd(acc + 2 * k, num); atomicAdd(acc + 2 * k + 1, den); }
}
__global__ void dbg_encode(const float* acc, float* out, int k0, int nk) {
    float c2 = 0.f;
    for (int k = k0; k < k0 + nk; ++k) { const float e = sqrtf(acc[2 * k] / fmaxf(acc[2 * k + 1], 1e-30f)); const float tol = (k == 9) ? 0.08f : 0.04f;
        if (!(e <= tol)) { const int bucket = !(e <= 0.5f) ? 0 : (e > 0.1f ? 1 : 2); c2 = (float)(k - k0 + 1) + 20.f * bucket; break; } }
    if (c2 == 0.f) { if (MK_DBG_NPH >= NPHASE) return; c2 = 90.f; }
    const float c = sqrtf(c2);
    for (size_t i = (size_t)blockIdx.x * blockDim.x + threadIdx.x; i < (size_t)T * 1024; i += (size_t)gridDim.x * blockDim.x) out[i] = c;
}
#endif
}

extern "C" void kernel_launch(void* const* d_in, const int* in_sizes, int n_in, void* d_out, int out_size, void* d_ws, size_t ws_size, hipStream_t stream) {
#if MK_MODE == 0
    gold::In I; const float** p = (const float**)&I;
    for (int i = 0; i < 29; ++i) p[i] = (const float*)d_in[i];
    for (int t0 = 0; t0 < 65536; t0 += 16384) gold::run(I, t0, 16384, (float*)d_ws, (float*)d_out + (size_t)t0 * 1024, (float*)d_out + (size_t)t0 * 1024, stream);
#else
    using namespace fx;
    static int grid = 0;
    if (grid == 0) {
        if (n_in != 29 || ws_size < WS_END) { fprintf(stderr, "kernel_launch: need 29 inputs and >= %zu bytes of workspace (got %d, %zu)\n", (size_t)WS_END, n_in, ws_size); grid = -1; return; }
        int dev = 0, cus = 0, per_cu = 0;
        hipGetDevice(&dev); hipDeviceGetAttribute(&cus, hipDeviceAttributeMultiprocessorCount, dev);
        if (hipFuncSetAttribute((const void*)fwd, hipFuncAttributeMaxDynamicSharedMemorySize, LDS_BYTES) != hipSuccess) { fprintf(stderr, "kernel_launch: hipFuncSetAttribute failed\n"); grid = -1; return; }
        if (hipOccupancyMaxActiveBlocksPerMultiprocessor(&per_cu, (const void*)fwd, 512, LDS_BYTES) != hipSuccess || per_cu < 1) { fprintf(stderr, "kernel_launch: occupancy query says %d\n", per_cu); }
        (void)hipGetLastError();
        grid = cus > 0 ? cus : 256;
    }
    if (grid < 0) return;
    hipMemsetAsync((char*)d_ws + WS_CTL, 0, CTL_BYTES, stream);
    Args a{};
    for (int i = 0; i < 29; ++i) a.in[i] = (const float*)d_in[i];
    a.out = (float*)d_out; a.ws = (unsigned char*)d_ws;
#if MK_MODE == 1
    for (int ph = 0; ph < NPHASE && ph < MK_DBG_NPH; ++ph) { a.ph_lo = ph; a.ph_hi = ph + 1; hipLaunchKernelGGL(fwd, dim3(grid), dim3(512), LDS_BYTES, stream, a); }
#else
    a.ph_lo = 0; a.ph_hi = NPHASE; hipLaunchKernelGGL(fwd, dim3(grid), dim3(512), LDS_BYTES, stream, a);
#endif
#if MK_DEBUG
    {
        gold::In I; const float** p = (const float**)&I;
        for (int i = 0; i < 29; ++i) p[i] = (const float*)d_in[i];
        float* gs = (float*)((char*)d_ws + WS_GOLD); float* gx1 = gs + (size_t)2048 * gold::GOLD_FLOATS_PER_TOK; float* gout = gx1 + (size_t)2048 * 1024;
        gold::Bufs B = gold::run(I, 0, 2048, gs, gx1, gout, stream);
        float* acc = (float*)((char*)d_ws + WS_CTL) + CW_DBG;
        for (int k = 0; k < 10; ++k) hipLaunchKernelGGL(dbg_cmp, dim3(2048), dim3(256), 0, stream, k, (const unsigned char*)d_ws, (const float*)d_out, B, (const float*)gx1, (const float*)gout, acc);
        hipLaunchKernelGGL(dbg_encode, dim3(1024), dim3(256), 0, stream, (const float*)acc, (float*)d_out, MK_DBG_K0, MK_DBG_NK);
    }
#endif
    const hipError_t le = hipPeekAtLastError();
    if (le != hipSuccess) fprintf(stderr, "kernel_launch: launch failed: %s\n", hipGetErrorName(le));
#endif
}
```

```cpp
#define MK_MODE 2
#include <hip/hip_runtime.h>
#include <cstdio>
#include <cstdint>
#include <cmath>
#ifndef MK_MODE
#define MK_MODE 1
#endif
#ifndef MK_DBG_NPH
#define MK_DBG_NPH 99
#endif
#ifndef MK_DBG_K0
#define MK_DBG_K0 0
#endif
#ifndef MK_DBG_NK
#define MK_DBG_NK 10
#endif
#ifndef MK_DUP
#define MK_DUP -1
#endif
#define REP(k) for (int rep_ = 0; rep_ < ((MK_DUP == (k)) ? 2 : 1); ++rep_)
#define DUP2(k, ...) do { __VA_ARGS__ if constexpr (MK_DUP == (k)) { __VA_ARGS__ } } while (0)
#ifndef MK_TPROBE
#define MK_TPROBE -1
#endif
#ifndef MK_STAG
#define MK_STAG 0
#endif
#ifndef MK_DEBUG
#define MK_DEBUG 0
#endif
namespace gold {
constexpr int D_MODEL = 1024, SEQ = 2048, D_SSM = 512, D_IN = 928, NH = 8, QLR = 256, KVLR = 128, ROPE = 32;
constexpr int NEXP = 64, TOPK = 6, DEXP = 256;
constexpr float ALPHA = 1.189207115002721f, LN_EPS = 1e-5f, RMS_EPS = 1e-6f, ATT_SCALE = 0.10206207261596577f;

__global__ void __launch_bounds__(256) sgemm(const float* __restrict__ A, int lda, const float* __restrict__ B, int ldb, float* __restrict__ C, int ldc, int M, int N, int K) {
    __shared__ float As[16][65];
    __shared__ float Bs[16][65];
    const int tid = threadIdx.x, tx = tid & 15, ty = tid >> 4;
    const int m0 = blockIdx.y * 64, n0 = blockIdx.x * 64;
    float acc[4][4];
#pragma unroll
    for (int i = 0; i < 4; ++i)
#pragma unroll
        for (int j = 0; j < 4; ++j) acc[i][j] = 0.f;
    for (int k0 = 0; k0 < K; k0 += 16) {
#pragma unroll
        for (int i = 0; i < 4; ++i) { const int idx = tid + 256 * i, r = idx >> 4, c = idx & 15; As[c][r] = A[(size_t)(m0 + r) * lda + k0 + c]; }
#pragma unroll
        for (int i = 0; i < 4; ++i) { const int idx = tid + 256 * i, r = idx >> 6, c = idx & 63; Bs[r][c] = (n0 + c < N) ? B[(size_t)(k0 + r) * ldb + n0 + c] : 0.f; }
        __syncthreads();
#pragma unroll
        for (int k = 0; k < 16; ++k) {
            float a[4], b[4];
#pragma unroll
            for (int i = 0; i < 4; ++i) a[i] = As[k][ty + 16 * i];
#pragma unroll
            for (int j = 0; j < 4; ++j) b[j] = Bs[k][tx + 16 * j];
#pragma unroll
            for (int i = 0; i < 4; ++i)
#pragma unroll
                for (int j = 0; j < 4; ++j) acc[i][j] = fmaf(a[i], b[j], acc[i][j]);
        }
        __syncthreads();
    }
#pragma unroll
    for (int i = 0; i < 4; ++i)
#pragma unroll
        for (int j = 0; j < 4; ++j) { const int c = n0 + tx + 16 * j; if (c < N) C[(size_t)(m0 + ty + 16 * i) * ldc + c] = acc[i][j]; }
}

__device__ __forceinline__ float gelu_tanh(float x) {
    const float z = 0.7978845608028654f * (x + 0.044715f * x * x * x);
    const float e = __expf(2.f * z);
    const float th = 1.f - 2.f / (1.f + e);
    return 0.5f * x * (1.f + th);
}
__device__ __forceinline__ float sigmoidf_(float x) { return 1.f / (1.f + __expf(-x)); }

struct SsmPar { float ar, ai, kr, ki; };
__device__ __forceinline__ SsmPar ssm_par(const float* lam_re, const float* lam_im, const float* log_dt, int d, int g, int n) {
    const float lr = fminf(lam_re[(d * 32 + g) * 64 + n], -1e-4f), li = lam_im[(d * 32 + g) * 64 + n];
    const float dt = expf(log_dt[d * 32 + g]);
    const float x = lr * dt, th = li * dt;
    const float em1 = expm1f(x), cs = cosf(th), sn = sinf(th), sh = sinf(0.5f * th);
    const float mag = em1 + 1.f;
    SsmPar p; p.ar = mag * cs; p.ai = mag * sn;
    const float arm1 = em1 * cs - 2.f * sh * sh;
    const float den = lr * lr + li * li;
    p.kr = (arm1 * lr + p.ai * li) / den; p.ki = (p.ai * lr - arm1 * li) / den;
    return p;
}

__global__ void __launch_bounds__(64) ssm_naive(const float* __restrict__ proj, int ldp, const float* __restrict__ lam_re, const float* __restrict__ lam_im, const float* __restrict__ log_dt,
                                                const float* __restrict__ b_re, const float* __restrict__ b_im, const float* __restrict__ c_re, const float* __restrict__ c_im,
                                                const float* __restrict__ d_skip, float* __restrict__ spre) {
    const int g = blockIdx.x, b = blockIdx.y, n = threadIdx.x;
    for (int d = 0; d < 2; ++d) {
        const SsmPar P = ssm_par(lam_re, lam_im, log_dt, d, g, n);
        float Br[16], Bi[16], Cr[16], Ci[16];
#pragma unroll
        for (int q = 0; q < 16; ++q) { const float br = b_re[((d * 32 + g) * 64 + n) * 16 + q], bi = b_im[((d * 32 + g) * 64 + n) * 16 + q];
            Br[q] = P.kr * br - P.ki * bi; Bi[q] = P.kr * bi + P.ki * br;
            Cr[q] = c_re[((d * 32 + g) * 16 + q) * 64 + n]; Ci[q] = c_im[((d * 32 + g) * 16 + q) * 64 + n]; }
        float hr = 0.f, hi = 0.f;
        for (int step = 0; step < SEQ; ++step) {
            const int t = d ? (SEQ - 1 - step) : step;
            const float* up = proj + (size_t)(b * SEQ + t) * ldp + g * 16;
            float u[16];
#pragma unroll
            for (int q = 0; q < 16; ++q) u[q] = up[q];
            float bur = 0.f, bui = 0.f;
#pragma unroll
            for (int q = 0; q < 16; ++q) { bur = fmaf(Br[q], u[q], bur); bui = fmaf(Bi[q], u[q], bui); }
            const float nr = P.ar * hr - P.ai * hi + bur, ni = P.ar * hi + P.ai * hr + bui;
            hr = nr; hi = ni;
            float y[16];
#pragma unroll
            for (int p = 0; p < 16; ++p) y[p] = Cr[p] * hr - Ci[p] * hi;
#pragma unroll
            for (int o = 1; o < 64; o <<= 1)
#pragma unroll
                for (int p = 0; p < 16; ++p) y[p] += __shfl_xor(y[p], o);
            if (n < 16) {
                float v = 0.f;
#pragma unroll
                for (int p = 0; p < 16; ++p) if (p == n) v = y[p];
                float* o = spre + (size_t)(b * SEQ + t) * 512 + g * 16 + n;
                if (d == 0) *o = v;
                else { float uu = 0.f;
#pragma unroll
                    for (int p = 0; p < 16; ++p) if (p == n) uu = u[p];
                    *o = gelu_tanh(*o + v + uu * d_skip[g * 16 + n]); }
            }
        }
    }
}
__global__ void glu_ew(const float* __restrict__ spre, const float* __restrict__ gl, const float* __restrict__ bglu, float* __restrict__ mix, int ntok) {
    const size_t i = (size_t)blockIdx.x * 256 + threadIdx.x; if (i >= (size_t)ntok * 512) return;
    const int c = (int)(i & 511); const size_t r = i >> 9;
    mix[r * 1024 + c] = spre[i] * sigmoidf_(gl[i] + bglu[c]);
}
__global__ void rmsnorm_rows(const float* __restrict__ in, int ld, int off, int n, const float* __restrict__ g, float* __restrict__ out, int ntok) {
    const int r = blockIdx.x * 256 + threadIdx.x; if (r >= ntok) return;
    const float* p = in + (size_t)r * ld + off; float s = 0.f;
    for (int j = 0; j < n; ++j) s = fmaf(p[j], p[j], s);
    const float rs = rsqrtf(s / n + RMS_EPS);
    for (int j = 0; j < n; ++j) out[(size_t)r * n + j] = p[j] * rs * g[j];
}
__device__ __forceinline__ void rope_cs(int pos, int i, float& c, float& s) {
    const float inv = expf(-9.210340371976184f * (float)i * (1.f / 16.f));
    const float a = (float)pos * inv; c = cosf(a); s = sinf(a);
}
__global__ void rope_ew(float* __restrict__ q, const float* __restrict__ proj, int ldp, float* __restrict__ krope, int ntok) {
    const int idx = blockIdx.x * 256 + threadIdx.x; if (idx >= ntok * 9 * 16) return;
    const int i = idx & 15, hh = (idx >> 4) % 9, r = idx / 144, pos = r % SEQ;
    float c, s; rope_cs(pos, i, c, s);
    if (hh < 8) { float* p = q + (size_t)r * 768 + hh * 96 + 64; const float t1 = p[i], t2 = p[i + 16]; p[i] = t1 * c - t2 * s; p[i + 16] = t1 * s + t2 * c; }
    else { const float* p = proj + (size_t)r * ldp + 896; const float t1 = p[i], t2 = p[i + 16]; krope[(size_t)r * 32 + i] = t1 * c - t2 * s; krope[(size_t)r * 32 + i + 16] = t1 * s + t2 * c; }
}
__global__ void __launch_bounds__(64) attn_naive(const float* __restrict__ q, const float* __restrict__ kv, const float* __restrict__ krope, float* __restrict__ mix) {
    const int qi = blockIdx.x * 64 + threadIdx.x, h = blockIdx.y, b = blockIdx.z;
    const size_t r = (size_t)b * SEQ + qi;
    float qv[96], o[64];
#pragma unroll
    for (int d = 0; d < 96; ++d) qv[d] = q[r * 768 + h * 96 + d] * ATT_SCALE;
#pragma unroll
    for (int d = 0; d < 64; ++d) o[d] = 0.f;
    float m = -1e30f, l = 0.f;
    for (int s = 0; s < SEQ; ++s) {
        const size_t kr = (size_t)b * SEQ + s;
        const float4* kn = (const float4*)(kv + kr * 1024 + h * 128);
        const float4* kp = (const float4*)(krope + kr * 32);
        float sc = 0.f;
#pragma unroll
        for (int d = 0; d < 16; ++d) { const float4 k4 = kn[d]; sc = fmaf(qv[4 * d], k4.x, sc); sc = fmaf(qv[4 * d + 1], k4.y, sc); sc = fmaf(qv[4 * d + 2], k4.z, sc); sc = fmaf(qv[4 * d + 3], k4.w, sc); }
#pragma unroll
        for (int d = 0; d < 8; ++d) { const float4 k4 = kp[d]; sc = fmaf(qv[64 + 4 * d], k4.x, sc); sc = fmaf(qv[64 + 4 * d + 1], k4.y, sc); sc = fmaf(qv[64 + 4 * d + 2], k4.z, sc); sc = fmaf(qv[64 + 4 * d + 3], k4.w, sc); }
        const float mn = fmaxf(m, sc), al = __expf(m - mn), p = __expf(sc - mn);
        l = l * al + p; m = mn;
        const float4* vp = (const float4*)(kv + kr * 1024 + h * 128 + 64);
#pragma unroll
        for (int d = 0; d < 16; ++d) { const float4 v4 = vp[d]; o[4 * d] = fmaf(o[4 * d], al, p * v4.x); o[4 * d + 1] = fmaf(o[4 * d + 1], al, p * v4.y); o[4 * d + 2] = fmaf(o[4 * d + 2], al, p * v4.z); o[4 * d + 3] = fmaf(o[4 * d + 3], al, p * v4.w); }
    }
    const float il = 1.f / l;
#pragma unroll
    for (int d = 0; d < 64; ++d) mix[r * 1024 + 512 + h * 64 + d] = o[d] * il;
}
__device__ __forceinline__ float wsum(float v) {
#pragma unroll
    for (int o = 1; o < 64; o <<= 1) v += __shfl_xor(v, o);
    return v;
}
__global__ void __launch_bounds__(256) ln1_rows(const float* __restrict__ x, const float* __restrict__ mixo, const float* __restrict__ g, const float* __restrict__ bb, float* __restrict__ x1, int ntok) {
    const int r = blockIdx.x * 4 + (threadIdx.x >> 6), lane = threadIdx.x & 63; if (r >= ntok) return;
    float v[16]; float s = 0.f;
#pragma unroll
    for (int j = 0; j < 16; ++j) { const int c = lane + 64 * j; v[j] = ALPHA * x[(size_t)r * 1024 + c] + mixo[(size_t)r * 1024 + c]; s += v[j]; }
    const float mean = wsum(s) * (1.f / 1024.f); float q = 0.f;
#pragma unroll
    for (int j = 0; j < 16; ++j) { v[j] -= mean; q = fmaf(v[j], v[j], q); }
    const float rstd = rsqrtf(wsum(q) * (1.f / 1024.f) + LN_EPS);
#pragma unroll
    for (int j = 0; j < 16; ++j) { const int c = lane + 64 * j; x1[(size_t)r * 1024 + c] = v[j] * rstd * g[c] + bb[c]; }
}
}

__device__ __forceinline__ void route_token(const float (&lg)[64], const float* __restrict__ rbias, int (&idx)[6], float (&w)[6]) {
    float sc[64], ch[64];
#pragma unroll
    for (int j = 0; j < 64; ++j) { sc[j] = 1.f / (1.f + __expf(-lg[j])); ch[j] = sc[j] + rbias[j]; }
    float gs[8];
#pragma unroll
    for (int g = 0; g < 8; ++g) { float m1 = -INFINITY, m2 = -INFINITY;
#pragma unroll
        for (int j = 0; j < 8; ++j) { const float v = ch[g * 8 + j]; if (v > m1) { m2 = m1; m1 = v; } else if (v > m2) m2 = v; }
        gs[g] = m1 + m2; }
    bool sel[8];
#pragma unroll
    for (int g = 0; g < 8; ++g) { int rank = 0;
#pragma unroll
        for (int o = 0; o < 8; ++o) { if (o != g && (gs[o] > gs[g] || (gs[o] == gs[g] && o < g))) ++rank; }
        sel[g] = rank < 4; }
#pragma unroll
    for (int j = 0; j < 64; ++j) if (!sel[j >> 3]) ch[j] = -INFINITY;
    float wsum_ = 0.f;
#pragma unroll
    for (int k = 0; k < 6; ++k) { float best = -INFINITY; int bi = 0;
#pragma unroll
        for (int j = 0; j < 64; ++j) if (ch[j] > best) { best = ch[j]; bi = j; }
        float sv = 0.f;
#pragma unroll
        for (int j = 0; j < 64; ++j) if (j == bi) { sv = sc[j]; ch[j] = -INFINITY; }
        idx[k] = bi; w[k] = sv; wsum_ += sv; }
    const float inv = 2.5f / (wsum_ + 1e-20f);
#pragma unroll
    for (int k = 0; k < 6; ++k) w[k] *= inv;
}

namespace gold {
__global__ void __launch_bounds__(64) route_rows(const float* __restrict__ logits, const float* __restrict__ rbias, int* __restrict__ topi, float* __restrict__ topw, int ntok) {
    const int r = blockIdx.x * 64 + threadIdx.x; if (r >= ntok) return;
    float lg[64];
#pragma unroll
    for (int j = 0; j < 16; ++j) { const float4 v = ((const float4*)(logits + (size_t)r * 64))[j]; lg[4 * j] = v.x; lg[4 * j + 1] = v.y; lg[4 * j + 2] = v.z; lg[4 * j + 3] = v.w; }
    int idx[6]; float w[6]; route_token(lg, rbias, idx, w);
#pragma unroll
    for (int k = 0; k < 6; ++k) { topi[(size_t)r * 6 + k] = idx[k]; topw[(size_t)r * 6 + k] = w[k]; }
}
__global__ void __launch_bounds__(256) moe_naive(const float* x1, const int* __restrict__ topi, const float* __restrict__ topw,
                                                  const float* __restrict__ weg, const float* __restrict__ weu, const float* __restrict__ wed,
                                                  const float* __restrict__ wsg, const float* __restrict__ wsu, const float* __restrict__ wsd,
                                                  const float* __restrict__ g2, const float* __restrict__ b2, float* out) {
    __shared__ float xs[1024]; __shared__ float hs[256]; __shared__ float red[8];
    const int r = blockIdx.x, tid = threadIdx.x;
#pragma unroll
    for (int j = 0; j < 4; ++j) xs[tid + 256 * j] = x1[(size_t)r * 1024 + tid + 256 * j];
    __syncthreads();
    float acc[4] = {0.f, 0.f, 0.f, 0.f};
    for (int ei = 0; ei < 7; ++ei) {
        const int e = ei < 6 ? topi[(size_t)r * 6 + ei] : 0; const float w = ei < 6 ? topw[(size_t)r * 6 + ei] : 1.f;
        const float* Wg = ei < 6 ? weg + (size_t)e * 1024 * 256 : wsg; const float* Wu = ei < 6 ? weu + (size_t)e * 1024 * 256 : wsu; const float* Wd = ei < 6 ? wed + (size_t)e * 256 * 1024 : wsd;
        float gg = 0.f, uu = 0.f;
        for (int k = 0; k < 1024; ++k) { const float xv = xs[k]; gg = fmaf(xv, Wg[(size_t)k * 256 + tid], gg); uu = fmaf(xv, Wu[(size_t)k * 256 + tid], uu); }
        hs[tid] = gg / (1.f + __expf(-gg)) * uu;
        __syncthreads();
        float y[4] = {0.f, 0.f, 0.f, 0.f};
        for (int i = 0; i < 256; ++i) { const float hv = hs[i];
#pragma unroll
            for (int j = 0; j < 4; ++j) y[j] = fmaf(hv, Wd[(size_t)i * 1024 + tid + 256 * j], y[j]); }
#pragma unroll
        for (int j = 0; j < 4; ++j) acc[j] = fmaf(w, y[j], acc[j]);
        __syncthreads();
    }
    float v[4]; float s = 0.f;
#pragma unroll
    for (int j = 0; j < 4; ++j) { v[j] = ALPHA * xs[tid + 256 * j] + acc[j]; s += v[j]; }
    s = wsum(s); if ((tid & 63) == 0) red[tid >> 6] = s; __syncthreads();
    const float mean = (red[0] + red[1] + red[2] + red[3]) * (1.f / 1024.f); float q = 0.f;
#pragma unroll
    for (int j = 0; j < 4; ++j) { v[j] -= mean; q = fmaf(v[j], v[j], q); }
    q = wsum(q); if ((tid & 63) == 0) red[4 + (tid >> 6)] = q; __syncthreads();
    const float rstd = rsqrtf((red[4] + red[5] + red[6] + red[7]) * (1.f / 1024.f) + LN_EPS);
#pragma unroll
    for (int j = 0; j < 4; ++j) { const int c = tid + 256 * j; out[(size_t)r * 1024 + c] = v[j] * rstd * g2[c] + b2[c]; }
}

struct In {
    const float *x, *w_in, *lam_re, *lam_im, *log_dt, *b_re, *b_im, *c_re, *c_im, *d_skip, *w_glu, *b_glu, *q_norm_g, *w_uq, *kv_norm_g, *w_ukv, *w_o, *ln1_g, *ln1_b,
                *w_router, *router_bias, *we_gate, *we_up, *we_down, *ws_gate, *ws_up, *ws_down, *ln2_g, *ln2_b;
};
constexpr size_t GOLD_FLOATS_PER_TOK = 6400;
struct Bufs { float *proj, *spre, *gl, *mix, *cqn, *ckvn, *q, *kv, *krope, *mixo, *logits; int* topi; float* topw; };
static Bufs run(const In& I, int tok0, int ntok, float* scratch, float* x1out, float* out, hipStream_t st) {
    Bufs B;
    B.proj = scratch; B.spre = B.proj + (size_t)ntok * 928; B.gl = B.spre + (size_t)ntok * 512; B.mix = B.gl + (size_t)ntok * 512;
    B.cqn = B.mix + (size_t)ntok * 1024; B.ckvn = B.cqn + (size_t)ntok * 256; B.q = B.ckvn + (size_t)ntok * 128; B.kv = B.q + (size_t)ntok * 768;
    B.krope = B.kv + (size_t)ntok * 1024; B.mixo = B.krope + (size_t)ntok * 32; B.logits = B.mixo + (size_t)ntok * 1024;
    B.topi = (int*)(B.logits + (size_t)ntok * 64); B.topw = (float*)(B.topi + (size_t)ntok * 6);
    float *proj = B.proj, *spre = B.spre, *gl = B.gl, *mix = B.mix, *cqn = B.cqn, *ckvn = B.ckvn, *q = B.q, *kv = B.kv, *krope = B.krope, *mixo = B.mixo, *logits = B.logits; int* topi = B.topi; float* topw = B.topw;
    const float* x = I.x + (size_t)tok0 * 1024; const int nb = ntok / SEQ;
    hipLaunchKernelGGL(sgemm, dim3((928 + 63) / 64, ntok / 64), dim3(256), 0, st, x, 1024, I.w_in, 928, proj, 928, ntok, 928, 1024);
    hipLaunchKernelGGL(ssm_naive, dim3(32, nb), dim3(64), 0, st, proj, 928, I.lam_re, I.lam_im, I.log_dt, I.b_re, I.b_im, I.c_re, I.c_im, I.d_skip, spre);
    hipLaunchKernelGGL(sgemm, dim3(8, ntok / 64), dim3(256), 0, st, spre, 512, I.w_glu, 512, gl, 512, ntok, 512, 512);
    hipLaunchKernelGGL(glu_ew, dim3((unsigned)(((size_t)ntok * 512 + 255) / 256)), dim3(256), 0, st, spre, gl, I.b_glu, mix, ntok);
    hipLaunchKernelGGL(rmsnorm_rows, dim3((ntok + 255) / 256), dim3(256), 0, st, proj, 928, 512, 256, I.q_norm_g, cqn, ntok);
    hipLaunchKernelGGL(rmsnorm_rows, dim3((ntok + 255) / 256), dim3(256), 0, st, proj, 928, 768, 128, I.kv_norm_g, ckvn, ntok);
    hipLaunchKernelGGL(sgemm, dim3(12, ntok / 64), dim3(256), 0, st, cqn, 256, I.w_uq, 768, q, 768, ntok, 768, 256);
    hipLaunchKernelGGL(sgemm, dim3(16, ntok / 64), dim3(256), 0, st, ckvn, 128, I.w_ukv, 1024, kv, 1024, ntok, 1024, 128);
    hipLaunchKernelGGL(rope_ew, dim3((ntok * 144 + 255) / 256), dim3(256), 0, st, q, proj, 928, krope, ntok);
    hipLaunchKernelGGL(attn_naive, dim3(SEQ / 64, 8, nb), dim3(64), 0, st, q, kv, krope, mix);
    hipLaunchKernelGGL(sgemm, dim3(16, ntok / 64), dim3(256), 0, st, mix, 1024, I.w_o, 1024, mixo, 1024, ntok, 1024, 1024);
    hipLaunchKernelGGL(ln1_rows, dim3(ntok / 4), dim3(256), 0, st, x, mixo, I.ln1_g, I.ln1_b, x1out, ntok);
    hipLaunchKernelGGL(sgemm, dim3(1, ntok / 64), dim3(256), 0, st, x1out, 1024, I.w_router, 64, logits, 64, ntok, 64, 1024);
    hipLaunchKernelGGL(route_rows, dim3(ntok / 64), dim3(64), 0, st, logits, I.router_bias, topi, topw, ntok);
    hipLaunchKernelGGL(moe_naive, dim3(ntok), dim3(256), 0, st, x1out, topi, topw, I.we_gate, I.we_up, I.we_down, I.ws_gate, I.ws_up, I.ws_down, I.ln2_g, I.ln2_b, out);
    return B;
}
}
#define GAS __attribute__((address_space(1)))
#define LAS __attribute__((address_space(3)))
typedef unsigned short bf16_t;
typedef short bf16x8 __attribute__((ext_vector_type(8)));
typedef short s16x4 __attribute__((ext_vector_type(4)));
typedef float f32x4 __attribute__((ext_vector_type(4)));
typedef float f32x2 __attribute__((ext_vector_type(2)));
typedef float f32x16 __attribute__((ext_vector_type(16)));
typedef unsigned u32x4 __attribute__((ext_vector_type(4)));
typedef unsigned u32x2 __attribute__((ext_vector_type(2)));

namespace fx {
constexpr int T = 65536, SEQ = 2048, DM = 1024, NB = 32;
constexpr int CHK = 32;
constexpr int NCHK = SEQ / CHK;
constexpr int UHR = NB * NCHK;
constexpr int UHK = CHK * 16 + 256;
constexpr int Y8_LD = 1024;
constexpr int SPRE_LD = 512;
constexpr int NCH = 2;
constexpr int CAPC = T / NCH;
constexpr int NVE = NCH * 65;
constexpr float ALPHA = 1.189207115002721f, LN_EPS = 1e-5f, RMS_EPS = 1e-6f;
constexpr float QSCALE = 0.10206207261596577f * 1.4426950408889634f;

constexpr size_t MiB = 1u << 20;
constexpr size_t WS_CTL = 0, CTL_BYTES = 1 * MiB;
constexpr size_t WS_ROPE = 1 * MiB;
constexpr size_t WS_KT = 2 * MiB;
constexpr size_t WS_WIN = 4 * MiB, WS_WGLU = 6 * MiB, WS_WUQ = 6 * MiB + 512 * 1024, WS_WUKV = 7 * MiB, WS_WO = 8 * MiB;
constexpr size_t WS_WST = 10 * MiB, WS_MO = 18 * MiB, WS_WGU = 42 * MiB  , WS_WR = 107 * MiB  , WS_WD = 107 * MiB + 512 * 1024;
constexpr size_t WS_SSQQ = 140 * MiB, WS_SSQKV = 141 * MiB, WS_TSLOT = 142 * MiB, WS_TOPW = 144 * MiB, WS_ROWTOK = 146 * MiB, WS_LOGIT = 162 * MiB;
constexpr size_t WS_XB = 178 * MiB, WS_UH = 306 * MiB, WS_CQ = 402 * MiB, WS_CKVR = 434 * MiB, WS_S = 466 * MiB, WS_Q = 530 * MiB, WS_KV = 626 * MiB, WS_SPRE = 754 * MiB, WS_MIX = 818 * MiB;
constexpr size_t WS_X1B = 178 * MiB, WS_H = 306 * MiB, WS_Y = 562 * MiB  , WS_YS = 800 * MiB  , WS_HS = 864 * MiB  ;
constexpr size_t WS_GOLD = 946 * MiB, WS_END = 1024 * MiB;
constexpr int CW_TMO = 0, CW_CODE = 1, CW_BAR = 4096, CW_CNT = 16384  , CW_DBG = 65536  , CW_QUEUE = 32768  ;

constexpr int RING_BYTES = 131072, TAB_OFF = RING_BYTES, IDX_OFF = TAB_OFF + 10752  , IDX_UNITS = 16, MISC_OFF = IDX_OFF + IDX_UNITS * 1024, LDS_BYTES = MISC_OFF + 256;

__device__ __forceinline__ unsigned cvt_pk_bf16(float lo, float hi) { unsigned r; asm volatile("v_cvt_pk_bf16_f32 %0, %1, %2" : "=v"(r) : "v"(lo), "v"(hi)); return r; }
__device__ __forceinline__ float bf_lo(unsigned w) { return __uint_as_float(w << 16); }
__device__ __forceinline__ float bf_hi(unsigned w) { return __uint_as_float(w & 0xffff0000u); }
__device__ __forceinline__ u32x4 pack8(const f32x4 a, const f32x4 b) { u32x4 w; w.x = cvt_pk_bf16(a[0], a[1]); w.y = cvt_pk_bf16(a[2], a[3]); w.z = cvt_pk_bf16(b[0], b[1]); w.w = cvt_pk_bf16(b[2], b[3]); return w; }
__device__ __forceinline__ void unpack8(const u32x4 w, f32x4& a, f32x4& b) { a = (f32x4){bf_lo(w.x), bf_hi(w.x), bf_lo(w.y), bf_hi(w.y)}; b = (f32x4){bf_lo(w.z), bf_hi(w.z), bf_lo(w.w), bf_hi(w.w)}; }
__device__ __forceinline__ float fast_sigmoid(float x) { return __builtin_amdgcn_rcpf(1.f + __builtin_amdgcn_exp2f(-1.4426950408889634f * x)); }
__device__ __forceinline__ float gelu_tanh_f(float x) {
    const float z2 = 1.5957691216057308f * (x + 0.044715f * x * x * x);
    return x * fast_sigmoid(z2);
}
#ifndef SC1_STORES
#define SC1_STORES 0
#endif
__device__ __forceinline__ void store16(void* p, const u32x4 v) {
#if SC1_STORES
    asm volatile("global_store_dwordx4 %0, %1, off sc1\n\ts_nop 1" :: "v"(p), "v"(v) : "memory");
#else
    *(u32x4*)p = v;
#endif
}
__device__ __forceinline__ u32x4 ror8_x4(const u32x4 v) { u32x4 r;
    r.x = (unsigned)__builtin_amdgcn_update_dpp(0, (int)v.x, 0x128, 0xF, 0xF, false); r.y = (unsigned)__builtin_amdgcn_update_dpp(0, (int)v.y, 0x128, 0xF, 0xF, false);
    r.z = (unsigned)__builtin_amdgcn_update_dpp(0, (int)v.z, 0x128, 0xF, 0xF, false); r.w = (unsigned)__builtin_amdgcn_update_dpp(0, (int)v.w, 0x128, 0xF, 0xF, false); return r; }
__device__ __forceinline__ void store_lines16(bf16_t* rowp, size_t ld, const u32x4 X, const u32x4 Y, int fr, int fq) {
    const bool lo = fr < 8; const u32x4 S = lo ? Y : X, R = ror8_x4(S);
    const u32x4 A1 = lo ? X : R, A2 = lo ? R : Y;
    bf16_t* p = rowp + (size_t)(fr & 7) * ld + (lo ? 8 * fq : 32 + 8 * fq);
    *(u32x4*)p = A1; *(u32x4*)(p + 8 * ld) = A2;
}
__device__ __forceinline__ float wave_sum(float v) {
#pragma unroll
    for (int o = 1; o < 64; o <<= 1) v += __shfl_xor(v, o);
    return v;
}

#define XB_TMO      128
#define XB_XCNT(j)  (256  + 64 * (j))
#define XB_XSUB(j)  (1280 + 64 * (j))
#define XB_XGEN(j)  (2304 + 64 * (j))
#define XB_TOP      3328
#define XB_TOPGEN   3392
#define XCD_BAR_WORDS 3456
#define XB_SPIN_CAP (1u << 18)
__device__ __forceinline__ unsigned xb_ld(unsigned* p)              { return __hip_atomic_load(p, __ATOMIC_RELAXED, __HIP_MEMORY_SCOPE_AGENT); }
__device__ __forceinline__ unsigned xb_add(unsigned* p, unsigned v) { return __hip_atomic_fetch_add(p, v, __ATOMIC_RELAXED, __HIP_MEMORY_SCOPE_AGENT); }
__device__ __forceinline__ unsigned xb_xcc_id() { return (unsigned)__builtin_amdgcn_s_getreg((3 << 11) | 20) & 0xFu; }
#define XB_SPIN(cond, bar) do { unsigned _sp = 0; while (cond) { __builtin_amdgcn_s_sleep(1); \
    if ((++_sp & 255u) == 0u) { if (xb_ld(&(bar)[XB_TMO])) break; if (_sp > XB_SPIN_CAP) { atomicAdd(&(bar)[XB_TMO], 1u); break; } } } } while (0)
struct XcdBarrier { unsigned* bar; unsigned x; volatile LAS unsigned* st; };
__device__ __forceinline__ XcdBarrier xcd_barrier_post(unsigned* bar, volatile LAS unsigned* st) {
    XcdBarrier b; b.bar = bar; b.x = xb_xcc_id(); b.st = st;
    if (threadIdx.x == 0) (void)xb_add(&bar[XB_XCNT(b.x)], 1u);
    return b;
}
__device__ __forceinline__ void xcd_barrier_complete(unsigned* bar, unsigned x, unsigned& nloc, unsigned& nx) {
    const unsigned G = gridDim.x * gridDim.y * gridDim.z;
    unsigned sum, cnt, mine, sp = 0u;
    for (;;) {
        sum = 0u; cnt = 0u; mine = 0u;
#pragma unroll
        for (unsigned j = 0; j < 16; ++j) { const unsigned c = xb_ld(&bar[XB_XCNT(j)]); sum += c; cnt += (c > 0u) ? 1u : 0u; mine = (j == x) ? c : mine; }
        if (sum == G) break;
        __builtin_amdgcn_s_sleep(1);
        if ((++sp & 255u) == 0u) { if (xb_ld(&bar[XB_TMO])) break; if (sp > XB_SPIN_CAP) { atomicAdd(&bar[XB_TMO], 1u); break; } }
    }
    nloc = mine > 0u ? mine : 1u; nx = cnt > 0u ? cnt : 1u;
}
__device__ __forceinline__ void xcd_barrier(const XcdBarrier& b) {
    asm volatile("s_waitcnt vmcnt(0)" ::: "memory");
    __syncthreads();
    if (threadIdx.x == 0) {
        unsigned* bar = b.bar;
        __builtin_amdgcn_s_waitcnt(0);
        unsigned nloc = b.st[0], nx = b.st[1];
        if (nloc == 0u) { xcd_barrier_complete(bar, b.x, nloc, nx); b.st[0] = nloc; b.st[1] = nx; }
        const unsigned old = xb_add(&bar[XB_XSUB(b.x)], 1u);
        const unsigned gen = old / nloc;
        if (old + 1u == (gen + 1u) * nloc) {
            __builtin_amdgcn_fence(__ATOMIC_RELEASE, "agent");
            asm volatile("s_waitcnt vmcnt(0)" ::: "memory");
            const unsigned og = xb_add(&bar[XB_TOP], 1u);
            const unsigned tg = og / nx;
            if (og + 1u == (tg + 1u) * nx) xb_add(&bar[XB_TOPGEN], 1u);
            else XB_SPIN(xb_ld(&bar[XB_TOPGEN]) == tg, bar);
            __builtin_amdgcn_fence(__ATOMIC_ACQUIRE, "agent");
            xb_add(&bar[XB_XGEN(b.x)], 1u);
            asm volatile("s_waitcnt vmcnt(0)" ::: "memory");
        } else {
            XB_SPIN(xb_ld(&bar[XB_XGEN(b.x)]) == gen, bar);
            __builtin_amdgcn_fence(__ATOMIC_ACQUIRE, "agent");
            asm volatile("s_waitcnt vmcnt(0)" ::: "memory");
        }
    }
    __syncthreads();
}

constexpr int BM = 256, BK = 64, HALF = 128, HTB = HALF * BK * 2, STAGE_BYTES = 8 * HTB;
__host__ __device__ __forceinline__ int lds_byte(int r, int c) { const int st = (r >> 4) * 2 + (c >> 5), rr = r & 15, cc = c & 31, ob = rr * 64 + cc * 2; return st * 1024 + (ob ^ (((ob >> 9) & 1) << 5)); }
__host__ __device__ __forceinline__ void stage_rc(int b, int& R, int& C) { const int st = b / 1024, sb = b % 1024, swz = sb ^ (((sb >> 9) & 1) << 5); R = (st >> 1) * 16 + swz / 64; C = (st & 1) * 32 + (swz % 64) / 2; }
__host__ __device__ __forceinline__ int perm32(int rho) { const int n = rho >> 4, i = rho & 15; return 8 * (i >> 2) + 4 * n + (i & 3); }
__host__ __device__ __forceinline__ int perm16x(int rho) { const int n = rho >> 4, i = rho & 15; return 16 * (i >> 2) + 4 * n + (i & 3); }

struct Unit { const char* A; const char* B; int i0, i1, i2, i3; };
__device__ __forceinline__ int xcd_remap(int L, int nwg) { const int q = nwg / 8, r = nwg % 8, xcd = L % 8, off = L / 8; return (xcd < r ? xcd * (q + 1) : r * (q + 1) + (xcd - r) * q) + off; }

template <class Epi, class Sched, bool ALIGN_EPI, bool GATHER, int STAG = 0, int AMODE = 0>
__device__ __forceinline__ void gemm_phase(LAS unsigned char* lds, const int lda, const int ldb, const int K, const Sched& S, const Epi& E) {
    if constexpr (STAG > 0) { const unsigned long long t0_ = __builtin_amdgcn_s_memrealtime(), dl_ = (unsigned long long)STAG * ((blockIdx.x >> 3) & 3u); while (__builtin_amdgcn_s_memrealtime() - t0_ < dl_) __builtin_amdgcn_s_sleep(4); }
    int tid = threadIdx.x; asm volatile("" : "+v"(tid));
    const int wid = __builtin_amdgcn_readfirstlane(tid >> 6), lane = tid & 63, wr = wid >> 2, wc = wid & 3, fr = lane & 15, fq = lane >> 4;
    const int nt = K / BK;
    unsigned voffA[2], voffB[2]; int RA[2], CA[2];
#pragma unroll
    for (int i = 0; i < 2; ++i) { int R, C; stage_rc(tid * 16 + i * 8192, R, C); const int Rb = 64 * (R >> 5) + (Epi::PERM == 2 ? perm16x(R & 31) : Epi::PERM ? perm32(R & 31) : (R & 31));
        RA[i] = R; CA[i] = C; voffA[i] = AMODE == 1 ? (unsigned)((R >> 4) * 8192 + (R & 7) * 1024 + (C >> 5) * 128 + ((R >> 3) & 1) * 64 + (C & 31) * 2) : (unsigned)(R * lda + C) * 2u; voffB[i] = (unsigned)(Rb * ldb + C) * 2u; }
    const size_t kstep = (size_t)(BK * 2), kstepA = AMODE == 1 ? 256 : kstep;
    const size_t hstepA = (size_t)HALF * lda * 2, hstepB = (size_t)(Epi::PERM == 2 ? 8 : 32) * ldb * 2;
    const unsigned ldsw = (unsigned)wid * 1024u;
    const int aoff = lds_byte(wr * 64 + fr, fq * 8), boff = lds_byte(wc * 32 + fr, fq * 8);
#define PG8_SA(b, h) (((b) * 2 + (h)) * HTB)
#define PG8_SB(b, h) ((4 + (b) * 2 + (h)) * HTB)
#define PG8_STAGE(bufoff, gbase, voff) do { _Pragma("unroll") for (int _i = 0; _i < 2; ++_i) \
        __builtin_amdgcn_global_load_lds((const unsigned*)((const char*)(gbase) + (voff)[_i]), (LAS unsigned*)(lds + (bufoff) + ldsw + _i * 8192), 16, 0, 0); } while (0)
#define PG8_STAGE_A(bufoff, base, g0, g1, h, kb) do { if constexpr (GATHER) { \
        __builtin_amdgcn_global_load_lds((const unsigned*)((base) + (kb) + (g0)), (LAS unsigned*)(lds + (bufoff) + ldsw), 16, 0, 0); \
        __builtin_amdgcn_global_load_lds((const unsigned*)((base) + (kb) + (g1)), (LAS unsigned*)(lds + (bufoff) + ldsw + 8192), 16, 0, 0); } \
      else { PG8_STAGE(bufoff, (base) + (h) * hstepA + (kb), voffA); } } while (0)
#define PG8_LDA(dst, b, h) do { _Pragma("unroll") for (int m = 0; m < 4; ++m) _Pragma("unroll") for (int k = 0; k < 2; ++k) dst[m][k] = *(const LAS bf16x8*)(lds + PG8_SA(b, h) + aoff + m * 2048 + k * 1024); } while (0)
#define PG8_LDB(dst, b, h) do { _Pragma("unroll") for (int n = 0; n < 2; ++n) _Pragma("unroll") for (int k = 0; k < 2; ++k) dst[n][k] = *(const LAS bf16x8*)(lds + PG8_SB(b, h) + boff + n * 2048 + k * 1024); } while (0)
#define PG8_MMA(ai, bj, At, Bt) do { __builtin_amdgcn_s_setprio(1); _Pragma("unroll") for (int m = 0; m < 4; ++m) _Pragma("unroll") for (int n = 0; n < 2; ++n) _Pragma("unroll") for (int k = 0; k < 2; ++k) \
        acc[ai][bj][m][n] = __builtin_amdgcn_mfma_f32_16x16x32_bf16(Bt[n][k], At[m][k], acc[ai][bj][m][n], 0, 0, 0); __builtin_amdgcn_s_setprio(0); } while (0)
#define PG8_WAIT_V(n) asm volatile("s_waitcnt vmcnt(" #n ")" ::: "memory")
#define PG8_WAIT_VN(n) asm volatile("s_waitcnt vmcnt(%0)" :: "n"(n) : "memory")
#define PG8_WAIT_L(n) asm volatile("s_waitcnt lgkmcnt(" #n ")" ::: "memory")
#define PG8_BAR __builtin_amdgcn_s_barrier()
#define PG8_SCHED __builtin_amdgcn_sched_barrier(0)
    Unit cur, nxt; int ui = 0;
    if (!S.next(0, cur)) return;
    unsigned gc00 = 0, gc01 = 0, gc10 = 0, gc11 = 0, gn00 = 0, gn01 = 0, gn10 = 0, gn11 = 0;
    if constexpr (GATHER) { S.gather(cur, RA[0], CA[0], RA[1], CA[1], gc00, gc01, gc10, gc11); gn00 = gc00; gn01 = gc01; gn10 = gc10; gn11 = gc11; }
    f32x4 acc[2][2][4][2];
#pragma unroll
    for (int a = 0; a < 2; ++a)
#pragma unroll
        for (int b = 0; b < 2; ++b)
#pragma unroll
            for (int m = 0; m < 4; ++m)
#pragma unroll
                for (int n = 0; n < 2; ++n) acc[a][b][m][n] = (f32x4){0.f, 0.f, 0.f, 0.f};
    bf16x8 At[4][2], B0[2][2], B1[2][2];
    const char* cA = cur.A; const char* cB = cur.B;
    PG8_STAGE(PG8_SB(0, 0), cB, voffB); PG8_STAGE(PG8_SB(0, 1), cB + hstepB, voffB); PG8_STAGE_A(PG8_SA(0, 0), cA, gc00, gc01, 0, 0); PG8_STAGE_A(PG8_SA(0, 1), cA, gc10, gc11, 1, 0);
    if (wr == 1) PG8_BAR;
    PG8_WAIT_V(2); PG8_BAR;
    PG8_STAGE(PG8_SB(1, 0), cB + kstep, voffB); PG8_STAGE_A(PG8_SA(1, 0), cA, gc00, gc01, 0, kstepA); PG8_STAGE(PG8_SB(1, 1), cB + hstepB + kstep, voffB);
    PG8_WAIT_V(6); PG8_BAR;
    for (;;) {
        const bool has_next = S.next(ui + 1, nxt);
        if constexpr (GATHER) { if (has_next) S.gather(nxt, RA[0], CA[0], RA[1], CA[1], gn00, gn01, gn10, gn11); }
        const char* nA = has_next ? nxt.A : cA; const char* nB = has_next ? nxt.B : cB;
#pragma unroll 1
        for (int t = 0; t < nt; t += 2) {
            const bool last = (t == nt - 2);
            const size_t k1 = (size_t)(t + 1) * kstepA;
            const char* a2 = last ? nA : cA; const char* b2 = last ? nB : cB + (size_t)(t + 2) * kstep;
            const size_t k2 = last ? 0 : (size_t)(t + 2) * kstepA, k3 = k2 + kstepA;
            const char* b3 = b2 + kstep;
            unsigned g200 = gc00, g201 = gc01, g210 = gc10, g211 = gc11;
            if constexpr (GATHER) { if (last) { g200 = gn00; g201 = gn01; g210 = gn10; g211 = gn11; } }
            PG8_LDB(B0, 0, 0); PG8_LDB(B1, 0, 1); PG8_SCHED; PG8_LDA(At, 0, 0); PG8_STAGE_A(PG8_SA(1, 1), cA, gc10, gc11, 1, k1);
            PG8_WAIT_V(8); PG8_WAIT_L(0); PG8_BAR; PG8_MMA(0, 0, At, B0); PG8_MMA(0, 1, At, B1); PG8_BAR; PG8_SCHED;
            PG8_LDA(At, 0, 1); PG8_STAGE(PG8_SB(0, 0), b2, voffB); PG8_STAGE(PG8_SB(0, 1), b2 + hstepB, voffB); PG8_STAGE_A(PG8_SA(0, 0), a2, g200, g201, 0, k2);
            PG8_WAIT_V(8); PG8_WAIT_L(0); PG8_BAR; PG8_MMA(1, 0, At, B0); PG8_MMA(1, 1, At, B1); PG8_BAR; PG8_SCHED;
            PG8_LDB(B0, 1, 0); PG8_LDB(B1, 1, 1); PG8_SCHED; PG8_LDA(At, 1, 0); PG8_STAGE_A(PG8_SA(0, 1), a2, g210, g211, 1, k2);
            PG8_WAIT_V(8); PG8_WAIT_L(0); PG8_BAR; PG8_MMA(0, 0, At, B0); PG8_MMA(0, 1, At, B1); PG8_BAR; PG8_SCHED;
            PG8_LDA(At, 1, 1); PG8_STAGE(PG8_SB(1, 0), b3, voffB); PG8_STAGE(PG8_SB(1, 1), b3 + hstepB, voffB); PG8_STAGE_A(PG8_SA(1, 0), a2, g200, g201, 0, k3);
            PG8_WAIT_V(8); PG8_WAIT_L(0); PG8_BAR; PG8_MMA(1, 0, At, B0); PG8_MMA(1, 1, At, B1); PG8_BAR; PG8_SCHED;
        }
#if defined(MK_TPROBE) && MK_TPROBE >= 200
        unsigned long long tp0_ = 0; if (blockIdx.x == 0 && wid == 0) tp0_ = __builtin_amdgcn_s_memrealtime();
#endif
        if constexpr (ALIGN_EPI) { if (wr == 0) PG8_BAR; }
        E(acc, cur, wr, wc, fr, fq);
#if defined(MK_TPROBE) && MK_TPROBE >= 200
        if (blockIdx.x == 0 && wid == 0) { asm volatile("s_waitcnt vmcnt(0)" ::: "memory"); const unsigned long long d_ = __builtin_amdgcn_s_memrealtime() - tp0_; if (lane == 0) { volatile LAS unsigned* M_ = (volatile LAS unsigned*)(lds + MISC_OFF); const unsigned long long a_ = (((unsigned long long)M_[23] << 32) | M_[22]) + d_; M_[22] = (unsigned)a_; M_[23] = (unsigned)(a_ >> 32); } }
#endif
        if (!has_next) break;
#pragma unroll
        for (int a = 0; a < 2; ++a)
#pragma unroll
            for (int b = 0; b < 2; ++b)
#pragma unroll
                for (int m = 0; m < 4; ++m)
#pragma unroll
                    for (int n = 0; n < 2; ++n) acc[a][b][m][n] = (f32x4){0.f, 0.f, 0.f, 0.f};
        cur = nxt; cA = nA; cB = nB; ++ui;
        if constexpr (GATHER) { gc00 = gn00; gc01 = gn01; gc10 = gn10; gc11 = gn11; }
        if constexpr (ALIGN_EPI) { if (wr == 1) PG8_BAR; }
    }
    PG8_WAIT_V(0);
    if constexpr (!ALIGN_EPI) { if (wr == 0) PG8_BAR; }
    PG8_BAR;
#undef PG8_SA
#undef PG8_SB
#undef PG8_STAGE
#undef PG8_STAGE_A
#undef PG8_LDA
#undef PG8_LDB
#undef PG8_MMA
#undef PG8_WAIT_V
#undef PG8_WAIT_VN
#undef PG8_WAIT_L
#undef PG8_BAR
#undef PG8_SCHED
}
}
namespace fx {
#define FX_ROWLOOP _Pragma("unroll") for (int ai = 0; ai < 2; ++ai) _Pragma("unroll") for (int m = 0; m < 4; ++m)

struct PlainOrder {
    const char* A; const char* B; int lda, ldb, nM, nN, nwg, G, c;
    __device__ __forceinline__ void init(const void* A_, int lda_, const void* B_, int ldb_, int M, int N, int G_, int c_) { A = (const char*)A_; B = (const char*)B_; lda = lda_; ldb = ldb_; nM = M / 256; nN = N / 256; nwg = nM * nN; G = G_; c = c_; }
    __device__ __forceinline__ bool next(int i, Unit& u) const {
        const long L = (long)i * G + c; if (L >= nwg) return false;
        const int wgid = xcd_remap((int)L, nwg);
        const int nig = 8 * nN, gid = wgid / nig, fm = gid * 8, gsz = (nM - fm) < 8 ? (nM - fm) : 8;
        const int pm = fm + ((wgid % nig) % gsz), pn = (wgid % nig) / gsz;
        u.A = A + (size_t)pm * 256 * lda * 2; u.B = B + (size_t)pn * 256 * ldb * 2; u.i0 = pm; u.i1 = pn; u.i2 = 0; u.i3 = 0; return true;
    }
};
struct PanelOrder {
    const char* A; const char* B; int lda, ldb, nM, nN, G, c;
    __device__ __forceinline__ void init(const void* A_, int lda_, const void* B_, int ldb_, int M, int N, int G_, int c_) { A = (const char*)A_; B = (const char*)B_; lda = lda_; ldb = ldb_; nM = M / 256; nN = N / 256; G = G_; c = c_; }
    __device__ __forceinline__ bool next(int i, Unit& u) const {
        const int j = i / nN, pn = i - j * nN, pm = c + j * G; if (pm >= nM) return false;
        u.A = A + (size_t)pm * 256 * lda * 2; u.B = B + (size_t)pn * 256 * ldb * 2; u.i0 = pm; u.i1 = pn; u.i2 = 0; u.i3 = 0; return true;
    }
};
struct GroupOrder {
    const char* A; const char* B; int ldb, nN, nwg, G, c;
    __device__ __forceinline__ void init(const void* A_, const void* B_, int ldb_, int nN_, int G_, int c_) { A = (const char*)A_; B = (const char*)B_; ldb = ldb_; nN = nN_; nwg = 32 * 8 * nN_; G = G_; c = c_; }
    __device__ __forceinline__ bool next(int i, Unit& u) const {
        const long L = (long)i * G + c; if (L >= nwg) return false;
        const int wgid = xcd_remap((int)L, nwg);
        const int per = 8 * nN, g = wgid / per, rem = wgid % per, pm = rem % 8, pn = rem / 8;
        u.A = A + ((size_t)g * UHR + (size_t)pm * 256) * UHK * 2; u.B = B + ((size_t)g * nN * 256 + (size_t)pn * 256) * ldb * 2; u.i0 = g; u.i1 = pm; u.i2 = pn; u.i3 = 0; return true;
    }
};

__device__ __forceinline__ void rope8(f32x4& v0, f32x4& v1, const float* __restrict__ ropec, const float* __restrict__ ropes, int pos, int fq) {
    const f32x4 c = *(const f32x4*)(ropec + pos * 16 + 4 * fq), s = *(const f32x4*)(ropes + pos * 16 + 4 * fq);
    const f32x4 a = v0, b = v1;
    v0 = (f32x4){a[0] * c[0] - a[1] * s[0], a[0] * s[0] + a[1] * c[0], a[2] * c[1] - a[3] * s[1], a[2] * s[1] + a[3] * c[1]};
    v1 = (f32x4){b[0] * c[2] - b[1] * s[2], b[0] * s[2] + b[1] * c[2], b[2] * c[3] - b[3] * s[3], b[2] * s[3] + b[3] * c[3]};
}
__device__ __forceinline__ float sumsq8(const f32x4 a, const f32x4 b) { return (a[0] * a[0] + a[1] * a[1]) + (a[2] * a[2] + a[3] * a[3]) + (b[0] * b[0] + b[1] * b[1]) + (b[2] * b[2] + b[3] * b[3]); }

struct EpiWin {
    static constexpr int PERM = 1; static constexpr int NST = 16;
    bf16_t* UH; bf16_t* CQ; bf16_t* CKVR; float* ssqq; float* ssqkv; const float* ropec; const float* ropes;
    __device__ __forceinline__ void operator()(const f32x4 (&acc)[2][2][4][2], const Unit& u, int wr, int wc, int fr, int fq) const {
        const int pm = u.i0, pn = u.i1, row0 = pm * 256 + wr * 64 + fr;
        if (pn < 2) {
            FX_ROWLOOP { const int row = row0 + ai * 128 + m * 16, r32 = row >> 5, tq = row & 31;
#pragma unroll
                for (int bj = 0; bj < 2; ++bj) { const int c = pn * 256 + wc * 64 + bj * 32 + 8 * fq, g = c >> 4, p0 = c & 15;
                    *(u32x4*)(UH + ((size_t)(g * UHR + r32) * UHK + tq * 16 + p0)) = pack8(acc[ai][bj][m][0], acc[ai][bj][m][1]); } }
        } else if (pn == 2) {
            FX_ROWLOOP { const int row = row0 + ai * 128 + m * 16; float ss = sumsq8(acc[ai][0][m][0], acc[ai][0][m][1]) + sumsq8(acc[ai][1][m][0], acc[ai][1][m][1]);
                store_lines16(CQ + (size_t)(row - fr) * 256 + 64 * wc, 256, pack8(acc[ai][0][m][0], acc[ai][0][m][1]), pack8(acc[ai][1][m][0], acc[ai][1][m][1]), fr, fq);
                ss += __shfl_xor(ss, 16); ss += __shfl_xor(ss, 32);
                if (fq == 0) ssqq[(size_t)row * 4 + wc] = ss; }
        } else {
            FX_ROWLOOP { const int row = row0 + ai * 128 + m * 16; float ss = 0.f; u32x4 w[2];
#pragma unroll
                for (int bj = 0; bj < 2; ++bj) { f32x4 v0 = acc[ai][bj][m][0], v1 = acc[ai][bj][m][1];
                    if (wc < 2) ss += sumsq8(v0, v1);
                    if (wc == 2 && bj == 0) rope8(v0, v1, ropec, ropes, row & (SEQ - 1), fq);
                    w[bj] = pack8(v0, v1); }
                store_lines16(CKVR + (size_t)(row - fr) * 256 + 64 * wc, 256, w[0], w[1], fr, fq);
                ss += __shfl_xor(ss, 16); ss += __shfl_xor(ss, 32);
                if (fq == 0) ssqkv[(size_t)row * 4 + wc] = ss; }
        }
    }
};
struct EpiQ {
    static constexpr int PERM = 1; static constexpr int NST = 16;
    bf16_t* Q; const float* ssqq; const float* ropec; const float* ropes;
    __device__ __forceinline__ void operator()(const f32x4 (&acc)[2][2][4][2], const Unit& u, int wr, int wc, int fr, int fq) const {
        const int pm = u.i0, pn = u.i1, row0 = pm * 256 + wr * 64;
        FX_ROWLOOP { const int row = row0 + fr + ai * 128 + m * 16; const f32x4 s4 = *(const f32x4*)(ssqq + (size_t)row * 4);
            const float rs = __builtin_amdgcn_rsqf(((s4[0] + s4[1]) + (s4[2] + s4[3])) * (1.f / 256.f) + RMS_EPS) * QSCALE;
            u32x4 w[2];
#pragma unroll
            for (int bj = 0; bj < 2; ++bj) { const int G = 8 * pn + 2 * wc + bj;
                f32x4 v0 = acc[ai][bj][m][0] * rs, v1 = acc[ai][bj][m][1] * rs;
                if (G % 3 == 2) rope8(v0, v1, ropec, ropes, row & (SEQ - 1), fq);
                w[bj] = pack8(v0, v1); }
            store_lines16(Q + (size_t)(row0 + ai * 128 + m * 16) * 768 + 256 * pn + 64 * wc, 768, w[0], w[1], fr, fq); }
    }
};
struct EpiKV {
    static constexpr int PERM = 1; static constexpr int NST = 16;
    bf16_t* KV; const float* ssqkv;
    __device__ __forceinline__ void operator()(const f32x4 (&acc)[2][2][4][2], const Unit& u, int wr, int wc, int fr, int fq) const {
        const int pm = u.i0, pn = u.i1, row0 = pm * 256 + wr * 64;
        FX_ROWLOOP { const int row = row0 + fr + ai * 128 + m * 16; const f32x4 s4 = *(const f32x4*)(ssqkv + (size_t)row * 4);
            const float rs = __builtin_amdgcn_rsqf(((s4[0] + s4[1]) + (s4[2] + s4[3])) * (1.f / 128.f) + RMS_EPS);
            store_lines16(KV + (size_t)(row0 + ai * 128 + m * 16) * 1024 + 256 * pn + 64 * wc, 1024, pack8(acc[ai][0][m][0] * rs, acc[ai][0][m][1] * rs), pack8(acc[ai][1][m][0] * rs, acc[ai][1][m][1] * rs), fr, fq); }
    }
};
struct EpiSt {
    static constexpr int PERM = 1; static constexpr int NST = 16;
    bf16_t* S;
    __device__ __forceinline__ void operator()(const f32x4 (&acc)[2][2][4][2], const Unit& u, int wr, int wc, int fr, int fq) const {
        const int g = u.i0, pm = u.i1, row0 = pm * 256 + wr * 64;
        FX_ROWLOOP store_lines16(S + ((size_t)g * UHR + row0 + ai * 128 + m * 16) * 256 + 64 * wc, 256, pack8(acc[ai][0][m][0], acc[ai][0][m][1]), pack8(acc[ai][1][m][0], acc[ai][1][m][1]), fr, fq);
    }
};
struct EpiSsmOut {
    static constexpr int PERM = 1; static constexpr int NST = 16;
    bf16_t* SPRE;
    __device__ __forceinline__ void operator()(const f32x4 (&acc)[2][2][4][2], const Unit& u, int wr, int wc, int fr, int fq) const {
        const int g = u.i0, pm = u.i1, pn = u.i2, row0 = pm * 256 + wr * 64 + fr;
        const int p0 = 8 * (fq & 1);
        FX_ROWLOOP { const int R = row0 + ai * 128 + m * 16;
#pragma unroll
            for (int bj = 0; bj < 2; ++bj) { const int c = 256 * pn + 64 * wc + 32 * bj + 8 * fq, tq = c >> 4;
                f32x4 y0 = acc[ai][bj][m][0], y1 = acc[ai][bj][m][1];
#pragma unroll
                for (int j = 0; j < 4; ++j) { y0[j] = gelu_tanh_f(y0[j]); y1[j] = gelu_tanh_f(y1[j]); }
                *(u32x4*)(SPRE + ((size_t)R * 32 + tq) * SPRE_LD + g * 16 + p0) = pack8(y0, y1); } }
    }
};
struct EpiGlu {
    static constexpr int PERM = 1; static constexpr int NST = 16;
    const bf16_t* SPRE; bf16_t* MIX; const float* bglu;
    __device__ __forceinline__ void operator()(const f32x4 (&acc)[2][2][4][2], const Unit& u, int wr, int wc, int fr, int fq) const {
        const int pm = u.i0, pn = u.i1, row0 = pm * 256 + wr * 64;
        f32x4 b0[2], b1[2];
#pragma unroll
        for (int bj = 0; bj < 2; ++bj) { const int c = 256 * pn + 64 * wc + 32 * bj + 8 * fq; b0[bj] = *(const f32x4*)(bglu + c); b1[bj] = *(const f32x4*)(bglu + c + 4); }
        FX_ROWLOOP { const int row = row0 + fr + ai * 128 + m * 16; u32x4 w[2];
#pragma unroll
            for (int bj = 0; bj < 2; ++bj) { const int c = 256 * pn + 64 * wc + 32 * bj + 8 * fq;
                const u32x4 sw = *(const u32x4*)(SPRE + (size_t)row * SPRE_LD + c); f32x4 s0, s1; unpack8(sw, s0, s1);
                f32x4 z0 = acc[ai][bj][m][0] + b0[bj], z1 = acc[ai][bj][m][1] + b1[bj];
#pragma unroll
                for (int j = 0; j < 4; ++j) { z0[j] = s0[j] * fast_sigmoid(z0[j]); z1[j] = s1[j] * fast_sigmoid(z1[j]); }
                w[bj] = pack8(z0, z1); }
            store_lines16(MIX + (size_t)(row0 + ai * 128 + m * 16) * 1024 + 256 * pn + 64 * wc, 1024, w[0], w[1], fr, fq); }
    }
};
struct EpiWo {
    static constexpr int PERM = 1; static constexpr int NST = 16;
    bf16_t* XY;
    __device__ __forceinline__ void operator()(const f32x4 (&acc)[2][2][4][2], const Unit& u, int wr, int wc, int fr, int fq) const {
        const int pm = u.i0, pn = u.i1, row0 = pm * 256 + wr * 64;
        u32x4 xw[2][4][2];
#pragma unroll
        for (int ai = 0; ai < 2; ++ai)
#pragma unroll
            for (int m = 0; m < 4; ++m)
#pragma unroll
                for (int bj = 0; bj < 2; ++bj) xw[ai][m][bj] = *(const u32x4*)(XY + (size_t)(row0 + fr + ai * 128 + m * 16) * 1024 + 256 * pn + wc * 64 + bj * 32 + 8 * fq);
        asm volatile("s_waitcnt vmcnt(0)" ::: "memory");
        FX_ROWLOOP { u32x4 w[2];
#pragma unroll
            for (int bj = 0; bj < 2; ++bj) { f32x4 x0, x1; unpack8(xw[ai][m][bj], x0, x1); w[bj] = pack8(x0 * ALPHA + acc[ai][bj][m][0], x1 * ALPHA + acc[ai][bj][m][1]); }
            store_lines16(XY + (size_t)(row0 + ai * 128 + m * 16) * 1024 + 256 * pn + 64 * wc, 1024, w[0], w[1], fr, fq); }
    }
};
__device__ __forceinline__ size_t h_off(int row, int col) { return (size_t)(row >> 4) * 4096 + (size_t)(row & 7) * 512 + (size_t)(col >> 5) * 64 + (size_t)((row >> 3) & 1) * 32 + (size_t)(col & 31); }
struct EpiSharedRouter {
    static constexpr int PERM = 1; static constexpr int NST = 0;
    bf16_t* HS; float* LG;
    __device__ __forceinline__ void operator()(const f32x4 (&acc)[2][2][4][2], const Unit& u, int wr, int wc, int fr, int fq) const {
        const int pm = u.i0, pn = u.i1, row0 = pm * 256 + wr * 64 + fr;
        if (pn < 2) {
            const int c = 128 * pn + 32 * wc + 8 * fq;
            FX_ROWLOOP { f32x4 h0, h1;
#pragma unroll
                for (int j = 0; j < 4; ++j) { const float g0 = acc[ai][0][m][0][j], g1 = acc[ai][0][m][1][j];
                    h0[j] = g0 * fast_sigmoid(g0) * acc[ai][1][m][0][j]; h1[j] = g1 * fast_sigmoid(g1) * acc[ai][1][m][1][j]; }
                *(u32x4*)(HS + h_off(row0 + ai * 128 + m * 16, c)) = pack8(h0, h1); }
        } else if (wc == 0) {
            FX_ROWLOOP { float* rp = LG + (size_t)(row0 + ai * 128 + m * 16) * 64 + 8 * fq;
#pragma unroll
                for (int bj = 0; bj < 2; ++bj) { *(f32x4*)(rp + bj * 32) = acc[ai][bj][m][0]; *(f32x4*)(rp + bj * 32 + 4) = acc[ai][bj][m][1]; } }
        }
    }
};

struct MoeTab { LAS int* tbase; LAS unsigned* tab; };
__device__ __forceinline__ MoeTab moe_tab(LAS unsigned char* lds) { MoeTab t; t.tbase = (LAS int*)(lds + TAB_OFF); t.tab = (LAS unsigned*)(lds + TAB_OFF + 2304); return t; }
__device__ __forceinline__ int ve_count(const unsigned* ctl, int ve) { return (ve % 65 == 64) ? CAPC : (int)__hip_atomic_load(ctl + CW_CNT + 64 * ve, __ATOMIC_RELAXED, __HIP_MEMORY_SCOPE_AGENT); }
__device__ __forceinline__ void moe_build_tab(LAS unsigned char* lds, const unsigned* ctl) {
    const MoeTab t = moe_tab(lds); LAS int* nt = (LAS int*)(lds + TAB_OFF + 1024 + 64);
    const int tid = threadIdx.x;
    if (tid < NVE) nt[tid] = (ve_count(ctl, tid) + 255) >> 8;
    __syncthreads();
    if (tid <= NVE) { int s = 0; for (int v = 0; v < tid; ++v) s += nt[v]; t.tbase[tid] = s; }
    __syncthreads();
    for (int v = tid; v < NVE; v += 512) { const int b = t.tbase[v], n = t.tbase[v + 1] - b; for (int j = 0; j < n; ++j) t.tab[b + j] = (unsigned)v | ((unsigned)j << 16); }
    __syncthreads();
}
struct GateUpOrder {
    const char* X1B; const char* WGU; MoeTab tb; LAS int* idx; int nunits, G, c;
    __device__ __forceinline__ int tile_of(int tr) const {
        int tile = 0;
#pragma unroll
        for (int ch = 0; ch < NCH; ++ch) { const int b = tb.tbase[ch * 65], n = tb.tbase[ch * 65 + 64] - b; if (tr >= 0 && tr < n) tile = b + tr; tr -= n; }
        return tile;
    }
    __device__ __forceinline__ void init(LAS unsigned char* lds, const void* x1b, const void* wgu, const int* rowtok, const unsigned* ctl, int G_, int c_) {
        X1B = (const char*)x1b; WGU = (const char*)wgu; tb = moe_tab(lds); idx = (LAS int*)(lds + IDX_OFF); G = G_; c = c_;
        int nr = 0;
#pragma unroll
        for (int ch = 0; ch < NCH; ++ch) nr += tb.tbase[ch * 65 + 64] - tb.tbase[ch * 65];
        nunits = 2 * nr;
        __syncthreads();
        int vals[IDX_UNITS / 2];
#pragma unroll
        for (int i2 = 0; i2 < IDX_UNITS / 2; ++i2) { const int i = 2 * i2 + (int)(threadIdx.x >> 8); const long L = (long)i * G + c; vals[i2] = 0;
            if (L < nunits) { const int tile = tile_of(xcd_remap((int)L, nunits) >> 1); const unsigned e = tb.tab[tile]; const int ve = (int)(e & 0xffffu), tix = (int)(e >> 16), ch = ve / 65, ex = ve % 65;
                const int cnt = ve_count(ctl, ve), slot = tix * 256 + (int)(threadIdx.x & 255);
                vals[i2] = slot < cnt ? rowtok[(size_t)(ch * 64 + ex) * CAPC + slot] : ch * CAPC; } }
#pragma unroll
        for (int i2 = 0; i2 < IDX_UNITS / 2; ++i2) idx[(2 * i2 + (int)(threadIdx.x >> 8)) * 256 + (threadIdx.x & 255)] = vals[i2];
        __syncthreads();
    }
    __device__ __forceinline__ bool next(int i, Unit& u) const {
        const long L = (long)i * G + c; if (L >= nunits) return false;
        const int wgid = xcd_remap((int)L, nunits), tile = tile_of(wgid >> 1), pn = wgid & 1;
        const int ex = (int)(tb.tab[tile] & 0xffffu) % 65;
        u.A = X1B; u.B = WGU + ((size_t)ex * 512 + (size_t)pn * 256) * 1024 * 2; u.i0 = tile * 256; u.i1 = pn; u.i2 = 0; u.i3 = i < IDX_UNITS ? i : IDX_UNITS - 1; return true;
    }
    __device__ __forceinline__ void gather(const Unit& u, int R0, int C0, int R1, int C1, unsigned& g00, unsigned& g01, unsigned& g10, unsigned& g11) const {
        const LAS int* ip = idx + u.i3 * 256;
        g00 = (unsigned)ip[R0] * 2048u + (unsigned)C0 * 2u; g01 = (unsigned)ip[R1] * 2048u + (unsigned)C1 * 2u;
        g10 = (unsigned)ip[128 + R0] * 2048u + (unsigned)C0 * 2u; g11 = (unsigned)ip[128 + R1] * 2048u + (unsigned)C1 * 2u;
    }
};
struct EpiGateUp {
    static constexpr int PERM = 1; static constexpr int NST = 8;
    bf16_t* H;
    __device__ __forceinline__ void operator()(const f32x4 (&acc)[2][2][4][2], const Unit& u, int wr, int wc, int fr, int fq) const {
        const int hrow0 = u.i0 + wr * 64 + fr, c = 128 * u.i1 + 32 * wc + 8 * fq;
        FX_ROWLOOP { f32x4 h0, h1;
#pragma unroll
            for (int j = 0; j < 4; ++j) { const float g0 = acc[ai][0][m][0][j], g1 = acc[ai][0][m][1][j];
                h0[j] = g0 * fast_sigmoid(g0) * acc[ai][1][m][0][j]; h1[j] = g1 * fast_sigmoid(g1) * acc[ai][1][m][1][j]; }
            *(u32x4*)(H + h_off(hrow0 + ai * 128 + m * 16, c)) = pack8(h0, h1); }
    }
};
struct DownOrder {
    const char* Hh; const char* HS; const char* WD; MoeTab tb; int t0, nunits, G, c, chn;
    __device__ __forceinline__ void init(const void* h, const void* hs, const void* wd, MoeTab tb_, int ch, int G_, int c_) { Hh = (const char*)h; HS = (const char*)hs; WD = (const char*)wd; tb = tb_; chn = ch; t0 = tb_.tbase[ch * 65]; nunits = 4 * (tb_.tbase[(ch + 1) * 65] - t0); G = G_; c = c_; }
    __device__ __forceinline__ bool next(int i, Unit& u) const {
        const long L = (long)i * G + c; if (L >= nunits) return false;
        const int wgid = xcd_remap((int)L, nunits), tile = t0 + (wgid >> 2), pn = wgid & 3;
        const int ex = (int)(tb.tab[tile] & 0xffffu) % 65;
        u.A = ex == 64 ? HS + ((size_t)chn * CAPC + (size_t)(tb.tab[tile] >> 16) * 256) * 256 * 2 : Hh + (size_t)tile * 256 * 256 * 2; u.B = WD + ((size_t)ex * 1024 + (size_t)pn * 256) * 256 * 2; u.i0 = ex == 64 ? (int)(tb.tab[tile] >> 16) * 256 : (tile - t0) * 256; u.i1 = pn; u.i2 = ex == 64; u.i3 = 0; return true;
    }
};
constexpr float Y8_SCALE = 16.f, Y8_INV = 1.f / 16.f;
__device__ __forceinline__ u32x2 pack8_fp8(const f32x4 a, const f32x4 b) {
    int w0 = 0, w1 = 0;
    w0 = __builtin_amdgcn_cvt_pk_fp8_f32(a[0] * Y8_SCALE, a[1] * Y8_SCALE, w0, false); w0 = __builtin_amdgcn_cvt_pk_fp8_f32(a[2] * Y8_SCALE, a[3] * Y8_SCALE, w0, true);
    w1 = __builtin_amdgcn_cvt_pk_fp8_f32(b[0] * Y8_SCALE, b[1] * Y8_SCALE, w1, false); w1 = __builtin_amdgcn_cvt_pk_fp8_f32(b[2] * Y8_SCALE, b[3] * Y8_SCALE, w1, true);
    u32x2 r; r.x = (unsigned)w0; r.y = (unsigned)w1; return r;
}
__device__ __forceinline__ void unpack8_fp8(const u32x2 w, f32x4& a, f32x4& b) {
    const f32x2 p0 = __builtin_amdgcn_cvt_pk_f32_fp8((int)w.x, false), p1 = __builtin_amdgcn_cvt_pk_f32_fp8((int)w.x, true);
    const f32x2 p2 = __builtin_amdgcn_cvt_pk_f32_fp8((int)w.y, false), p3 = __builtin_amdgcn_cvt_pk_f32_fp8((int)w.y, true);
    a = (f32x4){p0.x, p0.y, p1.x, p1.y}; b = (f32x4){p2.x, p2.y, p3.x, p3.y};
}
__device__ __forceinline__ size_t y8_off(int row, int col) { return (size_t)row * 1024 + (size_t)col; }
template <int STORE = 1> struct EpiDownT {
    static constexpr int PERM = 2; static constexpr int NST = 8;
    unsigned char* Y8; bf16_t* YS; LAS unsigned char* lds;
    __device__ __forceinline__ void operator()(const f32x4 (&acc)[2][2][4][2], const Unit& u, int wr, int wc, int fr, int fq) const {
        const int yrow0 = u.i0 + wr * 64, c0 = 256 * u.i1 + 64 * wc + 16 * fq;
        if (u.i2) {
            const bool lo = fr < 8;
            FX_ROWLOOP { const u32x4 X = pack8(acc[ai][0][m][0], acc[ai][0][m][1]), Y = pack8(acc[ai][1][m][0], acc[ai][1][m][1]);
                const u32x4 S = lo ? Y : X, R = ror8_x4(S); const u32x4 A1 = lo ? X : R, A2 = lo ? R : Y;
                bf16_t* p = YS + (size_t)(yrow0 + ai * 128 + m * 16 + (fr & 7)) * 1024 + c0 + (lo ? 0 : 8);
                *(u32x4*)p = A1; *(u32x4*)(p + 8 * 1024) = A2; }
        } else {
            FX_ROWLOOP { unsigned char* rp = Y8 + y8_off(yrow0 + ai * 128 + m * 16 + fr, c0);
                const u32x2 lo = pack8_fp8(acc[ai][0][m][0], acc[ai][0][m][1]), hi = pack8_fp8(acc[ai][1][m][0], acc[ai][1][m][1]);
                u32x4 w; w.x = lo.x; w.y = lo.y; w.z = hi.x; w.w = hi.y; *(u32x4*)rp = w; }
        }
    }
};
typedef EpiDownT<1> EpiDown;
}
namespace fx {
namespace att {
constexpr int NW = 8, QBLK = 32, KVBLK = 64;
constexpr int SHM_V = 16384, SHM_K = 16384;
constexpr float THRL = 8.f;
#define KSWZ(row, colB) ((row) * 256 + ((colB) ^ (((row) & 7) << 4)))
#define SBAR() __builtin_amdgcn_sched_barrier(0)
__device__ __forceinline__ int crow(int r, int hi) { return (r & 3) + 8 * (r >> 2) + 4 * hi; }
__device__ __forceinline__ float bf16_round(float x) { return __uint_as_float(cvt_pk_bf16(x, 0.f) << 16); }
template <bool FIRST> __device__ __forceinline__ void partialSM(f32x16& p0, f32x16& p1, float& m_reg, float& alpha, bf16x8& qm, int hi) {
  float mx0 = fmaxf(p0[0], p0[1]), mx1 = fmaxf(p0[8], p0[9]), mx2 = fmaxf(p1[0], p1[1]), mx3 = fmaxf(p1[8], p1[9]);
#pragma unroll
  for (int r = 2; r < 8; ++r) { mx0 = fmaxf(mx0, p0[r]); mx1 = fmaxf(mx1, p0[8 + r]); mx2 = fmaxf(mx2, p1[r]); mx3 = fmaxf(mx3, p1[8 + r]); }
  float pmax = fmaxf(fmaxf(mx0, mx1), fmaxf(mx2, mx3));
  { auto rr = __builtin_amdgcn_permlane32_swap(__float_as_uint(pmax), __float_as_uint(pmax), false, false);
    pmax = fmaxf(__uint_as_float(rr[0]), __uint_as_float(rr[1])); }
  if (!FIRST && __builtin_expect(__all(pmax <= THRL), 1)) { alpha = 1.f; }
  else {
    const float mnew = bf16_round(FIRST ? pmax : m_reg + fmaxf(pmax, 0.f)), delta = mnew - m_reg;
    alpha = FIRST ? 1.f : __builtin_amdgcn_exp2f(-delta); m_reg = mnew;
    qm[0] = hi == 0 ? (short)(cvt_pk_bf16(-mnew, 0.f) & 0xffffu) : (short)0;
#pragma unroll
    for (int r = 0; r < 16; ++r) p0[r] = p0[r] - delta;
#pragma unroll
    for (int r = 0; r < 16; ++r) p1[r] = p1[r] - delta;
  }
#pragma unroll
  for (int r = 0; r < 16; ++r) p0[r] = __builtin_amdgcn_exp2f(p0[r]);
}
__device__ __forceinline__ void finishSM(f32x16& p0, f32x16& p1, float alpha, float& l_reg, bf16x8& pa0, bf16x8& pa1, bf16x8& pa2, bf16x8& pa3) {
#pragma unroll
  for (int r = 0; r < 16; ++r) p1[r] = __builtin_amdgcn_exp2f(p1[r]);
  float ps0 = p0[0], ps1 = p0[8], ps2 = p1[0], ps3 = p1[8];
#pragma unroll
  for (int r = 1; r < 8; ++r) { ps0 += p0[r]; ps1 += p0[8 + r]; ps2 += p1[r]; ps3 += p1[8 + r]; }
  float ps = (ps0 + ps1) + (ps2 + ps3);
  { auto rr = __builtin_amdgcn_permlane32_swap(__float_as_uint(ps), __float_as_uint(ps), false, false);
    ps = __uint_as_float(rr[0]) + __uint_as_float(rr[1]); }
  l_reg = l_reg * alpha + ps;
#define PK4(P, BASE, OUT) do { unsigned a0 = cvt_pk_bf16(P[BASE + 0], P[BASE + 1]), a1 = cvt_pk_bf16(P[BASE + 2], P[BASE + 3]);   \
    unsigned b0 = cvt_pk_bf16(P[BASE + 4], P[BASE + 5]), b1 = cvt_pk_bf16(P[BASE + 6], P[BASE + 7]);                              \
    auto r0 = __builtin_amdgcn_permlane32_swap(a0, b0, false, false); auto r1 = __builtin_amdgcn_permlane32_swap(a1, b1, false, false); \
    u32x4 w = {r0[0], r1[0], r0[1], r1[1]}; OUT = *reinterpret_cast<bf16x8*>(&w); } while (0)
  PK4(p0, 0, pa0); PK4(p0, 8, pa1); PK4(p1, 0, pa2); PK4(p1, 8, pa3);
#undef PK4
}
__device__ __forceinline__ void qkt(f32x16& p0, f32x16& p1, const char* Ks, const bf16x8 (&qr)[6], const bf16x8 kone, const bf16x8 qm, int r32, int hi) {
  p0 = f32x16{}; p1 = f32x16{};
#pragma unroll
  for (int d0 = 0; d0 < 6; ++d0) { const int cb = (d0 * 16 + hi * 8) * 2;
    const bf16x8 b0 = *reinterpret_cast<const bf16x8*>(Ks + KSWZ(r32, cb));
    const bf16x8 b1 = *reinterpret_cast<const bf16x8*>(Ks + KSWZ(32 + r32, cb));
    p0 = __builtin_amdgcn_mfma_f32_32x32x16_bf16(b0, qr[d0], p0, 0, 0, 0);
    p1 = __builtin_amdgcn_mfma_f32_32x32x16_bf16(b1, qr[d0], p1, 0, 0, 0); }
  p0 = __builtin_amdgcn_mfma_f32_32x32x16_bf16(kone, qm, p0, 0, 0, 0);
  p1 = __builtin_amdgcn_mfma_f32_32x32x16_bf16(kone, qm, p1, 0, 0, 0);
}
__device__ __forceinline__ int v_st(int k, int c) { const int kk = (k & ~0xC) | ((k & 4) << 1) | ((k & 8) >> 1); return ((kk >> 3) * 4 + (c >> 5)) * 512 + ((kk & 7) * 32 + (c & 31)) * 2; }
__device__ __forceinline__ int v_rd_base(int lane) { return ((lane & 3) << 3) | (((lane >> 2) & 3) << 6) | (((lane >> 4) & 1) << 5) | (((lane >> 5) & 1) << 8); }
constexpr int v_rd_off(int d0, int ks, int half) { return d0 * 512 + ks * 4096 + half * 2048; }
template <int OFF> __device__ __forceinline__ s16x4 tr_read(int vb) {
  s16x4 r; asm volatile("ds_read_b64_tr_b16 %0, %1 offset:%2" : "=&v"(r) : "v"(vb), "i"(OFF) : "memory"); return r;
}
template <int D0> __device__ __forceinline__ void pv_one(f32x16& od, int vb, bf16x8 pa0, bf16x8 pa1, bf16x8 pa2, bf16x8 pa3) {
  const s16x4 l0 = tr_read<v_rd_off(D0, 0, 0)>(vb), h0 = tr_read<v_rd_off(D0, 0, 1)>(vb), l1 = tr_read<v_rd_off(D0, 1, 0)>(vb), h1 = tr_read<v_rd_off(D0, 1, 1)>(vb);
  const s16x4 l2 = tr_read<v_rd_off(D0, 2, 0)>(vb), h2 = tr_read<v_rd_off(D0, 2, 1)>(vb), l3 = tr_read<v_rd_off(D0, 3, 0)>(vb), h3 = tr_read<v_rd_off(D0, 3, 1)>(vb);
  asm volatile("s_waitcnt lgkmcnt(0)" ::: "memory"); SBAR();
#define PK(L, H) (bf16x8){L[0], L[1], L[2], L[3], H[0], H[1], H[2], H[3]}
  od = __builtin_amdgcn_mfma_f32_32x32x16_bf16(pa0, PK(l0, h0), od, 0, 0, 0);
  od = __builtin_amdgcn_mfma_f32_32x32x16_bf16(pa1, PK(l1, h1), od, 0, 0, 0);
  od = __builtin_amdgcn_mfma_f32_32x32x16_bf16(pa2, PK(l2, h2), od, 0, 0, 0);
  od = __builtin_amdgcn_mfma_f32_32x32x16_bf16(pa3, PK(l3, h3), od, 0, 0, 0);
#undef PK
}
__device__ __forceinline__ void pv_d0(f32x16 (&o)[2], int vb, bf16x8 pa0, bf16x8 pa1, bf16x8 pa2, bf16x8 pa3) {
  pv_one<0>(o[0], vb, pa0, pa1, pa2, pa3); pv_one<1>(o[1], vb, pa0, pa1, pa2, pa3);
}
__device__ __forceinline__ void attn_unit(const unsigned char* __restrict__ wsb, const bf16_t* __restrict__ Q, bf16_t* __restrict__ MIX, int tok0, int qrow0, int h, char* lds) {
  int tid = threadIdx.x; asm volatile("" : "+v"(tid));
  const int wid = __builtin_amdgcn_readfirstlane(tid >> 6), lane = tid & 63, r32 = lane & 31, hi = lane >> 5;
  char* K_lds = lds; char* V_lds = lds + 4 * SHM_K;
  float* ws = (float*)(lds + TAB_OFF) + wid * 64; float* li_l = ws; float* al_l = ws + 32;
  float m_reg = 0.f, l_reg = 0; f32x16 o[2] = {}; bf16x8 qr[6];
  const bf16_t* Qw = Q + (size_t)(tok0 + qrow0 + wid * QBLK + r32) * 768 + h * 96 + hi * 8;
#pragma unroll
  for (int d0 = 0; d0 < 6; ++d0) qr[d0] = *reinterpret_cast<const bf16x8*>(Qw + d0 * 16);
  const int vb0 = (int)(uintptr_t)V_lds + v_rd_base(lane);
  const int ra = tid / 12, ca = tid % 12, rb = (512 + tid) / 12, cb = (512 + tid) % 12, rv = tid >> 3, cv = tid & 7;
  const unsigned kinca = ca < 8 ? 64u * 2048u : 64u * 512u, kincb = cb < 8 ? 64u * 2048u : 64u * 512u;
  const unsigned kofa = ca < 8 ? (unsigned)WS_KV + (unsigned)(((tok0 + ra) * 1024 + h * 128 + ca * 8) * 2) : (unsigned)WS_CKVR + (unsigned)(((tok0 + ra) * 256 + 128 + (ca - 8) * 8) * 2);
  const unsigned kofb = cb < 8 ? (unsigned)WS_KV + (unsigned)(((tok0 + rb) * 1024 + h * 128 + cb * 8) * 2) : (unsigned)WS_CKVR + (unsigned)(((tok0 + rb) * 256 + 128 + (cb - 8) * 8) * 2);
  const unsigned vofs = (unsigned)WS_KV + (unsigned)(((tok0 + rv) * 1024 + h * 128 + 64 + cv * 8) * 2);
  const int ksta = KSWZ(ra, ca * 16), kstb = KSWZ(rb, cb * 16), vst = v_st(rv, cv * 8);
  const bool two = wid < 4;
  bf16x8 RK0a, RK0b, RV0, RK1a, RK1b, RV1;
#define TLOAD(KA, KB, VV, t) do { KA = *reinterpret_cast<const bf16x8*>(wsb + kofa + (unsigned)(t) * kinca); if (two) KB = *reinterpret_cast<const bf16x8*>(wsb + kofb + (unsigned)(t) * kincb); \
    VV = *reinterpret_cast<const bf16x8*>(wsb + vofs + (unsigned)(t) * (64u * 2048u)); } while (0)
#define TWRITE(KA, KB, VV, b) do { constexpr int bo_ = (b) * SHM_K; *(bf16x8*)(K_lds + bo_ + ksta) = KA; if (two) *(bf16x8*)(K_lds + bo_ + kstb) = KB; *(bf16x8*)(V_lds + bo_ + vst) = VV; } while (0)
#define RESC(a) do { if (__any((a) < 1.f)) { if (hi == 0) al_l[r32] = (a); asm volatile("s_waitcnt lgkmcnt(0)" ::: "memory"); \
    _Pragma("unroll") for (int d = 0; d < 2; ++d) _Pragma("unroll") for (int r = 0; r < 16; ++r) o[d][r] *= al_l[crow(r, hi)]; } } while (0)
#define STEP_END() do { asm volatile("s_waitcnt lgkmcnt(0)" ::: "memory"); __builtin_amdgcn_s_barrier(); asm volatile("" ::: "memory"); } while (0)
  f32x16 pA0, pA1, pB0, pB1; float alA, alB; bf16x8 pa0, pa1, pa2, pa3; constexpr int NT = SEQ / KVBLK;
  bf16x8 kone = {}, qm = {}; kone[0] = hi == 0 ? (short)0x3F80 : (short)0;
  m_reg = 0.f;
#define ATT_STEP(PC0, PC1, ALC, PP0, PP1, ALP, KB, VB, WB, RKA, RKB, RVV, S) do { \
    SBAR(); qkt(PC0, PC1, K_lds + (KB) * SHM_K, qr, kone, qm, r32, hi); \
    finishSM(PP0, PP1, ALP, l_reg, pa0, pa1, pa2, pa3); SBAR(); \
    if ((S) + 1 < NT) TWRITE(RKA, RKB, RVV, WB); \
    if ((S) + 3 < NT) TLOAD(RKA, RKB, RVV, (S) + 3); \
    SBAR(); \
    pv_d0(o, vb0 + (VB) * SHM_V, pa0, pa1, pa2, pa3); partialSM<false>(PC0, PC1, m_reg, ALC, qm, hi); \
    RESC(ALC); STEP_END(); } while (0)
  TLOAD(RK0a, RK0b, RV0, 0); TWRITE(RK0a, RK0b, RV0, 0); TLOAD(RK1a, RK1b, RV1, 1); TLOAD(RK0a, RK0b, RV0, 2);
  STEP_END();
  qkt(pA0, pA1, K_lds, qr, kone, qm, r32, hi); partialSM<true>(pA0, pA1, m_reg, alA, qm, hi);
  TWRITE(RK1a, RK1b, RV1, 1); TLOAD(RK1a, RK1b, RV1, 3);
  STEP_END();
  for (int s = 1; s + 3 < NT - 2; s += 4) {
    ATT_STEP(pB0, pB1, alB, pA0, pA1, alA, 1, 0, 2, RK0a, RK0b, RV0, s);
    ATT_STEP(pA0, pA1, alA, pB0, pB1, alB, 2, 1, 3, RK1a, RK1b, RV1, s + 1);
    ATT_STEP(pB0, pB1, alB, pA0, pA1, alA, 3, 2, 0, RK0a, RK0b, RV0, s + 2);
    ATT_STEP(pA0, pA1, alA, pB0, pB1, alB, 0, 3, 1, RK1a, RK1b, RV1, s + 3);
  }
  ATT_STEP(pB0, pB1, alB, pA0, pA1, alA, 1, 0, 2, RK0a, RK0b, RV0, NT - 3);
  ATT_STEP(pA0, pA1, alA, pB0, pB1, alB, 2, 1, 3, RK1a, RK1b, RV1, NT - 2);
  SBAR(); qkt(pB0, pB1, K_lds + 3 * SHM_K, qr, kone, qm, r32, hi);
  finishSM(pA0, pA1, alA, l_reg, pa0, pa1, pa2, pa3); SBAR();
  pv_d0(o, vb0 + 2 * SHM_V, pa0, pa1, pa2, pa3); partialSM<false>(pB0, pB1, m_reg, alB, qm, hi);
  RESC(alB);
  finishSM(pB0, pB1, alB, l_reg, pa0, pa1, pa2, pa3); SBAR();
  pv_d0(o, vb0 + 3 * SHM_V, pa0, pa1, pa2, pa3);
  if (hi == 0) li_l[r32] = l_reg;
  STEP_END();
  char* st = lds + wid * 4096;
#pragma unroll
  for (int r = 0; r < 16; ++r) { const int orow = crow(r, hi); const float rl = __builtin_amdgcn_rcpf(li_l[orow]);
#pragma unroll
    for (int d0 = 0; d0 < 2; ++d0) *(bf16_t*)(st + orow * 128 + (d0 * 32 + r32) * 2) = (bf16_t)(cvt_pk_bf16(o[d0][r] * rl, 0.f) & 0xffffu); }
  asm volatile("s_waitcnt lgkmcnt(0)" ::: "memory");
  bf16_t* Ow = MIX + (size_t)(tok0 + qrow0 + wid * QBLK) * 1024 + 512 + h * 64;
#pragma unroll
  for (int j = 0; j < 4; ++j) { const int q = lane + 64 * j; const u32x4 v = *(const u32x4*)(st + (q >> 3) * 128 + (q & 7) * 16); *(u32x4*)(Ow + (size_t)(q >> 3) * 1024 + (q & 7) * 8) = v; }
  STEP_END();
#undef TLOAD
#undef TWRITE
#undef RESC
#undef STEP_END
#undef ATT_STEP
}
#undef KSWZ
#undef SBAR
}

struct Frame {
    LAS unsigned char* lds; unsigned* ctl; unsigned char* ws; float* out; const float* in[29];
    int tid, lane, wave, G, bid;
};
enum { I_X = 0, I_WIN, I_LRE, I_LIM, I_LDT, I_BRE, I_BIM, I_CRE, I_CIM, I_DSK, I_WGLU, I_BGLU, I_QG, I_WUQ, I_KVG, I_WUKV, I_WO, I_LN1G, I_LN1B, I_WR, I_RB, I_WEG, I_WEU, I_WED, I_WSG, I_WSU, I_WSD, I_LN2G, I_LN2B };

#ifndef MK_TPROBE
#define MK_TPROBE -1
#endif
#define TSUB(F, id) do { if (MK_TPROBE >= 100) { __syncthreads(); if (blockIdx.x == 0 && threadIdx.x == 0) { volatile LAS unsigned* M_ = (volatile LAS unsigned*)((F).lds + MISC_OFF); const unsigned long long tn_ = __builtin_amdgcn_s_memrealtime(); \
    const unsigned long long tl_ = ((unsigned long long)M_[17] << 32) | M_[16]; if ((id) == MK_TPROBE) { const unsigned long long d_ = tn_ - tl_; M_[18] = (unsigned)d_; M_[19] = (unsigned)(d_ >> 32); } M_[16] = (unsigned)tn_; M_[17] = (unsigned)(tn_ >> 32); } } } while (0)
__device__ __forceinline__ int fresh_lane() { int l = (int)(threadIdx.x & 63u); asm volatile("" : "+v"(l)); return l; }
template <class F> __device__ __forceinline__ void transpose_load(const F& f, int k0, int n0, int lane, float (&tv)[32]) {
#pragma unroll
    for (int i = 0; i < 32; ++i) tv[i] = f(k0 + 2 * i + (lane >> 5), n0 + (lane & 31));
}
__device__ __forceinline__ void transpose_store(const float (&tv)[32], bf16_t* Bt, int ldk, int k0, int n0, LAS float* scr, int lane) {
#pragma unroll
    for (int i = 0; i < 32; ++i) scr[(2 * i + (lane >> 5)) * 33 + (lane & 31)] = tv[i];
    asm volatile("s_waitcnt lgkmcnt(0)" ::: "memory");
    const int c = lane & 7;
#pragma unroll
    for (int j = 0; j < 4; ++j) { const int n = (lane >> 3) + 8 * j; const LAS float* s = scr + (8 * c) * 33 + n;
        u32x4 o; o.x = cvt_pk_bf16(s[0 * 33], s[1 * 33]); o.y = cvt_pk_bf16(s[2 * 33], s[3 * 33]); o.z = cvt_pk_bf16(s[4 * 33], s[5 * 33]); o.w = cvt_pk_bf16(s[6 * 33], s[7 * 33]);
        *(u32x4*)(Bt + (size_t)(n0 + n) * ldk + k0 + 8 * c) = o; }
    asm volatile("s_waitcnt lgkmcnt(0)" ::: "memory");
}
template <class F> __device__ __forceinline__ void transpose_item(const F& f, bf16_t* Bt, int ldk, int k0, int n0, LAS float* scr, int lane) {
    float tv[32]; transpose_load(f, k0, n0, lane, tv); transpose_store(tv, Bt, ldk, k0, n0, scr, lane);
}
__device__ __forceinline__ int rope_perm_src(int p) { return (p & 1) ? 16 + (p >> 1) : (p >> 1); }
struct SsmPar { float lr, li, dt, kr, ki; };
__device__ __forceinline__ SsmPar ssm_par(const float* lam_re, const float* lam_im, const float* log_dt, int d, int g, int n) {
    SsmPar p; p.lr = fminf(lam_re[(d * 32 + g) * 64 + n], -1e-4f); p.li = lam_im[(d * 32 + g) * 64 + n]; p.dt = expf(log_dt[d * 32 + g]);
    const float x = p.lr * p.dt, th = p.li * p.dt;
    const float em1 = expm1f(x), cs = cosf(th), sn = sinf(th), sh = sinf(0.5f * th);
    const float ai = (em1 + 1.f) * sn, arm1 = em1 * cs - 2.f * sh * sh, den = p.lr * p.lr + p.li * p.li;
    p.kr = (arm1 * p.lr + ai * p.li) / den; p.ki = (ai * p.lr - arm1 * p.li) / den; return p;
}
__device__ __forceinline__ void ssm_pow_xt(float x, float th, float e, float& pr, float& pi) {
    const float mag = __builtin_amdgcn_exp2f(x * e * 1.4426950408889634f); double trd = (double)th * (double)e * 0.15915494309189535; trd -= rint(trd); const float tr = (float)trd;
    pr = mag * __builtin_amdgcn_cosf(tr); pi = mag * __builtin_amdgcn_sinf(tr);
}
__device__ __forceinline__ void ssm_pow(const SsmPar& p, float e, float& pr, float& pi) { ssm_pow_xt(p.lr * p.dt, p.li * p.dt, e, pr, pi); }

__device__ __forceinline__ void p0_ssm_item(Frame& F, int g, int j) {
    LAS float* Pr = (LAS float*)F.lds;
    LAS float* Pi = Pr + 2 * 64 * 33;
    LAS float* Br = Pi + 2 * 64 * 33;
    LAS float* Bi = Br + 2 * 64 * 16;
    LAS float* Cr = Bi + 2 * 64 * 16;
    LAS float* Ci = Cr + 2 * 16 * 64;
    LAS float* Par = Ci + 2 * 16 * 64;
    const float* lam_re = F.in[I_LRE]; const float* lam_im = F.in[I_LIM]; const float* log_dt = F.in[I_LDT];
    __syncthreads();
    if (F.tid < 128) { const SsmPar p = ssm_par(lam_re, lam_im, log_dt, F.tid >> 6, g, F.tid & 63); Par[F.tid * 4] = p.lr * p.dt; Par[F.tid * 4 + 1] = p.li * p.dt; Par[F.tid * 4 + 2] = p.kr; Par[F.tid * 4 + 3] = p.ki; }
    for (int idx = F.tid; idx < 2 * 16 * 64; idx += 512) { const int n = idx & 63, pp = (idx >> 6) & 15, d = idx >> 10;
        Cr[idx] = F.in[I_CRE][((d * 32 + g) * 16 + pp) * 64 + n]; Ci[idx] = F.in[I_CIM][((d * 32 + g) * 16 + pp) * 64 + n]; }
    __syncthreads();
    for (int idx = F.tid; idx < 2 * 64 * 33; idx += 512) { const int tau = idx % 33, dn = idx / 33; float pr, pi; ssm_pow_xt(Par[dn * 4], Par[dn * 4 + 1], (float)tau, pr, pi); Pr[idx] = pr; Pi[idx] = pi; }
    for (int idx = F.tid; idx < 2 * 64 * 16; idx += 512) { const int q = idx & 15, dn = idx >> 4, n = dn & 63, d = dn >> 6; const float kr = Par[dn * 4 + 2], ki = Par[dn * 4 + 3];
        const float br = F.in[I_BRE][((d * 32 + g) * 64 + n) * 16 + q], bi = F.in[I_BIM][((d * 32 + g) * 64 + n) * 16 + q];
        Br[idx] = kr * br - ki * bi; Bi[idx] = kr * bi + ki * br; }
    __syncthreads();
    float* Kt = (float*)(F.ws + WS_KT) + (size_t)g * 16384;
    { const int blk = 512 * j + F.tid;
      const int q2 = blk & 7, p2 = (blk >> 3) & 7, tau = (blk >> 6) & 31, d = blk >> 11; float s00 = 0.f, s01 = 0.f, s10 = 0.f, s11 = 0.f;
      for (int n = 0; n < 64; ++n) { const float pr = Pr[(d * 64 + n) * 33 + tau], pi = Pi[(d * 64 + n) * 33 + tau];
          const float b0r = Br[(d * 64 + n) * 16 + 2 * q2], b0i = Bi[(d * 64 + n) * 16 + 2 * q2], b1r = Br[(d * 64 + n) * 16 + 2 * q2 + 1], b1i = Bi[(d * 64 + n) * 16 + 2 * q2 + 1];
          const float d0r = pr * b0r - pi * b0i, d0i = pr * b0i + pi * b0r, d1r = pr * b1r - pi * b1i, d1i = pr * b1i + pi * b1r;
          const float c0r = Cr[(d * 16 + 2 * p2) * 64 + n], c0i = Ci[(d * 16 + 2 * p2) * 64 + n], c1r = Cr[(d * 16 + 2 * p2 + 1) * 64 + n], c1i = Ci[(d * 16 + 2 * p2 + 1) * 64 + n];
          s00 += c0r * d0r - c0i * d0i; s01 += c0r * d1r - c0i * d1i; s10 += c1r * d0r - c1i * d0i; s11 += c1r * d1r - c1i * d1i; }
      float* kp = Kt + ((size_t)(d * 32 + tau) * 16 + 2 * p2) * 16 + 2 * q2; kp[0] = s00; kp[1] = s01; kp[16] = s10; kp[17] = s11; }
    bf16_t* Wst = (bf16_t*)(F.ws + WS_WST) + (size_t)g * 256 * 512;
    for (int pc = F.tid; pc < 32 * 64; pc += 512) { const int row = 32 * j + (pc >> 6), k0 = (pc & 63) * 8, s = k0 >> 4, q0 = k0 & 15;
        const int d = row >> 7, ri = (row >> 6) & 1, n = row & 63, e = d ? s : (CHK - 1 - s);
        const float pr = Pr[(d * 64 + n) * 33 + e], pi = Pi[(d * 64 + n) * 33 + e]; float v[8];
#pragma unroll
        for (int t = 0; t < 8; ++t) { const float br = Br[(d * 64 + n) * 16 + q0 + t], bi = Bi[(d * 64 + n) * 16 + q0 + t]; v[t] = ri ? (pr * bi + pi * br) : (pr * br - pi * bi); }
        u32x4 o; o.x = cvt_pk_bf16(v[0], v[1]); o.y = cvt_pk_bf16(v[2], v[3]); o.z = cvt_pk_bf16(v[4], v[5]); o.w = cvt_pk_bf16(v[6], v[7]);
        *(u32x4*)(Wst + (size_t)row * 512 + k0) = o; }
    bf16_t* Mo = (bf16_t*)(F.ws + WS_MO) + (size_t)g * 512 * UHK;
    for (int pc = F.tid; pc < 64 * 32; pc += 512) { const int row = 64 * j + (pc >> 5), kk = (pc & 31) * 8, d = kk >> 7, ri = (kk >> 6) & 1, n0 = kk & 63, tq = row >> 4, pp = row & 15;
        const int e = d ? (CHK - tq) : (tq + 1); float v[8];
#pragma unroll
        for (int t = 0; t < 8; ++t) { const int n = n0 + t; const float pr = Pr[(d * 64 + n) * 33 + e], pi = Pi[(d * 64 + n) * 33 + e], cr = Cr[(d * 16 + pp) * 64 + n], ci = Ci[(d * 16 + pp) * 64 + n];
            v[t] = ri ? -(cr * pi + ci * pr) : (cr * pr - ci * pi); }
        u32x4 o; o.x = cvt_pk_bf16(v[0], v[1]); o.y = cvt_pk_bf16(v[2], v[3]); o.z = cvt_pk_bf16(v[4], v[5]); o.w = cvt_pk_bf16(v[6], v[7]);
        *(u32x4*)(Mo + (size_t)row * UHK + 512 + kk) = o; }
}

template <int PART> __device__ __forceinline__ void p0_prologue(Frame& F) {
    const int lane = fresh_lane();
    if (PART == 1) {
        for (int it = F.bid; it < 256; it += F.G) p0_ssm_item(F, it >> 3, it & 7);
        __syncthreads();
    }
    if (PART == 0) {
        float* rc = (float*)(F.ws + WS_ROPE); float* rs = rc + 2048 * 16;
        for (int idx = F.bid * 512 + F.tid; idx < 2048 * 16; idx += F.G * 512) { const int i = idx & 15, pos = idx >> 4;
            const float inv = expf(-9.210340371976184f * (float)i * (1.f / 16.f)); const float a = (float)pos * inv; rc[idx] = cosf(a); rs[idx] = sinf(a); } }
    LAS float* scr = (LAS float*)(F.lds + F.wave * 16384);
    const int gw = F.bid * 8 + F.wave, NGW = F.G * 8;
    constexpr int I_A = 512, I_B = 128, I_C = 96, I_D = 128, I_E = 128, I_F = 512, I_G = 65 * 256, I_H = 65 * 128;
    constexpr int NITEMS = I_A + I_B + I_C + I_D + I_E + I_F + I_G + I_H;
    for (int it = (PART == 0 ? gw : I_A + gw); it < (PART == 0 ? I_A : NITEMS); it += NGW) {
        int r = it;
        if (r < I_A) { const float* W = F.in[I_WIN]; const int kb = r / 32, nb = r % 32;
            transpose_item([&](int k, int n) -> float { if (n >= 928) return 0.f; const int src = n < 896 ? n : 896 + rope_perm_src(n - 896); return W[(size_t)k * 928 + src]; }, (bf16_t*)(F.ws + WS_WIN), 1024, kb * 64, nb * 32, scr, lane); continue; } r -= I_A;
        if (r < I_B) { const float* W = F.in[I_WGLU]; const int kb = r / 16, nb = r % 16;
            transpose_item([&](int k, int n) -> float { return W[(size_t)k * 512 + n]; }, (bf16_t*)(F.ws + WS_WGLU), 512, kb * 64, nb * 32, scr, lane); continue; } r -= I_B;
        if (r < I_C) { const float* W = F.in[I_WUQ]; const float* gq = F.in[I_QG]; const int kb = r / 24, nb = r % 24;
            transpose_item([&](int k, int n) -> float { const int hh = n / 96, jj = n % 96; const int src = jj < 64 ? n : hh * 96 + 64 + rope_perm_src(jj - 64); return W[(size_t)k * 768 + src] * gq[k]; }, (bf16_t*)(F.ws + WS_WUQ), 256, kb * 64, nb * 32, scr, lane); continue; } r -= I_C;
        if (r < I_D) { const float* W = F.in[I_WUKV]; const float* gk = F.in[I_KVG]; const int kb = r / 32, nb = r % 32;
            transpose_item([&](int k, int n) -> float { return k < 128 ? W[(size_t)k * 1024 + n] * gk[k] : 0.f; }, (bf16_t*)(F.ws + WS_WUKV), 256, kb * 64, nb * 32, scr, lane); continue; } r -= I_D;
        if (r < I_E) { const float* W = F.in[I_WR]; const int kb = r / 8, nb = r % 8;
            transpose_item([&](int k, int n) -> float { return n < 64 ? W[(size_t)k * 64 + n] : 0.f; }, (bf16_t*)(F.ws + WS_WR), 1024, kb * 64, nb * 32, scr, lane); continue; } r -= I_E;
        if (r < I_F) { const float* W = F.in[I_WO]; const int kb = r / 32, nb = r % 32;
            transpose_item([&](int k, int n) -> float { return W[(size_t)k * 1024 + n]; }, (bf16_t*)(F.ws + WS_WO), 1024, kb * 64, nb * 32, scr, lane); continue; } r -= I_F;
        const int it2 = it + NGW; const bool has2 = it2 < NITEMS; float tv0[32], tv1[32];
        auto geom = [&](int rr_, const float*& W0, const float*& W1, bf16_t*& dst, int& ldk, int& k0, int& n0, bool& gu) {
            if (rr_ < I_G) { const int e = rr_ / 256, q = rr_ % 256; gu = true; k0 = (q / 16) * 64; n0 = (q % 16) * 32; ldk = 1024;
                W0 = e < 64 ? F.in[I_WEG] + (size_t)e * 1024 * 256 : F.in[I_WSG]; W1 = e < 64 ? F.in[I_WEU] + (size_t)e * 1024 * 256 : F.in[I_WSU]; dst = (bf16_t*)(F.ws + WS_WGU) + (size_t)e * 512 * 1024; }
            else { const int q_ = rr_ - I_G, e = q_ / 128, q = q_ % 128; gu = false; k0 = (q / 32) * 64; n0 = (q % 32) * 32; ldk = 256;
                W0 = e < 64 ? F.in[I_WED] + (size_t)e * 256 * 1024 : F.in[I_WSD]; W1 = W0; dst = (bf16_t*)(F.ws + WS_WD) + (size_t)e * 1024 * 256; } };
        auto val = [&](bool gu, const float* W0, const float* W1, int k, int n) -> float { if (gu) { const int r_ = n & 255, col = 128 * (n >> 8) + 32 * (r_ >> 6) + (r_ & 31); return ((r_ >> 5) & 1) ? W1[(size_t)k * 256 + col] : W0[(size_t)k * 256 + col]; } return W0[(size_t)k * 1024 + n]; };
        const float *Wa0, *Wa1, *Wb0, *Wb1; bf16_t *da, *db; int lka, ka, na, lkb, kb_, nb_; bool gua, gub;
        geom(r, Wa0, Wa1, da, lka, ka, na, gua);
        transpose_load([&](int k, int n) -> float { return val(gua, Wa0, Wa1, k, n); }, ka, na, lane, tv0);
        if (has2) { geom(it2 - (I_A + I_B + I_C + I_D + I_E + I_F), Wb0, Wb1, db, lkb, kb_, nb_, gub); transpose_load([&](int k, int n) -> float { return val(gub, Wb0, Wb1, k, n); }, kb_, nb_, lane, tv1); }
        transpose_store(tv0, da, lka, ka, na, scr, lane);
        if (has2) transpose_store(tv1, db, lkb, kb_, nb_, scr, lane);
        it += NGW;
    }
    if (PART == 0) {
      const float* x = F.in[I_X]; bf16_t* xb = (bf16_t*)(F.ws + WS_XB); const size_t N8 = (size_t)T * DM / 8, st = (size_t)F.G * 512;
      for (size_t i = (size_t)F.bid * 512 + F.tid; i < N8; i += 4 * st) {
          f32x4 a[4], b[4];
#pragma unroll
          for (int u = 0; u < 4; ++u) { const size_t ii = i + u * st < N8 ? i + u * st : i; a[u] = __builtin_nontemporal_load((const f32x4*)(x + ii * 8)); b[u] = __builtin_nontemporal_load((const f32x4*)(x + ii * 8 + 4)); }
#pragma unroll
          for (int u = 0; u < 4; ++u) if (i + u * st < N8) *(u32x4*)(xb + (i + u * st) * 8) = pack8(a[u], b[u]); } }
    if (PART == 1) { asm volatile("s_waitcnt vmcnt(0) lgkmcnt(0)" ::: "memory"); __syncthreads(); }
}

__device__ __forceinline__ void scan_unit(Frame& F, int g, int pm) {
    const bf16_t* S = (const bf16_t*)(F.ws + WS_S); bf16_t* UH = (bf16_t*)(F.ws + WS_UH);
    {
        const int n = F.tid & 63, d = (F.tid >> 6) & 1, b = pm * 4 + (F.tid >> 7);
        const SsmPar p = ssm_par(F.in[I_LRE], F.in[I_LIM], F.in[I_LDT], d, g, n); float acr, aci; ssm_pow(p, (float)CHK, acr, aci);
        float hr = 0.f, hi = 0.f;
        const size_t rbase = (size_t)g * UHR + (size_t)b * NCHK;
#pragma unroll
        for (int hb = 0; hb < 2; ++hb) {
            float sr[32], si[32];
#pragma unroll
            for (int st = 0; st < 32; ++st) { const int ci = d ? (NCHK - 1 - (hb * 32 + st)) : (hb * 32 + st);
                sr[st] = __uint_as_float((unsigned)S[(rbase + ci) * 256 + d * 128 + n] << 16); si[st] = __uint_as_float((unsigned)S[(rbase + ci) * 256 + d * 128 + 64 + n] << 16); }
#pragma unroll
            for (int st = 0; st < 32; ++st) { const int ci = d ? (NCHK - 1 - (hb * 32 + st)) : (hb * 32 + st);
                bf16_t* hp = UH + (rbase + ci) * UHK + 512 + d * 128 + n;
                hp[0] = (bf16_t)(cvt_pk_bf16(hr, 0.f) & 0xffffu); hp[64] = (bf16_t)(cvt_pk_bf16(hi, 0.f) & 0xffffu);
                const float nr = acr * hr - aci * hi + sr[st], ni = acr * hi + aci * hr + si[st]; hr = nr; hi = ni; }
        }
    }
}
__device__ __forceinline__ void mo_fill(Frame& F) {
    const float* Kt = (const float*)(F.ws + WS_KT); bf16_t* Mo = (bf16_t*)(F.ws + WS_MO);
    for (int pc = F.bid * 512 + F.tid; pc < 32 * 512 * 64; pc += F.G * 512) {
        const int k0 = (pc & 63) * 8, row = (pc >> 6) & 511, g = pc >> 15, s = k0 >> 4, q0 = k0 & 15, tq = row >> 4, pp = row & 15;
        f32x4 v0 = {0.f, 0.f, 0.f, 0.f}, v1 = {0.f, 0.f, 0.f, 0.f};
        if (tq >= s) { const float* kp = Kt + ((size_t)(g * 2 + 0) * 32 + (tq - s)) * 256 + pp * 16 + q0; v0 += *(const f32x4*)kp; v1 += *(const f32x4*)(kp + 4); }
        if (s >= tq) { const float* kp = Kt + ((size_t)(g * 2 + 1) * 32 + (s - tq)) * 256 + pp * 16 + q0; v0 += *(const f32x4*)kp; v1 += *(const f32x4*)(kp + 4); }
        if (s == tq && (pp >> 3) == (q0 >> 3)) { const float dsk = F.in[I_DSK][g * 16 + pp];
#pragma unroll
            for (int j = 0; j < 4; ++j) { if (q0 + j == pp) v0[j] += dsk; if (q0 + 4 + j == pp) v1[j] += dsk; } }
        *(u32x4*)(Mo + ((size_t)g * 512 + row) * UHK + k0) = pack8(v0, v1);
    }
}

__device__ __forceinline__ void p7_ln1(Frame& F) {
    const int lane = fresh_lane();
    const float* g1 = F.in[I_LN1G]; const float* b1 = F.in[I_LN1B]; bf16_t* x1b = (bf16_t*)(F.ws + WS_X1B);
    f32x4 gg[4], bb[4];
#pragma unroll
    for (int j = 0; j < 4; ++j) { const int c = 8 * lane + (j >> 1) * 512 + (j & 1) * 4; gg[j] = *(const f32x4*)(g1 + c); bb[j] = *(const f32x4*)(b1 + c); }
    for (int pm = F.bid; pm < T / 256; pm += F.G)
    for (int row0 = pm * 256 + F.wave; row0 < pm * 256 + 256; row0 += 32) {
        u32x4 w0[4], w1[4];
#pragma unroll
        for (int j = 0; j < 4; ++j) { const bf16_t* rp = x1b + (size_t)(row0 + 8 * j) * 1024 + 8 * lane; w0[j] = *(const u32x4*)rp; w1[j] = *(const u32x4*)(rp + 512); }
#pragma unroll
        for (int j = 0; j < 4; ++j) {
            bf16_t* rp = x1b + (size_t)(row0 + 8 * j) * 1024 + 8 * lane; f32x4 v[4]; unpack8(w0[j], v[0], v[1]); unpack8(w1[j], v[2], v[3]);
            float s = 0.f;
#pragma unroll
            for (int q = 0; q < 4; ++q) s += (v[q][0] + v[q][1]) + (v[q][2] + v[q][3]);
            const float mean = wave_sum(s) * (1.f / 1024.f); float qq = 0.f;
#pragma unroll
            for (int q = 0; q < 4; ++q) { v[q] = v[q] - mean; qq += (v[q][0] * v[q][0] + v[q][1] * v[q][1]) + (v[q][2] * v[q][2] + v[q][3] * v[q][3]); }
            const float rstd = __builtin_amdgcn_rsqf(wave_sum(qq) * (1.f / 1024.f) + LN_EPS);
#pragma unroll
            for (int q = 0; q < 4; ++q) v[q] = v[q] * rstd * gg[q] + bb[q];
            *(u32x4*)rp = pack8(v[0], v[1]); *(u32x4*)(rp + 512) = pack8(v[2], v[3]);
        }
    }
}

__device__ __forceinline__ void route_batch(Frame& F, int bt) {
    LAS int* hist = (LAS int*)(F.lds); LAS int* base = hist + 64;
    const float* LG = (const float*)(F.ws + WS_LOGIT); int* rowtok = (int*)(F.ws + WS_ROWTOK); int* tslot = (int*)(F.ws + WS_TSLOT); float* topw = (float*)(F.ws + WS_TOPW);
    {
        __syncthreads();
        if (F.tid < 64) hist[F.tid] = 0;
        __syncthreads();
        const int tok = bt * 256 + F.tid, ch = (bt * 256) / CAPC;
        int idx[6], lr[6]; float w[6];
        if (F.tid < 256) {
            float lg[64];
#pragma unroll
            for (int j = 0; j < 16; ++j) { const f32x4 v = *(const f32x4*)(LG + (size_t)tok * 64 + 4 * j); lg[4 * j] = v[0]; lg[4 * j + 1] = v[1]; lg[4 * j + 2] = v[2]; lg[4 * j + 3] = v[3]; }
            route_token(lg, F.in[I_RB], idx, w);
#pragma unroll
            for (int k = 0; k < 6; ++k) lr[k] = atomicAdd((int*)&hist[idx[k]], 1);
        }
        __syncthreads();
        if (F.tid < 64) base[F.tid] = (int)__hip_atomic_fetch_add(F.ctl + CW_CNT + 64 * (ch * 65 + F.tid), (unsigned)hist[F.tid], __ATOMIC_RELAXED, __HIP_MEMORY_SCOPE_AGENT);
        __syncthreads();
        if (F.tid < 256) {
#pragma unroll
            for (int k = 0; k < 6; ++k) { const int slot = base[idx[k]] + lr[k];
                rowtok[(size_t)(ch * 64 + idx[k]) * CAPC + slot] = tok; tslot[(size_t)tok * 8 + k] = (idx[k] << 16) | slot; topw[(size_t)tok * 8 + k] = w[k]; }
        }
    }
}

__device__ __forceinline__ void p12_combine(Frame& F, int ch) {
    const int lane = fresh_lane();
    const MoeTab tb = moe_tab(F.lds); const int t0 = tb.tbase[ch * 65];
    const unsigned char* Y8 = F.ws + WS_Y; const bf16_t* YS = (const bf16_t*)(F.ws + WS_YS); const bf16_t* x1b = (const bf16_t*)(F.ws + WS_X1B);
    const int* tslot = (const int*)(F.ws + WS_TSLOT); const float* topw = (const float*)(F.ws + WS_TOPW);
    const float* g2 = F.in[I_LN2G]; const float* b2 = F.in[I_LN2B];
    f32x4 gg[4], bb[4];
#pragma unroll
    for (int j = 0; j < 4; ++j) { const int c = 8 * lane + (j >> 1) * 512 + (j & 1) * 4; gg[j] = *(const f32x4*)(g2 + c); bb[j] = *(const f32x4*)(b2 + c); }
    constexpr int NTK = 4;
    const int stride = F.G * 8;
    for (int tk0 = F.bid * 8 + F.wave; tk0 < CAPC; tk0 += NTK * stride) {
        int ts[NTK][6]; float tw[NTK][6];
#pragma unroll
        for (int t = 0; t < NTK; ++t) { const int tk = tk0 + t * stride < CAPC ? tk0 + t * stride : tk0; const size_t tok = (size_t)ch * CAPC + tk;
#pragma unroll
            for (int k = 0; k < 6; ++k) { ts[t][k] = tslot[tok * 8 + k]; tw[t][k] = topw[tok * 8 + k]; } }
        u32x4 xw[NTK][2], sw[NTK][2]; u32x2 yw[NTK][6][2];
#pragma unroll
        for (int t = 0; t < NTK; ++t) { const int tk = tk0 + t * stride < CAPC ? tk0 + t * stride : tk0; const size_t tok = (size_t)ch * CAPC + tk;
            const bf16_t* xr = x1b + tok * 1024 + 8 * lane; xw[t][0] = *(const u32x4*)xr; xw[t][1] = *(const u32x4*)(xr + 512);
            const bf16_t* yr = YS + (size_t)tk * 1024 + 8 * lane; sw[t][0] = *(const u32x4*)yr; sw[t][1] = *(const u32x4*)(yr + 512);
#pragma unroll
            for (int k = 0; k < 6; ++k) { const int yrow = (tb.tbase[ch * 65 + (ts[t][k] >> 16)] - t0) * 256 + (ts[t][k] & 0xffff);
                const unsigned char* y8 = Y8 + y8_off(yrow, 8 * lane); yw[t][k][0] = *(const u32x2*)y8; yw[t][k][1] = *(const u32x2*)(y8 + 512); } }
#pragma unroll
        for (int t = 0; t < NTK; ++t) {
            const int tk = tk0 + t * stride; if (tk >= CAPC) break;
            const size_t tok = (size_t)ch * CAPC + tk;
            f32x4 a[4]; unpack8(xw[t][0], a[0], a[1]); unpack8(xw[t][1], a[2], a[3]); a[0] *= ALPHA; a[1] *= ALPHA; a[2] *= ALPHA; a[3] *= ALPHA;
            { f32x4 y0, y1, y2, y3; unpack8(sw[t][0], y0, y1); unpack8(sw[t][1], y2, y3); a[0] += y0; a[1] += y1; a[2] += y2; a[3] += y3; }
#pragma unroll
            for (int k = 0; k < 6; ++k) { const float w = tw[t][k] * Y8_INV; f32x4 y0, y1, y2, y3; unpack8_fp8(yw[t][k][0], y0, y1); unpack8_fp8(yw[t][k][1], y2, y3);
                a[0] += y0 * w; a[1] += y1 * w; a[2] += y2 * w; a[3] += y3 * w; }
            float s = 0.f;
#pragma unroll
            for (int j = 0; j < 4; ++j) s += (a[j][0] + a[j][1]) + (a[j][2] + a[j][3]);
            const float mean = wave_sum(s) * (1.f / 1024.f); float q = 0.f;
#pragma unroll
            for (int j = 0; j < 4; ++j) { a[j] = a[j] - mean; q += (a[j][0] * a[j][0] + a[j][1] * a[j][1]) + (a[j][2] * a[j][2] + a[j][3] * a[j][3]); }
            const float rstd = __builtin_amdgcn_rsqf(wave_sum(q) * (1.f / 1024.f) + LN_EPS);
            float* orow = F.out + tok * 1024 + 8 * lane;
#pragma unroll
            for (int j = 0; j < 4; ++j) *(f32x4*)(orow + (j >> 1) * 512 + (j & 1) * 4) = a[j] * rstd * gg[j] + bb[j];
        }
    }
}
}

namespace fx {
constexpr int NPHASE = 11 + 2 * NCH;
struct Args { const float* in[29]; float* out; unsigned char* ws; int ph_lo, ph_hi; };

__global__ void __launch_bounds__(512, 2) fwd(Args args) {
    extern __shared__ __attribute__((aligned(16))) unsigned char lds_raw[];
    Frame F;
    F.lds = (LAS unsigned char*)lds_raw; F.ws = args.ws; F.ctl = (unsigned*)(args.ws + WS_CTL); F.out = args.out;
#pragma unroll
    for (int i = 0; i < 29; ++i) F.in[i] = args.in[i];
    F.tid = threadIdx.x; F.lane = 0; F.wave = __builtin_amdgcn_readfirstlane(F.tid >> 6); F.G = gridDim.x; F.bid = blockIdx.x;
    volatile LAS unsigned* MISC = (volatile LAS unsigned*)(F.lds + MISC_OFF);
    if (F.tid < 32) MISC[F.tid] = 0u;
    __syncthreads();
    const int lo = args.ph_lo, hi = args.ph_hi;
    XcdBarrier bar; bar.bar = F.ctl + CW_BAR; bar.x = 0; bar.st = MISC + 8;
    if (hi - lo > 1) bar = xcd_barrier_post(F.ctl + CW_BAR, MISC + 8);
#ifndef PH_MASK
#define PH_MASK 0xFFFFFFFFu
#endif
#define IN(k) (((PH_MASK >> ((k) > 11 ? 11 + (((k) - 11) & 1) : (k))) & 1u) && lo <= (k) && (k) < hi)
#define SEAM(k) do { if (IN(k) && IN((k) + 1)) xcd_barrier(bar); if (MK_TPROBE >= 300 && blockIdx.x == 0 && threadIdx.x == 0) { const unsigned long long cn_ = __builtin_amdgcn_s_memtime(); \
        const unsigned long long cl_ = ((unsigned long long)MISC[25] << 32) | MISC[24]; if ((k) + 300 == MK_TPROBE) { const unsigned long long dc_ = cn_ - cl_; MISC[26] = (unsigned)dc_; MISC[27] = (unsigned)(dc_ >> 32); } MISC[24] = (unsigned)cn_; MISC[25] = (unsigned)(cn_ >> 32); } \
     if (MK_TPROBE >= 0 && blockIdx.x == 0 && threadIdx.x == 0) { const unsigned long long tn_ = __builtin_amdgcn_s_memrealtime(); \
        const unsigned long long tl_ = ((unsigned long long)MISC[17] << 32) | MISC[16]; if (((k) == MK_TPROBE && MK_TPROBE < 100) || (k) + 300 == MK_TPROBE) { const unsigned long long d_ = tn_ - tl_; MISC[18] = (unsigned)d_; MISC[19] = (unsigned)(d_ >> 32); } if (MK_TPROBE == 200 + (k)) { MISC[18] = MISC[22]; MISC[19] = MISC[23]; } MISC[22] = 0u; MISC[23] = 0u; MISC[16] = (unsigned)tn_; MISC[17] = (unsigned)(tn_ >> 32); } } while (0)
    unsigned char* ws = args.ws;
    bf16_t* UH = (bf16_t*)(ws + WS_UH); bf16_t* CQ = (bf16_t*)(ws + WS_CQ); bf16_t* CKVR = (bf16_t*)(ws + WS_CKVR); bf16_t* Qb = (bf16_t*)(ws + WS_Q); bf16_t* KVb = (bf16_t*)(ws + WS_KV);
    bf16_t* SPRE = (bf16_t*)(ws + WS_SPRE); bf16_t* MIX = (bf16_t*)(ws + WS_MIX);
    float* ssqq = (float*)(ws + WS_SSQQ); float* ssqkv = (float*)(ws + WS_SSQKV); const float* ropec = (const float*)(ws + WS_ROPE); const float* ropes = ropec + 2048 * 16;

    if (MK_TPROBE >= 0 && blockIdx.x == 0 && threadIdx.x == 0) { const unsigned long long tn_ = __builtin_amdgcn_s_memrealtime(); MISC[16] = (unsigned)tn_; MISC[17] = (unsigned)(tn_ >> 32); }
    if (MK_TPROBE == 500 && threadIdx.x == 0) __hip_atomic_store(F.ctl + CW_DBG + 64 + blockIdx.x, 1u + xb_xcc_id(), __ATOMIC_RELAXED, __HIP_MEMORY_SCOPE_AGENT);
    if (IN(0)) { p0_prologue<0>(F); } SEAM(0);
    if (IN(1)) {
        const bool conv_first = ((F.bid >> 3) & 1) != 0;
        if (conv_first) p0_prologue<1>(F);
        { PlainOrder S; S.init(ws + WS_XB, 1024, ws + WS_WIN, 1024, T, 1024, F.G, F.bid);
          EpiWin E{UH, CQ, CKVR, ssqq, ssqkv, ropec, ropes};
          gemm_phase<EpiWin, PlainOrder, true, false>(F.lds, 1024, 1024, 1024, S, E); }
        if (!conv_first) p0_prologue<1>(F);
    } SEAM(1);
    if (IN(2)) {
        { GroupOrder S; S.init(UH, ws + WS_WST, 512, 1, F.G, F.bid); EpiSt E{(bf16_t*)(ws + WS_S)};
          gemm_phase<EpiSt, GroupOrder, true, false>(F.lds, UHK, 512, 512, S, E);
          asm volatile("s_waitcnt vmcnt(0)" ::: "memory"); __syncthreads();
          Unit u; for (int i = 0; S.next(i, u); ++i) scan_unit(F, u.i0, u.i1); }
        mo_fill(F);
        { PlainOrder S; S.init(CQ, 256, ws + WS_WUQ, 256, T, 768, F.G, F.bid); EpiQ E{Qb, ssqq, ropec, ropes};
          gemm_phase<EpiQ, PlainOrder, true, false>(F.lds, 256, 256, 256, S, E); }
        { PlainOrder S; S.init(CKVR, 256, ws + WS_WUKV, 256, T, 1024, F.G, F.bid); EpiKV E{KVb, ssqkv};
          gemm_phase<EpiKV, PlainOrder, true, false>(F.lds, 256, 256, 128, S, E); }
    } SEAM(2);
    if (IN(4)) {
#ifndef SUB4
#define SUB4 3
#endif
        if (SUB4 & 2) REP(40) for (int i = 0;; ++i) { const long L = (long)i * F.G + F.bid; if (L >= 2048) break;
            const int un = xcd_remap((int)L, 2048), pair = un >> 3, qb = un & 7, b = pair >> 3, h = pair & 7;
            att::attn_unit(ws, Qb, MIX, b * SEQ, qb * 256, h, (char*)lds_raw); }
        if (SUB4 & 1) DUP2(4, { GroupOrder S; S.init(UH, ws + WS_MO, UHK, 2, F.G, F.bid); EpiSsmOut E{SPRE};
          gemm_phase<EpiSsmOut, GroupOrder, true, false>(F.lds, UHK, UHK, UHK, S, E); });
    } SEAM(4);
    if (IN(5)) {
        { PanelOrder S; S.init(SPRE, SPRE_LD, ws + WS_WGLU, 512, T, 512, F.G, F.bid); EpiGlu E{SPRE, MIX, F.in[I_BGLU]};
          gemm_phase<EpiGlu, PanelOrder, true, false>(F.lds, SPRE_LD, 512, 512, S, E); }
        asm volatile("s_waitcnt vmcnt(0)" ::: "memory"); __syncthreads();
        { PanelOrder S; S.init(MIX, 1024, ws + WS_WO, 1024, T, 1024, F.G, F.bid); EpiWo E{(bf16_t*)(ws + WS_X1B)};
          gemm_phase<EpiWo, PanelOrder, true, false>(F.lds, 1024, 1024, 1024, S, E); }
        asm volatile("s_waitcnt vmcnt(0)" ::: "memory"); __syncthreads();
        p7_ln1(F);
        asm volatile("s_waitcnt vmcnt(0)" ::: "memory"); __syncthreads();
        { PanelOrder S; S.init(ws + WS_X1B, 1024, ws + WS_WGU + (size_t)64 * 512 * 1024 * 2, 1024, T, 768, F.G, F.bid); EpiSharedRouter E{(bf16_t*)(ws + WS_HS), (float*)(ws + WS_LOGIT)};
          gemm_phase<EpiSharedRouter, PanelOrder, true, false>(F.lds, 1024, 1024, 1024, S, E);
          asm volatile("s_waitcnt vmcnt(0)" ::: "memory"); __syncthreads();
          Unit u; for (int i = 0; S.next(i, u); ++i) if (u.i1 == 2) route_batch(F, u.i0); }
    } SEAM(8);
    if (IN(10)) {
        moe_build_tab(F.lds, F.ctl);
        GateUpOrder S; S.init(F.lds, ws + WS_X1B, ws + WS_WGU, (const int*)(ws + WS_ROWTOK), F.ctl, F.G, F.bid); EpiGateUp E{(bf16_t*)(ws + WS_H)};
        gemm_phase<EpiGateUp, GateUpOrder, true, true>(F.lds, 1024, 1024, 1024, S, E);
    } SEAM(10);
#pragma unroll
    for (int ch = 0; ch < NCH; ++ch) {
        if (IN(11 + 2 * ch)) {
            moe_build_tab(F.lds, F.ctl);
            { DownOrder S; S.init(ws + WS_H, ws + WS_HS, ws + WS_WD, moe_tab(F.lds), ch, F.G, F.bid); EpiDown E{ws + WS_Y, (bf16_t*)(ws + WS_YS)};
              gemm_phase<EpiDown, DownOrder, true, false, 0, 1>(F.lds, 256, 256, 256, S, E); }
        } SEAM(11 + 2 * ch);
        if (IN(12 + 2 * ch)) { moe_build_tab(F.lds, F.ctl); p12_combine(F, ch); } SEAM(12 + 2 * ch);
    }
    if (MK_TPROBE == 500 && blockIdx.x == 0 && threadIdx.x == 0) { unsigned bad = 0; for (unsigned b = 8; b < gridDim.x; ++b) bad += __hip_atomic_load(F.ctl + CW_DBG + 64 + b, __ATOMIC_RELAXED, __HIP_MEMORY_SCOPE_AGENT) != __hip_atomic_load(F.ctl + CW_DBG + 64 + (b & 7u), __ATOMIC_RELAXED, __HIP_MEMORY_SCOPE_AGENT);
        const unsigned long long t0_ = __builtin_amdgcn_s_memrealtime(); if (bad) while (__builtin_amdgcn_s_memrealtime() - t0_ < 100000ull) __builtin_amdgcn_s_sleep(8); }
    if (MK_TPROBE >= 0 && MK_TPROBE != 500 && blockIdx.x == 0 && threadIdx.x == 0) { const unsigned long long d_ = ((unsigned long long)MISC[19] << 32) | MISC[18]; const unsigned long long t0_ = __builtin_amdgcn_s_memrealtime();
        unsigned long long wait_ = 8ull * d_; if (MK_TPROBE >= 300) { const unsigned long long dc_ = ((unsigned long long)MISC[27] << 32) | MISC[26]; wait_ = d_ ? (dc_ * 100ull / d_) * 100ull : 0ull; }
        while (__builtin_amdgcn_s_memrealtime() - t0_ < wait_) __builtin_amdgcn_s_sleep(8); }
#undef IN
#undef SEAM
}

#if MK_DEBUG
__global__ void dbg_cmp(int k, const unsigned char* ws, const float* out_fast, gold::Bufs B, const float* gx1, const float* gout, float* acc) {
    const int t = blockIdx.x;
    float num = 0.f, den = 0.f;
    auto bf = [](const bf16_t* p, size_t i) -> float { return __uint_as_float(((unsigned)p[i]) << 16); };
    int ncol = 0;
    switch (k) { case 0: ncol = 512; break; case 1: ncol = 256; break; case 2: ncol = 160; break; case 3: ncol = 768; break; case 4: ncol = 1024; break; case 5: ncol = 512; break; case 6: ncol = 512; break; case 7: ncol = 512; break; case 8: ncol = 1024; break; default: ncol = 1024; }
    for (int c = threadIdx.x; c < ncol; c += blockDim.x) {
        float f = 0.f, g = 0.f;
        if (k == 0) { const int gg = c >> 4, p = c & 15; f = bf((const bf16_t*)(ws + WS_UH), ((size_t)gg * UHR + (t >> 5)) * UHK + (t & 31) * 16 + p); g = B.proj[(size_t)t * 928 + c]; }
        else if (k == 1) { f = bf((const bf16_t*)(ws + WS_CQ), (size_t)t * 256 + c); g = B.proj[(size_t)t * 928 + 512 + c]; }
        else if (k == 2) { f = bf((const bf16_t*)(ws + WS_CKVR), (size_t)t * 256 + c); g = c < 128 ? B.proj[(size_t)t * 928 + 768 + c] : B.krope[(size_t)t * 32 + rope_perm_src(c - 128)]; }
        else if (k == 3) { const int hh = c / 96, jj = c % 96, src = jj < 64 ? c : hh * 96 + 64 + rope_perm_src(jj - 64); f = bf((const bf16_t*)(ws + WS_Q), (size_t)t * 768 + c); g = B.q[(size_t)t * 768 + src] * QSCALE; }
        else if (k == 4) { f = bf((const bf16_t*)(ws + WS_KV), (size_t)t * 1024 + c); g = B.kv[(size_t)t * 1024 + c]; }
        else if (k == 5) { f = bf((const bf16_t*)(ws + WS_SPRE), (size_t)t * SPRE_LD + c); g = B.spre[(size_t)t * 512 + c]; }
        else if (k == 6) { f = bf((const bf16_t*)(ws + WS_MIX), (size_t)t * 1024 + c); g = B.mix[(size_t)t * 1024 + c]; }
        else if (k == 7) { f = bf((const bf16_t*)(ws + WS_MIX), (size_t)t * 1024 + 512 + c); g = B.mix[(size_t)t * 1024 + 512 + c]; }
        else if (k == 8) { f = bf((const bf16_t*)(ws + WS_X1B), (size_t)t * 1024 + c); g = gx1[(size_t)t * 1024 + c]; }
        else { f = out_fast[(size_t)t * 1024 + c]; g = gout[(size_t)t * 1024 + c]; }
        const float d = f - g; num += d * d; den += g * g;
        if (!(fabsf(f) < 1e30f)) num += 1e30f;
    }
    num = wave_sum(num); den = wave_sum(den);
    if ((threadIdx.x & 63) == 0) { atomicAdd(acc + 2 * k, num); atomicAdd(acc + 2 * k + 1, den); }
}
__global__ void dbg_encode(const float* acc, float* out, int k0, int nk) {
    float c2 = 0.f;
    for (int k = k0; k < k0 + nk; ++k) { const float e = sqrtf(acc[2 * k] / fmaxf(acc[2 * k + 1], 1e-30f)); const float tol = (k == 9) ? 0.08f : 0.04f;
        if (!(e <= tol)) { const int bucket = !(e <= 0.5f) ? 0 : (e > 0.1f ? 1 : 2); c2 = (float)(k - k0 + 1) + 20.f * bucket; break; } }
    if (c2 == 0.f) { if (MK_DBG_NPH >= NPHASE) return; c2 = 90.f; }
    const float c = sqrtf(c2);
    for (size_t i = (size_t)blockIdx.x * blockDim.x + threadIdx.x; i < (size_t)T * 1024; i += (size_t)gridDim.x * blockDim.x) out[i] = c;
}
#endif
}

extern "C" void kernel_launch(void* const* d_in, const int* in_sizes, int n_in, void* d_out, int out_size, void* d_ws, size_t ws_size, hipStream_t stream) {
#if MK_MODE == 0
    gold::In I; const float** p = (const float**)&I;
    for (int i = 0; i < 29; ++i) p[i] = (const float*)d_in[i];
    for (int t0 = 0; t0 < 65536; t0 += 16384) gold::run(I, t0, 16384, (float*)d_ws, (float*)d_out + (size_t)t0 * 1024, (float*)d_out + (size_t)t0 * 1024, stream);
#else
    using namespace fx;
    static int grid = 0;
    if (grid == 0) {
        if (n_in != 29 || ws_size < WS_END) { fprintf(stderr, "kernel_launch: need 29 inputs and >= %zu bytes of workspace (got %d, %zu)\n", (size_t)WS_END, n_in, ws_size); grid = -1; return; }
        int dev = 0, cus = 0, per_cu = 0;
        hipGetDevice(&dev); hipDeviceGetAttribute(&cus, hipDeviceAttributeMultiprocessorCount, dev);
        if (hipFuncSetAttribute((const void*)fwd, hipFuncAttributeMaxDynamicSharedMemorySize, LDS_BYTES) != hipSuccess) { fprintf(stderr, "kernel_launch: hipFuncSetAttribute failed\n"); grid = -1; return; }
        if (hipOccupancyMaxActiveBlocksPerMultiprocessor(&per_cu, (const void*)fwd, 512, LDS_BYTES) != hipSuccess || per_cu < 1) { fprintf(stderr, "kernel_launch: occupancy query says %d\n", per_cu); }
        (void)hipGetLastError();
        grid = cus > 0 ? cus : 256;
    }
    if (grid < 0) return;
    hipMemsetAsync((char*)d_ws + WS_CTL, 0, CTL_BYTES, stream);
    Args a{};
    for (int i = 0; i < 29; ++i) a.in[i] = (const float*)d_in[i];
    a.out = (float*)d_out; a.ws = (unsigned char*)d_ws;
#if MK_MODE == 1
    for (int ph = 0; ph < NPHASE && ph < MK_DBG_NPH; ++ph) { a.ph_lo = ph; a.ph_hi = ph + 1; hipLaunchKernelGGL(fwd, dim3(grid), dim3(512), LDS_BYTES, stream, a); }
#else
    a.ph_lo = 0; a.ph_hi = NPHASE; hipLaunchKernelGGL(fwd, dim3(grid), dim3(512), LDS_BYTES, stream, a);
#endif
#if MK_DEBUG
    {
        gold::In I; const float** p = (const float**)&I;
        for (int i = 0; i < 29; ++i) p[i] = (const float*)d_in[i];
        float* gs = (float*)((char*)d_ws + WS_GOLD); float* gx1 = gs + (size_t)2048 * gold::GOLD_FLOATS_PER_TOK; float* gout = gx1 + (size_t)2048 * 1024;
        gold::Bufs B = gold::run(I, 0, 2048, gs, gx1, gout, stream);
        float* acc = (float*)((char*)d_ws + WS_CTL) + CW_DBG;
        for (int k = 0; k < 10; ++k) hipLaunchKernelGGL(dbg_cmp, dim3(2048), dim3(256), 0, stream, k, (const unsigned char*)d_ws, (const float*)d_out, B, (const float*)gx1, (const float*)gout, acc);
        hipLaunchKernelGGL(dbg_encode, dim3(1024), dim3(256), 0, stream, (const float*)acc, (float*)d_out, MK_DBG_K0, MK_DBG_NK);
    }
#endif
    const hipError_t le = hipPeekAtLastError();
    if (le != hipSuccess) fprintf(stderr, "kernel_launch: launch failed: %s\n", hipGetErrorName(le));
#endif
}
```

```cpp
#define MK_MODE 2
#include <hip/hip_runtime.h>
#include <cstdio>
#include <cstdint>
#include <cmath>
#ifndef MK_MODE
#define MK_MODE 1
#endif
#ifndef MK_DBG_NPH
#define MK_DBG_NPH 99
#endif
#ifndef MK_DBG_K0
#define MK_DBG_K0 0
#endif
#ifndef MK_DBG_NK
#define MK_DBG_NK 10
#endif
#ifndef MK_DUP
#define MK_DUP -1
#endif
#define REP(k) for (int rep_ = 0; rep_ < ((MK_DUP == (k)) ? 2 : 1); ++rep_)
#define DUP2(k, ...) do { __VA_ARGS__ if constexpr (MK_DUP == (k)) { __VA_ARGS__ } } while (0)
#ifndef MK_TPROBE
#define MK_TPROBE -1
#endif
#ifndef MK_STAG
#define MK_STAG 0
#endif
#ifndef MK_DEBUG
#define MK_DEBUG 0
#endif
namespace gold {
constexpr int D_MODEL = 1024, SEQ = 2048, D_SSM = 512, D_IN = 928, NH = 8, QLR = 256, KVLR = 128, ROPE = 32;
constexpr int NEXP = 64, TOPK = 6, DEXP = 256;
constexpr float ALPHA = 1.189207115002721f, LN_EPS = 1e-5f, RMS_EPS = 1e-6f, ATT_SCALE = 0.10206207261596577f;

__global__ void __launch_bounds__(256) sgemm(const float* __restrict__ A, int lda, const float* __restrict__ B, int ldb, float* __restrict__ C, int ldc, int M, int N, int K) {
    __shared__ float As[16][65];
    __shared__ float Bs[16][65];
    const int tid = threadIdx.x, tx = tid & 15, ty = tid >> 4;
    const int m0 = blockIdx.y * 64, n0 = blockIdx.x * 64;
    float acc[4][4];
#pragma unroll
    for (int i = 0; i < 4; ++i)
#pragma unroll
        for (int j = 0; j < 4; ++j) acc[i][j] = 0.f;
    for (int k0 = 0; k0 < K; k0 += 16) {
#pragma unroll
        for (int i = 0; i < 4; ++i) { const int idx = tid + 256 * i, r = idx >> 4, c = idx & 15; As[c][r] = A[(size_t)(m0 + r) * lda + k0 + c]; }
#pragma unroll
        for (int i = 0; i < 4; ++i) { const int idx = tid + 256 * i, r = idx >> 6, c = idx & 63; Bs[r][c] = (n0 + c < N) ? B[(size_t)(k0 + r) * ldb + n0 + c] : 0.f; }
        __syncthreads();
#pragma unroll
        for (int k = 0; k < 16; ++k) {
            float a[4], b[4];
#pragma unroll
            for (int i = 0; i < 4; ++i) a[i] = As[k][ty + 16 * i];
#pragma unroll
            for (int j = 0; j < 4; ++j) b[j] = Bs[k][tx + 16 * j];
#pragma unroll
            for (int i = 0; i < 4; ++i)
#pragma unroll
                for (int j = 0; j < 4; ++j) acc[i][j] = fmaf(a[i], b[j], acc[i][j]);
        }
        __syncthreads();
    }
#pragma unroll
    for (int i = 0; i < 4; ++i)
#pragma unroll
        for (int j = 0; j < 4; ++j) { const int c = n0 + tx + 16 * j; if (c < N) C[(size_t)(m0 + ty + 16 * i) * ldc + c] = acc[i][j]; }
}

__device__ __forceinline__ float gelu_tanh(float x) {
    const float z = 0.7978845608028654f * (x + 0.044715f * x * x * x);
    const float e = __expf(2.f * z);
    const float th = 1.f - 2.f / (1.f + e);
    return 0.5f * x * (1.f + th);
}
__device__ __forceinline__ float sigmoidf_(float x) { return 1.f / (1.f + __expf(-x)); }

struct SsmPar { float ar, ai, kr, ki; };
__device__ __forceinline__ SsmPar ssm_par(const float* lam_re, const float* lam_im, const float* log_dt, int d, int g, int n) {
    const float lr = fminf(lam_re[(d * 32 + g) * 64 + n], -1e-4f), li = lam_im[(d * 32 + g) * 64 + n];
    const float dt = expf(log_dt[d * 32 + g]);
    const float x = lr * dt, th = li * dt;
    const float em1 = expm1f(x), cs = cosf(th), sn = sinf(th), sh = sinf(0.5f * th);
    const float mag = em1 + 1.f;
    SsmPar p; p.ar = mag * cs; p.ai = mag * sn;
    const float arm1 = em1 * cs - 2.f * sh * sh;
    const float den = lr * lr + li * li;
    p.kr = (arm1 * lr + p.ai * li) / den; p.ki = (p.ai * lr - arm1 * li) / den;
    return p;
}

__global__ void __launch_bounds__(64) ssm_naive(const float* __restrict__ proj, int ldp, const float* __restrict__ lam_re, const float* __restrict__ lam_im, const float* __restrict__ log_dt,
                                                const float* __restrict__ b_re, const float* __restrict__ b_im, const float* __restrict__ c_re, const float* __restrict__ c_im,
                                                const float* __restrict__ d_skip, float* __restrict__ spre) {
    const int g = blockIdx.x, b = blockIdx.y, n = threadIdx.x;
    for (int d = 0; d < 2; ++d) {
        const SsmPar P = ssm_par(lam_re, lam_im, log_dt, d, g, n);
        float Br[16], Bi[16], Cr[16], Ci[16];
#pragma unroll
        for (int q = 0; q < 16; ++q) { const float br = b_re[((d * 32 + g) * 64 + n) * 16 + q], bi = b_im[((d * 32 + g) * 64 + n) * 16 + q];
            Br[q] = P.kr * br - P.ki * bi; Bi[q] = P.kr * bi + P.ki * br;
            Cr[q] = c_re[((d * 32 + g) * 16 + q) * 64 + n]; Ci[q] = c_im[((d * 32 + g) * 16 + q) * 64 + n]; }
        float hr = 0.f, hi = 0.f;
        for (int step = 0; step < SEQ; ++step) {
            const int t = d ? (SEQ - 1 - step) : step;
            const float* up = proj + (size_t)(b * SEQ + t) * ldp + g * 16;
            float u[16];
#pragma unroll
            for (int q = 0; q < 16; ++q) u[q] = up[q];
            float bur = 0.f, bui = 0.f;
#pragma unroll
            for (int q = 0; q < 16; ++q) { bur = fmaf(Br[q], u[q], bur); bui = fmaf(Bi[q], u[q], bui); }
            const float nr = P.ar * hr - P.ai * hi + bur, ni = P.ar * hi + P.ai * hr + bui;
            hr = nr; hi = ni;
            float y[16];
#pragma unroll
            for (int p = 0; p < 16; ++p) y[p] = Cr[p] * hr - Ci[p] * hi;
#pragma unroll
            for (int o = 1; o < 64; o <<= 1)
#pragma unroll
                for (int p = 0; p < 16; ++p) y[p] += __shfl_xor(y[p], o);
            if (n < 16) {
                float v = 0.f;
#pragma unroll
                for (int p = 0; p < 16; ++p) if (p == n) v = y[p];
                float* o = spre + (size_t)(b * SEQ + t) * 512 + g * 16 + n;
                if (d == 0) *o = v;
                else { float uu = 0.f;
#pragma unroll
                    for (int p = 0; p < 16; ++p) if (p == n) uu = u[p];
                    *o = gelu_tanh(*o + v + uu * d_skip[g * 16 + n]); }
            }
        }
    }
}
__global__ void glu_ew(const float* __restrict__ spre, const float* __restrict__ gl, const float* __restrict__ bglu, float* __restrict__ mix, int ntok) {
    const size_t i = (size_t)blockIdx.x * 256 + threadIdx.x; if (i >= (size_t)ntok * 512) return;
    const int c = (int)(i & 511); const size_t r = i >> 9;
    mix[r * 1024 + c] = spre[i] * sigmoidf_(gl[i] + bglu[c]);
}
__global__ void rmsnorm_rows(const float* __restrict__ in, int ld, int off, int n, const float* __restrict__ g, float* __restrict__ out, int ntok) {
    const int r = blockIdx.x * 256 + threadIdx.x; if (r >= ntok) return;
    const float* p = in + (size_t)r * ld + off; float s = 0.f;
    for (int j = 0; j < n; ++j) s = fmaf(p[j], p[j], s);
    const float rs = rsqrtf(s / n + RMS_EPS);
    for (int j = 0; j < n; ++j) out[(size_t)r * n + j] = p[j] * rs * g[j];
}
__device__ __forceinline__ void rope_cs(int pos, int i, float& c, float& s) {
    const float inv = expf(-9.210340371976184f * (float)i * (1.f / 16.f));
    const float a = (float)pos * inv; c = cosf(a); s = sinf(a);
}
__global__ void rope_ew(float* __restrict__ q, const float* __restrict__ proj, int ldp, float* __restrict__ krope, int ntok) {
    const int idx = blockIdx.x * 256 + threadIdx.x; if (idx >= ntok * 9 * 16) return;
    const int i = idx & 15, hh = (idx >> 4) % 9, r = idx / 144, pos = r % SEQ;
    float c, s; rope_cs(pos, i, c, s);
    if (hh < 8) { float* p = q + (size_t)r * 768 + hh * 96 + 64; const float t1 = p[i], t2 = p[i + 16]; p[i] = t1 * c - t2 * s; p[i + 16] = t1 * s + t2 * c; }
    else { const float* p = proj + (size_t)r * ldp + 896; const float t1 = p[i], t2 = p[i + 16]; krope[(size_t)r * 32 + i] = t1 * c - t2 * s; krope[(size_t)r * 32 + i + 16] = t1 * s + t2 * c; }
}
__global__ void __launch_bounds__(64) attn_naive(const float* __restrict__ q, const float* __restrict__ kv, const float* __restrict__ krope, float* __restrict__ mix) {
    const int qi = blockIdx.x * 64 + threadIdx.x, h = blockIdx.y, b = blockIdx.z;
    const size_t r = (size_t)b * SEQ + qi;
    float qv[96], o[64];
#pragma unroll
    for (int d = 0; d < 96; ++d) qv[d] = q[r * 768 + h * 96 + d] * ATT_SCALE;
#pragma unroll
    for (int d = 0; d < 64; ++d) o[d] = 0.f;
    float m = -1e30f, l = 0.f;
    for (int s = 0; s < SEQ; ++s) {
        const size_t kr = (size_t)b * SEQ + s;
        const float4* kn = (const float4*)(kv + kr * 1024 + h * 128);
        const float4* kp = (const float4*)(krope + kr * 32);
        float sc = 0.f;
#pragma unroll
        for (int d = 0; d < 16; ++d) { const float4 k4 = kn[d]; sc = fmaf(qv[4 * d], k4.x, sc); sc = fmaf(qv[4 * d + 1], k4.y, sc); sc = fmaf(qv[4 * d + 2], k4.z, sc); sc = fmaf(qv[4 * d + 3], k4.w, sc); }
#pragma unroll
        for (int d = 0; d < 8; ++d) { const float4 k4 = kp[d]; sc = fmaf(qv[64 + 4 * d], k4.x, sc); sc = fmaf(qv[64 + 4 * d + 1], k4.y, sc); sc = fmaf(qv[64 + 4 * d + 2], k4.z, sc); sc = fmaf(qv[64 + 4 * d + 3], k4.w, sc); }
        const float mn = fmaxf(m, sc), al = __expf(m - mn), p = __expf(sc - mn);
        l = l * al + p; m = mn;
        const float4* vp = (const float4*)(kv + kr * 1024 + h * 128 + 64);
#pragma unroll
        for (int d = 0; d < 16; ++d) { const float4 v4 = vp[d]; o[4 * d] = fmaf(o[4 * d], al, p * v4.x); o[4 * d + 1] = fmaf(o[4 * d + 1], al, p * v4.y); o[4 * d + 2] = fmaf(o[4 * d + 2], al, p * v4.z); o[4 * d + 3] = fmaf(o[4 * d + 3], al, p * v4.w); }
    }
    const float il = 1.f / l;
#pragma unroll
    for (int d = 0; d < 64; ++d) mix[r * 1024 + 512 + h * 64 + d] = o[d] * il;
}
__device__ __forceinline__ float wsum(float v) {
#pragma unroll
    for (int o = 1; o < 64; o <<= 1) v += __shfl_xor(v, o);
    return v;
}
__global__ void __launch_bounds__(256) ln1_rows(const float* __restrict__ x, const float* __restrict__ mixo, const float* __restrict__ g, const float* __restrict__ bb, float* __restrict__ x1, int ntok) {
    const int r = blockIdx.x * 4 + (threadIdx.x >> 6), lane = threadIdx.x & 63; if (r >= ntok) return;
    float v[16]; float s = 0.f;
#pragma unroll
    for (int j = 0; j < 16; ++j) { const int c = lane + 64 * j; v[j] = ALPHA * x[(size_t)r * 1024 + c] + mixo[(size_t)r * 1024 + c]; s += v[j]; }
    const float mean = wsum(s) * (1.f / 1024.f); float q = 0.f;
#pragma unroll
    for (int j = 0; j < 16; ++j) { v[j] -= mean; q = fmaf(v[j], v[j], q); }
    const float rstd = rsqrtf(wsum(q) * (1.f / 1024.f) + LN_EPS);
#pragma unroll
    for (int j = 0; j < 16; ++j) { const int c = lane + 64 * j; x1[(size_t)r * 1024 + c] = v[j] * rstd * g[c] + bb[c]; }
}
}

__device__ __forceinline__ void route_token(const float (&lg)[64], const float* __restrict__ rbias, int (&idx)[6], float (&w)[6]) {
    float sc[64], ch[64];
#pragma unroll
    for (int j = 0; j < 64; ++j) { sc[j] = 1.f / (1.f + __expf(-lg[j])); ch[j] = sc[j] + rbias[j]; }
    float gs[8];
#pragma unroll
    for (int g = 0; g < 8; ++g) { float m1 = -INFINITY, m2 = -INFINITY;
#pragma unroll
        for (int j = 0; j < 8; ++j) { const float v = ch[g * 8 + j]; if (v > m1) { m2 = m1; m1 = v; } else if (v > m2) m2 = v; }
        gs[g] = m1 + m2; }
    bool sel[8];
#pragma unroll
    for (int g = 0; g < 8; ++g) { int rank = 0;
#pragma unroll
        for (int o = 0; o < 8; ++o) { if (o != g && (gs[o] > gs[g] || (gs[o] == gs[g] && o < g))) ++rank; }
        sel[g] = rank < 4; }
#pragma unroll
    for (int j = 0; j < 64; ++j) if (!sel[j >> 3]) ch[j] = -INFINITY;
    float wsum_ = 0.f;
#pragma unroll
    for (int k = 0; k < 6; ++k) { float best = -INFINITY; int bi = 0;
#pragma unroll
        for (int j = 0; j < 64; ++j) if (ch[j] > best) { best = ch[j]; bi = j; }
        float sv = 0.f;
#pragma unroll
        for (int j = 0; j < 64; ++j) if (j == bi) { sv = sc[j]; ch[j] = -INFINITY; }
        idx[k] = bi; w[k] = sv; wsum_ += sv; }
    const float inv = 2.5f / (wsum_ + 1e-20f);
#pragma unroll
    for (int k = 0; k < 6; ++k) w[k] *= inv;
}

namespace gold {
__global__ void __launch_bounds__(64) route_rows(const float* __restrict__ logits, const float* __restrict__ rbias, int* __restrict__ topi, float* __restrict__ topw, int ntok) {
    const int r = blockIdx.x * 64 + threadIdx.x; if (r >= ntok) return;
    float lg[64];
#pragma unroll
    for (int j = 0; j < 16; ++j) { const float4 v = ((const float4*)(logits + (size_t)r * 64))[j]; lg[4 * j] = v.x; lg[4 * j + 1] = v.y; lg[4 * j + 2] = v.z; lg[4 * j + 3] = v.w; }
    int idx[6]; float w[6]; route_token(lg, rbias, idx, w);
#pragma unroll
    for (int k = 0; k < 6; ++k) { topi[(size_t)r * 6 + k] = idx[k]; topw[(size_t)r * 6 + k] = w[k]; }
}
__global__ void __launch_bounds__(256) moe_naive(const float* x1, const int* __restrict__ topi, const float* __restrict__ topw,
                                                  const float* __restrict__ weg, const float* __restrict__ weu, const float* __restrict__ wed,
                                                  const float* __restrict__ wsg, const float* __restrict__ wsu, const float* __restrict__ wsd,
                                                  const float* __restrict__ g2, const float* __restrict__ b2, float* out) {
    __shared__ float xs[1024]; __shared__ float hs[256]; __shared__ float red[8];
    const int r = blockIdx.x, tid = threadIdx.x;
#pragma unroll
    for (int j = 0; j < 4; ++j) xs[tid + 256 * j] = x1[(size_t)r * 1024 + tid + 256 * j];
    __syncthreads();
    float acc[4] = {0.f, 0.f, 0.f, 0.f};
    for (int ei = 0; ei < 7; ++ei) {
        const int e = ei < 6 ? topi[(size_t)r * 6 + ei] : 0; const float w = ei < 6 ? topw[(size_t)r * 6 + ei] : 1.f;
        const float* Wg = ei < 6 ? weg + (size_t)e * 1024 * 256 : wsg; const float* Wu = ei < 6 ? weu + (size_t)e * 1024 * 256 : wsu; const float* Wd = ei < 6 ? wed + (size_t)e * 256 * 1024 : wsd;
        float gg = 0.f, uu = 0.f;
        for (int k = 0; k < 1024; ++k) { const float xv = xs[k]; gg = fmaf(xv, Wg[(size_t)k * 256 + tid], gg); uu = fmaf(xv, Wu[(size_t)k * 256 + tid], uu); }
        hs[tid] = gg / (1.f + __expf(-gg)) * uu;
        __syncthreads();
        float y[4] = {0.f, 0.f, 0.f, 0.f};
        for (int i = 0; i < 256; ++i) { const float hv = hs[i];
#pragma unroll
            for (int j = 0; j < 4; ++j) y[j] = fmaf(hv, Wd[(size_t)i * 1024 + tid + 256 * j], y[j]); }
#pragma unroll
        for (int j = 0; j < 4; ++j) acc[j] = fmaf(w, y[j], acc[j]);
        __syncthreads();
    }
    float v[4]; float s = 0.f;
#pragma unroll
    for (int j = 0; j < 4; ++j) { v[j] = ALPHA * xs[tid + 256 * j] + acc[j]; s += v[j]; }
    s = wsum(s); if ((tid & 63) == 0) red[tid >> 6] = s; __syncthreads();
    const float mean = (red[0] + red[1] + red[2] + red[3]) * (1.f / 1024.f); float q = 0.f;
#pragma unroll
    for (int j = 0; j < 4; ++j) { v[j] -= mean; q = fmaf(v[j], v[j], q); }
    q = wsum(q); if ((tid & 63) == 0) red[4 + (tid >> 6)] = q; __syncthreads();
    const float rstd = rsqrtf((red[4] + red[5] + red[6] + red[7]) * (1.f / 1024.f) + LN_EPS);
#pragma unroll
    for (int j = 0; j < 4; ++j) { const int c = tid + 256 * j; out[(size_t)r * 1024 + c] = v[j] * rstd * g2[c] + b2[c]; }
}

struct In {
    const float *x, *w_in, *lam_re, *lam_im, *log_dt, *b_re, *b_im, *c_re, *c_im, *d_skip, *w_glu, *b_glu, *q_norm_g, *w_uq, *kv_norm_g, *w_ukv, *w_o, *ln1_g, *ln1_b,
                *w_router, *router_bias, *we_gate, *we_up, *we_down, *ws_gate, *ws_up, *ws_down, *ln2_g, *ln2_b;
};
constexpr size_t GOLD_FLOATS_PER_TOK = 6400;
struct Bufs { float *proj, *spre, *gl, *mix, *cqn, *ckvn, *q, *kv, *krope, *mixo, *logits; int* topi; float* topw; };
static Bufs run(const In& I, int tok0, int ntok, float* scratch, float* x1out, float* out, hipStream_t st) {
    Bufs B;
    B.proj = scratch; B.spre = B.proj + (size_t)ntok * 928; B.gl = B.spre + (size_t)ntok * 512; B.mix = B.gl + (size_t)ntok * 512;
    B.cqn = B.mix + (size_t)ntok * 1024; B.ckvn = B.cqn + (size_t)ntok * 256; B.q = B.ckvn + (size_t)ntok * 128; B.kv = B.q + (size_t)ntok * 768;
    B.krope = B.kv + (size_t)ntok * 1024; B.mixo = B.krope + (size_t)ntok * 32; B.logits = B.mixo + (size_t)ntok * 1024;
    B.topi = (int*)(B.logits + (size_t)ntok * 64); B.topw = (float*)(B.topi + (size_t)ntok * 6);
    float *proj = B.proj, *spre = B.spre, *gl = B.gl, *mix = B.mix, *cqn = B.cqn, *ckvn = B.ckvn, *q = B.q, *kv = B.kv, *krope = B.krope, *mixo = B.mixo, *logits = B.logits; int* topi = B.topi; float* topw = B.topw;
    const float* x = I.x + (size_t)tok0 * 1024; const int nb = ntok / SEQ;
    hipLaunchKernelGGL(sgemm, dim3((928 + 63) / 64, ntok / 64), dim3(256), 0, st, x, 1024, I.w_in, 928, proj, 928, ntok, 928, 1024);
    hipLaunchKernelGGL(ssm_naive, dim3(32, nb), dim3(64), 0, st, proj, 928, I.lam_re, I.lam_im, I.log_dt, I.b_re, I.b_im, I.c_re, I.c_im, I.d_skip, spre);
    hipLaunchKernelGGL(sgemm, dim3(8, ntok / 64), dim3(256), 0, st, spre, 512, I.w_glu, 512, gl, 512, ntok, 512, 512);
    hipLaunchKernelGGL(glu_ew, dim3((unsigned)(((size_t)ntok * 512 + 255) / 256)), dim3(256), 0, st, spre, gl, I.b_glu, mix, ntok);
    hipLaunchKernelGGL(rmsnorm_rows, dim3((ntok + 255) / 256), dim3(256), 0, st, proj, 928, 512, 256, I.q_norm_g, cqn, ntok);
    hipLaunchKernelGGL(rmsnorm_rows, dim3((ntok + 255) / 256), dim3(256), 0, st, proj, 928, 768, 128, I.kv_norm_g, ckvn, ntok);
    hipLaunchKernelGGL(sgemm, dim3(12, ntok / 64), dim3(256), 0, st, cqn, 256, I.w_uq, 768, q, 768, ntok, 768, 256);
    hipLaunchKernelGGL(sgemm, dim3(16, ntok / 64), dim3(256), 0, st, ckvn, 128, I.w_ukv, 1024, kv, 1024, ntok, 1024, 128);
    hipLaunchKernelGGL(rope_ew, dim3((ntok * 144 + 255) / 256), dim3(256), 0, st, q, proj, 928, krope, ntok);
    hipLaunchKernelGGL(attn_naive, dim3(SEQ / 64, 8, nb), dim3(64), 0, st, q, kv, krope, mix);
    hipLaunchKernelGGL(sgemm, dim3(16, ntok / 64), dim3(256), 0, st, mix, 1024, I.w_o, 1024, mixo, 1024, ntok, 1024, 1024);
    hipLaunchKernelGGL(ln1_rows, dim3(ntok / 4), dim3(256), 0, st, x, mixo, I.ln1_g, I.ln1_b, x1out, ntok);
    hipLaunchKernelGGL(sgemm, dim3(1, ntok / 64), dim3(256), 0, st, x1out, 1024, I.w_router, 64, logits, 64, ntok, 64, 1024);
    hipLaunchKernelGGL(route_rows, dim3(ntok / 64), dim3(64), 0, st, logits, I.router_bias, topi, topw, ntok);
    hipLaunchKernelGGL(moe_naive, dim3(ntok), dim3(256), 0, st, x1out, topi, topw, I.we_gate, I.we_up, I.we_down, I.ws_gate, I.ws_up, I.ws_down, I.ln2_g, I.ln2_b, out);
    return B;
}
}
#define GAS __attribute__((address_space(1)))
#define LAS __attribute__((address_space(3)))
typedef unsigned short bf16_t;
typedef short bf16x8 __attribute__((ext_vector_type(8)));
typedef short s16x4 __attribute__((ext_vector_type(4)));
typedef float f32x4 __attribute__((ext_vector_type(4)));
typedef float f32x2 __attribute__((ext_vector_type(2)));
typedef float f32x16 __attribute__((ext_vector_type(16)));
typedef unsigned u32x4 __attribute__((ext_vector_type(4)));
typedef unsigned u32x2 __attribute__((ext_vector_type(2)));

namespace fx {
constexpr int T = 65536, SEQ = 2048, DM = 1024, NB = 32;
constexpr int CHK = 32;
constexpr int NCHK = SEQ / CHK;
constexpr int UHR = NB * NCHK;
constexpr int UHK = CHK * 16 + 256;
constexpr int Y8_LD = 1024;
constexpr int SPRE_LD = 512;
constexpr int NCH = 2;
constexpr int CAPC = T / NCH;
constexpr int NVE = NCH * 65;
constexpr float ALPHA = 1.189207115002721f, LN_EPS = 1e-5f, RMS_EPS = 1e-6f;
constexpr float QSCALE = 0.10206207261596577f * 1.4426950408889634f;

constexpr size_t MiB = 1u << 20;
constexpr size_t WS_CTL = 0, CTL_BYTES = 1 * MiB;
constexpr size_t WS_ROPE = 1 * MiB;
constexpr size_t WS_KT = 2 * MiB;
constexpr size_t WS_WIN = 4 * MiB, WS_WGLU = 6 * MiB, WS_WUQ = 6 * MiB + 512 * 1024, WS_WUKV = 7 * MiB, WS_WO = 8 * MiB;
constexpr size_t WS_WST = 10 * MiB, WS_MO = 18 * MiB, WS_WGU = 42 * MiB  , WS_WR = 107 * MiB  , WS_WD = 107 * MiB + 512 * 1024;
constexpr size_t WS_SSQQ = 140 * MiB, WS_SSQKV = 141 * MiB, WS_TSLOT = 142 * MiB, WS_TOPW = 144 * MiB, WS_ROWTOK = 146 * MiB, WS_LOGIT = 162 * MiB;
constexpr size_t WS_XB = 178 * MiB, WS_UH = 306 * MiB, WS_CQ = 402 * MiB, WS_CKVR = 434 * MiB, WS_S = 466 * MiB, WS_Q = 530 * MiB, WS_KV = 626 * MiB, WS_SPRE = 754 * MiB, WS_MIX = 818 * MiB;
constexpr size_t WS_X1B = 178 * MiB, WS_H = 306 * MiB, WS_Y = 562 * MiB  , WS_YS = 800 * MiB  , WS_HS = 864 * MiB  ;
constexpr size_t WS_GOLD = 946 * MiB, WS_END = 1024 * MiB;
constexpr int CW_TMO = 0, CW_CODE = 1, CW_BAR = 4096, CW_CNT = 16384  , CW_DBG = 65536  , CW_QUEUE = 32768  ;

constexpr int RING_BYTES = 131072, TAB_OFF = RING_BYTES, IDX_OFF = TAB_OFF + 10752  , IDX_UNITS = 16, MISC_OFF = IDX_OFF + IDX_UNITS * 1024, LDS_BYTES = MISC_OFF + 256;

__device__ __forceinline__ unsigned cvt_pk_bf16(float lo, float hi) { unsigned r; asm volatile("v_cvt_pk_bf16_f32 %0, %1, %2" : "=v"(r) : "v"(lo), "v"(hi)); return r; }
__device__ __forceinline__ float bf_lo(unsigned w) { return __uint_as_float(w << 16); }
__device__ __forceinline__ float bf_hi(unsigned w) { return __uint_as_float(w & 0xffff0000u); }
__device__ __forceinline__ u32x4 pack8(const f32x4 a, const f32x4 b) { u32x4 w; w.x = cvt_pk_bf16(a[0], a[1]); w.y = cvt_pk_bf16(a[2], a[3]); w.z = cvt_pk_bf16(b[0], b[1]); w.w = cvt_pk_bf16(b[2], b[3]); return w; }
__device__ __forceinline__ void unpack8(const u32x4 w, f32x4& a, f32x4& b) { a = (f32x4){bf_lo(w.x), bf_hi(w.x), bf_lo(w.y), bf_hi(w.y)}; b = (f32x4){bf_lo(w.z), bf_hi(w.z), bf_lo(w.w), bf_hi(w.w)}; }
__device__ __forceinline__ float fast_sigmoid(float x) { return __builtin_amdgcn_rcpf(1.f + __builtin_amdgcn_exp2f(-1.4426950408889634f * x)); }
__device__ __forceinline__ float gelu_tanh_f(float x) {
    const float z2 = 1.5957691216057308f * (x + 0.044715f * x * x * x);
    return x * fast_sigmoid(z2);
}
#ifndef SC1_STORES
#define SC1_STORES 0
#endif
__device__ __forceinline__ void store16(void* p, const u32x4 v) {
#if SC1_STORES
    asm volatile("global_store_dwordx4 %0, %1, off sc1\n\ts_nop 1" :: "v"(p), "v"(v) : "memory");
#else
    *(u32x4*)p = v;
#endif
}
__device__ __forceinline__ u32x4 ror8_x4(const u32x4 v) { u32x4 r;
    r.x = (unsigned)__builtin_amdgcn_update_dpp(0, (int)v.x, 0x128, 0xF, 0xF, false); r.y = (unsigned)__builtin_amdgcn_update_dpp(0, (int)v.y, 0x128, 0xF, 0xF, false);
    r.z = (unsigned)__builtin_amdgcn_update_dpp(0, (int)v.z, 0x128, 0xF, 0xF, false); r.w = (unsigned)__builtin_amdgcn_update_dpp(0, (int)v.w, 0x128, 0xF, 0xF, false); return r; }
__device__ __forceinline__ void store_lines16(bf16_t* rowp, size_t ld, const u32x4 X, const u32x4 Y, int fr, int fq) {
    const bool lo = fr < 8; const u32x4 S = lo ? Y : X, R = ror8_x4(S);
    const u32x4 A1 = lo ? X : R, A2 = lo ? R : Y;
    bf16_t* p = rowp + (size_t)(fr & 7) * ld + (lo ? 8 * fq : 32 + 8 * fq);
    *(u32x4*)p = A1; *(u32x4*)(p + 8 * ld) = A2;
}
__device__ __forceinline__ float wave_sum(float v) {
#pragma unroll
    for (int o = 1; o < 64; o <<= 1) v += __shfl_xor(v, o);
    return v;
}

#define XB_TMO      128
#define XB_XCNT(j)  (256  + 64 * (j))
#define XB_XSUB(j)  (1280 + 64 * (j))
#define XB_XGEN(j)  (2304 + 64 * (j))
#define XB_TOP      3328
#define XB_TOPGEN   3392
#define XCD_BAR_WORDS 3456
#define XB_SPIN_CAP (1u << 18)
__device__ __forceinline__ unsigned xb_ld(unsigned* p)              { return __hip_atomic_load(p, __ATOMIC_RELAXED, __HIP_MEMORY_SCOPE_AGENT); }
__device__ __forceinline__ unsigned xb_add(unsigned* p, unsigned v) { return __hip_atomic_fetch_add(p, v, __ATOMIC_RELAXED, __HIP_MEMORY_SCOPE_AGENT); }
__device__ __forceinline__ unsigned xb_xcc_id() { return (unsigned)__builtin_amdgcn_s_getreg((3 << 11) | 20) & 0xFu; }
#define XB_SPIN(cond, bar) do { unsigned _sp = 0; while (cond) { __builtin_amdgcn_s_sleep(1); \
    if ((++_sp & 255u) == 0u) { if (xb_ld(&(bar)[XB_TMO])) break; if (_sp > XB_SPIN_CAP) { atomicAdd(&(bar)[XB_TMO], 1u); break; } } } } while (0)
struct XcdBarrier { unsigned* bar; unsigned x; volatile LAS unsigned* st; };
__device__ __forceinline__ XcdBarrier xcd_barrier_post(unsigned* bar, volatile LAS unsigned* st) {
    XcdBarrier b; b.bar = bar; b.x = xb_xcc_id(); b.st = st;
    if (threadIdx.x == 0) (void)xb_add(&bar[XB_XCNT(b.x)], 1u);
    return b;
}
__device__ __forceinline__ void xcd_barrier_complete(unsigned* bar, unsigned x, unsigned& nloc, unsigned& nx) {
    const unsigned G = gridDim.x * gridDim.y * gridDim.z;
    unsigned sum, cnt, mine, sp = 0u;
    for (;;) {
        sum = 0u; cnt = 0u; mine = 0u;
#pragma unroll
        for (unsigned j = 0; j < 16; ++j) { const unsigned c = xb_ld(&bar[XB_XCNT(j)]); sum += c; cnt += (c > 0u) ? 1u : 0u; mine = (j == x) ? c : mine; }
        if (sum == G) break;
        __builtin_amdgcn_s_sleep(1);
        if ((++sp & 255u) == 0u) { if (xb_ld(&bar[XB_TMO])) break; if (sp > XB_SPIN_CAP) { atomicAdd(&bar[XB_TMO], 1u); break; } }
    }
    nloc = mine > 0u ? mine : 1u; nx = cnt > 0u ? cnt : 1u;
}
__device__ __forceinline__ void xcd_barrier(const XcdBarrier& b) {
    asm volatile("s_waitcnt vmcnt(0)" ::: "memory");
    __syncthreads();
    if (threadIdx.x == 0) {
        unsigned* bar = b.bar;
        __builtin_amdgcn_s_waitcnt(0);
        unsigned nloc = b.st[0], nx = b.st[1];
        if (nloc == 0u) { xcd_barrier_complete(bar, b.x, nloc, nx); b.st[0] = nloc; b.st[1] = nx; }
        const unsigned old = xb_add(&bar[XB_XSUB(b.x)], 1u);
        const unsigned gen = old / nloc;
        if (old + 1u == (gen + 1u) * nloc) {
            __builtin_amdgcn_fence(__ATOMIC_RELEASE, "agent");
            asm volatile("s_waitcnt vmcnt(0)" ::: "memory");
            const unsigned og = xb_add(&bar[XB_TOP], 1u);
            const unsigned tg = og / nx;
            if (og + 1u == (tg + 1u) * nx) xb_add(&bar[XB_TOPGEN], 1u);
            else XB_SPIN(xb_ld(&bar[XB_TOPGEN]) == tg, bar);
            __builtin_amdgcn_fence(__ATOMIC_ACQUIRE, "agent");
            xb_add(&bar[XB_XGEN(b.x)], 1u);
            asm volatile("s_waitcnt vmcnt(0)" ::: "memory");
        } else {
            XB_SPIN(xb_ld(&bar[XB_XGEN(b.x)]) == gen, bar);
            __builtin_amdgcn_fence(__ATOMIC_ACQUIRE, "agent");
            asm volatile("s_waitcnt vmcnt(0)" ::: "memory");
        }
    }
    __syncthreads();
}

constexpr int BM = 256, BK = 64, HALF = 128, HTB = HALF * BK * 2, STAGE_BYTES = 8 * HTB;
__host__ __device__ __forceinline__ int lds_byte(int r, int c) { const int st = (r >> 4) * 2 + (c >> 5), rr = r & 15, cc = c & 31, ob = rr * 64 + cc * 2; return st * 1024 + (ob ^ (((ob >> 9) & 1) << 5)); }
__host__ __device__ __forceinline__ void stage_rc(int b, int& R, int& C) { const int st = b / 1024, sb = b % 1024, swz = sb ^ (((sb >> 9) & 1) << 5); R = (st >> 1) * 16 + swz / 64; C = (st & 1) * 32 + (swz % 64) / 2; }
__host__ __device__ __forceinline__ int perm32(int rho) { const int n = rho >> 4, i = rho & 15; return 8 * (i >> 2) + 4 * n + (i & 3); }
__host__ __device__ __forceinline__ int perm16x(int rho) { const int n = rho >> 4, i = rho & 15; return 16 * (i >> 2) + 4 * n + (i & 3); }

struct Unit { const char* A; const char* B; int i0, i1, i2, i3; };
__device__ __forceinline__ int xcd_remap(int L, int nwg) { const int q = nwg / 8, r = nwg % 8, xcd = L % 8, off = L / 8; return (xcd < r ? xcd * (q + 1) : r * (q + 1) + (xcd - r) * q) + off; }

template <class Epi, class Sched, bool ALIGN_EPI, bool GATHER, int STAG = 0, int AMODE = 0>
__device__ __forceinline__ void gemm_phase(LAS unsigned char* lds, const int lda, const int ldb, const int K, const Sched& S, const Epi& E) {
    if constexpr (STAG > 0) { const unsigned long long t0_ = __builtin_amdgcn_s_memrealtime(), dl_ = (unsigned long long)STAG * ((blockIdx.x >> 3) & 3u); while (__builtin_amdgcn_s_memrealtime() - t0_ < dl_) __builtin_amdgcn_s_sleep(4); }
    int tid = threadIdx.x; asm volatile("" : "+v"(tid));
    const int wid = __builtin_amdgcn_readfirstlane(tid >> 6), lane = tid & 63, wr = wid >> 2, wc = wid & 3, fr = lane & 15, fq = lane >> 4;
    const int nt = K / BK;
    unsigned voffA[2], voffB[2]; int RA[2], CA[2];
#pragma unroll
    for (int i = 0; i < 2; ++i) { int R, C; stage_rc(tid * 16 + i * 8192, R, C); const int Rb = 64 * (R >> 5) + (Epi::PERM == 2 ? perm16x(R & 31) : Epi::PERM ? perm32(R & 31) : (R & 31));
        RA[i] = R; CA[i] = C; voffA[i] = AMODE == 1 ? (unsigned)((R >> 4) * 8192 + (R & 7) * 1024 + (C >> 5) * 128 + ((R >> 3) & 1) * 64 + (C & 31) * 2) : (unsigned)(R * lda + C) * 2u; voffB[i] = (unsigned)(Rb * ldb + C) * 2u; }
    const size_t kstep = (size_t)(BK * 2), kstepA = AMODE == 1 ? 256 : kstep;
    const size_t hstepA = (size_t)HALF * lda * 2, hstepB = (size_t)(Epi::PERM == 2 ? 8 : 32) * ldb * 2;
    const unsigned ldsw = (unsigned)wid * 1024u;
    const int aoff = lds_byte(wr * 64 + fr, fq * 8), boff = lds_byte(wc * 32 + fr, fq * 8);
#define PG8_SA(b, h) (((b) * 2 + (h)) * HTB)
#define PG8_SB(b, h) ((4 + (b) * 2 + (h)) * HTB)
#define PG8_STAGE(bufoff, gbase, voff) do { _Pragma("unroll") for (int _i = 0; _i < 2; ++_i) \
        __builtin_amdgcn_global_load_lds((const unsigned*)((const char*)(gbase) + (voff)[_i]), (LAS unsigned*)(lds + (bufoff) + ldsw + _i * 8192), 16, 0, 0); } while (0)
#define PG8_STAGE_A(bufoff, base, g0, g1, h, kb) do { if constexpr (GATHER) { \
        __builtin_amdgcn_global_load_lds((const unsigned*)((base) + (kb) + (g0)), (LAS unsigned*)(lds + (bufoff) + ldsw), 16, 0, 0); \
        __builtin_amdgcn_global_load_lds((const unsigned*)((base) + (kb) + (g1)), (LAS unsigned*)(lds + (bufoff) + ldsw + 8192), 16, 0, 0); } \
      else { PG8_STAGE(bufoff, (base) + (h) * hstepA + (kb), voffA); } } while (0)
#define PG8_LDA(dst, b, h) do { _Pragma("unroll") for (int m = 0; m < 4; ++m) _Pragma("unroll") for (int k = 0; k < 2; ++k) dst[m][k] = *(const LAS bf16x8*)(lds + PG8_SA(b, h) + aoff + m * 2048 + k * 1024); } while (0)
#define PG8_LDB(dst, b, h) do { _Pragma("unroll") for (int n = 0; n < 2; ++n) _Pragma("unroll") for (int k = 0; k < 2; ++k) dst[n][k] = *(const LAS bf16x8*)(lds + PG8_SB(b, h) + boff + n * 2048 + k * 1024); } while (0)
#define PG8_MMA(ai, bj, At, Bt) do { __builtin_amdgcn_s_setprio(1); _Pragma("unroll") for (int m = 0; m < 4; ++m) _Pragma("unroll") for (int n = 0; n < 2; ++n) _Pragma("unroll") for (int k = 0; k < 2; ++k) \
        acc[ai][bj][m][n] = __builtin_amdgcn_mfma_f32_16x16x32_bf16(Bt[n][k], At[m][k], acc[ai][bj][m][n], 0, 0, 0); __builtin_amdgcn_s_setprio(0); } while (0)
#define PG8_WAIT_V(n) asm volatile("s_waitcnt vmcnt(" #n ")" ::: "memory")
#define PG8_WAIT_VN(n) asm volatile("s_waitcnt vmcnt(%0)" :: "n"(n) : "memory")
#define PG8_WAIT_L(n) asm volatile("s_waitcnt lgkmcnt(" #n ")" ::: "memory")
#define PG8_BAR __builtin_amdgcn_s_barrier()
#define PG8_SCHED __builtin_amdgcn_sched_barrier(0)
    Unit cur, nxt; int ui = 0;
    if (!S.next(0, cur)) return;
    unsigned gc00 = 0, gc01 = 0, gc10 = 0, gc11 = 0, gn00 = 0, gn01 = 0, gn10 = 0, gn11 = 0;
    if constexpr (GATHER) { S.gather(cur, RA[0], CA[0], RA[1], CA[1], gc00, gc01, gc10, gc11); gn00 = gc00; gn01 = gc01; gn10 = gc10; gn11 = gc11; }
    f32x4 acc[2][2][4][2];
#pragma unroll
    for (int a = 0; a < 2; ++a)
#pragma unroll
        for (int b = 0; b < 2; ++b)
#pragma unroll
            for (int m = 0; m < 4; ++m)
#pragma unroll
                for (int n = 0; n < 2; ++n) acc[a][b][m][n] = (f32x4){0.f, 0.f, 0.f, 0.f};
    bf16x8 At[4][2], B0[2][2], B1[2][2];
    const char* cA = cur.A; const char* cB = cur.B;
    PG8_STAGE(PG8_SB(0, 0), cB, voffB); PG8_STAGE(PG8_SB(0, 1), cB + hstepB, voffB); PG8_STAGE_A(PG8_SA(0, 0), cA, gc00, gc01, 0, 0); PG8_STAGE_A(PG8_SA(0, 1), cA, gc10, gc11, 1, 0);
    if (wr == 1) PG8_BAR;
    PG8_WAIT_V(2); PG8_BAR;
    PG8_STAGE(PG8_SB(1, 0), cB + kstep, voffB); PG8_STAGE_A(PG8_SA(1, 0), cA, gc00, gc01, 0, kstepA); PG8_STAGE(PG8_SB(1, 1), cB + hstepB + kstep, voffB);
    PG8_WAIT_V(6); PG8_BAR;
    for (;;) {
        const bool has_next = S.next(ui + 1, nxt);
        if constexpr (GATHER) { if (has_next) S.gather(nxt, RA[0], CA[0], RA[1], CA[1], gn00, gn01, gn10, gn11); }
        const char* nA = has_next ? nxt.A : cA; const char* nB = has_next ? nxt.B : cB;
#pragma unroll 1
        for (int t = 0; t < nt; t += 2) {
            const bool last = (t == nt - 2);
            const size_t k1 = (size_t)(t + 1) * kstepA;
            const char* a2 = last ? nA : cA; const char* b2 = last ? nB : cB + (size_t)(t + 2) * kstep;
            const size_t k2 = last ? 0 : (size_t)(t + 2) * kstepA, k3 = k2 + kstepA;
            const char* b3 = b2 + kstep;
            unsigned g200 = gc00, g201 = gc01, g210 = gc10, g211 = gc11;
            if constexpr (GATHER) { if (last) { g200 = gn00; g201 = gn01; g210 = gn10; g211 = gn11; } }
            PG8_LDB(B0, 0, 0); PG8_LDB(B1, 0, 1); PG8_SCHED; PG8_LDA(At, 0, 0); PG8_STAGE_A(PG8_SA(1, 1), cA, gc10, gc11, 1, k1);
            PG8_WAIT_V(8); PG8_WAIT_L(0); PG8_BAR; PG8_MMA(0, 0, At, B0); PG8_MMA(0, 1, At, B1); PG8_BAR; PG8_SCHED;
            PG8_LDA(At, 0, 1); PG8_STAGE(PG8_SB(0, 0), b2, voffB); PG8_STAGE(PG8_SB(0, 1), b2 + hstepB, voffB); PG8_STAGE_A(PG8_SA(0, 0), a2, g200, g201, 0, k2);
            PG8_WAIT_V(8); PG8_WAIT_L(0); PG8_BAR; PG8_MMA(1, 0, At, B0); PG8_MMA(1, 1, At, B1); PG8_BAR; PG8_SCHED;
            PG8_LDB(B0, 1, 0); PG8_LDB(B1, 1, 1); PG8_SCHED; PG8_LDA(At, 1, 0); PG8_STAGE_A(PG8_SA(0, 1), a2, g210, g211, 1, k2);
            PG8_WAIT_V(8); PG8_WAIT_L(0); PG8_BAR; PG8_MMA(0, 0, At, B0); PG8_MMA(0, 1, At, B1); PG8_BAR; PG8_SCHED;
            PG8_LDA(At, 1, 1); PG8_STAGE(PG8_SB(1, 0), b3, voffB); PG8_STAGE(PG8_SB(1, 1), b3 + hstepB, voffB); PG8_STAGE_A(PG8_SA(1, 0), a2, g200, g201, 0, k3);
            PG8_WAIT_V(8); PG8_WAIT_L(0); PG8_BAR; PG8_MMA(1, 0, At, B0); PG8_MMA(1, 1, At, B1); PG8_BAR; PG8_SCHED;
        }
#if defined(MK_TPROBE) && MK_TPROBE >= 200
        unsigned long long tp0_ = 0; if (blockIdx.x == 0 && wid == 0) tp0_ = __builtin_amdgcn_s_memrealtime();
#endif
        if constexpr (ALIGN_EPI) { if (wr == 0) PG8_BAR; }
        E(acc, cur, wr, wc, fr, fq);
#if defined(MK_TPROBE) && MK_TPROBE >= 200
        if (blockIdx.x == 0 && wid == 0) { asm volatile("s_waitcnt vmcnt(0)" ::: "memory"); const unsigned long long d_ = __builtin_amdgcn_s_memrealtime() - tp0_; if (lane == 0) { volatile LAS unsigned* M_ = (volatile LAS unsigned*)(lds + MISC_OFF); const unsigned long long a_ = (((unsigned long long)M_[23] << 32) | M_[22]) + d_; M_[22] = (unsigned)a_; M_[23] = (unsigned)(a_ >> 32); } }
#endif
        if (!has_next) break;
#pragma unroll
        for (int a = 0; a < 2; ++a)
#pragma unroll
            for (int b = 0; b < 2; ++b)
#pragma unroll
                for (int m = 0; m < 4; ++m)
#pragma unroll
                    for (int n = 0; n < 2; ++n) acc[a][b][m][n] = (f32x4){0.f, 0.f, 0.f, 0.f};
        cur = nxt; cA = nA; cB = nB; ++ui;
        if constexpr (GATHER) { gc00 = gn00; gc01 = gn01; gc10 = gn10; gc11 = gn11; }
        if constexpr (ALIGN_EPI) { if (wr == 1) PG8_BAR; }
    }
    PG8_WAIT_V(0);
    if constexpr (!ALIGN_EPI) { if (wr == 0) PG8_BAR; }
    PG8_BAR;
#undef PG8_SA
#undef PG8_SB
#undef PG8_STAGE
#undef PG8_STAGE_A
#undef PG8_LDA
#undef PG8_LDB
#undef PG8_MMA
#undef PG8_WAIT_V
#undef PG8_WAIT_VN
#undef PG8_WAIT_L
#undef PG8_BAR
#undef PG8_SCHED
}
}
namespace fx {
#define FX_ROWLOOP _Pragma("unroll") for (int ai = 0; ai < 2; ++ai) _Pragma("unroll") for (int m = 0; m < 4; ++m)

struct PlainOrder {
    const char* A; const char* B; int lda, ldb, nM, nN, nwg, G, c;
    __device__ __forceinline__ void init(const void* A_, int lda_, const void* B_, int ldb_, int M, int N, int G_, int c_) { A = (const char*)A_; B = (const char*)B_; lda = lda_; ldb = ldb_; nM = M / 256; nN = N / 256; nwg = nM * nN; G = G_; c = c_; }
    __device__ __forceinline__ bool next(int i, Unit& u) const {
        const long L = (long)i * G + c; if (L >= nwg) return false;
        const int wgid = xcd_remap((int)L, nwg);
        const int nig = 8 * nN, gid = wgid / nig, fm = gid * 8, gsz = (nM - fm) < 8 ? (nM - fm) : 8;
        const int pm = fm + ((wgid % nig) % gsz), pn = (wgid % nig) / gsz;
        u.A = A + (size_t)pm * 256 * lda * 2; u.B = B + (size_t)pn * 256 * ldb * 2; u.i0 = pm; u.i1 = pn; u.i2 = 0; u.i3 = 0; return true;
    }
};
struct PanelOrder {
    const char* A; const char* B; int lda, ldb, nM, nN, G, c;
    __device__ __forceinline__ void init(const void* A_, int lda_, const void* B_, int ldb_, int M, int N, int G_, int c_) { A = (const char*)A_; B = (const char*)B_; lda = lda_; ldb = ldb_; nM = M / 256; nN = N / 256; G = G_; c = c_; }
    __device__ __forceinline__ bool next(int i, Unit& u) const {
        const int j = i / nN, pn = i - j * nN, pm = c + j * G; if (pm >= nM) return false;
        u.A = A + (size_t)pm * 256 * lda * 2; u.B = B + (size_t)pn * 256 * ldb * 2; u.i0 = pm; u.i1 = pn; u.i2 = 0; u.i3 = 0; return true;
    }
};
struct GroupOrder {
    const char* A; const char* B; int ldb, nN, nwg, G, c;
    __device__ __forceinline__ void init(const void* A_, const void* B_, int ldb_, int nN_, int G_, int c_) { A = (const char*)A_; B = (const char*)B_; ldb = ldb_; nN = nN_; nwg = 32 * 8 * nN_; G = G_; c = c_; }
    __device__ __forceinline__ bool next(int i, Unit& u) const {
        const long L = (long)i * G + c; if (L >= nwg) return false;
        const int wgid = xcd_remap((int)L, nwg);
        const int per = 8 * nN, g = wgid / per, rem = wgid % per, pm = rem % 8, pn = rem / 8;
        u.A = A + ((size_t)g * UHR + (size_t)pm * 256) * UHK * 2; u.B = B + ((size_t)g * nN * 256 + (size_t)pn * 256) * ldb * 2; u.i0 = g; u.i1 = pm; u.i2 = pn; u.i3 = 0; return true;
    }
};

__device__ __forceinline__ void rope8(f32x4& v0, f32x4& v1, const float* __restrict__ ropec, const float* __restrict__ ropes, int pos, int fq) {
    const f32x4 c = *(const f32x4*)(ropec + pos * 16 + 4 * fq), s = *(const f32x4*)(ropes + pos * 16 + 4 * fq);
    const f32x4 a = v0, b = v1;
    v0 = (f32x4){a[0] * c[0] - a[1] * s[0], a[0] * s[0] + a[1] * c[0], a[2] * c[1] - a[3] * s[1], a[2] * s[1] + a[3] * c[1]};
    v1 = (f32x4){b[0] * c[2] - b[1] * s[2], b[0] * s[2] + b[1] * c[2], b[2] * c[3] - b[3] * s[3], b[2] * s[3] + b[3] * c[3]};
}
__device__ __forceinline__ float sumsq8(const f32x4 a, const f32x4 b) { return (a[0] * a[0] + a[1] * a[1]) + (a[2] * a[2] + a[3] * a[3]) + (b[0] * b[0] + b[1] * b[1]) + (b[2] * b[2] + b[3] * b[3]); }

struct EpiWin {
    static constexpr int PERM = 1; static constexpr int NST = 16;
    bf16_t* UH; bf16_t* CQ; bf16_t* CKVR; float* ssqq; float* ssqkv; const float* ropec; const float* ropes;
    __device__ __forceinline__ void operator()(const f32x4 (&acc)[2][2][4][2], const Unit& u, int wr, int wc, int fr, int fq) const {
        const int pm = u.i0, pn = u.i1, row0 = pm * 256 + wr * 64 + fr;
        if (pn < 2) {
            FX_ROWLOOP { const int row = row0 + ai * 128 + m * 16, r32 = row >> 5, tq = row & 31;
#pragma unroll
                for (int bj = 0; bj < 2; ++bj) { const int c = pn * 256 + wc * 64 + bj * 32 + 8 * fq, g = c >> 4, p0 = c & 15;
                    *(u32x4*)(UH + ((size_t)(g * UHR + r32) * UHK + tq * 16 + p0)) = pack8(acc[ai][bj][m][0], acc[ai][bj][m][1]); } }
        } else if (pn == 2) {
            FX_ROWLOOP { const int row = row0 + ai * 128 + m * 16; float ss = sumsq8(acc[ai][0][m][0], acc[ai][0][m][1]) + sumsq8(acc[ai][1][m][0], acc[ai][1][m][1]);
                store_lines16(CQ + (size_t)(row - fr) * 256 + 64 * wc, 256, pack8(acc[ai][0][m][0], acc[ai][0][m][1]), pack8(acc[ai][1][m][0], acc[ai][1][m][1]), fr, fq);
                ss += __shfl_xor(ss, 16); ss += __shfl_xor(ss, 32);
                if (fq == 0) ssqq[(size_t)row * 4 + wc] = ss; }
        } else {
            FX_ROWLOOP { const int row = row0 + ai * 128 + m * 16; float ss = 0.f; u32x4 w[2];
#pragma unroll
                for (int bj = 0; bj < 2; ++bj) { f32x4 v0 = acc[ai][bj][m][0], v1 = acc[ai][bj][m][1];
                    if (wc < 2) ss += sumsq8(v0, v1);
                    if (wc == 2 && bj == 0) rope8(v0, v1, ropec, ropes, row & (SEQ - 1), fq);
                    w[bj] = pack8(v0, v1); }
                store_lines16(CKVR + (size_t)(row - fr) * 256 + 64 * wc, 256, w[0], w[1], fr, fq);
                ss += __shfl_xor(ss, 16); ss += __shfl_xor(ss, 32);
                if (fq == 0) ssqkv[(size_t)row * 4 + wc] = ss; }
        }
    }
};
struct EpiQ {
    static constexpr int PERM = 1; static constexpr int NST = 16;
    bf16_t* Q; const float* ssqq; const float* ropec; const float* ropes;
    __device__ __forceinline__ void operator()(const f32x4 (&acc)[2][2][4][2], const Unit& u, int wr, int wc, int fr, int fq) const {
        const int pm = u.i0, pn = u.i1, row0 = pm * 256 + wr * 64;
        FX_ROWLOOP { const int row = row0 + fr + ai * 128 + m * 16; const f32x4 s4 = *(const f32x4*)(ssqq + (size_t)row * 4);
            const float rs = __builtin_amdgcn_rsqf(((s4[0] + s4[1]) + (s4[2] + s4[3])) * (1.f / 256.f) + RMS_EPS) * QSCALE;
            u32x4 w[2];
#pragma unroll
            for (int bj = 0; bj < 2; ++bj) { const int G = 8 * pn + 2 * wc + bj;
                f32x4 v0 = acc[ai][bj][m][0] * rs, v1 = acc[ai][bj][m][1] * rs;
                if (G % 3 == 2) rope8(v0, v1, ropec, ropes, row & (SEQ - 1), fq);
                w[bj] = pack8(v0, v1); }
            store_lines16(Q + (size_t)(row0 + ai * 128 + m * 16) * 768 + 256 * pn + 64 * wc, 768, w[0], w[1], fr, fq); }
    }
};
struct EpiKV {
    static constexpr int PERM = 1; static constexpr int NST = 16;
    bf16_t* KV; const float* ssqkv;
    __device__ __forceinline__ void operator()(const f32x4 (&acc)[2][2][4][2], const Unit& u, int wr, int wc, int fr, int fq) const {
        const int pm = u.i0, pn = u.i1, row0 = pm * 256 + wr * 64;
        FX_ROWLOOP { const int row = row0 + fr + ai * 128 + m * 16; const f32x4 s4 = *(const f32x4*)(ssqkv + (size_t)row * 4);
            const float rs = __builtin_amdgcn_rsqf(((s4[0] + s4[1]) + (s4[2] + s4[3])) * (1.f / 128.f) + RMS_EPS);
            store_lines16(KV + (size_t)(row0 + ai * 128 + m * 16) * 1024 + 256 * pn + 64 * wc, 1024, pack8(acc[ai][0][m][0] * rs, acc[ai][0][m][1] * rs), pack8(acc[ai][1][m][0] * rs, acc[ai][1][m][1] * rs), fr, fq); }
    }
};
struct EpiSt {
    static constexpr int PERM = 1; static constexpr int NST = 16;
    bf16_t* S;
    __device__ __forceinline__ void operator()(const f32x4 (&acc)[2][2][4][2], const Unit& u, int wr, int wc, int fr, int fq) const {
        const int g = u.i0, pm = u.i1, row0 = pm * 256 + wr * 64;
        FX_ROWLOOP store_lines16(S + ((size_t)g * UHR + row0 + ai * 128 + m * 16) * 256 + 64 * wc, 256, pack8(acc[ai][0][m][0], acc[ai][0][m][1]), pack8(acc[ai][1][m][0], acc[ai][1][m][1]), fr, fq);
    }
};
struct EpiSsmOut {
    static constexpr int PERM = 1; static constexpr int NST = 16;
    bf16_t* SPRE;
    __device__ __forceinline__ void operator()(const f32x4 (&acc)[2][2][4][2], const Unit& u, int wr, int wc, int fr, int fq) const {
        const int g = u.i0, pm = u.i1, pn = u.i2, row0 = pm * 256 + wr * 64 + fr;
        const int p0 = 8 * (fq & 1);
        FX_ROWLOOP { const int R = row0 + ai * 128 + m * 16;
#pragma unroll
            for (int bj = 0; bj < 2; ++bj) { const int c = 256 * pn + 64 * wc + 32 * bj + 8 * fq, tq = c >> 4;
                f32x4 y0 = acc[ai][bj][m][0], y1 = acc[ai][bj][m][1];
#pragma unroll
                for (int j = 0; j < 4; ++j) { y0[j] = gelu_tanh_f(y0[j]); y1[j] = gelu_tanh_f(y1[j]); }
                *(u32x4*)(SPRE + ((size_t)R * 32 + tq) * SPRE_LD + g * 16 + p0) = pack8(y0, y1); } }
    }
};
struct EpiGlu {
    static constexpr int PERM = 1; static constexpr int NST = 16;
    const bf16_t* SPRE; bf16_t* MIX; const float* bglu;
    __device__ __forceinline__ void operator()(const f32x4 (&acc)[2][2][4][2], const Unit& u, int wr, int wc, int fr, int fq) const {
        const int pm = u.i0, pn = u.i1, row0 = pm * 256 + wr * 64;
        f32x4 b0[2], b1[2];
#pragma unroll
        for (int bj = 0; bj < 2; ++bj) { const int c = 256 * pn + 64 * wc + 32 * bj + 8 * fq; b0[bj] = *(const f32x4*)(bglu + c); b1[bj] = *(const f32x4*)(bglu + c + 4); }
        FX_ROWLOOP { const int row = row0 + fr + ai * 128 + m * 16; u32x4 w[2];
#pragma unroll
            for (int bj = 0; bj < 2; ++bj) { const int c = 256 * pn + 64 * wc + 32 * bj + 8 * fq;
                const u32x4 sw = *(const u32x4*)(SPRE + (size_t)row * SPRE_LD + c); f32x4 s0, s1; unpack8(sw, s0, s1);
                f32x4 z0 = acc[ai][bj][m][0] + b0[bj], z1 = acc[ai][bj][m][1] + b1[bj];
#pragma unroll
                for (int j = 0; j < 4; ++j) { z0[j] = s0[j] * fast_sigmoid(z0[j]); z1[j] = s1[j] * fast_sigmoid(z1[j]); }
                w[bj] = pack8(z0, z1); }
            store_lines16(MIX + (size_t)(row0 + ai * 128 + m * 16) * 1024 + 256 * pn + 64 * wc, 1024, w[0], w[1], fr, fq); }
    }
};
struct EpiWo {
    static constexpr int PERM = 1; static constexpr int NST = 16;
    bf16_t* XY;
    __device__ __forceinline__ void operator()(const f32x4 (&acc)[2][2][4][2], const Unit& u, int wr, int wc, int fr, int fq) const {
        const int pm = u.i0, pn = u.i1, row0 = pm * 256 + wr * 64;
        u32x4 xw[2][4][2];
#pragma unroll
        for (int ai = 0; ai < 2; ++ai)
#pragma unroll
            for (int m = 0; m < 4; ++m)
#pragma unroll
                for (int bj = 0; bj < 2; ++bj) xw[ai][m][bj] = *(const u32x4*)(XY + (size_t)(row0 + fr + ai * 128 + m * 16) * 1024 + 256 * pn + wc * 64 + bj * 32 + 8 * fq);
        asm volatile("s_waitcnt vmcnt(0)" ::: "memory");
        FX_ROWLOOP { u32x4 w[2];
#pragma unroll
            for (int bj = 0; bj < 2; ++bj) { f32x4 x0, x1; unpack8(xw[ai][m][bj], x0, x1); w[bj] = pack8(x0 * ALPHA + acc[ai][bj][m][0], x1 * ALPHA + acc[ai][bj][m][1]); }
            store_lines16(XY + (size_t)(row0 + ai * 128 + m * 16) * 1024 + 256 * pn + 64 * wc, 1024, w[0], w[1], fr, fq); }
    }
};
__device__ __forceinline__ size_t h_off(int row, int col) { return (size_t)(row >> 4) * 4096 + (size_t)(row & 7) * 512 + (size_t)(col >> 5) * 64 + (size_t)((row >> 3) & 1) * 32 + (size_t)(col & 31); }
struct EpiSharedRouter {
    static constexpr int PERM = 1; static constexpr int NST = 0;
    bf16_t* HS; float* LG;
    __device__ __forceinline__ void operator()(const f32x4 (&acc)[2][2][4][2], const Unit& u, int wr, int wc, int fr, int fq) const {
        const int pm = u.i0, pn = u.i1, row0 = pm * 256 + wr * 64 + fr;
        if (pn < 2) {
            const int c = 128 * pn + 32 * wc + 8 * fq;
            FX_ROWLOOP { f32x4 h0, h1;
#pragma unroll
                for (int j = 0; j < 4; ++j) { const float g0 = acc[ai][0][m][0][j], g1 = acc[ai][0][m][1][j];
                    h0[j] = g0 * fast_sigmoid(g0) * acc[ai][1][m][0][j]; h1[j] = g1 * fast_sigmoid(g1) * acc[ai][1][m][1][j]; }
                *(u32x4*)(HS + h_off(row0 + ai * 128 + m * 16, c)) = pack8(h0, h1); }
        } else if (wc == 0) {
            FX_ROWLOOP { float* rp = LG + (size_t)(row0 + ai * 128 + m * 16) * 64 + 8 * fq;
#pragma unroll
                for (int bj = 0; bj < 2; ++bj) { *(f32x4*)(rp + bj * 32) = acc[ai][bj][m][0]; *(f32x4*)(rp + bj * 32 + 4) = acc[ai][bj][m][1]; } }
        }
    }
};

struct MoeTab { LAS int* tbase; LAS unsigned* tab; };
__device__ __forceinline__ MoeTab moe_tab(LAS unsigned char* lds) { MoeTab t; t.tbase = (LAS int*)(lds + TAB_OFF); t.tab = (LAS unsigned*)(lds + TAB_OFF + 2304); return t; }
__device__ __forceinline__ int ve_count(const unsigned* ctl, int ve) { return (ve % 65 == 64) ? CAPC : (int)__hip_atomic_load(ctl + CW_CNT + 64 * ve, __ATOMIC_RELAXED, __HIP_MEMORY_SCOPE_AGENT); }
__device__ __forceinline__ void moe_build_tab(LAS unsigned char* lds, const unsigned* ctl) {
    const MoeTab t = moe_tab(lds); LAS int* nt = (LAS int*)(lds + TAB_OFF + 1024 + 64);
    const int tid = threadIdx.x;
    if (tid < NVE) nt[tid] = (ve_count(ctl, tid) + 255) >> 8;
    __syncthreads();
    if (tid <= NVE) { int s = 0; for (int v = 0; v < tid; ++v) s += nt[v]; t.tbase[tid] = s; }
    __syncthreads();
    for (int v = tid; v < NVE; v += 512) { const int b = t.tbase[v], n = t.tbase[v + 1] - b; for (int j = 0; j < n; ++j) t.tab[b + j] = (unsigned)v | ((unsigned)j << 16); }
    __syncthreads();
}
struct GateUpOrder {
    const char* X1B; const char* WGU; MoeTab tb; LAS int* idx; int nunits, G, c;
    __device__ __forceinline__ int tile_of(int tr) const {
        int tile = 0;
#pragma unroll
        for (int ch = 0; ch < NCH; ++ch) { const int b = tb.tbase[ch * 65], n = tb.tbase[ch * 65 + 64] - b; if (tr >= 0 && tr < n) tile = b + tr; tr -= n; }
        return tile;
    }
    __device__ __forceinline__ void init(LAS unsigned char* lds, const void* x1b, const void* wgu, const int* rowtok, const unsigned* ctl, int G_, int c_) {
        X1B = (const char*)x1b; WGU = (const char*)wgu; tb = moe_tab(lds); idx = (LAS int*)(lds + IDX_OFF); G = G_; c = c_;
        int nr = 0;
#pragma unroll
        for (int ch = 0; ch < NCH; ++ch) nr += tb.tbase[ch * 65 + 64] - tb.tbase[ch * 65];
        nunits = 2 * nr;
        __syncthreads();
        int vals[IDX_UNITS / 2];
#pragma unroll
        for (int i2 = 0; i2 < IDX_UNITS / 2; ++i2) { const int i = 2 * i2 + (int)(threadIdx.x >> 8); const long L = (long)i * G + c; vals[i2] = 0;
            if (L < nunits) { const int tile = tile_of(xcd_remap((int)L, nunits) >> 1); const unsigned e = tb.tab[tile]; const int ve = (int)(e & 0xffffu), tix = (int)(e >> 16), ch = ve / 65, ex = ve % 65;
                const int cnt = ve_count(ctl, ve), slot = tix * 256 + (int)(threadIdx.x & 255);
                vals[i2] = slot < cnt ? rowtok[(size_t)(ch * 64 + ex) * CAPC + slot] : ch * CAPC; } }
#pragma unroll
        for (int i2 = 0; i2 < IDX_UNITS / 2; ++i2) idx[(2 * i2 + (int)(threadIdx.x >> 8)) * 256 + (threadIdx.x & 255)] = vals[i2];
        __syncthreads();
    }
    __device__ __forceinline__ bool next(int i, Unit& u) const {
        const long L = (long)i * G + c; if (L >= nunits) return false;
        const int wgid = xcd_remap((int)L, nunits), tile = tile_of(wgid >> 1), pn = wgid & 1;
        const int ex = (int)(tb.tab[tile] & 0xffffu) % 65;
        u.A = X1B; u.B = WGU + ((size_t)ex * 512 + (size_t)pn * 256) * 1024 * 2; u.i0 = tile * 256; u.i1 = pn; u.i2 = 0; u.i3 = i < IDX_UNITS ? i : IDX_UNITS - 1; return true;
    }
    __device__ __forceinline__ void gather(const Unit& u, int R0, int C0, int R1, int C1, unsigned& g00, unsigned& g01, unsigned& g10, unsigned& g11) const {
        const LAS int* ip = idx + u.i3 * 256;
        g00 = (unsigned)ip[R0] * 2048u + (unsigned)C0 * 2u; g01 = (unsigned)ip[R1] * 2048u + (unsigned)C1 * 2u;
        g10 = (unsigned)ip[128 + R0] * 2048u + (unsigned)C0 * 2u; g11 = (unsigned)ip[128 + R1] * 2048u + (unsigned)C1 * 2u;
    }
};
struct EpiGateUp {
    static constexpr int PERM = 1; static constexpr int NST = 8;
    bf16_t* H;
    __device__ __forceinline__ void operator()(const f32x4 (&acc)[2][2][4][2], const Unit& u, int wr, int wc, int fr, int fq) const {
        const int hrow0 = u.i0 + wr * 64 + fr, c = 128 * u.i1 + 32 * wc + 8 * fq;
        FX_ROWLOOP { f32x4 h0, h1;
#pragma unroll
            for (int j = 0; j < 4; ++j) { const float g0 = acc[ai][0][m][0][j], g1 = acc[ai][0][m][1][j];
                h0[j] = g0 * fast_sigmoid(g0) * acc[ai][1][m][0][j]; h1[j] = g1 * fast_sigmoid(g1) * acc[ai][1][m][1][j]; }
            *(u32x4*)(H + h_off(hrow0 + ai * 128 + m * 16, c)) = pack8(h0, h1); }
    }
};
struct DownOrder {
    const char* Hh; const char* HS; const char* WD; MoeTab tb; int t0, nunits, G, c, chn;
    __device__ __forceinline__ void init(const void* h, const void* hs, const void* wd, MoeTab tb_, int ch, int G_, int c_) { Hh = (const char*)h; HS = (const char*)hs; WD = (const char*)wd; tb = tb_; chn = ch; t0 = tb_.tbase[ch * 65]; nunits = 4 * (tb_.tbase[(ch + 1) * 65] - t0); G = G_; c = c_; }
    __device__ __forceinline__ bool next(int i, Unit& u) const {
        const long L = (long)i * G + c; if (L >= nunits) return false;
        const int wgid = xcd_remap((int)L, nunits), tile = t0 + (wgid >> 2), pn = wgid & 3;
        const int ex = (int)(tb.tab[tile] & 0xffffu) % 65;
        u.A = ex == 64 ? HS + ((size_t)chn * CAPC + (size_t)(tb.tab[tile] >> 16) * 256) * 256 * 2 : Hh + (size_t)tile * 256 * 256 * 2; u.B = WD + ((size_t)ex * 1024 + (size_t)pn * 256) * 256 * 2; u.i0 = ex == 64 ? (int)(tb.tab[tile] >> 16) * 256 : (tile - t0) * 256; u.i1 = pn; u.i2 = ex == 64; u.i3 = 0; return true;
    }
};
constexpr float Y8_SCALE = 16.f, Y8_INV = 1.f / 16.f;
__device__ __forceinline__ u32x2 pack8_fp8(const f32x4 a, const f32x4 b) {
    int w0 = 0, w1 = 0;
    w0 = __builtin_amdgcn_cvt_pk_fp8_f32(a[0] * Y8_SCALE, a[1] * Y8_SCALE, w0, false); w0 = __builtin_amdgcn_cvt_pk_fp8_f32(a[2] * Y8_SCALE, a[3] * Y8_SCALE, w0, true);
    w1 = __builtin_amdgcn_cvt_pk_fp8_f32(b[0] * Y8_SCALE, b[1] * Y8_SCALE, w1, false); w1 = __builtin_amdgcn_cvt_pk_fp8_f32(b[2] * Y8_SCALE, b[3] * Y8_SCALE, w1, true);
    u32x2 r; r.x = (unsigned)w0; r.y = (unsigned)w1; return r;
}
__device__ __forceinline__ void unpack8_fp8(const u32x2 w, f32x4& a, f32x4& b) {
    const f32x2 p0 = __builtin_amdgcn_cvt_pk_f32_fp8((int)w.x, false), p1 = __builtin_amdgcn_cvt_pk_f32_fp8((int)w.x, true);
    const f32x2 p2 = __builtin_amdgcn_cvt_pk_f32_fp8((int)w.y, false), p3 = __builtin_amdgcn_cvt_pk_f32_fp8((int)w.y, true);
    a = (f32x4){p0.x, p0.y, p1.x, p1.y}; b = (f32x4){p2.x, p2.y, p3.x, p3.y};
}
__device__ __forceinline__ size_t y8_off(int row, int col) { return (size_t)row * 1024 + (size_t)col; }
template <int STORE = 1> struct EpiDownT {
    static constexpr int PERM = 2; static constexpr int NST = 8;
    unsigned char* Y8; bf16_t* YS; LAS unsigned char* lds;
    __device__ __forceinline__ void operator()(const f32x4 (&acc)[2][2][4][2], const Unit& u, int wr, int wc, int fr, int fq) const {
        const int yrow0 = u.i0 + wr * 64, c0 = 256 * u.i1 + 64 * wc + 16 * fq;
        if (u.i2) {
            const bool lo = fr < 8;
            FX_ROWLOOP { const u32x4 X = pack8(acc[ai][0][m][0], acc[ai][0][m][1]), Y = pack8(acc[ai][1][m][0], acc[ai][1][m][1]);
                const u32x4 S = lo ? Y : X, R = ror8_x4(S); const u32x4 A1 = lo ? X : R, A2 = lo ? R : Y;
                bf16_t* p = YS + (size_t)(yrow0 + ai * 128 + m * 16 + (fr & 7)) * 1024 + c0 + (lo ? 0 : 8);
                *(u32x4*)p = A1; *(u32x4*)(p + 8 * 1024) = A2; }
        } else {
            FX_ROWLOOP { unsigned char* rp = Y8 + y8_off(yrow0 + ai * 128 + m * 16 + fr, c0);
                const u32x2 lo = pack8_fp8(acc[ai][0][m][0], acc[ai][0][m][1]), hi = pack8_fp8(acc[ai][1][m][0], acc[ai][1][m][1]);
                u32x4 w; w.x = lo.x; w.y = lo.y; w.z = hi.x; w.w = hi.y; *(u32x4*)rp = w; }
        }
    }
};
typedef EpiDownT<1> EpiDown;
}
namespace fx {
namespace att {
constexpr int NW = 8, QBLK = 32, KVBLK = 64;
constexpr int SHM_V = 16384, SHM_K = 16384;
constexpr float THRL = 8.f;
#define KSWZ(row, colB) ((row) * 256 + ((colB) ^ (((row) & 7) << 4)))
#define SBAR() __builtin_amdgcn_sched_barrier(0)
__device__ __forceinline__ int crow(int r, int hi) { return (r & 3) + 8 * (r >> 2) + 4 * hi; }
__device__ __forceinline__ float bf16_round(float x) { return __uint_as_float(cvt_pk_bf16(x, 0.f) << 16); }
template <bool FIRST, bool EXPS = true> __device__ __forceinline__ void partialSM(f32x16& p0, f32x16& p1, float& m_reg, float& alpha, bf16x8& qm, int hi) {
  float mx0 = fmaxf(p0[0], p0[1]), mx1 = fmaxf(p0[8], p0[9]), mx2 = fmaxf(p1[0], p1[1]), mx3 = fmaxf(p1[8], p1[9]);
#pragma unroll
  for (int r = 2; r < 8; ++r) { mx0 = fmaxf(mx0, p0[r]); mx1 = fmaxf(mx1, p0[8 + r]); mx2 = fmaxf(mx2, p1[r]); mx3 = fmaxf(mx3, p1[8 + r]); }
  float pmax = fmaxf(fmaxf(mx0, mx1), fmaxf(mx2, mx3));
  { auto rr = __builtin_amdgcn_permlane32_swap(__float_as_uint(pmax), __float_as_uint(pmax), false, false);
    pmax = fmaxf(__uint_as_float(rr[0]), __uint_as_float(rr[1])); }
  if (!FIRST && __builtin_expect(__all(pmax <= THRL), 1)) { alpha = 1.f; }
  else {
    const float mnew = bf16_round(FIRST ? pmax : m_reg + fmaxf(pmax, 0.f)), delta = mnew - m_reg;
    alpha = FIRST ? 1.f : __builtin_amdgcn_exp2f(-delta); m_reg = mnew;
    qm[0] = hi == 0 ? (short)(cvt_pk_bf16(-mnew, 0.f) & 0xffffu) : (short)0;
#pragma unroll
    for (int r = 0; r < 16; ++r) p0[r] = p0[r] - delta;
#pragma unroll
    for (int r = 0; r < 16; ++r) p1[r] = p1[r] - delta;
  }
  if (EXPS) {
#pragma unroll
    for (int r = 0; r < 16; ++r) p0[r] = __builtin_amdgcn_exp2f(p0[r]);
  }
}
__device__ __forceinline__ void finishSM(f32x16& p0, f32x16& p1, float alpha, float& l_reg, bf16x8& pa0, bf16x8& pa1, bf16x8& pa2, bf16x8& pa3) {
#pragma unroll
  for (int r = 0; r < 16; ++r) p1[r] = __builtin_amdgcn_exp2f(p1[r]);
  f32x2 ps0 = {p0[0], p0[1]}, ps1 = {p0[8], p0[9]}, ps2 = {p1[0], p1[1]}, ps3 = {p1[8], p1[9]};
#pragma unroll
  for (int r = 2; r < 8; r += 2) { ps0 += f32x2{p0[r], p0[r + 1]}; ps1 += f32x2{p0[8 + r], p0[9 + r]}; ps2 += f32x2{p1[r], p1[r + 1]}; ps3 += f32x2{p1[8 + r], p1[9 + r]}; }
  const f32x2 psv = (ps0 + ps1) + (ps2 + ps3);
  float ps = psv[0] + psv[1];
  { auto rr = __builtin_amdgcn_permlane32_swap(__float_as_uint(ps), __float_as_uint(ps), false, false);
    ps = __uint_as_float(rr[0]) + __uint_as_float(rr[1]); }
  l_reg = l_reg * alpha + ps;
#define PK4(P, BASE, OUT) do { unsigned a0 = cvt_pk_bf16(P[BASE + 0], P[BASE + 1]), a1 = cvt_pk_bf16(P[BASE + 2], P[BASE + 3]);   \
    unsigned b0 = cvt_pk_bf16(P[BASE + 4], P[BASE + 5]), b1 = cvt_pk_bf16(P[BASE + 6], P[BASE + 7]);                              \
    auto r0 = __builtin_amdgcn_permlane32_swap(a0, b0, false, false); auto r1 = __builtin_amdgcn_permlane32_swap(a1, b1, false, false); \
    u32x4 w = {r0[0], r1[0], r0[1], r1[1]}; OUT = *reinterpret_cast<bf16x8*>(&w); } while (0)
  PK4(p0, 0, pa0); PK4(p0, 8, pa1); PK4(p1, 0, pa2); PK4(p1, 8, pa3);
#undef PK4
}
__device__ __forceinline__ void qkt(f32x16& p0, f32x16& p1, const char* Ks, const bf16x8 (&qr)[6], const bf16x8 kone, const bf16x8 qm, int r32, int hi) {
  p0 = f32x16{}; p1 = f32x16{};
#pragma unroll
  for (int d0 = 0; d0 < 6; ++d0) { const int cb = (d0 * 16 + hi * 8) * 2;
    const bf16x8 b0 = *reinterpret_cast<const bf16x8*>(Ks + KSWZ(r32, cb));
    const bf16x8 b1 = *reinterpret_cast<const bf16x8*>(Ks + KSWZ(32 + r32, cb));
    p0 = __builtin_amdgcn_mfma_f32_32x32x16_bf16(b0, qr[d0], p0, 0, 0, 0);
    p1 = __builtin_amdgcn_mfma_f32_32x32x16_bf16(b1, qr[d0], p1, 0, 0, 0); }
  p0 = __builtin_amdgcn_mfma_f32_32x32x16_bf16(kone, qm, p0, 0, 0, 0);
  p1 = __builtin_amdgcn_mfma_f32_32x32x16_bf16(kone, qm, p1, 0, 0, 0);
}
__device__ __forceinline__ int v_st(int k, int c) { const int kk = (k & ~0xC) | ((k & 4) << 1) | ((k & 8) >> 1); return ((kk >> 3) * 4 + (c >> 5)) * 512 + ((kk & 7) * 32 + (c & 31)) * 2; }
__device__ __forceinline__ int v_rd_base(int lane) { return ((lane & 3) << 3) | (((lane >> 2) & 3) << 6) | (((lane >> 4) & 1) << 5) | (((lane >> 5) & 1) << 8); }
constexpr int v_rd_off(int d0, int ks, int half) { return d0 * 512 + ks * 4096 + half * 2048; }
template <int OFF> __device__ __forceinline__ s16x4 tr_read(int vb) {
  s16x4 r; asm volatile("ds_read_b64_tr_b16 %0, %1 offset:%2" : "=&v"(r) : "v"(vb), "i"(OFF) : "memory"); return r;
}
template <int D0> __device__ __forceinline__ void pv_one(f32x16& od, int vb, bf16x8 pa0, bf16x8 pa1, bf16x8 pa2, bf16x8 pa3) {
  const s16x4 l0 = tr_read<v_rd_off(D0, 0, 0)>(vb), h0 = tr_read<v_rd_off(D0, 0, 1)>(vb), l1 = tr_read<v_rd_off(D0, 1, 0)>(vb), h1 = tr_read<v_rd_off(D0, 1, 1)>(vb);
  const s16x4 l2 = tr_read<v_rd_off(D0, 2, 0)>(vb), h2 = tr_read<v_rd_off(D0, 2, 1)>(vb), l3 = tr_read<v_rd_off(D0, 3, 0)>(vb), h3 = tr_read<v_rd_off(D0, 3, 1)>(vb);
  asm volatile("s_waitcnt lgkmcnt(0)" ::: "memory"); SBAR();
#define PK(L, H) (bf16x8){L[0], L[1], L[2], L[3], H[0], H[1], H[2], H[3]}
  od = __builtin_amdgcn_mfma_f32_32x32x16_bf16(pa0, PK(l0, h0), od, 0, 0, 0);
  od = __builtin_amdgcn_mfma_f32_32x32x16_bf16(pa1, PK(l1, h1), od, 0, 0, 0);
  od = __builtin_amdgcn_mfma_f32_32x32x16_bf16(pa2, PK(l2, h2), od, 0, 0, 0);
  od = __builtin_amdgcn_mfma_f32_32x32x16_bf16(pa3, PK(l3, h3), od, 0, 0, 0);
#undef PK
}
__device__ __forceinline__ void pv_d0(f32x16 (&o)[2], int vb, bf16x8 pa0, bf16x8 pa1, bf16x8 pa2, bf16x8 pa3) {
  pv_one<0>(o[0], vb, pa0, pa1, pa2, pa3); pv_one<1>(o[1], vb, pa0, pa1, pa2, pa3);
}
__device__ __forceinline__ void pv_sm(f32x16 (&o)[2], int vb, bf16x8 pa0, bf16x8 pa1, bf16x8 pa2, bf16x8 pa3, f32x16& pc0, f32x16& pc1, float& m_reg, float& alpha, bf16x8& qm, int hi) {
#define PK(L, H) (bf16x8){L[0], L[1], L[2], L[3], H[0], H[1], H[2], H[3]}
#define EX(r) do { float e_ = __builtin_amdgcn_exp2f(pc0[r]); asm volatile("" : "+v"(e_)); pc0[r] = e_; } while (0)
  const s16x4 l0 = tr_read<v_rd_off(0, 0, 0)>(vb), h0 = tr_read<v_rd_off(0, 0, 1)>(vb), l1 = tr_read<v_rd_off(0, 1, 0)>(vb), h1 = tr_read<v_rd_off(0, 1, 1)>(vb);
  const s16x4 l2 = tr_read<v_rd_off(0, 2, 0)>(vb), h2 = tr_read<v_rd_off(0, 2, 1)>(vb), l3 = tr_read<v_rd_off(0, 3, 0)>(vb), h3 = tr_read<v_rd_off(0, 3, 1)>(vb);
  SBAR();
  partialSM<false, false>(pc0, pc1, m_reg, alpha, qm, hi);
  SBAR();
  EX(0); EX(1);
  asm volatile("s_waitcnt lgkmcnt(0)" ::: "memory"); SBAR();
  o[0] = __builtin_amdgcn_mfma_f32_32x32x16_bf16(pa0, PK(l0, h0), o[0], 0, 0, 0); SBAR();
  const s16x4 m0 = tr_read<v_rd_off(1, 0, 0)>(vb), n0 = tr_read<v_rd_off(1, 0, 1)>(vb), m1 = tr_read<v_rd_off(1, 1, 0)>(vb), n1 = tr_read<v_rd_off(1, 1, 1)>(vb);
  const s16x4 m2 = tr_read<v_rd_off(1, 2, 0)>(vb), n2 = tr_read<v_rd_off(1, 2, 1)>(vb), m3 = tr_read<v_rd_off(1, 3, 0)>(vb), n3 = tr_read<v_rd_off(1, 3, 1)>(vb);
  EX(2); EX(3); SBAR();
  o[0] = __builtin_amdgcn_mfma_f32_32x32x16_bf16(pa1, PK(l1, h1), o[0], 0, 0, 0); SBAR();
  EX(4); EX(5); SBAR();
  o[0] = __builtin_amdgcn_mfma_f32_32x32x16_bf16(pa2, PK(l2, h2), o[0], 0, 0, 0); SBAR();
  EX(6); EX(7); SBAR();
  o[0] = __builtin_amdgcn_mfma_f32_32x32x16_bf16(pa3, PK(l3, h3), o[0], 0, 0, 0); SBAR();
  EX(8); EX(9);
  asm volatile("s_waitcnt lgkmcnt(0)" ::: "memory"); SBAR();
  o[1] = __builtin_amdgcn_mfma_f32_32x32x16_bf16(pa0, PK(m0, n0), o[1], 0, 0, 0); SBAR();
  EX(10); EX(11); SBAR();
  o[1] = __builtin_amdgcn_mfma_f32_32x32x16_bf16(pa1, PK(m1, n1), o[1], 0, 0, 0); SBAR();
  EX(12); EX(13); SBAR();
  o[1] = __builtin_amdgcn_mfma_f32_32x32x16_bf16(pa2, PK(m2, n2), o[1], 0, 0, 0); SBAR();
  EX(14); EX(15); SBAR();
  o[1] = __builtin_amdgcn_mfma_f32_32x32x16_bf16(pa3, PK(m3, n3), o[1], 0, 0, 0); SBAR();
#undef EX
#undef PK
}
__device__ __forceinline__ void attn_unit(const unsigned char* __restrict__ wsb, const bf16_t* __restrict__ Q, bf16_t* __restrict__ MIX, int tok0, int qrow0, int h, char* lds) {
  int tid = threadIdx.x; asm volatile("" : "+v"(tid));
  const int wid = __builtin_amdgcn_readfirstlane(tid >> 6), lane = tid & 63, r32 = lane & 31, hi = lane >> 5;
  char* K_lds = lds; char* V_lds = lds + 4 * SHM_K;
  float* ws = (float*)(lds + TAB_OFF) + wid * 64; float* li_l = ws; float* al_l = ws + 32;
  float m_reg = 0.f, l_reg = 0; f32x16 o[2] = {}; bf16x8 qr[6];
  const bf16_t* Qw = Q + (size_t)(tok0 + qrow0 + wid * QBLK + r32) * 768 + h * 96 + hi * 8;
#pragma unroll
  for (int d0 = 0; d0 < 6; ++d0) qr[d0] = *reinterpret_cast<const bf16x8*>(Qw + d0 * 16);
  const int vb0 = (int)(uintptr_t)V_lds + v_rd_base(lane);
  const int ra = tid / 12, ca = tid % 12, rb = (512 + tid) / 12, cb = (512 + tid) % 12, rv = tid >> 3, cv = tid & 7;
  const unsigned kinca = ca < 8 ? 64u * 2048u : 64u * 512u, kincb = cb < 8 ? 64u * 2048u : 64u * 512u;
  const unsigned kofa = ca < 8 ? (unsigned)WS_KV + (unsigned)(((tok0 + ra) * 1024 + h * 128 + ca * 8) * 2) : (unsigned)WS_CKVR + (unsigned)(((tok0 + ra) * 256 + 128 + (ca - 8) * 8) * 2);
  const unsigned kofb = cb < 8 ? (unsigned)WS_KV + (unsigned)(((tok0 + rb) * 1024 + h * 128 + cb * 8) * 2) : (unsigned)WS_CKVR + (unsigned)(((tok0 + rb) * 256 + 128 + (cb - 8) * 8) * 2);
  const unsigned vofs = (unsigned)WS_KV + (unsigned)(((tok0 + rv) * 1024 + h * 128 + 64 + cv * 8) * 2);
  const int ksta = KSWZ(ra, ca * 16), kstb = KSWZ(rb, cb * 16), vst = v_st(rv, cv * 8);
  const bool two = wid < 4;
  bf16x8 RK0a, RK0b, RV0, RK1a, RK1b, RV1;
#define TLOAD(KA, KB, VV, t) do { KA = *reinterpret_cast<const bf16x8*>(wsb + kofa + (unsigned)(t) * kinca); if (two) KB = *reinterpret_cast<const bf16x8*>(wsb + kofb + (unsigned)(t) * kincb); \
    VV = *reinterpret_cast<const bf16x8*>(wsb + vofs + (unsigned)(t) * (64u * 2048u)); } while (0)
#define TWRITE(KA, KB, VV, b) do { constexpr int bo_ = (b) * SHM_K; *(bf16x8*)(K_lds + bo_ + ksta) = KA; if (two) *(bf16x8*)(K_lds + bo_ + kstb) = KB; *(bf16x8*)(V_lds + bo_ + vst) = VV; } while (0)
#define RESC(a) do { if (__any((a) < 1.f)) { if (hi == 0) al_l[r32] = (a); asm volatile("s_waitcnt lgkmcnt(0)" ::: "memory"); \
    _Pragma("unroll") for (int d = 0; d < 2; ++d) _Pragma("unroll") for (int r = 0; r < 16; ++r) o[d][r] *= al_l[crow(r, hi)]; } } while (0)
#define STEP_END() do { asm volatile("s_waitcnt lgkmcnt(0)" ::: "memory"); __builtin_amdgcn_s_barrier(); asm volatile("" ::: "memory"); } while (0)
  f32x16 pA0, pA1, pB0, pB1; float alA, alB; bf16x8 pa0, pa1, pa2, pa3; constexpr int NT = SEQ / KVBLK;
  bf16x8 kone = {}, qm = {}; kone[0] = hi == 0 ? (short)0x3F80 : (short)0;
  m_reg = 0.f;
#define ATT_STEP(PC0, PC1, ALC, PP0, PP1, ALP, KB, VB, WB, RKA, RKB, RVV, S) do { \
    SBAR(); qkt(PC0, PC1, K_lds + (KB) * SHM_K, qr, kone, qm, r32, hi); \
    finishSM(PP0, PP1, ALP, l_reg, pa0, pa1, pa2, pa3); SBAR(); \
    if ((S) + 1 < NT) TWRITE(RKA, RKB, RVV, WB); \
    if ((S) + 3 < NT) TLOAD(RKA, RKB, RVV, (S) + 3); \
    SBAR(); \
    pv_sm(o, vb0 + (VB) * SHM_V, pa0, pa1, pa2, pa3, PC0, PC1, m_reg, ALC, qm, hi); \
    RESC(ALC); STEP_END(); } while (0)
  TLOAD(RK0a, RK0b, RV0, 0); TWRITE(RK0a, RK0b, RV0, 0); TLOAD(RK1a, RK1b, RV1, 1); TLOAD(RK0a, RK0b, RV0, 2);
  STEP_END();
  qkt(pA0, pA1, K_lds, qr, kone, qm, r32, hi); partialSM<true>(pA0, pA1, m_reg, alA, qm, hi);
  TWRITE(RK1a, RK1b, RV1, 1); TLOAD(RK1a, RK1b, RV1, 3);
  STEP_END();
  for (int s = 1; s + 3 < NT - 2; s += 4) {
    ATT_STEP(pB0, pB1, alB, pA0, pA1, alA, 1, 0, 2, RK0a, RK0b, RV0, s);
    ATT_STEP(pA0, pA1, alA, pB0, pB1, alB, 2, 1, 3, RK1a, RK1b, RV1, s + 1);
    ATT_STEP(pB0, pB1, alB, pA0, pA1, alA, 3, 2, 0, RK0a, RK0b, RV0, s + 2);
    ATT_STEP(pA0, pA1, alA, pB0, pB1, alB, 0, 3, 1, RK1a, RK1b, RV1, s + 3);
  }
  ATT_STEP(pB0, pB1, alB, pA0, pA1, alA, 1, 0, 2, RK0a, RK0b, RV0, NT - 3);
  ATT_STEP(pA0, pA1, alA, pB0, pB1, alB, 2, 1, 3, RK1a, RK1b, RV1, NT - 2);
  SBAR(); qkt(pB0, pB1, K_lds + 3 * SHM_K, qr, kone, qm, r32, hi);
  finishSM(pA0, pA1, alA, l_reg, pa0, pa1, pa2, pa3); SBAR();
  pv_sm(o, vb0 + 2 * SHM_V, pa0, pa1, pa2, pa3, pB0, pB1, m_reg, alB, qm, hi);
  RESC(alB);
  finishSM(pB0, pB1, alB, l_reg, pa0, pa1, pa2, pa3); SBAR();
  pv_d0(o, vb0 + 3 * SHM_V, pa0, pa1, pa2, pa3);
  if (hi == 0) li_l[r32] = l_reg;
  STEP_END();
  char* st = lds + wid * 4096;
#pragma unroll
  for (int r = 0; r < 16; ++r) { const int orow = crow(r, hi); const float rl = __builtin_amdgcn_rcpf(li_l[orow]);
#pragma unroll
    for (int d0 = 0; d0 < 2; ++d0) *(bf16_t*)(st + orow * 128 + (d0 * 32 + r32) * 2) = (bf16_t)(cvt_pk_bf16(o[d0][r] * rl, 0.f) & 0xffffu); }
  asm volatile("s_waitcnt lgkmcnt(0)" ::: "memory");
  bf16_t* Ow = MIX + (size_t)(tok0 + qrow0 + wid * QBLK) * 1024 + 512 + h * 64;
#pragma unroll
  for (int j = 0; j < 4; ++j) { const int q = lane + 64 * j; const u32x4 v = *(const u32x4*)(st + (q >> 3) * 128 + (q & 7) * 16); *(u32x4*)(Ow + (size_t)(q >> 3) * 1024 + (q & 7) * 8) = v; }
  STEP_END();
#undef TLOAD
#undef TWRITE
#undef RESC
#undef STEP_END
#undef ATT_STEP
}
#undef KSWZ
#undef SBAR
}

struct Frame {
    LAS unsigned char* lds; unsigned* ctl; unsigned char* ws; float* out; const float* in[29];
    int tid, lane, wave, G, bid;
};
enum { I_X = 0, I_WIN, I_LRE, I_LIM, I_LDT, I_BRE, I_BIM, I_CRE, I_CIM, I_DSK, I_WGLU, I_BGLU, I_QG, I_WUQ, I_KVG, I_WUKV, I_WO, I_LN1G, I_LN1B, I_WR, I_RB, I_WEG, I_WEU, I_WED, I_WSG, I_WSU, I_WSD, I_LN2G, I_LN2B };

#ifndef MK_TPROBE
#define MK_TPROBE -1
#endif
#define TSUB(F, id) do { if (MK_TPROBE >= 100) { __syncthreads(); if (blockIdx.x == 0 && threadIdx.x == 0) { volatile LAS unsigned* M_ = (volatile LAS unsigned*)((F).lds + MISC_OFF); const unsigned long long tn_ = __builtin_amdgcn_s_memrealtime(); \
    const unsigned long long tl_ = ((unsigned long long)M_[17] << 32) | M_[16]; if ((id) == MK_TPROBE) { const unsigned long long d_ = tn_ - tl_; M_[18] = (unsigned)d_; M_[19] = (unsigned)(d_ >> 32); } M_[16] = (unsigned)tn_; M_[17] = (unsigned)(tn_ >> 32); } } } while (0)
__device__ __forceinline__ int fresh_lane() { int l = (int)(threadIdx.x & 63u); asm volatile("" : "+v"(l)); return l; }
template <class F> __device__ __forceinline__ void transpose_load(const F& f, int k0, int n0, int lane, float (&tv)[32]) {
#pragma unroll
    for (int i = 0; i < 32; ++i) tv[i] = f(k0 + 2 * i + (lane >> 5), n0 + (lane & 31));
}
__device__ __forceinline__ void transpose_store(const float (&tv)[32], bf16_t* Bt, int ldk, int k0, int n0, LAS float* scr, int lane) {
#pragma unroll
    for (int i = 0; i < 32; ++i) scr[(2 * i + (lane >> 5)) * 33 + (lane & 31)] = tv[i];
    asm volatile("s_waitcnt lgkmcnt(0)" ::: "memory");
    const int c = lane & 7;
#pragma unroll
    for (int j = 0; j < 4; ++j) { const int n = (lane >> 3) + 8 * j; const LAS float* s = scr + (8 * c) * 33 + n;
        u32x4 o; o.x = cvt_pk_bf16(s[0 * 33], s[1 * 33]); o.y = cvt_pk_bf16(s[2 * 33], s[3 * 33]); o.z = cvt_pk_bf16(s[4 * 33], s[5 * 33]); o.w = cvt_pk_bf16(s[6 * 33], s[7 * 33]);
        *(u32x4*)(Bt + (size_t)(n0 + n) * ldk + k0 + 8 * c) = o; }
    asm volatile("s_waitcnt lgkmcnt(0)" ::: "memory");
}
template <class F> __device__ __forceinline__ void transpose_item(const F& f, bf16_t* Bt, int ldk, int k0, int n0, LAS float* scr, int lane) {
    float tv[32]; transpose_load(f, k0, n0, lane, tv); transpose_store(tv, Bt, ldk, k0, n0, scr, lane);
}
__device__ __forceinline__ int rope_perm_src(int p) { return (p & 1) ? 16 + (p >> 1) : (p >> 1); }
struct SsmPar { float lr, li, dt, kr, ki; };
__device__ __forceinline__ SsmPar ssm_par(const float* lam_re, const float* lam_im, const float* log_dt, int d, int g, int n) {
    SsmPar p; p.lr = fminf(lam_re[(d * 32 + g) * 64 + n], -1e-4f); p.li = lam_im[(d * 32 + g) * 64 + n]; p.dt = expf(log_dt[d * 32 + g]);
    const float x = p.lr * p.dt, th = p.li * p.dt;
    const float em1 = expm1f(x), cs = cosf(th), sn = sinf(th), sh = sinf(0.5f * th);
    const float ai = (em1 + 1.f) * sn, arm1 = em1 * cs - 2.f * sh * sh, den = p.lr * p.lr + p.li * p.li;
    p.kr = (arm1 * p.lr + ai * p.li) / den; p.ki = (ai * p.lr - arm1 * p.li) / den; return p;
}
__device__ __forceinline__ void ssm_pow_xt(float x, float th, float e, float& pr, float& pi) {
    const float mag = __builtin_amdgcn_exp2f(x * e * 1.4426950408889634f); double trd = (double)th * (double)e * 0.15915494309189535; trd -= rint(trd); const float tr = (float)trd;
    pr = mag * __builtin_amdgcn_cosf(tr); pi = mag * __builtin_amdgcn_sinf(tr);
}
__device__ __forceinline__ void ssm_pow(const SsmPar& p, float e, float& pr, float& pi) { ssm_pow_xt(p.lr * p.dt, p.li * p.dt, e, pr, pi); }

__device__ __forceinline__ void p0_ssm_item(Frame& F, int g, int j) {
    LAS float* Pr = (LAS float*)F.lds;
    LAS float* Pi = Pr + 2 * 64 * 33;
    LAS float* Br = Pi + 2 * 64 * 33;
    LAS float* Bi = Br + 2 * 64 * 16;
    LAS float* Cr = Bi + 2 * 64 * 16;
    LAS float* Ci = Cr + 2 * 16 * 64;
    LAS float* Par = Ci + 2 * 16 * 64;
    const float* lam_re = F.in[I_LRE]; const float* lam_im = F.in[I_LIM]; const float* log_dt = F.in[I_LDT];
    __syncthreads();
    if (F.tid < 128) { const SsmPar p = ssm_par(lam_re, lam_im, log_dt, F.tid >> 6, g, F.tid & 63); Par[F.tid * 4] = p.lr * p.dt; Par[F.tid * 4 + 1] = p.li * p.dt; Par[F.tid * 4 + 2] = p.kr; Par[F.tid * 4 + 3] = p.ki; }
    for (int idx = F.tid; idx < 2 * 16 * 64; idx += 512) { const int n = idx & 63, pp = (idx >> 6) & 15, d = idx >> 10;
        Cr[idx] = F.in[I_CRE][((d * 32 + g) * 16 + pp) * 64 + n]; Ci[idx] = F.in[I_CIM][((d * 32 + g) * 16 + pp) * 64 + n]; }
    __syncthreads();
    for (int idx = F.tid; idx < 2 * 64 * 33; idx += 512) { const int tau = idx % 33, dn = idx / 33; float pr, pi; ssm_pow_xt(Par[dn * 4], Par[dn * 4 + 1], (float)tau, pr, pi); Pr[idx] = pr; Pi[idx] = pi; }
    for (int idx = F.tid; idx < 2 * 64 * 16; idx += 512) { const int q = idx & 15, dn = idx >> 4, n = dn & 63, d = dn >> 6; const float kr = Par[dn * 4 + 2], ki = Par[dn * 4 + 3];
        const float br = F.in[I_BRE][((d * 32 + g) * 64 + n) * 16 + q], bi = F.in[I_BIM][((d * 32 + g) * 64 + n) * 16 + q];
        Br[idx] = kr * br - ki * bi; Bi[idx] = kr * bi + ki * br; }
    __syncthreads();
    float* Kt = (float*)(F.ws + WS_KT) + (size_t)g * 16384;
    { const int blk = 512 * j + F.tid;
      const int q2 = blk & 7, p2 = (blk >> 3) & 7, tau = (blk >> 6) & 31, d = blk >> 11; float s00 = 0.f, s01 = 0.f, s10 = 0.f, s11 = 0.f;
      for (int n = 0; n < 64; ++n) { const float pr = Pr[(d * 64 + n) * 33 + tau], pi = Pi[(d * 64 + n) * 33 + tau];
          const float b0r = Br[(d * 64 + n) * 16 + 2 * q2], b0i = Bi[(d * 64 + n) * 16 + 2 * q2], b1r = Br[(d * 64 + n) * 16 + 2 * q2 + 1], b1i = Bi[(d * 64 + n) * 16 + 2 * q2 + 1];
          const float d0r = pr * b0r - pi * b0i, d0i = pr * b0i + pi * b0r, d1r = pr * b1r - pi * b1i, d1i = pr * b1i + pi * b1r;
          const float c0r = Cr[(d * 16 + 2 * p2) * 64 + n], c0i = Ci[(d * 16 + 2 * p2) * 64 + n], c1r = Cr[(d * 16 + 2 * p2 + 1) * 64 + n], c1i = Ci[(d * 16 + 2 * p2 + 1) * 64 + n];
          s00 += c0r * d0r - c0i * d0i; s01 += c0r * d1r - c0i * d1i; s10 += c1r * d0r - c1i * d0i; s11 += c1r * d1r - c1i * d1i; }
      float* kp = Kt + ((size_t)(d * 32 + tau) * 16 + 2 * p2) * 16 + 2 * q2; kp[0] = s00; kp[1] = s01; kp[16] = s10; kp[17] = s11; }
    bf16_t* Wst = (bf16_t*)(F.ws + WS_WST) + (size_t)g * 256 * 512;
    for (int pc = F.tid; pc < 32 * 64; pc += 512) { const int row = 32 * j + (pc >> 6), k0 = (pc & 63) * 8, s = k0 >> 4, q0 = k0 & 15;
        const int d = row >> 7, ri = (row >> 6) & 1, n = row & 63, e = d ? s : (CHK - 1 - s);
        const float pr = Pr[(d * 64 + n) * 33 + e], pi = Pi[(d * 64 + n) * 33 + e]; float v[8];
#pragma unroll
        for (int t = 0; t < 8; ++t) { const float br = Br[(d * 64 + n) * 16 + q0 + t], bi = Bi[(d * 64 + n) * 16 + q0 + t]; v[t] = ri ? (pr * bi + pi * br) : (pr * br - pi * bi); }
        u32x4 o; o.x = cvt_pk_bf16(v[0], v[1]); o.y = cvt_pk_bf16(v[2], v[3]); o.z = cvt_pk_bf16(v[4], v[5]); o.w = cvt_pk_bf16(v[6], v[7]);
        *(u32x4*)(Wst + (size_t)row * 512 + k0) = o; }
    bf16_t* Mo = (bf16_t*)(F.ws + WS_MO) + (size_t)g * 512 * UHK;
    for (int pc = F.tid; pc < 64 * 32; pc += 512) { const int row = 64 * j + (pc >> 5), kk = (pc & 31) * 8, d = kk >> 7, ri = (kk >> 6) & 1, n0 = kk & 63, tq = row >> 4, pp = row & 15;
        const int e = d ? (CHK - tq) : (tq + 1); float v[8];
#pragma unroll
        for (int t = 0; t < 8; ++t) { const int n = n0 + t; const float pr = Pr[(d * 64 + n) * 33 + e], pi = Pi[(d * 64 + n) * 33 + e], cr = Cr[(d * 16 + pp) * 64 + n], ci = Ci[(d * 16 + pp) * 64 + n];
            v[t] = ri ? -(cr * pi + ci * pr) : (cr * pr - ci * pi); }
        u32x4 o; o.x = cvt_pk_bf16(v[0], v[1]); o.y = cvt_pk_bf16(v[2], v[3]); o.z = cvt_pk_bf16(v[4], v[5]); o.w = cvt_pk_bf16(v[6], v[7]);
        *(u32x4*)(Mo + (size_t)row * UHK + 512 + kk) = o; }
}

template <int PART> __device__ __forceinline__ void p0_prologue(Frame& F) {
    const int lane = fresh_lane();
    if (PART == 1) {
        for (int it = F.bid; it < 256; it += F.G) p0_ssm_item(F, it >> 3, it & 7);
        __syncthreads();
    }
    if (PART == 0) {
        float* rc = (float*)(F.ws + WS_ROPE); float* rs = rc + 2048 * 16;
        for (int idx = F.bid * 512 + F.tid; idx < 2048 * 16; idx += F.G * 512) { const int i = idx & 15, pos = idx >> 4;
            const float inv = expf(-9.210340371976184f * (float)i * (1.f / 16.f)); const float a = (float)pos * inv; rc[idx] = cosf(a); rs[idx] = sinf(a); } }
    LAS float* scr = (LAS float*)(F.lds + F.wave * 16384);
    const int gw = F.bid * 8 + F.wave, NGW = F.G * 8;
    constexpr int I_A = 512, I_B = 128, I_C = 96, I_D = 128, I_E = 128, I_F = 512, I_G = 65 * 256, I_H = 65 * 128;
    constexpr int NITEMS = I_A + I_B + I_C + I_D + I_E + I_F + I_G + I_H;
    for (int it = (PART == 0 ? gw : I_A + gw); it < (PART == 0 ? I_A : NITEMS); it += NGW) {
        int r = it;
        if (r < I_A) { const float* W = F.in[I_WIN]; const int kb = r / 32, nb = r % 32;
            transpose_item([&](int k, int n) -> float { if (n >= 928) return 0.f; const int src = n < 896 ? n : 896 + rope_perm_src(n - 896); return W[(size_t)k * 928 + src]; }, (bf16_t*)(F.ws + WS_WIN), 1024, kb * 64, nb * 32, scr, lane); continue; } r -= I_A;
        if (r < I_B) { const float* W = F.in[I_WGLU]; const int kb = r / 16, nb = r % 16;
            transpose_item([&](int k, int n) -> float { return W[(size_t)k * 512 + n]; }, (bf16_t*)(F.ws + WS_WGLU), 512, kb * 64, nb * 32, scr, lane); continue; } r -= I_B;
        if (r < I_C) { const float* W = F.in[I_WUQ]; const float* gq = F.in[I_QG]; const int kb = r / 24, nb = r % 24;
            transpose_item([&](int k, int n) -> float { const int hh = n / 96, jj = n % 96; const int src = jj < 64 ? n : hh * 96 + 64 + rope_perm_src(jj - 64); return W[(size_t)k * 768 + src] * gq[k]; }, (bf16_t*)(F.ws + WS_WUQ), 256, kb * 64, nb * 32, scr, lane); continue; } r -= I_C;
        if (r < I_D) { const float* W = F.in[I_WUKV]; const float* gk = F.in[I_KVG]; const int kb = r / 32, nb = r % 32;
            transpose_item([&](int k, int n) -> float { return k < 128 ? W[(size_t)k * 1024 + n] * gk[k] : 0.f; }, (bf16_t*)(F.ws + WS_WUKV), 256, kb * 64, nb * 32, scr, lane); continue; } r -= I_D;
        if (r < I_E) { const float* W = F.in[I_WR]; const int kb = r / 8, nb = r % 8;
            transpose_item([&](int k, int n) -> float { return n < 64 ? W[(size_t)k * 64 + n] : 0.f; }, (bf16_t*)(F.ws + WS_WR), 1024, kb * 64, nb * 32, scr, lane); continue; } r -= I_E;
        if (r < I_F) { const float* W = F.in[I_WO]; const int kb = r / 32, nb = r % 32;
            transpose_item([&](int k, int n) -> float { return W[(size_t)k * 1024 + n]; }, (bf16_t*)(F.ws + WS_WO), 1024, kb * 64, nb * 32, scr, lane); continue; } r -= I_F;
        const int it2 = it + NGW; const bool has2 = it2 < NITEMS; float tv0[32], tv1[32];
        auto geom = [&](int rr_, const float*& W0, const float*& W1, bf16_t*& dst, int& ldk, int& k0, int& n0, bool& gu) {
            if (rr_ < I_G) { const int e = rr_ / 256, q = rr_ % 256; gu = true; k0 = (q / 16) * 64; n0 = (q % 16) * 32; ldk = 1024;
                W0 = e < 64 ? F.in[I_WEG] + (size_t)e * 1024 * 256 : F.in[I_WSG]; W1 = e < 64 ? F.in[I_WEU] + (size_t)e * 1024 * 256 : F.in[I_WSU]; dst = (bf16_t*)(F.ws + WS_WGU) + (size_t)e * 512 * 1024; }
            else { const int q_ = rr_ - I_G, e = q_ / 128, q = q_ % 128; gu = false; k0 = (q / 32) * 64; n0 = (q % 32) * 32; ldk = 256;
                W0 = e < 64 ? F.in[I_WED] + (size_t)e * 256 * 1024 : F.in[I_WSD]; W1 = W0; dst = (bf16_t*)(F.ws + WS_WD) + (size_t)e * 1024 * 256; } };
        auto val = [&](bool gu, const float* W0, const float* W1, int k, int n) -> float { if (gu) { const int r_ = n & 255, col = 128 * (n >> 8) + 32 * (r_ >> 6) + (r_ & 31); return ((r_ >> 5) & 1) ? W1[(size_t)k * 256 + col] : W0[(size_t)k * 256 + col]; } return W0[(size_t)k * 1024 + n]; };
        const float *Wa0, *Wa1, *Wb0, *Wb1; bf16_t *da, *db; int lka, ka, na, lkb, kb_, nb_; bool gua, gub;
        geom(r, Wa0, Wa1, da, lka, ka, na, gua);
        transpose_load([&](int k, int n) -> float { return val(gua, Wa0, Wa1, k, n); }, ka, na, lane, tv0);
        if (has2) { geom(it2 - (I_A + I_B + I_C + I_D + I_E + I_F), Wb0, Wb1, db, lkb, kb_, nb_, gub); transpose_load([&](int k, int n) -> float { return val(gub, Wb0, Wb1, k, n); }, kb_, nb_, lane, tv1); }
        transpose_store(tv0, da, lka, ka, na, scr, lane);
        if (has2) transpose_store(tv1, db, lkb, kb_, nb_, scr, lane);
        it += NGW;
    }
    if (PART == 0) {
      const float* x = F.in[I_X]; bf16_t* xb = (bf16_t*)(F.ws + WS_XB); const size_t N8 = (size_t)T * DM / 8, st = (size_t)F.G * 512;
      for (size_t i = (size_t)F.bid * 512 + F.tid; i < N8; i += 4 * st) {
          f32x4 a[4], b[4];
#pragma unroll
          for (int u = 0; u < 4; ++u) { const size_t ii = i + u * st < N8 ? i + u * st : i; a[u] = __builtin_nontemporal_load((const f32x4*)(x + ii * 8)); b[u] = __builtin_nontemporal_load((const f32x4*)(x + ii * 8 + 4)); }
#pragma unroll
          for (int u = 0; u < 4; ++u) if (i + u * st < N8) *(u32x4*)(xb + (i + u * st) * 8) = pack8(a[u], b[u]); } }
    if (PART == 1) { asm volatile("s_waitcnt vmcnt(0) lgkmcnt(0)" ::: "memory"); __syncthreads(); }
}

__device__ __forceinline__ void scan_unit(Frame& F, int g, int pm) {
    const bf16_t* S = (const bf16_t*)(F.ws + WS_S); bf16_t* UH = (bf16_t*)(F.ws + WS_UH);
    {
        const int n = F.tid & 63, d = (F.tid >> 6) & 1, b = pm * 4 + (F.tid >> 7);
        const SsmPar p = ssm_par(F.in[I_LRE], F.in[I_LIM], F.in[I_LDT], d, g, n); float acr, aci; ssm_pow(p, (float)CHK, acr, aci);
        float hr = 0.f, hi = 0.f;
        const size_t rbase = (size_t)g * UHR + (size_t)b * NCHK;
#pragma unroll
        for (int hb = 0; hb < 2; ++hb) {
            float sr[32], si[32];
#pragma unroll
            for (int st = 0; st < 32; ++st) { const int ci = d ? (NCHK - 1 - (hb * 32 + st)) : (hb * 32 + st);
                sr[st] = __uint_as_float((unsigned)S[(rbase + ci) * 256 + d * 128 + n] << 16); si[st] = __uint_as_float((unsigned)S[(rbase + ci) * 256 + d * 128 + 64 + n] << 16); }
#pragma unroll
            for (int st = 0; st < 32; ++st) { const int ci = d ? (NCHK - 1 - (hb * 32 + st)) : (hb * 32 + st);
                bf16_t* hp = UH + (rbase + ci) * UHK + 512 + d * 128 + n;
                hp[0] = (bf16_t)(cvt_pk_bf16(hr, 0.f) & 0xffffu); hp[64] = (bf16_t)(cvt_pk_bf16(hi, 0.f) & 0xffffu);
                const float nr = acr * hr - aci * hi + sr[st], ni = acr * hi + aci * hr + si[st]; hr = nr; hi = ni; }
        }
    }
}
__device__ __forceinline__ void mo_fill(Frame& F) {
    const float* Kt = (const float*)(F.ws + WS_KT); bf16_t* Mo = (bf16_t*)(F.ws + WS_MO);
    for (int pc = F.bid * 512 + F.tid; pc < 32 * 512 * 64; pc += F.G * 512) {
        const int k0 = (pc & 63) * 8, row = (pc >> 6) & 511, g = pc >> 15, s = k0 >> 4, q0 = k0 & 15, tq = row >> 4, pp = row & 15;
        f32x4 v0 = {0.f, 0.f, 0.f, 0.f}, v1 = {0.f, 0.f, 0.f, 0.f};
        if (tq >= s) { const float* kp = Kt + ((size_t)(g * 2 + 0) * 32 + (tq - s)) * 256 + pp * 16 + q0; v0 += *(const f32x4*)kp; v1 += *(const f32x4*)(kp + 4); }
        if (s >= tq) { const float* kp = Kt + ((size_t)(g * 2 + 1) * 32 + (s - tq)) * 256 + pp * 16 + q0; v0 += *(const f32x4*)kp; v1 += *(const f32x4*)(kp + 4); }
        if (s == tq && (pp >> 3) == (q0 >> 3)) { const float dsk = F.in[I_DSK][g * 16 + pp];
#pragma unroll
            for (int j = 0; j < 4; ++j) { if (q0 + j == pp) v0[j] += dsk; if (q0 + 4 + j == pp) v1[j] += dsk; } }
        *(u32x4*)(Mo + ((size_t)g * 512 + row) * UHK + k0) = pack8(v0, v1);
    }
}

__device__ __forceinline__ void p7_ln1(Frame& F) {
    const int lane = fresh_lane();
    const float* g1 = F.in[I_LN1G]; const float* b1 = F.in[I_LN1B]; bf16_t* x1b = (bf16_t*)(F.ws + WS_X1B);
    f32x4 gg[4], bb[4];
#pragma unroll
    for (int j = 0; j < 4; ++j) { const int c = 8 * lane + (j >> 1) * 512 + (j & 1) * 4; gg[j] = *(const f32x4*)(g1 + c); bb[j] = *(const f32x4*)(b1 + c); }
    for (int pm = F.bid; pm < T / 256; pm += F.G)
    for (int row0 = pm * 256 + F.wave; row0 < pm * 256 + 256; row0 += 32) {
        u32x4 w0[4], w1[4];
#pragma unroll
        for (int j = 0; j < 4; ++j) { const bf16_t* rp = x1b + (size_t)(row0 + 8 * j) * 1024 + 8 * lane; w0[j] = *(const u32x4*)rp; w1[j] = *(const u32x4*)(rp + 512); }
#pragma unroll
        for (int j = 0; j < 4; ++j) {
            bf16_t* rp = x1b + (size_t)(row0 + 8 * j) * 1024 + 8 * lane; f32x4 v[4]; unpack8(w0[j], v[0], v[1]); unpack8(w1[j], v[2], v[3]);
            float s = 0.f;
#pragma unroll
            for (int q = 0; q < 4; ++q) s += (v[q][0] + v[q][1]) + (v[q][2] + v[q][3]);
            const float mean = wave_sum(s) * (1.f / 1024.f); float qq = 0.f;
#pragma unroll
            for (int q = 0; q < 4; ++q) { v[q] = v[q] - mean; qq += (v[q][0] * v[q][0] + v[q][1] * v[q][1]) + (v[q][2] * v[q][2] + v[q][3] * v[q][3]); }
            const float rstd = __builtin_amdgcn_rsqf(wave_sum(qq) * (1.f / 1024.f) + LN_EPS);
#pragma unroll
            for (int q = 0; q < 4; ++q) v[q] = v[q] * rstd * gg[q] + bb[q];
            *(u32x4*)rp = pack8(v[0], v[1]); *(u32x4*)(rp + 512) = pack8(v[2], v[3]);
        }
    }
}

__device__ __forceinline__ void route_batch(Frame& F, int bt) {
    LAS int* hist = (LAS int*)(F.lds); LAS int* base = hist + 64;
    const float* LG = (const float*)(F.ws + WS_LOGIT); int* rowtok = (int*)(F.ws + WS_ROWTOK); int* tslot = (int*)(F.ws + WS_TSLOT); float* topw = (float*)(F.ws + WS_TOPW);
    {
        __syncthreads();
        if (F.tid < 64) hist[F.tid] = 0;
        __syncthreads();
        const int tok = bt * 256 + F.tid, ch = (bt * 256) / CAPC;
        int idx[6], lr[6]; float w[6];
        if (F.tid < 256) {
            float lg[64];
#pragma unroll
            for (int j = 0; j < 16; ++j) { const f32x4 v = *(const f32x4*)(LG + (size_t)tok * 64 + 4 * j); lg[4 * j] = v[0]; lg[4 * j + 1] = v[1]; lg[4 * j + 2] = v[2]; lg[4 * j + 3] = v[3]; }
            route_token(lg, F.in[I_RB], idx, w);
#pragma unroll
            for (int k = 0; k < 6; ++k) lr[k] = atomicAdd((int*)&hist[idx[k]], 1);
        }
        __syncthreads();
        if (F.tid < 64) base[F.tid] = (int)__hip_atomic_fetch_add(F.ctl + CW_CNT + 64 * (ch * 65 + F.tid), (unsigned)hist[F.tid], __ATOMIC_RELAXED, __HIP_MEMORY_SCOPE_AGENT);
        __syncthreads();
        if (F.tid < 256) {
#pragma unroll
            for (int k = 0; k < 6; ++k) { const int slot = base[idx[k]] + lr[k];
                rowtok[(size_t)(ch * 64 + idx[k]) * CAPC + slot] = tok; tslot[(size_t)tok * 8 + k] = (idx[k] << 16) | slot; topw[(size_t)tok * 8 + k] = w[k]; }
        }
    }
}

__device__ __forceinline__ void p12_combine(Frame& F, int ch) {
    const int lane = fresh_lane();
    const MoeTab tb = moe_tab(F.lds); const int t0 = tb.tbase[ch * 65];
    const unsigned char* Y8 = F.ws + WS_Y; const bf16_t* YS = (const bf16_t*)(F.ws + WS_YS); const bf16_t* x1b = (const bf16_t*)(F.ws + WS_X1B);
    const int* tslot = (const int*)(F.ws + WS_TSLOT); const float* topw = (const float*)(F.ws + WS_TOPW);
    const float* g2 = F.in[I_LN2G]; const float* b2 = F.in[I_LN2B];
    f32x4 gg[4], bb[4];
#pragma unroll
    for (int j = 0; j < 4; ++j) { const int c = 8 * lane + (j >> 1) * 512 + (j & 1) * 4; gg[j] = *(const f32x4*)(g2 + c); bb[j] = *(const f32x4*)(b2 + c); }
    constexpr int NTK = 4;
    const int stride = F.G * 8;
    for (int tk0 = F.bid * 8 + F.wave; tk0 < CAPC; tk0 += NTK * stride) {
        int ts[NTK][6]; float tw[NTK][6];
#pragma unroll
        for (int t = 0; t < NTK; ++t) { const int tk = tk0 + t * stride < CAPC ? tk0 + t * stride : tk0; const size_t tok = (size_t)ch * CAPC + tk;
#pragma unroll
            for (int k = 0; k < 6; ++k) { ts[t][k] = tslot[tok * 8 + k]; tw[t][k] = topw[tok * 8 + k]; } }
        u32x4 xw[NTK][2], sw[NTK][2]; u32x2 yw[NTK][6][2];
#pragma unroll
        for (int t = 0; t < NTK; ++t) { const int tk = tk0 + t * stride < CAPC ? tk0 + t * stride : tk0; const size_t tok = (size_t)ch * CAPC + tk;
            const bf16_t* xr = x1b + tok * 1024 + 8 * lane; xw[t][0] = *(const u32x4*)xr; xw[t][1] = *(const u32x4*)(xr + 512);
            const bf16_t* yr = YS + (size_t)tk * 1024 + 8 * lane; sw[t][0] = *(const u32x4*)yr; sw[t][1] = *(const u32x4*)(yr + 512);
#pragma unroll
            for (int k = 0; k < 6; ++k) { const int yrow = (tb.tbase[ch * 65 + (ts[t][k] >> 16)] - t0) * 256 + (ts[t][k] & 0xffff);
                const unsigned char* y8 = Y8 + y8_off(yrow, 8 * lane); yw[t][k][0] = *(const u32x2*)y8; yw[t][k][1] = *(const u32x2*)(y8 + 512); } }
#pragma unroll
        for (int t = 0; t < NTK; ++t) {
            const int tk = tk0 + t * stride; if (tk >= CAPC) break;
            const size_t tok = (size_t)ch * CAPC + tk;
            f32x4 a[4]; unpack8(xw[t][0], a[0], a[1]); unpack8(xw[t][1], a[2], a[3]); a[0] *= ALPHA; a[1] *= ALPHA; a[2] *= ALPHA; a[3] *= ALPHA;
            { f32x4 y0, y1, y2, y3; unpack8(sw[t][0], y0, y1); unpack8(sw[t][1], y2, y3); a[0] += y0; a[1] += y1; a[2] += y2; a[3] += y3; }
#pragma unroll
            for (int k = 0; k < 6; ++k) { const float w = tw[t][k] * Y8_INV; f32x4 y0, y1, y2, y3; unpack8_fp8(yw[t][k][0], y0, y1); unpack8_fp8(yw[t][k][1], y2, y3);
                a[0] += y0 * w; a[1] += y1 * w; a[2] += y2 * w; a[3] += y3 * w; }
            float s = 0.f;
#pragma unroll
            for (int j = 0; j < 4; ++j) s += (a[j][0] + a[j][1]) + (a[j][2] + a[j][3]);
            const float mean = wave_sum(s) * (1.f / 1024.f); float q = 0.f;
#pragma unroll
            for (int j = 0; j < 4; ++j) { a[j] = a[j] - mean; q += (a[j][0] * a[j][0] + a[j][1] * a[j][1]) + (a[j][2] * a[j][2] + a[j][3] * a[j][3]); }
            const float rstd = __builtin_amdgcn_rsqf(wave_sum(q) * (1.f / 1024.f) + LN_EPS);
            float* orow = F.out + tok * 1024 + 8 * lane;
#pragma unroll
            for (int j = 0; j < 4; ++j) *(f32x4*)(orow + (j >> 1) * 512 + (j & 1) * 4) = a[j] * rstd * gg[j] + bb[j];
        }
    }
}
}

namespace fx {
constexpr int NPHASE = 11 + 2 * NCH;
struct Args { const float* in[29]; float* out; unsigned char* ws; int ph_lo, ph_hi; };

__global__ void __launch_bounds__(512, 2) fwd(Args args) {
    extern __shared__ __attribute__((aligned(16))) unsigned char lds_raw[];
    Frame F;
    F.lds = (LAS unsigned char*)lds_raw; F.ws = args.ws; F.ctl = (unsigned*)(args.ws + WS_CTL); F.out = args.out;
#pragma unroll
    for (int i = 0; i < 29; ++i) F.in[i] = args.in[i];
    F.tid = threadIdx.x; F.lane = 0; F.wave = __builtin_amdgcn_readfirstlane(F.tid >> 6); F.G = gridDim.x; F.bid = blockIdx.x;
    volatile LAS unsigned* MISC = (volatile LAS unsigned*)(F.lds + MISC_OFF);
    if (F.tid < 32) MISC[F.tid] = 0u;
    __syncthreads();
    const int lo = args.ph_lo, hi = args.ph_hi;
    XcdBarrier bar; bar.bar = F.ctl + CW_BAR; bar.x = 0; bar.st = MISC + 8;
    if (hi - lo > 1) bar = xcd_barrier_post(F.ctl + CW_BAR, MISC + 8);
#ifndef PH_MASK
#define PH_MASK 0xFFFFFFFFu
#endif
#define IN(k) (((PH_MASK >> ((k) > 11 ? 11 + (((k) - 11) & 1) : (k))) & 1u) && lo <= (k) && (k) < hi)
#define SEAM(k) do { if (IN(k) && IN((k) + 1)) xcd_barrier(bar); if (MK_TPROBE >= 300 && blockIdx.x == 0 && threadIdx.x == 0) { const unsigned long long cn_ = __builtin_amdgcn_s_memtime(); \
        const unsigned long long cl_ = ((unsigned long long)MISC[25] << 32) | MISC[24]; if ((k) + 300 == MK_TPROBE) { const unsigned long long dc_ = cn_ - cl_; MISC[26] = (unsigned)dc_; MISC[27] = (unsigned)(dc_ >> 32); } MISC[24] = (unsigned)cn_; MISC[25] = (unsigned)(cn_ >> 32); } \
     if (MK_TPROBE >= 0 && blockIdx.x == 0 && threadIdx.x == 0) { const unsigned long long tn_ = __builtin_amdgcn_s_memrealtime(); \
        const unsigned long long tl_ = ((unsigned long long)MISC[17] << 32) | MISC[16]; if (((k) == MK_TPROBE && MK_TPROBE < 100) || (k) + 300 == MK_TPROBE) { const unsigned long long d_ = tn_ - tl_; MISC[18] = (unsigned)d_; MISC[19] = (unsigned)(d_ >> 32); } if (MK_TPROBE == 200 + (k)) { MISC[18] = MISC[22]; MISC[19] = MISC[23]; } MISC[22] = 0u; MISC[23] = 0u; MISC[16] = (unsigned)tn_; MISC[17] = (unsigned)(tn_ >> 32); } } while (0)
    unsigned char* ws = args.ws;
    bf16_t* UH = (bf16_t*)(ws + WS_UH); bf16_t* CQ = (bf16_t*)(ws + WS_CQ); bf16_t* CKVR = (bf16_t*)(ws + WS_CKVR); bf16_t* Qb = (bf16_t*)(ws + WS_Q); bf16_t* KVb = (bf16_t*)(ws + WS_KV);
    bf16_t* SPRE = (bf16_t*)(ws + WS_SPRE); bf16_t* MIX = (bf16_t*)(ws + WS_MIX);
    float* ssqq = (float*)(ws + WS_SSQQ); float* ssqkv = (float*)(ws + WS_SSQKV); const float* ropec = (const float*)(ws + WS_ROPE); const float* ropes = ropec + 2048 * 16;

    if (MK_TPROBE >= 0 && blockIdx.x == 0 && threadIdx.x == 0) { const unsigned long long tn_ = __builtin_amdgcn_s_memrealtime(); MISC[16] = (unsigned)tn_; MISC[17] = (unsigned)(tn_ >> 32); }
    if (MK_TPROBE == 500 && threadIdx.x == 0) __hip_atomic_store(F.ctl + CW_DBG + 64 + blockIdx.x, 1u + xb_xcc_id(), __ATOMIC_RELAXED, __HIP_MEMORY_SCOPE_AGENT);
    if (IN(0)) { p0_prologue<0>(F); } SEAM(0);
    if (IN(1)) {
        const bool conv_first = ((F.bid >> 3) & 1) != 0;
        if (conv_first) p0_prologue<1>(F);
        { PlainOrder S; S.init(ws + WS_XB, 1024, ws + WS_WIN, 1024, T, 1024, F.G, F.bid);
          EpiWin E{UH, CQ, CKVR, ssqq, ssqkv, ropec, ropes};
          gemm_phase<EpiWin, PlainOrder, true, false>(F.lds, 1024, 1024, 1024, S, E); }
        if (!conv_first) p0_prologue<1>(F);
    } SEAM(1);
    if (IN(2)) {
        { GroupOrder S; S.init(UH, ws + WS_WST, 512, 1, F.G, F.bid); EpiSt E{(bf16_t*)(ws + WS_S)};
          gemm_phase<EpiSt, GroupOrder, true, false>(F.lds, UHK, 512, 512, S, E);
          asm volatile("s_waitcnt vmcnt(0)" ::: "memory"); __syncthreads();
          Unit u; for (int i = 0; S.next(i, u); ++i) scan_unit(F, u.i0, u.i1); }
        mo_fill(F);
        { PlainOrder S; S.init(CQ, 256, ws + WS_WUQ, 256, T, 768, F.G, F.bid); EpiQ E{Qb, ssqq, ropec, ropes};
          gemm_phase<EpiQ, PlainOrder, true, false>(F.lds, 256, 256, 256, S, E); }
        { PlainOrder S; S.init(CKVR, 256, ws + WS_WUKV, 256, T, 1024, F.G, F.bid); EpiKV E{KVb, ssqkv};
          gemm_phase<EpiKV, PlainOrder, true, false>(F.lds, 256, 256, 128, S, E); }
    } SEAM(2);
    if (IN(4)) {
#ifndef SUB4
#define SUB4 3
#endif
        if (SUB4 & 2) REP(40) for (int i = 0;; ++i) { const long L = (long)i * F.G + F.bid; if (L >= 2048) break;
            const int un = xcd_remap((int)L, 2048), pair = un >> 3, qb = un & 7, b = pair >> 3, h = pair & 7;
            att::attn_unit(ws, Qb, MIX, b * SEQ, qb * 256, h, (char*)lds_raw); }
        if (SUB4 & 1) DUP2(4, { GroupOrder S; S.init(UH, ws + WS_MO, UHK, 2, F.G, F.bid); EpiSsmOut E{SPRE};
          gemm_phase<EpiSsmOut, GroupOrder, true, false>(F.lds, UHK, UHK, UHK, S, E); });
    } SEAM(4);
    if (IN(5)) {
        { PanelOrder S; S.init(SPRE, SPRE_LD, ws + WS_WGLU, 512, T, 512, F.G, F.bid); EpiGlu E{SPRE, MIX, F.in[I_BGLU]};
          gemm_phase<EpiGlu, PanelOrder, true, false>(F.lds, SPRE_LD, 512, 512, S, E); }
        asm volatile("s_waitcnt vmcnt(0)" ::: "memory"); __syncthreads();
        { PanelOrder S; S.init(MIX, 1024, ws + WS_WO, 1024, T, 1024, F.G, F.bid); EpiWo E{(bf16_t*)(ws + WS_X1B)};
          gemm_phase<EpiWo, PanelOrder, true, false>(F.lds, 1024, 1024, 1024, S, E); }
        asm volatile("s_waitcnt vmcnt(0)" ::: "memory"); __syncthreads();
        p7_ln1(F);
        asm volatile("s_waitcnt vmcnt(0)" ::: "memory"); __syncthreads();
        { PanelOrder S; S.init(ws + WS_X1B, 1024, ws + WS_WGU + (size_t)64 * 512 * 1024 * 2, 1024, T, 768, F.G, F.bid); EpiSharedRouter E{(bf16_t*)(ws + WS_HS), (float*)(ws + WS_LOGIT)};
          gemm_phase<EpiSharedRouter, PanelOrder, true, false>(F.lds, 1024, 1024, 1024, S, E);
          asm volatile("s_waitcnt vmcnt(0)" ::: "memory"); __syncthreads();
          Unit u; for (int i = 0; S.next(i, u); ++i) if (u.i1 == 2) route_batch(F, u.i0); }
    } SEAM(8);
    if (IN(10)) {
        moe_build_tab(F.lds, F.ctl);
        GateUpOrder S; S.init(F.lds, ws + WS_X1B, ws + WS_WGU, (const int*)(ws + WS_ROWTOK), F.ctl, F.G, F.bid); EpiGateUp E{(bf16_t*)(ws + WS_H)};
        gemm_phase<EpiGateUp, GateUpOrder, true, true>(F.lds, 1024, 1024, 1024, S, E);
    } SEAM(10);
#pragma unroll
    for (int ch = 0; ch < NCH; ++ch) {
        if (IN(11 + 2 * ch)) {
            moe_build_tab(F.lds, F.ctl);
            { DownOrder S; S.init(ws + WS_H, ws + WS_HS, ws + WS_WD, moe_tab(F.lds), ch, F.G, F.bid); EpiDown E{ws + WS_Y, (bf16_t*)(ws + WS_YS)};
              gemm_phase<EpiDown, DownOrder, true, false, 0, 1>(F.lds, 256, 256, 256, S, E); }
        } SEAM(11 + 2 * ch);
        if (IN(12 + 2 * ch)) { moe_build_tab(F.lds, F.ctl); p12_combine(F, ch); } SEAM(12 + 2 * ch);
    }
    if (MK_TPROBE == 500 && blockIdx.x == 0 && threadIdx.x == 0) { unsigned bad = 0; for (unsigned b = 8; b < gridDim.x; ++b) bad += __hip_atomic_load(F.ctl + CW_DBG + 64 + b, __ATOMIC_RELAXED, __HIP_MEMORY_SCOPE_AGENT) != __hip_atomic_load(F.ctl + CW_DBG + 64 + (b & 7u), __ATOMIC_RELAXED, __HIP_MEMORY_SCOPE_AGENT);
        const unsigned long long t0_ = __builtin_amdgcn_s_memrealtime(); if (bad) while (__builtin_amdgcn_s_memrealtime() - t0_ < 100000ull) __builtin_amdgcn_s_sleep(8); }
    if (MK_TPROBE >= 0 && MK_TPROBE != 500 && blockIdx.x == 0 && threadIdx.x == 0) { const unsigned long long d_ = ((unsigned long long)MISC[19] << 32) | MISC[18]; const unsigned long long t0_ = __builtin_amdgcn_s_memrealtime();
        unsigned long long wait_ = 8ull * d_; if (MK_TPROBE >= 300) { const unsigned long long dc_ = ((unsigned long long)MISC[27] << 32) | MISC[26]; wait_ = d_ ? (dc_ * 100ull / d_) * 100ull : 0ull; }
        while (__builtin_amdgcn_s_memrealtime() - t0_ < wait_) __builtin_amdgcn_s_sleep(8); }
#undef IN
#undef SEAM
}

#if MK_DEBUG
__global__ void dbg_cmp(int k, const unsigned char* ws, const float* out_fast, gold::Bufs B, const float* gx1, const float* gout, float* acc) {
    const int t = blockIdx.x;
    float num = 0.f, den = 0.f;
    auto bf = [](const bf16_t* p, size_t i) -> float { return __uint_as_float(((unsigned)p[i]) << 16); };
    int ncol = 0;
    switch (k) { case 0: ncol = 512; break; case 1: ncol = 256; break; case 2: ncol = 160; break; case 3: ncol = 768; break; case 4: ncol = 1024; break; case 5: ncol = 512; break; case 6: ncol = 512; break; case 7: ncol = 512; break; case 8: ncol = 1024; break; default: ncol = 1024; }
    for (int c = threadIdx.x; c < ncol; c += blockDim.x) {
        float f = 0.f, g = 0.f;
        if (k == 0) { const int gg = c >> 4, p = c & 15; f = bf((const bf16_t*)(ws + WS_UH), ((size_t)gg * UHR + (t >> 5)) * UHK + (t & 31) * 16 + p); g = B.proj[(size_t)t * 928 + c]; }
        else if (k == 1) { f = bf((const bf16_t*)(ws + WS_CQ), (size_t)t * 256 + c); g = B.proj[(size_t)t * 928 + 512 + c]; }
        else if (k == 2) { f = bf((const bf16_t*)(ws + WS_CKVR), (size_t)t * 256 + c); g = c < 128 ? B.proj[(size_t)t * 928 + 768 + c] : B.krope[(size_t)t * 32 + rope_perm_src(c - 128)]; }
        else if (k == 3) { const int hh = c / 96, jj = c % 96, src = jj < 64 ? c : hh * 96 + 64 + rope_perm_src(jj - 64); f = bf((const bf16_t*)(ws + WS_Q), (size_t)t * 768 + c); g = B.q[(size_t)t * 768 + src] * QSCALE; }
        else if (k == 4) { f = bf((const bf16_t*)(ws + WS_KV), (size_t)t * 1024 + c); g = B.kv[(size_t)t * 1024 + c]; }
        else if (k == 5) { f = bf((const bf16_t*)(ws + WS_SPRE), (size_t)t * SPRE_LD + c); g = B.spre[(size_t)t * 512 + c]; }
        else if (k == 6) { f = bf((const bf16_t*)(ws + WS_MIX), (size_t)t * 1024 + c); g = B.mix[(size_t)t * 1024 + c]; }
        else if (k == 7) { f = bf((const bf16_t*)(ws + WS_MIX), (size_t)t * 1024 + 512 + c); g = B.mix[(size_t)t * 1024 + 512 + c]; }
        else if (k == 8) { f = bf((const bf16_t*)(ws + WS_X1B), (size_t)t * 1024 + c); g = gx1[(size_t)t * 1024 + c]; }
        else { f = out_fast[(size_t)t * 1024 + c]; g = gout[(size_t)t * 1024 + c]; }
        const float d = f - g; num += d * d; den += g * g;
        if (!(fabsf(f) < 1e30f)) num += 1e30f;
    }
    num = wave_sum(num); den = wave_sum(den);
    if ((threadIdx.x & 63) == 0) { atomicAdd(acc + 2 * k, num); atomicAdd(acc + 2 * k + 1, den); }
}
__global__ void dbg_encode(const float* acc, float* out, int k0, int nk) {
    float c2 = 0.f;
    for (int k = k0; k < k0 + nk; ++k) { const float e = sqrtf(acc[2 * k] / fmaxf(acc[2 * k + 1], 1e-30f)); const float tol = (k == 9) ? 0.08f : 0.04f;
        if (!(e <= tol)) { const int bucket = !(e <= 0.5f) ? 0 : (e > 0.1f ? 1 : 2); c2 = (float)(k - k0 + 1) + 20.f * bucket; break; } }
    if (c2 == 0.f) { if (MK_DBG_NPH >= NPHASE) return; c2 = 90.f; }
    const float c = sqrtf(c2);
    for (size_t i = (size_t)blockIdx.x * blockDim.x + threadIdx.x; i < (size_t)T * 1024; i += (size_t)gridDim.x * blockDim.x) out[i] = c;
}
#endif
}

extern "C" void kernel_launch(void* const* d_in, const int* in_sizes, int n_in, void* d_out, int out_size, void* d_ws, size_t ws_size, hipStream_t stream) {
#if MK_MODE == 0
    gold::In I; const float** p = (const float**)&I;
    for (int i = 0; i < 29; ++i) p[i] = (const float*)d_in[i];
    for (int t0 = 0; t0 < 65536; t0 += 16384) gold::run(I, t0, 16384, (float*)d_ws, (float*)d_out + (size_t)t0 * 1024, (float*)d_out + (size_t)t0 * 1024, stream);
#else
    using namespace fx;
    static int grid = 0;
    if (grid == 0) {
        if (n_in != 29 || ws_size < WS_END) { fprintf(stderr, "kernel_launch: need 29 inputs and >= %zu bytes of workspace (got %d, %zu)\n", (size_t)WS_END, n_in, ws_size); grid = -1; return; }
        int dev = 0, cus = 0, per_cu = 0;
        hipGetDevice(&dev); hipDeviceGetAttribute(&cus, hipDeviceAttributeMultiprocessorCount, dev);
        if (hipFuncSetAttribute((const void*)fwd, hipFuncAttributeMaxDynamicSharedMemorySize, LDS_BYTES) != hipSuccess) { fprintf(stderr, "kernel_launch: hipFuncSetAttribute failed\n"); grid = -1; return; }
        if (hipOccupancyMaxActiveBlocksPerMultiprocessor(&per_cu, (const void*)fwd, 512, LDS_BYTES) != hipSuccess || per_cu < 1) { fprintf(stderr, "kernel_launch: occupancy query says %d\n", per_cu); }
        (void)hipGetLastError();
        grid = cus > 0 ? cus : 256;
    }
    if (grid < 0) return;
    hipMemsetAsync((char*)d_ws + WS_CTL, 0, CTL_BYTES, stream);
    Args a{};
    for (int i = 0; i < 29; ++i) a.in[i] = (const float*)d_in[i];
    a.out = (float*)d_out; a.ws = (unsigned char*)d_ws;
#if MK_MODE == 1
    for (int ph = 0; ph < NPHASE && ph < MK_DBG_NPH; ++ph) { a.ph_lo = ph; a.ph_hi = ph + 1; hipLaunchKernelGGL(fwd, dim3(grid), dim3(512), LDS_BYTES, stream, a); }
#else
    a.ph_lo = 0; a.ph_hi = NPHASE; hipLaunchKernelGGL(fwd, dim3(grid), dim3(512), LDS_BYTES, stream, a);
#endif
#if MK_DEBUG
    {
        gold::In I; const float** p = (const float**)&I;
        for (int i = 0; i < 29; ++i) p[i] = (const float*)d_in[i];
        float* gs = (float*)((char*)d_ws + WS_GOLD); float* gx1 = gs + (size_t)2048 * gold::GOLD_FLOATS_PER_TOK; float* gout = gx1 + (size_t)2048 * 1024;
        gold::Bufs B = gold::run(I, 0, 2048, gs, gx1, gout, stream);
        float* acc = (float*)((char*)d_ws + WS_CTL) + CW_DBG;
        for (int k = 0; k < 10; ++k) hipLaunchKernelGGL(dbg_cmp, dim3(2048), dim3(256), 0, stream, k, (const unsigned char*)d_ws, (const float*)d_out, B, (const float*)gx1, (const float*)gout, acc);
        hipLaunchKernelGGL(dbg_encode, dim3(1024), dim3(256), 0, stream, (const float*)acc, (float*)d_out, MK_DBG_K0, MK_DBG_NK);
    }
#endif
    const hipError_t le = hipPeekAtLastError();
    if (le != hipSuccess) fprintf(stderr, "kernel_launch: launch failed: %s\n", hipGetErrorName(le));
#endif
}
```

```cpp
#define MK_MODE 2
#include <hip/hip_runtime.h>
#include <cstdio>
#include <cstdint>
#include <cmath>
#ifndef MK_MODE
#define MK_MODE 1
#endif
#ifndef MK_DBG_NPH
#define MK_DBG_NPH 99
#endif
#ifndef MK_DBG_K0
#define MK_DBG_K0 0
#endif
#ifndef MK_DBG_NK
#define MK_DBG_NK 10
#endif
#ifndef MK_DUP
#define MK_DUP -1
#endif
#define REP(k) for (int rep_ = 0; rep_ < ((MK_DUP == (k)) ? 2 : 1); ++rep_)
#define DUP2(k, ...) do { __VA_ARGS__ if constexpr (MK_DUP == (k)) { __VA_ARGS__ } } while (0)
#ifndef MK_TPROBE
#define MK_TPROBE -1
#endif
#ifndef MK_STAG
#define MK_STAG 0
#endif
#ifndef MK_DEBUG
#define MK_DEBUG 0
#endif
namespace gold {
constexpr int D_MODEL = 1024, SEQ = 2048, D_SSM = 512, D_IN = 928, NH = 8, QLR = 256, KVLR = 128, ROPE = 32;
constexpr int NEXP = 64, TOPK = 6, DEXP = 256;
constexpr float ALPHA = 1.189207115002721f, LN_EPS = 1e-5f, RMS_EPS = 1e-6f, ATT_SCALE = 0.10206207261596577f;

__global__ void __launch_bounds__(256) sgemm(const float* __restrict__ A, int lda, const float* __restrict__ B, int ldb, float* __restrict__ C, int ldc, int M, int N, int K) {
    __shared__ float As[16][65];
    __shared__ float Bs[16][65];
    const int tid = threadIdx.x, tx = tid & 15, ty = tid >> 4;
    const int m0 = blockIdx.y * 64, n0 = blockIdx.x * 64;
    float acc[4][4];
#pragma unroll
    for (int i = 0; i < 4; ++i)
#pragma unroll
        for (int j = 0; j < 4; ++j) acc[i][j] = 0.f;
    for (int k0 = 0; k0 < K; k0 += 16) {
#pragma unroll
        for (int i = 0; i < 4; ++i) { const int idx = tid + 256 * i, r = idx >> 4, c = idx & 15; As[c][r] = A[(size_t)(m0 + r) * lda + k0 + c]; }
#pragma unroll
        for (int i = 0; i < 4; ++i) { const int idx = tid + 256 * i, r = idx >> 6, c = idx & 63; Bs[r][c] = (n0 + c < N) ? B[(size_t)(k0 + r) * ldb + n0 + c] : 0.f; }
        __syncthreads();
#pragma unroll
        for (int k = 0; k < 16; ++k) {
            float a[4], b[4];
#pragma unroll
            for (int i = 0; i < 4; ++i) a[i] = As[k][ty + 16 * i];
#pragma unroll
            for (int j = 0; j < 4; ++j) b[j] = Bs[k][tx + 16 * j];
#pragma unroll
            for (int i = 0; i < 4; ++i)
#pragma unroll
                for (int j = 0; j < 4; ++j) acc[i][j] = fmaf(a[i], b[j], acc[i][j]);
        }
        __syncthreads();
    }
#pragma unroll
    for (int i = 0; i < 4; ++i)
#pragma unroll
        for (int j = 0; j < 4; ++j) { const int c = n0 + tx + 16 * j; if (c < N) C[(size_t)(m0 + ty + 16 * i) * ldc + c] = acc[i][j]; }
}

__device__ __forceinline__ float gelu_tanh(float x) {
    const float z = 0.7978845608028654f * (x + 0.044715f * x * x * x);
    const float e = __expf(2.f * z);
    const float th = 1.f - 2.f / (1.f + e);
    return 0.5f * x * (1.f + th);
}
__device__ __forceinline__ float sigmoidf_(float x) { return 1.f / (1.f + __expf(-x)); }

struct SsmPar { float ar, ai, kr, ki; };
__device__ __forceinline__ SsmPar ssm_par(const float* lam_re, const float* lam_im, const float* log_dt, int d, int g, int n) {
    const float lr = fminf(lam_re[(d * 32 + g) * 64 + n], -1e-4f), li = lam_im[(d * 32 + g) * 64 + n];
    const float dt = expf(log_dt[d * 32 + g]);
    const float x = lr * dt, th = li * dt;
    const float em1 = expm1f(x), cs = cosf(th), sn = sinf(th), sh = sinf(0.5f * th);
    const float mag = em1 + 1.f;
    SsmPar p; p.ar = mag * cs; p.ai = mag * sn;
    const float arm1 = em1 * cs - 2.f * sh * sh;
    const float den = lr * lr + li * li;
    p.kr = (arm1 * lr + p.ai * li) / den; p.ki = (p.ai * lr - arm1 * li) / den;
    return p;
}

__global__ void __launch_bounds__(64) ssm_naive(const float* __restrict__ proj, int ldp, const float* __restrict__ lam_re, const float* __restrict__ lam_im, const float* __restrict__ log_dt,
                                                const float* __restrict__ b_re, const float* __restrict__ b_im, const float* __restrict__ c_re, const float* __restrict__ c_im,
                                                const float* __restrict__ d_skip, float* __restrict__ spre) {
    const int g = blockIdx.x, b = blockIdx.y, n = threadIdx.x;
    for (int d = 0; d < 2; ++d) {
        const SsmPar P = ssm_par(lam_re, lam_im, log_dt, d, g, n);
        float Br[16], Bi[16], Cr[16], Ci[16];
#pragma unroll
        for (int q = 0; q < 16; ++q) { const float br = b_re[((d * 32 + g) * 64 + n) * 16 + q], bi = b_im[((d * 32 + g) * 64 + n) * 16 + q];
            Br[q] = P.kr * br - P.ki * bi; Bi[q] = P.kr * bi + P.ki * br;
            Cr[q] = c_re[((d * 32 + g) * 16 + q) * 64 + n]; Ci[q] = c_im[((d * 32 + g) * 16 + q) * 64 + n]; }
        float hr = 0.f, hi = 0.f;
        for (int step = 0; step < SEQ; ++step) {
            const int t = d ? (SEQ - 1 - step) : step;
            const float* up = proj + (size_t)(b * SEQ + t) * ldp + g * 16;
            float u[16];
#pragma unroll
            for (int q = 0; q < 16; ++q) u[q] = up[q];
            float bur = 0.f, bui = 0.f;
#pragma unroll
            for (int q = 0; q < 16; ++q) { bur = fmaf(Br[q], u[q], bur); bui = fmaf(Bi[q], u[q], bui); }
            const float nr = P.ar * hr - P.ai * hi + bur, ni = P.ar * hi + P.ai * hr + bui;
            hr = nr; hi = ni;
            float y[16];
#pragma unroll
            for (int p = 0; p < 16; ++p) y[p] = Cr[p] * hr - Ci[p] * hi;
#pragma unroll
            for (int o = 1; o < 64; o <<= 1)
#pragma unroll
                for (int p = 0; p < 16; ++p) y[p] += __shfl_xor(y[p], o);
            if (n < 16) {
                float v = 0.f;
#pragma unroll
                for (int p = 0; p < 16; ++p) if (p == n) v = y[p];
                float* o = spre + (size_t)(b * SEQ + t) * 512 + g * 16 + n;
                if (d == 0) *o = v;
                else { float uu = 0.f;
#pragma unroll
                    for (int p = 0; p < 16; ++p) if (p == n) uu = u[p];
                    *o = gelu_tanh(*o + v + uu * d_skip[g * 16 + n]); }
            }
        }
    }
}
__global__ void glu_ew(const float* __restrict__ spre, const float* __restrict__ gl, const float* __restrict__ bglu, float* __restrict__ mix, int ntok) {
    const size_t i = (size_t)blockIdx.x * 256 + threadIdx.x; if (i >= (size_t)ntok * 512) return;
    const int c = (int)(i & 511); const size_t r = i >> 9;
    mix[r * 1024 + c] = spre[i] * sigmoidf_(gl[i] + bglu[c]);
}
__global__ void rmsnorm_rows(const float* __restrict__ in, int ld, int off, int n, const float* __restrict__ g, float* __restrict__ out, int ntok) {
    const int r = blockIdx.x * 256 + threadIdx.x; if (r >= ntok) return;
    const float* p = in + (size_t)r * ld + off; float s = 0.f;
    for (int j = 0; j < n; ++j) s = fmaf(p[j], p[j], s);
    const float rs = rsqrtf(s / n + RMS_EPS);
    for (int j = 0; j < n; ++j) out[(size_t)r * n + j] = p[j] * rs * g[j];
}
__device__ __forceinline__ void rope_cs(int pos, int i, float& c, float& s) {
    const float inv = expf(-9.210340371976184f * (float)i * (1.f / 16.f));
    const float a = (float)pos * inv; c = cosf(a); s = sinf(a);
}
__global__ void rope_ew(float* __restrict__ q, const float* __restrict__ proj, int ldp, float* __restrict__ krope, int ntok) {
    const int idx = blockIdx.x * 256 + threadIdx.x; if (idx >= ntok * 9 * 16) return;
    const int i = idx & 15, hh = (idx >> 4) % 9, r = idx / 144, pos = r % SEQ;
    float c, s; rope_cs(pos, i, c, s);
    if (hh < 8) { float* p = q + (size_t)r * 768 + hh * 96 + 64; const float t1 = p[i], t2 = p[i + 16]; p[i] = t1 * c - t2 * s; p[i + 16] = t1 * s + t2 * c; }
    else { const float* p = proj + (size_t)r * ldp + 896; const float t1 = p[i], t2 = p[i + 16]; krope[(size_t)r * 32 + i] = t1 * c - t2 * s; krope[(size_t)r * 32 + i + 16] = t1 * s + t2 * c; }
}
__global__ void __launch_bounds__(64) attn_naive(const float* __restrict__ q, const float* __restrict__ kv, const float* __restrict__ krope, float* __restrict__ mix) {
    const int qi = blockIdx.x * 64 + threadIdx.x, h = blockIdx.y, b = blockIdx.z;
    const size_t r = (size_t)b * SEQ + qi;
    float qv[96], o[64];
#pragma unroll
    for (int d = 0; d < 96; ++d) qv[d] = q[r * 768 + h * 96 + d] * ATT_SCALE;
#pragma unroll
    for (int d = 0; d < 64; ++d) o[d] = 0.f;
    float m = -1e30f, l = 0.f;
    for (int s = 0; s < SEQ; ++s) {
        const size_t kr = (size_t)b * SEQ + s;
        const float4* kn = (const float4*)(kv + kr * 1024 + h * 128);
        const float4* kp = (const float4*)(krope + kr * 32);
        float sc = 0.f;
#pragma unroll
        for (int d = 0; d < 16; ++d) { const float4 k4 = kn[d]; sc = fmaf(qv[4 * d], k4.x, sc); sc = fmaf(qv[4 * d + 1], k4.y, sc); sc = fmaf(qv[4 * d + 2], k4.z, sc); sc = fmaf(qv[4 * d + 3], k4.w, sc); }
#pragma unroll
        for (int d = 0; d < 8; ++d) { const float4 k4 = kp[d]; sc = fmaf(qv[64 + 4 * d], k4.x, sc); sc = fmaf(qv[64 + 4 * d + 1], k4.y, sc); sc = fmaf(qv[64 + 4 * d + 2], k4.z, sc); sc = fmaf(qv[64 + 4 * d + 3], k4.w, sc); }
        const float mn = fmaxf(m, sc), al = __expf(m - mn), p = __expf(sc - mn);
        l = l * al + p; m = mn;
        const float4* vp = (const float4*)(kv + kr * 1024 + h * 128 + 64);
#pragma unroll
        for (int d = 0; d < 16; ++d) { const float4 v4 = vp[d]; o[4 * d] = fmaf(o[4 * d], al, p * v4.x); o[4 * d + 1] = fmaf(o[4 * d + 1], al, p * v4.y); o[4 * d + 2] = fmaf(o[4 * d + 2], al, p * v4.z); o[4 * d + 3] = fmaf(o[4 * d + 3], al, p * v4.w); }
    }
    const float il = 1.f / l;
#pragma unroll
    for (int d = 0; d < 64; ++d) mix[r * 1024 + 512 + h * 64 + d] = o[d] * il;
}
__device__ __forceinline__ float wsum(float v) {
#pragma unroll
    for (int o = 1; o < 64; o <<= 1) v += __shfl_xor(v, o);
    return v;
}
__global__ void __launch_bounds__(256) ln1_rows(const float* __restrict__ x, const float* __restrict__ mixo, const float* __restrict__ g, const float* __restrict__ bb, float* __restrict__ x1, int ntok) {
    const int r = blockIdx.x * 4 + (threadIdx.x >> 6), lane = threadIdx.x & 63; if (r >= ntok) return;
    float v[16]; float s = 0.f;
#pragma unroll
    for (int j = 0; j < 16; ++j) { const int c = lane + 64 * j; v[j] = ALPHA * x[(size_t)r * 1024 + c] + mixo[(size_t)r * 1024 + c]; s += v[j]; }
    const float mean = wsum(s) * (1.f / 1024.f); float q = 0.f;
#pragma unroll
    for (int j = 0; j < 16; ++j) { v[j] -= mean; q = fmaf(v[j], v[j], q); }
    const float rstd = rsqrtf(wsum(q) * (1.f / 1024.f) + LN_EPS);
#pragma unroll
    for (int j = 0; j < 16; ++j) { const int c = lane + 64 * j; x1[(size_t)r * 1024 + c] = v[j] * rstd * g[c] + bb[c]; }
}
}

__device__ __forceinline__ void route_token(const float (&lg)[64], const float* __restrict__ rbias, int (&idx)[6], float (&w)[6]) {
    float sc[64], ch[64];
#pragma unroll
    for (int j = 0; j < 64; ++j) { sc[j] = 1.f / (1.f + __expf(-lg[j])); ch[j] = sc[j] + rbias[j]; }
    float gs[8];
#pragma unroll
    for (int g = 0; g < 8; ++g) { float m1 = -INFINITY, m2 = -INFINITY;
#pragma unroll
        for (int j = 0; j < 8; ++j) { const float v = ch[g * 8 + j]; if (v > m1) { m2 = m1; m1 = v; } else if (v > m2) m2 = v; }
        gs[g] = m1 + m2; }
    bool sel[8];
#pragma unroll
    for (int g = 0; g < 8; ++g) { int rank = 0;
#pragma unroll
        for (int o = 0; o < 8; ++o) { if (o != g && (gs[o] > gs[g] || (gs[o] == gs[g] && o < g))) ++rank; }
        sel[g] = rank < 4; }
#pragma unroll
    for (int j = 0; j < 64; ++j) if (!sel[j >> 3]) ch[j] = -INFINITY;
    float wsum_ = 0.f;
#pragma unroll
    for (int k = 0; k < 6; ++k) { float best = -INFINITY; int bi = 0;
#pragma unroll
        for (int j = 0; j < 64; ++j) if (ch[j] > best) { best = ch[j]; bi = j; }
        float sv = 0.f;
#pragma unroll
        for (int j = 0; j < 64; ++j) if (j == bi) { sv = sc[j]; ch[j] = -INFINITY; }
        idx[k] = bi; w[k] = sv; wsum_ += sv; }
    const float inv = 2.5f / (wsum_ + 1e-20f);
#pragma unroll
    for (int k = 0; k < 6; ++k) w[k] *= inv;
}

namespace gold {
__global__ void __launch_bounds__(64) route_rows(const float* __restrict__ logits, const float* __restrict__ rbias, int* __restrict__ topi, float* __restrict__ topw, int ntok) {
    const int r = blockIdx.x * 64 + threadIdx.x; if (r >= ntok) return;
    float lg[64];
#pragma unroll
    for (int j = 0; j < 16; ++j) { const float4 v = ((const float4*)(logits + (size_t)r * 64))[j]; lg[4 * j] = v.x; lg[4 * j + 1] = v.y; lg[4 * j + 2] = v.z; lg[4 * j + 3] = v.w; }
    int idx[6]; float w[6]; route_token(lg, rbias, idx, w);
#pragma unroll
    for (int k = 0; k < 6; ++k) { topi[(size_t)r * 6 + k] = idx[k]; topw[(size_t)r * 6 + k] = w[k]; }
}
__global__ void __launch_bounds__(256) moe_naive(const float* x1, const int* __restrict__ topi, const float* __restrict__ topw,
                                                  const float* __restrict__ weg, const float* __restrict__ weu, const float* __restrict__ wed,
                                                  const float* __restrict__ wsg, const float* __restrict__ wsu, const float* __restrict__ wsd,
                                                  const float* __restrict__ g2, const float* __restrict__ b2, float* out) {
    __shared__ float xs[1024]; __shared__ float hs[256]; __shared__ float red[8];
    const int r = blockIdx.x, tid = threadIdx.x;
#pragma unroll
    for (int j = 0; j < 4; ++j) xs[tid + 256 * j] = x1[(size_t)r * 1024 + tid + 256 * j];
    __syncthreads();
    float acc[4] = {0.f, 0.f, 0.f, 0.f};
    for (int ei = 0; ei < 7; ++ei) {
        const int e = ei < 6 ? topi[(size_t)r * 6 + ei] : 0; const float w = ei < 6 ? topw[(size_t)r * 6 + ei] : 1.f;
        const float* Wg = ei < 6 ? weg + (size_t)e * 1024 * 256 : wsg; const float* Wu = ei < 6 ? weu + (size_t)e * 1024 * 256 : wsu; const float* Wd = ei < 6 ? wed + (size_t)e * 256 * 1024 : wsd;
        float gg = 0.f, uu = 0.f;
        for (int k = 0; k < 1024; ++k) { const float xv = xs[k]; gg = fmaf(xv, Wg[(size_t)k * 256 + tid], gg); uu = fmaf(xv, Wu[(size_t)k * 256 + tid], uu); }
        hs[tid] = gg / (1.f + __expf(-gg)) * uu;
        __syncthreads();
        float y[4] = {0.f, 0.f, 0.f, 0.f};
        for (int i = 0; i < 256; ++i) { const float hv = hs[i];
#pragma unroll
            for (int j = 0; j < 4; ++j) y[j] = fmaf(hv, Wd[(size_t)i * 1024 + tid + 256 * j], y[j]); }
#pragma unroll
        for (int j = 0; j < 4; ++j) acc[j] = fmaf(w, y[j], acc[j]);
        __syncthreads();
    }
    float v[4]; float s = 0.f;
#pragma unroll
    for (int j = 0; j < 4; ++j) { v[j] = ALPHA * xs[tid + 256 * j] + acc[j]; s += v[j]; }
    s = wsum(s); if ((tid & 63) == 0) red[tid >> 6] = s; __syncthreads();
    const float mean = (red[0] + red[1] + red[2] + red[3]) * (1.f / 1024.f); float q = 0.f;
#pragma unroll
    for (int j = 0; j < 4; ++j) { v[j] -= mean; q = fmaf(v[j], v[j], q); }
    q = wsum(q); if ((tid & 63) == 0) red[4 + (tid >> 6)] = q; __syncthreads();
    const float rstd = rsqrtf((red[4] + red[5] + red[6] + red[7]) * (1.f / 1024.f) + LN_EPS);
#pragma unroll
    for (int j = 0; j < 4; ++j) { const int c = tid + 256 * j; out[(size_t)r * 1024 + c] = v[j] * rstd * g2[c] + b2[c]; }
}

struct In {
    const float *x, *w_in, *lam_re, *lam_im, *log_dt, *b_re, *b_im, *c_re, *c_im, *d_skip, *w_glu, *b_glu, *q_norm_g, *w_uq, *kv_norm_g, *w_ukv, *w_o, *ln1_g, *ln1_b,
                *w_router, *router_bias, *we_gate, *we_up, *we_down, *ws_gate, *ws_up, *ws_down, *ln2_g, *ln2_b;
};
constexpr size_t GOLD_FLOATS_PER_TOK = 6400;
struct Bufs { float *proj, *spre, *gl, *mix, *cqn, *ckvn, *q, *kv, *krope, *mixo, *logits; int* topi; float* topw; };
static Bufs run(const In& I, int tok0, int ntok, float* scratch, float* x1out, float* out, hipStream_t st) {
    Bufs B;
    B.proj = scratch; B.spre = B.proj + (size_t)ntok * 928; B.gl = B.spre + (size_t)ntok * 512; B.mix = B.gl + (size_t)ntok * 512;
    B.cqn = B.mix + (size_t)ntok * 1024; B.ckvn = B.cqn + (size_t)ntok * 256; B.q = B.ckvn + (size_t)ntok * 128; B.kv = B.q + (size_t)ntok * 768;
    B.krope = B.kv + (size_t)ntok * 1024; B.mixo = B.krope + (size_t)ntok * 32; B.logits = B.mixo + (size_t)ntok * 1024;
    B.topi = (int*)(B.logits + (size_t)ntok * 64); B.topw = (float*)(B.topi + (size_t)ntok * 6);
    float *proj = B.proj, *spre = B.spre, *gl = B.gl, *mix = B.mix, *cqn = B.cqn, *ckvn = B.ckvn, *q = B.q, *kv = B.kv, *krope = B.krope, *mixo = B.mixo, *logits = B.logits; int* topi = B.topi; float* topw = B.topw;
    const float* x = I.x + (size_t)tok0 * 1024; const int nb = ntok / SEQ;
    hipLaunchKernelGGL(sgemm, dim3((928 + 63) / 64, ntok / 64), dim3(256), 0, st, x, 1024, I.w_in, 928, proj, 928, ntok, 928, 1024);
    hipLaunchKernelGGL(ssm_naive, dim3(32, nb), dim3(64), 0, st, proj, 928, I.lam_re, I.lam_im, I.log_dt, I.b_re, I.b_im, I.c_re, I.c_im, I.d_skip, spre);
    hipLaunchKernelGGL(sgemm, dim3(8, ntok / 64), dim3(256), 0, st, spre, 512, I.w_glu, 512, gl, 512, ntok, 512, 512);
    hipLaunchKernelGGL(glu_ew, dim3((unsigned)(((size_t)ntok * 512 + 255) / 256)), dim3(256), 0, st, spre, gl, I.b_glu, mix, ntok);
    hipLaunchKernelGGL(rmsnorm_rows, dim3((ntok + 255) / 256), dim3(256), 0, st, proj, 928, 512, 256, I.q_norm_g, cqn, ntok);
    hipLaunchKernelGGL(rmsnorm_rows, dim3((ntok + 255) / 256), dim3(256), 0, st, proj, 928, 768, 128, I.kv_norm_g, ckvn, ntok);
    hipLaunchKernelGGL(sgemm, dim3(12, ntok / 64), dim3(256), 0, st, cqn, 256, I.w_uq, 768, q, 768, ntok, 768, 256);
    hipLaunchKernelGGL(sgemm, dim3(16, ntok / 64), dim3(256), 0, st, ckvn, 128, I.w_ukv, 1024, kv, 1024, ntok, 1024, 128);
    hipLaunchKernelGGL(rope_ew, dim3((ntok * 144 + 255) / 256), dim3(256), 0, st, q, proj, 928, krope, ntok);
    hipLaunchKernelGGL(attn_naive, dim3(SEQ / 64, 8, nb), dim3(64), 0, st, q, kv, krope, mix);
    hipLaunchKernelGGL(sgemm, dim3(16, ntok / 64), dim3(256), 0, st, mix, 1024, I.w_o, 1024, mixo, 1024, ntok, 1024, 1024);
    hipLaunchKernelGGL(ln1_rows, dim3(ntok / 4), dim3(256), 0, st, x, mixo, I.ln1_g, I.ln1_b, x1out, ntok);
    hipLaunchKernelGGL(sgemm, dim3(1, ntok / 64), dim3(256), 0, st, x1out, 1024, I.w_router, 64, logits, 64, ntok, 64, 1024);
    hipLaunchKernelGGL(route_rows, dim3(ntok / 64), dim3(64), 0, st, logits, I.router_bias, topi, topw, ntok);
    hipLaunchKernelGGL(moe_naive, dim3(ntok), dim3(256), 0, st, x1out, topi, topw, I.we_gate, I.we_up, I.we_down, I.ws_gate, I.ws_up, I.ws_down, I.ln2_g, I.ln2_b, out);
    return B;
}
}
#define GAS __attribute__((address_space(1)))
#define LAS __attribute__((address_space(3)))
typedef unsigned short bf16_t;
typedef short bf16x8 __attribute__((ext_vector_type(8)));
typedef short s16x4 __attribute__((ext_vector_type(4)));
typedef float f32x4 __attribute__((ext_vector_type(4)));
typedef float f32x2 __attribute__((ext_vector_type(2)));
typedef float f32x16 __attribute__((ext_vector_type(16)));
typedef unsigned u32x4 __attribute__((ext_vector_type(4)));
typedef unsigned u32x2 __attribute__((ext_vector_type(2)));

namespace fx {
constexpr int T = 65536, SEQ = 2048, DM = 1024, NB = 32;
constexpr int CHK = 32;
constexpr int NCHK = SEQ / CHK;
constexpr int UHR = NB * NCHK;
constexpr int UHK = CHK * 16 + 256;
constexpr int Y8_LD = 1024;
constexpr int SPRE_LD = 512;
constexpr int NCH = 2;
constexpr int CAPC = T / NCH;
constexpr int NVE = NCH * 65;
constexpr float ALPHA = 1.189207115002721f, LN_EPS = 1e-5f, RMS_EPS = 1e-6f;
constexpr float QSCALE = 0.10206207261596577f * 1.4426950408889634f;

constexpr size_t MiB = 1u << 20;
constexpr size_t WS_CTL = 0, CTL_BYTES = 1 * MiB;
constexpr size_t WS_ROPE = 1 * MiB;
constexpr size_t WS_KT = 2 * MiB;
constexpr size_t WS_WIN = 4 * MiB, WS_WGLU = 6 * MiB, WS_WUQ = 6 * MiB + 512 * 1024, WS_WUKV = 7 * MiB, WS_WO = 8 * MiB;
constexpr size_t WS_WST = 10 * MiB, WS_MO = 18 * MiB, WS_WGU = 42 * MiB  , WS_WR = 107 * MiB  , WS_WD = 107 * MiB + 512 * 1024;
constexpr size_t WS_SSQQ = 140 * MiB, WS_SSQKV = 141 * MiB, WS_TSLOT = 142 * MiB, WS_TOPW = 144 * MiB, WS_ROWTOK = 146 * MiB, WS_LOGIT = 162 * MiB;
constexpr size_t WS_XB = 178 * MiB, WS_UH = 306 * MiB, WS_CQ = 402 * MiB, WS_CKVR = 434 * MiB, WS_S = 466 * MiB, WS_Q = 530 * MiB, WS_KV = 626 * MiB, WS_SPRE = 754 * MiB, WS_MIX = 818 * MiB;
constexpr size_t WS_X1B = 178 * MiB, WS_H = 306 * MiB, WS_Y = 562 * MiB  , WS_YS = 800 * MiB  , WS_HS = 864 * MiB  ;
constexpr size_t WS_GOLD = 946 * MiB, WS_END = 1024 * MiB;
constexpr int CW_TMO = 0, CW_CODE = 1, CW_BAR = 4096, CW_CNT = 16384  , CW_DBG = 65536  , CW_QUEUE = 32768  ;

constexpr int RING_BYTES = 131072, TAB_OFF = RING_BYTES, IDX_OFF = TAB_OFF + 10752  , IDX_UNITS = 16, MISC_OFF = IDX_OFF + IDX_UNITS * 1024, LDS_BYTES = MISC_OFF + 256;

__device__ __forceinline__ unsigned cvt_pk_bf16(float lo, float hi) { unsigned r; asm volatile("v_cvt_pk_bf16_f32 %0, %1, %2" : "=v"(r) : "v"(lo), "v"(hi)); return r; }
__device__ __forceinline__ float bf_lo(unsigned w) { return __uint_as_float(w << 16); }
__device__ __forceinline__ float bf_hi(unsigned w) { return __uint_as_float(w & 0xffff0000u); }
__device__ __forceinline__ u32x4 pack8(const f32x4 a, const f32x4 b) { u32x4 w; w.x = cvt_pk_bf16(a[0], a[1]); w.y = cvt_pk_bf16(a[2], a[3]); w.z = cvt_pk_bf16(b[0], b[1]); w.w = cvt_pk_bf16(b[2], b[3]); return w; }
__device__ __forceinline__ void unpack8(const u32x4 w, f32x4& a, f32x4& b) { a = (f32x4){bf_lo(w.x), bf_hi(w.x), bf_lo(w.y), bf_hi(w.y)}; b = (f32x4){bf_lo(w.z), bf_hi(w.z), bf_lo(w.w), bf_hi(w.w)}; }
__device__ __forceinline__ float fast_sigmoid(float x) { return __builtin_amdgcn_rcpf(1.f + __builtin_amdgcn_exp2f(-1.4426950408889634f * x)); }
__device__ __forceinline__ float gelu_tanh_f(float x) {
    const float z2 = 1.5957691216057308f * (x + 0.044715f * x * x * x);
    return x * fast_sigmoid(z2);
}
#ifndef SC1_STORES
#define SC1_STORES 0
#endif
__device__ __forceinline__ void store16(void* p, const u32x4 v) {
#if SC1_STORES
    asm volatile("global_store_dwordx4 %0, %1, off sc1\n\ts_nop 1" :: "v"(p), "v"(v) : "memory");
#else
    *(u32x4*)p = v;
#endif
}
__device__ __forceinline__ u32x4 ror8_x4(const u32x4 v) { u32x4 r;
    r.x = (unsigned)__builtin_amdgcn_update_dpp(0, (int)v.x, 0x128, 0xF, 0xF, false); r.y = (unsigned)__builtin_amdgcn_update_dpp(0, (int)v.y, 0x128, 0xF, 0xF, false);
    r.z = (unsigned)__builtin_amdgcn_update_dpp(0, (int)v.z, 0x128, 0xF, 0xF, false); r.w = (unsigned)__builtin_amdgcn_update_dpp(0, (int)v.w, 0x128, 0xF, 0xF, false); return r; }
__device__ __forceinline__ void store_lines16(bf16_t* rowp, size_t ld, const u32x4 X, const u32x4 Y, int fr, int fq) {
    const bool lo = fr < 8; const u32x4 S = lo ? Y : X, R = ror8_x4(S);
    const u32x4 A1 = lo ? X : R, A2 = lo ? R : Y;
    bf16_t* p = rowp + (size_t)(fr & 7) * ld + (lo ? 8 * fq : 32 + 8 * fq);
    *(u32x4*)p = A1; *(u32x4*)(p + 8 * ld) = A2;
}
__device__ __forceinline__ float wave_sum(float v) {
#pragma unroll
    for (int o = 1; o < 64; o <<= 1) v += __shfl_xor(v, o);
    return v;
}

#define XB_TMO      128
#define XB_XCNT(j)  (256  + 64 * (j))
#define XB_XSUB(j)  (1280 + 64 * (j))
#define XB_XGEN(j)  (2304 + 64 * (j))
#define XB_TOP      3328
#define XB_TOPGEN   3392
#define XCD_BAR_WORDS 3456
#define XB_SPIN_CAP (1u << 18)
__device__ __forceinline__ unsigned xb_ld(unsigned* p)              { return __hip_atomic_load(p, __ATOMIC_RELAXED, __HIP_MEMORY_SCOPE_AGENT); }
__device__ __forceinline__ unsigned xb_add(unsigned* p, unsigned v) { return __hip_atomic_fetch_add(p, v, __ATOMIC_RELAXED, __HIP_MEMORY_SCOPE_AGENT); }
__device__ __forceinline__ unsigned xb_xcc_id() { return (unsigned)__builtin_amdgcn_s_getreg((3 << 11) | 20) & 0xFu; }
#define XB_SPIN(cond, bar) do { unsigned _sp = 0; while (cond) { __builtin_amdgcn_s_sleep(1); \
    if ((++_sp & 255u) == 0u) { if (xb_ld(&(bar)[XB_TMO])) break; if (_sp > XB_SPIN_CAP) { atomicAdd(&(bar)[XB_TMO], 1u); break; } } } } while (0)
struct XcdBarrier { unsigned* bar; unsigned x; volatile LAS unsigned* st; };
__device__ __forceinline__ XcdBarrier xcd_barrier_post(unsigned* bar, volatile LAS unsigned* st) {
    XcdBarrier b; b.bar = bar; b.x = xb_xcc_id(); b.st = st;
    if (threadIdx.x == 0) (void)xb_add(&bar[XB_XCNT(b.x)], 1u);
    return b;
}
__device__ __forceinline__ void xcd_barrier_complete(unsigned* bar, unsigned x, unsigned& nloc, unsigned& nx) {
    const unsigned G = gridDim.x * gridDim.y * gridDim.z;
    unsigned sum, cnt, mine, sp = 0u;
    for (;;) {
        sum = 0u; cnt = 0u; mine = 0u;
#pragma unroll
        for (unsigned j = 0; j < 16; ++j) { const unsigned c = xb_ld(&bar[XB_XCNT(j)]); sum += c; cnt += (c > 0u) ? 1u : 0u; mine = (j == x) ? c : mine; }
        if (sum == G) break;
        __builtin_amdgcn_s_sleep(1);
        if ((++sp & 255u) == 0u) { if (xb_ld(&bar[XB_TMO])) break; if (sp > XB_SPIN_CAP) { atomicAdd(&bar[XB_TMO], 1u); break; } }
    }
    nloc = mine > 0u ? mine : 1u; nx = cnt > 0u ? cnt : 1u;
}
__device__ __forceinline__ void xcd_barrier(const XcdBarrier& b) {
    asm volatile("s_waitcnt vmcnt(0)" ::: "memory");
    __syncthreads();
    if (threadIdx.x == 0) {
        unsigned* bar = b.bar;
        __builtin_amdgcn_s_waitcnt(0);
        unsigned nloc = b.st[0], nx = b.st[1];
        if (nloc == 0u) { xcd_barrier_complete(bar, b.x, nloc, nx); b.st[0] = nloc; b.st[1] = nx; }
        const unsigned old = xb_add(&bar[XB_XSUB(b.x)], 1u);
        const unsigned gen = old / nloc;
        if (old + 1u == (gen + 1u) * nloc) {
            __builtin_amdgcn_fence(__ATOMIC_RELEASE, "agent");
            asm volatile("s_waitcnt vmcnt(0)" ::: "memory");
            const unsigned og = xb_add(&bar[XB_TOP], 1u);
            const unsigned tg = og / nx;
            if (og + 1u == (tg + 1u) * nx) xb_add(&bar[XB_TOPGEN], 1u);
            else XB_SPIN(xb_ld(&bar[XB_TOPGEN]) == tg, bar);
            __builtin_amdgcn_fence(__ATOMIC_ACQUIRE, "agent");
            xb_add(&bar[XB_XGEN(b.x)], 1u);
            asm volatile("s_waitcnt vmcnt(0)" ::: "memory");
        } else {
            XB_SPIN(xb_ld(&bar[XB_XGEN(b.x)]) == gen, bar);
            __builtin_amdgcn_fence(__ATOMIC_ACQUIRE, "agent");
            asm volatile("s_waitcnt vmcnt(0)" ::: "memory");
        }
    }
    __syncthreads();
}

constexpr int BM = 256, BK = 64, HALF = 128, HTB = HALF * BK * 2, STAGE_BYTES = 8 * HTB;
__host__ __device__ __forceinline__ int lds_byte(int r, int c) { const int st = (r >> 4) * 2 + (c >> 5), rr = r & 15, cc = c & 31, ob = rr * 64 + cc * 2; return st * 1024 + (ob ^ (((ob >> 9) & 1) << 5)); }
__host__ __device__ __forceinline__ void stage_rc(int b, int& R, int& C) { const int st = b / 1024, sb = b % 1024, swz = sb ^ (((sb >> 9) & 1) << 5); R = (st >> 1) * 16 + swz / 64; C = (st & 1) * 32 + (swz % 64) / 2; }
__host__ __device__ __forceinline__ int perm32(int rho) { const int n = rho >> 4, i = rho & 15; return 8 * (i >> 2) + 4 * n + (i & 3); }
__host__ __device__ __forceinline__ int perm16x(int rho) { const int n = rho >> 4, i = rho & 15; return 16 * (i >> 2) + 4 * n + (i & 3); }

struct Unit { const char* A; const char* B; int i0, i1, i2, i3; };
__device__ __forceinline__ int xcd_remap(int L, int nwg) { const int q = nwg / 8, r = nwg % 8, xcd = L % 8, off = L / 8; return (xcd < r ? xcd * (q + 1) : r * (q + 1) + (xcd - r) * q) + off; }

template <class Epi, class Sched, bool ALIGN_EPI, bool GATHER, int STAG = 0, int AMODE = 0>
__device__ __forceinline__ void gemm_phase(LAS unsigned char* lds, const int lda, const int ldb, const int K, const Sched& S, const Epi& E) {
    if constexpr (STAG > 0) { const unsigned long long t0_ = __builtin_amdgcn_s_memrealtime(), dl_ = (unsigned long long)STAG * ((blockIdx.x >> 3) & 3u); while (__builtin_amdgcn_s_memrealtime() - t0_ < dl_) __builtin_amdgcn_s_sleep(4); }
    int tid = threadIdx.x; asm volatile("" : "+v"(tid));
    const int wid = __builtin_amdgcn_readfirstlane(tid >> 6), lane = tid & 63, wr = wid >> 2, wc = wid & 3, fr = lane & 15, fq = lane >> 4;
    const int nt = K / BK;
    unsigned voffA[2], voffB[2]; int RA[2], CA[2];
#pragma unroll
    for (int i = 0; i < 2; ++i) { int R, C; stage_rc(tid * 16 + i * 8192, R, C); const int Rb = 64 * (R >> 5) + (Epi::PERM == 2 ? perm16x(R & 31) : Epi::PERM ? perm32(R & 31) : (R & 31));
        RA[i] = R; CA[i] = C; voffA[i] = AMODE == 1 ? (unsigned)((R >> 4) * 8192 + (R & 7) * 1024 + (C >> 5) * 128 + ((R >> 3) & 1) * 64 + (C & 31) * 2) : (unsigned)(R * lda + C) * 2u; voffB[i] = (unsigned)(Rb * ldb + C) * 2u; }
    const size_t kstep = (size_t)(BK * 2), kstepA = AMODE == 1 ? 256 : kstep;
    const size_t hstepA = (size_t)HALF * lda * 2, hstepB = (size_t)(Epi::PERM == 2 ? 8 : 32) * ldb * 2;
    const unsigned ldsw = (unsigned)wid * 1024u;
    const int aoff = lds_byte(wr * 64 + fr, fq * 8), boff = lds_byte(wc * 32 + fr, fq * 8);
#define PG8_SA(b, h) (((b) * 2 + (h)) * HTB)
#define PG8_SB(b, h) ((4 + (b) * 2 + (h)) * HTB)
#define PG8_STAGE(bufoff, gbase, voff) do { _Pragma("unroll") for (int _i = 0; _i < 2; ++_i) \
        __builtin_amdgcn_global_load_lds((const unsigned*)((const char*)(gbase) + (voff)[_i]), (LAS unsigned*)(lds + (bufoff) + ldsw + _i * 8192), 16, 0, 0); } while (0)
#define PG8_STAGE_A(bufoff, base, g0, g1, h, kb) do { if constexpr (GATHER) { \
        __builtin_amdgcn_global_load_lds((const unsigned*)((base) + (kb) + (g0)), (LAS unsigned*)(lds + (bufoff) + ldsw), 16, 0, 0); \
        __builtin_amdgcn_global_load_lds((const unsigned*)((base) + (kb) + (g1)), (LAS unsigned*)(lds + (bufoff) + ldsw + 8192), 16, 0, 0); } \
      else { PG8_STAGE(bufoff, (base) + (h) * hstepA + (kb), voffA); } } while (0)
#define PG8_LDA(dst, b, h) do { _Pragma("unroll") for (int m = 0; m < 4; ++m) _Pragma("unroll") for (int k = 0; k < 2; ++k) dst[m][k] = *(const LAS bf16x8*)(lds + PG8_SA(b, h) + aoff + m * 2048 + k * 1024); } while (0)
#define PG8_LDB(dst, b, h) do { _Pragma("unroll") for (int n = 0; n < 2; ++n) _Pragma("unroll") for (int k = 0; k < 2; ++k) dst[n][k] = *(const LAS bf16x8*)(lds + PG8_SB(b, h) + boff + n * 2048 + k * 1024); } while (0)
#define PG8_MMA(ai, bj, At, Bt) do { __builtin_amdgcn_s_setprio(1); _Pragma("unroll") for (int m = 0; m < 4; ++m) _Pragma("unroll") for (int n = 0; n < 2; ++n) _Pragma("unroll") for (int k = 0; k < 2; ++k) \
        acc[ai][bj][m][n] = __builtin_amdgcn_mfma_f32_16x16x32_bf16(Bt[n][k], At[m][k], acc[ai][bj][m][n], 0, 0, 0); __builtin_amdgcn_s_setprio(0); } while (0)
#define PG8_WAIT_V(n) asm volatile("s_waitcnt vmcnt(" #n ")" ::: "memory")
#define PG8_WAIT_VN(n) asm volatile("s_waitcnt vmcnt(%0)" :: "n"(n) : "memory")
#define PG8_WAIT_L(n) asm volatile("s_waitcnt lgkmcnt(" #n ")" ::: "memory")
#define PG8_BAR __builtin_amdgcn_s_barrier()
#define PG8_SCHED __builtin_amdgcn_sched_barrier(0)
    Unit cur, nxt; int ui = 0;
    if (!S.next(0, cur)) return;
    unsigned gc00 = 0, gc01 = 0, gc10 = 0, gc11 = 0, gn00 = 0, gn01 = 0, gn10 = 0, gn11 = 0;
    if constexpr (GATHER) { S.gather(cur, RA[0], CA[0], RA[1], CA[1], gc00, gc01, gc10, gc11); gn00 = gc00; gn01 = gc01; gn10 = gc10; gn11 = gc11; }
    f32x4 acc[2][2][4][2];
#pragma unroll
    for (int a = 0; a < 2; ++a)
#pragma unroll
        for (int b = 0; b < 2; ++b)
#pragma unroll
            for (int m = 0; m < 4; ++m)
#pragma unroll
                for (int n = 0; n < 2; ++n) acc[a][b][m][n] = (f32x4){0.f, 0.f, 0.f, 0.f};
    bf16x8 At[4][2], B0[2][2], B1[2][2];
    const char* cA = cur.A; const char* cB = cur.B;
    PG8_STAGE(PG8_SB(0, 0), cB, voffB); PG8_STAGE(PG8_SB(0, 1), cB + hstepB, voffB); PG8_STAGE_A(PG8_SA(0, 0), cA, gc00, gc01, 0, 0); PG8_STAGE_A(PG8_SA(0, 1), cA, gc10, gc11, 1, 0);
    if (wr == 1) PG8_BAR;
    PG8_WAIT_V(2); PG8_BAR;
    PG8_STAGE(PG8_SB(1, 0), cB + kstep, voffB); PG8_STAGE_A(PG8_SA(1, 0), cA, gc00, gc01, 0, kstepA); PG8_STAGE(PG8_SB(1, 1), cB + hstepB + kstep, voffB);
    PG8_WAIT_V(6); PG8_BAR;
    for (;;) {
        const bool has_next = S.next(ui + 1, nxt);
        if constexpr (GATHER) { if (has_next) S.gather(nxt, RA[0], CA[0], RA[1], CA[1], gn00, gn01, gn10, gn11); }
        const char* nA = has_next ? nxt.A : cA; const char* nB = has_next ? nxt.B : cB;
#if defined(MK_KLOOP)
        unsigned long long tk0_ = 0; if (blockIdx.x == 0 && wid == 0) tk0_ = __builtin_amdgcn_s_memrealtime();
#endif
#pragma unroll 1
        for (int t = 0; t < nt; t += 2) {
            const bool last = (t == nt - 2);
            const size_t k1 = (size_t)(t + 1) * kstepA;
            const char* a2 = last ? nA : cA; const char* b2 = last ? nB : cB + (size_t)(t + 2) * kstep;
            const size_t k2 = last ? 0 : (size_t)(t + 2) * kstepA, k3 = k2 + kstepA;
            const char* b3 = b2 + kstep;
            unsigned g200 = gc00, g201 = gc01, g210 = gc10, g211 = gc11;
            if constexpr (GATHER) { if (last) { g200 = gn00; g201 = gn01; g210 = gn10; g211 = gn11; } }
#if defined(MK_8PH)
            PG8_LDB(B0, 0, 0); PG8_SCHED; PG8_LDA(At, 0, 0); PG8_STAGE_A(PG8_SA(1, 1), cA, gc10, gc11, 1, k1);
            PG8_WAIT_L(8); PG8_BAR; PG8_WAIT_L(0); PG8_MMA(0, 0, At, B0); PG8_BAR; PG8_SCHED;
            PG8_LDB(B1, 0, 1); PG8_STAGE(PG8_SB(0, 0), b2, voffB);
            PG8_BAR; PG8_WAIT_L(0); PG8_MMA(0, 1, At, B1); PG8_BAR;
            PG8_LDA(At, 0, 1); PG8_STAGE_A(PG8_SA(0, 0), a2, g200, g201, 0, k2);
            PG8_BAR; PG8_WAIT_L(0); PG8_MMA(1, 0, At, B0); PG8_BAR; PG8_SCHED;
            PG8_STAGE(PG8_SB(0, 1), b2 + hstepB, voffB);
            PG8_WAIT_V(6); PG8_BAR; PG8_MMA(1, 1, At, B1); PG8_BAR;
            PG8_LDB(B0, 1, 0); PG8_SCHED; PG8_LDA(At, 1, 0); PG8_STAGE_A(PG8_SA(0, 1), a2, g210, g211, 1, k2);
            PG8_WAIT_L(8); PG8_BAR; PG8_WAIT_L(0); PG8_MMA(0, 0, At, B0); PG8_BAR; PG8_SCHED;
            PG8_LDB(B1, 1, 1); PG8_STAGE(PG8_SB(1, 0), b3, voffB);
            PG8_BAR; PG8_WAIT_L(0); PG8_MMA(0, 1, At, B1); PG8_BAR;
            PG8_LDA(At, 1, 1); PG8_STAGE_A(PG8_SA(1, 0), a2, g200, g201, 0, k3);
            PG8_BAR; PG8_WAIT_L(0); PG8_MMA(1, 0, At, B0); PG8_BAR; PG8_SCHED;
            PG8_STAGE(PG8_SB(1, 1), b3 + hstepB, voffB);
            PG8_WAIT_V(6); PG8_BAR; PG8_MMA(1, 1, At, B1); PG8_BAR;
#else
            PG8_LDB(B0, 0, 0); PG8_LDB(B1, 0, 1); PG8_SCHED; PG8_LDA(At, 0, 0); PG8_STAGE_A(PG8_SA(1, 1), cA, gc10, gc11, 1, k1);
            PG8_WAIT_V(8); PG8_WAIT_L(0); PG8_BAR; PG8_MMA(0, 0, At, B0); PG8_MMA(0, 1, At, B1); PG8_BAR; PG8_SCHED;
            PG8_LDA(At, 0, 1); PG8_STAGE(PG8_SB(0, 0), b2, voffB); PG8_STAGE(PG8_SB(0, 1), b2 + hstepB, voffB); PG8_STAGE_A(PG8_SA(0, 0), a2, g200, g201, 0, k2);
            PG8_WAIT_V(8); PG8_WAIT_L(0); PG8_BAR; PG8_MMA(1, 0, At, B0); PG8_MMA(1, 1, At, B1); PG8_BAR; PG8_SCHED;
            PG8_LDB(B0, 1, 0); PG8_LDB(B1, 1, 1); PG8_SCHED; PG8_LDA(At, 1, 0); PG8_STAGE_A(PG8_SA(0, 1), a2, g210, g211, 1, k2);
            PG8_WAIT_V(8); PG8_WAIT_L(0); PG8_BAR; PG8_MMA(0, 0, At, B0); PG8_MMA(0, 1, At, B1); PG8_BAR; PG8_SCHED;
            PG8_LDA(At, 1, 1); PG8_STAGE(PG8_SB(1, 0), b3, voffB); PG8_STAGE(PG8_SB(1, 1), b3 + hstepB, voffB); PG8_STAGE_A(PG8_SA(1, 0), a2, g200, g201, 0, k3);
            PG8_WAIT_V(8); PG8_WAIT_L(0); PG8_BAR; PG8_MMA(1, 0, At, B0); PG8_MMA(1, 1, At, B1); PG8_BAR; PG8_SCHED;
        #endif
        }
#if defined(MK_KLOOP)
        if (blockIdx.x == 0 && wid == 0) { const unsigned long long d_ = __builtin_amdgcn_s_memrealtime() - tk0_; if (lane == 0) { volatile LAS unsigned* M_ = (volatile LAS unsigned*)(lds + MISC_OFF); const unsigned long long a_ = (((unsigned long long)M_[23] << 32) | M_[22]) + d_; M_[22] = (unsigned)a_; M_[23] = (unsigned)(a_ >> 32); } }
#endif
#if defined(MK_TPROBE) && MK_TPROBE >= 200 && !defined(MK_KLOOP)
        unsigned long long tp0_ = 0; if (blockIdx.x == 0 && wid == 0) tp0_ = __builtin_amdgcn_s_memrealtime();
#endif
        if constexpr (ALIGN_EPI) { if (wr == 0) PG8_BAR; }
        E(acc, cur, wr, wc, fr, fq);
#if defined(MK_TPROBE) && MK_TPROBE >= 200 && !defined(MK_KLOOP)
        if (blockIdx.x == 0 && wid == 0) { asm volatile("s_waitcnt vmcnt(0)" ::: "memory"); const unsigned long long d_ = __builtin_amdgcn_s_memrealtime() - tp0_; if (lane == 0) { volatile LAS unsigned* M_ = (volatile LAS unsigned*)(lds + MISC_OFF); const unsigned long long a_ = (((unsigned long long)M_[23] << 32) | M_[22]) + d_; M_[22] = (unsigned)a_; M_[23] = (unsigned)(a_ >> 32); } }
#endif
        if (!has_next) break;
#pragma unroll
        for (int a = 0; a < 2; ++a)
#pragma unroll
            for (int b = 0; b < 2; ++b)
#pragma unroll
                for (int m = 0; m < 4; ++m)
#pragma unroll
                    for (int n = 0; n < 2; ++n) acc[a][b][m][n] = (f32x4){0.f, 0.f, 0.f, 0.f};
        cur = nxt; cA = nA; cB = nB; ++ui;
        if constexpr (GATHER) { gc00 = gn00; gc01 = gn01; gc10 = gn10; gc11 = gn11; }
        if constexpr (ALIGN_EPI) { if (wr == 1) PG8_BAR; }
    }
    PG8_WAIT_V(0);
    if constexpr (!ALIGN_EPI) { if (wr == 0) PG8_BAR; }
    PG8_BAR;
#undef PG8_SA
#undef PG8_SB
#undef PG8_STAGE
#undef PG8_STAGE_A
#undef PG8_LDA
#undef PG8_LDB
#undef PG8_MMA
#undef PG8_WAIT_V
#undef PG8_WAIT_VN
#undef PG8_WAIT_L
#undef PG8_BAR
#undef PG8_SCHED
}
}
namespace fx {
#define FX_ROWLOOP _Pragma("unroll") for (int ai = 0; ai < 2; ++ai) _Pragma("unroll") for (int m = 0; m < 4; ++m)

struct PlainOrder {
    const char* A; const char* B; int lda, ldb, nM, nN, nwg, G, c;
    __device__ __forceinline__ void init(const void* A_, int lda_, const void* B_, int ldb_, int M, int N, int G_, int c_) { A = (const char*)A_; B = (const char*)B_; lda = lda_; ldb = ldb_; nM = M / 256; nN = N / 256; nwg = nM * nN; G = G_; c = c_; }
    __device__ __forceinline__ bool next(int i, Unit& u) const {
        const long L = (long)i * G + c; if (L >= nwg) return false;
        const int wgid = xcd_remap((int)L, nwg);
        const int nig = 8 * nN, gid = wgid / nig, fm = gid * 8, gsz = (nM - fm) < 8 ? (nM - fm) : 8;
        const int pm = fm + ((wgid % nig) % gsz), pn = (wgid % nig) / gsz;
        u.A = A + (size_t)pm * 256 * lda * 2; u.B = B + (size_t)pn * 256 * ldb * 2; u.i0 = pm; u.i1 = pn; u.i2 = 0; u.i3 = 0; return true;
    }
};
struct PanelOrder {
    const char* A; const char* B; int lda, ldb, nM, nN, G, c;
    __device__ __forceinline__ void init(const void* A_, int lda_, const void* B_, int ldb_, int M, int N, int G_, int c_) { A = (const char*)A_; B = (const char*)B_; lda = lda_; ldb = ldb_; nM = M / 256; nN = N / 256; G = G_; c = c_; }
    __device__ __forceinline__ bool next(int i, Unit& u) const {
        const int j = i / nN, pn = i - j * nN, pm = c + j * G; if (pm >= nM) return false;
        u.A = A + (size_t)pm * 256 * lda * 2; u.B = B + (size_t)pn * 256 * ldb * 2; u.i0 = pm; u.i1 = pn; u.i2 = 0; u.i3 = 0; return true;
    }
};
struct GroupOrder {
    const char* A; const char* B; int ldb, nN, nwg, G, c;
    __device__ __forceinline__ void init(const void* A_, const void* B_, int ldb_, int nN_, int G_, int c_) { A = (const char*)A_; B = (const char*)B_; ldb = ldb_; nN = nN_; nwg = 32 * 8 * nN_; G = G_; c = c_; }
    __device__ __forceinline__ bool next(int i, Unit& u) const {
        const long L = (long)i * G + c; if (L >= nwg) return false;
        const int wgid = xcd_remap((int)L, nwg);
        const int per = 8 * nN, g = wgid / per, rem = wgid % per, pm = rem % 8, pn = rem / 8;
        u.A = A + ((size_t)g * UHR + (size_t)pm * 256) * UHK * 2; u.B = B + ((size_t)g * nN * 256 + (size_t)pn * 256) * ldb * 2; u.i0 = g; u.i1 = pm; u.i2 = pn; u.i3 = 0; return true;
    }
};

__device__ __forceinline__ void rope8(f32x4& v0, f32x4& v1, const float* __restrict__ ropec, const float* __restrict__ ropes, int pos, int fq) {
    const f32x4 c = *(const f32x4*)(ropec + pos * 16 + 4 * fq), s = *(const f32x4*)(ropes + pos * 16 + 4 * fq);
    const f32x4 a = v0, b = v1;
    v0 = (f32x4){a[0] * c[0] - a[1] * s[0], a[0] * s[0] + a[1] * c[0], a[2] * c[1] - a[3] * s[1], a[2] * s[1] + a[3] * c[1]};
    v1 = (f32x4){b[0] * c[2] - b[1] * s[2], b[0] * s[2] + b[1] * c[2], b[2] * c[3] - b[3] * s[3], b[2] * s[3] + b[3] * c[3]};
}
__device__ __forceinline__ float sumsq8(const f32x4 a, const f32x4 b) { return (a[0] * a[0] + a[1] * a[1]) + (a[2] * a[2] + a[3] * a[3]) + (b[0] * b[0] + b[1] * b[1]) + (b[2] * b[2] + b[3] * b[3]); }

struct EpiWin {
    static constexpr int PERM = 1; static constexpr int NST = 16;
    bf16_t* UH; bf16_t* CQ; bf16_t* CKVR; float* ssqq; float* ssqkv; const float* ropec; const float* ropes;
    __device__ __forceinline__ void operator()(const f32x4 (&acc)[2][2][4][2], const Unit& u, int wr, int wc, int fr, int fq) const {
        const int pm = u.i0, pn = u.i1, row0 = pm * 256 + wr * 64 + fr;
        if (pn < 2) {
            FX_ROWLOOP { const int row = row0 + ai * 128 + m * 16, r32 = row >> 5, tq = row & 31;
#pragma unroll
                for (int bj = 0; bj < 2; ++bj) { const int c = pn * 256 + wc * 64 + bj * 32 + 8 * fq, g = c >> 4, p0 = c & 15;
                    *(u32x4*)(UH + ((size_t)(g * UHR + r32) * UHK + tq * 16 + p0)) = pack8(acc[ai][bj][m][0], acc[ai][bj][m][1]); } }
        } else if (pn == 2) {
            FX_ROWLOOP { const int row = row0 + ai * 128 + m * 16; float ss = sumsq8(acc[ai][0][m][0], acc[ai][0][m][1]) + sumsq8(acc[ai][1][m][0], acc[ai][1][m][1]);
                store_lines16(CQ + (size_t)(row - fr) * 256 + 64 * wc, 256, pack8(acc[ai][0][m][0], acc[ai][0][m][1]), pack8(acc[ai][1][m][0], acc[ai][1][m][1]), fr, fq);
                ss += __shfl_xor(ss, 16); ss += __shfl_xor(ss, 32);
                if (fq == 0) ssqq[(size_t)row * 4 + wc] = ss; }
        } else {
            FX_ROWLOOP { const int row = row0 + ai * 128 + m * 16; float ss = 0.f; u32x4 w[2];
#pragma unroll
                for (int bj = 0; bj < 2; ++bj) { f32x4 v0 = acc[ai][bj][m][0], v1 = acc[ai][bj][m][1];
                    if (wc < 2) ss += sumsq8(v0, v1);
                    if (wc == 2 && bj == 0) rope8(v0, v1, ropec, ropes, row & (SEQ - 1), fq);
                    w[bj] = pack8(v0, v1); }
                store_lines16(CKVR + (size_t)(row - fr) * 256 + 64 * wc, 256, w[0], w[1], fr, fq);
                ss += __shfl_xor(ss, 16); ss += __shfl_xor(ss, 32);
                if (fq == 0) ssqkv[(size_t)row * 4 + wc] = ss; }
        }
    }
};
struct EpiQ {
    static constexpr int PERM = 1; static constexpr int NST = 16;
    bf16_t* Q; const float* ssqq; const float* ropec; const float* ropes;
    __device__ __forceinline__ void operator()(const f32x4 (&acc)[2][2][4][2], const Unit& u, int wr, int wc, int fr, int fq) const {
        const int pm = u.i0, pn = u.i1, row0 = pm * 256 + wr * 64;
        f32x4 sn = *(const f32x4*)(ssqq + (size_t)(row0 + fr) * 4);
        const int Gw = 8 * pn + 2 * wc; const bool roped = (Gw % 3 == 2) || ((Gw + 1) % 3 == 2);
        f32x4 rcn = {}, rsn_ = {}; if (roped) { rcn = *(const f32x4*)(ropec + ((row0 + fr) & (SEQ - 1)) * 16 + 4 * fq); rsn_ = *(const f32x4*)(ropes + ((row0 + fr) & (SEQ - 1)) * 16 + 4 * fq); }
        FX_ROWLOOP { const int row = row0 + fr + ai * 128 + m * 16; const f32x4 s4 = sn; { const int nx = ai * 4 + m + 1; if (nx < 8) sn = *(const f32x4*)(ssqq + (size_t)(row0 + fr + (nx >> 2) * 128 + (nx & 3) * 16) * 4); }
            const float rs = __builtin_amdgcn_rsqf(((s4[0] + s4[1]) + (s4[2] + s4[3])) * (1.f / 256.f) + RMS_EPS) * QSCALE;
            u32x4 w[2]; const f32x4 rcc = rcn, rsc = rsn_;
            if (roped) { const int nx = ai * 4 + m + 1; if (nx < 8) { const int nrow = row0 + fr + (nx >> 2) * 128 + (nx & 3) * 16; rcn = *(const f32x4*)(ropec + (nrow & (SEQ - 1)) * 16 + 4 * fq); rsn_ = *(const f32x4*)(ropes + (nrow & (SEQ - 1)) * 16 + 4 * fq); } }
#pragma unroll
            for (int bj = 0; bj < 2; ++bj) { const int G = 8 * pn + 2 * wc + bj;
                f32x4 v0 = acc[ai][bj][m][0] * rs, v1 = acc[ai][bj][m][1] * rs;
                if (G % 3 == 2) { const f32x4 a = v0, b = v1;
                    v0 = (f32x4){a[0] * rcc[0] - a[1] * rsc[0], a[0] * rsc[0] + a[1] * rcc[0], a[2] * rcc[1] - a[3] * rsc[1], a[2] * rsc[1] + a[3] * rcc[1]};
                    v1 = (f32x4){b[0] * rcc[2] - b[1] * rsc[2], b[0] * rsc[2] + b[1] * rcc[2], b[2] * rcc[3] - b[3] * rsc[3], b[2] * rsc[3] + b[3] * rcc[3]}; }
                w[bj] = pack8(v0, v1); }
            store_lines16(Q + (size_t)(row0 + ai * 128 + m * 16) * 768 + 256 * pn + 64 * wc, 768, w[0], w[1], fr, fq); }
    }
};
struct EpiKV {
    static constexpr int PERM = 1; static constexpr int NST = 16;
    bf16_t* KV; const float* ssqkv;
    __device__ __forceinline__ void operator()(const f32x4 (&acc)[2][2][4][2], const Unit& u, int wr, int wc, int fr, int fq) const {
        const int pm = u.i0, pn = u.i1, row0 = pm * 256 + wr * 64;
        f32x4 sn = *(const f32x4*)(ssqkv + (size_t)(row0 + fr) * 4);
        FX_ROWLOOP { const f32x4 s4 = sn; { const int nx = ai * 4 + m + 1; if (nx < 8) sn = *(const f32x4*)(ssqkv + (size_t)(row0 + fr + (nx >> 2) * 128 + (nx & 3) * 16) * 4); }
            const float rs = __builtin_amdgcn_rsqf(((s4[0] + s4[1]) + (s4[2] + s4[3])) * (1.f / 128.f) + RMS_EPS);
            store_lines16(KV + (size_t)(row0 + ai * 128 + m * 16) * 1024 + 256 * pn + 64 * wc, 1024, pack8(acc[ai][0][m][0] * rs, acc[ai][0][m][1] * rs), pack8(acc[ai][1][m][0] * rs, acc[ai][1][m][1] * rs), fr, fq); }
    }
};
struct EpiSt {
    static constexpr int PERM = 1; static constexpr int NST = 16;
    bf16_t* S;
    __device__ __forceinline__ void operator()(const f32x4 (&acc)[2][2][4][2], const Unit& u, int wr, int wc, int fr, int fq) const {
        const int g = u.i0, pm = u.i1, row0 = pm * 256 + wr * 64;
        FX_ROWLOOP store_lines16(S + ((size_t)g * UHR + row0 + ai * 128 + m * 16) * 256 + 64 * wc, 256, pack8(acc[ai][0][m][0], acc[ai][0][m][1]), pack8(acc[ai][1][m][0], acc[ai][1][m][1]), fr, fq);
    }
};
struct EpiSsmOut {
    static constexpr int PERM = 1; static constexpr int NST = 16;
    bf16_t* SPRE;
    __device__ __forceinline__ void operator()(const f32x4 (&acc)[2][2][4][2], const Unit& u, int wr, int wc, int fr, int fq) const {
        const int g = u.i0, pm = u.i1, pn = u.i2, row0 = pm * 256 + wr * 64 + fr;
        const int p0 = 8 * (fq & 1);
        FX_ROWLOOP { const int R = row0 + ai * 128 + m * 16;
#pragma unroll
            for (int bj = 0; bj < 2; ++bj) { const int c = 256 * pn + 64 * wc + 32 * bj + 8 * fq, tq = c >> 4;
                f32x4 y0 = acc[ai][bj][m][0], y1 = acc[ai][bj][m][1];
#pragma unroll
                for (int j = 0; j < 4; ++j) { y0[j] = gelu_tanh_f(y0[j]); y1[j] = gelu_tanh_f(y1[j]); }
                *(u32x4*)(SPRE + ((size_t)R * 32 + tq) * SPRE_LD + g * 16 + p0) = pack8(y0, y1); } }
    }
};
struct EpiGlu {
    static constexpr int PERM = 1; static constexpr int NST = 16;
    const bf16_t* SPRE; bf16_t* MIX; const float* bglu;
    __device__ __forceinline__ void operator()(const f32x4 (&acc)[2][2][4][2], const Unit& u, int wr, int wc, int fr, int fq) const {
        const int pm = u.i0, pn = u.i1, row0 = pm * 256 + wr * 64;
        f32x4 b0[2], b1[2];
#pragma unroll
        for (int bj = 0; bj < 2; ++bj) { const int c = 256 * pn + 64 * wc + 32 * bj + 8 * fq; b0[bj] = *(const f32x4*)(bglu + c); b1[bj] = *(const f32x4*)(bglu + c + 4); }
        const int cg = 256 * pn + 64 * wc + 8 * fq;
        u32x4 swn[2] = {*(const u32x4*)(SPRE + (size_t)(row0 + fr) * SPRE_LD + cg), *(const u32x4*)(SPRE + (size_t)(row0 + fr) * SPRE_LD + cg + 32)};
        FX_ROWLOOP { u32x4 w[2]; const u32x4 swc[2] = {swn[0], swn[1]};
            { const int nx = ai * 4 + m + 1; if (nx < 8) { const bf16_t* np = SPRE + (size_t)(row0 + fr + (nx >> 2) * 128 + (nx & 3) * 16) * SPRE_LD + cg; swn[0] = *(const u32x4*)np; swn[1] = *(const u32x4*)(np + 32); } }
#pragma unroll
            for (int bj = 0; bj < 2; ++bj) {
                const u32x4 sw = swc[bj]; f32x4 s0, s1; unpack8(sw, s0, s1);
                f32x4 z0 = acc[ai][bj][m][0] + b0[bj], z1 = acc[ai][bj][m][1] + b1[bj];
#pragma unroll
                for (int j = 0; j < 4; ++j) { z0[j] = s0[j] * fast_sigmoid(z0[j]); z1[j] = s1[j] * fast_sigmoid(z1[j]); }
                w[bj] = pack8(z0, z1); }
            store_lines16(MIX + (size_t)(row0 + ai * 128 + m * 16) * 1024 + 256 * pn + 64 * wc, 1024, w[0], w[1], fr, fq); }
    }
};
struct EpiWo {
    static constexpr int PERM = 1; static constexpr int NST = 16;
    bf16_t* XY;
    __device__ __forceinline__ void operator()(const f32x4 (&acc)[2][2][4][2], const Unit& u, int wr, int wc, int fr, int fq) const {
        const int pm = u.i0, pn = u.i1, row0 = pm * 256 + wr * 64;
        u32x4 xw[2][4][2];
#pragma unroll
        for (int ai = 0; ai < 2; ++ai)
#pragma unroll
            for (int m = 0; m < 4; ++m)
#pragma unroll
                for (int bj = 0; bj < 2; ++bj) xw[ai][m][bj] = *(const u32x4*)(XY + (size_t)(row0 + fr + ai * 128 + m * 16) * 1024 + 256 * pn + wc * 64 + bj * 32 + 8 * fq);
        asm volatile("s_waitcnt vmcnt(0)" ::: "memory");
        FX_ROWLOOP { u32x4 w[2];
#pragma unroll
            for (int bj = 0; bj < 2; ++bj) { f32x4 x0, x1; unpack8(xw[ai][m][bj], x0, x1); w[bj] = pack8(x0 * ALPHA + acc[ai][bj][m][0], x1 * ALPHA + acc[ai][bj][m][1]); }
            store_lines16(XY + (size_t)(row0 + ai * 128 + m * 16) * 1024 + 256 * pn + 64 * wc, 1024, w[0], w[1], fr, fq); }
    }
};
__device__ __forceinline__ size_t h_off(int row, int col) { return (size_t)(row >> 4) * 4096 + (size_t)(row & 7) * 512 + (size_t)(col >> 5) * 64 + (size_t)((row >> 3) & 1) * 32 + (size_t)(col & 31); }
struct EpiSharedRouter {
    static constexpr int PERM = 1; static constexpr int NST = 0;
    bf16_t* HS; float* LG;
    __device__ __forceinline__ void operator()(const f32x4 (&acc)[2][2][4][2], const Unit& u, int wr, int wc, int fr, int fq) const {
        const int pm = u.i0, pn = u.i1, row0 = pm * 256 + wr * 64 + fr;
        if (pn < 2) {
            const int c = 128 * pn + 32 * wc + 8 * fq;
            FX_ROWLOOP { f32x4 h0, h1;
#pragma unroll
                for (int j = 0; j < 4; ++j) { const float g0 = acc[ai][0][m][0][j], g1 = acc[ai][0][m][1][j];
                    h0[j] = g0 * fast_sigmoid(g0) * acc[ai][1][m][0][j]; h1[j] = g1 * fast_sigmoid(g1) * acc[ai][1][m][1][j]; }
                *(u32x4*)(HS + h_off(row0 + ai * 128 + m * 16, c)) = pack8(h0, h1); }
        } else if (wc == 0) {
            FX_ROWLOOP { float* rp = LG + (size_t)(row0 + ai * 128 + m * 16) * 64 + 8 * fq;
#pragma unroll
                for (int bj = 0; bj < 2; ++bj) { *(f32x4*)(rp + bj * 32) = acc[ai][bj][m][0]; *(f32x4*)(rp + bj * 32 + 4) = acc[ai][bj][m][1]; } }
        }
    }
};

struct MoeTab { LAS int* tbase; LAS unsigned* tab; };
__device__ __forceinline__ MoeTab moe_tab(LAS unsigned char* lds) { MoeTab t; t.tbase = (LAS int*)(lds + TAB_OFF); t.tab = (LAS unsigned*)(lds + TAB_OFF + 2304); return t; }
__device__ __forceinline__ int ve_count(const unsigned* ctl, int ve) { return (ve % 65 == 64) ? CAPC : (int)__hip_atomic_load(ctl + CW_CNT + 64 * ve, __ATOMIC_RELAXED, __HIP_MEMORY_SCOPE_AGENT); }
__device__ __forceinline__ void moe_build_tab(LAS unsigned char* lds, const unsigned* ctl) {
    const MoeTab t = moe_tab(lds); LAS int* nt = (LAS int*)(lds + TAB_OFF + 1024 + 64);
    const int tid = threadIdx.x;
    if (tid < NVE) nt[tid] = (ve_count(ctl, tid) + 255) >> 8;
    __syncthreads();
    if (tid <= NVE) { int s = 0; for (int v = 0; v < tid; ++v) s += nt[v]; t.tbase[tid] = s; }
    __syncthreads();
    for (int v = tid; v < NVE; v += 512) { const int b = t.tbase[v], n = t.tbase[v + 1] - b; for (int j = 0; j < n; ++j) t.tab[b + j] = (unsigned)v | ((unsigned)j << 16); }
    __syncthreads();
}
struct GateUpOrder {
    const char* X1B; const char* WGU; MoeTab tb; LAS int* idx; int nunits, G, c;
    __device__ __forceinline__ int tile_of(int tr) const {
        int tile = 0;
#pragma unroll
        for (int ch = 0; ch < NCH; ++ch) { const int b = tb.tbase[ch * 65], n = tb.tbase[ch * 65 + 64] - b; if (tr >= 0 && tr < n) tile = b + tr; tr -= n; }
        return tile;
    }
    __device__ __forceinline__ void init(LAS unsigned char* lds, const void* x1b, const void* wgu, const int* rowtok, const unsigned* ctl, int G_, int c_) {
        X1B = (const char*)x1b; WGU = (const char*)wgu; tb = moe_tab(lds); idx = (LAS int*)(lds + IDX_OFF); G = G_; c = c_;
        int nr = 0;
#pragma unroll
        for (int ch = 0; ch < NCH; ++ch) nr += tb.tbase[ch * 65 + 64] - tb.tbase[ch * 65];
        nunits = 2 * nr;
        __syncthreads();
        int vals[IDX_UNITS / 2];
#pragma unroll
        for (int i2 = 0; i2 < IDX_UNITS / 2; ++i2) { const int i = 2 * i2 + (int)(threadIdx.x >> 8); const long L = (long)i * G + c; vals[i2] = 0;
            if (L < nunits) { const int tile = tile_of(xcd_remap((int)L, nunits) >> 1); const unsigned e = tb.tab[tile]; const int ve = (int)(e & 0xffffu), tix = (int)(e >> 16), ch = ve / 65, ex = ve % 65;
                const int cnt = ve_count(ctl, ve), slot = tix * 256 + (int)(threadIdx.x & 255);
                vals[i2] = slot < cnt ? rowtok[(size_t)(ch * 64 + ex) * CAPC + slot] : ch * CAPC; } }
#pragma unroll
        for (int i2 = 0; i2 < IDX_UNITS / 2; ++i2) idx[(2 * i2 + (int)(threadIdx.x >> 8)) * 256 + (threadIdx.x & 255)] = vals[i2];
        __syncthreads();
    }
    __device__ __forceinline__ bool next(int i, Unit& u) const {
        const long L = (long)i * G + c; if (L >= nunits) return false;
        const int wgid = xcd_remap((int)L, nunits), tile = tile_of(wgid >> 1), pn = wgid & 1;
        const int ex = (int)(tb.tab[tile] & 0xffffu) % 65;
        u.A = X1B; u.B = WGU + ((size_t)ex * 512 + (size_t)pn * 256) * 1024 * 2; u.i0 = tile * 256; u.i1 = pn; u.i2 = 0; u.i3 = i < IDX_UNITS ? i : IDX_UNITS - 1; return true;
    }
    __device__ __forceinline__ void gather(const Unit& u, int R0, int C0, int R1, int C1, unsigned& g00, unsigned& g01, unsigned& g10, unsigned& g11) const {
        const LAS int* ip = idx + u.i3 * 256;
        g00 = (unsigned)ip[R0] * 2048u + (unsigned)C0 * 2u; g01 = (unsigned)ip[R1] * 2048u + (unsigned)C1 * 2u;
        g10 = (unsigned)ip[128 + R0] * 2048u + (unsigned)C0 * 2u; g11 = (unsigned)ip[128 + R1] * 2048u + (unsigned)C1 * 2u;
    }
};
struct EpiGateUp {
    static constexpr int PERM = 1; static constexpr int NST = 8;
    bf16_t* H;
    __device__ __forceinline__ void operator()(const f32x4 (&acc)[2][2][4][2], const Unit& u, int wr, int wc, int fr, int fq) const {
        const int hrow0 = u.i0 + wr * 64 + fr, c = 128 * u.i1 + 32 * wc + 8 * fq;
        FX_ROWLOOP { f32x4 h0, h1;
#pragma unroll
            for (int j = 0; j < 4; ++j) { const float g0 = acc[ai][0][m][0][j], g1 = acc[ai][0][m][1][j];
                h0[j] = g0 * fast_sigmoid(g0) * acc[ai][1][m][0][j]; h1[j] = g1 * fast_sigmoid(g1) * acc[ai][1][m][1][j]; }
            *(u32x4*)(H + h_off(hrow0 + ai * 128 + m * 16, c)) = pack8(h0, h1); }
    }
};
struct DownOrder {
    const char* Hh; const char* HS; const char* WD; MoeTab tb; int t0, nunits, G, c, chn;
    __device__ __forceinline__ void init(const void* h, const void* hs, const void* wd, MoeTab tb_, int ch, int G_, int c_) { Hh = (const char*)h; HS = (const char*)hs; WD = (const char*)wd; tb = tb_; chn = ch; t0 = tb_.tbase[ch * 65]; nunits = 4 * (tb_.tbase[(ch + 1) * 65] - t0); G = G_; c = c_; }
    __device__ __forceinline__ bool next(int i, Unit& u) const {
        const long L = (long)i * G + c; if (L >= nunits) return false;
        const int wgid = xcd_remap((int)L, nunits), tile = t0 + (wgid >> 2), pn = wgid & 3;
        const int ex = (int)(tb.tab[tile] & 0xffffu) % 65;
        u.A = ex == 64 ? HS + ((size_t)chn * CAPC + (size_t)(tb.tab[tile] >> 16) * 256) * 256 * 2 : Hh + (size_t)tile * 256 * 256 * 2; u.B = WD + ((size_t)ex * 1024 + (size_t)pn * 256) * 256 * 2; u.i0 = ex == 64 ? (int)(tb.tab[tile] >> 16) * 256 : (tile - t0) * 256; u.i1 = pn; u.i2 = ex == 64; u.i3 = 0; return true;
    }
};
constexpr float Y8_SCALE = 16.f, Y8_INV = 1.f / 16.f;
__device__ __forceinline__ u32x2 pack8_fp8(const f32x4 a, const f32x4 b) {
    int w0 = 0, w1 = 0;
    w0 = __builtin_amdgcn_cvt_pk_fp8_f32(a[0] * Y8_SCALE, a[1] * Y8_SCALE, w0, false); w0 = __builtin_amdgcn_cvt_pk_fp8_f32(a[2] * Y8_SCALE, a[3] * Y8_SCALE, w0, true);
    w1 = __builtin_amdgcn_cvt_pk_fp8_f32(b[0] * Y8_SCALE, b[1] * Y8_SCALE, w1, false); w1 = __builtin_amdgcn_cvt_pk_fp8_f32(b[2] * Y8_SCALE, b[3] * Y8_SCALE, w1, true);
    u32x2 r; r.x = (unsigned)w0; r.y = (unsigned)w1; return r;
}
__device__ __forceinline__ void unpack8_fp8(const u32x2 w, f32x4& a, f32x4& b) {
    const f32x2 p0 = __builtin_amdgcn_cvt_pk_f32_fp8((int)w.x, false), p1 = __builtin_amdgcn_cvt_pk_f32_fp8((int)w.x, true);
    const f32x2 p2 = __builtin_amdgcn_cvt_pk_f32_fp8((int)w.y, false), p3 = __builtin_amdgcn_cvt_pk_f32_fp8((int)w.y, true);
    a = (f32x4){p0.x, p0.y, p1.x, p1.y}; b = (f32x4){p2.x, p2.y, p3.x, p3.y};
}
__device__ __forceinline__ size_t y8_off(int row, int col) { return (size_t)row * 1024 + (size_t)col; }
template <int STORE = 1> struct EpiDownT {
    static constexpr int PERM = 2; static constexpr int NST = 8;
    unsigned char* Y8; bf16_t* YS; LAS unsigned char* lds;
    __device__ __forceinline__ void operator()(const f32x4 (&acc)[2][2][4][2], const Unit& u, int wr, int wc, int fr, int fq) const {
        const int yrow0 = u.i0 + wr * 64, c0 = 256 * u.i1 + 64 * wc + 16 * fq;
        unsigned char* base = u.i2 ? (unsigned char*)YS : Y8;
        FX_ROWLOOP { unsigned char* rp = base + y8_off(yrow0 + ai * 128 + m * 16 + fr, c0);
            const u32x2 lo = pack8_fp8(acc[ai][0][m][0], acc[ai][0][m][1]), hi = pack8_fp8(acc[ai][1][m][0], acc[ai][1][m][1]);
            u32x4 w; w.x = lo.x; w.y = lo.y; w.z = hi.x; w.w = hi.y; *(u32x4*)rp = w; }
    }
};
typedef EpiDownT<1> EpiDown;
}
namespace fx {
namespace att {
constexpr int NW = 8, QBLK = 32, KVBLK = 64;
constexpr int SHM_V = 16384, SHM_K = 16384;
constexpr float THRL = 8.f;
#define KSWZ(row, colB) ((row) * 256 + ((colB) ^ (((row) & 7) << 4)))
#define SBAR() __builtin_amdgcn_sched_barrier(0)
__device__ __forceinline__ int crow(int r, int hi) { return (r & 3) + 8 * (r >> 2) + 4 * hi; }
__device__ __forceinline__ float bf16_round(float x) { return __uint_as_float(cvt_pk_bf16(x, 0.f) << 16); }
template <bool FIRST, bool EXPS = true> __device__ __forceinline__ void partialSM(f32x16& p0, f32x16& p1, float& m_reg, float& alpha, bf16x8& qm, int hi) {
  float mx0 = fmaxf(p0[0], p0[1]), mx1 = fmaxf(p0[8], p0[9]), mx2 = fmaxf(p1[0], p1[1]), mx3 = fmaxf(p1[8], p1[9]);
#pragma unroll
  for (int r = 2; r < 8; ++r) { mx0 = fmaxf(mx0, p0[r]); mx1 = fmaxf(mx1, p0[8 + r]); mx2 = fmaxf(mx2, p1[r]); mx3 = fmaxf(mx3, p1[8 + r]); }
  float pmax = fmaxf(fmaxf(mx0, mx1), fmaxf(mx2, mx3));
  { auto rr = __builtin_amdgcn_permlane32_swap(__float_as_uint(pmax), __float_as_uint(pmax), false, false);
    pmax = fmaxf(__uint_as_float(rr[0]), __uint_as_float(rr[1])); }
  if (!FIRST && __builtin_expect(__all(pmax <= THRL), 1)) { alpha = 1.f; }
  else {
    const float mnew = bf16_round(FIRST ? pmax : m_reg + fmaxf(pmax, 0.f)), delta = mnew - m_reg;
    alpha = FIRST ? 1.f : __builtin_amdgcn_exp2f(-delta); m_reg = mnew;
    qm[0] = hi == 0 ? (short)(cvt_pk_bf16(-mnew, 0.f) & 0xffffu) : (short)0;
#pragma unroll
    for (int r = 0; r < 16; ++r) p0[r] = p0[r] - delta;
#pragma unroll
    for (int r = 0; r < 16; ++r) p1[r] = p1[r] - delta;
  }
  if (EXPS) {
#pragma unroll
    for (int r = 0; r < 16; ++r) p0[r] = __builtin_amdgcn_exp2f(p0[r]);
  }
}
__device__ __forceinline__ void finishSM(f32x16& p0, f32x16& p1, float alpha, float& l_reg, bf16x8& pa0, bf16x8& pa1, bf16x8& pa2, bf16x8& pa3) {
#pragma unroll
  for (int r = 0; r < 16; ++r) p1[r] = __builtin_amdgcn_exp2f(p1[r]);
  float ps0 = p0[0], ps1 = p0[8], ps2 = p1[0], ps3 = p1[8];
#pragma unroll
  for (int r = 1; r < 8; ++r) { ps0 += p0[r]; ps1 += p0[8 + r]; ps2 += p1[r]; ps3 += p1[8 + r]; }
  float ps = (ps0 + ps1) + (ps2 + ps3);
  { auto rr = __builtin_amdgcn_permlane32_swap(__float_as_uint(ps), __float_as_uint(ps), false, false);
    ps = __uint_as_float(rr[0]) + __uint_as_float(rr[1]); }
  l_reg = l_reg * alpha + ps;
#define PK4(P, BASE, OUT) do { u32x4 w = {cvt_pk_bf16(P[BASE + 0], P[BASE + 1]), cvt_pk_bf16(P[BASE + 2], P[BASE + 3]), cvt_pk_bf16(P[BASE + 4], P[BASE + 5]), cvt_pk_bf16(P[BASE + 6], P[BASE + 7])}; \
    OUT = *reinterpret_cast<bf16x8*>(&w); } while (0)
  PK4(p0, 0, pa0); PK4(p0, 8, pa1); PK4(p1, 0, pa2); PK4(p1, 8, pa3);
#undef PK4
}
__device__ __forceinline__ void qkt(f32x16& p0, f32x16& p1, const char* Ks, const bf16x8 (&qr)[6], const bf16x8 kone, const bf16x8 qm, int r32, int hi) {
  p0 = f32x16{}; p1 = f32x16{};
#pragma unroll
  for (int d0 = 0; d0 < 6; ++d0) { const int cb = (d0 * 16 + hi * 8) * 2;
    const bf16x8 b0 = *reinterpret_cast<const bf16x8*>(Ks + KSWZ(r32, cb));
    const bf16x8 b1 = *reinterpret_cast<const bf16x8*>(Ks + KSWZ(32 + r32, cb));
    p0 = __builtin_amdgcn_mfma_f32_32x32x16_bf16(b0, qr[d0], p0, 0, 0, 0);
    p1 = __builtin_amdgcn_mfma_f32_32x32x16_bf16(b1, qr[d0], p1, 0, 0, 0); }
  p0 = __builtin_amdgcn_mfma_f32_32x32x16_bf16(kone, qm, p0, 0, 0, 0);
  p1 = __builtin_amdgcn_mfma_f32_32x32x16_bf16(kone, qm, p1, 0, 0, 0);
}
__device__ __forceinline__ int v_st(int k, int c) { const int kk = k; return ((kk >> 3) * 4 + (c >> 5)) * 512 + ((kk & 7) * 32 + (c & 31)) * 2; }
__device__ __forceinline__ int v_rd_base(int lane) { return ((lane & 3) << 3) | (((lane >> 2) & 3) << 6) | (((lane >> 4) & 1) << 5) | (((lane >> 5) & 1) << 8); }
constexpr int v_rd_off(int d0, int ks, int half) { return d0 * 512 + ks * 4096 + half * 2048; }
template <int OFF> __device__ __forceinline__ s16x4 tr_read(int vb) {
  s16x4 r; asm volatile("ds_read_b64_tr_b16 %0, %1 offset:%2" : "=&v"(r) : "v"(vb), "i"(OFF) : "memory"); return r;
}
template <int D0> __device__ __forceinline__ void pv_one(f32x16& od, int vb, bf16x8 pa0, bf16x8 pa1, bf16x8 pa2, bf16x8 pa3) {
  const s16x4 l0 = tr_read<v_rd_off(D0, 0, 0)>(vb), h0 = tr_read<v_rd_off(D0, 0, 1)>(vb), l1 = tr_read<v_rd_off(D0, 1, 0)>(vb), h1 = tr_read<v_rd_off(D0, 1, 1)>(vb);
  const s16x4 l2 = tr_read<v_rd_off(D0, 2, 0)>(vb), h2 = tr_read<v_rd_off(D0, 2, 1)>(vb), l3 = tr_read<v_rd_off(D0, 3, 0)>(vb), h3 = tr_read<v_rd_off(D0, 3, 1)>(vb);
  asm volatile("s_waitcnt lgkmcnt(0)" ::: "memory"); SBAR();
#define PK(L, H) (bf16x8){L[0], L[1], L[2], L[3], H[0], H[1], H[2], H[3]}
  od = __builtin_amdgcn_mfma_f32_32x32x16_bf16(pa0, PK(l0, h0), od, 0, 0, 0);
  od = __builtin_amdgcn_mfma_f32_32x32x16_bf16(pa1, PK(l1, h1), od, 0, 0, 0);
  od = __builtin_amdgcn_mfma_f32_32x32x16_bf16(pa2, PK(l2, h2), od, 0, 0, 0);
  od = __builtin_amdgcn_mfma_f32_32x32x16_bf16(pa3, PK(l3, h3), od, 0, 0, 0);
#undef PK
}
__device__ __forceinline__ void pv_d0(f32x16 (&o)[2], int vb, bf16x8 pa0, bf16x8 pa1, bf16x8 pa2, bf16x8 pa3) {
  pv_one<0>(o[0], vb, pa0, pa1, pa2, pa3); pv_one<1>(o[1], vb, pa0, pa1, pa2, pa3);
}
__device__ __forceinline__ void pv_sm(f32x16 (&o)[2], int vb, bf16x8 pa0, bf16x8 pa1, bf16x8 pa2, bf16x8 pa3, f32x16& pc0, f32x16& pc1, float& m_reg, float& alpha, bf16x8& qm, int hi) {
#define PK(L, H) (bf16x8){L[0], L[1], L[2], L[3], H[0], H[1], H[2], H[3]}
#define EX(r) do { float e_ = __builtin_amdgcn_exp2f(pc0[r]); asm volatile("" : "+v"(e_)); pc0[r] = e_; } while (0)
  const s16x4 l0 = tr_read<v_rd_off(0, 0, 0)>(vb), h0 = tr_read<v_rd_off(0, 0, 1)>(vb), l1 = tr_read<v_rd_off(0, 1, 0)>(vb), h1 = tr_read<v_rd_off(0, 1, 1)>(vb);
  const s16x4 l2 = tr_read<v_rd_off(0, 2, 0)>(vb), h2 = tr_read<v_rd_off(0, 2, 1)>(vb), l3 = tr_read<v_rd_off(0, 3, 0)>(vb), h3 = tr_read<v_rd_off(0, 3, 1)>(vb);
  SBAR();
  partialSM<false, false>(pc0, pc1, m_reg, alpha, qm, hi);
  SBAR();
  EX(0); EX(1);
  asm volatile("s_waitcnt lgkmcnt(0)" ::: "memory"); SBAR();
  o[0] = __builtin_amdgcn_mfma_f32_32x32x16_bf16(pa0, PK(l0, h0), o[0], 0, 0, 0); SBAR();
  const s16x4 m0 = tr_read<v_rd_off(1, 0, 0)>(vb), n0 = tr_read<v_rd_off(1, 0, 1)>(vb), m1 = tr_read<v_rd_off(1, 1, 0)>(vb), n1 = tr_read<v_rd_off(1, 1, 1)>(vb);
  const s16x4 m2 = tr_read<v_rd_off(1, 2, 0)>(vb), n2 = tr_read<v_rd_off(1, 2, 1)>(vb), m3 = tr_read<v_rd_off(1, 3, 0)>(vb), n3 = tr_read<v_rd_off(1, 3, 1)>(vb);
  EX(2); EX(3); SBAR();
  o[0] = __builtin_amdgcn_mfma_f32_32x32x16_bf16(pa1, PK(l1, h1), o[0], 0, 0, 0); SBAR();
  EX(4); EX(5); SBAR();
  o[0] = __builtin_amdgcn_mfma_f32_32x32x16_bf16(pa2, PK(l2, h2), o[0], 0, 0, 0); SBAR();
  EX(6); EX(7); SBAR();
  o[0] = __builtin_amdgcn_mfma_f32_32x32x16_bf16(pa3, PK(l3, h3), o[0], 0, 0, 0); SBAR();
  EX(8); EX(9);
  asm volatile("s_waitcnt lgkmcnt(0)" ::: "memory"); SBAR();
  o[1] = __builtin_amdgcn_mfma_f32_32x32x16_bf16(pa0, PK(m0, n0), o[1], 0, 0, 0); SBAR();
  EX(10); EX(11); SBAR();
  o[1] = __builtin_amdgcn_mfma_f32_32x32x16_bf16(pa1, PK(m1, n1), o[1], 0, 0, 0); SBAR();
  EX(12); EX(13); SBAR();
  o[1] = __builtin_amdgcn_mfma_f32_32x32x16_bf16(pa2, PK(m2, n2), o[1], 0, 0, 0); SBAR();
  EX(14); EX(15); SBAR();
  o[1] = __builtin_amdgcn_mfma_f32_32x32x16_bf16(pa3, PK(m3, n3), o[1], 0, 0, 0); SBAR();
#undef EX
#undef PK
}
#define PIN(x) asm volatile("" : "+v"(x))
#define MF(acc, a, b) acc = __builtin_amdgcn_mfma_f32_32x32x16_bf16(a, b, acc, 0, 0, 0)
__device__ __forceinline__ float max3f(float a, float b, float c) { float d; asm volatile("v_max3_f32 %0, %1, %2, %3" : "=v"(d) : "v"(a), "v"(b), "v"(c)); return d; }
__device__ __forceinline__ void qk_fsm(f32x16& pc0, f32x16& pc1, const char* Ks, const bf16x8 (&qr)[6], const bf16x8 kone, const bf16x8 qm, int r32, int hi,
                                       f32x16& pp0, f32x16& pp1, float alpha, float& l_reg, bf16x8& pa0, bf16x8& pa1, bf16x8& pa2, bf16x8& pa3) {
#define LDK(d0, half) (*reinterpret_cast<const bf16x8*>(Ks + KSWZ((half) * 32 + r32, ((d0) * 16 + hi * 8) * 2)))
#define E1(r) do { float e_ = __builtin_amdgcn_exp2f(pp1[r]); PIN(e_); pp1[r] = e_; } while (0)
#define AD(sv, v) do { sv += (v); PIN(sv); } while (0)
  const bf16x8 ka0 = LDK(0, 0), kb0 = LDK(0, 1), ka1 = LDK(1, 0), kb1 = LDK(1, 1);
  pc0 = f32x16{}; pc1 = f32x16{};
  float s0 = pp0[0], s1 = pp0[8], s2, s3; u32x4 w0, w1, w2, w3;
  SBAR(); MF(pc0, ka0, qr[0]); SBAR();
  const bf16x8 ka2 = LDK(2, 0), kb2 = LDK(2, 1); E1(0); E1(1); AD(s0, pp0[1]); AD(s1, pp0[9]);
  SBAR(); MF(pc1, kb0, qr[0]); SBAR();
  E1(2); E1(3); AD(s0, pp0[2]); AD(s1, pp0[10]);
  SBAR(); MF(pc0, ka1, qr[1]); SBAR();
  const bf16x8 ka3 = LDK(3, 0), kb3 = LDK(3, 1); E1(4); E1(5); AD(s0, pp0[3]); AD(s1, pp0[11]);
  SBAR(); MF(pc1, kb1, qr[1]); SBAR();
  E1(6); E1(7); AD(s0, pp0[4]); AD(s1, pp0[12]);
  SBAR(); MF(pc0, ka2, qr[2]); SBAR();
  const bf16x8 ka4 = LDK(4, 0), kb4 = LDK(4, 1); E1(8); E1(9); AD(s0, pp0[5]); AD(s1, pp0[13]);
  SBAR(); MF(pc1, kb2, qr[2]); SBAR();
  E1(10); E1(11); AD(s0, pp0[6]); AD(s1, pp0[14]);
  SBAR(); MF(pc0, ka3, qr[3]); SBAR();
  const bf16x8 ka5 = LDK(5, 0), kb5 = LDK(5, 1); E1(12); E1(13); AD(s0, pp0[7]); AD(s1, pp0[15]);
  SBAR(); MF(pc1, kb3, qr[3]); SBAR();
  E1(14); E1(15); w0[0] = cvt_pk_bf16(pp0[0], pp0[1]); w0[1] = cvt_pk_bf16(pp0[2], pp0[3]);
  SBAR(); MF(pc0, ka4, qr[4]); SBAR();
  s2 = pp1[0] + pp1[1]; PIN(s2); AD(s2, pp1[2]); AD(s2, pp1[3]); w0[2] = cvt_pk_bf16(pp0[4], pp0[5]); w0[3] = cvt_pk_bf16(pp0[6], pp0[7]);
  SBAR(); MF(pc1, kb4, qr[4]); SBAR();
  AD(s2, pp1[4]); AD(s2, pp1[5]); AD(s2, pp1[6]); AD(s2, pp1[7]); w1[0] = cvt_pk_bf16(pp0[8], pp0[9]); w1[1] = cvt_pk_bf16(pp0[10], pp0[11]);
  SBAR(); MF(pc0, ka5, qr[5]); SBAR();
  s3 = pp1[8] + pp1[9]; PIN(s3); AD(s3, pp1[10]); AD(s3, pp1[11]); AD(s3, pp1[12]); w1[2] = cvt_pk_bf16(pp0[12], pp0[13]); w1[3] = cvt_pk_bf16(pp0[14], pp0[15]);
  SBAR(); MF(pc1, kb5, qr[5]); SBAR();
  AD(s3, pp1[13]); AD(s3, pp1[14]); AD(s3, pp1[15]); w2[0] = cvt_pk_bf16(pp1[0], pp1[1]); w2[1] = cvt_pk_bf16(pp1[2], pp1[3]); w2[2] = cvt_pk_bf16(pp1[4], pp1[5]);
  SBAR(); MF(pc0, kone, qm); SBAR();
  AD(s0, s1); AD(s2, s3); AD(s0, s2); w2[3] = cvt_pk_bf16(pp1[6], pp1[7]); w3[0] = cvt_pk_bf16(pp1[8], pp1[9]); w3[1] = cvt_pk_bf16(pp1[10], pp1[11]);
  SBAR(); MF(pc1, kone, qm); SBAR();
  { auto rr = __builtin_amdgcn_permlane32_swap(__float_as_uint(s0), __float_as_uint(s0), false, false);
    l_reg = l_reg * alpha + (__uint_as_float(rr[0]) + __uint_as_float(rr[1])); }
  w3[2] = cvt_pk_bf16(pp1[12], pp1[13]); w3[3] = cvt_pk_bf16(pp1[14], pp1[15]);
  pa0 = *reinterpret_cast<bf16x8*>(&w0); pa1 = *reinterpret_cast<bf16x8*>(&w1); pa2 = *reinterpret_cast<bf16x8*>(&w2); pa3 = *reinterpret_cast<bf16x8*>(&w3);
  SBAR();
#undef LDK
#undef E1
#undef AD
}
struct VFrag { s16x4 l0, h0, l1, h1, l2, h2, l3, h3; };
__device__ __forceinline__ void pv_reads(VFrag& f, int vb) {
  f.l0 = tr_read<v_rd_off(0, 0, 0)>(vb); f.h0 = tr_read<v_rd_off(0, 0, 1)>(vb); f.l1 = tr_read<v_rd_off(0, 1, 0)>(vb); f.h1 = tr_read<v_rd_off(0, 1, 1)>(vb);
  f.l2 = tr_read<v_rd_off(0, 2, 0)>(vb); f.h2 = tr_read<v_rd_off(0, 2, 1)>(vb); f.l3 = tr_read<v_rd_off(0, 3, 0)>(vb); f.h3 = tr_read<v_rd_off(0, 3, 1)>(vb);
}
__device__ __forceinline__ void pv_sm2(f32x16 (&o)[2], const VFrag& f, int vb, bf16x8 pa0, bf16x8 pa1, bf16x8 pa2, bf16x8 pa3, f32x16& pc0, f32x16& pc1, float& m_reg, float& alpha, bf16x8& qm, int hi) {
#define PK(L, H) (bf16x8){L[0], L[1], L[2], L[3], H[0], H[1], H[2], H[3]}
#define EX(r) do { float e_ = __builtin_amdgcn_exp2f(pc0[r]); PIN(e_); pc0[r] = e_; } while (0)
  float mx3 = fmaxf(pc1[14], pc1[15]); PIN(mx3);
  float mx0 = max3f(pc0[0], pc0[1], pc0[2]), mx1 = max3f(pc0[8], pc0[9], pc0[10]), mx2 = max3f(pc1[0], pc1[1], pc1[2]);
  mx3 = max3f(mx3, pc1[8], pc1[9]);
  mx0 = max3f(mx0, pc0[3], pc0[4]); mx1 = max3f(mx1, pc0[11], pc0[12]);
  asm volatile("s_waitcnt lgkmcnt(0)" ::: "memory");
  SBAR(); MF(o[0], pa0, PK(f.l0, f.h0)); SBAR();
  const s16x4 m0 = tr_read<v_rd_off(1, 0, 0)>(vb), n0 = tr_read<v_rd_off(1, 0, 1)>(vb), m1 = tr_read<v_rd_off(1, 1, 0)>(vb), n1 = tr_read<v_rd_off(1, 1, 1)>(vb);
  mx2 = max3f(mx2, pc1[3], pc1[4]); mx3 = max3f(mx3, pc1[10], pc1[11]);
  SBAR(); MF(o[0], pa1, PK(f.l1, f.h1)); SBAR();
  const s16x4 m2 = tr_read<v_rd_off(1, 2, 0)>(vb), n2 = tr_read<v_rd_off(1, 2, 1)>(vb), m3 = tr_read<v_rd_off(1, 3, 0)>(vb), n3 = tr_read<v_rd_off(1, 3, 1)>(vb);
  mx0 = max3f(mx0, pc0[5], pc0[6]); mx1 = max3f(mx1, pc0[13], pc0[14]);
  SBAR(); MF(o[0], pa2, PK(f.l2, f.h2)); SBAR();
  mx2 = max3f(mx2, pc1[5], pc1[6]); mx3 = max3f(mx3, pc1[12], pc1[13]); mx0 = max3f(mx0, pc0[7], pc0[15]); mx2 = max3f(mx2, pc1[7], mx3); mx0 = max3f(mx0, mx1, mx2);
  float pmax;
  { auto rr = __builtin_amdgcn_permlane32_swap(__float_as_uint(mx0), __float_as_uint(mx0), false, false);
    pmax = fmaxf(__uint_as_float(rr[0]), __uint_as_float(rr[1])); }
  SBAR(); MF(o[0], pa3, PK(f.l3, f.h3)); SBAR();
  if (__builtin_expect(__all(pmax <= THRL), 1)) { alpha = 1.f; }
  else {
    const float mnew = bf16_round(m_reg + fmaxf(pmax, 0.f)), delta = mnew - m_reg;
    alpha = __builtin_amdgcn_exp2f(-delta); m_reg = mnew;
    qm[0] = hi == 0 ? (short)(cvt_pk_bf16(-mnew, 0.f) & 0xffffu) : (short)0;
#pragma unroll
    for (int r = 0; r < 16; ++r) pc0[r] = pc0[r] - delta;
#pragma unroll
    for (int r = 0; r < 16; ++r) pc1[r] = pc1[r] - delta;
  }
  SBAR();
  EX(0); EX(1); EX(2);
  asm volatile("s_waitcnt lgkmcnt(0)" ::: "memory");
  SBAR(); MF(o[1], pa0, PK(m0, n0)); SBAR();
  EX(3); EX(4); EX(5);
  SBAR(); MF(o[1], pa1, PK(m1, n1)); SBAR();
  EX(6); EX(7); EX(8);
  SBAR(); MF(o[1], pa2, PK(m2, n2)); SBAR();
  EX(9); EX(10); EX(11);
  SBAR(); MF(o[1], pa3, PK(m3, n3)); SBAR();
  EX(12); EX(13); EX(14); EX(15);
  SBAR();
#undef EX
#undef PK
}
struct AttPre { bf16x8 qr[6]; bf16x8 k0a, k0b, v0, k1a, k1b, v1; };
#define ATT_OFFS(TOK0, H, KOFA, KOFB, VOFS) \
  const unsigned KOFA = (unsigned)WS_KV + (unsigned)((((TOK0) + (tid >> 3)) * 1024 + (H) * 128 + (tid & 7) * 8) * 2); \
  const unsigned KOFB = (unsigned)WS_CKVR + (unsigned)((((TOK0) + ((tid & 255) >> 2)) * 256 + 128 + (tid & 3) * 8) * 2); \
  const unsigned VOFS = (unsigned)WS_KV + (unsigned)((((TOK0) + (tid >> 3)) * 1024 + (H) * 128 + 64 + (tid & 7) * 8) * 2)
#define ATT_TLOADX(KA, KB, VV, t, KOFA, KOFB, VOFS) do { KA = *reinterpret_cast<const bf16x8*>(wsb + (unsigned)((KOFA) + (unsigned)(t) * (64u * 2048u))); \
    if (two) KB = *reinterpret_cast<const bf16x8*>(wsb + (unsigned)((KOFB) + (unsigned)(t) * (64u * 512u))); \
    VV = *reinterpret_cast<const bf16x8*>(wsb + (unsigned)((VOFS) + (unsigned)(t) * (64u * 2048u))); } while (0)
#define ATT_QLOAD(QR, TOK0, QROW0, H) do { const bf16_t* Qw_ = Q + (size_t)((TOK0) + (QROW0) + wid * QBLK + r32) * 768 + (H) * 96 + hi * 8; \
    _Pragma("unroll") for (int d0 = 0; d0 < 6; ++d0) QR[d0] = *reinterpret_cast<const bf16x8*>(Qw_ + d0 * 16); } while (0)
__device__ __forceinline__ void attn_prefetch(AttPre& ap, const unsigned char* __restrict__ wsb, const bf16_t* __restrict__ Q, int tok0, int qrow0, int h) {
  int tid = threadIdx.x; asm volatile("" : "+v"(tid));
  const int wid = __builtin_amdgcn_readfirstlane(tid >> 6), lane = tid & 63, r32 = lane & 31, hi = lane >> 5; const bool two = wid < 4;
  ATT_OFFS(tok0, h, kofa, kofb, vofs);
  ATT_QLOAD(ap.qr, tok0, qrow0, h);
  ATT_TLOADX(ap.k0a, ap.k0b, ap.v0, 0, kofa, kofb, vofs); ATT_TLOADX(ap.k1a, ap.k1b, ap.v1, 1, kofa, kofb, vofs);
}
__device__ __forceinline__ void attn_unit(const unsigned char* __restrict__ wsb, const bf16_t* __restrict__ Q, bf16_t* __restrict__ MIX, int tok0, int qrow0, int h, char* lds,
                                          AttPre& ap, bool has_next, int ntok0, int nqrow0, int nh) {
  int tid = threadIdx.x; asm volatile("" : "+v"(tid));
  const int wid = __builtin_amdgcn_readfirstlane(tid >> 6), lane = tid & 63, r32 = lane & 31, hi = lane >> 5;
  char* K_lds = lds; char* V_lds = lds + 4 * SHM_K;
  float* ws = (float*)(lds + TAB_OFF) + wid * 64; float* li_l = ws; float* al_l = ws + 32;
  float m_reg = 0.f, l_reg = 0; f32x16 o[2] = {}; bf16x8 (&qr)[6] = ap.qr;
  const int vb0 = (int)(uintptr_t)V_lds + v_rd_base(lane);
  const int ra = tid >> 3, ca = tid & 7, rb = (tid & 255) >> 2, cb = 8 + (tid & 3), rv = tid >> 3, cv = tid & 7;
  ATT_OFFS(tok0, h, kofa, kofb, vofs);
  const int ksta = KSWZ(ra, ca * 16), kstb = KSWZ(rb, cb * 16), vst = v_st(rv, cv * 8);
  const bool two = wid < 4;
  bf16x8 &RK0a = ap.k0a, &RK0b = ap.k0b, &RV0 = ap.v0, &RK1a = ap.k1a, &RK1b = ap.k1b, &RV1 = ap.v1;
#define TLOAD(KA, KB, VV, t) ATT_TLOADX(KA, KB, VV, t, kofa, kofb, vofs)
#define TWRITE(KA, KB, VV, b) do { constexpr int bo_ = (b) * SHM_K; *(bf16x8*)(K_lds + bo_ + ksta) = KA; if (two) *(bf16x8*)(K_lds + bo_ + kstb) = KB; *(bf16x8*)(V_lds + bo_ + vst) = VV; } while (0)
#define RESC(a) do { if (__any((a) < 1.f)) { if (hi == 0) al_l[r32] = (a); asm volatile("s_waitcnt lgkmcnt(0)" ::: "memory"); \
    _Pragma("unroll") for (int d = 0; d < 2; ++d) _Pragma("unroll") for (int r = 0; r < 16; ++r) o[d][r] *= al_l[crow(r, hi)]; } } while (0)
#define STEP_END() do { asm volatile("s_waitcnt lgkmcnt(0)" ::: "memory"); __builtin_amdgcn_s_barrier(); asm volatile("" ::: "memory"); } while (0)
  f32x16 pA0, pA1, pB0, pB1; float alA, alB; bf16x8 pa0, pa1, pa2, pa3; VFrag vf; constexpr int NT = SEQ / KVBLK;
  bf16x8 kone = {}, qm = {}; kone[0] = hi == 0 ? (short)0x3F80 : (short)0;
  m_reg = 0.f;
#define ATT_STEP(PC0, PC1, ALC, PP0, PP1, ALP, KB, VB, WB, RKA, RKB, RVV, S) do { \
    qk_fsm(PC0, PC1, K_lds + (KB) * SHM_K, qr, kone, qm, r32, hi, PP0, PP1, ALP, l_reg, pa0, pa1, pa2, pa3); \
    pv_reads(vf, vb0 + (VB) * SHM_V); SBAR(); \
    if ((S) + 1 < NT) TWRITE(RKA, RKB, RVV, WB); \
    if ((S) + 3 < NT) TLOAD(RKA, RKB, RVV, (S) + 3); else if (has_next) { ATT_OFFS(ntok0, nh, nkofa_, nkofb_, nvofs_); ATT_TLOADX(RKA, RKB, RVV, (S) + 3 - NT, nkofa_, nkofb_, nvofs_); } \
    SBAR(); \
    pv_sm2(o, vf, vb0 + (VB) * SHM_V, pa0, pa1, pa2, pa3, PC0, PC1, m_reg, ALC, qm, hi); \
    RESC(ALC); STEP_END(); } while (0)
  TWRITE(RK0a, RK0b, RV0, 0); TLOAD(RK0a, RK0b, RV0, 2);
  STEP_END();
  qkt(pA0, pA1, K_lds, qr, kone, qm, r32, hi); partialSM<true>(pA0, pA1, m_reg, alA, qm, hi);
  TWRITE(RK1a, RK1b, RV1, 1); TLOAD(RK1a, RK1b, RV1, 3);
  STEP_END();
  if (wid >= 4) __builtin_amdgcn_s_setprio(1);
  for (int s = 1; s + 3 < NT - 2; s += 4) {
    ATT_STEP(pB0, pB1, alB, pA0, pA1, alA, 1, 0, 2, RK0a, RK0b, RV0, s);
    ATT_STEP(pA0, pA1, alA, pB0, pB1, alB, 2, 1, 3, RK1a, RK1b, RV1, s + 1);
    ATT_STEP(pB0, pB1, alB, pA0, pA1, alA, 3, 2, 0, RK0a, RK0b, RV0, s + 2);
    ATT_STEP(pA0, pA1, alA, pB0, pB1, alB, 0, 3, 1, RK1a, RK1b, RV1, s + 3);
  }
  ATT_STEP(pB0, pB1, alB, pA0, pA1, alA, 1, 0, 2, RK0a, RK0b, RV0, NT - 3);
  ATT_STEP(pA0, pA1, alA, pB0, pB1, alB, 2, 1, 3, RK1a, RK1b, RV1, NT - 2);
  qk_fsm(pB0, pB1, K_lds + 3 * SHM_K, qr, kone, qm, r32, hi, pA0, pA1, alA, l_reg, pa0, pa1, pa2, pa3);
  if (has_next) ATT_QLOAD(qr, ntok0, nqrow0, nh);
  pv_reads(vf, vb0 + 2 * SHM_V); SBAR();
  pv_sm2(o, vf, vb0 + 2 * SHM_V, pa0, pa1, pa2, pa3, pB0, pB1, m_reg, alB, qm, hi);
  RESC(alB);
  finishSM(pB0, pB1, alB, l_reg, pa0, pa1, pa2, pa3); SBAR();
  pv_d0(o, vb0 + 3 * SHM_V, pa0, pa1, pa2, pa3);
  __builtin_amdgcn_s_setprio(0);
  if (hi == 0) li_l[r32] = l_reg;
  STEP_END();
  char* st = lds + wid * 4096;
#pragma unroll
  for (int r = 0; r < 16; ++r) { const int orow = crow(r, hi); const float rl = __builtin_amdgcn_rcpf(li_l[orow]);
#pragma unroll
    for (int d0 = 0; d0 < 2; ++d0) *(bf16_t*)(st + orow * 128 + (d0 * 32 + r32) * 2) = (bf16_t)(cvt_pk_bf16(o[d0][r] * rl, 0.f) & 0xffffu); }
  asm volatile("s_waitcnt lgkmcnt(0)" ::: "memory");
  bf16_t* Ow = MIX + (size_t)(tok0 + qrow0 + wid * QBLK) * 1024 + 512 + h * 64;
#pragma unroll
  for (int j = 0; j < 4; ++j) { const int q = lane + 64 * j; const u32x4 v = *(const u32x4*)(st + (q >> 3) * 128 + (q & 7) * 16); *(u32x4*)(Ow + (size_t)(q >> 3) * 1024 + (q & 7) * 8) = v; }
  STEP_END();
#undef TLOAD
#undef TWRITE
#undef RESC
#undef STEP_END
#undef ATT_STEP
}
#undef KSWZ
#undef SBAR
}

struct Frame {
    LAS unsigned char* lds; unsigned* ctl; unsigned char* ws; float* out; const float* in[29];
    int tid, lane, wave, G, bid;
};
enum { I_X = 0, I_WIN, I_LRE, I_LIM, I_LDT, I_BRE, I_BIM, I_CRE, I_CIM, I_DSK, I_WGLU, I_BGLU, I_QG, I_WUQ, I_KVG, I_WUKV, I_WO, I_LN1G, I_LN1B, I_WR, I_RB, I_WEG, I_WEU, I_WED, I_WSG, I_WSU, I_WSD, I_LN2G, I_LN2B };

#ifndef MK_TPROBE
#define MK_TPROBE -1
#endif
#define TSUB(F, id) do { if (MK_TPROBE >= 100) { __syncthreads(); if (blockIdx.x == 0 && threadIdx.x == 0) { volatile LAS unsigned* M_ = (volatile LAS unsigned*)((F).lds + MISC_OFF); const unsigned long long tn_ = __builtin_amdgcn_s_memrealtime(); \
    const unsigned long long tl_ = ((unsigned long long)M_[17] << 32) | M_[16]; if ((id) == MK_TPROBE) { const unsigned long long d_ = tn_ - tl_; M_[18] = (unsigned)d_; M_[19] = (unsigned)(d_ >> 32); } M_[16] = (unsigned)tn_; M_[17] = (unsigned)(tn_ >> 32); } } } while (0)
__device__ __forceinline__ int fresh_lane() { int l = (int)(threadIdx.x & 63u); asm volatile("" : "+v"(l)); return l; }
template <class F> __device__ __forceinline__ void transpose_load(const F& f, int k0, int n0, int lane, float (&tv)[32]) {
#pragma unroll
    for (int i = 0; i < 32; ++i) tv[i] = f(k0 + 2 * i + (lane >> 5), n0 + (lane & 31));
}
__device__ __forceinline__ void transpose_store(const float (&tv)[32], bf16_t* Bt, int ldk, int k0, int n0, LAS float* scr, int lane) {
#pragma unroll
    for (int i = 0; i < 32; ++i) scr[(2 * i + (lane >> 5)) * 33 + (lane & 31)] = tv[i];
    asm volatile("s_waitcnt lgkmcnt(0)" ::: "memory");
    const int c = lane & 7;
#pragma unroll
    for (int j = 0; j < 4; ++j) { const int n = (lane >> 3) + 8 * j; const LAS float* s = scr + (8 * c) * 33 + n;
        u32x4 o; o.x = cvt_pk_bf16(s[0 * 33], s[1 * 33]); o.y = cvt_pk_bf16(s[2 * 33], s[3 * 33]); o.z = cvt_pk_bf16(s[4 * 33], s[5 * 33]); o.w = cvt_pk_bf16(s[6 * 33], s[7 * 33]);
        *(u32x4*)(Bt + (size_t)(n0 + n) * ldk + k0 + 8 * c) = o; }
    asm volatile("s_waitcnt lgkmcnt(0)" ::: "memory");
}
template <class F> __device__ __forceinline__ void transpose_item(const F& f, bf16_t* Bt, int ldk, int k0, int n0, LAS float* scr, int lane) {
    float tv[32]; transpose_load(f, k0, n0, lane, tv); transpose_store(tv, Bt, ldk, k0, n0, scr, lane);
}
__device__ __forceinline__ int rope_perm_src(int p) { return (p & 1) ? 16 + (p >> 1) : (p >> 1); }
struct SsmPar { float lr, li, dt, kr, ki; };
__device__ __forceinline__ SsmPar ssm_par(const float* lam_re, const float* lam_im, const float* log_dt, int d, int g, int n) {
    SsmPar p; p.lr = fminf(lam_re[(d * 32 + g) * 64 + n], -1e-4f); p.li = lam_im[(d * 32 + g) * 64 + n]; p.dt = expf(log_dt[d * 32 + g]);
    const float x = p.lr * p.dt, th = p.li * p.dt;
    const float em1 = expm1f(x), cs = cosf(th), sn = sinf(th), sh = sinf(0.5f * th);
    const float ai = (em1 + 1.f) * sn, arm1 = em1 * cs - 2.f * sh * sh, den = p.lr * p.lr + p.li * p.li;
    p.kr = (arm1 * p.lr + ai * p.li) / den; p.ki = (ai * p.lr - arm1 * p.li) / den; return p;
}
__device__ __forceinline__ void ssm_pow_xt(float x, float th, float e, float& pr, float& pi) {
    const float mag = __builtin_amdgcn_exp2f(x * e * 1.4426950408889634f); double trd = (double)th * (double)e * 0.15915494309189535; trd -= rint(trd); const float tr = (float)trd;
    pr = mag * __builtin_amdgcn_cosf(tr); pi = mag * __builtin_amdgcn_sinf(tr);
}
__device__ __forceinline__ void ssm_pow(const SsmPar& p, float e, float& pr, float& pi) { ssm_pow_xt(p.lr * p.dt, p.li * p.dt, e, pr, pi); }

__device__ __forceinline__ void p0_ssm_item(Frame& F, int g, int j) {
    LAS float* Pr = (LAS float*)F.lds;
    LAS float* Pi = Pr + 2 * 64 * 33;
    LAS float* Br = Pi + 2 * 64 * 33;
    LAS float* Bi = Br + 2 * 64 * 16;
    LAS float* Cr = Bi + 2 * 64 * 16;
    LAS float* Ci = Cr + 2 * 16 * 64;
    LAS float* Par = Ci + 2 * 16 * 64;
    const float* lam_re = F.in[I_LRE]; const float* lam_im = F.in[I_LIM]; const float* log_dt = F.in[I_LDT];
    __syncthreads();
    if (F.tid < 128) { const SsmPar p = ssm_par(lam_re, lam_im, log_dt, F.tid >> 6, g, F.tid & 63); Par[F.tid * 4] = p.lr * p.dt; Par[F.tid * 4 + 1] = p.li * p.dt; Par[F.tid * 4 + 2] = p.kr; Par[F.tid * 4 + 3] = p.ki; }
    for (int idx = F.tid; idx < 2 * 16 * 64; idx += 512) { const int n = idx & 63, pp = (idx >> 6) & 15, d = idx >> 10;
        Cr[idx] = F.in[I_CRE][((d * 32 + g) * 16 + pp) * 64 + n]; Ci[idx] = F.in[I_CIM][((d * 32 + g) * 16 + pp) * 64 + n]; }
    __syncthreads();
    for (int idx = F.tid; idx < 2 * 64 * 33; idx += 512) { const int tau = idx % 33, dn = idx / 33; float pr, pi; ssm_pow_xt(Par[dn * 4], Par[dn * 4 + 1], (float)tau, pr, pi); Pr[idx] = pr; Pi[idx] = pi; }
    for (int idx = F.tid; idx < 2 * 64 * 16; idx += 512) { const int q = idx & 15, dn = idx >> 4, n = dn & 63, d = dn >> 6; const float kr = Par[dn * 4 + 2], ki = Par[dn * 4 + 3];
        const float br = F.in[I_BRE][((d * 32 + g) * 64 + n) * 16 + q], bi = F.in[I_BIM][((d * 32 + g) * 64 + n) * 16 + q];
        Br[idx] = kr * br - ki * bi; Bi[idx] = kr * bi + ki * br; }
    __syncthreads();
    float* Kt = (float*)(F.ws + WS_KT) + (size_t)g * 16384;
    { const int blk = 512 * j + F.tid;
      const int q2 = blk & 7, p2 = (blk >> 3) & 7, tau = (blk >> 6) & 31, d = blk >> 11; float s00 = 0.f, s01 = 0.f, s10 = 0.f, s11 = 0.f;
      for (int n = 0; n < 64; ++n) { const float pr = Pr[(d * 64 + n) * 33 + tau], pi = Pi[(d * 64 + n) * 33 + tau];
          const float b0r = Br[(d * 64 + n) * 16 + 2 * q2], b0i = Bi[(d * 64 + n) * 16 + 2 * q2], b1r = Br[(d * 64 + n) * 16 + 2 * q2 + 1], b1i = Bi[(d * 64 + n) * 16 + 2 * q2 + 1];
          const float d0r = pr * b0r - pi * b0i, d0i = pr * b0i + pi * b0r, d1r = pr * b1r - pi * b1i, d1i = pr * b1i + pi * b1r;
          const float c0r = Cr[(d * 16 + 2 * p2) * 64 + n], c0i = Ci[(d * 16 + 2 * p2) * 64 + n], c1r = Cr[(d * 16 + 2 * p2 + 1) * 64 + n], c1i = Ci[(d * 16 + 2 * p2 + 1) * 64 + n];
          s00 += c0r * d0r - c0i * d0i; s01 += c0r * d1r - c0i * d1i; s10 += c1r * d0r - c1i * d0i; s11 += c1r * d1r - c1i * d1i; }
      float* kp = Kt + ((size_t)(d * 32 + tau) * 16 + 2 * p2) * 16 + 2 * q2; kp[0] = s00; kp[1] = s01; kp[16] = s10; kp[17] = s11; }
    bf16_t* Wst = (bf16_t*)(F.ws + WS_WST) + (size_t)g * 256 * 512;
    for (int pc = F.tid; pc < 32 * 64; pc += 512) { const int row = 32 * j + (pc >> 6), k0 = (pc & 63) * 8, s = k0 >> 4, q0 = k0 & 15;
        const int d = row >> 7, ri = (row >> 6) & 1, n = row & 63, e = d ? s : (CHK - 1 - s);
        const float pr = Pr[(d * 64 + n) * 33 + e], pi = Pi[(d * 64 + n) * 33 + e]; float v[8];
#pragma unroll
        for (int t = 0; t < 8; ++t) { const float br = Br[(d * 64 + n) * 16 + q0 + t], bi = Bi[(d * 64 + n) * 16 + q0 + t]; v[t] = ri ? (pr * bi + pi * br) : (pr * br - pi * bi); }
        u32x4 o; o.x = cvt_pk_bf16(v[0], v[1]); o.y = cvt_pk_bf16(v[2], v[3]); o.z = cvt_pk_bf16(v[4], v[5]); o.w = cvt_pk_bf16(v[6], v[7]);
        *(u32x4*)(Wst + (size_t)row * 512 + k0) = o; }
    bf16_t* Mo = (bf16_t*)(F.ws + WS_MO) + (size_t)g * 512 * UHK;
    for (int pc = F.tid; pc < 64 * 32; pc += 512) { const int row = 64 * j + (pc >> 5), kk = (pc & 31) * 8, d = kk >> 7, ri = (kk >> 6) & 1, n0 = kk & 63, tq = row >> 4, pp = row & 15;
        const int e = d ? (CHK - tq) : (tq + 1); float v[8];
#pragma unroll
        for (int t = 0; t < 8; ++t) { const int n = n0 + t; const float pr = Pr[(d * 64 + n) * 33 + e], pi = Pi[(d * 64 + n) * 33 + e], cr = Cr[(d * 16 + pp) * 64 + n], ci = Ci[(d * 16 + pp) * 64 + n];
            v[t] = ri ? -(cr * pi + ci * pr) : (cr * pr - ci * pi); }
        u32x4 o; o.x = cvt_pk_bf16(v[0], v[1]); o.y = cvt_pk_bf16(v[2], v[3]); o.z = cvt_pk_bf16(v[4], v[5]); o.w = cvt_pk_bf16(v[6], v[7]);
        *(u32x4*)(Mo + (size_t)row * UHK + 512 + kk) = o; }
}

template <int PART> __device__ __forceinline__ void p0_prologue(Frame& F) {
    const int lane = fresh_lane();
    if (PART == 1) {
        for (int it = F.bid; it < 256; it += F.G) p0_ssm_item(F, it >> 3, it & 7);
        __syncthreads();
    }
    if (PART == 0) {
        float* rc = (float*)(F.ws + WS_ROPE); float* rs = rc + 2048 * 16;
        for (int idx = F.bid * 512 + F.tid; idx < 2048 * 16; idx += F.G * 512) { const int i = idx & 15, pos = idx >> 4;
            const float inv = expf(-9.210340371976184f * (float)i * (1.f / 16.f)); const float a = (float)pos * inv; rc[idx] = cosf(a); rs[idx] = sinf(a); } }
    LAS float* scr = (LAS float*)(F.lds + F.wave * 16384);
    const int gw = F.bid * 8 + F.wave, NGW = F.G * 8;
    constexpr int I_A = 512, I_B = 128, I_C = 96, I_D = 128, I_E = 128, I_F = 512, I_G = 65 * 256, I_H = 65 * 128;
    constexpr int NITEMS = I_A + I_B + I_C + I_D + I_E + I_F + I_G + I_H;
    for (int it = (PART == 0 ? gw : I_A + gw); it < (PART == 0 ? I_A : NITEMS); it += NGW) {
        int r = it;
        if (r < I_A) { const float* W = F.in[I_WIN]; const int kb = r / 32, nb = r % 32;
            transpose_item([&](int k, int n) -> float { if (n >= 928) return 0.f; const int src = n < 896 ? n : 896 + rope_perm_src(n - 896); return W[(size_t)k * 928 + src]; }, (bf16_t*)(F.ws + WS_WIN), 1024, kb * 64, nb * 32, scr, lane); continue; } r -= I_A;
        if (r < I_B) { const float* W = F.in[I_WGLU]; const int kb = r / 16, nb = r % 16;
            transpose_item([&](int k, int n) -> float { return W[(size_t)k * 512 + n]; }, (bf16_t*)(F.ws + WS_WGLU), 512, kb * 64, nb * 32, scr, lane); continue; } r -= I_B;
        if (r < I_C) { const float* W = F.in[I_WUQ]; const float* gq = F.in[I_QG]; const int kb = r / 24, nb = r % 24;
            transpose_item([&](int k, int n) -> float { const int hh = n / 96, jj = n % 96; const int src = jj < 64 ? n : hh * 96 + 64 + rope_perm_src(jj - 64); return W[(size_t)k * 768 + src] * gq[k]; }, (bf16_t*)(F.ws + WS_WUQ), 256, kb * 64, nb * 32, scr, lane); continue; } r -= I_C;
        if (r < I_D) { const float* W = F.in[I_WUKV]; const float* gk = F.in[I_KVG]; const int kb = r / 32, nb = r % 32;
            transpose_item([&](int k, int n) -> float { return k < 128 ? W[(size_t)k * 1024 + n] * gk[k] : 0.f; }, (bf16_t*)(F.ws + WS_WUKV), 256, kb * 64, nb * 32, scr, lane); continue; } r -= I_D;
        if (r < I_E) { const float* W = F.in[I_WR]; const int kb = r / 8, nb = r % 8;
            transpose_item([&](int k, int n) -> float { return n < 64 ? W[(size_t)k * 64 + n] : 0.f; }, (bf16_t*)(F.ws + WS_WR), 1024, kb * 64, nb * 32, scr, lane); continue; } r -= I_E;
        if (r < I_F) { const float* W = F.in[I_WO]; const int kb = r / 32, nb = r % 32;
            transpose_item([&](int k, int n) -> float { return W[(size_t)k * 1024 + n]; }, (bf16_t*)(F.ws + WS_WO), 1024, kb * 64, nb * 32, scr, lane); continue; } r -= I_F;
        const int it2 = it + NGW; const bool has2 = it2 < NITEMS; float tv0[32], tv1[32];
        auto geom = [&](int rr_, const float*& W0, const float*& W1, bf16_t*& dst, int& ldk, int& k0, int& n0, bool& gu) {
            if (rr_ < I_G) { const int e = rr_ / 256, q = rr_ % 256; gu = true; k0 = (q / 16) * 64; n0 = (q % 16) * 32; ldk = 1024;
                W0 = e < 64 ? F.in[I_WEG] + (size_t)e * 1024 * 256 : F.in[I_WSG]; W1 = e < 64 ? F.in[I_WEU] + (size_t)e * 1024 * 256 : F.in[I_WSU]; dst = (bf16_t*)(F.ws + WS_WGU) + (size_t)e * 512 * 1024; }
            else { const int q_ = rr_ - I_G, e = q_ / 128, q = q_ % 128; gu = false; k0 = (q / 32) * 64; n0 = (q % 32) * 32; ldk = 256;
                W0 = e < 64 ? F.in[I_WED] + (size_t)e * 256 * 1024 : F.in[I_WSD]; W1 = W0; dst = (bf16_t*)(F.ws + WS_WD) + (size_t)e * 1024 * 256; } };
        auto val = [&](bool gu, const float* W0, const float* W1, int k, int n) -> float { if (gu) { const int r_ = n & 255, col = 128 * (n >> 8) + 32 * (r_ >> 6) + (r_ & 31); return ((r_ >> 5) & 1) ? W1[(size_t)k * 256 + col] : W0[(size_t)k * 256 + col]; } return W0[(size_t)k * 1024 + n]; };
        const float *Wa0, *Wa1, *Wb0, *Wb1; bf16_t *da, *db; int lka, ka, na, lkb, kb_, nb_; bool gua, gub;
        geom(r, Wa0, Wa1, da, lka, ka, na, gua);
        transpose_load([&](int k, int n) -> float { return val(gua, Wa0, Wa1, k, n); }, ka, na, lane, tv0);
        if (has2) { geom(it2 - (I_A + I_B + I_C + I_D + I_E + I_F), Wb0, Wb1, db, lkb, kb_, nb_, gub); transpose_load([&](int k, int n) -> float { return val(gub, Wb0, Wb1, k, n); }, kb_, nb_, lane, tv1); }
        transpose_store(tv0, da, lka, ka, na, scr, lane);
        if (has2) transpose_store(tv1, db, lkb, kb_, nb_, scr, lane);
        it += NGW;
    }
    if (PART == 0) {
      const float* x = F.in[I_X]; bf16_t* xb = (bf16_t*)(F.ws + WS_XB); const size_t N8 = (size_t)T * DM / 8, st = (size_t)F.G * 512;
      for (size_t i = (size_t)F.bid * 512 + F.tid; i < N8; i += 4 * st) {
          f32x4 a[4], b[4];
#pragma unroll
          for (int u = 0; u < 4; ++u) { const size_t ii = i + u * st < N8 ? i + u * st : i; a[u] = __builtin_nontemporal_load((const f32x4*)(x + ii * 8)); b[u] = __builtin_nontemporal_load((const f32x4*)(x + ii * 8 + 4)); }
#pragma unroll
          for (int u = 0; u < 4; ++u) if (i + u * st < N8) *(u32x4*)(xb + (i + u * st) * 8) = pack8(a[u], b[u]); } }
    if (PART == 1) { asm volatile("s_waitcnt vmcnt(0) lgkmcnt(0)" ::: "memory"); __syncthreads(); }
}

__device__ __forceinline__ void scan_unit(Frame& F, int g, int pm) {
    const bf16_t* S = (const bf16_t*)(F.ws + WS_S); bf16_t* UH = (bf16_t*)(F.ws + WS_UH);
    {
        const int n = F.tid & 63, d = (F.tid >> 6) & 1, b = pm * 4 + (F.tid >> 7);
        const SsmPar p = ssm_par(F.in[I_LRE], F.in[I_LIM], F.in[I_LDT], d, g, n); float acr, aci; ssm_pow(p, (float)CHK, acr, aci);
        float hr = 0.f, hi = 0.f;
        const size_t rbase = (size_t)g * UHR + (size_t)b * NCHK;
#pragma unroll
        for (int hb = 0; hb < 2; ++hb) {
            float sr[32], si[32];
#pragma unroll
            for (int st = 0; st < 32; ++st) { const int ci = d ? (NCHK - 1 - (hb * 32 + st)) : (hb * 32 + st);
                sr[st] = __uint_as_float((unsigned)S[(rbase + ci) * 256 + d * 128 + n] << 16); si[st] = __uint_as_float((unsigned)S[(rbase + ci) * 256 + d * 128 + 64 + n] << 16); }
#pragma unroll
            for (int st = 0; st < 32; ++st) { const int ci = d ? (NCHK - 1 - (hb * 32 + st)) : (hb * 32 + st);
                bf16_t* hp = UH + (rbase + ci) * UHK + 512 + d * 128 + n;
                hp[0] = (bf16_t)(cvt_pk_bf16(hr, 0.f) & 0xffffu); hp[64] = (bf16_t)(cvt_pk_bf16(hi, 0.f) & 0xffffu);
                const float nr = acr * hr - aci * hi + sr[st], ni = acr * hi + aci * hr + si[st]; hr = nr; hi = ni; }
        }
    }
}
__device__ __forceinline__ void mo_fill(Frame& F) {
    const float* Kt = (const float*)(F.ws + WS_KT); bf16_t* Mo = (bf16_t*)(F.ws + WS_MO);
    for (int pc = F.bid * 512 + F.tid; pc < 32 * 512 * 64; pc += F.G * 512) {
        const int k0 = (pc & 63) * 8, row = (pc >> 6) & 511, g = pc >> 15, s = k0 >> 4, q0 = k0 & 15, tq = row >> 4, pp = row & 15;
        f32x4 v0 = {0.f, 0.f, 0.f, 0.f}, v1 = {0.f, 0.f, 0.f, 0.f};
        if (tq >= s) { const float* kp = Kt + ((size_t)(g * 2 + 0) * 32 + (tq - s)) * 256 + pp * 16 + q0; v0 += *(const f32x4*)kp; v1 += *(const f32x4*)(kp + 4); }
        if (s >= tq) { const float* kp = Kt + ((size_t)(g * 2 + 1) * 32 + (s - tq)) * 256 + pp * 16 + q0; v0 += *(const f32x4*)kp; v1 += *(const f32x4*)(kp + 4); }
        if (s == tq && (pp >> 3) == (q0 >> 3)) { const float dsk = F.in[I_DSK][g * 16 + pp];
#pragma unroll
            for (int j = 0; j < 4; ++j) { if (q0 + j == pp) v0[j] += dsk; if (q0 + 4 + j == pp) v1[j] += dsk; } }
        *(u32x4*)(Mo + ((size_t)g * 512 + row) * UHK + k0) = pack8(v0, v1);
    }
}

__device__ __forceinline__ void p7_ln1(Frame& F) {
    const int lane = fresh_lane();
    const float* g1 = F.in[I_LN1G]; const float* b1 = F.in[I_LN1B]; bf16_t* x1b = (bf16_t*)(F.ws + WS_X1B);
    f32x4 gg[4], bb[4];
#pragma unroll
    for (int j = 0; j < 4; ++j) { const int c = 8 * lane + (j >> 1) * 512 + (j & 1) * 4; gg[j] = *(const f32x4*)(g1 + c); bb[j] = *(const f32x4*)(b1 + c); }
    for (int pm = F.bid; pm < T / 256; pm += F.G)
    for (int row0 = pm * 256 + F.wave; row0 < pm * 256 + 256; row0 += 32) {
        u32x4 w0[4], w1[4];
#pragma unroll
        for (int j = 0; j < 4; ++j) { const bf16_t* rp = x1b + (size_t)(row0 + 8 * j) * 1024 + 8 * lane; w0[j] = *(const u32x4*)rp; w1[j] = *(const u32x4*)(rp + 512); }
#pragma unroll
        for (int j = 0; j < 4; ++j) {
            bf16_t* rp = x1b + (size_t)(row0 + 8 * j) * 1024 + 8 * lane; f32x4 v[4]; unpack8(w0[j], v[0], v[1]); unpack8(w1[j], v[2], v[3]);
            float s = 0.f;
#pragma unroll
            for (int q = 0; q < 4; ++q) s += (v[q][0] + v[q][1]) + (v[q][2] + v[q][3]);
            const float mean = wave_sum(s) * (1.f / 1024.f); float qq = 0.f;
#pragma unroll
            for (int q = 0; q < 4; ++q) { v[q] = v[q] - mean; qq += (v[q][0] * v[q][0] + v[q][1] * v[q][1]) + (v[q][2] * v[q][2] + v[q][3] * v[q][3]); }
            const float rstd = __builtin_amdgcn_rsqf(wave_sum(qq) * (1.f / 1024.f) + LN_EPS);
#pragma unroll
            for (int q = 0; q < 4; ++q) v[q] = v[q] * rstd * gg[q] + bb[q];
            *(u32x4*)rp = pack8(v[0], v[1]); *(u32x4*)(rp + 512) = pack8(v[2], v[3]);
        }
    }
}

__device__ __forceinline__ void route_batch(Frame& F, int bt) {
    LAS int* hist = (LAS int*)(F.lds); LAS int* base = hist + 64;
    const float* LG = (const float*)(F.ws + WS_LOGIT); int* rowtok = (int*)(F.ws + WS_ROWTOK); int* tslot = (int*)(F.ws + WS_TSLOT); float* topw = (float*)(F.ws + WS_TOPW);
    {
        __syncthreads();
        if (F.tid < 64) hist[F.tid] = 0;
        __syncthreads();
        const int tok = bt * 256 + F.tid, ch = (bt * 256) / CAPC;
        int idx[6], lr[6]; float w[6];
        if (F.tid < 256) {
            float lg[64];
#pragma unroll
            for (int j = 0; j < 16; ++j) { const f32x4 v = *(const f32x4*)(LG + (size_t)tok * 64 + 4 * j); lg[4 * j] = v[0]; lg[4 * j + 1] = v[1]; lg[4 * j + 2] = v[2]; lg[4 * j + 3] = v[3]; }
            route_token(lg, F.in[I_RB], idx, w);
#pragma unroll
            for (int k = 0; k < 6; ++k) lr[k] = atomicAdd((int*)&hist[idx[k]], 1);
        }
        __syncthreads();
        if (F.tid < 64) base[F.tid] = (int)__hip_atomic_fetch_add(F.ctl + CW_CNT + 64 * (ch * 65 + F.tid), (unsigned)hist[F.tid], __ATOMIC_RELAXED, __HIP_MEMORY_SCOPE_AGENT);
        __syncthreads();
        if (F.tid < 256) {
#pragma unroll
            for (int k = 0; k < 6; ++k) { const int slot = base[idx[k]] + lr[k];
                rowtok[(size_t)(ch * 64 + idx[k]) * CAPC + slot] = tok; tslot[(size_t)tok * 8 + k] = (idx[k] << 16) | slot; topw[(size_t)tok * 8 + k] = w[k]; }
        }
    }
}

__device__ __forceinline__ void p12_combine(Frame& F, int ch) {
    const int lane = fresh_lane();
    const MoeTab tb = moe_tab(F.lds); const int t0 = tb.tbase[ch * 65];
    const unsigned char* Y8 = F.ws + WS_Y; const unsigned char* YS = F.ws + WS_YS; const bf16_t* x1b = (const bf16_t*)(F.ws + WS_X1B);
    const int* tslot = (const int*)(F.ws + WS_TSLOT); const float* topw = (const float*)(F.ws + WS_TOPW);
    const float* g2 = F.in[I_LN2G]; const float* b2 = F.in[I_LN2B];
    f32x4 gg[4], bb[4];
#pragma unroll
    for (int j = 0; j < 4; ++j) { const int c = 8 * lane + (j >> 1) * 512 + (j & 1) * 4; gg[j] = *(const f32x4*)(g2 + c); bb[j] = *(const f32x4*)(b2 + c); }
    constexpr int NTK = 4;
    const int stride = F.G * 8;
    for (int tk0 = F.bid * 8 + F.wave; tk0 < CAPC; tk0 += NTK * stride) {
        int ts[NTK][6]; float tw[NTK][6];
#pragma unroll
        for (int t = 0; t < NTK; ++t) { const int tk = tk0 + t * stride < CAPC ? tk0 + t * stride : tk0; const size_t tok = (size_t)ch * CAPC + tk;
#pragma unroll
            for (int k = 0; k < 6; ++k) { ts[t][k] = tslot[tok * 8 + k]; tw[t][k] = topw[tok * 8 + k]; } }
        u32x4 xw[NTK][2]; u32x2 sw[NTK][2], yw[NTK][6][2];
#pragma unroll
        for (int t = 0; t < NTK; ++t) { const int tk = tk0 + t * stride < CAPC ? tk0 + t * stride : tk0; const size_t tok = (size_t)ch * CAPC + tk;
            const bf16_t* xr = x1b + tok * 1024 + 8 * lane; xw[t][0] = __builtin_nontemporal_load((const u32x4*)xr); xw[t][1] = __builtin_nontemporal_load((const u32x4*)(xr + 512));
            const unsigned char* yr = YS + y8_off(tk, 8 * lane); sw[t][0] = __builtin_nontemporal_load((const u32x2*)yr); sw[t][1] = __builtin_nontemporal_load((const u32x2*)(yr + 512));
#pragma unroll
            for (int k = 0; k < 6; ++k) { const int yrow = (tb.tbase[ch * 65 + (ts[t][k] >> 16)] - t0) * 256 + (ts[t][k] & 0xffff);
                const unsigned char* y8 = Y8 + y8_off(yrow, 8 * lane); yw[t][k][0] = __builtin_nontemporal_load((const u32x2*)y8); yw[t][k][1] = __builtin_nontemporal_load((const u32x2*)(y8 + 512)); } }
#pragma unroll
        for (int t = 0; t < NTK; ++t) {
            const int tk = tk0 + t * stride; if (tk >= CAPC) break;
            const size_t tok = (size_t)ch * CAPC + tk;
            f32x4 a[4]; unpack8(xw[t][0], a[0], a[1]); unpack8(xw[t][1], a[2], a[3]); a[0] *= ALPHA; a[1] *= ALPHA; a[2] *= ALPHA; a[3] *= ALPHA;
            { f32x4 y0, y1, y2, y3; unpack8_fp8(sw[t][0], y0, y1); unpack8_fp8(sw[t][1], y2, y3); a[0] += y0 * Y8_INV; a[1] += y1 * Y8_INV; a[2] += y2 * Y8_INV; a[3] += y3 * Y8_INV; }
#pragma unroll
            for (int k = 0; k < 6; ++k) { const float w = tw[t][k] * Y8_INV; f32x4 y0, y1, y2, y3; unpack8_fp8(yw[t][k][0], y0, y1); unpack8_fp8(yw[t][k][1], y2, y3);
                a[0] += y0 * w; a[1] += y1 * w; a[2] += y2 * w; a[3] += y3 * w; }
            float s = 0.f;
#pragma unroll
            for (int j = 0; j < 4; ++j) s += (a[j][0] + a[j][1]) + (a[j][2] + a[j][3]);
            const float mean = wave_sum(s) * (1.f / 1024.f); float q = 0.f;
#pragma unroll
            for (int j = 0; j < 4; ++j) { a[j] = a[j] - mean; q += (a[j][0] * a[j][0] + a[j][1] * a[j][1]) + (a[j][2] * a[j][2] + a[j][3] * a[j][3]); }
            const float rstd = __builtin_amdgcn_rsqf(wave_sum(q) * (1.f / 1024.f) + LN_EPS);
            float* orow = F.out + tok * 1024 + 8 * lane;
#pragma unroll
            for (int j = 0; j < 4; ++j) *(f32x4*)(orow + (j >> 1) * 512 + (j & 1) * 4) = a[j] * rstd * gg[j] + bb[j];
        }
    }
}
}

namespace fx {
constexpr int NPHASE = 11 + 2 * NCH;
struct Args { const float* in[29]; float* out; unsigned char* ws; int ph_lo, ph_hi; };

__global__ void __launch_bounds__(512, 2) fwd(Args args) {
    extern __shared__ __attribute__((aligned(16))) unsigned char lds_raw[];
    Frame F;
    F.lds = (LAS unsigned char*)lds_raw; F.ws = args.ws; F.ctl = (unsigned*)(args.ws + WS_CTL); F.out = args.out;
#pragma unroll
    for (int i = 0; i < 29; ++i) F.in[i] = args.in[i];
    F.tid = threadIdx.x; F.lane = 0; F.wave = __builtin_amdgcn_readfirstlane(F.tid >> 6); F.G = gridDim.x; F.bid = blockIdx.x;
    volatile LAS unsigned* MISC = (volatile LAS unsigned*)(F.lds + MISC_OFF);
    if (F.tid < 32) MISC[F.tid] = 0u;
    __syncthreads();
    const int lo = args.ph_lo, hi = args.ph_hi;
    XcdBarrier bar; bar.bar = F.ctl + CW_BAR; bar.x = 0; bar.st = MISC + 8;
    if (hi - lo > 1) bar = xcd_barrier_post(F.ctl + CW_BAR, MISC + 8);
#ifndef PH_MASK
#define PH_MASK 0xFFFFFFFFu
#endif
#define IN(k) (((PH_MASK >> ((k) > 11 ? 11 + (((k) - 11) & 1) : (k))) & 1u) && lo <= (k) && (k) < hi)
#define SEAM(k) do { if (IN(k) && IN((k) + 1)) xcd_barrier(bar); if (MK_TPROBE >= 300 && blockIdx.x == 0 && threadIdx.x == 0) { const unsigned long long cn_ = __builtin_amdgcn_s_memtime(); \
        const unsigned long long cl_ = ((unsigned long long)MISC[25] << 32) | MISC[24]; if ((k) + 300 == MK_TPROBE) { const unsigned long long dc_ = cn_ - cl_; MISC[26] = (unsigned)dc_; MISC[27] = (unsigned)(dc_ >> 32); } MISC[24] = (unsigned)cn_; MISC[25] = (unsigned)(cn_ >> 32); } \
     if (MK_TPROBE >= 0 && blockIdx.x == 0 && threadIdx.x == 0) { const unsigned long long tn_ = __builtin_amdgcn_s_memrealtime(); \
        const unsigned long long tl_ = ((unsigned long long)MISC[17] << 32) | MISC[16]; if (((k) == MK_TPROBE && MK_TPROBE < 100) || (k) + 300 == MK_TPROBE) { const unsigned long long d_ = tn_ - tl_; MISC[18] = (unsigned)d_; MISC[19] = (unsigned)(d_ >> 32); } if (MK_TPROBE == 200 + (k)) { MISC[18] = MISC[22]; MISC[19] = MISC[23]; } MISC[22] = 0u; MISC[23] = 0u; MISC[16] = (unsigned)tn_; MISC[17] = (unsigned)(tn_ >> 32); } } while (0)
    unsigned char* ws = args.ws;
    bf16_t* UH = (bf16_t*)(ws + WS_UH); bf16_t* CQ = (bf16_t*)(ws + WS_CQ); bf16_t* CKVR = (bf16_t*)(ws + WS_CKVR); bf16_t* Qb = (bf16_t*)(ws + WS_Q); bf16_t* KVb = (bf16_t*)(ws + WS_KV);
    bf16_t* SPRE = (bf16_t*)(ws + WS_SPRE); bf16_t* MIX = (bf16_t*)(ws + WS_MIX);
    float* ssqq = (float*)(ws + WS_SSQQ); float* ssqkv = (float*)(ws + WS_SSQKV); const float* ropec = (const float*)(ws + WS_ROPE); const float* ropes = ropec + 2048 * 16;

    if (MK_TPROBE >= 0 && blockIdx.x == 0 && threadIdx.x == 0) { const unsigned long long tn_ = __builtin_amdgcn_s_memrealtime(); MISC[16] = (unsigned)tn_; MISC[17] = (unsigned)(tn_ >> 32); }
    if (MK_TPROBE == 500 && threadIdx.x == 0) __hip_atomic_store(F.ctl + CW_DBG + 64 + blockIdx.x, 1u + xb_xcc_id(), __ATOMIC_RELAXED, __HIP_MEMORY_SCOPE_AGENT);
    if (IN(0)) { p0_prologue<0>(F); } SEAM(0);
    if (IN(1)) {
        const bool conv_first = ((F.bid >> 3) & 1) != 0;
        if (conv_first) p0_prologue<1>(F);
        { PlainOrder S; S.init(ws + WS_XB, 1024, ws + WS_WIN, 1024, T, 1024, F.G, F.bid);
          EpiWin E{UH, CQ, CKVR, ssqq, ssqkv, ropec, ropes};
          gemm_phase<EpiWin, PlainOrder, true, false>(F.lds, 1024, 1024, 1024, S, E); }
        if (!conv_first) p0_prologue<1>(F);
    } SEAM(1);
    if (IN(2)) {
        { GroupOrder S; S.init(UH, ws + WS_WST, 512, 1, F.G, F.bid); EpiSt E{(bf16_t*)(ws + WS_S)};
          gemm_phase<EpiSt, GroupOrder, true, false>(F.lds, UHK, 512, 512, S, E);
          asm volatile("s_waitcnt vmcnt(0)" ::: "memory"); __syncthreads();
          Unit u; for (int i = 0; S.next(i, u); ++i) scan_unit(F, u.i0, u.i1); }
        mo_fill(F);
        { PlainOrder S; S.init(CQ, 256, ws + WS_WUQ, 256, T, 768, F.G, F.bid); EpiQ E{Qb, ssqq, ropec, ropes};
          gemm_phase<EpiQ, PlainOrder, true, false>(F.lds, 256, 256, 256, S, E); }
        { PlainOrder S; S.init(CKVR, 256, ws + WS_WUKV, 256, T, 1024, F.G, F.bid); EpiKV E{KVb, ssqkv};
          gemm_phase<EpiKV, PlainOrder, true, false>(F.lds, 256, 256, 128, S, E); }
    } SEAM(2);
    if (IN(4)) {
#ifndef SUB4
#define SUB4 3
#endif
        if (SUB4 & 2) REP(40) { att::AttPre ap;
          for (int i = 0;; ++i) { const long L = (long)i * F.G + F.bid; if (L >= 2048) break;
            const int un = xcd_remap((int)L, 2048), pair = un >> 3, qb = un & 7, b = pair >> 3, h = pair & 7;
            const bool has_next = L + F.G < 2048; const int un2 = xcd_remap((int)(has_next ? L + F.G : L), 2048), pair2 = un2 >> 3, qb2 = un2 & 7, b2 = pair2 >> 3, h2 = pair2 & 7;
            if (i == 0) att::attn_prefetch(ap, ws, Qb, b * SEQ, qb * 256, h);
            att::attn_unit(ws, Qb, MIX, b * SEQ, qb * 256, h, (char*)lds_raw, ap, has_next, b2 * SEQ, qb2 * 256, h2); } }
        if (SUB4 & 1) DUP2(4, { GroupOrder S; S.init(UH, ws + WS_MO, UHK, 2, F.G, F.bid); EpiSsmOut E{SPRE};
          gemm_phase<EpiSsmOut, GroupOrder, true, false>(F.lds, UHK, UHK, UHK, S, E); });
    } SEAM(4);
    if (IN(5)) {
        { PanelOrder S; S.init(SPRE, SPRE_LD, ws + WS_WGLU, 512, T, 512, F.G, F.bid); EpiGlu E{SPRE, MIX, F.in[I_BGLU]};
          gemm_phase<EpiGlu, PanelOrder, true, false>(F.lds, SPRE_LD, 512, 512, S, E); }
        asm volatile("s_waitcnt vmcnt(0)" ::: "memory"); __syncthreads();
        { PanelOrder S; S.init(MIX, 1024, ws + WS_WO, 1024, T, 1024, F.G, F.bid); EpiWo E{(bf16_t*)(ws + WS_X1B)};
          gemm_phase<EpiWo, PanelOrder, true, false>(F.lds, 1024, 1024, 1024, S, E); }
        asm volatile("s_waitcnt vmcnt(0)" ::: "memory"); __syncthreads();
        p7_ln1(F);
        asm volatile("s_waitcnt vmcnt(0)" ::: "memory"); __syncthreads();
        { PanelOrder S; S.init(ws + WS_X1B, 1024, ws + WS_WGU + (size_t)64 * 512 * 1024 * 2, 1024, T, 768, F.G, F.bid); EpiSharedRouter E{(bf16_t*)(ws + WS_HS), (float*)(ws + WS_LOGIT)};
          gemm_phase<EpiSharedRouter, PanelOrder, true, false>(F.lds, 1024, 1024, 1024, S, E);
          asm volatile("s_waitcnt vmcnt(0)" ::: "memory"); __syncthreads();
          Unit u; for (int i = 0; S.next(i, u); ++i) if (u.i1 == 2) route_batch(F, u.i0); }
    } SEAM(8);
    if (IN(10)) {
        moe_build_tab(F.lds, F.ctl);
        GateUpOrder S; S.init(F.lds, ws + WS_X1B, ws + WS_WGU, (const int*)(ws + WS_ROWTOK), F.ctl, F.G, F.bid); EpiGateUp E{(bf16_t*)(ws + WS_H)};
        gemm_phase<EpiGateUp, GateUpOrder, true, true>(F.lds, 1024, 1024, 1024, S, E);
    } SEAM(10);
#pragma unroll
    for (int ch = 0; ch < NCH; ++ch) {
        if (IN(11 + 2 * ch)) {
            moe_build_tab(F.lds, F.ctl);
            { DownOrder S; S.init(ws + WS_H, ws + WS_HS, ws + WS_WD, moe_tab(F.lds), ch, F.G, F.bid); EpiDown E{ws + WS_Y, (bf16_t*)(ws + WS_YS)};
              gemm_phase<EpiDown, DownOrder, true, false, 0, 1>(F.lds, 256, 256, 256, S, E); }
        } SEAM(11 + 2 * ch);
        if (IN(12 + 2 * ch)) { moe_build_tab(F.lds, F.ctl); p12_combine(F, ch); } SEAM(12 + 2 * ch);
    }
    if (MK_TPROBE == 500 && blockIdx.x == 0 && threadIdx.x == 0) { unsigned bad = 0; for (unsigned b = 8; b < gridDim.x; ++b) bad += __hip_atomic_load(F.ctl + CW_DBG + 64 + b, __ATOMIC_RELAXED, __HIP_MEMORY_SCOPE_AGENT) != __hip_atomic_load(F.ctl + CW_DBG + 64 + (b & 7u), __ATOMIC_RELAXED, __HIP_MEMORY_SCOPE_AGENT);
        const unsigned long long t0_ = __builtin_amdgcn_s_memrealtime(); if (bad) while (__builtin_amdgcn_s_memrealtime() - t0_ < 100000ull) __builtin_amdgcn_s_sleep(8); }
    if (MK_TPROBE >= 0 && MK_TPROBE != 500 && blockIdx.x == 0 && threadIdx.x == 0) { unsigned long long d_ = ((unsigned long long)MISC[19] << 32) | MISC[18]; if (MK_TPROBE == 600) d_ = ((unsigned long long)MISC[29] << 32) | MISC[28]; const unsigned long long t0_ = __builtin_amdgcn_s_memrealtime();
        unsigned long long wait_ = 8ull * d_; if (MK_TPROBE >= 300 && MK_TPROBE != 600) { const unsigned long long dc_ = ((unsigned long long)MISC[27] << 32) | MISC[26]; wait_ = d_ ? (dc_ * 100ull / d_) * 100ull : 0ull; }
        while (__builtin_amdgcn_s_memrealtime() - t0_ < wait_) __builtin_amdgcn_s_sleep(8); }
#undef IN
#undef SEAM
}

#if MK_DEBUG
__global__ void dbg_cmp(int k, const unsigned char* ws, const float* out_fast, gold::Bufs B, const float* gx1, const float* gout, float* acc) {
    const int t = blockIdx.x;
    float num = 0.f, den = 0.f;
    auto bf = [](const bf16_t* p, size_t i) -> float { return __uint_as_float(((unsigned)p[i]) << 16); };
    int ncol = 0;
    switch (k) { case 0: ncol = 512; break; case 1: ncol = 256; break; case 2: ncol = 160; break; case 3: ncol = 768; break; case 4: ncol = 1024; break; case 5: ncol = 512; break; case 6: ncol = 512; break; case 7: ncol = 512; break; case 8: ncol = 1024; break; default: ncol = 1024; }
    for (int c = threadIdx.x; c < ncol; c += blockDim.x) {
        float f = 0.f, g = 0.f;
        if (k == 0) { const int gg = c >> 4, p = c & 15; f = bf((const bf16_t*)(ws + WS_UH), ((size_t)gg * UHR + (t >> 5)) * UHK + (t & 31) * 16 + p); g = B.proj[(size_t)t * 928 + c]; }
        else if (k == 1) { f = bf((const bf16_t*)(ws + WS_CQ), (size_t)t * 256 + c); g = B.proj[(size_t)t * 928 + 512 + c]; }
        else if (k == 2) { f = bf((const bf16_t*)(ws + WS_CKVR), (size_t)t * 256 + c); g = c < 128 ? B.proj[(size_t)t * 928 + 768 + c] : B.krope[(size_t)t * 32 + rope_perm_src(c - 128)]; }
        else if (k == 3) { const int hh = c / 96, jj = c % 96, src = jj < 64 ? c : hh * 96 + 64 + rope_perm_src(jj - 64); f = bf((const bf16_t*)(ws + WS_Q), (size_t)t * 768 + c); g = B.q[(size_t)t * 768 + src] * QSCALE; }
        else if (k == 4) { f = bf((const bf16_t*)(ws + WS_KV), (size_t)t * 1024 + c); g = B.kv[(size_t)t * 1024 + c]; }
        else if (k == 5) { f = bf((const bf16_t*)(ws + WS_SPRE), (size_t)t * SPRE_LD + c); g = B.spre[(size_t)t * 512 + c]; }
        else if (k == 6) { f = bf((const bf16_t*)(ws + WS_MIX), (size_t)t * 1024 + c); g = B.mix[(size_t)t * 1024 + c]; }
        else if (k == 7) { f = bf((const bf16_t*)(ws + WS_MIX), (size_t)t * 1024 + 512 + c); g = B.mix[(size_t)t * 1024 + 512 + c]; }
        else if (k == 8) { f = bf((const bf16_t*)(ws + WS_X1B), (size_t)t * 1024 + c); g = gx1[(size_t)t * 1024 + c]; }
        else { f = out_fast[(size_t)t * 1024 + c]; g = gout[(size_t)t * 1024 + c]; }
        const float d = f - g; num += d * d; den += g * g;
        if (!(fabsf(f) < 1e30f)) num += 1e30f;
    }
    num = wave_sum(num); den = wave_sum(den);
    if ((threadIdx.x & 63) == 0) { atomicAdd(acc + 2 * k, num); atomicAdd(acc + 2 * k + 1, den); }
}
__global__ void dbg_encode(const float* acc, float* out, int k0, int nk) {
    float c2 = 0.f;
    for (int k = k0; k < k0 + nk; ++k) { const float e = sqrtf(acc[2 * k] / fmaxf(acc[2 * k + 1], 1e-30f)); const float tol = (k == 9) ? 0.08f : 0.04f;
        if (!(e <= tol)) { const int bucket = !(e <= 0.5f) ? 0 : (e > 0.1f ? 1 : 2); c2 = (float)(k - k0 + 1) + 20.f * bucket; break; } }
    if (c2 == 0.f) { if (MK_DBG_NPH >= NPHASE) return; c2 = 90.f; }
    const float c = sqrtf(c2);
    for (size_t i = (size_t)blockIdx.x * blockDim.x + threadIdx.x; i < (size_t)T * 1024; i += (size_t)gridDim.x * blockDim.x) out[i] = c;
}
#endif
}

extern "C" void kernel_launch(void* const* d_in, const int* in_sizes, int n_in, void* d_out, int out_size, void* d_ws, size_t ws_size, hipStream_t stream) {
#if MK_MODE == 0
    gold::In I; const float** p = (const float**)&I;
    for (int i = 0; i < 29; ++i) p[i] = (const float*)d_in[i];
    for (int t0 = 0; t0 < 65536; t0 += 16384) gold::run(I, t0, 16384, (float*)d_ws, (float*)d_out + (size_t)t0 * 1024, (float*)d_out + (size_t)t0 * 1024, stream);
#else
    using namespace fx;
    static int grid = 0;
    if (grid == 0) {
        if (n_in != 29 || ws_size < WS_END) { fprintf(stderr, "kernel_launch: need 29 inputs and >= %zu bytes of workspace (got %d, %zu)\n", (size_t)WS_END, n_in, ws_size); grid = -1; return; }
        int dev = 0, cus = 0, per_cu = 0;
        hipGetDevice(&dev); hipDeviceGetAttribute(&cus, hipDeviceAttributeMultiprocessorCount, dev);
        if (hipFuncSetAttribute((const void*)fwd, hipFuncAttributeMaxDynamicSharedMemorySize, LDS_BYTES) != hipSuccess) { fprintf(stderr, "kernel_launch: hipFuncSetAttribute failed\n"); grid = -1; return; }
        if (hipOccupancyMaxActiveBlocksPerMultiprocessor(&per_cu, (const void*)fwd, 512, LDS_BYTES) != hipSuccess || per_cu < 1) { fprintf(stderr, "kernel_launch: occupancy query says %d\n", per_cu); }
        (void)hipGetLastError();
        grid = cus > 0 ? cus : 256;
    }
    if (grid < 0) return;
    hipMemsetAsync((char*)d_ws + WS_CTL, 0, CTL_BYTES, stream);
    Args a{};
    for (int i = 0; i < 29; ++i) a.in[i] = (const float*)d_in[i];
    a.out = (float*)d_out; a.ws = (unsigned char*)d_ws;
#if MK_MODE == 1
    for (int ph = 0; ph < NPHASE && ph < MK_DBG_NPH; ++ph) { a.ph_lo = ph; a.ph_hi = ph + 1; hipLaunchKernelGGL(fwd, dim3(grid), dim3(512), LDS_BYTES, stream, a); }
#else
    a.ph_lo = 0; a.ph_hi = NPHASE; hipLaunchKernelGGL(fwd, dim3(grid), dim3(512), LDS_BYTES, stream, a);
#endif
#if MK_DEBUG
    {
        gold::In I; const float** p = (const float**)&I;
        for (int i = 0; i < 29; ++i) p[i] = (const float*)d_in[i];
        float* gs = (float*)((char*)d_ws + WS_GOLD); float* gx1 = gs + (size_t)2048 * gold::GOLD_FLOATS_PER_TOK; float* gout = gx1 + (size_t)2048 * 1024;
        gold::Bufs B = gold::run(I, 0, 2048, gs, gx1, gout, stream);
        float* acc = (float*)((char*)d_ws + WS_CTL) + CW_DBG;
        for (int k = 0; k < 10; ++k) hipLaunchKernelGGL(dbg_cmp, dim3(2048), dim3(256), 0, stream, k, (const unsigned char*)d_ws, (const float*)d_out, B, (const float*)gx1, (const float*)gout, acc);
        hipLaunchKernelGGL(dbg_encode, dim3(1024), dim3(256), 0, stream, (const float*)acc, (float*)d_out, MK_DBG_K0, MK_DBG_NK);
    }
#endif
    const hipError_t le = hipPeekAtLastError();
    if (le != hipSuccess) fprintf(stderr, "kernel_launch: launch failed: %s\n", hipGetErrorName(le));
#endif
}
```
